# Optimizing an MI355X kernel written in HIP

```python
import jax, jax.numpy as jnp
from jax import lax
import numpy as np


D_MODEL = 1024
BATCH = 16
SEQ = 4096
DEPTH = 4

CTX_LEN = 256
GRID_W = 64
HEAD_DIM = 128
D_LRU = D_MODEL
LRU_BLOCK_W = 64
LRU_BLOCKS = D_LRU // LRU_BLOCK_W
LRU_C = 8.0
CONV_W = 4
CONV_LEFT = 2
N_HEADS_W = D_MODEL // HEAD_DIM
N_KV_W = N_HEADS_W // 4
WINDOW = 128
N_HEADS_G = D_MODEL // HEAD_DIM
N_KV_G = N_HEADS_G // 4
Q_BLOCK = 128
ROPE_THETA = 10000.0
EPS = 1e-6
NEG_INF = -1e30
N_BRANCH = 3
BRANCH_W = D_MODEL

QW_W, KVW_W = N_HEADS_W * HEAD_DIM, N_KV_W * HEAD_DIM
QW_G, KVW_G = N_HEADS_G * HEAD_DIM, N_KV_G * HEAD_DIM
IN_WIDTHS = (D_LRU, D_LRU,
             QW_W, KVW_W, KVW_W, QW_W,
             QW_G, KVW_G, KVW_G, QW_G,
             D_MODEL, D_MODEL, D_MODEL)
IN_WIDTH = sum(IN_WIDTHS)
SPLIT_POINTS = tuple(int(v) for v in np.cumsum(IN_WIDTHS)[:-1])

kernel_name = "hybrid_rglru_window_axial_prefix_block"


def rmsnorm(x, g):
    xf = x.astype(jnp.float32)
    y = xf * lax.rsqrt(jnp.mean(xf * xf, axis=-1, keepdims=True) + EPS)
    return y.astype(x.dtype) * g


def axial_rope_tables(S):
    rows = S // GRID_W
    row_id = jnp.repeat(jnp.arange(rows), GRID_W)
    col_id = jnp.tile(jnp.arange(GRID_W), rows)
    P = HEAD_DIM // 4
    inv = ROPE_THETA ** (-jnp.arange(P, dtype=jnp.float32) / P)
    ang = jnp.stack([row_id[:, None] * inv, col_id[:, None] * inv], axis=1)
    return jnp.cos(ang), jnp.sin(ang)


def rope_2d(x, cos, sin):
    B, T, H, hd = x.shape
    xs = x.reshape(B, T, H, 2, 2, hd // 4)
    x0, x1 = xs[..., 0, :], xs[..., 1, :]
    c, s = cos[None, :, None], sin[None, :, None]
    return jnp.stack([x0 * c - x1 * s, x1 * c + x0 * s], axis=-2).reshape(B, T, H, hd).astype(x.dtype)


def dwconv(u, w, b):
    T = u.shape[1]
    up = jnp.pad(u, ((0, 0), (CONV_LEFT, CONV_W - 1 - CONV_LEFT), (0, 0)))
    return sum(up[:, k:k + T] * w[k] for k in range(CONV_W)) + b


def lru_coeffs(u, wa, ba, wx, bx, lam):
    ub = u.reshape(*u.shape[:-1], LRU_BLOCKS, LRU_BLOCK_W)
    r = jax.nn.sigmoid(jnp.einsum('btnd,nde->btne', ub, wa).reshape(u.shape) + ba)
    i = jax.nn.sigmoid(jnp.einsum('btnd,nde->btne', ub, wx).reshape(u.shape) + bx)
    log_a = -LRU_C * r.astype(jnp.float32) * jax.nn.softplus(-lam.astype(jnp.float32))
    a = jnp.exp(log_a)
    b = jnp.sqrt(-jnp.expm1(2.0 * log_a)) * (i * u).astype(jnp.float32)
    return a, b


def _combine(left, right):
    a1, b1 = left
    a2, b2 = right
    return a1 * a2, a2 * b1 + b2


def linear_scan(a, b, reverse):
    return lax.associative_scan(_combine, (a, b), reverse=reverse, axis=1)[1]


def rglru_branch(u, uc, conv_w, conv_b, wa, ba, wx, bx, lam):
    u = dwconv(u, conv_w, conv_b)
    uc = dwconv(uc, conv_w, conv_b)
    y, yc = 0.0, 0.0
    for d, rev in enumerate((False, True)):
        ac, bc = lru_coeffs(uc, wa[d], ba[d], wx[d], bx[d], lam[d])
        hc = linear_scan(ac, bc, rev)
        a, b = lru_coeffs(u, wa[d], ba[d], wx[d], bx[d], lam[d])
        if rev:
            b = b.at[:, -1].add(a[:, -1] * hc[:, 0])
        else:
            b = b.at[:, 0].add(a[:, 0] * hc[:, -1])
        y = y + linear_scan(a, b, rev)
        yc = yc + hc
    return y.astype(u.dtype), yc.astype(u.dtype)


def attend(q, kv_sets, sink):
    scale = q.shape[-1] ** -0.5
    logits = []
    for k, v, mask in kv_sets:
        s = jnp.einsum('bqkgd,bjkd->bkgqj', q, k).astype(jnp.float32) * scale
        if mask is not None:
            s = jnp.where(mask, s, NEG_INF)
        logits.append(s)
    if sink is not None:
        B, Q, KVH, G, _ = q.shape
        logits.append(jnp.broadcast_to(sink.astype(jnp.float32).reshape(1, KVH, G, 1, 1), (B, KVH, G, Q, 1)))
    p = jax.nn.softmax(jnp.concatenate(logits, axis=-1), axis=-1)
    out, off = 0.0, 0
    for k, v, _ in kv_sets:
        J = k.shape[1]
        out = out + jnp.einsum('bkgqj,bjkd->bqkgd', p[..., off:off + J].astype(v.dtype), v)
        off += J
    return out


def latent_attention(q, k, v, kc, vc, sink, window):
    B, S, H, hd = q.shape
    KVH = k.shape[2]
    nblk = S // Q_BLOCK
    qb = q.reshape(B, nblk, Q_BLOCK, KVH, H // KVH, hd).swapaxes(0, 1)
    if window is None:
        out = lax.map(lambda qn: attend(qn, [(k, v, None), (kc, vc, None)], sink), qb)
    else:
        span = Q_BLOCK + 2 * window
        pad = ((0, 0), (window, window), (0, 0), (0, 0))
        kp, vp = jnp.pad(k, pad), jnp.pad(v, pad)

        def body(args):
            n, qn = args
            start = n * Q_BLOCK
            kn = lax.dynamic_slice_in_dim(kp, start, span, axis=1)
            vn = lax.dynamic_slice_in_dim(vp, start, span, axis=1)
            qpos = start + jnp.arange(Q_BLOCK)
            kpos = start - window + jnp.arange(span)
            mask = (jnp.abs(kpos[None, :] - qpos[:, None]) <= window) & (kpos >= 0)[None, :] & (kpos < S)[None, :]
            return attend(qn, [(kn, vn, mask), (kc, vc, None)], sink)

        out = lax.map(body, (jnp.arange(nblk), qb))
    return out.swapaxes(0, 1).reshape(B, S, H * hd)


def context_attention(q, k, v, sink):
    B, L, H, hd = q.shape
    KVH = k.shape[2]
    o = attend(q.reshape(B, L, KVH, H // KVH, hd), [(k, v, None)], sink)
    return o.reshape(B, L, H * hd)


def heads(t, n):
    return t.reshape(*t.shape[:-1], n, HEAD_DIM)


def merge_branches(ys, gate_paths, merge_logits, w_branch, w_out):
    out = 0.0
    for n in range(N_BRANCH):
        out = out + jax.nn.sigmoid(merge_logits[n]) * ((ys[n] * jax.nn.silu(gate_paths[n])) @ w_branch[n])
    return out @ w_out


def setup_inputs(seed: int = 0) -> dict:
    key = jax.random.key(seed)
    ks = jax.random.split(key, 24)
    nrm = lambda k, shape, s: jax.random.normal(k, shape, jnp.float32) * s
    x = nrm(ks[0], (BATCH, SEQ, D_MODEL), 1.0)
    c = nrm(ks[1], (BATCH, D_MODEL), 1.0)
    ctx = nrm(ks[2], (BATCH, CTX_LEN, D_MODEL), 1.0)
    c_ctx = nrm(ks[3], (D_MODEL,), 1.0)
    norm_g = 1.0 + nrm(ks[4], (DEPTH, D_MODEL), 0.02)
    w_mod = nrm(ks[5], (DEPTH, D_MODEL, 3 * D_MODEL), 0.5 * D_MODEL ** -0.5)
    b_mod = nrm(ks[6], (DEPTH, 3 * D_MODEL), 0.02)
    w_in = nrm(ks[7], (DEPTH, D_MODEL, IN_WIDTH), D_MODEL ** -0.5)
    conv_w = nrm(ks[8], (DEPTH, CONV_W, D_LRU), CONV_W ** -0.5)
    conv_b = nrm(ks[9], (DEPTH, D_LRU), 0.02)
    lru_wa = nrm(ks[10], (DEPTH, 2, LRU_BLOCKS, LRU_BLOCK_W, LRU_BLOCK_W), LRU_BLOCK_W ** -0.5)
    lru_ba = nrm(ks[11], (DEPTH, 2, D_LRU), 0.1)
    lru_wx = nrm(ks[12], (DEPTH, 2, LRU_BLOCKS, LRU_BLOCK_W, LRU_BLOCK_W), LRU_BLOCK_W ** -0.5)
    lru_bx = nrm(ks[13], (DEPTH, 2, D_LRU), 0.1)
    u = jax.random.uniform(ks[14], (DEPTH, 2, D_LRU), jnp.float32, 0.9, 0.999)
    a = u ** (1.0 / LRU_C)
    lru_lambda = jnp.log(a) - jnp.log1p(-a)
    attn_sink = nrm(ks[15], (DEPTH, N_HEADS_W), 0.5)
    q_norm_g = 1.0 + nrm(ks[16], (DEPTH, HEAD_DIM), 0.02)
    k_norm_g = 1.0 + nrm(ks[17], (DEPTH, HEAD_DIM), 0.02)
    w_branch = nrm(ks[18], (DEPTH, N_BRANCH, BRANCH_W, D_MODEL), BRANCH_W ** -0.5)
    w_out = nrm(ks[19], (DEPTH, D_MODEL, D_MODEL), D_MODEL ** -0.5)
    final_g = 1.0 + nrm(ks[20], (D_MODEL,), 0.02)
    return {"x": x, "c": c, "ctx": ctx, "c_ctx": c_ctx, "norm_g": norm_g, "w_mod": w_mod, "b_mod": b_mod,
            "w_in": w_in, "conv_w": conv_w, "conv_b": conv_b, "lru_wa": lru_wa, "lru_ba": lru_ba,
            "lru_wx": lru_wx, "lru_bx": lru_bx, "lru_lambda": lru_lambda, "attn_sink": attn_sink,
            "q_norm_g": q_norm_g, "k_norm_g": k_norm_g, "w_branch": w_branch, "w_out": w_out,
            "final_g": final_g}


def reference(x, c, ctx, c_ctx, norm_g, w_mod, b_mod, w_in, conv_w, conv_b, lru_wa, lru_ba, lru_wx, lru_bx,
              lru_lambda, attn_sink, q_norm_g, k_norm_g, w_branch, w_out, final_g):
    S = x.shape[1]
    cos, sin = axial_rope_tables(S)
    sc, scc = jax.nn.silu(c), jax.nn.silu(c_ctx)
    xc = ctx
    for l in range(DEPTH):
        last = l == DEPTH - 1
        shift, scale, gate = jnp.split(sc @ w_mod[l] + b_mod[l], 3, axis=-1)
        shift_c, scale_c, gate_c = jnp.split(scc @ w_mod[l] + b_mod[l], 3, axis=-1)
        h = rmsnorm(x, norm_g[l]) * (1.0 + scale[:, None]) + shift[:, None]
        hc = rmsnorm(xc, norm_g[l]) * (1.0 + scale_c) + shift_c
        w_parts = jnp.split(w_in[l], SPLIT_POINTS, axis=1)
        uA, gA, qB, kB, vB, gB, qC, kC, vC, gC, mA, mB, mC = [h @ w for w in w_parts]
        uAc, gAc, qBc, kBc, vBc, gBc, qCc, kCc, vCc, gCc, mAc, mBc, mCc = [hc @ w for w in w_parts]
        yA, yAc = rglru_branch(uA, uAc, conv_w[l], conv_b[l], lru_wa[l], lru_ba[l], lru_wx[l], lru_bx[l], lru_lambda[l])
        kBc_h, vBc_h = heads(kBc, N_KV_W), heads(vBc, N_KV_W)
        yB = latent_attention(rope_2d(heads(qB, N_HEADS_W), cos, sin), rope_2d(heads(kB, N_KV_W), cos, sin),
                              heads(vB, N_KV_W), kBc_h, vBc_h, attn_sink[l], WINDOW)
        kCc_h, vCc_h = rmsnorm(heads(kCc, N_KV_G), k_norm_g[l]), heads(vCc, N_KV_G)
        yC = latent_attention(rope_2d(rmsnorm(heads(qC, N_HEADS_G), q_norm_g[l]), cos, sin),
                              rope_2d(rmsnorm(heads(kC, N_KV_G), k_norm_g[l]), cos, sin),
                              heads(vC, N_KV_G), kCc_h, vCc_h, None, None)
        y = merge_branches((yA, yB, yC), (gA, gB, gC), (mA, mB, mC), w_branch[l], w_out[l])
        if not last:
            yBc = context_attention(heads(qBc, N_HEADS_W), kBc_h, vBc_h, attn_sink[l])
            yCc = context_attention(rmsnorm(heads(qCc, N_HEADS_G), q_norm_g[l]), kCc_h, vCc_h, None)
            yc = merge_branches((yAc, yBc, yCc), (gAc, gBc, gCc), (mAc, mBc, mCc), w_branch[l], w_out[l])
            xc = xc + gate_c * yc
        x = x + gate[:, None] * y
    return rmsnorm(x, final_g)
```

```cpp
#include <hip/hip_runtime.h>
#include <hip/hip_cooperative_groups.h>
#include <cstdio>
#include <cstdint>
namespace cg = cooperative_groups;

typedef unsigned short u16;
typedef __attribute__((ext_vector_type(8))) short bf16x8;
typedef __attribute__((ext_vector_type(4))) short s16x4;
typedef __attribute__((ext_vector_type(16))) float f32x16;
typedef __bf16 bf16x2_t __attribute__((ext_vector_type(2)));
typedef float float2_t __attribute__((ext_vector_type(2)));
typedef __attribute__((ext_vector_type(4))) unsigned u32x4;
typedef __attribute__((ext_vector_type(2))) unsigned u32x2;

#define DI __device__ __forceinline__
#define MFMA32(a, b, c) __builtin_amdgcn_mfma_f32_32x32x16_bf16((a), (b), (c), 0, 0, 0)

constexpr int D = 1024, NBATCH = 16, S = 4096, L = 256, DEPTH = 4, INW = 10240;
constexpr int LDS_BYTES = 73728;
constexpr float EPS = 1e-6f;
constexpr float QSCALE = 0.08838834764831845f * 1.4426950408889634f;
constexpr float LOG2E = 1.4426950408889634f;

struct Params {
  const float *x, *c, *ctx, *c_ctx, *norm_g, *w_mod, *b_mod, *w_in, *conv_w, *conv_b, *lru_wa, *lru_ba, *lru_wx, *lru_bx,
      *lru_lambda, *attn_sink, *q_norm_g, *k_norm_g, *w_branch, *w_out, *final_g;
  float* out;
  u16 *WinT, *WbT, *WoT;
  u16 *Hb, *U, *Z, *Q, *Kb, *VtL, *VtC, *Ms;
  float *modv, *sc, *rope, *xc;
  int* ctr;
  int NB;
  int nchunk;
};

DI unsigned pack2(float a, float b) {
  float2_t f = {a, b};
  bf16x2_t v = __builtin_convertvector(f, bf16x2_t);
  return __builtin_bit_cast(unsigned, v);
}
DI float bf2f(u16 v) { return __uint_as_float(((unsigned)v) << 16); }
DI float bflo(unsigned v) { return __uint_as_float(v << 16); }
DI float bfhi(unsigned v) { return __uint_as_float(v & 0xffff0000u); }
DI float sigmoidf_(float x) { return 1.f / (1.f + __expf(-x)); }
DI float siluf_(float x) { return x / (1.f + __expf(-x)); }
DI int otid() { int t = threadIdx.x; asm volatile("" : "+v"(t)); return t; }
DI int crow(int i, int hh) { return (i & 3) + 8 * (i >> 2) + 4 * hh; }

DI void phase0(const Params& p, char* lds) {
  const int tid = otid();
  float* tile = (float*)lds;
  const int n_in = DEPTH * 16 * 160, n_b = DEPTH * 3 * 256, n_o = DEPTH * 256;
  for (int it = blockIdx.x; it < n_in + n_b + n_o; it += gridDim.x) {
    const float* src; u16* dst; int ldsrc;
    if (it < n_in) {
      int l = it / 2560, rem = it % 2560, kt = rem / 160, nt = rem % 160;
      src = p.w_in + (size_t)l * D * INW + (size_t)(kt * 64) * INW + nt * 64; ldsrc = INW;
      dst = p.WinT + (size_t)l * INW * D + (size_t)(nt * 64) * D + kt * 64;
    } else if (it < n_in + n_b) {
      int i2 = it - n_in; int mat = i2 / 256, rem = i2 % 256, kt = rem / 16, nt = rem % 16;
      src = p.w_branch + (size_t)mat * D * D + (size_t)(kt * 64) * D + nt * 64; ldsrc = D;
      dst = p.WbT + (size_t)mat * D * D + (size_t)(nt * 64) * D + kt * 64;
    } else {
      int i2 = it - n_in - n_b; int mat = i2 / 256, rem = i2 % 256, kt = rem / 16, nt = rem % 16;
      src = p.w_out + (size_t)mat * D * D + (size_t)(kt * 64) * D + nt * 64; ldsrc = D;
      dst = p.WoT + (size_t)mat * D * D + (size_t)(nt * 64) * D + kt * 64;
    }
    __syncthreads();
#pragma unroll
    for (int i = 0; i < 4; ++i) {
      int c = tid + 256 * i; int row = c >> 4, c4 = c & 15;
      float4 v = *(const float4*)(src + (size_t)row * ldsrc + c4 * 4);
      float* t = tile + row * 65 + c4 * 4;
      t[0] = v.x; t[1] = v.y; t[2] = v.z; t[3] = v.w;
    }
    __syncthreads();
#pragma unroll
    for (int i = 0; i < 2; ++i) {
      int c = tid + 256 * i; int nrow = c >> 3, k8 = c & 7;
      float v[8];
#pragma unroll
      for (int j = 0; j < 8; ++j) v[j] = tile[(k8 * 8 + j) * 65 + nrow];
      uint4 o; o.x = pack2(v[0], v[1]); o.y = pack2(v[2], v[3]); o.z = pack2(v[4], v[5]); o.w = pack2(v[6], v[7]);
      *(uint4*)(dst + (size_t)nrow * D + k8 * 8) = o;
    }
  }
  const int gt = blockIdx.x * 256 + tid, gn = gridDim.x * 256;
  for (int i = gt; i < 17 * D; i += gn) {
    int r = i / D, k = i % D;
    float v = (r < 16) ? p.c[r * D + k] : p.c_ctx[k];
    p.sc[i] = siluf_(v);
  }
  for (int i = gt; i < 64 * 32; i += gn) {
    int pos = i >> 5, pp = i & 31;
    float inv = powf(10000.f, -(float)pp / 32.f);
    float ang = (float)pos * inv;
    p.rope[i] = cosf(ang);
    p.rope[2048 + i] = sinf(ang);
  }
  if (blockIdx.x == 0 && tid < 64) p.ctr[tid] = 0;
}

DI void phase_mod(const Params& p, char* lds) {
  const int tid = otid();
  float* red = (float*)lds;
  const int col = tid & 63, kg = tid >> 6;
  for (int it = blockIdx.x; it < DEPTH * 48; it += gridDim.x) {
    int l = it / 48, cb = it % 48;
    float acc[17];
#pragma unroll
    for (int r = 0; r < 17; ++r) acc[r] = 0.f;
    const float* w = p.w_mod + (size_t)l * D * 3072 + cb * 64 + col;
    for (int k = kg * 256; k < kg * 256 + 256; ++k) {
      float wv = w[(size_t)k * 3072];
#pragma unroll
      for (int r = 0; r < 17; ++r) acc[r] += p.sc[r * D + k] * wv;
    }
    __syncthreads();
#pragma unroll
    for (int r = 0; r < 17; ++r) red[(kg * 17 + r) * 64 + col] = acc[r];
    __syncthreads();
    for (int i = tid; i < 17 * 64; i += 256) {
      int r = i >> 6, cc = i & 63;
      float s = red[(0 * 17 + r) * 64 + cc] + red[(1 * 17 + r) * 64 + cc] + red[(2 * 17 + r) * 64 + cc] + red[(3 * 17 + r) * 64 + cc];
      p.modv[((size_t)l * 17 + r) * 3072 + cb * 64 + cc] = s + p.b_mod[l * 3072 + cb * 64 + cc];
    }
  }
}

DI void phase_prenorm(const Params& p, int chunk, int l) {
  const int NB = p.NB, RL = NB * S, R = NB * (S + L);
  const int tid_ = otid();
  const int lane = tid_ & 63;
  const int wg = blockIdx.x * 4 + (tid_ >> 6), nw = gridDim.x * 4;
  const float* g = p.norm_g + l * D;
  for (int r = wg; r < R; r += nw) {
    const float* src; int mrow;
    if (r < RL) {
      int b = r / S, t = r % S; int bg = chunk * NB + b;
      src = (l == 0 ? p.x : p.out) + ((size_t)bg * S + t) * D; mrow = bg;
    } else {
      int rc = r - RL; int b = rc / L, t = rc % L; int bg = chunk * NB + b;
      src = (l == 0 ? p.ctx : p.xc) + ((size_t)bg * L + t) * D; mrow = 16;
    }
    const float* mv = p.modv + ((size_t)l * 17 + mrow) * 3072;
    float4 v[4]; float ss = 0.f;
#pragma unroll
    for (int i = 0; i < 4; ++i) {
      v[i] = *(const float4*)(src + i * 256 + lane * 4);
      ss += v[i].x * v[i].x + v[i].y * v[i].y + v[i].z * v[i].z + v[i].w * v[i].w;
    }
#pragma unroll
    for (int o = 32; o >= 1; o >>= 1) ss += __shfl_xor(ss, o);
    float rstd = rsqrtf(ss * (1.f / D) + EPS);
#pragma unroll
    for (int i = 0; i < 4; ++i) {
      int cidx = i * 256 + lane * 4;
      float4 gg = *(const float4*)(g + cidx);
      float4 sh = *(const float4*)(mv + cidx);
      float4 scl = *(const float4*)(mv + 1024 + cidx);
      float h0 = v[i].x * rstd * gg.x * (1.f + scl.x) + sh.x;
      float h1 = v[i].y * rstd * gg.y * (1.f + scl.y) + sh.y;
      float h2 = v[i].z * rstd * gg.z * (1.f + scl.z) + sh.z;
      float h3 = v[i].w * rstd * gg.w * (1.f + scl.w) + sh.w;
      uint2 o; o.x = pack2(h0, h1); o.y = pack2(h2, h3);
      *(uint2*)(p.Hb + (size_t)r * D + cidx) = o;
    }
  }
}

DI void gemm_core(const u16* A, int lda, const u16* Bt, int ldb, int K, char* ldsc, f32x16 (&acc)[2][2]) {
  const int tid = otid(), lane = tid & 63, w = tid >> 6, wm = w >> 1, wn = w & 1;
  const int r = lane & 31, hh = lane >> 5;
  u16* sA = (u16*)ldsc;
  u16* sB = sA + 2 * 128 * 72;
  const int lrow = tid >> 3, lc = (tid & 7) * 8;
  const u16* Ap = A + (size_t)lrow * lda + lc;
  const u16* Bp = Bt + (size_t)lrow * ldb + lc;
  u32x4 ra[4], rb[4];
#pragma unroll
  for (int i = 0; i < 2; ++i)
#pragma unroll
    for (int j = 0; j < 2; ++j)
#pragma unroll
      for (int x = 0; x < 16; ++x) acc[i][j][x] = 0.f;
#pragma unroll
  for (int i = 0; i < 4; ++i) {
    ra[i] = *(const u32x4*)(Ap + (size_t)(32 * i) * lda);
    rb[i] = *(const u32x4*)(Bp + (size_t)(32 * i) * ldb);
  }
  __syncthreads();
#pragma unroll
  for (int i = 0; i < 4; ++i) {
    *(u32x4*)(sA + (lrow + 32 * i) * 72 + lc) = ra[i];
    *(u32x4*)(sB + (lrow + 32 * i) * 72 + lc) = rb[i];
  }
  __syncthreads();
  const int KT = K >> 6;
  for (int kt = 0; kt < KT; ++kt) {
    const int cur = kt & 1;
    if (kt + 1 < KT) {
#pragma unroll
      for (int i = 0; i < 4; ++i) {
        ra[i] = *(const u32x4*)(Ap + (size_t)(32 * i) * lda + (kt + 1) * 64);
        rb[i] = *(const u32x4*)(Bp + (size_t)(32 * i) * ldb + (kt + 1) * 64);
      }
    }
    const u16* ab = sA + cur * 128 * 72 + (wm * 64 + r) * 72 + hh * 8;
    const u16* bb = sB + cur * 128 * 72 + (wn * 64 + r) * 72 + hh * 8;
#pragma unroll
    for (int ks = 0; ks < 4; ++ks) {
      bf16x8 a0 = *(const bf16x8*)(ab + ks * 16);
      bf16x8 a1 = *(const bf16x8*)(ab + 32 * 72 + ks * 16);
      bf16x8 b0 = *(const bf16x8*)(bb + ks * 16);
      bf16x8 b1 = *(const bf16x8*)(bb + 32 * 72 + ks * 16);
      acc[0][0] = MFMA32(a0, b0, acc[0][0]);
      acc[0][1] = MFMA32(a0, b1, acc[0][1]);
      acc[1][0] = MFMA32(a1, b0, acc[1][0]);
      acc[1][1] = MFMA32(a1, b1, acc[1][1]);
    }
    if (kt + 1 < KT) {
      u16* sa2 = sA + (cur ^ 1) * 128 * 72;
      u16* sb2 = sB + (cur ^ 1) * 128 * 72;
#pragma unroll
      for (int i = 0; i < 4; ++i) {
        *(u32x4*)(sa2 + (lrow + 32 * i) * 72 + lc) = ra[i];
        *(u32x4*)(sb2 + (lrow + 32 * i) * 72 + lc) = rb[i];
      }
    }
    __syncthreads();
  }
}

DI void stage_acc(char* ldsc, f32x16 (&acc)[2][2]) {
  const int tid = otid(), lane = tid & 63, w = tid >> 6, wm = w >> 1, wn = w & 1;
  const int r = lane & 31, hh = lane >> 5;
  float* Cs = (float*)ldsc;
#pragma unroll
  for (int i = 0; i < 2; ++i)
#pragma unroll
    for (int j = 0; j < 2; ++j)
#pragma unroll
      for (int x = 0; x < 16; ++x) {
        int m = wm * 64 + i * 32 + crow(x, hh);
        int n = wn * 64 + j * 32 + r;
        Cs[m * 132 + n] = acc[i][j][x];
      }
  __syncthreads();
}

DI void read_row64(const char* ldsc, int row, int half, float (&v)[64]) {
  const float* Cs = (const float*)ldsc + row * 132 + half * 64;
#pragma unroll
  for (int j = 0; j < 16; ++j) {
    float4 t = *(const float4*)(Cs + j * 4);
    v[j * 4] = t.x; v[j * 4 + 1] = t.y; v[j * 4 + 2] = t.z; v[j * 4 + 3] = t.w;
  }
}

DI void store_row64_bf16(u16* dst, const float (&v)[64]) {
#pragma unroll
  for (int j = 0; j < 8; ++j) {
    uint4 o;
    o.x = pack2(v[j * 8], v[j * 8 + 1]); o.y = pack2(v[j * 8 + 2], v[j * 8 + 3]);
    o.z = pack2(v[j * 8 + 4], v[j * 8 + 5]); o.w = pack2(v[j * 8 + 6], v[j * 8 + 7]);
    *(uint4*)(dst + j * 8) = o;
  }
}

DI void phase_gemm_in(const Params& p, int chunk, int l, char* lds) {
  const int NB = p.NB, RL = NB * S, R = NB * (S + L);
  const int MT = R / 128, NT = 80;
  const int tid = otid();
  const int ntiles = MT * NT;
  const u16* Wt = p.WinT + (size_t)l * INW * D;
  for (int it = blockIdx.x; it < ntiles; it += gridDim.x) {
    int panel = it / (16 * NT), rem = it % (16 * NT);
    int mrem = MT - panel * 16; if (mrem > 16) mrem = 16;
    int nt = rem / mrem, mt = panel * 16 + rem % mrem;
    const int m0 = mt * 128, n0 = nt * 128;
    f32x16 acc[2][2];
    gemm_core(p.Hb + (size_t)m0 * D, D, Wt + (size_t)n0 * D, D, D, lds, acc);
    stage_acc(lds, acc);
    const bool lat = m0 < RL;
    int b, t0;
    if (lat) { b = m0 / S; t0 = m0 % S; } else { int rc = m0 - RL; b = rc / L; t0 = rc % L; }
    const bool isV = (nt == 26 || nt == 27 || nt == 46 || nt == 47);
    if (isV) {
      int slot = (nt < 40) ? (nt - 26) : (2 + nt - 46);
      int d = tid >> 1, th = tid & 1;
      const float* Cs = (const float*)lds;
      float v[64];
#pragma unroll
      for (int j = 0; j < 64; ++j) v[j] = Cs[(th * 64 + j) * 132 + d];
      u16* dst = lat ? p.VtL + ((size_t)(b * 4 + slot) * 128 + d) * S + t0 + th * 64
                     : p.VtC + ((size_t)(b * 4 + slot) * 128 + d) * L + t0 + th * 64;
      store_row64_bf16(dst, v);
    } else {
      const int row = tid >> 1, half = tid & 1;
      const size_t gr = (size_t)m0 + row;
      const int t = t0 + row;
      float v[64];
      read_row64(lds, row, half, v);
      if (nt < 8) {
        store_row64_bf16(p.U + gr * D + nt * 128 + half * 64, v);
      } else if (nt < 16 || (nt >= 28 && nt < 36) || (nt >= 48 && nt < 56)) {
        int zc = (nt < 16) ? (nt - 8) * 128 : (nt < 36 ? 1024 + (nt - 28) * 128 : 2048 + (nt - 48) * 128);
#pragma unroll
        for (int j = 0; j < 64; ++j) v[j] = siluf_(v[j]);
        store_row64_bf16(p.Z + gr * 3072 + zc + half * 64, v);
      } else if (nt >= 56) {
#pragma unroll
        for (int j = 0; j < 64; ++j) v[j] = sigmoidf_(v[j]);
        store_row64_bf16(p.Ms + gr * 3072 + (nt - 56) * 128 + half * 64, v);
      } else {
        const bool isC = nt >= 36;
        const bool isQ = (nt >= 16 && nt < 24) || (nt >= 36 && nt < 44);
        if (isC) {
          const float* gn = (isQ ? p.q_norm_g : p.k_norm_g) + l * 128 + half * 64;
          float ss = 0.f;
#pragma unroll
          for (int j = 0; j < 64; ++j) ss += v[j] * v[j];
          ss += __shfl_xor(ss, 1);
          float rstd = rsqrtf(ss * (1.f / 128.f) + EPS);
#pragma unroll
          for (int j = 0; j < 64; ++j) v[j] = v[j] * rstd * gn[j];
        }
        if (lat) {
          int pos = (half == 0) ? (t >> 6) : (t & 63);
          const float* cs = p.rope + pos * 32;
          const float* sn = p.rope + 2048 + pos * 32;
#pragma unroll
          for (int j = 0; j < 32; ++j) {
            float c_ = cs[j], s_ = sn[j];
            float x0 = v[j], x1 = v[32 + j];
            v[j] = x0 * c_ - x1 * s_;
            v[32 + j] = x1 * c_ + x0 * s_;
          }
        }
        if (isQ) {
#pragma unroll
          for (int j = 0; j < 64; ++j) v[j] *= QSCALE;
          int qc = isC ? 1024 + (nt - 36) * 128 : (nt - 16) * 128;
          store_row64_bf16(p.Q + gr * 2048 + qc + half * 64, v);
        } else {
          int kc = isC ? 256 + (nt - 44) * 128 : (nt - 24) * 128;
          store_row64_bf16(p.Kb + gr * 512 + kc + half * 64, v);
        }
      }
    }
  }
}

struct AttnArgs {
  const u16* q;
  u16* z;
  const u16* kctx;
  const u16* vctx;
  const u16* klat;
  const u16* vlat;
  int n_lat_tiles;
  int lat_key0;
  int q_t0;
  int band;
  int has_sink;
  float sink_l2;
};

DI void attn_load_tile(const AttnArgs& a, int ti, u32x4 (&rk)[4], u32x4 (&rv)[4]) {
  const int tid = otid();
  const u16* kp; const u16* vp; int vs;
  if (ti < 4) { kp = a.kctx + (size_t)(ti * 64) * 512; vp = a.vctx + ti * 64; vs = L; }
  else { kp = a.klat + (size_t)((ti - 4) * 64) * 512; vp = a.vlat + (ti - 4) * 64; vs = S; }
#pragma unroll
  for (int i = 0; i < 4; ++i) {
    int c = tid + 256 * i;
    rk[i] = *(const u32x4*)(kp + (size_t)(c >> 4) * 512 + (c & 15) * 8);
    rv[i] = *(const u32x4*)(vp + (size_t)(c >> 3) * vs + (c & 7) * 8);
  }
}
DI void attn_store_tile(u16* sK, u16* sV, const u32x4 (&rk)[4], const u32x4 (&rv)[4]) {
  const int tid = otid();
#pragma unroll
  for (int i = 0; i < 4; ++i) {
    int c = tid + 256 * i;
    *(u32x4*)(sK + (c >> 4) * 136 + (c & 15) * 8) = rk[i];
    u16* vd = sV + (c >> 3) * 68 + (c & 7) * 8;
    { u32x2 t0 = {rv[i].x, rv[i].y}; *(u32x2*)(vd) = t0; }
    { u32x2 t1 = {rv[i].z, rv[i].w}; *(u32x2*)(vd + 4) = t1; }
  }
}

DI void attn_item(const AttnArgs& a, char* lds) {
  const int tid = otid(), lane = tid & 63, w = tid >> 6;
  const int r = lane & 31, hh = lane >> 5;
  u16* sKb = (u16*)lds;
  u16* sVb = sKb + 2 * 64 * 136;
  const int ntiles = 4 + a.n_lat_tiles;

  bf16x8 qf[8];
  {
    const u16* qp = a.q + (size_t)(w * 32 + r) * 2048 + hh * 8;
#pragma unroll
    for (int ks = 0; ks < 8; ++ks) qf[ks] = *(const bf16x8*)(qp + ks * 16);
  }
  f32x16 O[4];
#pragma unroll
  for (int dt = 0; dt < 4; ++dt)
#pragma unroll
    for (int x = 0; x < 16; ++x) O[dt][x] = 0.f;
  float m = a.has_sink ? a.sink_l2 : -1e30f;
  float lsum = (a.has_sink && hh == 0) ? 1.f : 0.f;

  u32x4 rk[4], rv[4];
  attn_load_tile(a, 0, rk, rv);
  __syncthreads();
  attn_store_tile(sKb, sVb, rk, rv);
  __syncthreads();
  const int qpos = a.q_t0 + w * 32 + r;

  for (int ti = 0; ti < ntiles; ++ti) {
    const int cur = ti & 1;
    if (ti + 1 < ntiles) attn_load_tile(a, ti + 1, rk, rv);
    const u16* sK = sKb + cur * 64 * 136;
    const u16* sV = sVb + cur * 128 * 68;
    f32x16 s[2];
#pragma unroll
    for (int kt2 = 0; kt2 < 2; ++kt2) {
#pragma unroll
      for (int x = 0; x < 16; ++x) s[kt2][x] = 0.f;
      const u16* kb = sK + (kt2 * 32 + r) * 136 + hh * 8;
#pragma unroll
      for (int ks = 0; ks < 8; ++ks) {
        bf16x8 ka = *(const bf16x8*)(kb + ks * 16);
        s[kt2] = MFMA32(ka, qf[ks], s[kt2]);
      }
    }
    if (a.band && ti >= 4) {
      const int k0 = a.lat_key0 + (ti - 4) * 64;
#pragma unroll
      for (int kt2 = 0; kt2 < 2; ++kt2)
#pragma unroll
        for (int x = 0; x < 16; ++x) {
          int kp = k0 + kt2 * 32 + crow(x, hh);
          int dlt = kp - qpos; dlt = dlt < 0 ? -dlt : dlt;
          if (dlt > 128) s[kt2][x] = -1e30f;
        }
    }
    float mx = s[0][0];
#pragma unroll
    for (int kt2 = 0; kt2 < 2; ++kt2)
#pragma unroll
      for (int x = 0; x < 16; ++x) mx = fmaxf(mx, s[kt2][x]);
    mx = fmaxf(mx, __shfl_xor(mx, 32));
    const float mnew = fmaxf(m, mx);
    const float alpha = exp2f(m - mnew);
    m = mnew;
    float ps = 0.f;
#pragma unroll
    for (int kt2 = 0; kt2 < 2; ++kt2)
#pragma unroll
      for (int x = 0; x < 16; ++x) { float pv = exp2f(s[kt2][x] - mnew); s[kt2][x] = pv; ps += pv; }
    lsum = lsum * alpha + ps;
    if (__any(alpha != 1.f)) {
#pragma unroll
      for (int dt = 0; dt < 4; ++dt)
#pragma unroll
        for (int x = 0; x < 16; ++x) O[dt][x] *= alpha;
    }
#pragma unroll
    for (int kt2 = 0; kt2 < 2; ++kt2)
#pragma unroll
      for (int s2 = 0; s2 < 2; ++s2) {
        union { unsigned u[4]; bf16x8 v; } pf;
#pragma unroll
        for (int j = 0; j < 4; ++j) pf.u[j] = pack2(s[kt2][8 * s2 + 2 * j], s[kt2][8 * s2 + 2 * j + 1]);
        const u16* vb = sV + r * 68 + kt2 * 32 + 16 * s2 + 4 * hh;
#pragma unroll
        for (int dt = 0; dt < 4; ++dt) {
          s16x4 lo = *(const s16x4*)(vb + dt * 32 * 68);
          s16x4 hi = *(const s16x4*)(vb + dt * 32 * 68 + 8);
          bf16x8 va = __builtin_shufflevector(lo, hi, 0, 1, 2, 3, 4, 5, 6, 7);
          O[dt] = MFMA32(va, pf.v, O[dt]);
        }
      }
    if (ti + 1 < ntiles) attn_store_tile(sKb + (cur ^ 1) * 64 * 136, sVb + (cur ^ 1) * 128 * 68, rk, rv);
    __syncthreads();
  }
  float ltot = lsum + __shfl_xor(lsum, 32);
  const float inv = 1.f / ltot;
  u16* zp = a.z + (size_t)(w * 32 + r) * 3072;
#pragma unroll
  for (int dt = 0; dt < 4; ++dt)
#pragma unroll
    for (int g4 = 0; g4 < 4; ++g4) {
      int d0 = dt * 32 + 8 * g4 + 4 * hh;
      uint2 gv = *(const uint2*)(zp + d0);
      float y0 = O[dt][4 * g4 + 0] * inv * bflo(gv.x);
      float y1 = O[dt][4 * g4 + 1] * inv * bfhi(gv.x);
      float y2 = O[dt][4 * g4 + 2] * inv * bflo(gv.y);
      float y3 = O[dt][4 * g4 + 3] * inv * bfhi(gv.y);
      uint2 o; o.x = pack2(y0, y1); o.y = pack2(y2, y3);
      *(uint2*)(zp + d0) = o;
    }
}

template <bool REV>
DI void lru_scan(float (&av)[2][16], float (&bv)[2][16], float& carry, int hh) {
  float segA[8], segB[8];
#pragma unroll
  for (int k = 0; k < 8; ++k) {
    const int mt = k >> 2, q = k & 3;
    float cA = 1.f, hl = 0.f;
#pragma unroll
    for (int jj = 0; jj < 4; ++jj) {
      const int j = REV ? 3 - jj : jj;
      const int i = 4 * q + j;
      hl = av[mt][i] * hl + bv[mt][i];
      cA *= av[mt][i];
      av[mt][i] = cA; bv[mt][i] = hl;
    }
    segA[k] = cA; segB[k] = hl;
  }
  float oA[8], oB[8];
#pragma unroll
  for (int k = 0; k < 8; ++k) { oA[k] = __shfl_xor(segA[k], 32); oB[k] = __shfl_xor(segB[k], 32); }
  float init[8];
  float st = carry;
#pragma unroll
  for (int kk = 0; kk < 8; ++kk) {
    const int k = REV ? 7 - kk : kk;
    const int first = REV ? 1 : 0;
    float A1 = (hh == first) ? segA[k] : oA[k];
    float B1 = (hh == first) ? segB[k] : oB[k];
    float st0 = st;
    st = A1 * st + B1;
    float A2 = (hh == first) ? oA[k] : segA[k];
    float B2 = (hh == first) ? oB[k] : segB[k];
    float st1 = st;
    st = A2 * st + B2;
    init[k] = (hh == first) ? st0 : st1;
  }
  carry = st;
#pragma unroll
  for (int k = 0; k < 8; ++k) {
    const int mt = k >> 2, q = k & 3;
#pragma unroll
    for (int j = 0; j < 4; ++j) {
      const int i = 4 * q + j;
      bv[mt][i] = bv[mt][i] + av[mt][i] * init[k];
    }
  }
}

DI void lru_item(const Params& p, int l, int b, int n, bool last, char* lds) {
  const int NB = p.NB, RL = NB * S;
  const int tid = otid(), lane = tid & 63, w = tid >> 6;
  const int dir = w >> 1, w2 = w & 1;
  const int tl = tid & 127;
  const int r = lane & 31, hh = lane >> 5;
  u16* sRaw = (u16*)lds + dir * (8704 / 2);
  u16* sUp = (u16*)(lds + 17408) + dir * (9216 / 2);
  float* sH = (float*)(lds + 35840) + w * (64 * 36);

  const int chb = n * 64;
  const int cp = (tl & 31) * 2, tg = tl >> 5;
  float cw0[4], cw1[4], cb0, cb1;
#pragma unroll
  for (int k = 0; k < 4; ++k) {
    cw0[k] = p.conv_w[((size_t)l * 4 + k) * D + chb + cp];
    cw1[k] = p.conv_w[((size_t)l * 4 + k) * D + chb + cp + 1];
  }
  cb0 = p.conv_b[l * D + chb + cp]; cb1 = p.conv_b[l * D + chb + cp + 1];
  bf16x8 waf[4], wxf[4];
  {
    const float* wa = p.lru_wa + (((size_t)(l * 2 + dir) * 16 + n) * 64) * 64;
    const float* wx = p.lru_wx + (((size_t)(l * 2 + dir) * 16 + n) * 64) * 64;
    const int e = 32 * w2 + r;
#pragma unroll
    for (int ks = 0; ks < 4; ++ks) {
      union { unsigned u[4]; bf16x8 v; } fa, fx;
#pragma unroll
      for (int j = 0; j < 4; ++j) {
        int d0 = ks * 16 + 8 * hh + 2 * j;
        fa.u[j] = pack2(wa[d0 * 64 + e], wa[(d0 + 1) * 64 + e]);
        fx.u[j] = pack2(wx[d0 * 64 + e], wx[(d0 + 1) * 64 + e]);
      }
      waf[ks] = fa.v; wxf[ks] = fx.v;
    }
  }
  const int che = chb + 32 * w2 + r;
  const float ba = p.lru_ba[(l * 2 + dir) * D + che];
  const float bx = p.lru_bx[(l * 2 + dir) * D + che];
  float c8sp;
  {
    float lam = p.lru_lambda[(l * 2 + dir) * D + che];
    float sp = (lam < -20.f) ? -lam : log1pf(expf(-lam));
    c8sp = 8.f * sp;
  }
  float carry = 0.f;

  auto step_tile = [&](int st, bool& isctx, int& tt) {
    if (dir == 0) { if (st < 4) { isctx = true; tt = st; } else { isctx = false; tt = st - 4; } }
    else { if (st < 4) { isctx = true; tt = 3 - st; } else { isctx = false; tt = 63 - (st - 4); } }
  };
  u32x4 pre[5];
  auto load_raw = [&](int st) {
    bool isctx; int tt; step_tile(st, isctx, tt);
    const int seqlen = isctx ? L : S;
    const size_t rowbase = isctx ? (size_t)RL + (size_t)b * L : (size_t)b * S;
    const int t0 = tt * 64;
#pragma unroll
    for (int i = 0; i < 5; ++i) {
      int c = tl + 128 * i;
      int rr = c >> 3, c16 = c & 7;
      int t = t0 - 2 + rr;
      u32x4 v = {0u, 0u, 0u, 0u};
      if (rr < 67 && t >= 0 && t < seqlen) v = *(const u32x4*)(p.U + (rowbase + t) * D + chb + c16 * 8);
      pre[i] = v;
    }
  };
  load_raw(0);
  __syncthreads();
  for (int st = 0; st < 68; ++st) {
    bool isctx; int tt; step_tile(st, isctx, tt);
    const size_t rowbase = isctx ? (size_t)RL + (size_t)b * L : (size_t)b * S;
    const int t0 = tt * 64;
#pragma unroll
    for (int i = 0; i < 5; ++i) {
      int c = tl + 128 * i;
      int rr = c >> 3, c16 = c & 7;
      if (rr < 67) *(u32x4*)(sRaw + rr * 64 + c16 * 8) = pre[i];
    }
    if (st + 1 < 68) load_raw(st + 1);
    __syncthreads();
    {
      const u16* rp = sRaw + (tg * 16) * 64 + cp;
      unsigned r0 = *(const unsigned*)(rp), r1 = *(const unsigned*)(rp + 64), r2 = *(const unsigned*)(rp + 128);
#pragma unroll
      for (int i = 0; i < 16; ++i) {
        unsigned r3 = *(const unsigned*)(rp + (i + 3) * 64);
        float o0 = cb0 + cw0[0] * bflo(r0) + cw0[1] * bflo(r1) + cw0[2] * bflo(r2) + cw0[3] * bflo(r3);
        float o1 = cb1 + cw1[0] * bfhi(r0) + cw1[1] * bfhi(r1) + cw1[2] * bfhi(r2) + cw1[3] * bfhi(r3);
        *(unsigned*)(sUp + (tg * 16 + i) * 72 + cp) = pack2(o0, o1);
        r0 = r1; r1 = r2; r2 = r3;
      }
    }
    __syncthreads();
    float av[2][16], bv[2][16];
    {
      f32x16 aR[2];
#pragma unroll
      for (int mt = 0; mt < 2; ++mt) {
#pragma unroll
        for (int x = 0; x < 16; ++x) aR[mt][x] = 0.f;
        const u16* ub = sUp + (mt * 32 + r) * 72 + hh * 8;
#pragma unroll
        for (int ks = 0; ks < 4; ++ks) aR[mt] = MFMA32(*(const bf16x8*)(ub + ks * 16), waf[ks], aR[mt]);
      }
#pragma unroll
      for (int mt = 0; mt < 2; ++mt)
#pragma unroll
        for (int x = 0; x < 16; ++x) {
          const float rg = sigmoidf_(aR[mt][x] + ba);
          av[mt][x] = -c8sp * rg;
        }
    }
    {
      f32x16 aI[2];
#pragma unroll
      for (int mt = 0; mt < 2; ++mt) {
#pragma unroll
        for (int x = 0; x < 16; ++x) aI[mt][x] = 0.f;
        const u16* ub = sUp + (mt * 32 + r) * 72 + hh * 8;
#pragma unroll
        for (int ks = 0; ks < 4; ++ks) aI[mt] = MFMA32(*(const bf16x8*)(ub + ks * 16), wxf[ks], aI[mt]);
      }
#pragma unroll
      for (int mt = 0; mt < 2; ++mt)
#pragma unroll
        for (int x = 0; x < 16; ++x) {
          const int tok = mt * 32 + crow(x, hh);
          const float up = bf2f(sUp[tok * 72 + 32 * w2 + r]);
          const float ig = sigmoidf_(aI[mt][x] + bx);
          const float la = av[mt][x];
          const float om = -expm1f(2.f * la);
          av[mt][x] = __expf(la);
          bv[mt][x] = sqrtf(om) * (ig * up);
        }
    }
    if (dir == 0) lru_scan<false>(av, bv, carry, hh); else lru_scan<true>(av, bv, carry, hh);
#pragma unroll
    for (int mt = 0; mt < 2; ++mt)
#pragma unroll
      for (int x = 0; x < 16; ++x) sH[(mt * 32 + crow(x, hh)) * 36 + r] = bv[mt][x];
    const bool fwd_first = isctx ? (tt <= 1) : (tt <= 31);
    const bool first = (dir == 0) ? fwd_first : !fwd_first;
    if (!(isctx && last)) {
#pragma unroll
      for (int j = 0; j < 4; ++j) {
        const int q = lane + 64 * j;
        const int tok = q >> 2, cc = (q & 3) * 8;
        const float4 h0 = *(const float4*)(sH + tok * 36 + cc);
        const float4 h1 = *(const float4*)(sH + tok * 36 + cc + 4);
        const size_t row = rowbase + t0 + tok;
        const int col = chb + 32 * w2 + cc;
        u16* tp = p.Hb + row * D + col;
        if (first) {
          uint4 o; o.x = pack2(h0.x, h0.y); o.y = pack2(h0.z, h0.w); o.z = pack2(h1.x, h1.y); o.w = pack2(h1.z, h1.w);
          *(uint4*)tp = o;
        } else {
          unsigned long long t01 = __hip_atomic_load((const unsigned long long*)tp, __ATOMIC_RELAXED, __HIP_MEMORY_SCOPE_AGENT);
          unsigned long long t23 = __hip_atomic_load((const unsigned long long*)tp + 1, __ATOMIC_RELAXED, __HIP_MEMORY_SCOPE_AGENT);
          unsigned tx = (unsigned)t01, ty = (unsigned)(t01 >> 32), tz = (unsigned)t23, tw = (unsigned)(t23 >> 32);
          u16* zp = p.Z + row * 3072 + col;
          uint4 g = *(const uint4*)zp;
          uint4 o;
          o.x = pack2((h0.x + bflo(tx)) * bflo(g.x), (h0.y + bfhi(tx)) * bfhi(g.x));
          o.y = pack2((h0.z + bflo(ty)) * bflo(g.y), (h0.w + bfhi(ty)) * bfhi(g.y));
          o.z = pack2((h1.x + bflo(tz)) * bflo(g.z), (h1.y + bfhi(tz)) * bfhi(g.z));
          o.w = pack2((h1.z + bflo(tw)) * bflo(g.w), (h1.w + bfhi(tw)) * bfhi(g.w));
          *(uint4*)zp = o;
        }
      }
    }
    __threadfence();
  }
}

DI void phase_mixers(const Params& p, int chunk, int l, char* lds) {
  const int NB = p.NB, RL = NB * S;
  const bool last = (l == DEPTH - 1);
  const int nLRU = NB * 16, nC = NB * 8 * 32, nBw = NB * 8 * 32, nCtx = last ? 0 : NB * 8 * 2 * 2;
  const int total = nLRU + nC + nBw + nCtx;
  int* ctr = p.ctr + chunk * DEPTH + l;
  int* s_item = (int*)(lds + LDS_BYTES - 16);
  int it;
  while (true) {
    __syncthreads();
    if (threadIdx.x == 0) *s_item = atomicAdd(ctr, 1);
    __syncthreads();
    it = __builtin_amdgcn_readfirstlane(*s_item);
    __syncthreads();
    if (it >= nLRU) break;
    lru_item(p, l, it >> 4, it & 15, last, lds);
  }
  bool have = true;
  while (true) {
    if (!have) {
      __syncthreads();
      if (threadIdx.x == 0) *s_item = atomicAdd(ctr, 1);
      __syncthreads();
      it = __builtin_amdgcn_readfirstlane(*s_item);
      __syncthreads();
    }
    have = false;
    if (it >= total) break;
    it -= nLRU;
    AttnArgs a;
    if (it < nC + nBw) {
      const bool isB = it >= nC;
      if (isB) it -= nC;
      const int b = it >> 8, h = (it >> 5) & 7, qb = it & 31;
      const int kvh = h >> 2;
      const int br = isB ? 0 : 1;
      const size_t qrow0 = (size_t)b * S + qb * 128;
      a.q = p.Q + qrow0 * 2048 + br * 1024 + h * 128;
      a.z = p.Z + qrow0 * 3072 + (br + 1) * 1024 + h * 128;
      const int kcol = br * 256 + kvh * 128, slot = br * 2 + kvh;
      a.kctx = p.Kb + ((size_t)RL + (size_t)b * L) * 512 + kcol;
      a.vctx = p.VtC + (size_t)(b * 4 + slot) * 128 * L;
      int k0, k1;
      if (isB) { k0 = qb * 128 - 128; if (k0 < 0) k0 = 0; k1 = qb * 128 + 256; if (k1 > S) k1 = S; }
      else { k0 = 0; k1 = S; }
      a.lat_key0 = k0;
      a.n_lat_tiles = (k1 - k0) >> 6;
      a.klat = p.Kb + ((size_t)b * S + k0) * 512 + kcol;
      a.vlat = p.VtL + (size_t)(b * 4 + slot) * 128 * S + k0;
      a.q_t0 = qb * 128;
      a.band = isB ? 1 : 0;
      a.has_sink = isB ? 1 : 0;
      a.sink_l2 = isB ? p.attn_sink[l * 8 + h] * LOG2E : 0.f;
    } else {
      it -= nC + nBw;
      const int qb = it & 1, h = (it >> 1) & 7, br = (it >> 4) & 1, b = it >> 5;
      const int kvh = h >> 2;
      const size_t qrow0 = (size_t)RL + (size_t)b * L + qb * 128;
      a.q = p.Q + qrow0 * 2048 + br * 1024 + h * 128;
      a.z = p.Z + qrow0 * 3072 + (br + 1) * 1024 + h * 128;
      const int kcol = br * 256 + kvh * 128, slot = br * 2 + kvh;
      a.kctx = p.Kb + ((size_t)RL + (size_t)b * L) * 512 + kcol;
      a.vctx = p.VtC + (size_t)(b * 4 + slot) * 128 * L;
      a.klat = a.kctx; a.vlat = a.vctx;
      a.n_lat_tiles = 0; a.lat_key0 = 0; a.q_t0 = 0; a.band = 0;
      a.has_sink = (br == 0) ? 1 : 0;
      a.sink_l2 = (br == 0) ? p.attn_sink[l * 8 + h] * LOG2E : 0.f;
    }
    attn_item(a, lds);
  }
}

DI void phase_merge(const Params& p, int chunk, int l, char* lds) {
  const int NB = p.NB, RL = NB * S, R = NB * (S + L);
  const bool last = (l == DEPTH - 1);
  const int MT = (last ? RL : R) / 128, NT = 8;
  const int tid = otid();
  for (int it = blockIdx.x; it < MT * NT; it += gridDim.x) {
    const int mt = it / NT, nt = it % NT;
    const int m0 = mt * 128, n0 = nt * 128;
    const int row = tid >> 1, half = tid & 1;
    const size_t gr = (size_t)m0 + row;
    float tot[64];
#pragma unroll
    for (int j = 0; j < 64; ++j) tot[j] = 0.f;
#pragma unroll 1
    for (int n = 0; n < 3; ++n) {
      f32x16 acc[2][2];
      gemm_core(p.Z + (size_t)m0 * 3072 + n * 1024, 3072, p.WbT + ((size_t)(l * 3 + n) * D + n0) * D, D, D, lds, acc);
      stage_acc(lds, acc);
      const float* Cs = (const float*)lds + row * 132 + half * 64;
      const u16* sg = p.Ms + gr * 3072 + n * 1024 + n0 + half * 64;
#pragma unroll
      for (int j = 0; j < 8; ++j) {
        uint4 sv = *(const uint4*)(sg + j * 8);
        float4 c0 = *(const float4*)(Cs + j * 8);
        float4 c1 = *(const float4*)(Cs + j * 8 + 4);
        tot[j * 8 + 0] += bflo(sv.x) * c0.x; tot[j * 8 + 1] += bfhi(sv.x) * c0.y;
        tot[j * 8 + 2] += bflo(sv.y) * c0.z; tot[j * 8 + 3] += bfhi(sv.y) * c0.w;
        tot[j * 8 + 4] += bflo(sv.z) * c1.x; tot[j * 8 + 5] += bfhi(sv.z) * c1.y;
        tot[j * 8 + 6] += bflo(sv.w) * c1.z; tot[j * 8 + 7] += bfhi(sv.w) * c1.w;
      }
    }
    store_row64_bf16(p.Hb + gr * D + n0 + half * 64, tot);
  }
}

DI void phase_outproj(const Params& p, int chunk, int l, char* lds) {
  const int NB = p.NB, RL = NB * S, R = NB * (S + L);
  const bool last = (l == DEPTH - 1);
  const int MT = (last ? RL : R) / 128, NT = 8;
  const int tid = otid();
  for (int it = blockIdx.x; it < MT * NT; it += gridDim.x) {
    const int mt = it / NT, nt = it % NT;
    const int m0 = mt * 128, n0 = nt * 128;
    f32x16 acc[2][2];
    gemm_core(p.Hb + (size_t)m0 * D, D, p.WoT + ((size_t)l * D + n0) * D, D, D, lds, acc);
    stage_acc(lds, acc);
    const int row = tid >> 1, half = tid & 1;
    const int gr = m0 + row;
    const float* src; float* dst; int mrow;
    if (gr < RL) {
      int b = gr / S, t = gr % S; int bg = chunk * NB + b;
      size_t off = ((size_t)bg * S + t) * D + n0 + half * 64;
      src = (l == 0 ? p.x : p.out) + off; dst = p.out + off; mrow = bg;
    } else {
      int rc = gr - RL; int b = rc / L, t = rc % L; int bg = chunk * NB + b;
      size_t off = ((size_t)bg * L + t) * D + n0 + half * 64;
      src = (l == 0 ? p.ctx : p.xc) + off; dst = p.xc + off; mrow = 16;
    }
    const float* gate = p.modv + ((size_t)l * 17 + mrow) * 3072 + 2048 + n0 + half * 64;
    const float* Cs = (const float*)lds + row * 132 + half * 64;
#pragma unroll
    for (int j = 0; j < 16; ++j) {
      float4 cv = *(const float4*)(Cs + j * 4);
      float4 xv = *(const float4*)(src + j * 4);
      float4 gv = *(const float4*)(gate + j * 4);
      float4 o;
      o.x = xv.x + gv.x * cv.x; o.y = xv.y + gv.y * cv.y; o.z = xv.z + gv.z * cv.z; o.w = xv.w + gv.w * cv.w;
      *(float4*)(dst + j * 4) = o;
    }
  }
}

DI void phase_final(const Params& p) {
  const int tid_ = otid();
  const int lane = tid_ & 63;
  const int wg = blockIdx.x * 4 + (tid_ >> 6), nw = gridDim.x * 4;
  for (int r = wg; r < NBATCH * S; r += nw) {
    float* src = p.out + (size_t)r * D;
    float4 v[4]; float ss = 0.f;
#pragma unroll
    for (int i = 0; i < 4; ++i) {
      v[i] = *(const float4*)(src + i * 256 + lane * 4);
      ss += v[i].x * v[i].x + v[i].y * v[i].y + v[i].z * v[i].z + v[i].w * v[i].w;
    }
#pragma unroll
    for (int o = 32; o >= 1; o >>= 1) ss += __shfl_xor(ss, o);
    float rstd = rsqrtf(ss * (1.f / D) + EPS);
#pragma unroll
    for (int i = 0; i < 4; ++i) {
      int cidx = i * 256 + lane * 4;
      float4 gg = *(const float4*)(p.final_g + cidx);
      float4 o;
      o.x = v[i].x * rstd * gg.x; o.y = v[i].y * rstd * gg.y; o.z = v[i].z * rstd * gg.z; o.w = v[i].w * rstd * gg.w;
      *(float4*)(src + cidx) = o;
    }
  }
}

__global__ void __launch_bounds__(256, 2) fwd_megakernel(Params p) {
  cg::grid_group grid = cg::this_grid();
  __shared__ __attribute__((aligned(16))) char lds[LDS_BYTES];
  phase0(p, lds);
  grid.sync();
  phase_mod(p, lds);
  grid.sync();
  for (int chunk = 0; chunk < p.nchunk; ++chunk) {
    for (int l = 0; l < DEPTH; ++l) {
      phase_prenorm(p, chunk, l);
      grid.sync();
      phase_gemm_in(p, chunk, l, lds);
      grid.sync();
      phase_mixers(p, chunk, l, lds);
      grid.sync();
      phase_merge(p, chunk, l, lds);
      grid.sync();
      phase_outproj(p, chunk, l, lds);
      grid.sync();
    }
  }
  phase_final(p);
}

extern "C" void kernel_launch(void* const* d_in, const int* in_sizes, int n_in,
                              void* d_out, int out_size, void* d_ws, size_t ws_size,
                              hipStream_t stream) {
  static int grid_blocks = 0;
  if (!grid_blocks) {
    int dev = 0, cus = 0, per_cu = 0;
    (void)hipGetDevice(&dev);
    (void)hipDeviceGetAttribute(&cus, hipDeviceAttributeMultiprocessorCount, dev);
    (void)hipOccupancyMaxActiveBlocksPerMultiprocessor(&per_cu, fwd_megakernel, 256, 0);
    if (per_cu > 2) per_cu = 2;
    if (per_cu < 1) per_cu = 1;
    grid_blocks = cus * per_cu;
  }
  Params p{};
  const float* const* in = (const float* const*)d_in;
  p.x = in[0]; p.c = in[1]; p.ctx = in[2]; p.c_ctx = in[3]; p.norm_g = in[4]; p.w_mod = in[5]; p.b_mod = in[6];
  p.w_in = in[7]; p.conv_w = in[8]; p.conv_b = in[9]; p.lru_wa = in[10]; p.lru_ba = in[11]; p.lru_wx = in[12];
  p.lru_bx = in[13]; p.lru_lambda = in[14]; p.attn_sink = in[15]; p.q_norm_g = in[16]; p.k_norm_g = in[17];
  p.w_branch = in[18]; p.w_out = in[19]; p.final_g = in[20];
  p.out = (float*)d_out;
  char* ws = (char*)d_ws;
  size_t off = 0;
  auto take = [&](size_t bytes) { char* r = ws + off; off += (bytes + 255) & ~(size_t)255; return r; };
  p.ctr = (int*)take(256);
  p.modv = (float*)take((size_t)DEPTH * 17 * 3072 * 4);
  p.sc = (float*)take((size_t)17 * D * 4);
  p.rope = (float*)take(4096 * 4);
  p.xc = (float*)take((size_t)NBATCH * L * D * 4);
  p.WinT = (u16*)take((size_t)DEPTH * INW * D * 2);
  p.WbT = (u16*)take((size_t)DEPTH * 3 * D * D * 2);
  p.WoT = (u16*)take((size_t)DEPTH * D * D * 2);
  const size_t fixed = off;
  int NB = 8;
  while (NB > 1) {
    size_t R = (size_t)NB * (S + L);
    size_t need = fixed + R * (size_t)(1024 + 1024 + 3072 + 2048 + 512 + 512 + 3072) * 2 + 8 * 256;
    if (need <= ws_size) break;
    NB >>= 1;
  }
  p.NB = NB; p.nchunk = NBATCH / NB;
  const size_t R = (size_t)NB * (S + L);
  p.Hb = (u16*)take(R * 1024 * 2);
  p.U = (u16*)take(R * 1024 * 2);
  p.Z = (u16*)take(R * 3072 * 2);
  p.Q = (u16*)take(R * 2048 * 2);
  p.Kb = (u16*)take(R * 512 * 2);
  p.VtL = (u16*)take((size_t)NB * 4 * 128 * S * 2);
  p.VtC = (u16*)take((size_t)NB * 4 * 128 * L * 2);
  p.Ms = (u16*)take(R * 3072 * 2);
  void* args[] = {&p};
  hipError_t e = hipLaunchCooperativeKernel((void*)fwd_megakernel, dim3(grid_blocks), dim3(256), args, 0, stream);
  if (e != hipSuccess) fprintf(stderr, "cooperative launch failed: %s (grid %d)\n", hipGetErrorString(e), grid_blocks);
}
```

```cpp
#include <hip/hip_runtime.h>
#include <hip/hip_cooperative_groups.h>
#include <cstdio>
#include <cstdint>
namespace cg = cooperative_groups;

typedef unsigned short u16;
typedef __attribute__((ext_vector_type(8))) short bf16x8;
typedef __attribute__((ext_vector_type(4))) short s16x4;
typedef __attribute__((ext_vector_type(16))) float f32x16;
typedef __bf16 bf16x2_t __attribute__((ext_vector_type(2)));
typedef float float2_t __attribute__((ext_vector_type(2)));
typedef __attribute__((ext_vector_type(4))) unsigned u32x4;
typedef __attribute__((ext_vector_type(2))) unsigned u32x2;

#define DI __device__ __forceinline__
#define MFMA32(a, b, c) __builtin_amdgcn_mfma_f32_32x32x16_bf16((a), (b), (c), 0, 0, 0)

constexpr int D = 1024, NBATCH = 16, S = 4096, L = 256, DEPTH = 4, INW = 10240;
constexpr int LDS_BYTES = 73728;
constexpr float EPS = 1e-6f;
constexpr float QSCALE = 0.08838834764831845f * 1.4426950408889634f;
constexpr float LOG2E = 1.4426950408889634f;

struct Params {
  const float *x, *c, *ctx, *c_ctx, *norm_g, *w_mod, *b_mod, *w_in, *conv_w, *conv_b, *lru_wa, *lru_ba, *lru_wx, *lru_bx,
      *lru_lambda, *attn_sink, *q_norm_g, *k_norm_g, *w_branch, *w_out, *final_g;
  float* out;
  u16 *WinT, *WbT, *WoT;
  u16 *Hb, *U, *Z, *Q, *Kb, *VtL, *VtC, *Ms;
  float *modv, *sc, *rope, *xc;
  int* ctr;
  int NB;
  int nchunk;
};

DI unsigned pack2(float a, float b) {
  float2_t f = {a, b};
  bf16x2_t v = __builtin_convertvector(f, bf16x2_t);
  return __builtin_bit_cast(unsigned, v);
}
DI float bf2f(u16 v) { return __uint_as_float(((unsigned)v) << 16); }
DI float bflo(unsigned v) { return __uint_as_float(v << 16); }
DI float bfhi(unsigned v) { return __uint_as_float(v & 0xffff0000u); }
DI float sigmoidf_(float x) { return __builtin_amdgcn_rcpf(1.f + __expf(-x)); }
DI float siluf_(float x) { return x * __builtin_amdgcn_rcpf(1.f + __expf(-x)); }
DI int otid() { int t = threadIdx.x; asm volatile("" : "+v"(t)); return t; }
DI int crow(int i, int hh) { return (i & 3) + 8 * (i >> 2) + 4 * hh; }

DI void phase0(const Params& p, char* lds) {
  const int tid = otid();
  float* tile = (float*)lds;
  const int n_in = DEPTH * 16 * 160, n_b = DEPTH * 3 * 256, n_o = DEPTH * 256;
  for (int it = blockIdx.x; it < n_in + n_b + n_o; it += gridDim.x) {
    const float* src; u16* dst; int ldsrc;
    if (it < n_in) {
      int l = it / 2560, rem = it % 2560, kt = rem / 160, nt = rem % 160;
      src = p.w_in + (size_t)l * D * INW + (size_t)(kt * 64) * INW + nt * 64; ldsrc = INW;
      dst = p.WinT + (size_t)l * INW * D + (size_t)(nt * 64) * D + kt * 64;
    } else if (it < n_in + n_b) {
      int i2 = it - n_in; int mat = i2 / 256, rem = i2 % 256, kt = rem / 16, nt = rem % 16;
      src = p.w_branch + (size_t)mat * D * D + (size_t)(kt * 64) * D + nt * 64; ldsrc = D;
      dst = p.WbT + (size_t)mat * D * D + (size_t)(nt * 64) * D + kt * 64;
    } else {
      int i2 = it - n_in - n_b; int mat = i2 / 256, rem = i2 % 256, kt = rem / 16, nt = rem % 16;
      src = p.w_out + (size_t)mat * D * D + (size_t)(kt * 64) * D + nt * 64; ldsrc = D;
      dst = p.WoT + (size_t)mat * D * D + (size_t)(nt * 64) * D + kt * 64;
    }
    __syncthreads();
#pragma unroll
    for (int i = 0; i < 4; ++i) {
      int c = tid + 256 * i; int row = c >> 4, c4 = c & 15;
      float4 v = *(const float4*)(src + (size_t)row * ldsrc + c4 * 4);
      float* t = tile + row * 65 + c4 * 4;
      t[0] = v.x; t[1] = v.y; t[2] = v.z; t[3] = v.w;
    }
    __syncthreads();
#pragma unroll
    for (int i = 0; i < 2; ++i) {
      int c = tid + 256 * i; int nrow = c >> 3, k8 = c & 7;
      float v[8];
#pragma unroll
      for (int j = 0; j < 8; ++j) v[j] = tile[(k8 * 8 + j) * 65 + nrow];
      uint4 o; o.x = pack2(v[0], v[1]); o.y = pack2(v[2], v[3]); o.z = pack2(v[4], v[5]); o.w = pack2(v[6], v[7]);
      *(uint4*)(dst + (size_t)nrow * D + k8 * 8) = o;
    }
  }
  const int gt = blockIdx.x * 256 + tid, gn = gridDim.x * 256;
  for (int i = gt; i < 17 * D; i += gn) {
    int r = i / D, k = i % D;
    float v = (r < 16) ? p.c[r * D + k] : p.c_ctx[k];
    p.sc[i] = siluf_(v);
  }
  for (int i = gt; i < 64 * 32; i += gn) {
    int pos = i >> 5, pp = i & 31;
    float inv = powf(10000.f, -(float)pp / 32.f);
    float ang = (float)pos * inv;
    p.rope[i] = cosf(ang);
    p.rope[2048 + i] = sinf(ang);
  }
  if (blockIdx.x == 0 && tid < 64) p.ctr[tid] = 0;
}

DI void phase_mod(const Params& p, char* lds) {
  const int tid = otid();
  float* red = (float*)lds;
  const int col = tid & 63, kg = tid >> 6;
  for (int it = blockIdx.x; it < DEPTH * 48; it += gridDim.x) {
    int l = it / 48, cb = it % 48;
    float acc[17];
#pragma unroll
    for (int r = 0; r < 17; ++r) acc[r] = 0.f;
    const float* w = p.w_mod + (size_t)l * D * 3072 + cb * 64 + col;
    for (int k = kg * 256; k < kg * 256 + 256; ++k) {
      float wv = w[(size_t)k * 3072];
#pragma unroll
      for (int r = 0; r < 17; ++r) acc[r] += p.sc[r * D + k] * wv;
    }
    __syncthreads();
#pragma unroll
    for (int r = 0; r < 17; ++r) red[(kg * 17 + r) * 64 + col] = acc[r];
    __syncthreads();
    for (int i = tid; i < 17 * 64; i += 256) {
      int r = i >> 6, cc = i & 63;
      float s = red[(0 * 17 + r) * 64 + cc] + red[(1 * 17 + r) * 64 + cc] + red[(2 * 17 + r) * 64 + cc] + red[(3 * 17 + r) * 64 + cc];
      p.modv[((size_t)l * 17 + r) * 3072 + cb * 64 + cc] = s + p.b_mod[l * 3072 + cb * 64 + cc];
    }
  }
}

DI void phase_prenorm(const Params& p, int chunk, int l) {
  const int NB = p.NB, RL = NB * S, R = NB * (S + L);
  const int tid_ = otid();
  const int lane = tid_ & 63;
  const int wg = blockIdx.x * 4 + (tid_ >> 6), nw = gridDim.x * 4;
  const float* g = p.norm_g + l * D;
  for (int r = wg; r < R; r += nw) {
    const float* src; int mrow;
    if (r < RL) {
      int b = r / S, t = r % S; int bg = chunk * NB + b;
      src = (l == 0 ? p.x : p.out) + ((size_t)bg * S + t) * D; mrow = bg;
    } else {
      int rc = r - RL; int b = rc / L, t = rc % L; int bg = chunk * NB + b;
      src = (l == 0 ? p.ctx : p.xc) + ((size_t)bg * L + t) * D; mrow = 16;
    }
    const float* mv = p.modv + ((size_t)l * 17 + mrow) * 3072;
    float4 v[4]; float ss = 0.f;
#pragma unroll
    for (int i = 0; i < 4; ++i) {
      v[i] = *(const float4*)(src + i * 256 + lane * 4);
      ss += v[i].x * v[i].x + v[i].y * v[i].y + v[i].z * v[i].z + v[i].w * v[i].w;
    }
#pragma unroll
    for (int o = 32; o >= 1; o >>= 1) ss += __shfl_xor(ss, o);
    float rstd = rsqrtf(ss * (1.f / D) + EPS);
#pragma unroll
    for (int i = 0; i < 4; ++i) {
      int cidx = i * 256 + lane * 4;
      float4 gg = *(const float4*)(g + cidx);
      float4 sh = *(const float4*)(mv + cidx);
      float4 scl = *(const float4*)(mv + 1024 + cidx);
      float h0 = v[i].x * rstd * gg.x * (1.f + scl.x) + sh.x;
      float h1 = v[i].y * rstd * gg.y * (1.f + scl.y) + sh.y;
      float h2 = v[i].z * rstd * gg.z * (1.f + scl.z) + sh.z;
      float h3 = v[i].w * rstd * gg.w * (1.f + scl.w) + sh.w;
      uint2 o; o.x = pack2(h0, h1); o.y = pack2(h2, h3);
      *(uint2*)(p.Hb + (size_t)r * D + cidx) = o;
    }
  }
}

DI void gemm_core(const u16* A, int lda, const u16* Bt, int ldb, int K, char* ldsc, f32x16 (&acc)[2][2]) {
  const int tid = otid(), lane = tid & 63, w = tid >> 6, wm = w >> 1, wn = w & 1;
  const int r = lane & 31, hh = lane >> 5;
  u16* sA = (u16*)ldsc;
  u16* sB = sA + 2 * 128 * 72;
  const int lrow = tid >> 3, lc = (tid & 7) * 8;
  const u16* Ap = A + (size_t)lrow * lda + lc;
  const u16* Bp = Bt + (size_t)lrow * ldb + lc;
  u32x4 ra[4], rb[4];
#pragma unroll
  for (int i = 0; i < 2; ++i)
#pragma unroll
    for (int j = 0; j < 2; ++j)
#pragma unroll
      for (int x = 0; x < 16; ++x) acc[i][j][x] = 0.f;
#pragma unroll
  for (int i = 0; i < 4; ++i) {
    ra[i] = *(const u32x4*)(Ap + (size_t)(32 * i) * lda);
    rb[i] = *(const u32x4*)(Bp + (size_t)(32 * i) * ldb);
  }
  __syncthreads();
#pragma unroll
  for (int i = 0; i < 4; ++i) {
    *(u32x4*)(sA + (lrow + 32 * i) * 72 + lc) = ra[i];
    *(u32x4*)(sB + (lrow + 32 * i) * 72 + lc) = rb[i];
  }
  __syncthreads();
  const int KT = K >> 6;
  for (int kt = 0; kt < KT; ++kt) {
    const int cur = kt & 1;
    if (kt + 1 < KT) {
#pragma unroll
      for (int i = 0; i < 4; ++i) {
        ra[i] = *(const u32x4*)(Ap + (size_t)(32 * i) * lda + (kt + 1) * 64);
        rb[i] = *(const u32x4*)(Bp + (size_t)(32 * i) * ldb + (kt + 1) * 64);
      }
    }
    const u16* ab = sA + cur * 128 * 72 + (wm * 64 + r) * 72 + hh * 8;
    const u16* bb = sB + cur * 128 * 72 + (wn * 64 + r) * 72 + hh * 8;
#pragma unroll
    for (int ks = 0; ks < 4; ++ks) {
      bf16x8 a0 = *(const bf16x8*)(ab + ks * 16);
      bf16x8 a1 = *(const bf16x8*)(ab + 32 * 72 + ks * 16);
      bf16x8 b0 = *(const bf16x8*)(bb + ks * 16);
      bf16x8 b1 = *(const bf16x8*)(bb + 32 * 72 + ks * 16);
      acc[0][0] = MFMA32(a0, b0, acc[0][0]);
      acc[0][1] = MFMA32(a0, b1, acc[0][1]);
      acc[1][0] = MFMA32(a1, b0, acc[1][0]);
      acc[1][1] = MFMA32(a1, b1, acc[1][1]);
    }
    if (kt + 1 < KT) {
      u16* sa2 = sA + (cur ^ 1) * 128 * 72;
      u16* sb2 = sB + (cur ^ 1) * 128 * 72;
#pragma unroll
      for (int i = 0; i < 4; ++i) {
        *(u32x4*)(sa2 + (lrow + 32 * i) * 72 + lc) = ra[i];
        *(u32x4*)(sb2 + (lrow + 32 * i) * 72 + lc) = rb[i];
      }
    }
    __syncthreads();
  }
}

DI void stage_acc(char* ldsc, f32x16 (&acc)[2][2]) {
  const int tid = otid(), lane = tid & 63, w = tid >> 6, wm = w >> 1, wn = w & 1;
  const int r = lane & 31, hh = lane >> 5;
  float* Cs = (float*)ldsc;
#pragma unroll
  for (int i = 0; i < 2; ++i)
#pragma unroll
    for (int j = 0; j < 2; ++j)
#pragma unroll
      for (int x = 0; x < 16; ++x) {
        int m = wm * 64 + i * 32 + crow(x, hh);
        int n = wn * 64 + j * 32 + r;
        Cs[m * 132 + n] = acc[i][j][x];
      }
  __syncthreads();
}

DI void read_row64(const char* ldsc, int row, int half, float (&v)[64]) {
  const float* Cs = (const float*)ldsc + row * 132 + half * 64;
#pragma unroll
  for (int j = 0; j < 16; ++j) {
    float4 t = *(const float4*)(Cs + j * 4);
    v[j * 4] = t.x; v[j * 4 + 1] = t.y; v[j * 4 + 2] = t.z; v[j * 4 + 3] = t.w;
  }
}

DI void store_row64_bf16(u16* dst, const float (&v)[64]) {
#pragma unroll
  for (int j = 0; j < 8; ++j) {
    uint4 o;
    o.x = pack2(v[j * 8], v[j * 8 + 1]); o.y = pack2(v[j * 8 + 2], v[j * 8 + 3]);
    o.z = pack2(v[j * 8 + 4], v[j * 8 + 5]); o.w = pack2(v[j * 8 + 6], v[j * 8 + 7]);
    *(uint4*)(dst + j * 8) = o;
  }
}

DI void phase_gemm_in(const Params& p, int chunk, int l, char* lds) {
  const int NB = p.NB, RL = NB * S, R = NB * (S + L);
  const int MT = R / 128, NT = 80;
  const int tid = otid();
  const int ntiles = MT * NT;
  const u16* Wt = p.WinT + (size_t)l * INW * D;
  for (int it = blockIdx.x; it < ntiles; it += gridDim.x) {
    int panel = it / (16 * NT), rem = it % (16 * NT);
    int mrem = MT - panel * 16; if (mrem > 16) mrem = 16;
    int nt = rem / mrem, mt = panel * 16 + rem % mrem;
    const int m0 = mt * 128, n0 = nt * 128;
    f32x16 acc[2][2];
    gemm_core(p.Hb + (size_t)m0 * D, D, Wt + (size_t)n0 * D, D, D, lds, acc);
    stage_acc(lds, acc);
    const bool lat = m0 < RL;
    int b, t0;
    if (lat) { b = m0 / S; t0 = m0 % S; } else { int rc = m0 - RL; b = rc / L; t0 = rc % L; }
    const bool isV = (nt == 26 || nt == 27 || nt == 46 || nt == 47);
    if (isV) {
      int slot = (nt < 40) ? (nt - 26) : (2 + nt - 46);
      int d = tid >> 1, th = tid & 1;
      const float* Cs = (const float*)lds;
      float v[64];
#pragma unroll
      for (int j = 0; j < 64; ++j) v[j] = Cs[(th * 64 + j) * 132 + d];
      u16* dst = lat ? p.VtL + ((size_t)(b * 4 + slot) * 128 + d) * S + t0 + th * 64
                     : p.VtC + ((size_t)(b * 4 + slot) * 128 + d) * L + t0 + th * 64;
      store_row64_bf16(dst, v);
    } else {
      const int row = tid >> 1, half = tid & 1;
      const size_t gr = (size_t)m0 + row;
      const int t = t0 + row;
      float v[64];
      read_row64(lds, row, half, v);
      if (nt < 8) {
        store_row64_bf16(p.U + gr * D + nt * 128 + half * 64, v);
      } else if (nt < 16 || (nt >= 28 && nt < 36) || (nt >= 48 && nt < 56)) {
        int zc = (nt < 16) ? (nt - 8) * 128 : (nt < 36 ? 1024 + (nt - 28) * 128 : 2048 + (nt - 48) * 128);
#pragma unroll
        for (int j = 0; j < 64; ++j) v[j] = siluf_(v[j]);
        store_row64_bf16(p.Z + gr * 3072 + zc + half * 64, v);
      } else if (nt >= 56) {
#pragma unroll
        for (int j = 0; j < 64; ++j) v[j] = sigmoidf_(v[j]);
        store_row64_bf16(p.Ms + gr * 3072 + (nt - 56) * 128 + half * 64, v);
      } else {
        const bool isC = nt >= 36;
        const bool isQ = (nt >= 16 && nt < 24) || (nt >= 36 && nt < 44);
        if (isC) {
          const float* gn = (isQ ? p.q_norm_g : p.k_norm_g) + l * 128 + half * 64;
          float ss = 0.f;
#pragma unroll
          for (int j = 0; j < 64; ++j) ss += v[j] * v[j];
          ss += __shfl_xor(ss, 1);
          float rstd = rsqrtf(ss * (1.f / 128.f) + EPS);
#pragma unroll
          for (int j = 0; j < 64; ++j) v[j] = v[j] * rstd * gn[j];
        }
        if (lat) {
          int pos = (half == 0) ? (t >> 6) : (t & 63);
          const float* cs = p.rope + pos * 32;
          const float* sn = p.rope + 2048 + pos * 32;
#pragma unroll
          for (int j = 0; j < 32; ++j) {
            float c_ = cs[j], s_ = sn[j];
            float x0 = v[j], x1 = v[32 + j];
            v[j] = x0 * c_ - x1 * s_;
            v[32 + j] = x1 * c_ + x0 * s_;
          }
        }
        if (isQ) {
#pragma unroll
          for (int j = 0; j < 64; ++j) v[j] *= QSCALE;
          int qc = isC ? 1024 + (nt - 36) * 128 : (nt - 16) * 128;
          store_row64_bf16(p.Q + gr * 2048 + qc + half * 64, v);
        } else {
          int kc = isC ? 256 + (nt - 44) * 128 : (nt - 24) * 128;
          store_row64_bf16(p.Kb + gr * 512 + kc + half * 64, v);
        }
      }
    }
  }
}

struct AttnArgs {
  const u16* q;
  u16* z;
  const u16* kctx;
  const u16* vctx;
  const u16* klat;
  const u16* vlat;
  int n_lat_tiles;
  int lat_key0;
  int q_t0;
  int band;
  int has_sink;
  float sink_l2;
  int dry;
};

DI void attn_load_tile(const AttnArgs& a, int ti, u32x4 (&rk)[4], u32x4 (&rv)[4]) {
  const int tid = otid();
  const u16* kp; const u16* vp; int vs;
  if (ti < 4) { kp = a.kctx + (size_t)(ti * 64) * 512; vp = a.vctx + ti * 64; vs = L; }
  else { kp = a.klat + (size_t)((ti - 4) * 64) * 512; vp = a.vlat + (ti - 4) * 64; vs = S; }
#pragma unroll
  for (int i = 0; i < 4; ++i) {
    int c = tid + 256 * i;
    rk[i] = *(const u32x4*)(kp + (size_t)(c >> 4) * 512 + (c & 15) * 8);
    rv[i] = *(const u32x4*)(vp + (size_t)(c >> 3) * vs + (c & 7) * 8);
  }
}
DI void attn_store_tile(u16* sK, u16* sV, const u32x4 (&rk)[4], const u32x4 (&rv)[4]) {
  const int tid = otid();
#pragma unroll
  for (int i = 0; i < 4; ++i) {
    int c = tid + 256 * i;
    *(u32x4*)(sK + (c >> 4) * 136 + (c & 15) * 8) = rk[i];
    u16* vd = sV + (c >> 3) * 68 + (c & 7) * 8;
    { u32x2 t0 = {rv[i].x, rv[i].y}; *(u32x2*)(vd) = t0; }
    { u32x2 t1 = {rv[i].z, rv[i].w}; *(u32x2*)(vd + 4) = t1; }
  }
}

DI void attn_item(const AttnArgs& a, char* lds) {
  const int tid = otid(), lane = tid & 63, w = tid >> 6;
  const int r = lane & 31, hh = lane >> 5;
  u16* sKb = (u16*)lds;
  u16* sVb = sKb + 2 * 64 * 136;
  const int ntiles = 4 + a.n_lat_tiles;

  bf16x8 qf[8];
  {
    const u16* qp = a.q + (size_t)(w * 32 + r) * 2048 + hh * 8;
#pragma unroll
    for (int ks = 0; ks < 8; ++ks) qf[ks] = *(const bf16x8*)(qp + ks * 16);
  }
  f32x16 O[4];
#pragma unroll
  for (int dt = 0; dt < 4; ++dt)
#pragma unroll
    for (int x = 0; x < 16; ++x) O[dt][x] = 0.f;
  float m = a.has_sink ? a.sink_l2 : -1e30f;
  float lsum = (a.has_sink && hh == 0) ? 1.f : 0.f;

  u32x4 rk[4], rv[4];
  attn_load_tile(a, 0, rk, rv);
  __syncthreads();
  attn_store_tile(sKb, sVb, rk, rv);
  __syncthreads();
  const int qpos = a.q_t0 + w * 32 + r;

  for (int ti = 0; ti < ntiles; ++ti) {
    const int cur = ti & 1;
    if (ti + 1 < ntiles) attn_load_tile(a, ti + 1, rk, rv);
    const u16* sK = sKb + cur * 64 * 136;
    const u16* sV = sVb + cur * 128 * 68;
    f32x16 s[2];
#pragma unroll
    for (int kt2 = 0; kt2 < 2; ++kt2) {
#pragma unroll
      for (int x = 0; x < 16; ++x) s[kt2][x] = 0.f;
      const u16* kb = sK + (kt2 * 32 + r) * 136 + hh * 8;
#pragma unroll
      for (int ks = 0; ks < 8; ++ks) {
        bf16x8 ka = *(const bf16x8*)(kb + ks * 16);
        s[kt2] = MFMA32(ka, qf[ks], s[kt2]);
      }
    }
    if (a.band && ti >= 4) {
      const int k0 = a.lat_key0 + (ti - 4) * 64;
#pragma unroll
      for (int kt2 = 0; kt2 < 2; ++kt2)
#pragma unroll
        for (int x = 0; x < 16; ++x) {
          int kp = k0 + kt2 * 32 + crow(x, hh);
          int dlt = kp - qpos; dlt = dlt < 0 ? -dlt : dlt;
          if (dlt > 128) s[kt2][x] = -1e30f;
        }
    }
    float mx = s[0][0];
#pragma unroll
    for (int kt2 = 0; kt2 < 2; ++kt2)
#pragma unroll
      for (int x = 0; x < 16; ++x) mx = fmaxf(mx, s[kt2][x]);
    mx = fmaxf(mx, __shfl_xor(mx, 32));
    const float mnew = fmaxf(m, mx);
    const float alpha = exp2f(m - mnew);
    m = mnew;
    float ps = 0.f;
#pragma unroll
    for (int kt2 = 0; kt2 < 2; ++kt2)
#pragma unroll
      for (int x = 0; x < 16; ++x) { float pv = exp2f(s[kt2][x] - mnew); s[kt2][x] = pv; ps += pv; }
    lsum = lsum * alpha + ps;
    if (__any(alpha != 1.f)) {
#pragma unroll
      for (int dt = 0; dt < 4; ++dt)
#pragma unroll
        for (int x = 0; x < 16; ++x) O[dt][x] *= alpha;
    }
#pragma unroll
    for (int kt2 = 0; kt2 < 2; ++kt2)
#pragma unroll
      for (int s2 = 0; s2 < 2; ++s2) {
        union { unsigned u[4]; bf16x8 v; } pf;
#pragma unroll
        for (int j = 0; j < 4; ++j) pf.u[j] = pack2(s[kt2][8 * s2 + 2 * j], s[kt2][8 * s2 + 2 * j + 1]);
        const u16* vb = sV + r * 68 + kt2 * 32 + 16 * s2 + 4 * hh;
#pragma unroll
        for (int dt = 0; dt < 4; ++dt) {
          s16x4 lo = *(const s16x4*)(vb + dt * 32 * 68);
          s16x4 hi = *(const s16x4*)(vb + dt * 32 * 68 + 8);
          bf16x8 va = __builtin_shufflevector(lo, hi, 0, 1, 2, 3, 4, 5, 6, 7);
          O[dt] = MFMA32(va, pf.v, O[dt]);
        }
      }
    if (ti + 1 < ntiles) attn_store_tile(sKb + (cur ^ 1) * 64 * 136, sVb + (cur ^ 1) * 128 * 68, rk, rv);
    __syncthreads();
  }
  float ltot = lsum + __shfl_xor(lsum, 32);
  const float inv = 1.f / ltot;
  u16* zp = a.z + (size_t)(w * 32 + r) * 3072;
#pragma unroll
  for (int dt = 0; dt < 4; ++dt)
#pragma unroll
    for (int g4 = 0; g4 < 4; ++g4) {
      int d0 = dt * 32 + 8 * g4 + 4 * hh;
      uint2 gv = *(const uint2*)(zp + d0);
      float y0 = O[dt][4 * g4 + 0] * inv * bflo(gv.x);
      float y1 = O[dt][4 * g4 + 1] * inv * bfhi(gv.x);
      float y2 = O[dt][4 * g4 + 2] * inv * bflo(gv.y);
      float y3 = O[dt][4 * g4 + 3] * inv * bfhi(gv.y);
      uint2 o; o.x = pack2(y0, y1); o.y = pack2(y2, y3);
      if (!a.dry || y0 != y0) *(uint2*)(zp + d0) = o;
    }
}

template <bool REV>
DI void lru_scan(float (&av)[2][16], float (&bv)[2][16], float& carry, int hh) {
  float segA[8], segB[8];
#pragma unroll
  for (int k = 0; k < 8; ++k) {
    const int mt = k >> 2, q = k & 3;
    float cA = 1.f, hl = 0.f;
#pragma unroll
    for (int jj = 0; jj < 4; ++jj) {
      const int j = REV ? 3 - jj : jj;
      const int i = 4 * q + j;
      hl = av[mt][i] * hl + bv[mt][i];
      cA *= av[mt][i];
      av[mt][i] = cA; bv[mt][i] = hl;
    }
    segA[k] = cA; segB[k] = hl;
  }
  float oA[8], oB[8];
#pragma unroll
  for (int k = 0; k < 8; ++k) { oA[k] = __shfl_xor(segA[k], 32); oB[k] = __shfl_xor(segB[k], 32); }
  float init[8];
  float st = carry;
#pragma unroll
  for (int kk = 0; kk < 8; ++kk) {
    const int k = REV ? 7 - kk : kk;
    const int first = REV ? 1 : 0;
    float A1 = (hh == first) ? segA[k] : oA[k];
    float B1 = (hh == first) ? segB[k] : oB[k];
    float st0 = st;
    st = A1 * st + B1;
    float A2 = (hh == first) ? oA[k] : segA[k];
    float B2 = (hh == first) ? oB[k] : segB[k];
    float st1 = st;
    st = A2 * st + B2;
    init[k] = (hh == first) ? st0 : st1;
  }
  carry = st;
#pragma unroll
  for (int k = 0; k < 8; ++k) {
    const int mt = k >> 2, q = k & 3;
#pragma unroll
    for (int j = 0; j < 4; ++j) {
      const int i = 4 * q + j;
      bv[mt][i] = bv[mt][i] + av[mt][i] * init[k];
    }
  }
}

DI void lru_item(const Params& p, int l, int b, int n, bool last, char* lds, int dry = 0) {
  const int NB = p.NB, RL = NB * S;
  const int tid = otid(), lane = tid & 63, w = tid >> 6;
  const int dir = w >> 1, w2 = w & 1;
  const int tl = tid & 127;
  const int r = lane & 31, hh = lane >> 5;
  u16* sRaw = (u16*)lds + dir * (8704 / 2);
  u16* sUp = (u16*)(lds + 17408) + dir * (9216 / 2);
  float* sH = (float*)(lds + 35840) + w * (64 * 36);

  const int chb = n * 64;
  const int cp = (tl & 31) * 2, tg = tl >> 5;
  float cw0[4], cw1[4], cb0, cb1;
#pragma unroll
  for (int k = 0; k < 4; ++k) {
    cw0[k] = p.conv_w[((size_t)l * 4 + k) * D + chb + cp];
    cw1[k] = p.conv_w[((size_t)l * 4 + k) * D + chb + cp + 1];
  }
  cb0 = p.conv_b[l * D + chb + cp]; cb1 = p.conv_b[l * D + chb + cp + 1];
  bf16x8 waf[4], wxf[4];
  {
    const float* wa = p.lru_wa + (((size_t)(l * 2 + dir) * 16 + n) * 64) * 64;
    const float* wx = p.lru_wx + (((size_t)(l * 2 + dir) * 16 + n) * 64) * 64;
    const int e = 32 * w2 + r;
#pragma unroll
    for (int ks = 0; ks < 4; ++ks) {
      union { unsigned u[4]; bf16x8 v; } fa, fx;
#pragma unroll
      for (int j = 0; j < 4; ++j) {
        int d0 = ks * 16 + 8 * hh + 2 * j;
        fa.u[j] = pack2(wa[d0 * 64 + e], wa[(d0 + 1) * 64 + e]);
        fx.u[j] = pack2(wx[d0 * 64 + e], wx[(d0 + 1) * 64 + e]);
      }
      waf[ks] = fa.v; wxf[ks] = fx.v;
    }
  }
  const int che = chb + 32 * w2 + r;
  const float ba = p.lru_ba[(l * 2 + dir) * D + che];
  const float bx = p.lru_bx[(l * 2 + dir) * D + che];
  float c8sp;
  {
    float lam = p.lru_lambda[(l * 2 + dir) * D + che];
    float sp = (lam < -20.f) ? -lam : log1pf(expf(-lam));
    c8sp = 8.f * sp;
  }
  float carry = 0.f;

  auto step_tile = [&](int st, bool& isctx, int& tt) {
    if (dir == 0) { if (st < 4) { isctx = true; tt = st; } else { isctx = false; tt = st - 4; } }
    else { if (st < 4) { isctx = true; tt = 3 - st; } else { isctx = false; tt = 63 - (st - 4); } }
  };
  u32x4 pre[5];
  auto load_raw = [&](int st) {
    bool isctx; int tt; step_tile(st, isctx, tt);
    const int seqlen = isctx ? L : S;
    const size_t rowbase = isctx ? (size_t)RL + (size_t)b * L : (size_t)b * S;
    const int t0 = tt * 64;
#pragma unroll
    for (int i = 0; i < 5; ++i) {
      int c = tl + 128 * i;
      int rr = c >> 3, c16 = c & 7;
      int t = t0 - 2 + rr;
      u32x4 v = {0u, 0u, 0u, 0u};
      if (rr < 67 && t >= 0 && t < seqlen) v = *(const u32x4*)(p.U + (rowbase + t) * D + chb + c16 * 8);
      pre[i] = v;
    }
  };
  load_raw(0);
  __syncthreads();
  for (int st = 0; st < 68; ++st) {
    bool isctx; int tt; step_tile(st, isctx, tt);
    const size_t rowbase = isctx ? (size_t)RL + (size_t)b * L : (size_t)b * S;
    const int t0 = tt * 64;
#pragma unroll
    for (int i = 0; i < 5; ++i) {
      int c = tl + 128 * i;
      int rr = c >> 3, c16 = c & 7;
      if (rr < 67) *(u32x4*)(sRaw + rr * 64 + c16 * 8) = pre[i];
    }
    if (st + 1 < 68) load_raw(st + 1);
    __syncthreads();
    {
      const u16* rp = sRaw + (tg * 16) * 64 + cp;
      unsigned r0 = *(const unsigned*)(rp), r1 = *(const unsigned*)(rp + 64), r2 = *(const unsigned*)(rp + 128);
#pragma unroll
      for (int i = 0; i < 16; ++i) {
        unsigned r3 = *(const unsigned*)(rp + (i + 3) * 64);
        float o0 = cb0 + cw0[0] * bflo(r0) + cw0[1] * bflo(r1) + cw0[2] * bflo(r2) + cw0[3] * bflo(r3);
        float o1 = cb1 + cw1[0] * bfhi(r0) + cw1[1] * bfhi(r1) + cw1[2] * bfhi(r2) + cw1[3] * bfhi(r3);
        *(unsigned*)(sUp + (tg * 16 + i) * 72 + cp) = pack2(o0, o1);
        r0 = r1; r1 = r2; r2 = r3;
      }
    }
    __syncthreads();
    const bool fwd_first = isctx ? (tt <= 1) : (tt <= 31);
    const bool first = (dir == 0) ? fwd_first : !fwd_first;
    unsigned long long pt0[4], pt1[4];
    u32x4 pg[4];
    if (!first && !(isctx && last)) {
#pragma unroll
      for (int j = 0; j < 4; ++j) {
        const int q = lane + 64 * j;
        const int tok = q >> 2, cc = (q & 3) * 8;
        const size_t row = rowbase + t0 + tok;
        const int col = chb + 32 * w2 + cc;
        const u16* tp = p.Hb + row * D + col;
        pt0[j] = __hip_atomic_load((const unsigned long long*)tp, __ATOMIC_RELAXED, __HIP_MEMORY_SCOPE_AGENT);
        pt1[j] = __hip_atomic_load((const unsigned long long*)tp + 1, __ATOMIC_RELAXED, __HIP_MEMORY_SCOPE_AGENT);
        pg[j] = *(const u32x4*)(p.Z + row * 3072 + col);
      }
    } else {
#pragma unroll
      for (int j = 0; j < 4; ++j) { pt0[j] = 0; pt1[j] = 0; pg[j] = u32x4{0u, 0u, 0u, 0u}; }
    }
    float av[2][16], bv[2][16];
    {
      f32x16 aR[2];
#pragma unroll
      for (int mt = 0; mt < 2; ++mt) {
#pragma unroll
        for (int x = 0; x < 16; ++x) aR[mt][x] = 0.f;
        const u16* ub = sUp + (mt * 32 + r) * 72 + hh * 8;
#pragma unroll
        for (int ks = 0; ks < 4; ++ks) aR[mt] = MFMA32(*(const bf16x8*)(ub + ks * 16), waf[ks], aR[mt]);
      }
#pragma unroll
      for (int mt = 0; mt < 2; ++mt)
#pragma unroll
        for (int x = 0; x < 16; ++x) {
          const float rg = sigmoidf_(aR[mt][x] + ba);
          av[mt][x] = -c8sp * rg;
        }
    }
    {
      f32x16 aI[2];
#pragma unroll
      for (int mt = 0; mt < 2; ++mt) {
#pragma unroll
        for (int x = 0; x < 16; ++x) aI[mt][x] = 0.f;
        const u16* ub = sUp + (mt * 32 + r) * 72 + hh * 8;
#pragma unroll
        for (int ks = 0; ks < 4; ++ks) aI[mt] = MFMA32(*(const bf16x8*)(ub + ks * 16), wxf[ks], aI[mt]);
      }
#pragma unroll
      for (int mt = 0; mt < 2; ++mt)
#pragma unroll
        for (int x = 0; x < 16; ++x) {
          const int tok = mt * 32 + crow(x, hh);
          const float up = bf2f(sUp[tok * 72 + 32 * w2 + r]);
          const float ig = sigmoidf_(aI[mt][x] + bx);
          const float la = av[mt][x];
          const float a_ = __expf(la);
          const float om = fmaxf(1.f - a_ * a_, 0.f);
          av[mt][x] = a_;
          bv[mt][x] = __builtin_amdgcn_sqrtf(om) * (ig * up);
        }
    }
    if (dir == 0) lru_scan<false>(av, bv, carry, hh); else lru_scan<true>(av, bv, carry, hh);
#pragma unroll
    for (int mt = 0; mt < 2; ++mt)
#pragma unroll
      for (int x = 0; x < 16; ++x) sH[(mt * 32 + crow(x, hh)) * 36 + r] = bv[mt][x];
    if (!(isctx && last)) {
#pragma unroll
      for (int j = 0; j < 4; ++j) {
        const int q = lane + 64 * j;
        const int tok = q >> 2, cc = (q & 3) * 8;
        const float4 h0 = *(const float4*)(sH + tok * 36 + cc);
        const float4 h1 = *(const float4*)(sH + tok * 36 + cc + 4);
        const size_t row = rowbase + t0 + tok;
        const int col = chb + 32 * w2 + cc;
        u16* tp = p.Hb + row * D + col;
        if (first) {
          uint4 o; o.x = pack2(h0.x, h0.y); o.y = pack2(h0.z, h0.w); o.z = pack2(h1.x, h1.y); o.w = pack2(h1.z, h1.w);
          if (!dry || h0.x != h0.x) *(uint4*)tp = o;
        } else {
          unsigned tx = (unsigned)pt0[j], ty = (unsigned)(pt0[j] >> 32), tz = (unsigned)pt1[j], tw = (unsigned)(pt1[j] >> 32);
          u16* zp = p.Z + row * 3072 + col;
          u32x4 g = pg[j];
          uint4 o;
          o.x = pack2((h0.x + bflo(tx)) * bflo(g.x), (h0.y + bfhi(tx)) * bfhi(g.x));
          o.y = pack2((h0.z + bflo(ty)) * bflo(g.y), (h0.w + bfhi(ty)) * bfhi(g.y));
          o.z = pack2((h1.x + bflo(tz)) * bflo(g.z), (h1.y + bfhi(tz)) * bfhi(g.z));
          o.w = pack2((h1.z + bflo(tw)) * bflo(g.w), (h1.w + bfhi(tw)) * bfhi(g.w));
          if (!dry || h0.x != h0.x) *(uint4*)zp = o;
        }
      }
    }
    __builtin_amdgcn_fence(__ATOMIC_RELEASE, "workgroup");
  }
}

DI void phase_mixers(const Params& p, int chunk, int l, char* lds, int dry = 0) {
  const int NB = p.NB, RL = NB * S;
  const bool last = (l == DEPTH - 1);
  const int nLRU = (dry == 1) ? 0 : NB * 16, nC = (dry == 2) ? 0 : NB * 8 * 32, nBw = (dry == 2) ? 0 : NB * 8 * 32, nCtx = (last || dry == 2) ? 0 : NB * 8 * 2 * 2;
  const int total = nLRU + nC + nBw + nCtx;
  int* ctr = p.ctr + chunk * DEPTH + l + (dry ? 32 : 0);
  if (dry == 2) __threadfence();
  int* s_item = (int*)(lds + LDS_BYTES - 16);
  int it;
  while (true) {
    __syncthreads();
    if (threadIdx.x == 0) *s_item = atomicAdd(ctr, 1);
    __syncthreads();
    it = __builtin_amdgcn_readfirstlane(*s_item);
    __syncthreads();
    if (it >= nLRU) break;
    lru_item(p, l, it >> 4, it & 15, last, lds, dry);
  }
  bool have = true;
  while (true) {
    if (!have) {
      __syncthreads();
      if (threadIdx.x == 0) *s_item = atomicAdd(ctr, 1);
      __syncthreads();
      it = __builtin_amdgcn_readfirstlane(*s_item);
      __syncthreads();
    }
    have = false;
    if (it >= total) break;
    it -= nLRU;
    AttnArgs a;
    a.dry = dry;
    if (it < nC + nBw) {
      const bool isB = it >= nC;
      if (isB) it -= nC;
      const int b = it >> 8, h = (it >> 5) & 7, qb = it & 31;
      const int kvh = h >> 2;
      const int br = isB ? 0 : 1;
      const size_t qrow0 = (size_t)b * S + qb * 128;
      a.q = p.Q + qrow0 * 2048 + br * 1024 + h * 128;
      a.z = p.Z + qrow0 * 3072 + (br + 1) * 1024 + h * 128;
      const int kcol = br * 256 + kvh * 128, slot = br * 2 + kvh;
      a.kctx = p.Kb + ((size_t)RL + (size_t)b * L) * 512 + kcol;
      a.vctx = p.VtC + (size_t)(b * 4 + slot) * 128 * L;
      int k0, k1;
      if (isB) { k0 = qb * 128 - 128; if (k0 < 0) k0 = 0; k1 = qb * 128 + 256; if (k1 > S) k1 = S; }
      else { k0 = 0; k1 = S; }
      a.lat_key0 = k0;
      a.n_lat_tiles = (k1 - k0) >> 6;
      a.klat = p.Kb + ((size_t)b * S + k0) * 512 + kcol;
      a.vlat = p.VtL + (size_t)(b * 4 + slot) * 128 * S + k0;
      a.q_t0 = qb * 128;
      a.band = isB ? 1 : 0;
      a.has_sink = isB ? 1 : 0;
      a.sink_l2 = isB ? p.attn_sink[l * 8 + h] * LOG2E : 0.f;
    } else {
      it -= nC + nBw;
      const int qb = it & 1, h = (it >> 1) & 7, br = (it >> 4) & 1, b = it >> 5;
      const int kvh = h >> 2;
      const size_t qrow0 = (size_t)RL + (size_t)b * L + qb * 128;
      a.q = p.Q + qrow0 * 2048 + br * 1024 + h * 128;
      a.z = p.Z + qrow0 * 3072 + (br + 1) * 1024 + h * 128;
      const int kcol = br * 256 + kvh * 128, slot = br * 2 + kvh;
      a.kctx = p.Kb + ((size_t)RL + (size_t)b * L) * 512 + kcol;
      a.vctx = p.VtC + (size_t)(b * 4 + slot) * 128 * L;
      a.klat = a.kctx; a.vlat = a.vctx;
      a.n_lat_tiles = 0; a.lat_key0 = 0; a.q_t0 = 0; a.band = 0;
      a.has_sink = (br == 0) ? 1 : 0;
      a.sink_l2 = (br == 0) ? p.attn_sink[l * 8 + h] * LOG2E : 0.f;
    }
    attn_item(a, lds);
  }
}

DI void phase_merge(const Params& p, int chunk, int l, char* lds) {
  const int NB = p.NB, RL = NB * S, R = NB * (S + L);
  const bool last = (l == DEPTH - 1);
  const int MT = (last ? RL : R) / 128, NT = 8;
  const int tid = otid();
  for (int it = blockIdx.x; it < MT * NT; it += gridDim.x) {
    const int mt = it / NT, nt = it % NT;
    const int m0 = mt * 128, n0 = nt * 128;
    const int row = tid >> 1, half = tid & 1;
    const size_t gr = (size_t)m0 + row;
    float tot[64];
#pragma unroll
    for (int j = 0; j < 64; ++j) tot[j] = 0.f;
#pragma unroll 1
    for (int n = 0; n < 3; ++n) {
      f32x16 acc[2][2];
      gemm_core(p.Z + (size_t)m0 * 3072 + n * 1024, 3072, p.WbT + ((size_t)(l * 3 + n) * D + n0) * D, D, D, lds, acc);
      stage_acc(lds, acc);
      const float* Cs = (const float*)lds + row * 132 + half * 64;
      const u16* sg = p.Ms + gr * 3072 + n * 1024 + n0 + half * 64;
#pragma unroll
      for (int j = 0; j < 8; ++j) {
        uint4 sv = *(const uint4*)(sg + j * 8);
        float4 c0 = *(const float4*)(Cs + j * 8);
        float4 c1 = *(const float4*)(Cs + j * 8 + 4);
        tot[j * 8 + 0] += bflo(sv.x) * c0.x; tot[j * 8 + 1] += bfhi(sv.x) * c0.y;
        tot[j * 8 + 2] += bflo(sv.y) * c0.z; tot[j * 8 + 3] += bfhi(sv.y) * c0.w;
        tot[j * 8 + 4] += bflo(sv.z) * c1.x; tot[j * 8 + 5] += bfhi(sv.z) * c1.y;
        tot[j * 8 + 6] += bflo(sv.w) * c1.z; tot[j * 8 + 7] += bfhi(sv.w) * c1.w;
      }
    }
    store_row64_bf16(p.Hb + gr * D + n0 + half * 64, tot);
  }
}

DI void phase_outproj(const Params& p, int chunk, int l, char* lds) {
  const int NB = p.NB, RL = NB * S, R = NB * (S + L);
  const bool last = (l == DEPTH - 1);
  const int MT = (last ? RL : R) / 128, NT = 8;
  const int tid = otid();
  for (int it = blockIdx.x; it < MT * NT; it += gridDim.x) {
    const int mt = it / NT, nt = it % NT;
    const int m0 = mt * 128, n0 = nt * 128;
    f32x16 acc[2][2];
    gemm_core(p.Hb + (size_t)m0 * D, D, p.WoT + ((size_t)l * D + n0) * D, D, D, lds, acc);
    stage_acc(lds, acc);
    const int row = tid >> 1, half = tid & 1;
    const int gr = m0 + row;
    const float* src; float* dst; int mrow;
    if (gr < RL) {
      int b = gr / S, t = gr % S; int bg = chunk * NB + b;
      size_t off = ((size_t)bg * S + t) * D + n0 + half * 64;
      src = (l == 0 ? p.x : p.out) + off; dst = p.out + off; mrow = bg;
    } else {
      int rc = gr - RL; int b = rc / L, t = rc % L; int bg = chunk * NB + b;
      size_t off = ((size_t)bg * L + t) * D + n0 + half * 64;
      src = (l == 0 ? p.ctx : p.xc) + off; dst = p.xc + off; mrow = 16;
    }
    const float* gate = p.modv + ((size_t)l * 17 + mrow) * 3072 + 2048 + n0 + half * 64;
    const float* Cs = (const float*)lds + row * 132 + half * 64;
#pragma unroll
    for (int j = 0; j < 16; ++j) {
      float4 cv = *(const float4*)(Cs + j * 4);
      float4 xv = *(const float4*)(src + j * 4);
      float4 gv = *(const float4*)(gate + j * 4);
      float4 o;
      o.x = xv.x + gv.x * cv.x; o.y = xv.y + gv.y * cv.y; o.z = xv.z + gv.z * cv.z; o.w = xv.w + gv.w * cv.w;
      *(float4*)(dst + j * 4) = o;
    }
  }
}

DI void phase_final(const Params& p) {
  const int tid_ = otid();
  const int lane = tid_ & 63;
  const int wg = blockIdx.x * 4 + (tid_ >> 6), nw = gridDim.x * 4;
  for (int r = wg; r < NBATCH * S; r += nw) {
    float* src = p.out + (size_t)r * D;
    float4 v[4]; float ss = 0.f;
#pragma unroll
    for (int i = 0; i < 4; ++i) {
      v[i] = *(const float4*)(src + i * 256 + lane * 4);
      ss += v[i].x * v[i].x + v[i].y * v[i].y + v[i].z * v[i].z + v[i].w * v[i].w;
    }
#pragma unroll
    for (int o = 32; o >= 1; o >>= 1) ss += __shfl_xor(ss, o);
    float rstd = rsqrtf(ss * (1.f / D) + EPS);
#pragma unroll
    for (int i = 0; i < 4; ++i) {
      int cidx = i * 256 + lane * 4;
      float4 gg = *(const float4*)(p.final_g + cidx);
      float4 o;
      o.x = v[i].x * rstd * gg.x; o.y = v[i].y * rstd * gg.y; o.z = v[i].z * rstd * gg.z; o.w = v[i].w * rstd * gg.w;
      *(float4*)(src + cidx) = o;
    }
  }
}

#ifndef DUP_PHASE
#define DUP_PHASE 0
#endif
#ifndef PROBE_A
#define PROBE_A -1
#define PROBE_B -1
#endif
__global__ void __launch_bounds__(256, 2) fwd_megakernel(Params p) {
  cg::grid_group grid = cg::this_grid();
  __shared__ __attribute__((aligned(16))) char lds[LDS_BYTES];
#if PROBE_A >= 0
  long long tacc[8] = {0, 0, 0, 0, 0, 0, 0, 0};
  long long t0 = wall_clock64(), t1;
#define TICK(i) { t1 = wall_clock64(); tacc[i] += t1 - t0; t0 = t1; }
#else
#define TICK(i)
#endif
  phase0(p, lds);
  grid.sync();
  TICK(0)
  phase_mod(p, lds);
  grid.sync();
  TICK(1)
  for (int chunk = 0; chunk < p.nchunk; ++chunk) {
    for (int l = 0; l < DEPTH; ++l) {
      phase_prenorm(p, chunk, l);
      grid.sync();
      TICK(2)
      phase_gemm_in(p, chunk, l, lds);
      grid.sync();
      TICK(3)
#if DUP_PHASE == 3
      phase_gemm_in(p, chunk, l, lds);
      grid.sync();
#endif
#if DUP_PHASE == 4
      phase_mixers(p, chunk, l, lds, 1);
      grid.sync();
#endif
#if DUP_PHASE == 6
      phase_mixers(p, chunk, l, lds, 2);
      grid.sync();
#endif
      phase_mixers(p, chunk, l, lds);
      grid.sync();
      TICK(4)
      phase_merge(p, chunk, l, lds);
      grid.sync();
      TICK(5)
#if DUP_PHASE == 5
      phase_merge(p, chunk, l, lds);
      grid.sync();
#endif
      phase_outproj(p, chunk, l, lds);
      grid.sync();
      TICK(6)
    }
  }
  phase_final(p);
#if PROBE_A >= 0
  grid.sync();
  TICK(7)
  if (blockIdx.x == 0) {
    float A = (float)tacc[PROBE_A] * 0.01f;
    float B = (float)tacc[PROBE_B] * 0.001f;
    A = exp2f(rintf(log2f(A) * 8.f) * 0.125f);
    B = exp2f(rintf(log2f(B) * 8.f) * 0.125f);
    for (int i = threadIdx.x; i <= 1000000; i += 256) p.out[i] = (i == 0) ? A : B;
  }
#endif
}

extern "C" void kernel_launch(void* const* d_in, const int* in_sizes, int n_in,
                              void* d_out, int out_size, void* d_ws, size_t ws_size,
                              hipStream_t stream) {
  static int grid_blocks = 0;
  if (!grid_blocks) {
    int dev = 0, cus = 0, per_cu = 0;
    (void)hipGetDevice(&dev);
    (void)hipDeviceGetAttribute(&cus, hipDeviceAttributeMultiprocessorCount, dev);
    (void)hipOccupancyMaxActiveBlocksPerMultiprocessor(&per_cu, fwd_megakernel, 256, 0);
    if (per_cu > 2) per_cu = 2;
    if (per_cu < 1) per_cu = 1;
    grid_blocks = cus * per_cu;
  }
  Params p{};
  const float* const* in = (const float* const*)d_in;
  p.x = in[0]; p.c = in[1]; p.ctx = in[2]; p.c_ctx = in[3]; p.norm_g = in[4]; p.w_mod = in[5]; p.b_mod = in[6];
  p.w_in = in[7]; p.conv_w = in[8]; p.conv_b = in[9]; p.lru_wa = in[10]; p.lru_ba = in[11]; p.lru_wx = in[12];
  p.lru_bx = in[13]; p.lru_lambda = in[14]; p.attn_sink = in[15]; p.q_norm_g = in[16]; p.k_norm_g = in[17];
  p.w_branch = in[18]; p.w_out = in[19]; p.final_g = in[20];
  p.out = (float*)d_out;
  char* ws = (char*)d_ws;
  size_t off = 0;
  auto take = [&](size_t bytes) { char* r = ws + off; off += (bytes + 255) & ~(size_t)255; return r; };
  p.ctr = (int*)take(256);
  p.modv = (float*)take((size_t)DEPTH * 17 * 3072 * 4);
  p.sc = (float*)take((size_t)17 * D * 4);
  p.rope = (float*)take(4096 * 4);
  p.xc = (float*)take((size_t)NBATCH * L * D * 4);
  p.WinT = (u16*)take((size_t)DEPTH * INW * D * 2);
  p.WbT = (u16*)take((size_t)DEPTH * 3 * D * D * 2);
  p.WoT = (u16*)take((size_t)DEPTH * D * D * 2);
  const size_t fixed = off;
  int NB = 8;
  while (NB > 1) {
    size_t R = (size_t)NB * (S + L);
    size_t need = fixed + R * (size_t)(1024 + 1024 + 3072 + 2048 + 512 + 512 + 3072) * 2 + 8 * 256;
    if (need <= ws_size) break;
    NB >>= 1;
  }
  p.NB = NB; p.nchunk = NBATCH / NB;
  const size_t R = (size_t)NB * (S + L);
  p.Hb = (u16*)take(R * 1024 * 2);
  p.U = (u16*)take(R * 1024 * 2);
  p.Z = (u16*)take(R * 3072 * 2);
  p.Q = (u16*)take(R * 2048 * 2);
  p.Kb = (u16*)take(R * 512 * 2);
  p.VtL = (u16*)take((size_t)NB * 4 * 128 * S * 2);
  p.VtC = (u16*)take((size_t)NB * 4 * 128 * L * 2);
  p.Ms = (u16*)take(R * 3072 * 2);
  void* args[] = {&p};
  hipError_t e = hipLaunchCooperativeKernel((void*)fwd_megakernel, dim3(grid_blocks), dim3(256), args, 0, stream);
  if (e != hipSuccess) fprintf(stderr, "cooperative launch failed: %s (grid %d)\n", hipGetErrorString(e), grid_blocks);
}
```

```cpp
#include <hip/hip_runtime.h>
#include <hip/hip_cooperative_groups.h>
#include <cstdio>
#include <cstdint>
namespace cg = cooperative_groups;

typedef unsigned short u16;
typedef __attribute__((ext_vector_type(8))) short bf16x8;
typedef __attribute__((ext_vector_type(4))) short s16x4;
typedef __attribute__((ext_vector_type(16))) float f32x16;
typedef __bf16 bf16x2_t __attribute__((ext_vector_type(2)));
typedef float float2_t __attribute__((ext_vector_type(2)));
typedef __attribute__((ext_vector_type(4))) unsigned u32x4;
typedef __attribute__((ext_vector_type(2))) unsigned u32x2;

#define DI __device__ __forceinline__
#define MFMA32(a, b, c) __builtin_amdgcn_mfma_f32_32x32x16_bf16((a), (b), (c), 0, 0, 0)

constexpr int D = 1024, NBATCH = 16, S = 4096, L = 256, DEPTH = 4, INW = 10240;
constexpr int LDS_BYTES = 73728;
constexpr float EPS = 1e-6f;
constexpr float QSCALE = 0.08838834764831845f * 1.4426950408889634f;
constexpr float LOG2E = 1.4426950408889634f;

struct Params {
  const float *x, *c, *ctx, *c_ctx, *norm_g, *w_mod, *b_mod, *w_in, *conv_w, *conv_b, *lru_wa, *lru_ba, *lru_wx, *lru_bx,
      *lru_lambda, *attn_sink, *q_norm_g, *k_norm_g, *w_branch, *w_out, *final_g;
  float* out;
  u16 *WinT, *WbT, *WoT;
  u16 *Hb, *U, *Z, *Q, *Kb, *VtL, *VtC, *Ms;
  float *modv, *sc, *rope, *xc;
  int* ctr;
  int NB;
  int nchunk;
};

DI unsigned pack2(float a, float b) {
  float2_t f = {a, b};
  bf16x2_t v = __builtin_convertvector(f, bf16x2_t);
  return __builtin_bit_cast(unsigned, v);
}
DI float bf2f(u16 v) { return __uint_as_float(((unsigned)v) << 16); }
DI float bflo(unsigned v) { return __uint_as_float(v << 16); }
DI float bfhi(unsigned v) { return __uint_as_float(v & 0xffff0000u); }
DI float sigmoidf_(float x) { return __builtin_amdgcn_rcpf(1.f + __expf(-x)); }
DI float siluf_(float x) { return x * __builtin_amdgcn_rcpf(1.f + __expf(-x)); }
DI int otid() { int t = threadIdx.x; asm volatile("" : "+v"(t)); return t; }
DI int crow(int i, int hh) { return (i & 3) + 8 * (i >> 2) + 4 * hh; }

DI void phase0(const Params& p, char* lds) {
  const int tid = otid();
  float* tile = (float*)lds;
  const int n_in = DEPTH * 16 * 160, n_b = DEPTH * 3 * 256, n_o = DEPTH * 256;
  for (int it = blockIdx.x; it < n_in + n_b + n_o; it += gridDim.x) {
    const float* src; u16* dst; int ldsrc;
    if (it < n_in) {
      int l = it / 2560, rem = it % 2560, kt = rem / 160, nt = rem % 160;
      src = p.w_in + (size_t)l * D * INW + (size_t)(kt * 64) * INW + nt * 64; ldsrc = INW;
      dst = p.WinT + (size_t)l * INW * D + (size_t)(nt * 64) * D + kt * 64;
    } else if (it < n_in + n_b) {
      int i2 = it - n_in; int mat = i2 / 256, rem = i2 % 256, kt = rem / 16, nt = rem % 16;
      src = p.w_branch + (size_t)mat * D * D + (size_t)(kt * 64) * D + nt * 64; ldsrc = D;
      dst = p.WbT + (size_t)mat * D * D + (size_t)(nt * 64) * D + kt * 64;
    } else {
      int i2 = it - n_in - n_b; int mat = i2 / 256, rem = i2 % 256, kt = rem / 16, nt = rem % 16;
      src = p.w_out + (size_t)mat * D * D + (size_t)(kt * 64) * D + nt * 64; ldsrc = D;
      dst = p.WoT + (size_t)mat * D * D + (size_t)(nt * 64) * D + kt * 64;
    }
    __syncthreads();
#pragma unroll
    for (int i = 0; i < 4; ++i) {
      int c = tid + 256 * i; int row = c >> 4, c4 = c & 15;
      float4 v = *(const float4*)(src + (size_t)row * ldsrc + c4 * 4);
      float* t = tile + row * 65 + c4 * 4;
      t[0] = v.x; t[1] = v.y; t[2] = v.z; t[3] = v.w;
    }
    __syncthreads();
#pragma unroll
    for (int i = 0; i < 2; ++i) {
      int c = tid + 256 * i; int nrow = c >> 3, k8 = c & 7;
      float v[8];
#pragma unroll
      for (int j = 0; j < 8; ++j) v[j] = tile[(k8 * 8 + j) * 65 + nrow];
      uint4 o; o.x = pack2(v[0], v[1]); o.y = pack2(v[2], v[3]); o.z = pack2(v[4], v[5]); o.w = pack2(v[6], v[7]);
      *(uint4*)(dst + (size_t)nrow * D + k8 * 8) = o;
    }
  }
  const int gt = blockIdx.x * 256 + tid, gn = gridDim.x * 256;
  for (int i = gt; i < 17 * D; i += gn) {
    int r = i / D, k = i % D;
    float v = (r < 16) ? p.c[r * D + k] : p.c_ctx[k];
    p.sc[i] = siluf_(v);
  }
  for (int i = gt; i < 64 * 32; i += gn) {
    int pos = i >> 5, pp = i & 31;
    float inv = powf(10000.f, -(float)pp / 32.f);
    float ang = (float)pos * inv;
    p.rope[i] = cosf(ang);
    p.rope[2048 + i] = sinf(ang);
  }
  if (blockIdx.x == 0 && tid < 64) p.ctr[tid] = 0;
}

DI void phase_mod(const Params& p, char* lds) {
  const int tid = otid();
  float* red = (float*)lds;
  const int col = tid & 63, kg = tid >> 6;
  for (int it = blockIdx.x; it < DEPTH * 48; it += gridDim.x) {
    int l = it / 48, cb = it % 48;
    float acc[17];
#pragma unroll
    for (int r = 0; r < 17; ++r) acc[r] = 0.f;
    const float* w = p.w_mod + (size_t)l * D * 3072 + cb * 64 + col;
    for (int k = kg * 256; k < kg * 256 + 256; ++k) {
      float wv = w[(size_t)k * 3072];
#pragma unroll
      for (int r = 0; r < 17; ++r) acc[r] += p.sc[r * D + k] * wv;
    }
    __syncthreads();
#pragma unroll
    for (int r = 0; r < 17; ++r) red[(kg * 17 + r) * 64 + col] = acc[r];
    __syncthreads();
    for (int i = tid; i < 17 * 64; i += 256) {
      int r = i >> 6, cc = i & 63;
      float s = red[(0 * 17 + r) * 64 + cc] + red[(1 * 17 + r) * 64 + cc] + red[(2 * 17 + r) * 64 + cc] + red[(3 * 17 + r) * 64 + cc];
      p.modv[((size_t)l * 17 + r) * 3072 + cb * 64 + cc] = s + p.b_mod[l * 3072 + cb * 64 + cc];
    }
  }
}

DI void phase_prenorm(const Params& p, int chunk, int l) {
  const int NB = p.NB, RL = NB * S, R = NB * (S + L);
  const int tid_ = otid();
  const int lane = tid_ & 63;
  const int wg = blockIdx.x * 4 + (tid_ >> 6), nw = gridDim.x * 4;
  const float* g = p.norm_g + l * D;
  for (int r = wg; r < R; r += nw) {
    const float* src; int mrow;
    if (r < RL) {
      int b = r / S, t = r % S; int bg = chunk * NB + b;
      src = (l == 0 ? p.x : p.out) + ((size_t)bg * S + t) * D; mrow = bg;
    } else {
      int rc = r - RL; int b = rc / L, t = rc % L; int bg = chunk * NB + b;
      src = (l == 0 ? p.ctx : p.xc) + ((size_t)bg * L + t) * D; mrow = 16;
    }
    const float* mv = p.modv + ((size_t)l * 17 + mrow) * 3072;
    float4 v[4]; float ss = 0.f;
#pragma unroll
    for (int i = 0; i < 4; ++i) {
      v[i] = *(const float4*)(src + i * 256 + lane * 4);
      ss += v[i].x * v[i].x + v[i].y * v[i].y + v[i].z * v[i].z + v[i].w * v[i].w;
    }
#pragma unroll
    for (int o = 32; o >= 1; o >>= 1) ss += __shfl_xor(ss, o);
    float rstd = rsqrtf(ss * (1.f / D) + EPS);
#pragma unroll
    for (int i = 0; i < 4; ++i) {
      int cidx = i * 256 + lane * 4;
      float4 gg = *(const float4*)(g + cidx);
      float4 sh = *(const float4*)(mv + cidx);
      float4 scl = *(const float4*)(mv + 1024 + cidx);
      float h0 = v[i].x * rstd * gg.x * (1.f + scl.x) + sh.x;
      float h1 = v[i].y * rstd * gg.y * (1.f + scl.y) + sh.y;
      float h2 = v[i].z * rstd * gg.z * (1.f + scl.z) + sh.z;
      float h3 = v[i].w * rstd * gg.w * (1.f + scl.w) + sh.w;
      uint2 o; o.x = pack2(h0, h1); o.y = pack2(h2, h3);
      *(uint2*)(p.Hb + (size_t)r * D + cidx) = o;
    }
  }
}

DI void gemm_core(const u16* A, int lda, const u16* Bt, int ldb, int K, char* ldsc, f32x16 (&acc)[2][2]) {
  const int tid = otid(), lane = tid & 63, w = tid >> 6, wm = w >> 1, wn = w & 1;
  const int r = lane & 31, hh = lane >> 5;
  u16* sA = (u16*)ldsc;
  u16* sB = sA + 2 * 128 * 72;
  const int lrow = tid >> 3, lc = (tid & 7) * 8;
  const u16* Ap = A + (size_t)lrow * lda + lc;
  const u16* Bp = Bt + (size_t)lrow * ldb + lc;
  u32x4 ra0[4], rb0[4], ra1[4], rb1[4];
#pragma unroll
  for (int i = 0; i < 2; ++i)
#pragma unroll
    for (int j = 0; j < 2; ++j)
#pragma unroll
      for (int x = 0; x < 16; ++x) acc[i][j][x] = 0.f;
  auto LOAD = [&](u32x4 (&ra)[4], u32x4 (&rb)[4], int kt) {
#pragma unroll
    for (int i = 0; i < 4; ++i) {
      ra[i] = *(const u32x4*)(Ap + (size_t)(32 * i) * lda + kt * 64);
      rb[i] = *(const u32x4*)(Bp + (size_t)(32 * i) * ldb + kt * 64);
    }
  };
  auto STORE = [&](const u32x4 (&ra)[4], const u32x4 (&rb)[4], int buf) {
    u16* sa2 = sA + buf * 128 * 72;
    u16* sb2 = sB + buf * 128 * 72;
#pragma unroll
    for (int i = 0; i < 4; ++i) {
      *(u32x4*)(sa2 + (lrow + 32 * i) * 72 + lc) = ra[i];
      *(u32x4*)(sb2 + (lrow + 32 * i) * 72 + lc) = rb[i];
    }
  };
  auto COMPUTE = [&](int buf) {
    const u16* ab = sA + buf * 128 * 72 + (wm * 64 + r) * 72 + hh * 8;
    const u16* bb = sB + buf * 128 * 72 + (wn * 64 + r) * 72 + hh * 8;
#pragma unroll
    for (int ks = 0; ks < 4; ++ks) {
      bf16x8 a0 = *(const bf16x8*)(ab + ks * 16);
      bf16x8 a1 = *(const bf16x8*)(ab + 32 * 72 + ks * 16);
      bf16x8 b0 = *(const bf16x8*)(bb + ks * 16);
      bf16x8 b1 = *(const bf16x8*)(bb + 32 * 72 + ks * 16);
      acc[0][0] = MFMA32(b0, a0, acc[0][0]);
      acc[0][1] = MFMA32(b1, a0, acc[0][1]);
      acc[1][0] = MFMA32(b0, a1, acc[1][0]);
      acc[1][1] = MFMA32(b1, a1, acc[1][1]);
    }
  };
  const int KT = K >> 6;
  LOAD(ra0, rb0, 0);
  LOAD(ra1, rb1, 1);
  __syncthreads();
  STORE(ra0, rb0, 0);
  __syncthreads();
  for (int kt = 0; kt < KT; kt += 2) {
    if (kt + 2 < KT) LOAD(ra0, rb0, kt + 2);
    __builtin_amdgcn_sched_barrier(0);
    COMPUTE(0);
    __builtin_amdgcn_sched_barrier(0);
    STORE(ra1, rb1, 1);
    __syncthreads();
    if (kt + 3 < KT) LOAD(ra1, rb1, kt + 3);
    __builtin_amdgcn_sched_barrier(0);
    COMPUTE(1);
    __builtin_amdgcn_sched_barrier(0);
    if (kt + 2 < KT) STORE(ra0, rb0, 0);
    __syncthreads();
  }
}

DI void stage_acc(char* ldsc, f32x16 (&acc)[2][2]) {
  const int tid = otid(), lane = tid & 63, w = tid >> 6, wm = w >> 1, wn = w & 1;
  const int r = lane & 31, hh = lane >> 5;
  float* Cs = (float*)ldsc;
#pragma unroll
  for (int i = 0; i < 2; ++i)
#pragma unroll
    for (int j = 0; j < 2; ++j)
#pragma unroll
      for (int g = 0; g < 4; ++g) {
        int m = wm * 64 + i * 32 + r;
        int n = wn * 64 + j * 32 + 8 * g + 4 * hh;
        float4 v; v.x = acc[i][j][4 * g]; v.y = acc[i][j][4 * g + 1]; v.z = acc[i][j][4 * g + 2]; v.w = acc[i][j][4 * g + 3];
        *(float4*)(Cs + m * 132 + n) = v;
      }
  __syncthreads();
}

DI void read_row64(const char* ldsc, int row, int half, float (&v)[64]) {
  const float* Cs = (const float*)ldsc + row * 132 + half * 64;
#pragma unroll
  for (int j = 0; j < 16; ++j) {
    float4 t = *(const float4*)(Cs + j * 4);
    v[j * 4] = t.x; v[j * 4 + 1] = t.y; v[j * 4 + 2] = t.z; v[j * 4 + 3] = t.w;
  }
}

DI void store_row64_bf16(u16* dst, const float (&v)[64]) {
#pragma unroll
  for (int j = 0; j < 8; ++j) {
    uint4 o;
    o.x = pack2(v[j * 8], v[j * 8 + 1]); o.y = pack2(v[j * 8 + 2], v[j * 8 + 3]);
    o.z = pack2(v[j * 8 + 4], v[j * 8 + 5]); o.w = pack2(v[j * 8 + 6], v[j * 8 + 7]);
    *(uint4*)(dst + j * 8) = o;
  }
}

DI bool tile_map(int i, int MT, int NT, int& mt, int& nt) {
  const int G = gridDim.x, bid = blockIdx.x;
  if ((G & 63) == 0 && (MT & 7) == 0 && (NT % (G >> 6)) == 0) {
    const int SH = G >> 6;
    const int xcd = bid & 7, slot = bid >> 3;
    const int sx = slot & 7, sy = slot >> 3;
    const int nsn = NT / SH, nsm = MT >> 3;
    const int st = i * 8 + xcd;
    if (st >= nsm * nsn) return false;
    mt = (st / nsn) * 8 + sx;
    nt = (st % nsn) * SH + sy;
    return true;
  }
  const int it = bid + i * G;
  if (it >= MT * NT) return false;
  mt = it / NT; nt = it % NT;
  return true;
}

DI void phase_gemm_in(const Params& p, int chunk, int l, char* lds, int probe = 0) {
  const int NB = p.NB, RL = NB * S, R = NB * (S + L);
  const int MT = R / 128, NT = 80;
  const int tid = otid();
  const u16* Wt = p.WinT + (size_t)l * INW * D;
  for (int ti = 0;; ++ti) {
    int mt, nt;
    if (!tile_map(ti, MT, NT, mt, nt)) break;
    const int m0 = mt * 128, n0 = nt * 128;
    f32x16 acc[2][2];
    if (probe == 2) gemm_core(p.Hb, D, Wt, D, D, lds, acc);
    else gemm_core(p.Hb + (size_t)m0 * D, D, Wt + (size_t)n0 * D, D, D, lds, acc);
    if (probe) {
      if (acc[0][0][0] != acc[0][0][0] && acc[1][1][5] == 12345.f && acc[0][1][7] == 3.f && acc[1][0][9] == 7.f) p.U[tid] = 1;
      continue;
    }
    {
      int mode = -1; u16* dbase = nullptr; int dld = 0;
      if (nt < 8) { mode = 0; dbase = p.U + nt * 128; dld = D; }
      else if (nt < 16) { mode = 1; dbase = p.Z + (nt - 8) * 128; dld = 3072; }
      else if (nt >= 28 && nt < 36) { mode = 1; dbase = p.Z + 1024 + (nt - 28) * 128; dld = 3072; }
      else if (nt >= 48 && nt < 56) { mode = 1; dbase = p.Z + 2048 + (nt - 48) * 128; dld = 3072; }
      else if (nt >= 56) { mode = 2; dbase = p.Ms + (nt - 56) * 128; dld = 3072; }
      if (mode >= 0) {
        const int lane = tid & 63, w = tid >> 6, wm = w >> 1, wn = w & 1, r = lane & 31, hh = lane >> 5;
#pragma unroll
        for (int i = 0; i < 2; ++i)
#pragma unroll
          for (int j = 0; j < 2; ++j)
#pragma unroll
            for (int g = 0; g < 4; ++g) {
              float v0 = acc[i][j][4 * g], v1 = acc[i][j][4 * g + 1], v2 = acc[i][j][4 * g + 2], v3 = acc[i][j][4 * g + 3];
              if (mode == 1) { v0 = siluf_(v0); v1 = siluf_(v1); v2 = siluf_(v2); v3 = siluf_(v3); }
              else if (mode == 2) { v0 = sigmoidf_(v0); v1 = sigmoidf_(v1); v2 = sigmoidf_(v2); v3 = sigmoidf_(v3); }
              uint2 o; o.x = pack2(v0, v1); o.y = pack2(v2, v3);
              const size_t row = (size_t)m0 + wm * 64 + i * 32 + r;
              const int col = wn * 64 + j * 32 + 8 * g + 4 * hh;
              *(uint2*)(dbase + row * dld + col) = o;
            }
        continue;
      }
    }
    stage_acc(lds, acc);
    const bool lat = m0 < RL;
    int b, t0;
    if (lat) { b = m0 / S; t0 = m0 % S; } else { int rc = m0 - RL; b = rc / L; t0 = rc % L; }
    const bool isV = (nt == 26 || nt == 27 || nt == 46 || nt == 47);
    if (isV) {
      int slot = (nt < 40) ? (nt - 26) : (2 + nt - 46);
      int d = tid >> 1, th = tid & 1;
      const float* Cs = (const float*)lds;
      float v[64];
#pragma unroll
      for (int j = 0; j < 64; ++j) v[j] = Cs[(th * 64 + j) * 132 + d];
      u16* dst = lat ? p.VtL + ((size_t)(b * 4 + slot) * 128 + d) * S + t0 + th * 64
                     : p.VtC + ((size_t)(b * 4 + slot) * 128 + d) * L + t0 + th * 64;
      store_row64_bf16(dst, v);
    } else {
      const int row = tid >> 1, half = tid & 1;
      const size_t gr = (size_t)m0 + row;
      const int t = t0 + row;
      float v[64];
      read_row64(lds, row, half, v);
      if (nt < 8) {
        store_row64_bf16(p.U + gr * D + nt * 128 + half * 64, v);
      } else if (nt < 16 || (nt >= 28 && nt < 36) || (nt >= 48 && nt < 56)) {
        int zc = (nt < 16) ? (nt - 8) * 128 : (nt < 36 ? 1024 + (nt - 28) * 128 : 2048 + (nt - 48) * 128);
#pragma unroll
        for (int j = 0; j < 64; ++j) v[j] = siluf_(v[j]);
        store_row64_bf16(p.Z + gr * 3072 + zc + half * 64, v);
      } else if (nt >= 56) {
#pragma unroll
        for (int j = 0; j < 64; ++j) v[j] = sigmoidf_(v[j]);
        store_row64_bf16(p.Ms + gr * 3072 + (nt - 56) * 128 + half * 64, v);
      } else {
        const bool isC = nt >= 36;
        const bool isQ = (nt >= 16 && nt < 24) || (nt >= 36 && nt < 44);
        if (isC) {
          const float* gn = (isQ ? p.q_norm_g : p.k_norm_g) + l * 128 + half * 64;
          float ss = 0.f;
#pragma unroll
          for (int j = 0; j < 64; ++j) ss += v[j] * v[j];
          ss += __shfl_xor(ss, 1);
          float rstd = rsqrtf(ss * (1.f / 128.f) + EPS);
#pragma unroll
          for (int j = 0; j < 64; ++j) v[j] = v[j] * rstd * gn[j];
        }
        if (lat) {
          int pos = (half == 0) ? (t >> 6) : (t & 63);
          const float* cs = p.rope + pos * 32;
          const float* sn = p.rope + 2048 + pos * 32;
#pragma unroll
          for (int j = 0; j < 32; ++j) {
            float c_ = cs[j], s_ = sn[j];
            float x0 = v[j], x1 = v[32 + j];
            v[j] = x0 * c_ - x1 * s_;
            v[32 + j] = x1 * c_ + x0 * s_;
          }
        }
        if (isQ) {
#pragma unroll
          for (int j = 0; j < 64; ++j) v[j] *= QSCALE;
          int qc = isC ? 1024 + (nt - 36) * 128 : (nt - 16) * 128;
          store_row64_bf16(p.Q + gr * 2048 + qc + half * 64, v);
        } else {
          int kc = isC ? 256 + (nt - 44) * 128 : (nt - 24) * 128;
          store_row64_bf16(p.Kb + gr * 512 + kc + half * 64, v);
        }
      }
    }
  }
}

struct AttnArgs {
  const u16* q;
  u16* z;
  const u16* kctx;
  const u16* vctx;
  const u16* klat;
  const u16* vlat;
  int n_lat_tiles;
  int lat_key0;
  int q_t0;
  int band;
  int has_sink;
  float sink_l2;
  int dry;
};

DI void attn_load_tile(const AttnArgs& a, int ti, u32x4 (&rk)[4], u32x4 (&rv)[4]) {
  const int tid = otid();
  const u16* kp; const u16* vp; int vs;
  if (ti < 4) { kp = a.kctx + (size_t)(ti * 64) * 512; vp = a.vctx + ti * 64; vs = L; }
  else { kp = a.klat + (size_t)((ti - 4) * 64) * 512; vp = a.vlat + (ti - 4) * 64; vs = S; }
#pragma unroll
  for (int i = 0; i < 4; ++i) {
    int c = tid + 256 * i;
    rk[i] = *(const u32x4*)(kp + (size_t)(c >> 4) * 512 + (c & 15) * 8);
    rv[i] = *(const u32x4*)(vp + (size_t)(c >> 3) * vs + (c & 7) * 8);
  }
}
DI void attn_store_tile(u16* sK, u16* sV, const u32x4 (&rk)[4], const u32x4 (&rv)[4]) {
  const int tid = otid();
#pragma unroll
  for (int i = 0; i < 4; ++i) {
    int c = tid + 256 * i;
    *(u32x4*)(sK + (c >> 4) * 136 + (c & 15) * 8) = rk[i];
    u16* vd = sV + (c >> 3) * 68 + (c & 7) * 8;
    { u32x2 t0 = {rv[i].x, rv[i].y}; *(u32x2*)(vd) = t0; }
    { u32x2 t1 = {rv[i].z, rv[i].w}; *(u32x2*)(vd + 4) = t1; }
  }
}

DI void attn_item(const AttnArgs& a, char* lds) {
  const int tid = otid(), lane = tid & 63, w = tid >> 6;
  const int r = lane & 31, hh = lane >> 5;
  u16* sKb = (u16*)lds;
  u16* sVb = sKb + 2 * 64 * 136;
  const int ntiles = 4 + a.n_lat_tiles;

  bf16x8 qf[8];
  {
    const u16* qp = a.q + (size_t)(w * 32 + r) * 2048 + hh * 8;
#pragma unroll
    for (int ks = 0; ks < 8; ++ks) qf[ks] = *(const bf16x8*)(qp + ks * 16);
  }
  f32x16 O[4];
#pragma unroll
  for (int dt = 0; dt < 4; ++dt)
#pragma unroll
    for (int x = 0; x < 16; ++x) O[dt][x] = 0.f;
  float m = a.has_sink ? a.sink_l2 : -1e30f;
  float lsum = (a.has_sink && hh == 0) ? 1.f : 0.f;

  u32x4 rk[4], rv[4];
  attn_load_tile(a, 0, rk, rv);
  __syncthreads();
  attn_store_tile(sKb, sVb, rk, rv);
  __syncthreads();
  const int qpos = a.q_t0 + w * 32 + r;

  for (int ti = 0; ti < ntiles; ++ti) {
    const int cur = ti & 1;
    if (ti + 1 < ntiles) attn_load_tile(a, ti + 1, rk, rv);
    const u16* sK = sKb + cur * 64 * 136;
    const u16* sV = sVb + cur * 128 * 68;
    f32x16 s[2];
#pragma unroll
    for (int kt2 = 0; kt2 < 2; ++kt2) {
#pragma unroll
      for (int x = 0; x < 16; ++x) s[kt2][x] = 0.f;
      const u16* kb = sK + (kt2 * 32 + r) * 136 + hh * 8;
#pragma unroll
      for (int ks = 0; ks < 8; ++ks) {
        bf16x8 ka = *(const bf16x8*)(kb + ks * 16);
        s[kt2] = MFMA32(ka, qf[ks], s[kt2]);
      }
    }
    if (a.band && ti >= 4) {
      const int k0 = a.lat_key0 + (ti - 4) * 64;
#pragma unroll
      for (int kt2 = 0; kt2 < 2; ++kt2)
#pragma unroll
        for (int x = 0; x < 16; ++x) {
          int kp = k0 + kt2 * 32 + crow(x, hh);
          int dlt = kp - qpos; dlt = dlt < 0 ? -dlt : dlt;
          if (dlt > 128) s[kt2][x] = -1e30f;
        }
    }
    float mx = s[0][0];
#pragma unroll
    for (int kt2 = 0; kt2 < 2; ++kt2)
#pragma unroll
      for (int x = 0; x < 16; ++x) mx = fmaxf(mx, s[kt2][x]);
    mx = fmaxf(mx, __shfl_xor(mx, 32));
    if (__any(mx > m + 8.f)) {
      const float mnew = fmaxf(m, mx);
      const float alpha = __builtin_amdgcn_exp2f(m - mnew);
      m = mnew;
      lsum *= alpha;
#pragma unroll
      for (int dt = 0; dt < 4; ++dt)
#pragma unroll
        for (int x = 0; x < 16; ++x) O[dt][x] *= alpha;
    }
    float ps = 0.f;
#pragma unroll
    for (int kt2 = 0; kt2 < 2; ++kt2)
#pragma unroll
      for (int x = 0; x < 16; ++x) { float pv = __builtin_amdgcn_exp2f(s[kt2][x] - m); s[kt2][x] = pv; ps += pv; }
    lsum += ps;
#pragma unroll
    for (int kt2 = 0; kt2 < 2; ++kt2)
#pragma unroll
      for (int s2 = 0; s2 < 2; ++s2) {
        union { unsigned u[4]; bf16x8 v; } pf;
#pragma unroll
        for (int j = 0; j < 4; ++j) pf.u[j] = pack2(s[kt2][8 * s2 + 2 * j], s[kt2][8 * s2 + 2 * j + 1]);
        const u16* vb = sV + r * 68 + kt2 * 32 + 16 * s2 + 4 * hh;
#pragma unroll
        for (int dt = 0; dt < 4; ++dt) {
          s16x4 lo = *(const s16x4*)(vb + dt * 32 * 68);
          s16x4 hi = *(const s16x4*)(vb + dt * 32 * 68 + 8);
          bf16x8 va = __builtin_shufflevector(lo, hi, 0, 1, 2, 3, 4, 5, 6, 7);
          O[dt] = MFMA32(va, pf.v, O[dt]);
        }
      }
    if (ti + 1 < ntiles) attn_store_tile(sKb + (cur ^ 1) * 64 * 136, sVb + (cur ^ 1) * 128 * 68, rk, rv);
    __syncthreads();
  }
  float ltot = lsum + __shfl_xor(lsum, 32);
  const float inv = 1.f / ltot;
  u16* zp = a.z + (size_t)(w * 32 + r) * 3072;
  u32x2 gv[4][4];
#pragma unroll
  for (int dt = 0; dt < 4; ++dt)
#pragma unroll
    for (int g4 = 0; g4 < 4; ++g4) gv[dt][g4] = *(const u32x2*)(zp + dt * 32 + 8 * g4 + 4 * hh);
#pragma unroll
  for (int dt = 0; dt < 4; ++dt)
#pragma unroll
    for (int g4 = 0; g4 < 4; ++g4) {
      int d0 = dt * 32 + 8 * g4 + 4 * hh;
      float y0 = O[dt][4 * g4 + 0] * inv * bflo(gv[dt][g4].x);
      float y1 = O[dt][4 * g4 + 1] * inv * bfhi(gv[dt][g4].x);
      float y2 = O[dt][4 * g4 + 2] * inv * bflo(gv[dt][g4].y);
      float y3 = O[dt][4 * g4 + 3] * inv * bfhi(gv[dt][g4].y);
      uint2 o; o.x = pack2(y0, y1); o.y = pack2(y2, y3);
      if (!a.dry || y0 != y0) *(uint2*)(zp + d0) = o;
    }
}

template <bool REV>
DI void lru_scan(float (&av)[2][16], float (&bv)[2][16], float& carry, int hh) {
  float segA[8], segB[8];
#pragma unroll
  for (int k = 0; k < 8; ++k) {
    const int mt = k >> 2, q = k & 3;
    float cA = 1.f, hl = 0.f;
#pragma unroll
    for (int jj = 0; jj < 4; ++jj) {
      const int j = REV ? 3 - jj : jj;
      const int i = 4 * q + j;
      hl = av[mt][i] * hl + bv[mt][i];
      cA *= av[mt][i];
      av[mt][i] = cA; bv[mt][i] = hl;
    }
    segA[k] = cA; segB[k] = hl;
  }
  float oA[8], oB[8];
#pragma unroll
  for (int k = 0; k < 8; ++k) { oA[k] = __shfl_xor(segA[k], 32); oB[k] = __shfl_xor(segB[k], 32); }
  float init[8];
  float st = carry;
#pragma unroll
  for (int kk = 0; kk < 8; ++kk) {
    const int k = REV ? 7 - kk : kk;
    const int first = REV ? 1 : 0;
    float A1 = (hh == first) ? segA[k] : oA[k];
    float B1 = (hh == first) ? segB[k] : oB[k];
    float st0 = st;
    st = A1 * st + B1;
    float A2 = (hh == first) ? oA[k] : segA[k];
    float B2 = (hh == first) ? oB[k] : segB[k];
    float st1 = st;
    st = A2 * st + B2;
    init[k] = (hh == first) ? st0 : st1;
  }
  carry = st;
#pragma unroll
  for (int k = 0; k < 8; ++k) {
    const int mt = k >> 2, q = k & 3;
#pragma unroll
    for (int j = 0; j < 4; ++j) {
      const int i = 4 * q + j;
      bv[mt][i] = bv[mt][i] + av[mt][i] * init[k];
    }
  }
}

DI void lru_item(const Params& p, int l, int b, int n, bool last, char* lds, int dry = 0) {
  const int NB = p.NB, RL = NB * S;
  const int tid = otid(), lane = tid & 63, w = tid >> 6;
  const int dir = w >> 1, w2 = w & 1;
  const int tl = tid & 127;
  const int r = lane & 31, hh = lane >> 5;
  u16* sRaw = (u16*)lds + dir * (8704 / 2);
  u16* sUp = (u16*)(lds + 17408) + dir * (9216 / 2);
  float* sH = (float*)(lds + 35840) + w * (64 * 36);

  const int chb = n * 64;
  const int cp = (tl & 31) * 2, tg = tl >> 5;
  float cw0[4], cw1[4], cb0, cb1;
#pragma unroll
  for (int k = 0; k < 4; ++k) {
    cw0[k] = p.conv_w[((size_t)l * 4 + k) * D + chb + cp];
    cw1[k] = p.conv_w[((size_t)l * 4 + k) * D + chb + cp + 1];
  }
  cb0 = p.conv_b[l * D + chb + cp]; cb1 = p.conv_b[l * D + chb + cp + 1];
  bf16x8 waf[4], wxf[4];
  {
    const float* wa = p.lru_wa + (((size_t)(l * 2 + dir) * 16 + n) * 64) * 64;
    const float* wx = p.lru_wx + (((size_t)(l * 2 + dir) * 16 + n) * 64) * 64;
    const int e = 32 * w2 + r;
#pragma unroll
    for (int ks = 0; ks < 4; ++ks) {
      union { unsigned u[4]; bf16x8 v; } fa, fx;
#pragma unroll
      for (int j = 0; j < 4; ++j) {
        int d0 = ks * 16 + 8 * hh + 2 * j;
        fa.u[j] = pack2(wa[d0 * 64 + e], wa[(d0 + 1) * 64 + e]);
        fx.u[j] = pack2(wx[d0 * 64 + e], wx[(d0 + 1) * 64 + e]);
      }
      waf[ks] = fa.v; wxf[ks] = fx.v;
    }
  }
  const int che = chb + 32 * w2 + r;
  const float ba = p.lru_ba[(l * 2 + dir) * D + che];
  const float bx = p.lru_bx[(l * 2 + dir) * D + che];
  float c8sp;
  {
    float lam = p.lru_lambda[(l * 2 + dir) * D + che];
    float sp = (lam < -20.f) ? -lam : log1pf(expf(-lam));
    c8sp = 8.f * sp;
  }
  float carry = 0.f;

  auto step_tile = [&](int st, bool& isctx, int& tt) {
    if (dir == 0) { if (st < 4) { isctx = true; tt = st; } else { isctx = false; tt = st - 4; } }
    else { if (st < 4) { isctx = true; tt = 3 - st; } else { isctx = false; tt = 63 - (st - 4); } }
  };
  u32x4 pre[5];
  auto load_raw = [&](int st) {
    bool isctx; int tt; step_tile(st, isctx, tt);
    const int seqlen = isctx ? L : S;
    const size_t rowbase = isctx ? (size_t)RL + (size_t)b * L : (size_t)b * S;
    const int t0 = tt * 64;
#pragma unroll
    for (int i = 0; i < 5; ++i) {
      int c = tl + 128 * i;
      int rr = c >> 3, c16 = c & 7;
      int t = t0 - 2 + rr;
      u32x4 v = {0u, 0u, 0u, 0u};
      if (rr < 67 && t >= 0 && t < seqlen) v = *(const u32x4*)(p.U + (rowbase + t) * D + chb + c16 * 8);
      pre[i] = v;
    }
  };
  load_raw(0);
  __syncthreads();
  for (int st = 0; st < 68; ++st) {
    bool isctx; int tt; step_tile(st, isctx, tt);
    const size_t rowbase = isctx ? (size_t)RL + (size_t)b * L : (size_t)b * S;
    const int t0 = tt * 64;
#pragma unroll
    for (int i = 0; i < 5; ++i) {
      int c = tl + 128 * i;
      int rr = c >> 3, c16 = c & 7;
      if (rr < 67) *(u32x4*)(sRaw + rr * 64 + c16 * 8) = pre[i];
    }
    if (st + 1 < 68) load_raw(st + 1);
    __syncthreads();
    {
      const u16* rp = sRaw + (tg * 16) * 64 + cp;
      unsigned r0 = *(const unsigned*)(rp), r1 = *(const unsigned*)(rp + 64), r2 = *(const unsigned*)(rp + 128);
#pragma unroll
      for (int i = 0; i < 16; ++i) {
        unsigned r3 = *(const unsigned*)(rp + (i + 3) * 64);
        float o0 = cb0 + cw0[0] * bflo(r0) + cw0[1] * bflo(r1) + cw0[2] * bflo(r2) + cw0[3] * bflo(r3);
        float o1 = cb1 + cw1[0] * bfhi(r0) + cw1[1] * bfhi(r1) + cw1[2] * bfhi(r2) + cw1[3] * bfhi(r3);
        *(unsigned*)(sUp + (tg * 16 + i) * 72 + cp) = pack2(o0, o1);
        r0 = r1; r1 = r2; r2 = r3;
      }
    }
    __syncthreads();
    const bool fwd_first = isctx ? (tt <= 1) : (tt <= 31);
    const bool first = (dir == 0) ? fwd_first : !fwd_first;
    unsigned long long pt0[4], pt1[4];
    u32x4 pg[4];
    if (!first && !(isctx && last)) {
#pragma unroll
      for (int j = 0; j < 4; ++j) {
        const int q = lane + 64 * j;
        const int tok = q >> 2, cc = (q & 3) * 8;
        const size_t row = rowbase + t0 + tok;
        const int col = chb + 32 * w2 + cc;
        const u16* tp = p.Hb + row * D + col;
        pt0[j] = __hip_atomic_load((const unsigned long long*)tp, __ATOMIC_RELAXED, __HIP_MEMORY_SCOPE_AGENT);
        pt1[j] = __hip_atomic_load((const unsigned long long*)tp + 1, __ATOMIC_RELAXED, __HIP_MEMORY_SCOPE_AGENT);
        pg[j] = *(const u32x4*)(p.Z + row * 3072 + col);
      }
    } else {
#pragma unroll
      for (int j = 0; j < 4; ++j) { pt0[j] = 0; pt1[j] = 0; pg[j] = u32x4{0u, 0u, 0u, 0u}; }
    }
    float av[2][16], bv[2][16];
    {
      f32x16 aR[2];
#pragma unroll
      for (int mt = 0; mt < 2; ++mt) {
#pragma unroll
        for (int x = 0; x < 16; ++x) aR[mt][x] = 0.f;
        const u16* ub = sUp + (mt * 32 + r) * 72 + hh * 8;
#pragma unroll
        for (int ks = 0; ks < 4; ++ks) aR[mt] = MFMA32(*(const bf16x8*)(ub + ks * 16), waf[ks], aR[mt]);
      }
#pragma unroll
      for (int mt = 0; mt < 2; ++mt)
#pragma unroll
        for (int x = 0; x < 16; ++x) {
          const float rg = sigmoidf_(aR[mt][x] + ba);
          av[mt][x] = -c8sp * rg;
        }
    }
    {
      f32x16 aI[2];
#pragma unroll
      for (int mt = 0; mt < 2; ++mt) {
#pragma unroll
        for (int x = 0; x < 16; ++x) aI[mt][x] = 0.f;
        const u16* ub = sUp + (mt * 32 + r) * 72 + hh * 8;
#pragma unroll
        for (int ks = 0; ks < 4; ++ks) aI[mt] = MFMA32(*(const bf16x8*)(ub + ks * 16), wxf[ks], aI[mt]);
      }
#pragma unroll
      for (int mt = 0; mt < 2; ++mt)
#pragma unroll
        for (int x = 0; x < 16; ++x) {
          const int tok = mt * 32 + crow(x, hh);
          const float up = bf2f(sUp[tok * 72 + 32 * w2 + r]);
          const float ig = sigmoidf_(aI[mt][x] + bx);
          const float la = av[mt][x];
          const float a_ = __expf(la);
          const float om = fmaxf(1.f - a_ * a_, 0.f);
          av[mt][x] = a_;
          bv[mt][x] = __builtin_amdgcn_sqrtf(om) * (ig * up);
        }
    }
    if (dir == 0) lru_scan<false>(av, bv, carry, hh); else lru_scan<true>(av, bv, carry, hh);
#pragma unroll
    for (int mt = 0; mt < 2; ++mt)
#pragma unroll
      for (int x = 0; x < 16; ++x) sH[(mt * 32 + crow(x, hh)) * 36 + r] = bv[mt][x];
    if (!(isctx && last)) {
#pragma unroll
      for (int j = 0; j < 4; ++j) {
        const int q = lane + 64 * j;
        const int tok = q >> 2, cc = (q & 3) * 8;
        const float4 h0 = *(const float4*)(sH + tok * 36 + cc);
        const float4 h1 = *(const float4*)(sH + tok * 36 + cc + 4);
        const size_t row = rowbase + t0 + tok;
        const int col = chb + 32 * w2 + cc;
        u16* tp = p.Hb + row * D + col;
        if (first) {
          uint4 o; o.x = pack2(h0.x, h0.y); o.y = pack2(h0.z, h0.w); o.z = pack2(h1.x, h1.y); o.w = pack2(h1.z, h1.w);
          if (!dry || h0.x != h0.x) *(uint4*)tp = o;
        } else {
          unsigned tx = (unsigned)pt0[j], ty = (unsigned)(pt0[j] >> 32), tz = (unsigned)pt1[j], tw = (unsigned)(pt1[j] >> 32);
          u16* zp = p.Z + row * 3072 + col;
          u32x4 g = pg[j];
          uint4 o;
          o.x = pack2((h0.x + bflo(tx)) * bflo(g.x), (h0.y + bfhi(tx)) * bfhi(g.x));
          o.y = pack2((h0.z + bflo(ty)) * bflo(g.y), (h0.w + bfhi(ty)) * bfhi(g.y));
          o.z = pack2((h1.x + bflo(tz)) * bflo(g.z), (h1.y + bfhi(tz)) * bfhi(g.z));
          o.w = pack2((h1.z + bflo(tw)) * bflo(g.w), (h1.w + bfhi(tw)) * bfhi(g.w));
          if (!dry || h0.x != h0.x) *(uint4*)zp = o;
        }
      }
    }
    __builtin_amdgcn_fence(__ATOMIC_RELEASE, "workgroup");
  }
}

DI void phase_mixers(const Params& p, int chunk, int l, char* lds, int dry = 0) {
  const int NB = p.NB, RL = NB * S;
  const bool last = (l == DEPTH - 1);
  const int nLRU = (dry == 1) ? 0 : NB * 16, nC = (dry == 2) ? 0 : NB * 8 * 32, nBw = (dry == 2) ? 0 : NB * 8 * 32, nCtx = (last || dry == 2) ? 0 : NB * 8 * 2 * 2;
  const int total = nLRU + nC + nBw + nCtx;
  int* ctr = p.ctr + chunk * DEPTH + l + (dry ? 32 : 0);
  if (dry == 2) __threadfence();
  int* s_item = (int*)(lds + LDS_BYTES - 16);
  int it;
  while (true) {
    __syncthreads();
    if (threadIdx.x == 0) *s_item = atomicAdd(ctr, 1);
    __syncthreads();
    it = __builtin_amdgcn_readfirstlane(*s_item);
    __syncthreads();
    if (it >= nLRU) break;
    lru_item(p, l, it >> 4, it & 15, last, lds, dry);
  }
  bool have = true;
  while (true) {
    if (!have) {
      __syncthreads();
      if (threadIdx.x == 0) *s_item = atomicAdd(ctr, 1);
      __syncthreads();
      it = __builtin_amdgcn_readfirstlane(*s_item);
      __syncthreads();
    }
    have = false;
    if (it >= total) break;
    it -= nLRU;
    AttnArgs a;
    a.dry = dry;
    if (it < nC + nBw) {
      const bool isB = it >= nC;
      if (isB) it -= nC;
      const int b = it >> 8, h = (it >> 5) & 7, qb = it & 31;
      const int kvh = h >> 2;
      const int br = isB ? 0 : 1;
      const size_t qrow0 = (size_t)b * S + qb * 128;
      a.q = p.Q + qrow0 * 2048 + br * 1024 + h * 128;
      a.z = p.Z + qrow0 * 3072 + (br + 1) * 1024 + h * 128;
      const int kcol = br * 256 + kvh * 128, slot = br * 2 + kvh;
      a.kctx = p.Kb + ((size_t)RL + (size_t)b * L) * 512 + kcol;
      a.vctx = p.VtC + (size_t)(b * 4 + slot) * 128 * L;
      int k0, k1;
      if (isB) { k0 = qb * 128 - 128; if (k0 < 0) k0 = 0; k1 = qb * 128 + 256; if (k1 > S) k1 = S; }
      else { k0 = 0; k1 = S; }
      a.lat_key0 = k0;
      a.n_lat_tiles = (k1 - k0) >> 6;
      a.klat = p.Kb + ((size_t)b * S + k0) * 512 + kcol;
      a.vlat = p.VtL + (size_t)(b * 4 + slot) * 128 * S + k0;
      a.q_t0 = qb * 128;
      a.band = isB ? 1 : 0;
      a.has_sink = isB ? 1 : 0;
      a.sink_l2 = isB ? p.attn_sink[l * 8 + h] * LOG2E : 0.f;
    } else {
      it -= nC + nBw;
      const int qb = it & 1, h = (it >> 1) & 7, br = (it >> 4) & 1, b = it >> 5;
      const int kvh = h >> 2;
      const size_t qrow0 = (size_t)RL + (size_t)b * L + qb * 128;
      a.q = p.Q + qrow0 * 2048 + br * 1024 + h * 128;
      a.z = p.Z + qrow0 * 3072 + (br + 1) * 1024 + h * 128;
      const int kcol = br * 256 + kvh * 128, slot = br * 2 + kvh;
      a.kctx = p.Kb + ((size_t)RL + (size_t)b * L) * 512 + kcol;
      a.vctx = p.VtC + (size_t)(b * 4 + slot) * 128 * L;
      a.klat = a.kctx; a.vlat = a.vctx;
      a.n_lat_tiles = 0; a.lat_key0 = 0; a.q_t0 = 0; a.band = 0;
      a.has_sink = (br == 0) ? 1 : 0;
      a.sink_l2 = (br == 0) ? p.attn_sink[l * 8 + h] * LOG2E : 0.f;
    }
    attn_item(a, lds);
  }
}

DI void phase_merge(const Params& p, int chunk, int l, char* lds) {
  const int NB = p.NB, RL = NB * S, R = NB * (S + L);
  const bool last = (l == DEPTH - 1);
  const int MT = (last ? RL : R) / 128, NT = 8;
  const int tid = otid();
  for (int ti = 0;; ++ti) {
    int mt, nt;
    if (!tile_map(ti, MT, NT, mt, nt)) break;
    const int m0 = mt * 128, n0 = nt * 128;
    const int lane = tid & 63, w = tid >> 6, wm = w >> 1, wn = w & 1, r = lane & 31, hh = lane >> 5;
    f32x16 tot[2][2];
#pragma unroll
    for (int i = 0; i < 2; ++i)
#pragma unroll
      for (int j = 0; j < 2; ++j)
#pragma unroll
        for (int x = 0; x < 16; ++x) tot[i][j][x] = 0.f;
#pragma unroll 1
    for (int n = 0; n < 3; ++n) {
      f32x16 acc[2][2];
      gemm_core(p.Z + (size_t)m0 * 3072 + n * 1024, 3072, p.WbT + ((size_t)(l * 3 + n) * D + n0) * D, D, D, lds, acc);
#pragma unroll
      for (int i = 0; i < 2; ++i)
#pragma unroll
        for (int j = 0; j < 2; ++j)
#pragma unroll
          for (int g = 0; g < 4; ++g) {
            const size_t row = (size_t)m0 + wm * 64 + i * 32 + r;
            const int col = n0 + wn * 64 + j * 32 + 8 * g + 4 * hh;
            uint2 sv = *(const uint2*)(p.Ms + row * 3072 + n * 1024 + col);
            tot[i][j][4 * g + 0] += bflo(sv.x) * acc[i][j][4 * g + 0];
            tot[i][j][4 * g + 1] += bfhi(sv.x) * acc[i][j][4 * g + 1];
            tot[i][j][4 * g + 2] += bflo(sv.y) * acc[i][j][4 * g + 2];
            tot[i][j][4 * g + 3] += bfhi(sv.y) * acc[i][j][4 * g + 3];
          }
    }
#pragma unroll
    for (int i = 0; i < 2; ++i)
#pragma unroll
      for (int j = 0; j < 2; ++j)
#pragma unroll
        for (int g = 0; g < 4; ++g) {
          const size_t row = (size_t)m0 + wm * 64 + i * 32 + r;
          const int col = n0 + wn * 64 + j * 32 + 8 * g + 4 * hh;
          uint2 o; o.x = pack2(tot[i][j][4 * g], tot[i][j][4 * g + 1]); o.y = pack2(tot[i][j][4 * g + 2], tot[i][j][4 * g + 3]);
          *(uint2*)(p.Hb + row * D + col) = o;
        }
  }
}

DI void phase_outproj(const Params& p, int chunk, int l, char* lds) {
  const int NB = p.NB, RL = NB * S, R = NB * (S + L);
  const bool last = (l == DEPTH - 1);
  const int MT = (last ? RL : R) / 128, NT = 8;
  const int tid = otid();
  for (int ti = 0;; ++ti) {
    int mt, nt;
    if (!tile_map(ti, MT, NT, mt, nt)) break;
    const int m0 = mt * 128, n0 = nt * 128;
    f32x16 acc[2][2];
    gemm_core(p.Hb + (size_t)m0 * D, D, p.WoT + ((size_t)l * D + n0) * D, D, D, lds, acc);
    stage_acc(lds, acc);
    const int row = tid >> 1, half = tid & 1;
    const int gr = m0 + row;
    const float* src; float* dst; int mrow;
    if (gr < RL) {
      int b = gr / S, t = gr % S; int bg = chunk * NB + b;
      size_t off = ((size_t)bg * S + t) * D + n0 + half * 64;
      src = (l == 0 ? p.x : p.out) + off; dst = p.out + off; mrow = bg;
    } else {
      int rc = gr - RL; int b = rc / L, t = rc % L; int bg = chunk * NB + b;
      size_t off = ((size_t)bg * L + t) * D + n0 + half * 64;
      src = (l == 0 ? p.ctx : p.xc) + off; dst = p.xc + off; mrow = 16;
    }
    const float* gate = p.modv + ((size_t)l * 17 + mrow) * 3072 + 2048 + n0 + half * 64;
    const float* Cs = (const float*)lds + row * 132 + half * 64;
    float4 xv[16], gv[16];
#pragma unroll
    for (int j = 0; j < 16; ++j) { xv[j] = *(const float4*)(src + j * 4); gv[j] = *(const float4*)(gate + j * 4); }
#pragma unroll
    for (int j = 0; j < 16; ++j) {
      float4 cv = *(const float4*)(Cs + j * 4);
      float4 o;
      o.x = xv[j].x + gv[j].x * cv.x; o.y = xv[j].y + gv[j].y * cv.y; o.z = xv[j].z + gv[j].z * cv.z; o.w = xv[j].w + gv[j].w * cv.w;
      *(float4*)(dst + j * 4) = o;
    }
  }
}

DI void phase_final(const Params& p) {
  const int tid_ = otid();
  const int lane = tid_ & 63;
  const int wg = blockIdx.x * 4 + (tid_ >> 6), nw = gridDim.x * 4;
  for (int r = wg; r < NBATCH * S; r += nw) {
    float* src = p.out + (size_t)r * D;
    float4 v[4]; float ss = 0.f;
#pragma unroll
    for (int i = 0; i < 4; ++i) {
      v[i] = *(const float4*)(src + i * 256 + lane * 4);
      ss += v[i].x * v[i].x + v[i].y * v[i].y + v[i].z * v[i].z + v[i].w * v[i].w;
    }
#pragma unroll
    for (int o = 32; o >= 1; o >>= 1) ss += __shfl_xor(ss, o);
    float rstd = rsqrtf(ss * (1.f / D) + EPS);
#pragma unroll
    for (int i = 0; i < 4; ++i) {
      int cidx = i * 256 + lane * 4;
      float4 gg = *(const float4*)(p.final_g + cidx);
      float4 o;
      o.x = v[i].x * rstd * gg.x; o.y = v[i].y * rstd * gg.y; o.z = v[i].z * rstd * gg.z; o.w = v[i].w * rstd * gg.w;
      *(float4*)(src + cidx) = o;
    }
  }
}

#ifndef DUP_PHASE
#define DUP_PHASE 0
#endif
#ifndef PROBE_A
#define PROBE_A -1
#define PROBE_B -1
#endif
__global__ void __launch_bounds__(256, 2) fwd_megakernel(Params p) {
  cg::grid_group grid = cg::this_grid();
  __shared__ __attribute__((aligned(16))) char lds[LDS_BYTES];
#if PROBE_A >= 0
  long long tacc[8] = {0, 0, 0, 0, 0, 0, 0, 0};
  long long t0 = wall_clock64(), t1;
#define TICK(i) { t1 = wall_clock64(); tacc[i] += t1 - t0; t0 = t1; }
#else
#define TICK(i)
#endif
  phase0(p, lds);
  grid.sync();
  TICK(0)
  phase_mod(p, lds);
  grid.sync();
  TICK(1)
  for (int chunk = 0; chunk < p.nchunk; ++chunk) {
    for (int l = 0; l < DEPTH; ++l) {
      phase_prenorm(p, chunk, l);
      grid.sync();
      TICK(2)
      phase_gemm_in(p, chunk, l, lds);
      grid.sync();
      TICK(3)
#if DUP_PHASE == 3
      phase_gemm_in(p, chunk, l, lds);
      grid.sync();
#endif
#if DUP_PHASE == 31
      phase_gemm_in(p, chunk, l, lds, 1);
      grid.sync();
#endif
#if DUP_PHASE == 32
      phase_gemm_in(p, chunk, l, lds, 2);
      grid.sync();
#endif
#if DUP_PHASE == 4
      phase_mixers(p, chunk, l, lds, 1);
      grid.sync();
#endif
#if DUP_PHASE == 6
      phase_mixers(p, chunk, l, lds, 2);
      grid.sync();
#endif
      phase_mixers(p, chunk, l, lds);
      grid.sync();
      TICK(4)
      phase_merge(p, chunk, l, lds);
      grid.sync();
      TICK(5)
#if DUP_PHASE == 5
      phase_merge(p, chunk, l, lds);
      grid.sync();
#endif
      phase_outproj(p, chunk, l, lds);
      grid.sync();
      TICK(6)
    }
  }
  phase_final(p);
#if PROBE_A >= 0
  grid.sync();
  TICK(7)
  if (blockIdx.x == 0) {
    float A = (float)tacc[PROBE_A] * 0.01f;
    float B = (float)tacc[PROBE_B] * 0.001f;
    A = exp2f(rintf(log2f(A) * 8.f) * 0.125f);
    B = exp2f(rintf(log2f(B) * 8.f) * 0.125f);
    for (int i = threadIdx.x; i <= 1000000; i += 256) p.out[i] = (i == 0) ? A : B;
  }
#endif
}

extern "C" void kernel_launch(void* const* d_in, const int* in_sizes, int n_in,
                              void* d_out, int out_size, void* d_ws, size_t ws_size,
                              hipStream_t stream) {
  static int grid_blocks = 0;
  if (!grid_blocks) {
    int dev = 0, cus = 0, per_cu = 0;
    (void)hipGetDevice(&dev);
    (void)hipDeviceGetAttribute(&cus, hipDeviceAttributeMultiprocessorCount, dev);
    (void)hipOccupancyMaxActiveBlocksPerMultiprocessor(&per_cu, fwd_megakernel, 256, 0);
    if (per_cu > 2) per_cu = 2;
    if (per_cu < 1) per_cu = 1;
    grid_blocks = cus * per_cu;
  }
  Params p{};
  const float* const* in = (const float* const*)d_in;
  p.x = in[0]; p.c = in[1]; p.ctx = in[2]; p.c_ctx = in[3]; p.norm_g = in[4]; p.w_mod = in[5]; p.b_mod = in[6];
  p.w_in = in[7]; p.conv_w = in[8]; p.conv_b = in[9]; p.lru_wa = in[10]; p.lru_ba = in[11]; p.lru_wx = in[12];
  p.lru_bx = in[13]; p.lru_lambda = in[14]; p.attn_sink = in[15]; p.q_norm_g = in[16]; p.k_norm_g = in[17];
  p.w_branch = in[18]; p.w_out = in[19]; p.final_g = in[20];
  p.out = (float*)d_out;
  char* ws = (char*)d_ws;
  size_t off = 0;
  auto take = [&](size_t bytes) { char* r = ws + off; off += (bytes + 255) & ~(size_t)255; return r; };
  p.ctr = (int*)take(256);
  p.modv = (float*)take((size_t)DEPTH * 17 * 3072 * 4);
  p.sc = (float*)take((size_t)17 * D * 4);
  p.rope = (float*)take(4096 * 4);
  p.xc = (float*)take((size_t)NBATCH * L * D * 4);
  p.WinT = (u16*)take((size_t)DEPTH * INW * D * 2);
  p.WbT = (u16*)take((size_t)DEPTH * 3 * D * D * 2);
  p.WoT = (u16*)take((size_t)DEPTH * D * D * 2);
  const size_t fixed = off;
  int NB = 8;
  while (NB > 1) {
    size_t R = (size_t)NB * (S + L);
    size_t need = fixed + R * (size_t)(1024 + 1024 + 3072 + 2048 + 512 + 512 + 3072) * 2 + 8 * 256;
    if (need <= ws_size) break;
    NB >>= 1;
  }
  p.NB = NB; p.nchunk = NBATCH / NB;
  const size_t R = (size_t)NB * (S + L);
  p.Hb = (u16*)take(R * 1024 * 2);
  p.U = (u16*)take(R * 1024 * 2);
  p.Z = (u16*)take(R * 3072 * 2);
  p.Q = (u16*)take(R * 2048 * 2);
  p.Kb = (u16*)take(R * 512 * 2);
  p.VtL = (u16*)take((size_t)NB * 4 * 128 * S * 2);
  p.VtC = (u16*)take((size_t)NB * 4 * 128 * L * 2);
  p.Ms = (u16*)take(R * 3072 * 2);
  void* args[] = {&p};
  hipError_t e = hipLaunchCooperativeKernel((void*)fwd_megakernel, dim3(grid_blocks), dim3(256), args, 0, stream);
  if (e != hipSuccess) fprintf(stderr, "cooperative launch failed: %s (grid %d)\n", hipGetErrorString(e), grid_blocks);
}
```

```cpp
#include <hip/hip_runtime.h>
#include <hip/hip_cooperative_groups.h>
#include <cstdio>
#include <cstdint>
namespace cg = cooperative_groups;

typedef unsigned short u16;
typedef __attribute__((ext_vector_type(8))) short bf16x8;
typedef __attribute__((ext_vector_type(4))) short s16x4;
typedef __attribute__((ext_vector_type(16))) float f32x16;
typedef __bf16 bf16x2_t __attribute__((ext_vector_type(2)));
typedef float float2_t __attribute__((ext_vector_type(2)));
typedef __attribute__((ext_vector_type(4))) unsigned u32x4;
typedef __attribute__((ext_vector_type(2))) unsigned u32x2;

#define DI __device__ __forceinline__
#define MFMA32(a, b, c) __builtin_amdgcn_mfma_f32_32x32x16_bf16((a), (b), (c), 0, 0, 0)

constexpr int D = 1024, NBATCH = 16, S = 4096, L = 256, DEPTH = 4, INW = 10240;
constexpr int LDS_BYTES = 73728;
constexpr float EPS = 1e-6f;
constexpr float QSCALE = 0.08838834764831845f * 1.4426950408889634f;
constexpr float LOG2E = 1.4426950408889634f;

struct Params {
  const float *x, *c, *ctx, *c_ctx, *norm_g, *w_mod, *b_mod, *w_in, *conv_w, *conv_b, *lru_wa, *lru_ba, *lru_wx, *lru_bx,
      *lru_lambda, *attn_sink, *q_norm_g, *k_norm_g, *w_branch, *w_out, *final_g;
  float* out;
  u16 *WinT, *WbT, *WoT;
  u16 *Hb, *U, *Z, *Q, *Kb, *VtL, *VtC, *Ms;
  float *modv, *sc, *rope, *xc;
  int* ctr;
  int NB;
  int nchunk;
};

DI unsigned pack2(float a, float b) {
  float2_t f = {a, b};
  bf16x2_t v = __builtin_convertvector(f, bf16x2_t);
  return __builtin_bit_cast(unsigned, v);
}
DI float bf2f(u16 v) { return __uint_as_float(((unsigned)v) << 16); }
DI float bflo(unsigned v) { return __uint_as_float(v << 16); }
DI float bfhi(unsigned v) { return __uint_as_float(v & 0xffff0000u); }
DI float sigmoidf_(float x) { return __builtin_amdgcn_rcpf(1.f + __expf(-x)); }
DI float siluf_(float x) { return x * __builtin_amdgcn_rcpf(1.f + __expf(-x)); }
DI int otid() { int t = threadIdx.x; asm volatile("" : "+v"(t)); return t; }
DI int crow(int i, int hh) { return (i & 3) + 8 * (i >> 2) + 4 * hh; }

DI void phase0(const Params& p, char* lds) {
  const int tid = otid();
  float* tile = (float*)lds;
  const int n_in = DEPTH * 16 * 160, n_b = DEPTH * 3 * 256, n_o = DEPTH * 256;
  for (int it = blockIdx.x; it < n_in + n_b + n_o; it += gridDim.x) {
    const float* src; u16* dst; int ldsrc;
    if (it < n_in) {
      int l = it / 2560, rem = it % 2560, kt = rem / 160, nt = rem % 160;
      src = p.w_in + (size_t)l * D * INW + (size_t)(kt * 64) * INW + nt * 64; ldsrc = INW;
      dst = p.WinT + (size_t)l * INW * D + (size_t)(nt * 64) * D + kt * 64;
    } else if (it < n_in + n_b) {
      int i2 = it - n_in; int mat = i2 / 256, rem = i2 % 256, kt = rem / 16, nt = rem % 16;
      src = p.w_branch + (size_t)mat * D * D + (size_t)(kt * 64) * D + nt * 64; ldsrc = D;
      dst = p.WbT + (size_t)mat * D * D + (size_t)(nt * 64) * D + kt * 64;
    } else {
      int i2 = it - n_in - n_b; int mat = i2 / 256, rem = i2 % 256, kt = rem / 16, nt = rem % 16;
      src = p.w_out + (size_t)mat * D * D + (size_t)(kt * 64) * D + nt * 64; ldsrc = D;
      dst = p.WoT + (size_t)mat * D * D + (size_t)(nt * 64) * D + kt * 64;
    }
    __syncthreads();
#pragma unroll
    for (int i = 0; i < 4; ++i) {
      int c = tid + 256 * i; int row = c >> 4, c4 = c & 15;
      float4 v = *(const float4*)(src + (size_t)row * ldsrc + c4 * 4);
      float* t = tile + row * 65 + c4 * 4;
      t[0] = v.x; t[1] = v.y; t[2] = v.z; t[3] = v.w;
    }
    __syncthreads();
#pragma unroll
    for (int i = 0; i < 2; ++i) {
      int c = tid + 256 * i; int nrow = c >> 3, k8 = c & 7;
      float v[8];
#pragma unroll
      for (int j = 0; j < 8; ++j) v[j] = tile[(k8 * 8 + j) * 65 + nrow];
      uint4 o; o.x = pack2(v[0], v[1]); o.y = pack2(v[2], v[3]); o.z = pack2(v[4], v[5]); o.w = pack2(v[6], v[7]);
      *(uint4*)(dst + (size_t)nrow * D + k8 * 8) = o;
    }
  }
  const int gt = blockIdx.x * 256 + tid, gn = gridDim.x * 256;
  for (int i = gt; i < 17 * D; i += gn) {
    int r = i / D, k = i % D;
    float v = (r < 16) ? p.c[r * D + k] : p.c_ctx[k];
    p.sc[i] = siluf_(v);
  }
  for (int i = gt; i < 64 * 32; i += gn) {
    int pos = i >> 5, pp = i & 31;
    float inv = powf(10000.f, -(float)pp / 32.f);
    float ang = (float)pos * inv;
    p.rope[i] = cosf(ang);
    p.rope[2048 + i] = sinf(ang);
  }
  if (blockIdx.x == 0 && tid < 64) p.ctr[tid] = 0;
}

DI void phase_mod(const Params& p, char* lds) {
  const int tid = otid();
  float* red = (float*)lds;
  const int col = tid & 63, kg = tid >> 6;
  for (int it = blockIdx.x; it < DEPTH * 48; it += gridDim.x) {
    int l = it / 48, cb = it % 48;
    float acc[17];
#pragma unroll
    for (int r = 0; r < 17; ++r) acc[r] = 0.f;
    const float* w = p.w_mod + (size_t)l * D * 3072 + cb * 64 + col;
    for (int k = kg * 256; k < kg * 256 + 256; ++k) {
      float wv = w[(size_t)k * 3072];
#pragma unroll
      for (int r = 0; r < 17; ++r) acc[r] += p.sc[r * D + k] * wv;
    }
    __syncthreads();
#pragma unroll
    for (int r = 0; r < 17; ++r) red[(kg * 17 + r) * 64 + col] = acc[r];
    __syncthreads();
    for (int i = tid; i < 17 * 64; i += 256) {
      int r = i >> 6, cc = i & 63;
      float s = red[(0 * 17 + r) * 64 + cc] + red[(1 * 17 + r) * 64 + cc] + red[(2 * 17 + r) * 64 + cc] + red[(3 * 17 + r) * 64 + cc];
      p.modv[((size_t)l * 17 + r) * 3072 + cb * 64 + cc] = s + p.b_mod[l * 3072 + cb * 64 + cc];
    }
  }
}

DI void phase_prenorm(const Params& p, int chunk, int l) {
  const int NB = p.NB, RL = NB * S, R = NB * (S + L);
  const int tid_ = otid();
  const int lane = tid_ & 63;
  const int wg = blockIdx.x * 4 + (tid_ >> 6), nw = gridDim.x * 4;
  const float* g = p.norm_g + l * D;
  for (int r = wg; r < R; r += nw) {
    const float* src; int mrow;
    if (r < RL) {
      int b = r / S, t = r % S; int bg = chunk * NB + b;
      src = (l == 0 ? p.x : p.out) + ((size_t)bg * S + t) * D; mrow = bg;
    } else {
      int rc = r - RL; int b = rc / L, t = rc % L; int bg = chunk * NB + b;
      src = (l == 0 ? p.ctx : p.xc) + ((size_t)bg * L + t) * D; mrow = 16;
    }
    const float* mv = p.modv + ((size_t)l * 17 + mrow) * 3072;
    float4 v[4]; float ss = 0.f;
#pragma unroll
    for (int i = 0; i < 4; ++i) {
      v[i] = *(const float4*)(src + i * 256 + lane * 4);
      ss += v[i].x * v[i].x + v[i].y * v[i].y + v[i].z * v[i].z + v[i].w * v[i].w;
    }
#pragma unroll
    for (int o = 32; o >= 1; o >>= 1) ss += __shfl_xor(ss, o);
    float rstd = rsqrtf(ss * (1.f / D) + EPS);
#pragma unroll
    for (int i = 0; i < 4; ++i) {
      int cidx = i * 256 + lane * 4;
      float4 gg = *(const float4*)(g + cidx);
      float4 sh = *(const float4*)(mv + cidx);
      float4 scl = *(const float4*)(mv + 1024 + cidx);
      float h0 = v[i].x * rstd * gg.x * (1.f + scl.x) + sh.x;
      float h1 = v[i].y * rstd * gg.y * (1.f + scl.y) + sh.y;
      float h2 = v[i].z * rstd * gg.z * (1.f + scl.z) + sh.z;
      float h3 = v[i].w * rstd * gg.w * (1.f + scl.w) + sh.w;
      uint2 o; o.x = pack2(h0, h1); o.y = pack2(h2, h3);
      *(uint2*)(p.Hb + (size_t)r * D + cidx) = o;
    }
  }
}

DI void gemm_core(const u16* A, int lda, const u16* Bt, int ldb, int K, char* ldsc, f32x16 (&acc)[2][2]) {
  const int tid = otid(), lane = tid & 63, w = tid >> 6, wm = w >> 1, wn = w & 1;
  const int r = lane & 31, hh = lane >> 5;
  const int drow = lane >> 3, dcp = lane & 7;
  const u16* gA[4]; const u16* gB[4];
#pragma unroll
  for (int q = 0; q < 4; ++q) {
    const int row = (w * 4 + q) * 8 + drow;
    const int chunk = dcp ^ ((row >> 1) & 7);
    gA[q] = A + (size_t)row * lda + chunk * 8;
    gB[q] = Bt + (size_t)row * ldb + chunk * 8;
  }
#pragma unroll
  for (int i = 0; i < 2; ++i)
#pragma unroll
    for (int j = 0; j < 2; ++j)
#pragma unroll
      for (int x = 0; x < 16; ++x) acc[i][j][x] = 0.f;
  auto DMA = [&](int kt, int stage) {
    char* sa = ldsc + stage * 32768 + (w * 4) * 1024;
#pragma unroll
    for (int q = 0; q < 4; ++q) {
      __builtin_amdgcn_global_load_lds((const unsigned*)(gA[q] + kt * 64), (unsigned*)(sa + q * 1024), 16, 0, 0);
      __builtin_amdgcn_global_load_lds((const unsigned*)(gB[q] + kt * 64), (unsigned*)(sa + 16384 + q * 1024), 16, 0, 0);
    }
  };
  const int sw = (r >> 1) & 7;
  int koff[4];
#pragma unroll
  for (int ks = 0; ks < 4; ++ks) koff[ks] = ((2 * ks + hh) ^ sw) << 4;
  auto COMPUTE = [&](int stage) {
    const char* ab = ldsc + stage * 32768 + (wm * 64 + r) * 128;
    const char* bb = ldsc + stage * 32768 + 16384 + (wn * 64 + r) * 128;
#pragma unroll
    for (int ks = 0; ks < 4; ++ks) {
      bf16x8 a0 = *(const bf16x8*)(ab + koff[ks]);
      bf16x8 a1 = *(const bf16x8*)(ab + 32 * 128 + koff[ks]);
      bf16x8 b0 = *(const bf16x8*)(bb + koff[ks]);
      bf16x8 b1 = *(const bf16x8*)(bb + 32 * 128 + koff[ks]);
      acc[0][0] = MFMA32(b0, a0, acc[0][0]);
      acc[0][1] = MFMA32(b1, a0, acc[0][1]);
      acc[1][0] = MFMA32(b0, a1, acc[1][0]);
      acc[1][1] = MFMA32(b1, a1, acc[1][1]);
    }
  };
  const int KT = K >> 6;
  __syncthreads();
  DMA(0, 0);
  __syncthreads();
  for (int kt = 0; kt < KT; kt += 2) {
    DMA(kt + 1, 1);
    COMPUTE(0);
    __syncthreads();
    if (kt + 2 < KT) DMA(kt + 2, 0);
    COMPUTE(1);
    __syncthreads();
  }
}

DI void stage_acc(char* ldsc, f32x16 (&acc)[2][2]) {
  const int tid = otid(), lane = tid & 63, w = tid >> 6, wm = w >> 1, wn = w & 1;
  const int r = lane & 31, hh = lane >> 5;
  float* Cs = (float*)ldsc;
#pragma unroll
  for (int i = 0; i < 2; ++i)
#pragma unroll
    for (int j = 0; j < 2; ++j)
#pragma unroll
      for (int g = 0; g < 4; ++g) {
        int m = wm * 64 + i * 32 + r;
        int n = wn * 64 + j * 32 + 8 * g + 4 * hh;
        float4 v; v.x = acc[i][j][4 * g]; v.y = acc[i][j][4 * g + 1]; v.z = acc[i][j][4 * g + 2]; v.w = acc[i][j][4 * g + 3];
        *(float4*)(Cs + m * 132 + n) = v;
      }
  __syncthreads();
}

DI void read_row64(const char* ldsc, int row, int half, float (&v)[64]) {
  const float* Cs = (const float*)ldsc + row * 132 + half * 64;
#pragma unroll
  for (int j = 0; j < 16; ++j) {
    float4 t = *(const float4*)(Cs + j * 4);
    v[j * 4] = t.x; v[j * 4 + 1] = t.y; v[j * 4 + 2] = t.z; v[j * 4 + 3] = t.w;
  }
}

DI void store_row64_bf16(u16* dst, const float (&v)[64]) {
#pragma unroll
  for (int j = 0; j < 8; ++j) {
    uint4 o;
    o.x = pack2(v[j * 8], v[j * 8 + 1]); o.y = pack2(v[j * 8 + 2], v[j * 8 + 3]);
    o.z = pack2(v[j * 8 + 4], v[j * 8 + 5]); o.w = pack2(v[j * 8 + 6], v[j * 8 + 7]);
    *(uint4*)(dst + j * 8) = o;
  }
}

DI bool tile_map(int i, int MT, int NT, int& mt, int& nt) {
  const int G = gridDim.x, bid = blockIdx.x;
  if ((G & 63) == 0 && (MT & 7) == 0 && (NT % (G >> 6)) == 0) {
    const int SH = G >> 6;
    const int xcd = bid & 7, slot = bid >> 3;
    const int sx = slot & 7, sy = slot >> 3;
    const int nsn = NT / SH, nsm = MT >> 3;
    const int st = i * 8 + xcd;
    if (st >= nsm * nsn) return false;
    mt = (st / nsn) * 8 + sx;
    nt = (st % nsn) * SH + sy;
    return true;
  }
  const int it = bid + i * G;
  if (it >= MT * NT) return false;
  mt = it / NT; nt = it % NT;
  return true;
}

DI void phase_gemm_in(const Params& p, int chunk, int l, char* lds, int probe = 0) {
  const int NB = p.NB, RL = NB * S, R = NB * (S + L);
  const int MT = R / 128, NT = 80;
  const int tid = otid();
  const u16* Wt = p.WinT + (size_t)l * INW * D;
  for (int ti = 0;; ++ti) {
    int mt, nt;
    if (!tile_map(ti, MT, NT, mt, nt)) break;
    const int m0 = mt * 128, n0 = nt * 128;
    f32x16 acc[2][2];
    if (probe == 2) gemm_core(p.Hb, D, Wt, D, D, lds, acc);
    else gemm_core(p.Hb + (size_t)m0 * D, D, Wt + (size_t)n0 * D, D, D, lds, acc);
    if (probe) {
      if (acc[0][0][0] != acc[0][0][0] && acc[1][1][5] == 12345.f && acc[0][1][7] == 3.f && acc[1][0][9] == 7.f) p.U[tid] = 1;
      continue;
    }
    {
      int mode = -1; u16* dbase = nullptr; int dld = 0;
      if (nt < 8) { mode = 0; dbase = p.U + nt * 128; dld = D; }
      else if (nt < 16) { mode = 1; dbase = p.Z + (nt - 8) * 128; dld = 3072; }
      else if (nt >= 28 && nt < 36) { mode = 1; dbase = p.Z + 1024 + (nt - 28) * 128; dld = 3072; }
      else if (nt >= 48 && nt < 56) { mode = 1; dbase = p.Z + 2048 + (nt - 48) * 128; dld = 3072; }
      else if (nt >= 56) { mode = 2; dbase = p.Ms + (nt - 56) * 128; dld = 3072; }
      if (mode >= 0) {
        const int lane = tid & 63, w = tid >> 6, wm = w >> 1, wn = w & 1, r = lane & 31, hh = lane >> 5;
#pragma unroll
        for (int i = 0; i < 2; ++i)
#pragma unroll
          for (int j = 0; j < 2; ++j)
#pragma unroll
            for (int g = 0; g < 4; ++g) {
              float v0 = acc[i][j][4 * g], v1 = acc[i][j][4 * g + 1], v2 = acc[i][j][4 * g + 2], v3 = acc[i][j][4 * g + 3];
              if (mode == 1) { v0 = siluf_(v0); v1 = siluf_(v1); v2 = siluf_(v2); v3 = siluf_(v3); }
              else if (mode == 2) { v0 = sigmoidf_(v0); v1 = sigmoidf_(v1); v2 = sigmoidf_(v2); v3 = sigmoidf_(v3); }
              uint2 o; o.x = pack2(v0, v1); o.y = pack2(v2, v3);
              const size_t row = (size_t)m0 + wm * 64 + i * 32 + r;
              const int col = wn * 64 + j * 32 + 8 * g + 4 * hh;
              *(uint2*)(dbase + row * dld + col) = o;
            }
        continue;
      }
    }
    stage_acc(lds, acc);
    const bool lat = m0 < RL;
    int b, t0;
    if (lat) { b = m0 / S; t0 = m0 % S; } else { int rc = m0 - RL; b = rc / L; t0 = rc % L; }
    const bool isV = (nt == 26 || nt == 27 || nt == 46 || nt == 47);
    if (isV) {
      int slot = (nt < 40) ? (nt - 26) : (2 + nt - 46);
      int d = tid >> 1, th = tid & 1;
      const float* Cs = (const float*)lds;
      float v[64];
#pragma unroll
      for (int j = 0; j < 64; ++j) v[j] = Cs[(th * 64 + j) * 132 + d];
      u16* dst = lat ? p.VtL + ((size_t)(b * 4 + slot) * 128 + d) * S + t0 + th * 64
                     : p.VtC + ((size_t)(b * 4 + slot) * 128 + d) * L + t0 + th * 64;
      store_row64_bf16(dst, v);
    } else {
      const int row = tid >> 1, half = tid & 1;
      const size_t gr = (size_t)m0 + row;
      const int t = t0 + row;
      float v[64];
      read_row64(lds, row, half, v);
      if (nt < 8) {
        store_row64_bf16(p.U + gr * D + nt * 128 + half * 64, v);
      } else if (nt < 16 || (nt >= 28 && nt < 36) || (nt >= 48 && nt < 56)) {
        int zc = (nt < 16) ? (nt - 8) * 128 : (nt < 36 ? 1024 + (nt - 28) * 128 : 2048 + (nt - 48) * 128);
#pragma unroll
        for (int j = 0; j < 64; ++j) v[j] = siluf_(v[j]);
        store_row64_bf16(p.Z + gr * 3072 + zc + half * 64, v);
      } else if (nt >= 56) {
#pragma unroll
        for (int j = 0; j < 64; ++j) v[j] = sigmoidf_(v[j]);
        store_row64_bf16(p.Ms + gr * 3072 + (nt - 56) * 128 + half * 64, v);
      } else {
        const bool isC = nt >= 36;
        const bool isQ = (nt >= 16 && nt < 24) || (nt >= 36 && nt < 44);
        if (isC) {
          const float* gn = (isQ ? p.q_norm_g : p.k_norm_g) + l * 128 + half * 64;
          float ss = 0.f;
#pragma unroll
          for (int j = 0; j < 64; ++j) ss += v[j] * v[j];
          ss += __shfl_xor(ss, 1);
          float rstd = rsqrtf(ss * (1.f / 128.f) + EPS);
#pragma unroll
          for (int j = 0; j < 64; ++j) v[j] = v[j] * rstd * gn[j];
        }
        if (lat) {
          int pos = (half == 0) ? (t >> 6) : (t & 63);
          const float* cs = p.rope + pos * 32;
          const float* sn = p.rope + 2048 + pos * 32;
#pragma unroll
          for (int j = 0; j < 32; ++j) {
            float c_ = cs[j], s_ = sn[j];
            float x0 = v[j], x1 = v[32 + j];
            v[j] = x0 * c_ - x1 * s_;
            v[32 + j] = x1 * c_ + x0 * s_;
          }
        }
        if (isQ) {
#pragma unroll
          for (int j = 0; j < 64; ++j) v[j] *= QSCALE;
          int qc = isC ? 1024 + (nt - 36) * 128 : (nt - 16) * 128;
          store_row64_bf16(p.Q + gr * 2048 + qc + half * 64, v);
        } else {
          int kc = isC ? 256 + (nt - 44) * 128 : (nt - 24) * 128;
          store_row64_bf16(p.Kb + gr * 512 + kc + half * 64, v);
        }
      }
    }
  }
}

struct AttnArgs {
  const u16* q;
  u16* z;
  const u16* kctx;
  const u16* vctx;
  const u16* klat;
  const u16* vlat;
  int n_lat_tiles;
  int lat_key0;
  int q_t0;
  int band;
  int has_sink;
  float sink_l2;
  int dry;
};

DI void attn_load_tile(const AttnArgs& a, int ti, u32x4 (&rk)[4], u32x4 (&rv)[4]) {
  const int tid = otid();
  const u16* kp; const u16* vp; int vs;
  if (ti < 4) { kp = a.kctx + (size_t)(ti * 64) * 512; vp = a.vctx + ti * 64; vs = L; }
  else { kp = a.klat + (size_t)((ti - 4) * 64) * 512; vp = a.vlat + (ti - 4) * 64; vs = S; }
#pragma unroll
  for (int i = 0; i < 4; ++i) {
    int c = tid + 256 * i;
    rk[i] = *(const u32x4*)(kp + (size_t)(c >> 4) * 512 + (c & 15) * 8);
    rv[i] = *(const u32x4*)(vp + (size_t)(c >> 3) * vs + (c & 7) * 8);
  }
}
DI void attn_store_tile(u16* sK, u16* sV, const u32x4 (&rk)[4], const u32x4 (&rv)[4]) {
  const int tid = otid();
#pragma unroll
  for (int i = 0; i < 4; ++i) {
    int c = tid + 256 * i;
    *(u32x4*)(sK + (c >> 4) * 136 + (c & 15) * 8) = rk[i];
    u16* vd = sV + (c >> 3) * 68 + (c & 7) * 8;
    { u32x2 t0 = {rv[i].x, rv[i].y}; *(u32x2*)(vd) = t0; }
    { u32x2 t1 = {rv[i].z, rv[i].w}; *(u32x2*)(vd + 4) = t1; }
  }
}

DI void attn_item(const AttnArgs& a, char* lds) {
  const int tid = otid(), lane = tid & 63, w = tid >> 6;
  const int r = lane & 31, hh = lane >> 5;
  u16* sKb = (u16*)lds;
  u16* sVb = sKb + 2 * 64 * 136;
  const int ntiles = 4 + a.n_lat_tiles;

  bf16x8 qf[8];
  {
    const u16* qp = a.q + (size_t)(w * 32 + r) * 2048 + hh * 8;
#pragma unroll
    for (int ks = 0; ks < 8; ++ks) qf[ks] = *(const bf16x8*)(qp + ks * 16);
  }
  f32x16 O[4];
#pragma unroll
  for (int dt = 0; dt < 4; ++dt)
#pragma unroll
    for (int x = 0; x < 16; ++x) O[dt][x] = 0.f;
  float m = a.has_sink ? a.sink_l2 : -1e30f;
  float lsum = (a.has_sink && hh == 0) ? 1.f : 0.f;

  u32x4 rk[4], rv[4];
  attn_load_tile(a, 0, rk, rv);
  __syncthreads();
  attn_store_tile(sKb, sVb, rk, rv);
  __syncthreads();
  const int qpos = a.q_t0 + w * 32 + r;

  for (int ti = 0; ti < ntiles; ++ti) {
    const int cur = ti & 1;
    if (ti + 1 < ntiles) attn_load_tile(a, ti + 1, rk, rv);
    const u16* sK = sKb + cur * 64 * 136;
    const u16* sV = sVb + cur * 128 * 68;
    f32x16 s[2];
#pragma unroll
    for (int kt2 = 0; kt2 < 2; ++kt2) {
#pragma unroll
      for (int x = 0; x < 16; ++x) s[kt2][x] = 0.f;
      const u16* kb = sK + (kt2 * 32 + r) * 136 + hh * 8;
#pragma unroll
      for (int ks = 0; ks < 8; ++ks) {
        bf16x8 ka = *(const bf16x8*)(kb + ks * 16);
        s[kt2] = MFMA32(ka, qf[ks], s[kt2]);
      }
    }
    if (a.band && ti >= 4) {
      const int k0 = a.lat_key0 + (ti - 4) * 64;
#pragma unroll
      for (int kt2 = 0; kt2 < 2; ++kt2)
#pragma unroll
        for (int x = 0; x < 16; ++x) {
          int kp = k0 + kt2 * 32 + crow(x, hh);
          int dlt = kp - qpos; dlt = dlt < 0 ? -dlt : dlt;
          if (dlt > 128) s[kt2][x] = -1e30f;
        }
    }
    float mx = s[0][0];
#pragma unroll
    for (int kt2 = 0; kt2 < 2; ++kt2)
#pragma unroll
      for (int x = 0; x < 16; ++x) mx = fmaxf(mx, s[kt2][x]);
    mx = fmaxf(mx, __shfl_xor(mx, 32));
    if (__any(mx > m + 8.f)) {
      const float mnew = fmaxf(m, mx);
      const float alpha = __builtin_amdgcn_exp2f(m - mnew);
      m = mnew;
      lsum *= alpha;
#pragma unroll
      for (int dt = 0; dt < 4; ++dt)
#pragma unroll
        for (int x = 0; x < 16; ++x) O[dt][x] *= alpha;
    }
    float ps = 0.f;
#pragma unroll
    for (int kt2 = 0; kt2 < 2; ++kt2)
#pragma unroll
      for (int x = 0; x < 16; ++x) { float pv = __builtin_amdgcn_exp2f(s[kt2][x] - m); s[kt2][x] = pv; ps += pv; }
    lsum += ps;
#pragma unroll
    for (int kt2 = 0; kt2 < 2; ++kt2)
#pragma unroll
      for (int s2 = 0; s2 < 2; ++s2) {
        union { unsigned u[4]; bf16x8 v; } pf;
#pragma unroll
        for (int j = 0; j < 4; ++j) pf.u[j] = pack2(s[kt2][8 * s2 + 2 * j], s[kt2][8 * s2 + 2 * j + 1]);
        const u16* vb = sV + r * 68 + kt2 * 32 + 16 * s2 + 4 * hh;
#pragma unroll
        for (int dt = 0; dt < 4; ++dt) {
          s16x4 lo = *(const s16x4*)(vb + dt * 32 * 68);
          s16x4 hi = *(const s16x4*)(vb + dt * 32 * 68 + 8);
          bf16x8 va = __builtin_shufflevector(lo, hi, 0, 1, 2, 3, 4, 5, 6, 7);
          O[dt] = MFMA32(va, pf.v, O[dt]);
        }
      }
    if (ti + 1 < ntiles) attn_store_tile(sKb + (cur ^ 1) * 64 * 136, sVb + (cur ^ 1) * 128 * 68, rk, rv);
    __syncthreads();
  }
  float ltot = lsum + __shfl_xor(lsum, 32);
  const float inv = 1.f / ltot;
  u16* zp = a.z + (size_t)(w * 32 + r) * 3072;
  u32x2 gv[4][4];
#pragma unroll
  for (int dt = 0; dt < 4; ++dt)
#pragma unroll
    for (int g4 = 0; g4 < 4; ++g4) gv[dt][g4] = *(const u32x2*)(zp + dt * 32 + 8 * g4 + 4 * hh);
#pragma unroll
  for (int dt = 0; dt < 4; ++dt)
#pragma unroll
    for (int g4 = 0; g4 < 4; ++g4) {
      int d0 = dt * 32 + 8 * g4 + 4 * hh;
      float y0 = O[dt][4 * g4 + 0] * inv * bflo(gv[dt][g4].x);
      float y1 = O[dt][4 * g4 + 1] * inv * bfhi(gv[dt][g4].x);
      float y2 = O[dt][4 * g4 + 2] * inv * bflo(gv[dt][g4].y);
      float y3 = O[dt][4 * g4 + 3] * inv * bfhi(gv[dt][g4].y);
      uint2 o; o.x = pack2(y0, y1); o.y = pack2(y2, y3);
      if (!a.dry || y0 != y0) *(uint2*)(zp + d0) = o;
    }
}

template <bool REV>
DI void lru_scan(float (&av)[2][16], float (&bv)[2][16], float& carry, int hh) {
  float segA[8], segB[8];
#pragma unroll
  for (int k = 0; k < 8; ++k) {
    const int mt = k >> 2, q = k & 3;
    float cA = 1.f, hl = 0.f;
#pragma unroll
    for (int jj = 0; jj < 4; ++jj) {
      const int j = REV ? 3 - jj : jj;
      const int i = 4 * q + j;
      hl = av[mt][i] * hl + bv[mt][i];
      cA *= av[mt][i];
      av[mt][i] = cA; bv[mt][i] = hl;
    }
    segA[k] = cA; segB[k] = hl;
  }
  float oA[8], oB[8];
#pragma unroll
  for (int k = 0; k < 8; ++k) { oA[k] = __shfl_xor(segA[k], 32); oB[k] = __shfl_xor(segB[k], 32); }
  float init[8];
  float st = carry;
#pragma unroll
  for (int kk = 0; kk < 8; ++kk) {
    const int k = REV ? 7 - kk : kk;
    const int first = REV ? 1 : 0;
    float A1 = (hh == first) ? segA[k] : oA[k];
    float B1 = (hh == first) ? segB[k] : oB[k];
    float st0 = st;
    st = A1 * st + B1;
    float A2 = (hh == first) ? oA[k] : segA[k];
    float B2 = (hh == first) ? oB[k] : segB[k];
    float st1 = st;
    st = A2 * st + B2;
    init[k] = (hh == first) ? st0 : st1;
  }
  carry = st;
#pragma unroll
  for (int k = 0; k < 8; ++k) {
    const int mt = k >> 2, q = k & 3;
#pragma unroll
    for (int j = 0; j < 4; ++j) {
      const int i = 4 * q + j;
      bv[mt][i] = bv[mt][i] + av[mt][i] * init[k];
    }
  }
}

DI void lru_item(const Params& p, int l, int b, int n, bool last, char* lds, int dry = 0) {
  const int NB = p.NB, RL = NB * S;
  const int tid = otid(), lane = tid & 63, w = tid >> 6;
  const int dir = w >> 1, w2 = w & 1;
  const int tl = tid & 127;
  const int r = lane & 31, hh = lane >> 5;
  u16* sRaw = (u16*)lds + dir * (8704 / 2);
  u16* sUp = (u16*)(lds + 17408) + dir * (9216 / 2);
  float* sH = (float*)(lds + 35840) + w * (64 * 36);

  const int chb = n * 64;
  const int cp = (tl & 31) * 2, tg = tl >> 5;
  float cw0[4], cw1[4], cb0, cb1;
#pragma unroll
  for (int k = 0; k < 4; ++k) {
    cw0[k] = p.conv_w[((size_t)l * 4 + k) * D + chb + cp];
    cw1[k] = p.conv_w[((size_t)l * 4 + k) * D + chb + cp + 1];
  }
  cb0 = p.conv_b[l * D + chb + cp]; cb1 = p.conv_b[l * D + chb + cp + 1];
  bf16x8 waf[4], wxf[4];
  {
    const float* wa = p.lru_wa + (((size_t)(l * 2 + dir) * 16 + n) * 64) * 64;
    const float* wx = p.lru_wx + (((size_t)(l * 2 + dir) * 16 + n) * 64) * 64;
    const int e = 32 * w2 + r;
#pragma unroll
    for (int ks = 0; ks < 4; ++ks) {
      union { unsigned u[4]; bf16x8 v; } fa, fx;
#pragma unroll
      for (int j = 0; j < 4; ++j) {
        int d0 = ks * 16 + 8 * hh + 2 * j;
        fa.u[j] = pack2(wa[d0 * 64 + e], wa[(d0 + 1) * 64 + e]);
        fx.u[j] = pack2(wx[d0 * 64 + e], wx[(d0 + 1) * 64 + e]);
      }
      waf[ks] = fa.v; wxf[ks] = fx.v;
    }
  }
  const int che = chb + 32 * w2 + r;
  const float ba = p.lru_ba[(l * 2 + dir) * D + che];
  const float bx = p.lru_bx[(l * 2 + dir) * D + che];
  float c8sp;
  {
    float lam = p.lru_lambda[(l * 2 + dir) * D + che];
    float sp = (lam < -20.f) ? -lam : log1pf(expf(-lam));
    c8sp = 8.f * sp;
  }
  float carry = 0.f;

  auto step_tile = [&](int st, bool& isctx, int& tt) {
    if (dir == 0) { if (st < 4) { isctx = true; tt = st; } else { isctx = false; tt = st - 4; } }
    else { if (st < 4) { isctx = true; tt = 3 - st; } else { isctx = false; tt = 63 - (st - 4); } }
  };
  u32x4 pre[5];
  auto load_raw = [&](int st) {
    bool isctx; int tt; step_tile(st, isctx, tt);
    const int seqlen = isctx ? L : S;
    const size_t rowbase = isctx ? (size_t)RL + (size_t)b * L : (size_t)b * S;
    const int t0 = tt * 64;
#pragma unroll
    for (int i = 0; i < 5; ++i) {
      int c = tl + 128 * i;
      int rr = c >> 3, c16 = c & 7;
      int t = t0 - 2 + rr;
      u32x4 v = {0u, 0u, 0u, 0u};
      if (rr < 67 && t >= 0 && t < seqlen) v = *(const u32x4*)(p.U + (rowbase + t) * D + chb + c16 * 8);
      pre[i] = v;
    }
  };
  load_raw(0);
  __syncthreads();
  for (int st = 0; st < 68; ++st) {
    bool isctx; int tt; step_tile(st, isctx, tt);
    const size_t rowbase = isctx ? (size_t)RL + (size_t)b * L : (size_t)b * S;
    const int t0 = tt * 64;
#pragma unroll
    for (int i = 0; i < 5; ++i) {
      int c = tl + 128 * i;
      int rr = c >> 3, c16 = c & 7;
      if (rr < 67) *(u32x4*)(sRaw + rr * 64 + c16 * 8) = pre[i];
    }
    if (st + 1 < 68) load_raw(st + 1);
    __syncthreads();
    {
      const u16* rp = sRaw + (tg * 16) * 64 + cp;
      unsigned r0 = *(const unsigned*)(rp), r1 = *(const unsigned*)(rp + 64), r2 = *(const unsigned*)(rp + 128);
#pragma unroll
      for (int i = 0; i < 16; ++i) {
        unsigned r3 = *(const unsigned*)(rp + (i + 3) * 64);
        float o0 = cb0 + cw0[0] * bflo(r0) + cw0[1] * bflo(r1) + cw0[2] * bflo(r2) + cw0[3] * bflo(r3);
        float o1 = cb1 + cw1[0] * bfhi(r0) + cw1[1] * bfhi(r1) + cw1[2] * bfhi(r2) + cw1[3] * bfhi(r3);
        *(unsigned*)(sUp + (tg * 16 + i) * 72 + cp) = pack2(o0, o1);
        r0 = r1; r1 = r2; r2 = r3;
      }
    }
    __syncthreads();
    const bool fwd_first = isctx ? (tt <= 1) : (tt <= 31);
    const bool first = (dir == 0) ? fwd_first : !fwd_first;
    unsigned long long pt0[4], pt1[4];
    u32x4 pg[4];
    if (!first && !(isctx && last)) {
#pragma unroll
      for (int j = 0; j < 4; ++j) {
        const int q = lane + 64 * j;
        const int tok = q >> 2, cc = (q & 3) * 8;
        const size_t row = rowbase + t0 + tok;
        const int col = chb + 32 * w2 + cc;
        const u16* tp = p.Hb + row * D + col;
        pt0[j] = __hip_atomic_load((const unsigned long long*)tp, __ATOMIC_RELAXED, __HIP_MEMORY_SCOPE_AGENT);
        pt1[j] = __hip_atomic_load((const unsigned long long*)tp + 1, __ATOMIC_RELAXED, __HIP_MEMORY_SCOPE_AGENT);
        pg[j] = *(const u32x4*)(p.Z + row * 3072 + col);
      }
    } else {
#pragma unroll
      for (int j = 0; j < 4; ++j) { pt0[j] = 0; pt1[j] = 0; pg[j] = u32x4{0u, 0u, 0u, 0u}; }
    }
    float av[2][16], bv[2][16];
    {
      f32x16 aR[2];
#pragma unroll
      for (int mt = 0; mt < 2; ++mt) {
#pragma unroll
        for (int x = 0; x < 16; ++x) aR[mt][x] = 0.f;
        const u16* ub = sUp + (mt * 32 + r) * 72 + hh * 8;
#pragma unroll
        for (int ks = 0; ks < 4; ++ks) aR[mt] = MFMA32(*(const bf16x8*)(ub + ks * 16), waf[ks], aR[mt]);
      }
#pragma unroll
      for (int mt = 0; mt < 2; ++mt)
#pragma unroll
        for (int x = 0; x < 16; ++x) {
          const float rg = sigmoidf_(aR[mt][x] + ba);
          av[mt][x] = -c8sp * rg;
        }
    }
    {
      f32x16 aI[2];
#pragma unroll
      for (int mt = 0; mt < 2; ++mt) {
#pragma unroll
        for (int x = 0; x < 16; ++x) aI[mt][x] = 0.f;
        const u16* ub = sUp + (mt * 32 + r) * 72 + hh * 8;
#pragma unroll
        for (int ks = 0; ks < 4; ++ks) aI[mt] = MFMA32(*(const bf16x8*)(ub + ks * 16), wxf[ks], aI[mt]);
      }
#pragma unroll
      for (int mt = 0; mt < 2; ++mt)
#pragma unroll
        for (int x = 0; x < 16; ++x) {
          const int tok = mt * 32 + crow(x, hh);
          const float up = bf2f(sUp[tok * 72 + 32 * w2 + r]);
          const float ig = sigmoidf_(aI[mt][x] + bx);
          const float la = av[mt][x];
          const float a_ = __expf(la);
          const float om = fmaxf(1.f - a_ * a_, 0.f);
          av[mt][x] = a_;
          bv[mt][x] = __builtin_amdgcn_sqrtf(om) * (ig * up);
        }
    }
    if (dir == 0) lru_scan<false>(av, bv, carry, hh); else lru_scan<true>(av, bv, carry, hh);
#pragma unroll
    for (int mt = 0; mt < 2; ++mt)
#pragma unroll
      for (int x = 0; x < 16; ++x) sH[(mt * 32 + crow(x, hh)) * 36 + r] = bv[mt][x];
    if (!(isctx && last)) {
#pragma unroll
      for (int j = 0; j < 4; ++j) {
        const int q = lane + 64 * j;
        const int tok = q >> 2, cc = (q & 3) * 8;
        const float4 h0 = *(const float4*)(sH + tok * 36 + cc);
        const float4 h1 = *(const float4*)(sH + tok * 36 + cc + 4);
        const size_t row = rowbase + t0 + tok;
        const int col = chb + 32 * w2 + cc;
        u16* tp = p.Hb + row * D + col;
        if (first) {
          uint4 o; o.x = pack2(h0.x, h0.y); o.y = pack2(h0.z, h0.w); o.z = pack2(h1.x, h1.y); o.w = pack2(h1.z, h1.w);
          if (!dry || h0.x != h0.x) *(uint4*)tp = o;
        } else {
          unsigned tx = (unsigned)pt0[j], ty = (unsigned)(pt0[j] >> 32), tz = (unsigned)pt1[j], tw = (unsigned)(pt1[j] >> 32);
          u16* zp = p.Z + row * 3072 + col;
          u32x4 g = pg[j];
          uint4 o;
          o.x = pack2((h0.x + bflo(tx)) * bflo(g.x), (h0.y + bfhi(tx)) * bfhi(g.x));
          o.y = pack2((h0.z + bflo(ty)) * bflo(g.y), (h0.w + bfhi(ty)) * bfhi(g.y));
          o.z = pack2((h1.x + bflo(tz)) * bflo(g.z), (h1.y + bfhi(tz)) * bfhi(g.z));
          o.w = pack2((h1.z + bflo(tw)) * bflo(g.w), (h1.w + bfhi(tw)) * bfhi(g.w));
          if (!dry || h0.x != h0.x) *(uint4*)zp = o;
        }
      }
    }
    __builtin_amdgcn_fence(__ATOMIC_RELEASE, "workgroup");
  }
}

DI void phase_mixers(const Params& p, int chunk, int l, char* lds, int dry = 0) {
  const int NB = p.NB, RL = NB * S;
  const bool last = (l == DEPTH - 1);
  const int nLRU = (dry == 1) ? 0 : NB * 16, nC = (dry == 2) ? 0 : NB * 8 * 32, nBw = (dry == 2) ? 0 : NB * 8 * 32, nCtx = (last || dry == 2) ? 0 : NB * 8 * 2 * 2;
  const int total = nLRU + nC + nBw + nCtx;
  int* ctr = p.ctr + chunk * DEPTH + l + (dry ? 32 : 0);
  if (dry == 2) __threadfence();
  int* s_item = (int*)(lds + LDS_BYTES - 16);
  int it;
  while (true) {
    __syncthreads();
    if (threadIdx.x == 0) *s_item = atomicAdd(ctr, 1);
    __syncthreads();
    it = __builtin_amdgcn_readfirstlane(*s_item);
    __syncthreads();
    if (it >= nLRU) break;
    lru_item(p, l, it >> 4, it & 15, last, lds, dry);
  }
  bool have = true;
  while (true) {
    if (!have) {
      __syncthreads();
      if (threadIdx.x == 0) *s_item = atomicAdd(ctr, 1);
      __syncthreads();
      it = __builtin_amdgcn_readfirstlane(*s_item);
      __syncthreads();
    }
    have = false;
    if (it >= total) break;
    it -= nLRU;
    AttnArgs a;
    a.dry = dry;
    if (it < nC + nBw) {
      const bool isB = it >= nC;
      if (isB) it -= nC;
      const int b = it >> 8, h = (it >> 5) & 7, qb = it & 31;
      const int kvh = h >> 2;
      const int br = isB ? 0 : 1;
      const size_t qrow0 = (size_t)b * S + qb * 128;
      a.q = p.Q + qrow0 * 2048 + br * 1024 + h * 128;
      a.z = p.Z + qrow0 * 3072 + (br + 1) * 1024 + h * 128;
      const int kcol = br * 256 + kvh * 128, slot = br * 2 + kvh;
      a.kctx = p.Kb + ((size_t)RL + (size_t)b * L) * 512 + kcol;
      a.vctx = p.VtC + (size_t)(b * 4 + slot) * 128 * L;
      int k0, k1;
      if (isB) { k0 = qb * 128 - 128; if (k0 < 0) k0 = 0; k1 = qb * 128 + 256; if (k1 > S) k1 = S; }
      else { k0 = 0; k1 = S; }
      a.lat_key0 = k0;
      a.n_lat_tiles = (k1 - k0) >> 6;
      a.klat = p.Kb + ((size_t)b * S + k0) * 512 + kcol;
      a.vlat = p.VtL + (size_t)(b * 4 + slot) * 128 * S + k0;
      a.q_t0 = qb * 128;
      a.band = isB ? 1 : 0;
      a.has_sink = isB ? 1 : 0;
      a.sink_l2 = isB ? p.attn_sink[l * 8 + h] * LOG2E : 0.f;
    } else {
      it -= nC + nBw;
      const int qb = it & 1, h = (it >> 1) & 7, br = (it >> 4) & 1, b = it >> 5;
      const int kvh = h >> 2;
      const size_t qrow0 = (size_t)RL + (size_t)b * L + qb * 128;
      a.q = p.Q + qrow0 * 2048 + br * 1024 + h * 128;
      a.z = p.Z + qrow0 * 3072 + (br + 1) * 1024 + h * 128;
      const int kcol = br * 256 + kvh * 128, slot = br * 2 + kvh;
      a.kctx = p.Kb + ((size_t)RL + (size_t)b * L) * 512 + kcol;
      a.vctx = p.VtC + (size_t)(b * 4 + slot) * 128 * L;
      a.klat = a.kctx; a.vlat = a.vctx;
      a.n_lat_tiles = 0; a.lat_key0 = 0; a.q_t0 = 0; a.band = 0;
      a.has_sink = (br == 0) ? 1 : 0;
      a.sink_l2 = (br == 0) ? p.attn_sink[l * 8 + h] * LOG2E : 0.f;
    }
    attn_item(a, lds);
  }
}

DI void phase_merge(const Params& p, int chunk, int l, char* lds) {
  const int NB = p.NB, RL = NB * S, R = NB * (S + L);
  const bool last = (l == DEPTH - 1);
  const int MT = (last ? RL : R) / 128, NT = 8;
  const int tid = otid();
  for (int ti = 0;; ++ti) {
    int mt, nt;
    if (!tile_map(ti, MT, NT, mt, nt)) break;
    const int m0 = mt * 128, n0 = nt * 128;
    const int lane = tid & 63, w = tid >> 6, wm = w >> 1, wn = w & 1, r = lane & 31, hh = lane >> 5;
    f32x16 tot[2][2];
#pragma unroll
    for (int i = 0; i < 2; ++i)
#pragma unroll
      for (int j = 0; j < 2; ++j)
#pragma unroll
        for (int x = 0; x < 16; ++x) tot[i][j][x] = 0.f;
#pragma unroll 1
    for (int n = 0; n < 3; ++n) {
      f32x16 acc[2][2];
      u32x2 sv[2][2][4];
#pragma unroll
      for (int i = 0; i < 2; ++i)
#pragma unroll
        for (int j = 0; j < 2; ++j)
#pragma unroll
          for (int g = 0; g < 4; ++g) {
            const size_t row = (size_t)m0 + wm * 64 + i * 32 + r;
            const int col = n0 + wn * 64 + j * 32 + 8 * g + 4 * hh;
            sv[i][j][g] = *(const u32x2*)(p.Ms + row * 3072 + n * 1024 + col);
          }
      gemm_core(p.Z + (size_t)m0 * 3072 + n * 1024, 3072, p.WbT + ((size_t)(l * 3 + n) * D + n0) * D, D, D, lds, acc);
#pragma unroll
      for (int i = 0; i < 2; ++i)
#pragma unroll
        for (int j = 0; j < 2; ++j)
#pragma unroll
          for (int g = 0; g < 4; ++g) {
            tot[i][j][4 * g + 0] += bflo(sv[i][j][g].x) * acc[i][j][4 * g + 0];
            tot[i][j][4 * g + 1] += bfhi(sv[i][j][g].x) * acc[i][j][4 * g + 1];
            tot[i][j][4 * g + 2] += bflo(sv[i][j][g].y) * acc[i][j][4 * g + 2];
            tot[i][j][4 * g + 3] += bfhi(sv[i][j][g].y) * acc[i][j][4 * g + 3];
          }
    }
#pragma unroll
    for (int i = 0; i < 2; ++i)
#pragma unroll
      for (int j = 0; j < 2; ++j)
#pragma unroll
        for (int g = 0; g < 4; ++g) {
          const size_t row = (size_t)m0 + wm * 64 + i * 32 + r;
          const int col = n0 + wn * 64 + j * 32 + 8 * g + 4 * hh;
          uint2 o; o.x = pack2(tot[i][j][4 * g], tot[i][j][4 * g + 1]); o.y = pack2(tot[i][j][4 * g + 2], tot[i][j][4 * g + 3]);
          *(uint2*)(p.Hb + row * D + col) = o;
        }
  }
}

DI void phase_outproj(const Params& p, int chunk, int l, char* lds) {
  const int NB = p.NB, RL = NB * S, R = NB * (S + L);
  const bool last = (l == DEPTH - 1);
  const int MT = (last ? RL : R) / 128, NT = 8;
  const int tid = otid();
  for (int ti = 0;; ++ti) {
    int mt, nt;
    if (!tile_map(ti, MT, NT, mt, nt)) break;
    const int m0 = mt * 128, n0 = nt * 128;
    const int row = tid >> 1, half = tid & 1;
    const int gr = m0 + row;
    const float* src; float* dst; int mrow;
    if (gr < RL) {
      int b = gr / S, t = gr % S; int bg = chunk * NB + b;
      size_t off = ((size_t)bg * S + t) * D + n0 + half * 64;
      src = (l == 0 ? p.x : p.out) + off; dst = p.out + off; mrow = bg;
    } else {
      int rc = gr - RL; int b = rc / L, t = rc % L; int bg = chunk * NB + b;
      size_t off = ((size_t)bg * L + t) * D + n0 + half * 64;
      src = (l == 0 ? p.ctx : p.xc) + off; dst = p.xc + off; mrow = 16;
    }
    float4 xv[16];
#pragma unroll
    for (int j = 0; j < 16; ++j) xv[j] = *(const float4*)(src + j * 4);
    f32x16 acc[2][2];
    gemm_core(p.Hb + (size_t)m0 * D, D, p.WoT + ((size_t)l * D + n0) * D, D, D, lds, acc);
    stage_acc(lds, acc);
    const float* gate = p.modv + ((size_t)l * 17 + mrow) * 3072 + 2048 + n0 + half * 64;
    const float* Cs = (const float*)lds + row * 132 + half * 64;
    float4 gv[16];
#pragma unroll
    for (int j = 0; j < 16; ++j) gv[j] = *(const float4*)(gate + j * 4);
#pragma unroll
    for (int j = 0; j < 16; ++j) {
      float4 cv = *(const float4*)(Cs + j * 4);
      float4 o;
      o.x = xv[j].x + gv[j].x * cv.x; o.y = xv[j].y + gv[j].y * cv.y; o.z = xv[j].z + gv[j].z * cv.z; o.w = xv[j].w + gv[j].w * cv.w;
      *(float4*)(dst + j * 4) = o;
    }
  }
}

DI void phase_final(const Params& p) {
  const int tid_ = otid();
  const int lane = tid_ & 63;
  const int wg = blockIdx.x * 4 + (tid_ >> 6), nw = gridDim.x * 4;
  for (int r = wg; r < NBATCH * S; r += nw) {
    float* src = p.out + (size_t)r * D;
    float4 v[4]; float ss = 0.f;
#pragma unroll
    for (int i = 0; i < 4; ++i) {
      v[i] = *(const float4*)(src + i * 256 + lane * 4);
      ss += v[i].x * v[i].x + v[i].y * v[i].y + v[i].z * v[i].z + v[i].w * v[i].w;
    }
#pragma unroll
    for (int o = 32; o >= 1; o >>= 1) ss += __shfl_xor(ss, o);
    float rstd = rsqrtf(ss * (1.f / D) + EPS);
#pragma unroll
    for (int i = 0; i < 4; ++i) {
      int cidx = i * 256 + lane * 4;
      float4 gg = *(const float4*)(p.final_g + cidx);
      float4 o;
      o.x = v[i].x * rstd * gg.x; o.y = v[i].y * rstd * gg.y; o.z = v[i].z * rstd * gg.z; o.w = v[i].w * rstd * gg.w;
      *(float4*)(src + cidx) = o;
    }
  }
}

#ifndef DUP_PHASE
#define DUP_PHASE 0
#endif
#ifndef PROBE_A
#define PROBE_A -1
#define PROBE_B -1
#endif
__global__ void __launch_bounds__(256, 2) fwd_megakernel(Params p) {
  cg::grid_group grid = cg::this_grid();
  __shared__ __attribute__((aligned(16))) char lds[LDS_BYTES];
#if PROBE_A >= 0
  long long tacc[8] = {0, 0, 0, 0, 0, 0, 0, 0};
  long long t0 = wall_clock64(), t1;
#define TICK(i) { t1 = wall_clock64(); tacc[i] += t1 - t0; t0 = t1; }
#else
#define TICK(i)
#endif
  phase0(p, lds);
  grid.sync();
  TICK(0)
  phase_mod(p, lds);
  grid.sync();
  TICK(1)
  for (int chunk = 0; chunk < p.nchunk; ++chunk) {
    for (int l = 0; l < DEPTH; ++l) {
      phase_prenorm(p, chunk, l);
      grid.sync();
      TICK(2)
      phase_gemm_in(p, chunk, l, lds);
      grid.sync();
      TICK(3)
#if DUP_PHASE == 3
      phase_gemm_in(p, chunk, l, lds);
      grid.sync();
#endif
#if DUP_PHASE == 31
      phase_gemm_in(p, chunk, l, lds, 1);
      grid.sync();
#endif
#if DUP_PHASE == 32
      phase_gemm_in(p, chunk, l, lds, 2);
      grid.sync();
#endif
#if DUP_PHASE == 4
      phase_mixers(p, chunk, l, lds, 1);
      grid.sync();
#endif
#if DUP_PHASE == 6
      phase_mixers(p, chunk, l, lds, 2);
      grid.sync();
#endif
      phase_mixers(p, chunk, l, lds);
      grid.sync();
      TICK(4)
      phase_merge(p, chunk, l, lds);
      grid.sync();
      TICK(5)
#if DUP_PHASE == 5
      phase_merge(p, chunk, l, lds);
      grid.sync();
#endif
      phase_outproj(p, chunk, l, lds);
      grid.sync();
      TICK(6)
    }
  }
  phase_final(p);
#if PROBE_A >= 0
  grid.sync();
  TICK(7)
  if (blockIdx.x == 0) {
    float A = (float)tacc[PROBE_A] * 0.01f;
    float B = (float)tacc[PROBE_B] * 0.001f;
    A = exp2f(rintf(log2f(A) * 8.f) * 0.125f);
    B = exp2f(rintf(log2f(B) * 8.f) * 0.125f);
    for (int i = threadIdx.x; i <= 1000000; i += 256) p.out[i] = (i == 0) ? A : B;
  }
#endif
}

extern "C" void kernel_launch(void* const* d_in, const int* in_sizes, int n_in,
                              void* d_out, int out_size, void* d_ws, size_t ws_size,
                              hipStream_t stream) {
  static int grid_blocks = 0;
  if (!grid_blocks) {
    int dev = 0, cus = 0, per_cu = 0;
    (void)hipGetDevice(&dev);
    (void)hipDeviceGetAttribute(&cus, hipDeviceAttributeMultiprocessorCount, dev);
    (void)hipOccupancyMaxActiveBlocksPerMultiprocessor(&per_cu, fwd_megakernel, 256, 0);
    if (per_cu > 2) per_cu = 2;
    if (per_cu < 1) per_cu = 1;
    grid_blocks = cus * per_cu;
  }
  Params p{};
  const float* const* in = (const float* const*)d_in;
  p.x = in[0]; p.c = in[1]; p.ctx = in[2]; p.c_ctx = in[3]; p.norm_g = in[4]; p.w_mod = in[5]; p.b_mod = in[6];
  p.w_in = in[7]; p.conv_w = in[8]; p.conv_b = in[9]; p.lru_wa = in[10]; p.lru_ba = in[11]; p.lru_wx = in[12];
  p.lru_bx = in[13]; p.lru_lambda = in[14]; p.attn_sink = in[15]; p.q_norm_g = in[16]; p.k_norm_g = in[17];
  p.w_branch = in[18]; p.w_out = in[19]; p.final_g = in[20];
  p.out = (float*)d_out;
  char* ws = (char*)d_ws;
  size_t off = 0;
  auto take = [&](size_t bytes) { char* r = ws + off; off += (bytes + 255) & ~(size_t)255; return r; };
  p.ctr = (int*)take(256);
  p.modv = (float*)take((size_t)DEPTH * 17 * 3072 * 4);
  p.sc = (float*)take((size_t)17 * D * 4);
  p.rope = (float*)take(4096 * 4);
  p.xc = (float*)take((size_t)NBATCH * L * D * 4);
  p.WinT = (u16*)take((size_t)DEPTH * INW * D * 2);
  p.WbT = (u16*)take((size_t)DEPTH * 3 * D * D * 2);
  p.WoT = (u16*)take((size_t)DEPTH * D * D * 2);
  const size_t fixed = off;
  int NB = 8;
  while (NB > 1) {
    size_t R = (size_t)NB * (S + L);
    size_t need = fixed + R * (size_t)(1024 + 1024 + 3072 + 2048 + 512 + 512 + 3072) * 2 + 8 * 256;
    if (need <= ws_size) break;
    NB >>= 1;
  }
  p.NB = NB; p.nchunk = NBATCH / NB;
  const size_t R = (size_t)NB * (S + L);
  p.Hb = (u16*)take(R * 1024 * 2);
  p.U = (u16*)take(R * 1024 * 2);
  p.Z = (u16*)take(R * 3072 * 2);
  p.Q = (u16*)take(R * 2048 * 2);
  p.Kb = (u16*)take(R * 512 * 2);
  p.VtL = (u16*)take((size_t)NB * 4 * 128 * S * 2);
  p.VtC = (u16*)take((size_t)NB * 4 * 128 * L * 2);
  p.Ms = (u16*)take(R * 3072 * 2);
  void* args[] = {&p};
  hipError_t e = hipLaunchCooperativeKernel((void*)fwd_megakernel, dim3(grid_blocks), dim3(256), args, 0, stream);
  if (e != hipSuccess) fprintf(stderr, "cooperative launch failed: %s (grid %d)\n", hipGetErrorString(e), grid_blocks);
}
```

```cpp
#include <hip/hip_runtime.h>
#include <hip/hip_cooperative_groups.h>
#include <cstdio>
#include <cstdint>
namespace cg = cooperative_groups;

typedef unsigned short u16;
typedef __attribute__((ext_vector_type(8))) short bf16x8;
typedef __attribute__((ext_vector_type(4))) short s16x4;
typedef __attribute__((ext_vector_type(16))) float f32x16;
typedef __bf16 bf16x2_t __attribute__((ext_vector_type(2)));
typedef float float2_t __attribute__((ext_vector_type(2)));
typedef __attribute__((ext_vector_type(4))) unsigned u32x4;
typedef __attribute__((ext_vector_type(2))) unsigned u32x2;

#define DI __device__ __forceinline__
#define MFMA32(a, b, c) __builtin_amdgcn_mfma_f32_32x32x16_bf16((a), (b), (c), 0, 0, 0)

constexpr int D = 1024, NBATCH = 16, S = 4096, L = 256, DEPTH = 4, INW = 10240;
constexpr int LDS_BYTES = 73728;
constexpr float EPS = 1e-6f;
constexpr float QSCALE = 0.08838834764831845f * 1.4426950408889634f;
constexpr float LOG2E = 1.4426950408889634f;

struct Params {
  const float *x, *c, *ctx, *c_ctx, *norm_g, *w_mod, *b_mod, *w_in, *conv_w, *conv_b, *lru_wa, *lru_ba, *lru_wx, *lru_bx,
      *lru_lambda, *attn_sink, *q_norm_g, *k_norm_g, *w_branch, *w_out, *final_g;
  float* out;
  u16 *WinT, *WbT, *WoT;
  u16 *Hb, *U, *Z, *Q, *Kb, *VtL, *VtC, *Ms;
  float *modv, *sc, *rope, *xc;
  int* ctr;
  int NB;
  int nchunk;
};

DI unsigned pack2(float a, float b) {
  float2_t f = {a, b};
  bf16x2_t v = __builtin_convertvector(f, bf16x2_t);
  return __builtin_bit_cast(unsigned, v);
}
DI float bf2f(u16 v) { return __uint_as_float(((unsigned)v) << 16); }
DI float bflo(unsigned v) { return __uint_as_float(v << 16); }
DI float bfhi(unsigned v) { return __uint_as_float(v & 0xffff0000u); }
DI float sigmoidf_(float x) { return __builtin_amdgcn_rcpf(1.f + __expf(-x)); }
DI float siluf_(float x) { return x * __builtin_amdgcn_rcpf(1.f + __expf(-x)); }
DI int otid() { int t = threadIdx.x; asm volatile("" : "+v"(t)); return t; }
DI int crow(int i, int hh) { return (i & 3) + 8 * (i >> 2) + 4 * hh; }

DI void phase0(const Params& p, char* lds) {
  const int tid = otid();
  float* tile = (float*)lds;
  const int n_in = DEPTH * 16 * 160, n_b = DEPTH * 3 * 256, n_o = DEPTH * 256;
  for (int it = blockIdx.x; it < n_in + n_b + n_o; it += gridDim.x) {
    const float* src; u16* dst; int ldsrc;
    if (it < n_in) {
      int l = it / 2560, rem = it % 2560, kt = rem / 160, nt = rem % 160;
      src = p.w_in + (size_t)l * D * INW + (size_t)(kt * 64) * INW + nt * 64; ldsrc = INW;
      dst = p.WinT + (size_t)l * INW * D + ((size_t)(nt >> 1) * 16 + kt) * 8192 + (nt & 1) * 4096;
    } else if (it < n_in + n_b) {
      int i2 = it - n_in; int mat = i2 / 256, rem = i2 % 256, kt = rem / 16, nt = rem % 16;
      src = p.w_branch + (size_t)mat * D * D + (size_t)(kt * 64) * D + nt * 64; ldsrc = D;
      dst = p.WbT + (size_t)mat * D * D + ((size_t)(nt >> 1) * 16 + kt) * 8192 + (nt & 1) * 4096;
    } else {
      int i2 = it - n_in - n_b; int mat = i2 / 256, rem = i2 % 256, kt = rem / 16, nt = rem % 16;
      src = p.w_out + (size_t)mat * D * D + (size_t)(kt * 64) * D + nt * 64; ldsrc = D;
      dst = p.WoT + (size_t)mat * D * D + ((size_t)(nt >> 1) * 16 + kt) * 8192 + (nt & 1) * 4096;
    }
    __syncthreads();
#pragma unroll
    for (int i = 0; i < 4; ++i) {
      int c = tid + 256 * i; int row = c >> 4, c4 = c & 15;
      float4 v = *(const float4*)(src + (size_t)row * ldsrc + c4 * 4);
      float* t = tile + row * 65 + c4 * 4;
      t[0] = v.x; t[1] = v.y; t[2] = v.z; t[3] = v.w;
    }
    __syncthreads();
#pragma unroll
    for (int i = 0; i < 2; ++i) {
      int c = tid + 256 * i; int nrow = c >> 3, k8 = c & 7;
      float v[8];
#pragma unroll
      for (int j = 0; j < 8; ++j) v[j] = tile[(k8 * 8 + j) * 65 + nrow];
      uint4 o; o.x = pack2(v[0], v[1]); o.y = pack2(v[2], v[3]); o.z = pack2(v[4], v[5]); o.w = pack2(v[6], v[7]);
      *(uint4*)(dst + (size_t)nrow * 64 + k8 * 8) = o;
    }
  }
  const int gt = blockIdx.x * 256 + tid, gn = gridDim.x * 256;
  for (int i = gt; i < 17 * D; i += gn) {
    int r = i / D, k = i % D;
    float v = (r < 16) ? p.c[r * D + k] : p.c_ctx[k];
    p.sc[i] = siluf_(v);
  }
  for (int i = gt; i < 64 * 32; i += gn) {
    int pos = i >> 5, pp = i & 31;
    float inv = powf(10000.f, -(float)pp / 32.f);
    float ang = (float)pos * inv;
    p.rope[i] = cosf(ang);
    p.rope[2048 + i] = sinf(ang);
  }
  if (blockIdx.x == 0 && tid < 64) p.ctr[tid] = 0;
}

DI void phase_mod(const Params& p, char* lds) {
  const int tid = otid();
  float* red = (float*)lds;
  const int col = tid & 63, kg = tid >> 6;
  for (int it = blockIdx.x; it < DEPTH * 48; it += gridDim.x) {
    int l = it / 48, cb = it % 48;
    float acc[17];
#pragma unroll
    for (int r = 0; r < 17; ++r) acc[r] = 0.f;
    const float* w = p.w_mod + (size_t)l * D * 3072 + cb * 64 + col;
    for (int k = kg * 256; k < kg * 256 + 256; ++k) {
      float wv = w[(size_t)k * 3072];
#pragma unroll
      for (int r = 0; r < 17; ++r) acc[r] += p.sc[r * D + k] * wv;
    }
    __syncthreads();
#pragma unroll
    for (int r = 0; r < 17; ++r) red[(kg * 17 + r) * 64 + col] = acc[r];
    __syncthreads();
    for (int i = tid; i < 17 * 64; i += 256) {
      int r = i >> 6, cc = i & 63;
      float s = red[(0 * 17 + r) * 64 + cc] + red[(1 * 17 + r) * 64 + cc] + red[(2 * 17 + r) * 64 + cc] + red[(3 * 17 + r) * 64 + cc];
      p.modv[((size_t)l * 17 + r) * 3072 + cb * 64 + cc] = s + p.b_mod[l * 3072 + cb * 64 + cc];
    }
  }
}

DI void phase_prenorm(const Params& p, int chunk, int l) {
  const int NB = p.NB, RL = NB * S, R = NB * (S + L);
  const int tid_ = otid();
  const int lane = tid_ & 63;
  const int wg = blockIdx.x * 4 + (tid_ >> 6), nw = gridDim.x * 4;
  const float* g = p.norm_g + l * D;
  for (int r = wg; r < R; r += nw) {
    const float* src; int mrow;
    if (r < RL) {
      int b = r / S, t = r % S; int bg = chunk * NB + b;
      src = (l == 0 ? p.x : p.out) + ((size_t)bg * S + t) * D; mrow = bg;
    } else {
      int rc = r - RL; int b = rc / L, t = rc % L; int bg = chunk * NB + b;
      src = (l == 0 ? p.ctx : p.xc) + ((size_t)bg * L + t) * D; mrow = 16;
    }
    const float* mv = p.modv + ((size_t)l * 17 + mrow) * 3072;
    float4 v[4]; float ss = 0.f;
#pragma unroll
    for (int i = 0; i < 4; ++i) {
      v[i] = *(const float4*)(src + i * 256 + lane * 4);
      ss += v[i].x * v[i].x + v[i].y * v[i].y + v[i].z * v[i].z + v[i].w * v[i].w;
    }
#pragma unroll
    for (int o = 32; o >= 1; o >>= 1) ss += __shfl_xor(ss, o);
    float rstd = rsqrtf(ss * (1.f / D) + EPS);
#pragma unroll
    for (int i = 0; i < 4; ++i) {
      int cidx = i * 256 + lane * 4;
      float4 gg = *(const float4*)(g + cidx);
      float4 sh = *(const float4*)(mv + cidx);
      float4 scl = *(const float4*)(mv + 1024 + cidx);
      float h0 = v[i].x * rstd * gg.x * (1.f + scl.x) + sh.x;
      float h1 = v[i].y * rstd * gg.y * (1.f + scl.y) + sh.y;
      float h2 = v[i].z * rstd * gg.z * (1.f + scl.z) + sh.z;
      float h3 = v[i].w * rstd * gg.w * (1.f + scl.w) + sh.w;
      uint2 o; o.x = pack2(h0, h1); o.y = pack2(h2, h3);
      *(uint2*)(p.Hb + ((size_t)(r >> 7) * 16 + (cidx >> 6)) * 8192 + (r & 127) * 64 + (cidx & 63)) = o;
    }
  }
}

template <bool PIPE>
DI void gemm_core(const u16* A, int lda, int ksa, const u16* Bt, int ldb, int ksb, int K, char* ldsc, f32x16 (&acc)[2][2]) {
  const int tid = otid(), lane = tid & 63, w = tid >> 6, wm = w >> 1, wn = w & 1;
  const int r = lane & 31, hh = lane >> 5;
  const int drow = lane >> 3, dcp = lane & 7;
  const int chunk0 = dcp ^ (drow >> 1);
  const u16* gAe = A + (size_t)(w * 32 + drow) * lda + chunk0 * 8;
  const u16* gAo = A + (size_t)(w * 32 + 8 + drow) * lda + (chunk0 ^ 4) * 8;
  const u16* gBe = Bt + (size_t)(w * 32 + drow) * ldb + chunk0 * 8;
  const u16* gBo = Bt + (size_t)(w * 32 + 8 + drow) * ldb + (chunk0 ^ 4) * 8;
  const size_t a16 = (size_t)16 * lda, b16 = (size_t)16 * ldb;
#pragma unroll
  for (int i = 0; i < 2; ++i)
#pragma unroll
    for (int j = 0; j < 2; ++j)
#pragma unroll
      for (int x = 0; x < 16; ++x) acc[i][j][x] = 0.f;
  auto DMA = [&](int kt, int stage) {
    char* sa = ldsc + stage * 32768 + (w * 4) * 1024;
    const size_t ka = (size_t)kt * ksa, kb = (size_t)kt * ksb;
    __builtin_amdgcn_global_load_lds((const unsigned*)(gAe + ka), (unsigned*)(sa), 16, 0, 0);
    __builtin_amdgcn_global_load_lds((const unsigned*)(gBe + kb), (unsigned*)(sa + 16384), 16, 0, 0);
    __builtin_amdgcn_global_load_lds((const unsigned*)(gAo + ka), (unsigned*)(sa + 1024), 16, 0, 0);
    __builtin_amdgcn_global_load_lds((const unsigned*)(gBo + kb), (unsigned*)(sa + 16384 + 1024), 16, 0, 0);
    __builtin_amdgcn_global_load_lds((const unsigned*)(gAe + a16 + ka), (unsigned*)(sa + 2048), 16, 0, 0);
    __builtin_amdgcn_global_load_lds((const unsigned*)(gBe + b16 + kb), (unsigned*)(sa + 16384 + 2048), 16, 0, 0);
    __builtin_amdgcn_global_load_lds((const unsigned*)(gAo + a16 + ka), (unsigned*)(sa + 3072), 16, 0, 0);
    __builtin_amdgcn_global_load_lds((const unsigned*)(gBo + b16 + kb), (unsigned*)(sa + 16384 + 3072), 16, 0, 0);
  };
  const int sw = (r >> 1) & 7;
  int koff[4];
#pragma unroll
  for (int ks = 0; ks < 4; ++ks) koff[ks] = ((2 * ks + hh) ^ sw) << 4;
  auto COMPUTE = [&](int stage) {
    const char* ab = ldsc + stage * 32768 + (wm * 64 + r) * 128;
    const char* bb = ldsc + stage * 32768 + 16384 + (wn * 64 + r) * 128;
#define LDF(ks, a0_, a1_, b0_, b1_)                                  \
    a0_ = *(const bf16x8*)(ab + koff[ks]);                           \
    b0_ = *(const bf16x8*)(bb + koff[ks]);                           \
    a1_ = *(const bf16x8*)(ab + 32 * 128 + koff[ks]);                \
    b1_ = *(const bf16x8*)(bb + 32 * 128 + koff[ks]);
#define MM(a0_, a1_, b0_, b1_)                                       \
    acc[0][0] = MFMA32(b0_, a0_, acc[0][0]);                         \
    acc[0][1] = MFMA32(b1_, a0_, acc[0][1]);                         \
    acc[1][0] = MFMA32(b0_, a1_, acc[1][0]);                         \
    acc[1][1] = MFMA32(b1_, a1_, acc[1][1]);
    bf16x8 pa0, pa1, pb0, pb1, qa0, qa1, qb0, qb1;
    if (!PIPE) {
#pragma unroll
      for (int ks = 0; ks < 4; ++ks) {
        LDF(ks, pa0, pa1, pb0, pb1)
        MM(pa0, pa1, pb0, pb1)
      }
      return;
    }
    LDF(0, pa0, pa1, pb0, pb1)
    LDF(1, qa0, qa1, qb0, qb1)
    __builtin_amdgcn_sched_barrier(0);
    MM(pa0, pa1, pb0, pb1)
    LDF(2, pa0, pa1, pb0, pb1)
    __builtin_amdgcn_sched_barrier(0);
    MM(qa0, qa1, qb0, qb1)
    LDF(3, qa0, qa1, qb0, qb1)
    __builtin_amdgcn_sched_barrier(0);
    MM(pa0, pa1, pb0, pb1)
    MM(qa0, qa1, qb0, qb1)
#undef LDF
#undef MM
  };
  const int KT = K >> 6;
  __syncthreads();
  DMA(0, 0);
  __syncthreads();
  for (int kt = 0; kt < KT; kt += 2) {
    DMA(kt + 1, 1);
    COMPUTE(0);
    __syncthreads();
    if (kt + 2 < KT) DMA(kt + 2, 0);
    COMPUTE(1);
    __syncthreads();
  }
}

DI void stage_acc(char* ldsc, f32x16 (&acc)[2][2]) {
  const int tid = otid(), lane = tid & 63, w = tid >> 6, wm = w >> 1, wn = w & 1;
  const int r = lane & 31, hh = lane >> 5;
  float* Cs = (float*)ldsc;
#pragma unroll
  for (int i = 0; i < 2; ++i)
#pragma unroll
    for (int j = 0; j < 2; ++j)
#pragma unroll
      for (int g = 0; g < 4; ++g) {
        int m = wm * 64 + i * 32 + r;
        int n = wn * 64 + j * 32 + 8 * g + 4 * hh;
        float4 v; v.x = acc[i][j][4 * g]; v.y = acc[i][j][4 * g + 1]; v.z = acc[i][j][4 * g + 2]; v.w = acc[i][j][4 * g + 3];
        *(float4*)(Cs + m * 132 + n) = v;
      }
  __syncthreads();
}

DI void read_row64(const char* ldsc, int row, int half, float (&v)[64]) {
  const float* Cs = (const float*)ldsc + row * 132 + half * 64;
#pragma unroll
  for (int j = 0; j < 16; ++j) {
    float4 t = *(const float4*)(Cs + j * 4);
    v[j * 4] = t.x; v[j * 4 + 1] = t.y; v[j * 4 + 2] = t.z; v[j * 4 + 3] = t.w;
  }
}

DI void store_row64_bf16(u16* dst, const float (&v)[64]) {
#pragma unroll
  for (int j = 0; j < 8; ++j) {
    uint4 o;
    o.x = pack2(v[j * 8], v[j * 8 + 1]); o.y = pack2(v[j * 8 + 2], v[j * 8 + 3]);
    o.z = pack2(v[j * 8 + 4], v[j * 8 + 5]); o.w = pack2(v[j * 8 + 6], v[j * 8 + 7]);
    *(uint4*)(dst + j * 8) = o;
  }
}

DI bool tile_map(int i, int MT, int NT, int& mt, int& nt) {
  const int G = gridDim.x, bid = blockIdx.x;
  if ((G & 63) == 0 && (MT & 7) == 0 && (NT % (G >> 6)) == 0) {
    const int SH = G >> 6;
    const int xcd = bid & 7, slot = bid >> 3;
    const int sx = slot & 7, sy = slot >> 3;
    const int nsn = NT / SH, nsm = MT >> 3;
    const int st = i * 8 + xcd;
    if (st >= nsm * nsn) return false;
    mt = (st / nsn) * 8 + sx;
    nt = (st % nsn) * SH + sy;
    return true;
  }
  const int it = bid + i * G;
  if (it >= MT * NT) return false;
  mt = it / NT; nt = it % NT;
  return true;
}

DI void phase_gemm_in(const Params& p, int chunk, int l, char* lds, int probe = 0) {
  const int NB = p.NB, RL = NB * S, R = NB * (S + L);
  const int MT = R / 128, NT = 80;
  const int tid = otid();
  const u16* Wt = p.WinT + (size_t)l * INW * D;
  for (int ti = 0;; ++ti) {
    int mt, nt;
    if (!tile_map(ti, MT, NT, mt, nt)) break;
    const int m0 = mt * 128, n0 = nt * 128;
    f32x16 acc[2][2];
    if (probe == 2) gemm_core<true>(p.Hb, 64, 8192, Wt, 64, 8192, D, lds, acc);
    else gemm_core<true>(p.Hb + (size_t)m0 * D, 64, 8192, Wt + (size_t)n0 * D, 64, 8192, D, lds, acc);
    if (probe) {
      if (acc[0][0][0] != acc[0][0][0] && acc[1][1][5] == 12345.f && acc[0][1][7] == 3.f && acc[1][0][9] == 7.f) p.U[tid] = 1;
      continue;
    }
    {
      int mode = -1; u16* dbase = nullptr; int dld = 0;
      if (nt < 8) { mode = 0; dbase = p.U + nt * 128; dld = D; }
      else if (nt < 16) { mode = 1; dbase = p.Z + (nt - 8) * 128; dld = 3072; }
      else if (nt >= 28 && nt < 36) { mode = 1; dbase = p.Z + 1024 + (nt - 28) * 128; dld = 3072; }
      else if (nt >= 48 && nt < 56) { mode = 1; dbase = p.Z + 2048 + (nt - 48) * 128; dld = 3072; }
      else if (nt >= 56) { mode = 2; dbase = p.Ms + (nt - 56) * 128; dld = 3072; }
      if (mode >= 0) {
        const int lane = tid & 63, w = tid >> 6, wm = w >> 1, wn = w & 1, r = lane & 31, hh = lane >> 5;
#pragma unroll
        for (int i = 0; i < 2; ++i)
#pragma unroll
          for (int j = 0; j < 2; ++j)
#pragma unroll
            for (int g = 0; g < 4; ++g) {
              float v0 = acc[i][j][4 * g], v1 = acc[i][j][4 * g + 1], v2 = acc[i][j][4 * g + 2], v3 = acc[i][j][4 * g + 3];
              if (mode == 1) { v0 = siluf_(v0); v1 = siluf_(v1); v2 = siluf_(v2); v3 = siluf_(v3); }
              else if (mode == 2) { v0 = sigmoidf_(v0); v1 = sigmoidf_(v1); v2 = sigmoidf_(v2); v3 = sigmoidf_(v3); }
              uint2 o; o.x = pack2(v0, v1); o.y = pack2(v2, v3);
              const size_t row = (size_t)m0 + wm * 64 + i * 32 + r;
              const int col = wn * 64 + j * 32 + 8 * g + 4 * hh;
              *(uint2*)(dbase + row * dld + col) = o;
            }
        continue;
      }
    }
    stage_acc(lds, acc);
    const bool lat = m0 < RL;
    int b, t0;
    if (lat) { b = m0 / S; t0 = m0 % S; } else { int rc = m0 - RL; b = rc / L; t0 = rc % L; }
    const bool isV = (nt == 26 || nt == 27 || nt == 46 || nt == 47);
    if (isV) {
      int slot = (nt < 40) ? (nt - 26) : (2 + nt - 46);
      int d = tid >> 1, th = tid & 1;
      const float* Cs = (const float*)lds;
      float v[64];
#pragma unroll
      for (int j = 0; j < 64; ++j) v[j] = Cs[(th * 64 + j) * 132 + d];
      u16* dst = lat ? p.VtL + ((size_t)(b * 4 + slot) * 128 + d) * S + t0 + th * 64
                     : p.VtC + ((size_t)(b * 4 + slot) * 128 + d) * L + t0 + th * 64;
      store_row64_bf16(dst, v);
    } else {
      const int row = tid >> 1, half = tid & 1;
      const size_t gr = (size_t)m0 + row;
      const int t = t0 + row;
      float v[64];
      read_row64(lds, row, half, v);
      if (nt < 8) {
        store_row64_bf16(p.U + gr * D + nt * 128 + half * 64, v);
      } else if (nt < 16 || (nt >= 28 && nt < 36) || (nt >= 48 && nt < 56)) {
        int zc = (nt < 16) ? (nt - 8) * 128 : (nt < 36 ? 1024 + (nt - 28) * 128 : 2048 + (nt - 48) * 128);
#pragma unroll
        for (int j = 0; j < 64; ++j) v[j] = siluf_(v[j]);
        store_row64_bf16(p.Z + gr * 3072 + zc + half * 64, v);
      } else if (nt >= 56) {
#pragma unroll
        for (int j = 0; j < 64; ++j) v[j] = sigmoidf_(v[j]);
        store_row64_bf16(p.Ms + gr * 3072 + (nt - 56) * 128 + half * 64, v);
      } else {
        const bool isC = nt >= 36;
        const bool isQ = (nt >= 16 && nt < 24) || (nt >= 36 && nt < 44);
        if (isC) {
          const float* gn = (isQ ? p.q_norm_g : p.k_norm_g) + l * 128 + half * 64;
          float ss = 0.f;
#pragma unroll
          for (int j = 0; j < 64; ++j) ss += v[j] * v[j];
          ss += __shfl_xor(ss, 1);
          float rstd = rsqrtf(ss * (1.f / 128.f) + EPS);
#pragma unroll
          for (int j = 0; j < 64; ++j) v[j] = v[j] * rstd * gn[j];
        }
        if (lat) {
          int pos = (half == 0) ? (t >> 6) : (t & 63);
          const float* cs = p.rope + pos * 32;
          const float* sn = p.rope + 2048 + pos * 32;
#pragma unroll
          for (int j = 0; j < 32; ++j) {
            float c_ = cs[j], s_ = sn[j];
            float x0 = v[j], x1 = v[32 + j];
            v[j] = x0 * c_ - x1 * s_;
            v[32 + j] = x1 * c_ + x0 * s_;
          }
        }
        if (isQ) {
#pragma unroll
          for (int j = 0; j < 64; ++j) v[j] *= QSCALE;
          int qc = isC ? 1024 + (nt - 36) * 128 : (nt - 16) * 128;
          store_row64_bf16(p.Q + gr * 2048 + qc + half * 64, v);
        } else {
          int kc = isC ? 256 + (nt - 44) * 128 : (nt - 24) * 128;
          store_row64_bf16(p.Kb + gr * 512 + kc + half * 64, v);
        }
      }
    }
  }
}

struct AttnArgs {
  const u16* q;
  u16* z;
  const u16* kctx;
  const u16* vctx;
  const u16* klat;
  const u16* vlat;
  int n_lat_tiles;
  int lat_key0;
  int q_t0;
  int band;
  int has_sink;
  float sink_l2;
  int dry;
};

DI void attn_load_tile(const AttnArgs& a, int ti, u32x4 (&rk)[4], u32x4 (&rv)[4]) {
  const int tid = otid();
  const u16* kp; const u16* vp; int vs;
  if (ti < 4) { kp = a.kctx + (size_t)(ti * 64) * 512; vp = a.vctx + ti * 64; vs = L; }
  else { kp = a.klat + (size_t)((ti - 4) * 64) * 512; vp = a.vlat + (ti - 4) * 64; vs = S; }
#pragma unroll
  for (int i = 0; i < 4; ++i) {
    int c = tid + 256 * i;
    rk[i] = *(const u32x4*)(kp + (size_t)(c >> 4) * 512 + (c & 15) * 8);
    rv[i] = *(const u32x4*)(vp + (size_t)(c >> 3) * vs + (c & 7) * 8);
  }
}
DI void attn_store_tile(u16* sK, u16* sV, const u32x4 (&rk)[4], const u32x4 (&rv)[4]) {
  const int tid = otid();
#pragma unroll
  for (int i = 0; i < 4; ++i) {
    int c = tid + 256 * i;
    *(u32x4*)(sK + (c >> 4) * 136 + (c & 15) * 8) = rk[i];
    u16* vd = sV + (c >> 3) * 68 + (c & 7) * 8;
    { u32x2 t0 = {rv[i].x, rv[i].y}; *(u32x2*)(vd) = t0; }
    { u32x2 t1 = {rv[i].z, rv[i].w}; *(u32x2*)(vd + 4) = t1; }
  }
}

DI void attn_item(const AttnArgs& a, char* lds) {
  const int tid = otid(), lane = tid & 63, w = tid >> 6;
  const int r = lane & 31, hh = lane >> 5;
  u16* sKb = (u16*)lds;
  u16* sVb = sKb + 2 * 64 * 136;
  const int ntiles = 4 + a.n_lat_tiles;

  bf16x8 qf[8];
  {
    const u16* qp = a.q + (size_t)(w * 32 + r) * 2048 + hh * 8;
#pragma unroll
    for (int ks = 0; ks < 8; ++ks) qf[ks] = *(const bf16x8*)(qp + ks * 16);
  }
  f32x16 O[4];
#pragma unroll
  for (int dt = 0; dt < 4; ++dt)
#pragma unroll
    for (int x = 0; x < 16; ++x) O[dt][x] = 0.f;
  float m = a.has_sink ? a.sink_l2 : -1e30f;
  float lsum = (a.has_sink && hh == 0) ? 1.f : 0.f;

  u32x4 rk[4], rv[4];
  attn_load_tile(a, 0, rk, rv);
  __syncthreads();
  attn_store_tile(sKb, sVb, rk, rv);
  __syncthreads();
  const int qpos = a.q_t0 + w * 32 + r;

  for (int ti = 0; ti < ntiles; ++ti) {
    const int cur = ti & 1;
    if (ti + 1 < ntiles) attn_load_tile(a, ti + 1, rk, rv);
    const u16* sK = sKb + cur * 64 * 136;
    const u16* sV = sVb + cur * 128 * 68;
    f32x16 s[2];
#pragma unroll
    for (int kt2 = 0; kt2 < 2; ++kt2) {
#pragma unroll
      for (int x = 0; x < 16; ++x) s[kt2][x] = 0.f;
      const u16* kb = sK + (kt2 * 32 + r) * 136 + hh * 8;
#pragma unroll
      for (int ks = 0; ks < 8; ++ks) {
        bf16x8 ka = *(const bf16x8*)(kb + ks * 16);
        s[kt2] = MFMA32(ka, qf[ks], s[kt2]);
      }
    }
    if (a.band && ti >= 4) {
      const int k0 = a.lat_key0 + (ti - 4) * 64;
#pragma unroll
      for (int kt2 = 0; kt2 < 2; ++kt2)
#pragma unroll
        for (int x = 0; x < 16; ++x) {
          int kp = k0 + kt2 * 32 + crow(x, hh);
          int dlt = kp - qpos; dlt = dlt < 0 ? -dlt : dlt;
          if (dlt > 128) s[kt2][x] = -1e30f;
        }
    }
    float mx = s[0][0];
#pragma unroll
    for (int kt2 = 0; kt2 < 2; ++kt2)
#pragma unroll
      for (int x = 0; x < 16; ++x) mx = fmaxf(mx, s[kt2][x]);
    mx = fmaxf(mx, __shfl_xor(mx, 32));
    if (__any(mx > m + 8.f)) {
      const float mnew = fmaxf(m, mx);
      const float alpha = __builtin_amdgcn_exp2f(m - mnew);
      m = mnew;
      lsum *= alpha;
#pragma unroll
      for (int dt = 0; dt < 4; ++dt)
#pragma unroll
        for (int x = 0; x < 16; ++x) O[dt][x] *= alpha;
    }
    float ps = 0.f;
#pragma unroll
    for (int kt2 = 0; kt2 < 2; ++kt2)
#pragma unroll
      for (int x = 0; x < 16; ++x) { float pv = __builtin_amdgcn_exp2f(s[kt2][x] - m); s[kt2][x] = pv; ps += pv; }
    lsum += ps;
#pragma unroll
    for (int kt2 = 0; kt2 < 2; ++kt2)
#pragma unroll
      for (int s2 = 0; s2 < 2; ++s2) {
        union { unsigned u[4]; bf16x8 v; } pf;
#pragma unroll
        for (int j = 0; j < 4; ++j) pf.u[j] = pack2(s[kt2][8 * s2 + 2 * j], s[kt2][8 * s2 + 2 * j + 1]);
        const u16* vb = sV + r * 68 + kt2 * 32 + 16 * s2 + 4 * hh;
#pragma unroll
        for (int dt = 0; dt < 4; ++dt) {
          s16x4 lo = *(const s16x4*)(vb + dt * 32 * 68);
          s16x4 hi = *(const s16x4*)(vb + dt * 32 * 68 + 8);
          bf16x8 va = __builtin_shufflevector(lo, hi, 0, 1, 2, 3, 4, 5, 6, 7);
          O[dt] = MFMA32(va, pf.v, O[dt]);
        }
      }
    if (ti + 1 < ntiles) attn_store_tile(sKb + (cur ^ 1) * 64 * 136, sVb + (cur ^ 1) * 128 * 68, rk, rv);
    __syncthreads();
  }
  float ltot = lsum + __shfl_xor(lsum, 32);
  const float inv = 1.f / ltot;
  u16* zp = a.z + (size_t)(w * 32 + r) * 3072;
  u32x2 gv[4][4];
#pragma unroll
  for (int dt = 0; dt < 4; ++dt)
#pragma unroll
    for (int g4 = 0; g4 < 4; ++g4) gv[dt][g4] = *(const u32x2*)(zp + dt * 32 + 8 * g4 + 4 * hh);
#pragma unroll
  for (int dt = 0; dt < 4; ++dt)
#pragma unroll
    for (int g4 = 0; g4 < 4; ++g4) {
      int d0 = dt * 32 + 8 * g4 + 4 * hh;
      float y0 = O[dt][4 * g4 + 0] * inv * bflo(gv[dt][g4].x);
      float y1 = O[dt][4 * g4 + 1] * inv * bfhi(gv[dt][g4].x);
      float y2 = O[dt][4 * g4 + 2] * inv * bflo(gv[dt][g4].y);
      float y3 = O[dt][4 * g4 + 3] * inv * bfhi(gv[dt][g4].y);
      uint2 o; o.x = pack2(y0, y1); o.y = pack2(y2, y3);
      if (!a.dry || y0 != y0) *(uint2*)(zp + d0) = o;
    }
}

template <bool REV>
DI void lru_scan(float (&av)[2][16], float (&bv)[2][16], float& carry, int hh) {
  float segA[8], segB[8];
#pragma unroll
  for (int k = 0; k < 8; ++k) {
    const int mt = k >> 2, q = k & 3;
    float cA = 1.f, hl = 0.f;
#pragma unroll
    for (int jj = 0; jj < 4; ++jj) {
      const int j = REV ? 3 - jj : jj;
      const int i = 4 * q + j;
      hl = av[mt][i] * hl + bv[mt][i];
      cA *= av[mt][i];
      av[mt][i] = cA; bv[mt][i] = hl;
    }
    segA[k] = cA; segB[k] = hl;
  }
  float oA[8], oB[8];
#pragma unroll
  for (int k = 0; k < 8; ++k) { oA[k] = __shfl_xor(segA[k], 32); oB[k] = __shfl_xor(segB[k], 32); }
  float init[8];
  float st = carry;
#pragma unroll
  for (int kk = 0; kk < 8; ++kk) {
    const int k = REV ? 7 - kk : kk;
    const int first = REV ? 1 : 0;
    float A1 = (hh == first) ? segA[k] : oA[k];
    float B1 = (hh == first) ? segB[k] : oB[k];
    float st0 = st;
    st = A1 * st + B1;
    float A2 = (hh == first) ? oA[k] : segA[k];
    float B2 = (hh == first) ? oB[k] : segB[k];
    float st1 = st;
    st = A2 * st + B2;
    init[k] = (hh == first) ? st0 : st1;
  }
  carry = st;
#pragma unroll
  for (int k = 0; k < 8; ++k) {
    const int mt = k >> 2, q = k & 3;
#pragma unroll
    for (int j = 0; j < 4; ++j) {
      const int i = 4 * q + j;
      bv[mt][i] = bv[mt][i] + av[mt][i] * init[k];
    }
  }
}

DI void lru_item(const Params& p, int l, int b, int n, bool last, char* lds, int dry = 0) {
  const int NB = p.NB, RL = NB * S;
  const int tid = otid(), lane = tid & 63, w = tid >> 6;
  const int dir = w >> 1, w2 = w & 1;
  const int tl = tid & 127;
  const int r = lane & 31, hh = lane >> 5;
  u16* sRaw = (u16*)lds + dir * (8704 / 2);
  u16* sUp = (u16*)(lds + 17408) + dir * (9216 / 2);
  float* sH = (float*)(lds + 35840) + w * (64 * 36);

  const int chb = n * 64;
  const int cp = (tl & 31) * 2, tg = tl >> 5;
  float cw0[4], cw1[4], cb0, cb1;
#pragma unroll
  for (int k = 0; k < 4; ++k) {
    cw0[k] = p.conv_w[((size_t)l * 4 + k) * D + chb + cp];
    cw1[k] = p.conv_w[((size_t)l * 4 + k) * D + chb + cp + 1];
  }
  cb0 = p.conv_b[l * D + chb + cp]; cb1 = p.conv_b[l * D + chb + cp + 1];
  bf16x8 waf[4], wxf[4];
  {
    const float* wa = p.lru_wa + (((size_t)(l * 2 + dir) * 16 + n) * 64) * 64;
    const float* wx = p.lru_wx + (((size_t)(l * 2 + dir) * 16 + n) * 64) * 64;
    const int e = 32 * w2 + r;
#pragma unroll
    for (int ks = 0; ks < 4; ++ks) {
      union { unsigned u[4]; bf16x8 v; } fa, fx;
#pragma unroll
      for (int j = 0; j < 4; ++j) {
        int d0 = ks * 16 + 8 * hh + 2 * j;
        fa.u[j] = pack2(wa[d0 * 64 + e], wa[(d0 + 1) * 64 + e]);
        fx.u[j] = pack2(wx[d0 * 64 + e], wx[(d0 + 1) * 64 + e]);
      }
      waf[ks] = fa.v; wxf[ks] = fx.v;
    }
  }
  const int che = chb + 32 * w2 + r;
  const float ba = p.lru_ba[(l * 2 + dir) * D + che];
  const float bx = p.lru_bx[(l * 2 + dir) * D + che];
  float c8sp;
  {
    float lam = p.lru_lambda[(l * 2 + dir) * D + che];
    float sp = (lam < -20.f) ? -lam : log1pf(expf(-lam));
    c8sp = 8.f * sp;
  }
  float carry = 0.f;

  auto step_tile = [&](int st, bool& isctx, int& tt) {
    if (dir == 0) { if (st < 4) { isctx = true; tt = st; } else { isctx = false; tt = st - 4; } }
    else { if (st < 4) { isctx = true; tt = 3 - st; } else { isctx = false; tt = 63 - (st - 4); } }
  };
  u32x4 pre[5];
  auto load_raw = [&](int st) {
    bool isctx; int tt; step_tile(st, isctx, tt);
    const int seqlen = isctx ? L : S;
    const size_t rowbase = isctx ? (size_t)RL + (size_t)b * L : (size_t)b * S;
    const int t0 = tt * 64;
#pragma unroll
    for (int i = 0; i < 5; ++i) {
      int c = tl + 128 * i;
      int rr = c >> 3, c16 = c & 7;
      int t = t0 - 2 + rr;
      u32x4 v = {0u, 0u, 0u, 0u};
      if (rr < 67 && t >= 0 && t < seqlen) v = *(const u32x4*)(p.U + (rowbase + t) * D + chb + c16 * 8);
      pre[i] = v;
    }
  };
  load_raw(0);
  __syncthreads();
  for (int st = 0; st < 68; ++st) {
    bool isctx; int tt; step_tile(st, isctx, tt);
    const size_t rowbase = isctx ? (size_t)RL + (size_t)b * L : (size_t)b * S;
    const int t0 = tt * 64;
#pragma unroll
    for (int i = 0; i < 5; ++i) {
      int c = tl + 128 * i;
      int rr = c >> 3, c16 = c & 7;
      if (rr < 67) *(u32x4*)(sRaw + rr * 64 + c16 * 8) = pre[i];
    }
    if (st + 1 < 68) load_raw(st + 1);
    __syncthreads();
    {
      const u16* rp = sRaw + (tg * 16) * 64 + cp;
      unsigned r0 = *(const unsigned*)(rp), r1 = *(const unsigned*)(rp + 64), r2 = *(const unsigned*)(rp + 128);
#pragma unroll
      for (int i = 0; i < 16; ++i) {
        unsigned r3 = *(const unsigned*)(rp + (i + 3) * 64);
        float o0 = cb0 + cw0[0] * bflo(r0) + cw0[1] * bflo(r1) + cw0[2] * bflo(r2) + cw0[3] * bflo(r3);
        float o1 = cb1 + cw1[0] * bfhi(r0) + cw1[1] * bfhi(r1) + cw1[2] * bfhi(r2) + cw1[3] * bfhi(r3);
        *(unsigned*)(sUp + (tg * 16 + i) * 72 + cp) = pack2(o0, o1);
        r0 = r1; r1 = r2; r2 = r3;
      }
    }
    __syncthreads();
    const bool fwd_first = isctx ? (tt <= 1) : (tt <= 31);
    const bool first = (dir == 0) ? fwd_first : !fwd_first;
    unsigned long long pt0[4], pt1[4];
    u32x4 pg[4];
    if (!first && !(isctx && last)) {
#pragma unroll
      for (int j = 0; j < 4; ++j) {
        const int q = lane + 64 * j;
        const int tok = q >> 2, cc = (q & 3) * 8;
        const size_t row = rowbase + t0 + tok;
        const int col = chb + 32 * w2 + cc;
        const u16* tp = p.Hb + row * D + col;
        pt0[j] = __hip_atomic_load((const unsigned long long*)tp, __ATOMIC_RELAXED, __HIP_MEMORY_SCOPE_AGENT);
        pt1[j] = __hip_atomic_load((const unsigned long long*)tp + 1, __ATOMIC_RELAXED, __HIP_MEMORY_SCOPE_AGENT);
        pg[j] = *(const u32x4*)(p.Z + row * 3072 + col);
      }
    } else {
#pragma unroll
      for (int j = 0; j < 4; ++j) { pt0[j] = 0; pt1[j] = 0; pg[j] = u32x4{0u, 0u, 0u, 0u}; }
    }
    float av[2][16], bv[2][16];
    {
      f32x16 aR[2];
#pragma unroll
      for (int mt = 0; mt < 2; ++mt) {
#pragma unroll
        for (int x = 0; x < 16; ++x) aR[mt][x] = 0.f;
        const u16* ub = sUp + (mt * 32 + r) * 72 + hh * 8;
#pragma unroll
        for (int ks = 0; ks < 4; ++ks) aR[mt] = MFMA32(*(const bf16x8*)(ub + ks * 16), waf[ks], aR[mt]);
      }
#pragma unroll
      for (int mt = 0; mt < 2; ++mt)
#pragma unroll
        for (int x = 0; x < 16; ++x) {
          const float rg = sigmoidf_(aR[mt][x] + ba);
          av[mt][x] = -c8sp * rg;
        }
    }
    {
      f32x16 aI[2];
#pragma unroll
      for (int mt = 0; mt < 2; ++mt) {
#pragma unroll
        for (int x = 0; x < 16; ++x) aI[mt][x] = 0.f;
        const u16* ub = sUp + (mt * 32 + r) * 72 + hh * 8;
#pragma unroll
        for (int ks = 0; ks < 4; ++ks) aI[mt] = MFMA32(*(const bf16x8*)(ub + ks * 16), wxf[ks], aI[mt]);
      }
#pragma unroll
      for (int mt = 0; mt < 2; ++mt)
#pragma unroll
        for (int x = 0; x < 16; ++x) {
          const int tok = mt * 32 + crow(x, hh);
          const float up = bf2f(sUp[tok * 72 + 32 * w2 + r]);
          const float ig = sigmoidf_(aI[mt][x] + bx);
          const float la = av[mt][x];
          const float a_ = __expf(la);
          const float om = fmaxf(1.f - a_ * a_, 0.f);
          av[mt][x] = a_;
          bv[mt][x] = __builtin_amdgcn_sqrtf(om) * (ig * up);
        }
    }
    if (dir == 0) lru_scan<false>(av, bv, carry, hh); else lru_scan<true>(av, bv, carry, hh);
#pragma unroll
    for (int mt = 0; mt < 2; ++mt)
#pragma unroll
      for (int x = 0; x < 16; ++x) sH[(mt * 32 + crow(x, hh)) * 36 + r] = bv[mt][x];
    if (!(isctx && last)) {
#pragma unroll
      for (int j = 0; j < 4; ++j) {
        const int q = lane + 64 * j;
        const int tok = q >> 2, cc = (q & 3) * 8;
        const float4 h0 = *(const float4*)(sH + tok * 36 + cc);
        const float4 h1 = *(const float4*)(sH + tok * 36 + cc + 4);
        const size_t row = rowbase + t0 + tok;
        const int col = chb + 32 * w2 + cc;
        u16* tp = p.Hb + row * D + col;
        if (first) {
          uint4 o; o.x = pack2(h0.x, h0.y); o.y = pack2(h0.z, h0.w); o.z = pack2(h1.x, h1.y); o.w = pack2(h1.z, h1.w);
          if (!dry || h0.x != h0.x) *(uint4*)tp = o;
        } else {
          unsigned tx = (unsigned)pt0[j], ty = (unsigned)(pt0[j] >> 32), tz = (unsigned)pt1[j], tw = (unsigned)(pt1[j] >> 32);
          u16* zp = p.Z + row * 3072 + col;
          u32x4 g = pg[j];
          uint4 o;
          o.x = pack2((h0.x + bflo(tx)) * bflo(g.x), (h0.y + bfhi(tx)) * bfhi(g.x));
          o.y = pack2((h0.z + bflo(ty)) * bflo(g.y), (h0.w + bfhi(ty)) * bfhi(g.y));
          o.z = pack2((h1.x + bflo(tz)) * bflo(g.z), (h1.y + bfhi(tz)) * bfhi(g.z));
          o.w = pack2((h1.z + bflo(tw)) * bflo(g.w), (h1.w + bfhi(tw)) * bfhi(g.w));
          if (!dry || h0.x != h0.x) *(uint4*)zp = o;
        }
      }
    }
    __builtin_amdgcn_fence(__ATOMIC_RELEASE, "workgroup");
  }
}

DI void phase_mixers(const Params& p, int chunk, int l, char* lds, int dry = 0) {
  const int NB = p.NB, RL = NB * S;
  const bool last = (l == DEPTH - 1);
  const int nLRU = (dry == 1) ? 0 : NB * 16, nC = (dry == 2) ? 0 : NB * 8 * 32, nBw = (dry == 2) ? 0 : NB * 8 * 32, nCtx = (last || dry == 2) ? 0 : NB * 8 * 2 * 2;
  const int total = nLRU + nC + nBw + nCtx;
  int* ctr = p.ctr + chunk * DEPTH + l + (dry ? 32 : 0);
  if (dry == 2) __threadfence();
  int* s_item = (int*)(lds + LDS_BYTES - 16);
  int it;
  while (true) {
    __syncthreads();
    if (threadIdx.x == 0) *s_item = atomicAdd(ctr, 1);
    __syncthreads();
    it = __builtin_amdgcn_readfirstlane(*s_item);
    __syncthreads();
    if (it >= nLRU) break;
    lru_item(p, l, it >> 4, it & 15, last, lds, dry);
  }
  bool have = true;
  while (true) {
    if (!have) {
      __syncthreads();
      if (threadIdx.x == 0) *s_item = atomicAdd(ctr, 1);
      __syncthreads();
      it = __builtin_amdgcn_readfirstlane(*s_item);
      __syncthreads();
    }
    have = false;
    if (it >= total) break;
    it -= nLRU;
    AttnArgs a;
    a.dry = dry;
    if (it < nC + nBw) {
      const bool isB = it >= nC;
      if (isB) it -= nC;
      const int b = it >> 8, h = (it >> 5) & 7, qb = it & 31;
      const int kvh = h >> 2;
      const int br = isB ? 0 : 1;
      const size_t qrow0 = (size_t)b * S + qb * 128;
      a.q = p.Q + qrow0 * 2048 + br * 1024 + h * 128;
      a.z = p.Z + qrow0 * 3072 + (br + 1) * 1024 + h * 128;
      const int kcol = br * 256 + kvh * 128, slot = br * 2 + kvh;
      a.kctx = p.Kb + ((size_t)RL + (size_t)b * L) * 512 + kcol;
      a.vctx = p.VtC + (size_t)(b * 4 + slot) * 128 * L;
      int k0, k1;
      if (isB) { k0 = qb * 128 - 128; if (k0 < 0) k0 = 0; k1 = qb * 128 + 256; if (k1 > S) k1 = S; }
      else { k0 = 0; k1 = S; }
      a.lat_key0 = k0;
      a.n_lat_tiles = (k1 - k0) >> 6;
      a.klat = p.Kb + ((size_t)b * S + k0) * 512 + kcol;
      a.vlat = p.VtL + (size_t)(b * 4 + slot) * 128 * S + k0;
      a.q_t0 = qb * 128;
      a.band = isB ? 1 : 0;
      a.has_sink = isB ? 1 : 0;
      a.sink_l2 = isB ? p.attn_sink[l * 8 + h] * LOG2E : 0.f;
    } else {
      it -= nC + nBw;
      const int qb = it & 1, h = (it >> 1) & 7, br = (it >> 4) & 1, b = it >> 5;
      const int kvh = h >> 2;
      const size_t qrow0 = (size_t)RL + (size_t)b * L + qb * 128;
      a.q = p.Q + qrow0 * 2048 + br * 1024 + h * 128;
      a.z = p.Z + qrow0 * 3072 + (br + 1) * 1024 + h * 128;
      const int kcol = br * 256 + kvh * 128, slot = br * 2 + kvh;
      a.kctx = p.Kb + ((size_t)RL + (size_t)b * L) * 512 + kcol;
      a.vctx = p.VtC + (size_t)(b * 4 + slot) * 128 * L;
      a.klat = a.kctx; a.vlat = a.vctx;
      a.n_lat_tiles = 0; a.lat_key0 = 0; a.q_t0 = 0; a.band = 0;
      a.has_sink = (br == 0) ? 1 : 0;
      a.sink_l2 = (br == 0) ? p.attn_sink[l * 8 + h] * LOG2E : 0.f;
    }
    attn_item(a, lds);
  }
}

DI void phase_merge(const Params& p, int chunk, int l, char* lds) {
  const int NB = p.NB, RL = NB * S, R = NB * (S + L);
  const bool last = (l == DEPTH - 1);
  const int MT = (last ? RL : R) / 128, NT = 8;
  const int tid = otid();
  for (int ti = 0;; ++ti) {
    int mt, nt;
    if (!tile_map(ti, MT, NT, mt, nt)) break;
    const int m0 = mt * 128, n0 = nt * 128;
    const int lane = tid & 63, w = tid >> 6, wm = w >> 1, wn = w & 1, r = lane & 31, hh = lane >> 5;
    f32x16 tot[2][2];
#pragma unroll
    for (int i = 0; i < 2; ++i)
#pragma unroll
      for (int j = 0; j < 2; ++j)
#pragma unroll
        for (int x = 0; x < 16; ++x) tot[i][j][x] = 0.f;
#pragma unroll 1
    for (int n = 0; n < 3; ++n) {
      f32x16 acc[2][2];
      gemm_core<false>(p.Z + (size_t)m0 * 3072 + n * 1024, 3072, 64, p.WbT + ((size_t)(l * 3 + n) * D + n0) * D, 64, 8192, D, lds, acc);
#pragma unroll
      for (int i = 0; i < 2; ++i)
#pragma unroll
        for (int j = 0; j < 2; ++j)
#pragma unroll
          for (int g = 0; g < 4; ++g) {
            const size_t row = (size_t)m0 + wm * 64 + i * 32 + r;
            const int col = n0 + wn * 64 + j * 32 + 8 * g + 4 * hh;
            uint2 sv = *(const uint2*)(p.Ms + row * 3072 + n * 1024 + col);
            tot[i][j][4 * g + 0] += bflo(sv.x) * acc[i][j][4 * g + 0];
            tot[i][j][4 * g + 1] += bfhi(sv.x) * acc[i][j][4 * g + 1];
            tot[i][j][4 * g + 2] += bflo(sv.y) * acc[i][j][4 * g + 2];
            tot[i][j][4 * g + 3] += bfhi(sv.y) * acc[i][j][4 * g + 3];
          }
    }
#pragma unroll
    for (int i = 0; i < 2; ++i)
#pragma unroll
      for (int j = 0; j < 2; ++j)
#pragma unroll
        for (int g = 0; g < 4; ++g) {
          const size_t row = (size_t)m0 + wm * 64 + i * 32 + r;
          const int col = n0 + wn * 64 + j * 32 + 8 * g + 4 * hh;
          uint2 o; o.x = pack2(tot[i][j][4 * g], tot[i][j][4 * g + 1]); o.y = pack2(tot[i][j][4 * g + 2], tot[i][j][4 * g + 3]);
          *(uint2*)(p.Hb + ((row >> 7) * 16 + (col >> 6)) * 8192 + (row & 127) * 64 + (col & 63)) = o;
        }
  }
}

DI void phase_outproj(const Params& p, int chunk, int l, char* lds) {
  const int NB = p.NB, RL = NB * S, R = NB * (S + L);
  const bool last = (l == DEPTH - 1);
  const int MT = (last ? RL : R) / 128, NT = 8;
  const int tid = otid();
  for (int ti = 0;; ++ti) {
    int mt, nt;
    if (!tile_map(ti, MT, NT, mt, nt)) break;
    const int m0 = mt * 128, n0 = nt * 128;
    f32x16 acc[2][2];
    gemm_core<true>(p.Hb + (size_t)m0 * D, 64, 8192, p.WoT + ((size_t)l * D + n0) * D, 64, 8192, D, lds, acc);
    stage_acc(lds, acc);
    const int row = tid >> 1, half = tid & 1;
    const int gr = m0 + row;
    const float* src; float* dst; int mrow;
    if (gr < RL) {
      int b = gr / S, t = gr % S; int bg = chunk * NB + b;
      size_t off = ((size_t)bg * S + t) * D + n0 + half * 64;
      src = (l == 0 ? p.x : p.out) + off; dst = p.out + off; mrow = bg;
    } else {
      int rc = gr - RL; int b = rc / L, t = rc % L; int bg = chunk * NB + b;
      size_t off = ((size_t)bg * L + t) * D + n0 + half * 64;
      src = (l == 0 ? p.ctx : p.xc) + off; dst = p.xc + off; mrow = 16;
    }
    const float* gate = p.modv + ((size_t)l * 17 + mrow) * 3072 + 2048 + n0 + half * 64;
    const float* Cs = (const float*)lds + row * 132 + half * 64;
    float4 xv[16], gv[16];
#pragma unroll
    for (int j = 0; j < 16; ++j) { xv[j] = *(const float4*)(src + j * 4); gv[j] = *(const float4*)(gate + j * 4); }
#pragma unroll
    for (int j = 0; j < 16; ++j) {
      float4 cv = *(const float4*)(Cs + j * 4);
      float4 o;
      o.x = xv[j].x + gv[j].x * cv.x; o.y = xv[j].y + gv[j].y * cv.y; o.z = xv[j].z + gv[j].z * cv.z; o.w = xv[j].w + gv[j].w * cv.w;
      *(float4*)(dst + j * 4) = o;
    }
  }
}

DI void phase_final(const Params& p) {
  const int tid_ = otid();
  const int lane = tid_ & 63;
  const int wg = blockIdx.x * 4 + (tid_ >> 6), nw = gridDim.x * 4;
  for (int r = wg; r < NBATCH * S; r += nw) {
    float* src = p.out + (size_t)r * D;
    float4 v[4]; float ss = 0.f;
#pragma unroll
    for (int i = 0; i < 4; ++i) {
      v[i] = *(const float4*)(src + i * 256 + lane * 4);
      ss += v[i].x * v[i].x + v[i].y * v[i].y + v[i].z * v[i].z + v[i].w * v[i].w;
    }
#pragma unroll
    for (int o = 32; o >= 1; o >>= 1) ss += __shfl_xor(ss, o);
    float rstd = rsqrtf(ss * (1.f / D) + EPS);
#pragma unroll
    for (int i = 0; i < 4; ++i) {
      int cidx = i * 256 + lane * 4;
      float4 gg = *(const float4*)(p.final_g + cidx);
      float4 o;
      o.x = v[i].x * rstd * gg.x; o.y = v[i].y * rstd * gg.y; o.z = v[i].z * rstd * gg.z; o.w = v[i].w * rstd * gg.w;
      *(float4*)(src + cidx) = o;
    }
  }
}

#ifndef DUP_PHASE
#define DUP_PHASE 0
#endif
#ifndef PROBE_A
#define PROBE_A -1
#define PROBE_B -1
#endif
__global__ void __launch_bounds__(256, 2) fwd_megakernel(Params p) {
  cg::grid_group grid = cg::this_grid();
  __shared__ __attribute__((aligned(16))) char lds[LDS_BYTES];
#if PROBE_A >= 0
  long long tacc[8] = {0, 0, 0, 0, 0, 0, 0, 0};
  long long t0 = wall_clock64(), t1;
#define TICK(i) { t1 = wall_clock64(); tacc[i] += t1 - t0; t0 = t1; }
#else
#define TICK(i)
#endif
  phase0(p, lds);
  grid.sync();
  TICK(0)
  phase_mod(p, lds);
  grid.sync();
  TICK(1)
  for (int chunk = 0; chunk < p.nchunk; ++chunk) {
    for (int l = 0; l < DEPTH; ++l) {
      phase_prenorm(p, chunk, l);
      grid.sync();
      TICK(2)
      phase_gemm_in(p, chunk, l, lds);
      grid.sync();
      TICK(3)
#if DUP_PHASE == 3
      phase_gemm_in(p, chunk, l, lds);
      grid.sync();
#endif
#if DUP_PHASE == 31
      phase_gemm_in(p, chunk, l, lds, 1);
      grid.sync();
#endif
#if DUP_PHASE == 32
      phase_gemm_in(p, chunk, l, lds, 2);
      grid.sync();
#endif
#if DUP_PHASE == 4
      phase_mixers(p, chunk, l, lds, 1);
      grid.sync();
#endif
#if DUP_PHASE == 6
      phase_mixers(p, chunk, l, lds, 2);
      grid.sync();
#endif
      phase_mixers(p, chunk, l, lds);
      grid.sync();
      TICK(4)
      phase_merge(p, chunk, l, lds);
      grid.sync();
      TICK(5)
#if DUP_PHASE == 5
      phase_merge(p, chunk, l, lds);
      grid.sync();
#endif
      phase_outproj(p, chunk, l, lds);
      grid.sync();
      TICK(6)
    }
  }
  phase_final(p);
#if PROBE_A >= 0
  grid.sync();
  TICK(7)
  if (blockIdx.x == 0) {
    float A = (float)tacc[PROBE_A] * 0.01f;
    float B = (float)tacc[PROBE_B] * 0.001f;
    A = exp2f(rintf(log2f(A) * 8.f) * 0.125f);
    B = exp2f(rintf(log2f(B) * 8.f) * 0.125f);
    for (int i = threadIdx.x; i <= 1000000; i += 256) p.out[i] = (i == 0) ? A : B;
  }
#endif
}

extern "C" void kernel_launch(void* const* d_in, const int* in_sizes, int n_in,
                              void* d_out, int out_size, void* d_ws, size_t ws_size,
                              hipStream_t stream) {
  static int grid_blocks = 0;
  if (!grid_blocks) {
    int dev = 0, cus = 0, per_cu = 0;
    (void)hipGetDevice(&dev);
    (void)hipDeviceGetAttribute(&cus, hipDeviceAttributeMultiprocessorCount, dev);
    (void)hipOccupancyMaxActiveBlocksPerMultiprocessor(&per_cu, fwd_megakernel, 256, 0);
    if (per_cu > 2) per_cu = 2;
    if (per_cu < 1) per_cu = 1;
    grid_blocks = cus * per_cu;
  }
  Params p{};
  const float* const* in = (const float* const*)d_in;
  p.x = in[0]; p.c = in[1]; p.ctx = in[2]; p.c_ctx = in[3]; p.norm_g = in[4]; p.w_mod = in[5]; p.b_mod = in[6];
  p.w_in = in[7]; p.conv_w = in[8]; p.conv_b = in[9]; p.lru_wa = in[10]; p.lru_ba = in[11]; p.lru_wx = in[12];
  p.lru_bx = in[13]; p.lru_lambda = in[14]; p.attn_sink = in[15]; p.q_norm_g = in[16]; p.k_norm_g = in[17];
  p.w_branch = in[18]; p.w_out = in[19]; p.final_g = in[20];
  p.out = (float*)d_out;
  char* ws = (char*)d_ws;
  size_t off = 0;
  auto take = [&](size_t bytes) { char* r = ws + off; off += (bytes + 255) & ~(size_t)255; return r; };
  p.ctr = (int*)take(256);
  p.modv = (float*)take((size_t)DEPTH * 17 * 3072 * 4);
  p.sc = (float*)take((size_t)17 * D * 4);
  p.rope = (float*)take(4096 * 4);
  p.xc = (float*)take((size_t)NBATCH * L * D * 4);
  p.WinT = (u16*)take((size_t)DEPTH * INW * D * 2);
  p.WbT = (u16*)take((size_t)DEPTH * 3 * D * D * 2);
  p.WoT = (u16*)take((size_t)DEPTH * D * D * 2);
  const size_t fixed = off;
  int NB = 8;
  while (NB > 1) {
    size_t R = (size_t)NB * (S + L);
    size_t need = fixed + R * (size_t)(1024 + 1024 + 3072 + 2048 + 512 + 512 + 3072) * 2 + 8 * 256;
    if (need <= ws_size) break;
    NB >>= 1;
  }
  p.NB = NB; p.nchunk = NBATCH / NB;
  const size_t R = (size_t)NB * (S + L);
  p.Hb = (u16*)take(R * 1024 * 2);
  p.U = (u16*)take(R * 1024 * 2);
  p.Z = (u16*)take(R * 3072 * 2);
  p.Q = (u16*)take(R * 2048 * 2);
  p.Kb = (u16*)take(R * 512 * 2);
  p.VtL = (u16*)take((size_t)NB * 4 * 128 * S * 2);
  p.VtC = (u16*)take((size_t)NB * 4 * 128 * L * 2);
  p.Ms = (u16*)take(R * 3072 * 2);
  void* args[] = {&p};
  hipError_t e = hipLaunchCooperativeKernel((void*)fwd_megakernel, dim3(grid_blocks), dim3(256), args, 0, stream);
  if (e != hipSuccess) fprintf(stderr, "cooperative launch failed: %s (grid %d)\n", hipGetErrorString(e), grid_blocks);
}
```

```cpp
#include <hip/hip_runtime.h>
#include <hip/hip_cooperative_groups.h>
#include <cstdio>
#include <cstdint>
namespace cg = cooperative_groups;

typedef unsigned short u16;
typedef __attribute__((ext_vector_type(8))) short bf16x8;
typedef __attribute__((ext_vector_type(4))) short s16x4;
typedef __attribute__((ext_vector_type(16))) float f32x16;
typedef __bf16 bf16x2_t __attribute__((ext_vector_type(2)));
typedef float float2_t __attribute__((ext_vector_type(2)));
typedef __attribute__((ext_vector_type(4))) unsigned u32x4;
typedef __attribute__((ext_vector_type(2))) unsigned u32x2;

#define DI __device__ __forceinline__
#define MFMA32(a, b, c) __builtin_amdgcn_mfma_f32_32x32x16_bf16((a), (b), (c), 0, 0, 0)

constexpr int D = 1024, NBATCH = 16, S = 4096, L = 256, DEPTH = 4, INW = 10240;
constexpr int LDS_BYTES = 147456;
constexpr int NTHR = 512;
constexpr float EPS = 1e-6f;
constexpr float QSCALE = 0.08838834764831845f * 1.4426950408889634f;
constexpr float LOG2E = 1.4426950408889634f;

struct Params {
  const float *x, *c, *ctx, *c_ctx, *norm_g, *w_mod, *b_mod, *w_in, *conv_w, *conv_b, *lru_wa, *lru_ba, *lru_wx, *lru_bx,
      *lru_lambda, *attn_sink, *q_norm_g, *k_norm_g, *w_branch, *w_out, *final_g;
  float* out;
  u16 *WinT, *WbT, *WoT;
  u16 *Hb, *U, *Z, *Q, *Kb, *VtL, *VtC, *Ms;
  float *modv, *sc, *rope, *xc;
  int* ctr;
  int NB;
  int nchunk;
};

DI unsigned pack2(float a, float b) {
  float2_t f = {a, b};
  bf16x2_t v = __builtin_convertvector(f, bf16x2_t);
  return __builtin_bit_cast(unsigned, v);
}
DI float bf2f(u16 v) { return __uint_as_float(((unsigned)v) << 16); }
DI float bflo(unsigned v) { return __uint_as_float(v << 16); }
DI float bfhi(unsigned v) { return __uint_as_float(v & 0xffff0000u); }
DI float sigmoidf_(float x) { return __builtin_amdgcn_rcpf(1.f + __expf(-x)); }
DI float siluf_(float x) { return x * __builtin_amdgcn_rcpf(1.f + __expf(-x)); }
DI int otid() { int t = threadIdx.x; asm volatile("" : "+v"(t)); return t; }
DI int crow(int i, int hh) { return (i & 3) + 8 * (i >> 2) + 4 * hh; }

DI void phase0(const Params& p, char* lds) {
  const int tid = otid();
  float* tile = (float*)lds;
  const int n_in = DEPTH * 16 * 160, n_b = DEPTH * 3 * 256, n_o = DEPTH * 256;
  for (int it = blockIdx.x; it < n_in + n_b + n_o; it += gridDim.x) {
    const float* src; u16* dst; int ldsrc;
    if (it < n_in) {
      int l = it / 2560, rem = it % 2560, kt = rem / 160, nt = rem % 160;
      src = p.w_in + (size_t)l * D * INW + (size_t)(kt * 64) * INW + nt * 64; ldsrc = INW;
      dst = p.WinT + (size_t)l * INW * D + ((size_t)(nt >> 1) * 16 + kt) * 8192 + (nt & 1) * 4096;
    } else if (it < n_in + n_b) {
      int i2 = it - n_in; int mat = i2 / 256, rem = i2 % 256, kt = rem / 16, nt = rem % 16;
      src = p.w_branch + (size_t)mat * D * D + (size_t)(kt * 64) * D + nt * 64; ldsrc = D;
      dst = p.WbT + (size_t)mat * D * D + ((size_t)(nt >> 1) * 16 + kt) * 8192 + (nt & 1) * 4096;
    } else {
      int i2 = it - n_in - n_b; int mat = i2 / 256, rem = i2 % 256, kt = rem / 16, nt = rem % 16;
      src = p.w_out + (size_t)mat * D * D + (size_t)(kt * 64) * D + nt * 64; ldsrc = D;
      dst = p.WoT + (size_t)mat * D * D + ((size_t)(nt >> 1) * 16 + kt) * 8192 + (nt & 1) * 4096;
    }
    __syncthreads();
#pragma unroll
    for (int i = 0; i < 2; ++i) {
      int c = tid + NTHR * i; int row = c >> 4, c4 = c & 15;
      float4 v = *(const float4*)(src + (size_t)row * ldsrc + c4 * 4);
      float* t = tile + row * 65 + c4 * 4;
      t[0] = v.x; t[1] = v.y; t[2] = v.z; t[3] = v.w;
    }
    __syncthreads();
    {
      int c = tid; int nrow = c >> 3, k8 = c & 7;
      float v[8];
#pragma unroll
      for (int j = 0; j < 8; ++j) v[j] = tile[(k8 * 8 + j) * 65 + nrow];
      uint4 o; o.x = pack2(v[0], v[1]); o.y = pack2(v[2], v[3]); o.z = pack2(v[4], v[5]); o.w = pack2(v[6], v[7]);
      *(uint4*)(dst + (size_t)nrow * 64 + k8 * 8) = o;
    }
  }
  const int gt = blockIdx.x * NTHR + tid, gn = gridDim.x * NTHR;
  for (int i = gt; i < 17 * D; i += gn) {
    int r = i / D, k = i % D;
    float v = (r < 16) ? p.c[r * D + k] : p.c_ctx[k];
    p.sc[i] = siluf_(v);
  }
  for (int i = gt; i < 64 * 32; i += gn) {
    int pos = i >> 5, pp = i & 31;
    float inv = powf(10000.f, -(float)pp / 32.f);
    float ang = (float)pos * inv;
    p.rope[i] = cosf(ang);
    p.rope[2048 + i] = sinf(ang);
  }
  if (blockIdx.x == 0 && tid < 64) p.ctr[tid] = 0;
}

DI void phase_mod(const Params& p, char* lds) {
  const int tid = otid();
  float* red = (float*)lds;
  const int col = tid & 63, kg = tid >> 6;
  for (int it = blockIdx.x; it < DEPTH * 48; it += gridDim.x) {
    int l = it / 48, cb = it % 48;
    float acc[17];
#pragma unroll
    for (int r = 0; r < 17; ++r) acc[r] = 0.f;
    const float* w = p.w_mod + (size_t)l * D * 3072 + cb * 64 + col;
    for (int k = kg * 128; k < kg * 128 + 128; ++k) {
      float wv = w[(size_t)k * 3072];
#pragma unroll
      for (int r = 0; r < 17; ++r) acc[r] += p.sc[r * D + k] * wv;
    }
    __syncthreads();
#pragma unroll
    for (int r = 0; r < 17; ++r) red[(kg * 17 + r) * 64 + col] = acc[r];
    __syncthreads();
    for (int i = tid; i < 17 * 64; i += NTHR) {
      int r = i >> 6, cc = i & 63;
      float s = 0.f;
#pragma unroll
      for (int g = 0; g < 8; ++g) s += red[(g * 17 + r) * 64 + cc];
      p.modv[((size_t)l * 17 + r) * 3072 + cb * 64 + cc] = s + p.b_mod[l * 3072 + cb * 64 + cc];
    }
  }
}

DI void phase_prenorm(const Params& p, int chunk, int l) {
  const int NB = p.NB, RL = NB * S, R = NB * (S + L);
  const int tid_ = otid();
  const int lane = tid_ & 63;
  const int wg = blockIdx.x * 8 + (tid_ >> 6), nw = gridDim.x * 8;
  const float* g = p.norm_g + l * D;
  for (int r = wg; r < R; r += nw) {
    const float* src; int mrow;
    if (r < RL) {
      int b = r / S, t = r % S; int bg = chunk * NB + b;
      src = (l == 0 ? p.x : p.out) + ((size_t)bg * S + t) * D; mrow = bg;
    } else {
      int rc = r - RL; int b = rc / L, t = rc % L; int bg = chunk * NB + b;
      src = (l == 0 ? p.ctx : p.xc) + ((size_t)bg * L + t) * D; mrow = 16;
    }
    const float* mv = p.modv + ((size_t)l * 17 + mrow) * 3072;
    float4 v[4]; float ss = 0.f;
#pragma unroll
    for (int i = 0; i < 4; ++i) {
      v[i] = *(const float4*)(src + i * 256 + lane * 4);
      ss += v[i].x * v[i].x + v[i].y * v[i].y + v[i].z * v[i].z + v[i].w * v[i].w;
    }
#pragma unroll
    for (int o = 32; o >= 1; o >>= 1) ss += __shfl_xor(ss, o);
    float rstd = rsqrtf(ss * (1.f / D) + EPS);
#pragma unroll
    for (int i = 0; i < 4; ++i) {
      int cidx = i * 256 + lane * 4;
      float4 gg = *(const float4*)(g + cidx);
      float4 sh = *(const float4*)(mv + cidx);
      float4 scl = *(const float4*)(mv + 1024 + cidx);
      float h0 = v[i].x * rstd * gg.x * (1.f + scl.x) + sh.x;
      float h1 = v[i].y * rstd * gg.y * (1.f + scl.y) + sh.y;
      float h2 = v[i].z * rstd * gg.z * (1.f + scl.z) + sh.z;
      float h3 = v[i].w * rstd * gg.w * (1.f + scl.w) + sh.w;
      uint2 o; o.x = pack2(h0, h1); o.y = pack2(h2, h3);
      *(uint2*)(p.Hb + ((size_t)(r >> 7) * 16 + (cidx >> 6)) * 8192 + (r & 127) * 64 + (cidx & 63)) = o;
    }
  }
}

template <int BN, bool PIPE>
DI void gemm_core(const u16* A, int lda, int ksa, size_t a_blk, const u16* Bt, int ldb, int ksb, size_t b_blk, int K, char* ldsc,
                  f32x16 (&acc)[BN / 64][2]) {
  constexpr int MI = BN / 64;
  constexpr int SS = 32768 + BN * 128;
  const int tid = otid(), lane = tid & 63, w = tid >> 6;
  const int wm = (BN == 256) ? (w >> 2) : (w >> 1), wn = (BN == 256) ? (w & 3) : (w & 1);
  const int r = lane & 31, hh = lane >> 5;
  const int drow = lane >> 3, dcp = lane & 7;
  const int chunk0 = dcp ^ (drow >> 1);
  const u16* gAe = A + (size_t)(w >> 2) * a_blk + (size_t)((w & 3) * 32 + drow) * lda + chunk0 * 8;
  const u16* gAo = gAe + (size_t)8 * lda + ((chunk0 ^ 4) - chunk0) * 8;
  const size_t a16 = (size_t)16 * lda;
  const int brow0 = (BN == 256) ? (w & 3) * 32 : w * 16;
  const u16* gBe = Bt + ((BN == 256) ? (size_t)(w >> 2) * b_blk : (size_t)0) + (size_t)(brow0 + drow) * ldb + chunk0 * 8;
  const u16* gBo = gBe + (size_t)8 * ldb + ((chunk0 ^ 4) - chunk0) * 8;
  const size_t b16 = (size_t)16 * ldb;
#pragma unroll
  for (int i = 0; i < MI; ++i)
#pragma unroll
    for (int j = 0; j < 2; ++j)
#pragma unroll
      for (int x = 0; x < 16; ++x) acc[i][j][x] = 0.f;
  auto DMA = [&](int kt, int stage) {
    char* sa = ldsc + stage * SS + (w * 4) * 1024;
    char* sb = ldsc + stage * SS + 32768 + ((BN == 256) ? (w * 4) : (w * 2)) * 1024;
    const size_t ka = (size_t)kt * ksa, kb = (size_t)kt * ksb;
    __builtin_amdgcn_global_load_lds((const unsigned*)(gAe + ka), (unsigned*)(sa), 16, 0, 0);
    __builtin_amdgcn_global_load_lds((const unsigned*)(gBe + kb), (unsigned*)(sb), 16, 0, 0);
    __builtin_amdgcn_global_load_lds((const unsigned*)(gAo + ka), (unsigned*)(sa + 1024), 16, 0, 0);
    __builtin_amdgcn_global_load_lds((const unsigned*)(gBo + kb), (unsigned*)(sb + 1024), 16, 0, 0);
    __builtin_amdgcn_global_load_lds((const unsigned*)(gAe + a16 + ka), (unsigned*)(sa + 2048), 16, 0, 0);
    __builtin_amdgcn_global_load_lds((const unsigned*)(gAo + a16 + ka), (unsigned*)(sa + 3072), 16, 0, 0);
    if (BN == 256) {
      __builtin_amdgcn_global_load_lds((const unsigned*)(gBe + b16 + kb), (unsigned*)(sb + 2048), 16, 0, 0);
      __builtin_amdgcn_global_load_lds((const unsigned*)(gBo + b16 + kb), (unsigned*)(sb + 3072), 16, 0, 0);
    }
  };
  const int sw = (r >> 1) & 7;
  int koff[4];
#pragma unroll
  for (int ks = 0; ks < 4; ++ks) koff[ks] = ((2 * ks + hh) ^ sw) << 4;
  auto COMPUTE = [&](int stage) {
    const char* ab = ldsc + stage * SS + (wm * (MI * 32) + r) * 128;
    const char* bb = ldsc + stage * SS + 32768 + (wn * 64 + r) * 128;
    bf16x8 fa[2][MI], fb[2][2];
    auto LDF = [&](int ks, int slot) {
#pragma unroll
      for (int i = 0; i < MI; ++i) fa[slot][i] = *(const bf16x8*)(ab + i * 32 * 128 + koff[ks]);
#pragma unroll
      for (int j = 0; j < 2; ++j) fb[slot][j] = *(const bf16x8*)(bb + j * 32 * 128 + koff[ks]);
    };
    auto MM = [&](int slot) {
#pragma unroll
      for (int i = 0; i < MI; ++i)
#pragma unroll
        for (int j = 0; j < 2; ++j) acc[i][j] = MFMA32(fb[slot][j], fa[slot][i], acc[i][j]);
    };
    if (!PIPE) {
#pragma unroll
      for (int ks = 0; ks < 4; ++ks) { LDF(ks, 0); MM(0); }
      return;
    }
    LDF(0, 0); LDF(1, 1);
    __builtin_amdgcn_sched_barrier(0);
    MM(0); LDF(2, 0);
    __builtin_amdgcn_sched_barrier(0);
    MM(1); LDF(3, 1);
    __builtin_amdgcn_sched_barrier(0);
    MM(0); MM(1);
  };
  const int KT = K >> 6;
  __syncthreads();
  DMA(0, 0);
  __syncthreads();
  for (int kt = 0; kt < KT; kt += 2) {
    DMA(kt + 1, 1);
    COMPUTE(0);
    __syncthreads();
    if (kt + 2 < KT) DMA(kt + 2, 0);
    COMPUTE(1);
    __syncthreads();
  }
}

template <int MI>
DI void stage_acc(char* ldsc, f32x16 (&acc)[MI][2], int wm, int ncol0, bool active) {
  const int tid = otid(), lane = tid & 63;
  const int r = lane & 31, hh = lane >> 5;
  float* Cs = (float*)ldsc;
  if (active) {
#pragma unroll
    for (int i = 0; i < MI; ++i)
#pragma unroll
      for (int j = 0; j < 2; ++j)
#pragma unroll
        for (int g = 0; g < 4; ++g) {
          int m = wm * (MI * 32) + i * 32 + r;
          int n = ncol0 + j * 32 + 8 * g + 4 * hh;
          float4 v; v.x = acc[i][j][4 * g]; v.y = acc[i][j][4 * g + 1]; v.z = acc[i][j][4 * g + 2]; v.w = acc[i][j][4 * g + 3];
          *(float4*)(Cs + m * 132 + n) = v;
        }
  }
  __syncthreads();
}

DI void read_row64(const char* ldsc, int row, int half, float (&v)[64]) {
  const float* Cs = (const float*)ldsc + row * 132 + half * 64;
#pragma unroll
  for (int j = 0; j < 16; ++j) {
    float4 t = *(const float4*)(Cs + j * 4);
    v[j * 4] = t.x; v[j * 4 + 1] = t.y; v[j * 4 + 2] = t.z; v[j * 4 + 3] = t.w;
  }
}

DI void store_row64_bf16(u16* dst, const float (&v)[64]) {
#pragma unroll
  for (int j = 0; j < 8; ++j) {
    uint4 o;
    o.x = pack2(v[j * 8], v[j * 8 + 1]); o.y = pack2(v[j * 8 + 2], v[j * 8 + 3]);
    o.z = pack2(v[j * 8 + 4], v[j * 8 + 5]); o.w = pack2(v[j * 8 + 6], v[j * 8 + 7]);
    *(uint4*)(dst + j * 8) = o;
  }
}

DI bool tile_map(int i, int MT, int NT, int& mt, int& nt) {
  const int G = gridDim.x, bid = blockIdx.x;
  if ((G & 63) == 0 && (MT & 7) == 0 && (NT % (G >> 6)) == 0) {
    const int SH = G >> 6;
    const int xcd = bid & 7, slot = bid >> 3;
    const int sx = slot & 7, sy = slot >> 3;
    const int nsn = NT / SH, nsm = MT >> 3;
    const int st = i * 8 + xcd;
    if (st >= nsm * nsn) return false;
    mt = (st / nsn) * 8 + sx;
    nt = (st % nsn) * SH + sy;
    return true;
  }
  const int it = bid + i * G;
  if (it >= MT * NT) return false;
  mt = it / NT; nt = it % NT;
  return true;
}

DI void phase_gemm_in(const Params& p, int chunk, int l, char* lds) {
  const int NB = p.NB, RL = NB * S, R = NB * (S + L);
  const int MT = R / 256, NT = 40;
  const int tid = otid();
  const int lane = tid & 63, w = tid >> 6, wm = w >> 2, wn = w & 3, r = lane & 31, hh = lane >> 5;
  const u16* Wt = p.WinT + (size_t)l * INW * D;
  for (int ti = 0;; ++ti) {
    int mt, nt;
    if (!tile_map(ti, MT, NT, mt, nt)) break;
    const int m0 = mt * 256, n0 = nt * 256;
    f32x16 acc[4][2];
    gemm_core<256, false>(p.Hb + (size_t)m0 * D, 64, 8192, 131072, Wt + (size_t)n0 * D, 64, 8192, 131072, D, lds, acc);
    {
      int mode = -1; u16* dbase = nullptr; int dld = 0;
      if (nt < 4) { mode = 0; dbase = p.U + nt * 256; dld = D; }
      else if (nt < 8) { mode = 1; dbase = p.Z + (nt - 4) * 256; dld = 3072; }
      else if (nt >= 14 && nt < 18) { mode = 1; dbase = p.Z + 1024 + (nt - 14) * 256; dld = 3072; }
      else if (nt >= 24 && nt < 28) { mode = 1; dbase = p.Z + 2048 + (nt - 24) * 256; dld = 3072; }
      else if (nt >= 28) { mode = 2; dbase = p.Ms + (nt - 28) * 256; dld = 3072; }
      if (mode >= 0) {
#pragma unroll
        for (int i = 0; i < 4; ++i)
#pragma unroll
          for (int j = 0; j < 2; ++j)
#pragma unroll
            for (int g = 0; g < 4; ++g) {
              float v0 = acc[i][j][4 * g], v1 = acc[i][j][4 * g + 1], v2 = acc[i][j][4 * g + 2], v3 = acc[i][j][4 * g + 3];
              if (mode == 1) { v0 = siluf_(v0); v1 = siluf_(v1); v2 = siluf_(v2); v3 = siluf_(v3); }
              else if (mode == 2) { v0 = sigmoidf_(v0); v1 = sigmoidf_(v1); v2 = sigmoidf_(v2); v3 = sigmoidf_(v3); }
              uint2 o; o.x = pack2(v0, v1); o.y = pack2(v2, v3);
              const size_t row = (size_t)m0 + wm * 128 + i * 32 + r;
              const int col = wn * 64 + j * 32 + 8 * g + 4 * hh;
              *(uint2*)(dbase + row * dld + col) = o;
            }
        continue;
      }
    }
    const bool lat = m0 < RL;
    int b, t0;
    if (lat) { b = m0 / S; t0 = m0 % S; } else { int rc = m0 - RL; b = rc / L; t0 = rc % L; }
    const bool isV = (nt == 13 || nt == 23);
    const bool isC = nt >= 18;
    const bool isQ = (nt >= 8 && nt < 12) || (nt >= 18 && nt < 22);
    auto process_unit = [&](int hsel, int u) {
      if (isV) {
        const int slot = (isC ? 2 : 0) + hsel;
        const int d = u >> 2, tq = u & 3;
        const float* Cs = (const float*)lds;
        u16* dst = lat ? p.VtL + ((size_t)(b * 4 + slot) * 128 + d) * S + t0 + tq * 64
                       : p.VtC + ((size_t)(b * 4 + slot) * 128 + d) * L + t0 + tq * 64;
#pragma unroll 1
        for (int c = 0; c < 4; ++c) {
          float v[16];
#pragma unroll
          for (int j = 0; j < 16; ++j) v[j] = Cs[(tq * 64 + c * 16 + j) * 132 + d];
          uint4 o0, o1;
          o0.x = pack2(v[0], v[1]); o0.y = pack2(v[2], v[3]); o0.z = pack2(v[4], v[5]); o0.w = pack2(v[6], v[7]);
          o1.x = pack2(v[8], v[9]); o1.y = pack2(v[10], v[11]); o1.z = pack2(v[12], v[13]); o1.w = pack2(v[14], v[15]);
          *(uint4*)(dst + c * 16) = o0;
          *(uint4*)(dst + c * 16 + 8) = o1;
        }
      } else {
        const int row = u >> 1, half = u & 1;
        const size_t gr = (size_t)m0 + row;
        const int t = t0 + row;
        const float* Cr = (const float*)lds + row * 132 + half * 64;
        float rstd = 1.f;
        const float* gn = (isQ ? p.q_norm_g : p.k_norm_g) + l * 128 + half * 64;
        if (isC) {
          float ss = 0.f;
#pragma unroll
          for (int j = 0; j < 16; ++j) {
            float4 tv = *(const float4*)(Cr + j * 4);
            ss += tv.x * tv.x + tv.y * tv.y + tv.z * tv.z + tv.w * tv.w;
          }
          ss += __shfl_xor(ss, 1);
          rstd = rsqrtf(ss * (1.f / 128.f) + EPS);
        }
        const int pos = (half == 0) ? (t >> 6) : (t & 63);
        const float* cs = p.rope + pos * 32;
        const float* sn = p.rope + 2048 + pos * 32;
        u16* dst;
        if (isQ) {
          const int head = (isC ? (nt - 18) : (nt - 8)) * 2 + hsel;
          dst = p.Q + gr * 2048 + (isC ? 1024 : 0) + head * 128 + half * 64;
        } else {
          dst = p.Kb + gr * 512 + (isC ? 256 : 0) + hsel * 128 + half * 64;
        }
#pragma unroll 1
        for (int c = 0; c < 2; ++c) {
          float x0[16], x1[16];
#pragma unroll
          for (int j = 0; j < 4; ++j) {
            float4 ta_ = *(const float4*)(Cr + c * 16 + j * 4);
            float4 tb_ = *(const float4*)(Cr + 32 + c * 16 + j * 4);
            x0[4 * j] = ta_.x; x0[4 * j + 1] = ta_.y; x0[4 * j + 2] = ta_.z; x0[4 * j + 3] = ta_.w;
            x1[4 * j] = tb_.x; x1[4 * j + 1] = tb_.y; x1[4 * j + 2] = tb_.z; x1[4 * j + 3] = tb_.w;
          }
          if (isC) {
#pragma unroll
            for (int j = 0; j < 16; ++j) { x0[j] = x0[j] * rstd * gn[c * 16 + j]; x1[j] = x1[j] * rstd * gn[32 + c * 16 + j]; }
          }
          if (lat) {
#pragma unroll
            for (int j = 0; j < 16; ++j) {
              float c_ = cs[c * 16 + j], s_ = sn[c * 16 + j];
              float a0 = x0[j], a1 = x1[j];
              x0[j] = a0 * c_ - a1 * s_;
              x1[j] = a1 * c_ + a0 * s_;
            }
          }
          if (isQ) {
#pragma unroll
            for (int j = 0; j < 16; ++j) { x0[j] *= QSCALE; x1[j] *= QSCALE; }
          }
          uint4 o0, o1, o2, o3;
          o0.x = pack2(x0[0], x0[1]); o0.y = pack2(x0[2], x0[3]); o0.z = pack2(x0[4], x0[5]); o0.w = pack2(x0[6], x0[7]);
          o1.x = pack2(x0[8], x0[9]); o1.y = pack2(x0[10], x0[11]); o1.z = pack2(x0[12], x0[13]); o1.w = pack2(x0[14], x0[15]);
          o2.x = pack2(x1[0], x1[1]); o2.y = pack2(x1[2], x1[3]); o2.z = pack2(x1[4], x1[5]); o2.w = pack2(x1[6], x1[7]);
          o3.x = pack2(x1[8], x1[9]); o3.y = pack2(x1[10], x1[11]); o3.z = pack2(x1[12], x1[13]); o3.w = pack2(x1[14], x1[15]);
          *(uint4*)(dst + c * 16) = o0;
          *(uint4*)(dst + c * 16 + 8) = o1;
          *(uint4*)(dst + 32 + c * 16) = o2;
          *(uint4*)(dst + 32 + c * 16 + 8) = o3;
        }
      }
    };
    auto stage_mine = [&]() {
      float* Cs = (float*)lds;
#pragma unroll
      for (int i = 0; i < 4; ++i)
#pragma unroll
        for (int j = 0; j < 2; ++j)
#pragma unroll
          for (int g = 0; g < 4; ++g) {
            int m = wm * 128 + i * 32 + r;
            int n = (wn & 1) * 64 + j * 32 + 8 * g + 4 * hh;
            float4 v; v.x = acc[i][j][4 * g]; v.y = acc[i][j][4 * g + 1]; v.z = acc[i][j][4 * g + 2]; v.w = acc[i][j][4 * g + 3];
            *(float4*)(Cs + m * 132 + n) = v;
          }
    };
    if ((wn >> 1) == 0) {
      const int ta = ((wm * 2 + (wn & 1)) << 6) + lane;
      stage_mine();
      __syncthreads();
      process_unit(0, ta);
      process_unit(0, ta + 256);
      __syncthreads();
      __syncthreads();
      process_unit(1, tid);
      __syncthreads();
    } else {
      __syncthreads();
      __syncthreads();
      stage_mine();
      __syncthreads();
      process_unit(1, tid);
      __syncthreads();
    }
  }
}

struct AttnArgs {
  const u16* q;
  u16* z;
  const u16* kctx;
  const u16* vctx;
  const u16* klat;
  const u16* vlat;
  int n_lat_tiles;
  int lat_key0;
  int q_t0;
  int band;
  int has_sink;
  float sink_l2;
  int dry;
};

DI void attn_load_tile(const AttnArgs& a, int ti, u32x4 (&rk)[2], u32x4 (&rv)[2]) {
  const int tid = otid();
  const u16* kp; const u16* vp; int vs;
  if (ti < 4) { kp = a.kctx + (size_t)(ti * 64) * 512; vp = a.vctx + ti * 64; vs = L; }
  else { kp = a.klat + (size_t)((ti - 4) * 64) * 512; vp = a.vlat + (ti - 4) * 64; vs = S; }
#pragma unroll
  for (int i = 0; i < 2; ++i) {
    int c = tid + NTHR * i;
    rk[i] = *(const u32x4*)(kp + (size_t)(c >> 4) * 512 + (c & 15) * 8);
    rv[i] = *(const u32x4*)(vp + (size_t)(c >> 3) * vs + (c & 7) * 8);
  }
}
DI void attn_store_tile(u16* sK, u16* sV, const u32x4 (&rk)[2], const u32x4 (&rv)[2]) {
  const int tid = otid();
#pragma unroll
  for (int i = 0; i < 2; ++i) {
    int c = tid + NTHR * i;
    *(u32x4*)(sK + (c >> 4) * 136 + (c & 15) * 8) = rk[i];
    u16* vd = sV + (c >> 3) * 68 + (c & 7) * 8;
    { u32x2 t0 = {rv[i].x, rv[i].y}; *(u32x2*)(vd) = t0; }
    { u32x2 t1 = {rv[i].z, rv[i].w}; *(u32x2*)(vd + 4) = t1; }
  }
}

DI void attn_item(const AttnArgs& a, char* lds) {
  const int tid = otid(), lane = tid & 63, w = tid >> 6;
  const int r = lane & 31, hh = lane >> 5;
  u16* sKb = (u16*)lds;
  u16* sVb = sKb + 2 * 64 * 136;
  const int ntiles = 4 + a.n_lat_tiles;

  bf16x8 qf[8];
  {
    const u16* qp = a.q + (size_t)(w * 32 + r) * 2048 + hh * 8;
#pragma unroll
    for (int ks = 0; ks < 8; ++ks) qf[ks] = *(const bf16x8*)(qp + ks * 16);
  }
  f32x16 O[4];
#pragma unroll
  for (int dt = 0; dt < 4; ++dt)
#pragma unroll
    for (int x = 0; x < 16; ++x) O[dt][x] = 0.f;
  float m = a.has_sink ? a.sink_l2 : -1e30f;
  float lsum = (a.has_sink && hh == 0) ? 1.f : 0.f;

  u32x4 rk[2], rv[2];
  attn_load_tile(a, 0, rk, rv);
  __syncthreads();
  attn_store_tile(sKb, sVb, rk, rv);
  __syncthreads();
  const int qpos = a.q_t0 + w * 32 + r;

  for (int ti = 0; ti < ntiles; ++ti) {
    const int cur = ti & 1;
    if (ti + 1 < ntiles) attn_load_tile(a, ti + 1, rk, rv);
    const u16* sK = sKb + cur * 64 * 136;
    const u16* sV = sVb + cur * 128 * 68;
    f32x16 s[2];
#pragma unroll
    for (int kt2 = 0; kt2 < 2; ++kt2) {
#pragma unroll
      for (int x = 0; x < 16; ++x) s[kt2][x] = 0.f;
      const u16* kb = sK + (kt2 * 32 + r) * 136 + hh * 8;
#pragma unroll
      for (int ks = 0; ks < 8; ++ks) {
        bf16x8 ka = *(const bf16x8*)(kb + ks * 16);
        s[kt2] = MFMA32(ka, qf[ks], s[kt2]);
      }
    }
    if (a.band && ti >= 4) {
      const int k0 = a.lat_key0 + (ti - 4) * 64;
#pragma unroll
      for (int kt2 = 0; kt2 < 2; ++kt2)
#pragma unroll
        for (int x = 0; x < 16; ++x) {
          int kp = k0 + kt2 * 32 + crow(x, hh);
          int dlt = kp - qpos; dlt = dlt < 0 ? -dlt : dlt;
          if (dlt > 128) s[kt2][x] = -1e30f;
        }
    }
    float mx = s[0][0];
#pragma unroll
    for (int kt2 = 0; kt2 < 2; ++kt2)
#pragma unroll
      for (int x = 0; x < 16; ++x) mx = fmaxf(mx, s[kt2][x]);
    mx = fmaxf(mx, __shfl_xor(mx, 32));
    if (__any(mx > m + 8.f)) {
      const float mnew = fmaxf(m, mx);
      const float alpha = __builtin_amdgcn_exp2f(m - mnew);
      m = mnew;
      lsum *= alpha;
#pragma unroll
      for (int dt = 0; dt < 4; ++dt)
#pragma unroll
        for (int x = 0; x < 16; ++x) O[dt][x] *= alpha;
    }
    float ps = 0.f;
#pragma unroll
    for (int kt2 = 0; kt2 < 2; ++kt2)
#pragma unroll
      for (int x = 0; x < 16; ++x) { float pv = __builtin_amdgcn_exp2f(s[kt2][x] - m); s[kt2][x] = pv; ps += pv; }
    lsum += ps;
#pragma unroll
    for (int kt2 = 0; kt2 < 2; ++kt2)
#pragma unroll
      for (int s2 = 0; s2 < 2; ++s2) {
        union { unsigned u[4]; bf16x8 v; } pf;
#pragma unroll
        for (int j = 0; j < 4; ++j) pf.u[j] = pack2(s[kt2][8 * s2 + 2 * j], s[kt2][8 * s2 + 2 * j + 1]);
        const u16* vb = sV + r * 68 + kt2 * 32 + 16 * s2 + 4 * hh;
#pragma unroll
        for (int dt = 0; dt < 4; ++dt) {
          s16x4 lo = *(const s16x4*)(vb + dt * 32 * 68);
          s16x4 hi = *(const s16x4*)(vb + dt * 32 * 68 + 8);
          bf16x8 va = __builtin_shufflevector(lo, hi, 0, 1, 2, 3, 4, 5, 6, 7);
          O[dt] = MFMA32(va, pf.v, O[dt]);
        }
      }
    if (ti + 1 < ntiles) attn_store_tile(sKb + (cur ^ 1) * 64 * 136, sVb + (cur ^ 1) * 128 * 68, rk, rv);
    __syncthreads();
  }
  float ltot = lsum + __shfl_xor(lsum, 32);
  const float inv = 1.f / ltot;
  u16* zp = a.z + (size_t)(w * 32 + r) * 3072;
  u32x2 gv[4][4];
#pragma unroll
  for (int dt = 0; dt < 4; ++dt)
#pragma unroll
    for (int g4 = 0; g4 < 4; ++g4) gv[dt][g4] = *(const u32x2*)(zp + dt * 32 + 8 * g4 + 4 * hh);
#pragma unroll
  for (int dt = 0; dt < 4; ++dt)
#pragma unroll
    for (int g4 = 0; g4 < 4; ++g4) {
      int d0 = dt * 32 + 8 * g4 + 4 * hh;
      float y0 = O[dt][4 * g4 + 0] * inv * bflo(gv[dt][g4].x);
      float y1 = O[dt][4 * g4 + 1] * inv * bfhi(gv[dt][g4].x);
      float y2 = O[dt][4 * g4 + 2] * inv * bflo(gv[dt][g4].y);
      float y3 = O[dt][4 * g4 + 3] * inv * bfhi(gv[dt][g4].y);
      uint2 o; o.x = pack2(y0, y1); o.y = pack2(y2, y3);
      if (!a.dry || y0 != y0) *(uint2*)(zp + d0) = o;
    }
}

template <bool REV>
DI void lru_scan(float (&av)[2][16], float (&bv)[2][16], float& carry, int hh) {
  float segA[8], segB[8];
#pragma unroll
  for (int k = 0; k < 8; ++k) {
    const int mt = k >> 2, q = k & 3;
    float cA = 1.f, hl = 0.f;
#pragma unroll
    for (int jj = 0; jj < 4; ++jj) {
      const int j = REV ? 3 - jj : jj;
      const int i = 4 * q + j;
      hl = av[mt][i] * hl + bv[mt][i];
      cA *= av[mt][i];
      av[mt][i] = cA; bv[mt][i] = hl;
    }
    segA[k] = cA; segB[k] = hl;
  }
  float oA[8], oB[8];
#pragma unroll
  for (int k = 0; k < 8; ++k) { oA[k] = __shfl_xor(segA[k], 32); oB[k] = __shfl_xor(segB[k], 32); }
  float init[8];
  float st = carry;
#pragma unroll
  for (int kk = 0; kk < 8; ++kk) {
    const int k = REV ? 7 - kk : kk;
    const int first = REV ? 1 : 0;
    float A1 = (hh == first) ? segA[k] : oA[k];
    float B1 = (hh == first) ? segB[k] : oB[k];
    float st0 = st;
    st = A1 * st + B1;
    float A2 = (hh == first) ? oA[k] : segA[k];
    float B2 = (hh == first) ? oB[k] : segB[k];
    float st1 = st;
    st = A2 * st + B2;
    init[k] = (hh == first) ? st0 : st1;
  }
  carry = st;
#pragma unroll
  for (int k = 0; k < 8; ++k) {
    const int mt = k >> 2, q = k & 3;
#pragma unroll
    for (int j = 0; j < 4; ++j) {
      const int i = 4 * q + j;
      bv[mt][i] = bv[mt][i] + av[mt][i] * init[k];
    }
  }
}

DI void lru_item(const Params& p, int l, int b, int n, bool last, char* lds, int dry = 0) {
  const int NB = p.NB, RL = NB * S;
  const int tid = otid(), lane = tid & 63, w8 = tid >> 6;
  const int sub = __builtin_amdgcn_readfirstlane(w8 >> 2), w = w8 & 3;
  n = n + sub;
  lds += sub * 73728;
  const int dir = w >> 1, w2 = w & 1;
  const int tl = tid & 127;
  const int r = lane & 31, hh = lane >> 5;
  u16* sRaw = (u16*)lds + dir * (8704 / 2);
  u16* sUp = (u16*)(lds + 17408) + dir * (9216 / 2);
  float* sH = (float*)(lds + 35840) + w * (64 * 36);

  const int chb = n * 64;
  const int cp = (tl & 31) * 2, tg = tl >> 5;
  float cw0[4], cw1[4], cb0, cb1;
#pragma unroll
  for (int k = 0; k < 4; ++k) {
    cw0[k] = p.conv_w[((size_t)l * 4 + k) * D + chb + cp];
    cw1[k] = p.conv_w[((size_t)l * 4 + k) * D + chb + cp + 1];
  }
  cb0 = p.conv_b[l * D + chb + cp]; cb1 = p.conv_b[l * D + chb + cp + 1];
  bf16x8 waf[4], wxf[4];
  {
    const float* wa = p.lru_wa + (((size_t)(l * 2 + dir) * 16 + n) * 64) * 64;
    const float* wx = p.lru_wx + (((size_t)(l * 2 + dir) * 16 + n) * 64) * 64;
    const int e = 32 * w2 + r;
#pragma unroll
    for (int ks = 0; ks < 4; ++ks) {
      union { unsigned u[4]; bf16x8 v; } fa, fx;
#pragma unroll
      for (int j = 0; j < 4; ++j) {
        int d0 = ks * 16 + 8 * hh + 2 * j;
        fa.u[j] = pack2(wa[d0 * 64 + e], wa[(d0 + 1) * 64 + e]);
        fx.u[j] = pack2(wx[d0 * 64 + e], wx[(d0 + 1) * 64 + e]);
      }
      waf[ks] = fa.v; wxf[ks] = fx.v;
    }
  }
  const int che = chb + 32 * w2 + r;
  const float ba = p.lru_ba[(l * 2 + dir) * D + che];
  const float bx = p.lru_bx[(l * 2 + dir) * D + che];
  float c8sp;
  {
    float lam = p.lru_lambda[(l * 2 + dir) * D + che];
    float sp = (lam < -20.f) ? -lam : log1pf(expf(-lam));
    c8sp = 8.f * sp;
  }
  float carry = 0.f;

  auto step_tile = [&](int st, bool& isctx, int& tt) {
    if (dir == 0) { if (st < 4) { isctx = true; tt = st; } else { isctx = false; tt = st - 4; } }
    else { if (st < 4) { isctx = true; tt = 3 - st; } else { isctx = false; tt = 63 - (st - 4); } }
  };
  u32x4 pre[5];
  auto load_raw = [&](int st) {
    bool isctx; int tt; step_tile(st, isctx, tt);
    const int seqlen = isctx ? L : S;
    const size_t rowbase = isctx ? (size_t)RL + (size_t)b * L : (size_t)b * S;
    const int t0 = tt * 64;
#pragma unroll
    for (int i = 0; i < 5; ++i) {
      int c = tl + 128 * i;
      int rr = c >> 3, c16 = c & 7;
      int t = t0 - 2 + rr;
      u32x4 v = {0u, 0u, 0u, 0u};
      if (rr < 67 && t >= 0 && t < seqlen) v = *(const u32x4*)(p.U + (rowbase + t) * D + chb + c16 * 8);
      pre[i] = v;
    }
  };
  load_raw(0);
  __syncthreads();
  for (int st = 0; st < 68; ++st) {
    bool isctx; int tt; step_tile(st, isctx, tt);
    const size_t rowbase = isctx ? (size_t)RL + (size_t)b * L : (size_t)b * S;
    const int t0 = tt * 64;
#pragma unroll
    for (int i = 0; i < 5; ++i) {
      int c = tl + 128 * i;
      int rr = c >> 3, c16 = c & 7;
      if (rr < 67) *(u32x4*)(sRaw + rr * 64 + c16 * 8) = pre[i];
    }
    if (st + 1 < 68) load_raw(st + 1);
    __syncthreads();
    {
      const u16* rp = sRaw + (tg * 16) * 64 + cp;
      unsigned r0 = *(const unsigned*)(rp), r1 = *(const unsigned*)(rp + 64), r2 = *(const unsigned*)(rp + 128);
#pragma unroll
      for (int i = 0; i < 16; ++i) {
        unsigned r3 = *(const unsigned*)(rp + (i + 3) * 64);
        float o0 = cb0 + cw0[0] * bflo(r0) + cw0[1] * bflo(r1) + cw0[2] * bflo(r2) + cw0[3] * bflo(r3);
        float o1 = cb1 + cw1[0] * bfhi(r0) + cw1[1] * bfhi(r1) + cw1[2] * bfhi(r2) + cw1[3] * bfhi(r3);
        *(unsigned*)(sUp + (tg * 16 + i) * 72 + cp) = pack2(o0, o1);
        r0 = r1; r1 = r2; r2 = r3;
      }
    }
    __syncthreads();
    const bool fwd_first = isctx ? (tt <= 1) : (tt <= 31);
    const bool first = (dir == 0) ? fwd_first : !fwd_first;
    unsigned long long pt0[4], pt1[4];
    u32x4 pg[4];
    if (!first && !(isctx && last)) {
#pragma unroll
      for (int j = 0; j < 4; ++j) {
        const int q = lane + 64 * j;
        const int tok = q >> 2, cc = (q & 3) * 8;
        const size_t row = rowbase + t0 + tok;
        const int col = chb + 32 * w2 + cc;
        const u16* tp = p.Hb + row * D + col;
        pt0[j] = __hip_atomic_load((const unsigned long long*)tp, __ATOMIC_RELAXED, __HIP_MEMORY_SCOPE_AGENT);
        pt1[j] = __hip_atomic_load((const unsigned long long*)tp + 1, __ATOMIC_RELAXED, __HIP_MEMORY_SCOPE_AGENT);
        pg[j] = *(const u32x4*)(p.Z + row * 3072 + col);
      }
    } else {
#pragma unroll
      for (int j = 0; j < 4; ++j) { pt0[j] = 0; pt1[j] = 0; pg[j] = u32x4{0u, 0u, 0u, 0u}; }
    }
    float av[2][16], bv[2][16];
    {
      f32x16 aR[2];
#pragma unroll
      for (int mt = 0; mt < 2; ++mt) {
#pragma unroll
        for (int x = 0; x < 16; ++x) aR[mt][x] = 0.f;
        const u16* ub = sUp + (mt * 32 + r) * 72 + hh * 8;
#pragma unroll
        for (int ks = 0; ks < 4; ++ks) aR[mt] = MFMA32(*(const bf16x8*)(ub + ks * 16), waf[ks], aR[mt]);
      }
#pragma unroll
      for (int mt = 0; mt < 2; ++mt)
#pragma unroll
        for (int x = 0; x < 16; ++x) {
          const float rg = sigmoidf_(aR[mt][x] + ba);
          av[mt][x] = -c8sp * rg;
        }
    }
    {
      f32x16 aI[2];
#pragma unroll
      for (int mt = 0; mt < 2; ++mt) {
#pragma unroll
        for (int x = 0; x < 16; ++x) aI[mt][x] = 0.f;
        const u16* ub = sUp + (mt * 32 + r) * 72 + hh * 8;
#pragma unroll
        for (int ks = 0; ks < 4; ++ks) aI[mt] = MFMA32(*(const bf16x8*)(ub + ks * 16), wxf[ks], aI[mt]);
      }
#pragma unroll
      for (int mt = 0; mt < 2; ++mt)
#pragma unroll
        for (int x = 0; x < 16; ++x) {
          const int tok = mt * 32 + crow(x, hh);
          const float up = bf2f(sUp[tok * 72 + 32 * w2 + r]);
          const float ig = sigmoidf_(aI[mt][x] + bx);
          const float la = av[mt][x];
          const float a_ = __expf(la);
          const float om = fmaxf(1.f - a_ * a_, 0.f);
          av[mt][x] = a_;
          bv[mt][x] = __builtin_amdgcn_sqrtf(om) * (ig * up);
        }
    }
    if (dir == 0) lru_scan<false>(av, bv, carry, hh); else lru_scan<true>(av, bv, carry, hh);
#pragma unroll
    for (int mt = 0; mt < 2; ++mt)
#pragma unroll
      for (int x = 0; x < 16; ++x) sH[(mt * 32 + crow(x, hh)) * 36 + r] = bv[mt][x];
    if (!(isctx && last)) {
#pragma unroll
      for (int j = 0; j < 4; ++j) {
        const int q = lane + 64 * j;
        const int tok = q >> 2, cc = (q & 3) * 8;
        const float4 h0 = *(const float4*)(sH + tok * 36 + cc);
        const float4 h1 = *(const float4*)(sH + tok * 36 + cc + 4);
        const size_t row = rowbase + t0 + tok;
        const int col = chb + 32 * w2 + cc;
        u16* tp = p.Hb + row * D + col;
        if (first) {
          uint4 o; o.x = pack2(h0.x, h0.y); o.y = pack2(h0.z, h0.w); o.z = pack2(h1.x, h1.y); o.w = pack2(h1.z, h1.w);
          if (!dry || h0.x != h0.x) *(uint4*)tp = o;
        } else {
          unsigned tx = (unsigned)pt0[j], ty = (unsigned)(pt0[j] >> 32), tz = (unsigned)pt1[j], tw = (unsigned)(pt1[j] >> 32);
          u16* zp = p.Z + row * 3072 + col;
          u32x4 g = pg[j];
          uint4 o;
          o.x = pack2((h0.x + bflo(tx)) * bflo(g.x), (h0.y + bfhi(tx)) * bfhi(g.x));
          o.y = pack2((h0.z + bflo(ty)) * bflo(g.y), (h0.w + bfhi(ty)) * bfhi(g.y));
          o.z = pack2((h1.x + bflo(tz)) * bflo(g.z), (h1.y + bfhi(tz)) * bfhi(g.z));
          o.w = pack2((h1.z + bflo(tw)) * bflo(g.w), (h1.w + bfhi(tw)) * bfhi(g.w));
          if (!dry || h0.x != h0.x) *(uint4*)zp = o;
        }
      }
    }
    __builtin_amdgcn_fence(__ATOMIC_RELEASE, "workgroup");
  }
}

DI void phase_mixers(const Params& p, int chunk, int l, char* lds) {
  const int NB = p.NB, RL = NB * S;
  const bool last = (l == DEPTH - 1);
  const int nLRU = NB * 8, nC = NB * 8 * 16, nBw = NB * 8 * 16, nCtx = last ? 0 : NB * 8 * 2;
  const int total = nLRU + nC + nBw + nCtx;
  int* ctr = p.ctr + chunk * DEPTH + l;
  int* s_item = (int*)(lds + LDS_BYTES - 16);
  int it;
  while (true) {
    __syncthreads();
    if (threadIdx.x == 0) *s_item = atomicAdd(ctr, 1);
    __syncthreads();
    it = __builtin_amdgcn_readfirstlane(*s_item);
    __syncthreads();
    if (it >= nLRU) break;
    lru_item(p, l, it >> 3, (it & 7) * 2, last, lds, 0);
  }
  bool have = true;
  while (true) {
    if (!have) {
      __syncthreads();
      if (threadIdx.x == 0) *s_item = atomicAdd(ctr, 1);
      __syncthreads();
      it = __builtin_amdgcn_readfirstlane(*s_item);
      __syncthreads();
    }
    have = false;
    if (it >= total) break;
    it -= nLRU;
    AttnArgs a;
    a.dry = 0;
    if (it < nC + nBw) {
      const bool isB = it >= nC;
      if (isB) it -= nC;
      const int b = it >> 7, h = (it >> 4) & 7, qb = it & 15;
      const int kvh = h >> 2;
      const int br = isB ? 0 : 1;
      const size_t qrow0 = (size_t)b * S + qb * 256;
      a.q = p.Q + qrow0 * 2048 + br * 1024 + h * 128;
      a.z = p.Z + qrow0 * 3072 + (br + 1) * 1024 + h * 128;
      const int kcol = br * 256 + kvh * 128, slot = br * 2 + kvh;
      a.kctx = p.Kb + ((size_t)RL + (size_t)b * L) * 512 + kcol;
      a.vctx = p.VtC + (size_t)(b * 4 + slot) * 128 * L;
      int k0, k1;
      if (isB) { k0 = qb * 256 - 128; if (k0 < 0) k0 = 0; k1 = qb * 256 + 384; if (k1 > S) k1 = S; }
      else { k0 = 0; k1 = S; }
      a.lat_key0 = k0;
      a.n_lat_tiles = (k1 - k0) >> 6;
      a.klat = p.Kb + ((size_t)b * S + k0) * 512 + kcol;
      a.vlat = p.VtL + (size_t)(b * 4 + slot) * 128 * S + k0;
      a.q_t0 = qb * 256;
      a.band = isB ? 1 : 0;
      a.has_sink = isB ? 1 : 0;
      a.sink_l2 = isB ? p.attn_sink[l * 8 + h] * LOG2E : 0.f;
    } else {
      it -= nC + nBw;
      const int h = it & 7, br = (it >> 3) & 1, b = it >> 4;
      const int kvh = h >> 2;
      const size_t qrow0 = (size_t)RL + (size_t)b * L;
      a.q = p.Q + qrow0 * 2048 + br * 1024 + h * 128;
      a.z = p.Z + qrow0 * 3072 + (br + 1) * 1024 + h * 128;
      const int kcol = br * 256 + kvh * 128, slot = br * 2 + kvh;
      a.kctx = p.Kb + ((size_t)RL + (size_t)b * L) * 512 + kcol;
      a.vctx = p.VtC + (size_t)(b * 4 + slot) * 128 * L;
      a.klat = a.kctx; a.vlat = a.vctx;
      a.n_lat_tiles = 0; a.lat_key0 = 0; a.q_t0 = 0; a.band = 0;
      a.has_sink = (br == 0) ? 1 : 0;
      a.sink_l2 = (br == 0) ? p.attn_sink[l * 8 + h] * LOG2E : 0.f;
    }
    attn_item(a, lds);
  }
}

DI void phase_merge(const Params& p, int chunk, int l, char* lds) {
  const int NB = p.NB, RL = NB * S, R = NB * (S + L);
  const bool last = (l == DEPTH - 1);
  const int MT = (last ? RL : R) / 256, NT = 8;
  const int tid = otid();
  const int lane = tid & 63, w = tid >> 6, wm = w >> 1, wn = w & 1, r = lane & 31, hh = lane >> 5;
  for (int ti = 0;; ++ti) {
    int mt, nt;
    if (!tile_map(ti, MT, NT, mt, nt)) break;
    const int m0 = mt * 256, n0 = nt * 128;
    f32x16 tot[2][2];
#pragma unroll
    for (int i = 0; i < 2; ++i)
#pragma unroll
      for (int j = 0; j < 2; ++j)
#pragma unroll
        for (int x = 0; x < 16; ++x) tot[i][j][x] = 0.f;
#pragma unroll 1
    for (int n = 0; n < 3; ++n) {
      f32x16 acc[2][2];
      gemm_core<128, false>(p.Z + (size_t)m0 * 3072 + n * 1024, 3072, 64, (size_t)128 * 3072,
                            p.WbT + ((size_t)(l * 3 + n) * D + n0) * D, 64, 8192, 0, D, lds, acc);
#pragma unroll
      for (int i = 0; i < 2; ++i)
#pragma unroll
        for (int j = 0; j < 2; ++j)
#pragma unroll
          for (int g = 0; g < 4; ++g) {
            const size_t row = (size_t)m0 + wm * 64 + i * 32 + r;
            const int col = n0 + wn * 64 + j * 32 + 8 * g + 4 * hh;
            uint2 sv = *(const uint2*)(p.Ms + row * 3072 + n * 1024 + col);
            tot[i][j][4 * g + 0] += bflo(sv.x) * acc[i][j][4 * g + 0];
            tot[i][j][4 * g + 1] += bfhi(sv.x) * acc[i][j][4 * g + 1];
            tot[i][j][4 * g + 2] += bflo(sv.y) * acc[i][j][4 * g + 2];
            tot[i][j][4 * g + 3] += bfhi(sv.y) * acc[i][j][4 * g + 3];
          }
    }
#pragma unroll
    for (int i = 0; i < 2; ++i)
#pragma unroll
      for (int j = 0; j < 2; ++j)
#pragma unroll
        for (int g = 0; g < 4; ++g) {
          const size_t row = (size_t)m0 + wm * 64 + i * 32 + r;
          const int col = n0 + wn * 64 + j * 32 + 8 * g + 4 * hh;
          uint2 o; o.x = pack2(tot[i][j][4 * g], tot[i][j][4 * g + 1]); o.y = pack2(tot[i][j][4 * g + 2], tot[i][j][4 * g + 3]);
          *(uint2*)(p.Hb + ((row >> 7) * 16 + (col >> 6)) * 8192 + (row & 127) * 64 + (col & 63)) = o;
        }
  }
}

DI void phase_outproj(const Params& p, int chunk, int l, char* lds) {
  const int NB = p.NB, RL = NB * S, R = NB * (S + L);
  const bool last = (l == DEPTH - 1);
  const int MT = (last ? RL : R) / 256, NT = 8;
  const int tid = otid();
  const int w = tid >> 6, wm = w >> 1, wn = w & 1;
  for (int ti = 0;; ++ti) {
    int mt, nt;
    if (!tile_map(ti, MT, NT, mt, nt)) break;
    const int m0 = mt * 256, n0 = nt * 128;
    f32x16 acc[2][2];
    gemm_core<128, true>(p.Hb + (size_t)m0 * D, 64, 8192, 131072, p.WoT + ((size_t)l * D + n0) * D, 64, 8192, 0, D, lds, acc);
    stage_acc<2>(lds, acc, wm, wn * 64, true);
    const int row = tid >> 1, half = tid & 1;
    const int gr = m0 + row;
    const float* src; float* dst; int mrow;
    if (gr < RL) {
      int b = gr / S, t = gr % S; int bg = chunk * NB + b;
      size_t off = ((size_t)bg * S + t) * D + n0 + half * 64;
      src = (l == 0 ? p.x : p.out) + off; dst = p.out + off; mrow = bg;
    } else {
      int rc = gr - RL; int b = rc / L, t = rc % L; int bg = chunk * NB + b;
      size_t off = ((size_t)bg * L + t) * D + n0 + half * 64;
      src = (l == 0 ? p.ctx : p.xc) + off; dst = p.xc + off; mrow = 16;
    }
    const float* gate = p.modv + ((size_t)l * 17 + mrow) * 3072 + 2048 + n0 + half * 64;
    const float* Cs = (const float*)lds + row * 132 + half * 64;
    float4 xv[16], gv[16];
#pragma unroll
    for (int j = 0; j < 16; ++j) { xv[j] = *(const float4*)(src + j * 4); gv[j] = *(const float4*)(gate + j * 4); }
#pragma unroll
    for (int j = 0; j < 16; ++j) {
      float4 cv = *(const float4*)(Cs + j * 4);
      float4 o;
      o.x = xv[j].x + gv[j].x * cv.x; o.y = xv[j].y + gv[j].y * cv.y; o.z = xv[j].z + gv[j].z * cv.z; o.w = xv[j].w + gv[j].w * cv.w;
      *(float4*)(dst + j * 4) = o;
    }
  }
}

DI void phase_final(const Params& p) {
  const int tid_ = otid();
  const int lane = tid_ & 63;
  const int wg = blockIdx.x * 8 + (tid_ >> 6), nw = gridDim.x * 8;
  for (int r = wg; r < NBATCH * S; r += nw) {
    float* src = p.out + (size_t)r * D;
    float4 v[4]; float ss = 0.f;
#pragma unroll
    for (int i = 0; i < 4; ++i) {
      v[i] = *(const float4*)(src + i * 256 + lane * 4);
      ss += v[i].x * v[i].x + v[i].y * v[i].y + v[i].z * v[i].z + v[i].w * v[i].w;
    }
#pragma unroll
    for (int o = 32; o >= 1; o >>= 1) ss += __shfl_xor(ss, o);
    float rstd = rsqrtf(ss * (1.f / D) + EPS);
#pragma unroll
    for (int i = 0; i < 4; ++i) {
      int cidx = i * 256 + lane * 4;
      float4 gg = *(const float4*)(p.final_g + cidx);
      float4 o;
      o.x = v[i].x * rstd * gg.x; o.y = v[i].y * rstd * gg.y; o.z = v[i].z * rstd * gg.z; o.w = v[i].w * rstd * gg.w;
      *(float4*)(src + cidx) = o;
    }
  }
}

__global__ void __launch_bounds__(NTHR, 2) fwd_megakernel(Params p) {
  cg::grid_group grid = cg::this_grid();
  __shared__ __attribute__((aligned(16))) char lds[LDS_BYTES];
  phase0(p, lds);
  grid.sync();
  phase_mod(p, lds);
  grid.sync();
  for (int chunk = 0; chunk < p.nchunk; ++chunk) {
    for (int l = 0; l < DEPTH; ++l) {
      phase_prenorm(p, chunk, l);
      grid.sync();
      phase_gemm_in(p, chunk, l, lds);
      grid.sync();
      phase_mixers(p, chunk, l, lds);
      grid.sync();
      phase_merge(p, chunk, l, lds);
      grid.sync();
      phase_outproj(p, chunk, l, lds);
      grid.sync();
    }
  }
  phase_final(p);
}

extern "C" void kernel_launch(void* const* d_in, const int* in_sizes, int n_in,
                              void* d_out, int out_size, void* d_ws, size_t ws_size,
                              hipStream_t stream) {
  static int grid_blocks = 0;
  if (!grid_blocks) {
    int dev = 0, cus = 0, per_cu = 0;
    (void)hipGetDevice(&dev);
    (void)hipDeviceGetAttribute(&cus, hipDeviceAttributeMultiprocessorCount, dev);
    (void)hipOccupancyMaxActiveBlocksPerMultiprocessor(&per_cu, fwd_megakernel, NTHR, 0);
    if (per_cu > 1) per_cu = 1;
    if (per_cu < 1) per_cu = 1;
    grid_blocks = cus * per_cu;
  }
  Params p{};
  const float* const* in = (const float* const*)d_in;
  p.x = in[0]; p.c = in[1]; p.ctx = in[2]; p.c_ctx = in[3]; p.norm_g = in[4]; p.w_mod = in[5]; p.b_mod = in[6];
  p.w_in = in[7]; p.conv_w = in[8]; p.conv_b = in[9]; p.lru_wa = in[10]; p.lru_ba = in[11]; p.lru_wx = in[12];
  p.lru_bx = in[13]; p.lru_lambda = in[14]; p.attn_sink = in[15]; p.q_norm_g = in[16]; p.k_norm_g = in[17];
  p.w_branch = in[18]; p.w_out = in[19]; p.final_g = in[20];
  p.out = (float*)d_out;
  char* ws = (char*)d_ws;
  size_t off = 0;
  auto take = [&](size_t bytes) { char* r = ws + off; off += (bytes + 255) & ~(size_t)255; return r; };
  p.ctr = (int*)take(256);
  p.modv = (float*)take((size_t)DEPTH * 17 * 3072 * 4);
  p.sc = (float*)take((size_t)17 * D * 4);
  p.rope = (float*)take(4096 * 4);
  p.xc = (float*)take((size_t)NBATCH * L * D * 4);
  p.WinT = (u16*)take((size_t)DEPTH * INW * D * 2);
  p.WbT = (u16*)take((size_t)DEPTH * 3 * D * D * 2);
  p.WoT = (u16*)take((size_t)DEPTH * D * D * 2);
  const size_t fixed = off;
  int NB = 8;
  while (NB > 1) {
    size_t R = (size_t)NB * (S + L);
    size_t need = fixed + R * (size_t)(1024 + 1024 + 3072 + 2048 + 512 + 512 + 3072) * 2 + 8 * 256;
    if (need <= ws_size) break;
    NB >>= 1;
  }
  p.NB = NB; p.nchunk = NBATCH / NB;
  const size_t R = (size_t)NB * (S + L);
  p.Hb = (u16*)take(R * 1024 * 2);
  p.U = (u16*)take(R * 1024 * 2);
  p.Z = (u16*)take(R * 3072 * 2);
  p.Q = (u16*)take(R * 2048 * 2);
  p.Kb = (u16*)take(R * 512 * 2);
  p.VtL = (u16*)take((size_t)NB * 4 * 128 * S * 2);
  p.VtC = (u16*)take((size_t)NB * 4 * 128 * L * 2);
  p.Ms = (u16*)take(R * 3072 * 2);
  void* args[] = {&p};
  hipError_t e = hipLaunchCooperativeKernel((void*)fwd_megakernel, dim3(grid_blocks), dim3(NTHR), args, 0, stream);
  if (e != hipSuccess) fprintf(stderr, "cooperative launch failed: %s (grid %d)\n", hipGetErrorString(e), grid_blocks);
}
```

```cpp
#include <hip/hip_runtime.h>
#include <hip/hip_cooperative_groups.h>
#include <cstdio>
#include <cstdint>
namespace cg = cooperative_groups;

typedef unsigned short u16;
typedef __attribute__((ext_vector_type(8))) short bf16x8;
typedef __attribute__((ext_vector_type(4))) short s16x4;
typedef __attribute__((ext_vector_type(16))) float f32x16;
typedef __bf16 bf16x2_t __attribute__((ext_vector_type(2)));
typedef float float2_t __attribute__((ext_vector_type(2)));
typedef __attribute__((ext_vector_type(4))) unsigned u32x4;
typedef __attribute__((ext_vector_type(2))) unsigned u32x2;

#define DI __device__ __forceinline__
#define MFMA32(a, b, c) __builtin_amdgcn_mfma_f32_32x32x16_bf16((a), (b), (c), 0, 0, 0)

constexpr int D = 1024, NBATCH = 16, S = 4096, L = 256, DEPTH = 4, INW = 10240;
constexpr int LDS_BYTES = 147456;
constexpr int NTHR = 512;
constexpr float EPS = 1e-6f;
constexpr float QSCALE = 0.08838834764831845f * 1.4426950408889634f;
constexpr float LOG2E = 1.4426950408889634f;

struct Params {
  const float *x, *c, *ctx, *c_ctx, *norm_g, *w_mod, *b_mod, *w_in, *conv_w, *conv_b, *lru_wa, *lru_ba, *lru_wx, *lru_bx,
      *lru_lambda, *attn_sink, *q_norm_g, *k_norm_g, *w_branch, *w_out, *final_g;
  float* out;
  u16 *WinT, *WbT, *WoT;
  u16 *Hb, *U, *Z, *Q, *Kb, *VtL, *VtC, *Ms;
  float *modv, *sc, *rope, *xc;
  int* ctr;
  int NB;
  int nchunk;
};

DI unsigned pack2(float a, float b) {
  float2_t f = {a, b};
  bf16x2_t v = __builtin_convertvector(f, bf16x2_t);
  return __builtin_bit_cast(unsigned, v);
}
DI float bf2f(u16 v) { return __uint_as_float(((unsigned)v) << 16); }
DI float bflo(unsigned v) { return __uint_as_float(v << 16); }
DI float bfhi(unsigned v) { return __uint_as_float(v & 0xffff0000u); }
DI float sigmoidf_(float x) { return __builtin_amdgcn_rcpf(1.f + __expf(-x)); }
DI float siluf_(float x) { return x * __builtin_amdgcn_rcpf(1.f + __expf(-x)); }
DI int otid() { int t = threadIdx.x; asm volatile("" : "+v"(t)); return t; }
DI int crow(int i, int hh) { return (i & 3) + 8 * (i >> 2) + 4 * hh; }

DI void phase0(const Params& p, char* lds) {
  const int tid = otid();
  float* tile = (float*)lds;
  const int n_in = DEPTH * 16 * 160, n_b = DEPTH * 3 * 256, n_o = DEPTH * 256;
  for (int it = blockIdx.x; it < n_in + n_b + n_o; it += gridDim.x) {
    const float* src; u16* dst; int ldsrc;
    if (it < n_in) {
      int l = it / 2560, rem = it % 2560, kt = rem / 160, nt = rem % 160;
      src = p.w_in + (size_t)l * D * INW + (size_t)(kt * 64) * INW + nt * 64; ldsrc = INW;
      dst = p.WinT + (size_t)l * INW * D + ((size_t)(nt >> 1) * 16 + kt) * 8192 + (nt & 1) * 4096;
    } else if (it < n_in + n_b) {
      int i2 = it - n_in; int mat = i2 / 256, rem = i2 % 256, kt = rem / 16, nt = rem % 16;
      src = p.w_branch + (size_t)mat * D * D + (size_t)(kt * 64) * D + nt * 64; ldsrc = D;
      dst = p.WbT + (size_t)mat * D * D + ((size_t)(nt >> 1) * 16 + kt) * 8192 + (nt & 1) * 4096;
    } else {
      int i2 = it - n_in - n_b; int mat = i2 / 256, rem = i2 % 256, kt = rem / 16, nt = rem % 16;
      src = p.w_out + (size_t)mat * D * D + (size_t)(kt * 64) * D + nt * 64; ldsrc = D;
      dst = p.WoT + (size_t)mat * D * D + ((size_t)(nt >> 1) * 16 + kt) * 8192 + (nt & 1) * 4096;
    }
    __syncthreads();
#pragma unroll
    for (int i = 0; i < 2; ++i) {
      int c = tid + NTHR * i; int row = c >> 4, c4 = c & 15;
      float4 v = *(const float4*)(src + (size_t)row * ldsrc + c4 * 4);
      float* t = tile + row * 65 + c4 * 4;
      t[0] = v.x; t[1] = v.y; t[2] = v.z; t[3] = v.w;
    }
    __syncthreads();
    {
      int c = tid; int nrow = c >> 3, k8 = c & 7;
      float v[8];
#pragma unroll
      for (int j = 0; j < 8; ++j) v[j] = tile[(k8 * 8 + j) * 65 + nrow];
      uint4 o; o.x = pack2(v[0], v[1]); o.y = pack2(v[2], v[3]); o.z = pack2(v[4], v[5]); o.w = pack2(v[6], v[7]);
      *(uint4*)(dst + (size_t)nrow * 64 + k8 * 8) = o;
    }
  }
  const int gt = blockIdx.x * NTHR + tid, gn = gridDim.x * NTHR;
  for (int i = gt; i < 17 * D; i += gn) {
    int r = i / D, k = i % D;
    float v = (r < 16) ? p.c[r * D + k] : p.c_ctx[k];
    p.sc[i] = siluf_(v);
  }
  for (int i = gt; i < 64 * 32; i += gn) {
    int pos = i >> 5, pp = i & 31;
    float inv = powf(10000.f, -(float)pp / 32.f);
    float ang = (float)pos * inv;
    p.rope[i] = cosf(ang);
    p.rope[2048 + i] = sinf(ang);
  }
  if (blockIdx.x == 0 && tid < 64) p.ctr[tid] = 0;
}

DI void phase_mod(const Params& p, char* lds) {
  const int tid = otid();
  float* red = (float*)lds;
  const int col = tid & 63, kg = tid >> 6;
  for (int it = blockIdx.x; it < DEPTH * 48; it += gridDim.x) {
    int l = it / 48, cb = it % 48;
    float acc[17];
#pragma unroll
    for (int r = 0; r < 17; ++r) acc[r] = 0.f;
    const float* w = p.w_mod + (size_t)l * D * 3072 + cb * 64 + col;
    for (int k = kg * 128; k < kg * 128 + 128; ++k) {
      float wv = w[(size_t)k * 3072];
#pragma unroll
      for (int r = 0; r < 17; ++r) acc[r] += p.sc[r * D + k] * wv;
    }
    __syncthreads();
#pragma unroll
    for (int r = 0; r < 17; ++r) red[(kg * 17 + r) * 64 + col] = acc[r];
    __syncthreads();
    for (int i = tid; i < 17 * 64; i += NTHR) {
      int r = i >> 6, cc = i & 63;
      float s = 0.f;
#pragma unroll
      for (int g = 0; g < 8; ++g) s += red[(g * 17 + r) * 64 + cc];
      p.modv[((size_t)l * 17 + r) * 3072 + cb * 64 + cc] = s + p.b_mod[l * 3072 + cb * 64 + cc];
    }
  }
}

DI void phase_prenorm(const Params& p, int chunk, int l) {
  const int NB = p.NB, RL = NB * S, R = NB * (S + L);
  const int tid_ = otid();
  const int lane = tid_ & 63;
  const int wg = blockIdx.x * 8 + (tid_ >> 6), nw = gridDim.x * 8;
  const float* g = p.norm_g + l * D;
  for (int r = wg; r < R; r += nw) {
    const float* src; int mrow;
    if (r < RL) {
      int b = r / S, t = r % S; int bg = chunk * NB + b;
      src = (l == 0 ? p.x : p.out) + ((size_t)bg * S + t) * D; mrow = bg;
    } else {
      int rc = r - RL; int b = rc / L, t = rc % L; int bg = chunk * NB + b;
      src = (l == 0 ? p.ctx : p.xc) + ((size_t)bg * L + t) * D; mrow = 16;
    }
    const float* mv = p.modv + ((size_t)l * 17 + mrow) * 3072;
    float4 v[4]; float ss = 0.f;
#pragma unroll
    for (int i = 0; i < 4; ++i) {
      v[i] = *(const float4*)(src + i * 256 + lane * 4);
      ss += v[i].x * v[i].x + v[i].y * v[i].y + v[i].z * v[i].z + v[i].w * v[i].w;
    }
#pragma unroll
    for (int o = 32; o >= 1; o >>= 1) ss += __shfl_xor(ss, o);
    float rstd = rsqrtf(ss * (1.f / D) + EPS);
#pragma unroll
    for (int i = 0; i < 4; ++i) {
      int cidx = i * 256 + lane * 4;
      float4 gg = *(const float4*)(g + cidx);
      float4 sh = *(const float4*)(mv + cidx);
      float4 scl = *(const float4*)(mv + 1024 + cidx);
      float h0 = v[i].x * rstd * gg.x * (1.f + scl.x) + sh.x;
      float h1 = v[i].y * rstd * gg.y * (1.f + scl.y) + sh.y;
      float h2 = v[i].z * rstd * gg.z * (1.f + scl.z) + sh.z;
      float h3 = v[i].w * rstd * gg.w * (1.f + scl.w) + sh.w;
      uint2 o; o.x = pack2(h0, h1); o.y = pack2(h2, h3);
      *(uint2*)(p.Hb + ((size_t)(r >> 7) * 16 + (cidx >> 6)) * 8192 + (r & 127) * 64 + (cidx & 63)) = o;
    }
  }
}

template <int BN, bool PIPE>
DI void gemm_core(const u16* A, int lda, int ksa, size_t a_blk, const u16* Bt, int ldb, int ksb, size_t b_blk, int K, char* ldsc,
                  f32x16 (&acc)[BN / 64][2]) {
  constexpr int MI = BN / 64;
  constexpr int SS = 32768 + BN * 128;
  const int tid = otid(), lane = tid & 63, w = tid >> 6;
  const int wm = (BN == 256) ? (w >> 2) : (w >> 1), wn = (BN == 256) ? (w & 3) : (w & 1);
  const int r = lane & 31, hh = lane >> 5;
  const int drow = lane >> 3, dcp = lane & 7;
  const int chunk0 = dcp ^ (drow >> 1);
  const u16* gAe = A + (size_t)(w >> 2) * a_blk + (size_t)((w & 3) * 32 + drow) * lda + chunk0 * 8;
  const u16* gAo = gAe + (size_t)8 * lda + ((chunk0 ^ 4) - chunk0) * 8;
  const size_t a16 = (size_t)16 * lda;
  const int brow0 = (BN == 256) ? (w & 3) * 32 : w * 16;
  const u16* gBe = Bt + ((BN == 256) ? (size_t)(w >> 2) * b_blk : (size_t)0) + (size_t)(brow0 + drow) * ldb + chunk0 * 8;
  const u16* gBo = gBe + (size_t)8 * ldb + ((chunk0 ^ 4) - chunk0) * 8;
  const size_t b16 = (size_t)16 * ldb;
#pragma unroll
  for (int i = 0; i < MI; ++i)
#pragma unroll
    for (int j = 0; j < 2; ++j)
#pragma unroll
      for (int x = 0; x < 16; ++x) acc[i][j][x] = 0.f;
  auto DMA = [&](int kt, int stage) {
    char* sa = ldsc + stage * SS + (w * 4) * 1024;
    char* sb = ldsc + stage * SS + 32768 + ((BN == 256) ? (w * 4) : (w * 2)) * 1024;
    const size_t ka = (size_t)kt * ksa, kb = (size_t)kt * ksb;
    __builtin_amdgcn_global_load_lds((const unsigned*)(gAe + ka), (unsigned*)(sa), 16, 0, 0);
    __builtin_amdgcn_global_load_lds((const unsigned*)(gBe + kb), (unsigned*)(sb), 16, 0, 0);
    __builtin_amdgcn_global_load_lds((const unsigned*)(gAo + ka), (unsigned*)(sa + 1024), 16, 0, 0);
    __builtin_amdgcn_global_load_lds((const unsigned*)(gBo + kb), (unsigned*)(sb + 1024), 16, 0, 0);
    __builtin_amdgcn_global_load_lds((const unsigned*)(gAe + a16 + ka), (unsigned*)(sa + 2048), 16, 0, 0);
    __builtin_amdgcn_global_load_lds((const unsigned*)(gAo + a16 + ka), (unsigned*)(sa + 3072), 16, 0, 0);
    if (BN == 256) {
      __builtin_amdgcn_global_load_lds((const unsigned*)(gBe + b16 + kb), (unsigned*)(sb + 2048), 16, 0, 0);
      __builtin_amdgcn_global_load_lds((const unsigned*)(gBo + b16 + kb), (unsigned*)(sb + 3072), 16, 0, 0);
    }
  };
  const int sw = (r >> 1) & 7;
  int koff[4];
#pragma unroll
  for (int ks = 0; ks < 4; ++ks) koff[ks] = ((2 * ks + hh) ^ sw) << 4;
  auto COMPUTE = [&](int stage) {
    const char* ab = ldsc + stage * SS + (wm * (MI * 32) + r) * 128;
    const char* bb = ldsc + stage * SS + 32768 + (wn * 64 + r) * 128;
    bf16x8 fa[2][MI], fb[2][2];
    auto LDF = [&](int ks, int slot) {
#pragma unroll
      for (int i = 0; i < MI; ++i) fa[slot][i] = *(const bf16x8*)(ab + i * 32 * 128 + koff[ks]);
#pragma unroll
      for (int j = 0; j < 2; ++j) fb[slot][j] = *(const bf16x8*)(bb + j * 32 * 128 + koff[ks]);
    };
    auto MM = [&](int slot) {
#pragma unroll
      for (int i = 0; i < MI; ++i)
#pragma unroll
        for (int j = 0; j < 2; ++j) acc[i][j] = MFMA32(fb[slot][j], fa[slot][i], acc[i][j]);
    };
    if (!PIPE) {
#pragma unroll
      for (int ks = 0; ks < 4; ++ks) { LDF(ks, 0); MM(0); }
      return;
    }
    LDF(0, 0); LDF(1, 1);
    __builtin_amdgcn_sched_barrier(0);
    MM(0); LDF(2, 0);
    __builtin_amdgcn_sched_barrier(0);
    MM(1); LDF(3, 1);
    __builtin_amdgcn_sched_barrier(0);
    MM(0); MM(1);
  };
  const int KT = K >> 6;
  __syncthreads();
  DMA(0, 0);
  __syncthreads();
  for (int kt = 0; kt < KT; kt += 2) {
    DMA(kt + 1, 1);
    COMPUTE(0);
    __syncthreads();
    if (kt + 2 < KT) DMA(kt + 2, 0);
    COMPUTE(1);
    __syncthreads();
  }
}

template <int MI>
DI void stage_acc(char* ldsc, f32x16 (&acc)[MI][2], int wm, int ncol0, bool active) {
  const int tid = otid(), lane = tid & 63;
  const int r = lane & 31, hh = lane >> 5;
  float* Cs = (float*)ldsc;
  if (active) {
#pragma unroll
    for (int i = 0; i < MI; ++i)
#pragma unroll
      for (int j = 0; j < 2; ++j)
#pragma unroll
        for (int g = 0; g < 4; ++g) {
          int m = wm * (MI * 32) + i * 32 + r;
          int n = ncol0 + j * 32 + 8 * g + 4 * hh;
          float4 v; v.x = acc[i][j][4 * g]; v.y = acc[i][j][4 * g + 1]; v.z = acc[i][j][4 * g + 2]; v.w = acc[i][j][4 * g + 3];
          *(float4*)(Cs + m * 132 + n) = v;
        }
  }
  __syncthreads();
}

DI void read_row64(const char* ldsc, int row, int half, float (&v)[64]) {
  const float* Cs = (const float*)ldsc + row * 132 + half * 64;
#pragma unroll
  for (int j = 0; j < 16; ++j) {
    float4 t = *(const float4*)(Cs + j * 4);
    v[j * 4] = t.x; v[j * 4 + 1] = t.y; v[j * 4 + 2] = t.z; v[j * 4 + 3] = t.w;
  }
}

DI void store_row64_bf16(u16* dst, const float (&v)[64]) {
#pragma unroll
  for (int j = 0; j < 8; ++j) {
    uint4 o;
    o.x = pack2(v[j * 8], v[j * 8 + 1]); o.y = pack2(v[j * 8 + 2], v[j * 8 + 3]);
    o.z = pack2(v[j * 8 + 4], v[j * 8 + 5]); o.w = pack2(v[j * 8 + 6], v[j * 8 + 7]);
    *(uint4*)(dst + j * 8) = o;
  }
}

DI bool tile_map(int i, int MT, int NT, int& mt, int& nt) {
  const int G = gridDim.x, bid = blockIdx.x;
  if ((G & 63) == 0 && (MT & 7) == 0 && (NT % (G >> 6)) == 0) {
    const int SH = G >> 6;
    const int xcd = bid & 7, slot = bid >> 3;
    const int sx = slot & 7, sy = slot >> 3;
    const int nsn = NT / SH, nsm = MT >> 3;
    const int st = i * 8 + xcd;
    if (st >= nsm * nsn) return false;
    mt = (st / nsn) * 8 + sx;
    nt = (st % nsn) * SH + sy;
    return true;
  }
  const int it = bid + i * G;
  if (it >= MT * NT) return false;
  mt = it / NT; nt = it % NT;
  return true;
}

DI void phase_gemm_in(const Params& p, int chunk, int l, char* lds) {
  const int NB = p.NB, RL = NB * S, R = NB * (S + L);
  const int MT = R / 256, NT = 40;
  const int tid = otid();
  const int lane = tid & 63, w = tid >> 6, wm = w >> 2, wn = w & 3, r = lane & 31, hh = lane >> 5;
  const u16* Wt = p.WinT + (size_t)l * INW * D;
  for (int ti = 0;; ++ti) {
    int mt, nt;
    if (!tile_map(ti, MT, NT, mt, nt)) break;
    const int m0 = mt * 256, n0 = nt * 256;
    f32x16 acc[4][2];
    gemm_core<256, false>(p.Hb + (size_t)m0 * D, 64, 8192, 131072, Wt + (size_t)n0 * D, 64, 8192, 131072, D, lds, acc);
    {
      int mode = -1; u16* dbase = nullptr; int dld = 0;
      if (nt < 4) { mode = 0; dbase = p.U + nt * 256; dld = D; }
      else if (nt < 8) { mode = 1; dbase = p.Z + (nt - 4) * 256; dld = 3072; }
      else if (nt >= 14 && nt < 18) { mode = 1; dbase = p.Z + 1024 + (nt - 14) * 256; dld = 3072; }
      else if (nt >= 24 && nt < 28) { mode = 1; dbase = p.Z + 2048 + (nt - 24) * 256; dld = 3072; }
      else if (nt >= 28) { mode = 2; dbase = p.Ms + (nt - 28) * 256; dld = 3072; }
      if (mode >= 0) {
#pragma unroll
        for (int i = 0; i < 4; ++i)
#pragma unroll
          for (int j = 0; j < 2; ++j)
#pragma unroll
            for (int g = 0; g < 4; ++g) {
              float v0 = acc[i][j][4 * g], v1 = acc[i][j][4 * g + 1], v2 = acc[i][j][4 * g + 2], v3 = acc[i][j][4 * g + 3];
              if (mode == 1) { v0 = siluf_(v0); v1 = siluf_(v1); v2 = siluf_(v2); v3 = siluf_(v3); }
              else if (mode == 2) { v0 = sigmoidf_(v0); v1 = sigmoidf_(v1); v2 = sigmoidf_(v2); v3 = sigmoidf_(v3); }
              uint2 o; o.x = pack2(v0, v1); o.y = pack2(v2, v3);
              const size_t row = (size_t)m0 + wm * 128 + i * 32 + r;
              const int col = wn * 64 + j * 32 + 8 * g + 4 * hh;
              *(uint2*)(dbase + row * dld + col) = o;
            }
        continue;
      }
    }
    const bool lat = m0 < RL;
    int b, t0;
    if (lat) { b = m0 / S; t0 = m0 % S; } else { int rc = m0 - RL; b = rc / L; t0 = rc % L; }
    const bool isV = (nt == 13 || nt == 23);
    const bool isC = nt >= 18;
    const bool isQ = (nt >= 8 && nt < 12) || (nt >= 18 && nt < 22);
    auto process_unit = [&](int hsel, int u) {
      if (isV) {
        const int slot = (isC ? 2 : 0) + hsel;
        const int d = u >> 2, tq = u & 3;
        const float* Cs = (const float*)lds;
        u16* dst = lat ? p.VtL + ((size_t)(b * 4 + slot) * 128 + d) * S + t0 + tq * 64
                       : p.VtC + ((size_t)(b * 4 + slot) * 128 + d) * L + t0 + tq * 64;
#pragma unroll 1
        for (int c = 0; c < 4; ++c) {
          float v[16];
#pragma unroll
          for (int j = 0; j < 16; ++j) v[j] = Cs[(tq * 64 + c * 16 + j) * 132 + d];
          uint4 o0, o1;
          o0.x = pack2(v[0], v[1]); o0.y = pack2(v[2], v[3]); o0.z = pack2(v[4], v[5]); o0.w = pack2(v[6], v[7]);
          o1.x = pack2(v[8], v[9]); o1.y = pack2(v[10], v[11]); o1.z = pack2(v[12], v[13]); o1.w = pack2(v[14], v[15]);
          *(uint4*)(dst + c * 16) = o0;
          *(uint4*)(dst + c * 16 + 8) = o1;
        }
      } else {
        const int row = u >> 1, half = u & 1;
        const size_t gr = (size_t)m0 + row;
        const int t = t0 + row;
        const float* Cr = (const float*)lds + row * 132 + half * 64;
        float rstd = 1.f;
        const float* gn = (isQ ? p.q_norm_g : p.k_norm_g) + l * 128 + half * 64;
        if (isC) {
          float ss = 0.f;
#pragma unroll
          for (int j = 0; j < 16; ++j) {
            float4 tv = *(const float4*)(Cr + j * 4);
            ss += tv.x * tv.x + tv.y * tv.y + tv.z * tv.z + tv.w * tv.w;
          }
          ss += __shfl_xor(ss, 1);
          rstd = rsqrtf(ss * (1.f / 128.f) + EPS);
        }
        const int pos = (half == 0) ? (t >> 6) : (t & 63);
        const float* cs = p.rope + pos * 32;
        const float* sn = p.rope + 2048 + pos * 32;
        u16* dst;
        if (isQ) {
          const int head = (isC ? (nt - 18) : (nt - 8)) * 2 + hsel;
          dst = p.Q + gr * 2048 + (isC ? 1024 : 0) + head * 128 + half * 64;
        } else {
          dst = p.Kb + gr * 512 + (isC ? 256 : 0) + hsel * 128 + half * 64;
        }
#pragma unroll 1
        for (int c = 0; c < 2; ++c) {
          float x0[16], x1[16];
#pragma unroll
          for (int j = 0; j < 4; ++j) {
            float4 ta_ = *(const float4*)(Cr + c * 16 + j * 4);
            float4 tb_ = *(const float4*)(Cr + 32 + c * 16 + j * 4);
            x0[4 * j] = ta_.x; x0[4 * j + 1] = ta_.y; x0[4 * j + 2] = ta_.z; x0[4 * j + 3] = ta_.w;
            x1[4 * j] = tb_.x; x1[4 * j + 1] = tb_.y; x1[4 * j + 2] = tb_.z; x1[4 * j + 3] = tb_.w;
          }
          if (isC) {
#pragma unroll
            for (int j = 0; j < 16; ++j) { x0[j] = x0[j] * rstd * gn[c * 16 + j]; x1[j] = x1[j] * rstd * gn[32 + c * 16 + j]; }
          }
          if (lat) {
#pragma unroll
            for (int j = 0; j < 16; ++j) {
              float c_ = cs[c * 16 + j], s_ = sn[c * 16 + j];
              float a0 = x0[j], a1 = x1[j];
              x0[j] = a0 * c_ - a1 * s_;
              x1[j] = a1 * c_ + a0 * s_;
            }
          }
          if (isQ) {
#pragma unroll
            for (int j = 0; j < 16; ++j) { x0[j] *= QSCALE; x1[j] *= QSCALE; }
          }
          uint4 o0, o1, o2, o3;
          o0.x = pack2(x0[0], x0[1]); o0.y = pack2(x0[2], x0[3]); o0.z = pack2(x0[4], x0[5]); o0.w = pack2(x0[6], x0[7]);
          o1.x = pack2(x0[8], x0[9]); o1.y = pack2(x0[10], x0[11]); o1.z = pack2(x0[12], x0[13]); o1.w = pack2(x0[14], x0[15]);
          o2.x = pack2(x1[0], x1[1]); o2.y = pack2(x1[2], x1[3]); o2.z = pack2(x1[4], x1[5]); o2.w = pack2(x1[6], x1[7]);
          o3.x = pack2(x1[8], x1[9]); o3.y = pack2(x1[10], x1[11]); o3.z = pack2(x1[12], x1[13]); o3.w = pack2(x1[14], x1[15]);
          *(uint4*)(dst + c * 16) = o0;
          *(uint4*)(dst + c * 16 + 8) = o1;
          *(uint4*)(dst + 32 + c * 16) = o2;
          *(uint4*)(dst + 32 + c * 16 + 8) = o3;
        }
      }
    };
    auto stage_mine = [&]() {
      float* Cs = (float*)lds;
#pragma unroll
      for (int i = 0; i < 4; ++i)
#pragma unroll
        for (int j = 0; j < 2; ++j)
#pragma unroll
          for (int g = 0; g < 4; ++g) {
            int m = wm * 128 + i * 32 + r;
            int n = (wn & 1) * 64 + j * 32 + 8 * g + 4 * hh;
            float4 v; v.x = acc[i][j][4 * g]; v.y = acc[i][j][4 * g + 1]; v.z = acc[i][j][4 * g + 2]; v.w = acc[i][j][4 * g + 3];
            *(float4*)(Cs + m * 132 + n) = v;
          }
    };
    if ((wn >> 1) == 0) {
      const int ta = ((wm * 2 + (wn & 1)) << 6) + lane;
      stage_mine();
      __syncthreads();
      process_unit(0, ta);
      process_unit(0, ta + 256);
      __syncthreads();
      __syncthreads();
      process_unit(1, tid);
      __syncthreads();
    } else {
      __syncthreads();
      __syncthreads();
      stage_mine();
      __syncthreads();
      process_unit(1, tid);
      __syncthreads();
    }
  }
}

struct AttnArgs {
  const u16* q;
  u16* z;
  const u16* kctx;
  const u16* vctx;
  const u16* klat;
  const u16* vlat;
  int n_lat_tiles;
  int lat_key0;
  int q_t0;
  int band;
  int has_sink;
  float sink_l2;
  int dry;
};

DI void attn_load_tile(const AttnArgs& a, int ti, u32x4 (&rk)[2], u32x4 (&rv)[2]) {
  const int tid = otid();
  const u16* kp; const u16* vp; int vs;
  if (ti < 4) { kp = a.kctx + (size_t)(ti * 64) * 512; vp = a.vctx + ti * 64; vs = L; }
  else { kp = a.klat + (size_t)((ti - 4) * 64) * 512; vp = a.vlat + (ti - 4) * 64; vs = S; }
#pragma unroll
  for (int i = 0; i < 2; ++i) {
    int c = tid + NTHR * i;
    rk[i] = *(const u32x4*)(kp + (size_t)(c >> 4) * 512 + (c & 15) * 8);
    rv[i] = *(const u32x4*)(vp + (size_t)(c >> 3) * vs + (c & 7) * 8);
  }
}
DI void attn_store_tile(u16* sK, u16* sV, const u32x4 (&rk)[2], const u32x4 (&rv)[2]) {
  const int tid = otid();
#pragma unroll
  for (int i = 0; i < 2; ++i) {
    int c = tid + NTHR * i;
    *(u32x4*)(sK + (c >> 4) * 136 + (c & 15) * 8) = rk[i];
    u16* vd = sV + (c >> 3) * 68 + (c & 7) * 8;
    { u32x2 t0 = {rv[i].x, rv[i].y}; *(u32x2*)(vd) = t0; }
    { u32x2 t1 = {rv[i].z, rv[i].w}; *(u32x2*)(vd + 4) = t1; }
  }
}

DI void attn_item(const AttnArgs& a, char* lds) {
  const int tid = otid(), lane = tid & 63, w = tid >> 6;
  const int r = lane & 31, hh = lane >> 5;
  constexpr int STG = 34816;
  const int ntiles = 4 + a.n_lat_tiles;

  bf16x8 qf[8];
  {
    const u16* qp = a.q + (size_t)(w * 32 + r) * 2048 + hh * 8;
#pragma unroll
    for (int ks = 0; ks < 8; ++ks) qf[ks] = *(const bf16x8*)(qp + ks * 16);
  }
  f32x16 O[4];
#pragma unroll
  for (int dt = 0; dt < 4; ++dt)
#pragma unroll
    for (int x = 0; x < 16; ++x) O[dt][x] = 0.f;
  float m = a.has_sink ? a.sink_l2 : -1e30f;
  float lsum = (a.has_sink && hh == 0) ? 1.f : 0.f;
  const int qpos = a.q_t0 + w * 32 + r;

  auto QK = [&](int stage, f32x16 (&sc)[2]) {
    const u16* sK = (const u16*)(lds + stage * STG);
#pragma unroll
    for (int kt2 = 0; kt2 < 2; ++kt2) {
#pragma unroll
      for (int x = 0; x < 16; ++x) sc[kt2][x] = 0.f;
      const u16* kb = sK + (kt2 * 32 + r) * 136 + hh * 8;
#pragma unroll
      for (int ks = 0; ks < 8; ++ks) {
        bf16x8 ka = *(const bf16x8*)(kb + ks * 16);
        sc[kt2] = MFMA32(ka, qf[ks], sc[kt2]);
      }
    }
  };
  u32x4 rk[2], rv[2];
  auto STEP = [&](int ti, int st, f32x16 (&sc)[2], f32x16 (&sn)[2]) {
    const int st1 = (st == 2) ? 0 : st + 1, st2 = (st == 0) ? 2 : st - 1;
    if (ti + 2 < ntiles) attn_load_tile(a, ti + 2, rk, rv);
    if (ti + 1 < ntiles) QK(st1, sn);
    if (a.band && ti >= 4) {
      const int k0 = a.lat_key0 + (ti - 4) * 64;
#pragma unroll
      for (int kt2 = 0; kt2 < 2; ++kt2)
#pragma unroll
        for (int x = 0; x < 16; ++x) {
          int kp = k0 + kt2 * 32 + crow(x, hh);
          int dlt = kp - qpos; dlt = dlt < 0 ? -dlt : dlt;
          if (dlt > 128) sc[kt2][x] = -1e30f;
        }
    }
    float mx = sc[0][0];
#pragma unroll
    for (int kt2 = 0; kt2 < 2; ++kt2)
#pragma unroll
      for (int x = 0; x < 16; ++x) mx = fmaxf(mx, sc[kt2][x]);
    mx = fmaxf(mx, __shfl_xor(mx, 32));
    if (__any(mx > m + 8.f)) {
      const float mnew = fmaxf(m, mx);
      const float alpha = __builtin_amdgcn_exp2f(m - mnew);
      m = mnew;
      lsum *= alpha;
#pragma unroll
      for (int dt = 0; dt < 4; ++dt)
#pragma unroll
        for (int x = 0; x < 16; ++x) O[dt][x] *= alpha;
    }
    float ps = 0.f;
#pragma unroll
    for (int kt2 = 0; kt2 < 2; ++kt2)
#pragma unroll
      for (int x = 0; x < 16; ++x) { float pv = __builtin_amdgcn_exp2f(sc[kt2][x] - m); sc[kt2][x] = pv; ps += pv; }
    lsum += ps;
    const u16* sV = (const u16*)(lds + st * STG + 17408);
#pragma unroll
    for (int kt2 = 0; kt2 < 2; ++kt2)
#pragma unroll
      for (int s2 = 0; s2 < 2; ++s2) {
        union { unsigned u[4]; bf16x8 v; } pf;
#pragma unroll
        for (int j = 0; j < 4; ++j) pf.u[j] = pack2(sc[kt2][8 * s2 + 2 * j], sc[kt2][8 * s2 + 2 * j + 1]);
        const u16* vb = sV + r * 68 + kt2 * 32 + 16 * s2 + 4 * hh;
#pragma unroll
        for (int dt = 0; dt < 4; ++dt) {
          s16x4 lo = *(const s16x4*)(vb + dt * 32 * 68);
          s16x4 hi = *(const s16x4*)(vb + dt * 32 * 68 + 8);
          bf16x8 va = __builtin_shufflevector(lo, hi, 0, 1, 2, 3, 4, 5, 6, 7);
          O[dt] = MFMA32(va, pf.v, O[dt]);
        }
      }
    if (ti + 2 < ntiles) attn_store_tile((u16*)(lds + st2 * STG), (u16*)(lds + st2 * STG + 17408), rk, rv);
    __syncthreads();
  };

  attn_load_tile(a, 0, rk, rv);
  __syncthreads();
  attn_store_tile((u16*)lds, (u16*)(lds + 17408), rk, rv);
  attn_load_tile(a, 1, rk, rv);
  attn_store_tile((u16*)(lds + STG), (u16*)(lds + STG + 17408), rk, rv);
  __syncthreads();
  f32x16 sA[2], sB[2];
  QK(0, sA);
  int st = 0;
  for (int ti = 0; ti < ntiles; ti += 2) {
    STEP(ti, st, sA, sB);
    st = (st == 2) ? 0 : st + 1;
    if (ti + 1 < ntiles) {
      STEP(ti + 1, st, sB, sA);
      st = (st == 2) ? 0 : st + 1;
    }
  }
  float ltot = lsum + __shfl_xor(lsum, 32);
  const float inv = 1.f / ltot;
  u16* zp = a.z + (size_t)(w * 32 + r) * 3072;
  u32x2 gv[4][4];
#pragma unroll
  for (int dt = 0; dt < 4; ++dt)
#pragma unroll
    for (int g4 = 0; g4 < 4; ++g4) gv[dt][g4] = *(const u32x2*)(zp + dt * 32 + 8 * g4 + 4 * hh);
#pragma unroll
  for (int dt = 0; dt < 4; ++dt)
#pragma unroll
    for (int g4 = 0; g4 < 4; ++g4) {
      int d0 = dt * 32 + 8 * g4 + 4 * hh;
      float y0 = O[dt][4 * g4 + 0] * inv * bflo(gv[dt][g4].x);
      float y1 = O[dt][4 * g4 + 1] * inv * bfhi(gv[dt][g4].x);
      float y2 = O[dt][4 * g4 + 2] * inv * bflo(gv[dt][g4].y);
      float y3 = O[dt][4 * g4 + 3] * inv * bfhi(gv[dt][g4].y);
      uint2 o; o.x = pack2(y0, y1); o.y = pack2(y2, y3);
      if (!a.dry || y0 != y0) *(uint2*)(zp + d0) = o;
    }
}

template <bool REV>
DI void lru_scan(float (&av)[2][16], float (&bv)[2][16], float& carry, int hh) {
  float segA[8], segB[8];
#pragma unroll
  for (int k = 0; k < 8; ++k) {
    const int mt = k >> 2, q = k & 3;
    float cA = 1.f, hl = 0.f;
#pragma unroll
    for (int jj = 0; jj < 4; ++jj) {
      const int j = REV ? 3 - jj : jj;
      const int i = 4 * q + j;
      hl = av[mt][i] * hl + bv[mt][i];
      cA *= av[mt][i];
      av[mt][i] = cA; bv[mt][i] = hl;
    }
    segA[k] = cA; segB[k] = hl;
  }
  float oA[8], oB[8];
#pragma unroll
  for (int k = 0; k < 8; ++k) { oA[k] = __shfl_xor(segA[k], 32); oB[k] = __shfl_xor(segB[k], 32); }
  float init[8];
  float st = carry;
#pragma unroll
  for (int kk = 0; kk < 8; ++kk) {
    const int k = REV ? 7 - kk : kk;
    const int first = REV ? 1 : 0;
    float A1 = (hh == first) ? segA[k] : oA[k];
    float B1 = (hh == first) ? segB[k] : oB[k];
    float st0 = st;
    st = A1 * st + B1;
    float A2 = (hh == first) ? oA[k] : segA[k];
    float B2 = (hh == first) ? oB[k] : segB[k];
    float st1 = st;
    st = A2 * st + B2;
    init[k] = (hh == first) ? st0 : st1;
  }
  carry = st;
#pragma unroll
  for (int k = 0; k < 8; ++k) {
    const int mt = k >> 2, q = k & 3;
#pragma unroll
    for (int j = 0; j < 4; ++j) {
      const int i = 4 * q + j;
      bv[mt][i] = bv[mt][i] + av[mt][i] * init[k];
    }
  }
}

DI void lru_item(const Params& p, int l, int b, int n, bool last, char* lds, int dry = 0) {
  const int NB = p.NB, RL = NB * S;
  const int tid = otid(), lane = tid & 63, w8 = tid >> 6;
  const int sub = __builtin_amdgcn_readfirstlane(w8 >> 2), w = w8 & 3;
  n = n + sub;
  lds += sub * 73728;
  const int dir = w >> 1, w2 = w & 1;
  const int tl = tid & 127;
  const int r = lane & 31, hh = lane >> 5;
  u16* sRaw = (u16*)lds + dir * (8704 / 2);
  u16* sUp = (u16*)(lds + 17408) + dir * (9216 / 2);
  float* sH = (float*)(lds + 35840) + w * (64 * 36);

  const int chb = n * 64;
  const int cp = (tl & 31) * 2, tg = tl >> 5;
  float cw0[4], cw1[4], cb0, cb1;
#pragma unroll
  for (int k = 0; k < 4; ++k) {
    cw0[k] = p.conv_w[((size_t)l * 4 + k) * D + chb + cp];
    cw1[k] = p.conv_w[((size_t)l * 4 + k) * D + chb + cp + 1];
  }
  cb0 = p.conv_b[l * D + chb + cp]; cb1 = p.conv_b[l * D + chb + cp + 1];
  bf16x8 waf[4], wxf[4];
  {
    const float* wa = p.lru_wa + (((size_t)(l * 2 + dir) * 16 + n) * 64) * 64;
    const float* wx = p.lru_wx + (((size_t)(l * 2 + dir) * 16 + n) * 64) * 64;
    const int e = 32 * w2 + r;
#pragma unroll
    for (int ks = 0; ks < 4; ++ks) {
      union { unsigned u[4]; bf16x8 v; } fa, fx;
#pragma unroll
      for (int j = 0; j < 4; ++j) {
        int d0 = ks * 16 + 8 * hh + 2 * j;
        fa.u[j] = pack2(wa[d0 * 64 + e], wa[(d0 + 1) * 64 + e]);
        fx.u[j] = pack2(wx[d0 * 64 + e], wx[(d0 + 1) * 64 + e]);
      }
      waf[ks] = fa.v; wxf[ks] = fx.v;
    }
  }
  const int che = chb + 32 * w2 + r;
  const float ba = p.lru_ba[(l * 2 + dir) * D + che];
  const float bx = p.lru_bx[(l * 2 + dir) * D + che];
  float c8sp;
  {
    float lam = p.lru_lambda[(l * 2 + dir) * D + che];
    float sp = (lam < -20.f) ? -lam : log1pf(expf(-lam));
    c8sp = 8.f * sp;
  }
  float carry = 0.f;

  auto step_tile = [&](int st, bool& isctx, int& tt) {
    if (dir == 0) { if (st < 4) { isctx = true; tt = st; } else { isctx = false; tt = st - 4; } }
    else { if (st < 4) { isctx = true; tt = 3 - st; } else { isctx = false; tt = 63 - (st - 4); } }
  };
  u32x4 pre[5];
  auto load_raw = [&](int st) {
    bool isctx; int tt; step_tile(st, isctx, tt);
    const int seqlen = isctx ? L : S;
    const size_t rowbase = isctx ? (size_t)RL + (size_t)b * L : (size_t)b * S;
    const int t0 = tt * 64;
#pragma unroll
    for (int i = 0; i < 5; ++i) {
      int c = tl + 128 * i;
      int rr = c >> 3, c16 = c & 7;
      int t = t0 - 2 + rr;
      u32x4 v = {0u, 0u, 0u, 0u};
      if (rr < 67 && t >= 0 && t < seqlen) v = *(const u32x4*)(p.U + (rowbase + t) * D + chb + c16 * 8);
      pre[i] = v;
    }
  };
  load_raw(0);
  __syncthreads();
  for (int st = 0; st < 68; ++st) {
    bool isctx; int tt; step_tile(st, isctx, tt);
    const size_t rowbase = isctx ? (size_t)RL + (size_t)b * L : (size_t)b * S;
    const int t0 = tt * 64;
#pragma unroll
    for (int i = 0; i < 5; ++i) {
      int c = tl + 128 * i;
      int rr = c >> 3, c16 = c & 7;
      if (rr < 67) *(u32x4*)(sRaw + rr * 64 + c16 * 8) = pre[i];
    }
    if (st + 1 < 68) load_raw(st + 1);
    __syncthreads();
    {
      const u16* rp = sRaw + (tg * 16) * 64 + cp;
      unsigned r0 = *(const unsigned*)(rp), r1 = *(const unsigned*)(rp + 64), r2 = *(const unsigned*)(rp + 128);
#pragma unroll
      for (int i = 0; i < 16; ++i) {
        unsigned r3 = *(const unsigned*)(rp + (i + 3) * 64);
        float o0 = cb0 + cw0[0] * bflo(r0) + cw0[1] * bflo(r1) + cw0[2] * bflo(r2) + cw0[3] * bflo(r3);
        float o1 = cb1 + cw1[0] * bfhi(r0) + cw1[1] * bfhi(r1) + cw1[2] * bfhi(r2) + cw1[3] * bfhi(r3);
        *(unsigned*)(sUp + (tg * 16 + i) * 72 + cp) = pack2(o0, o1);
        r0 = r1; r1 = r2; r2 = r3;
      }
    }
    __syncthreads();
    const bool fwd_first = isctx ? (tt <= 1) : (tt <= 31);
    const bool first = (dir == 0) ? fwd_first : !fwd_first;
    unsigned long long pt0[4], pt1[4];
    u32x4 pg[4];
    if (!first && !(isctx && last)) {
#pragma unroll
      for (int j = 0; j < 4; ++j) {
        const int q = lane + 64 * j;
        const int tok = q >> 2, cc = (q & 3) * 8;
        const size_t row = rowbase + t0 + tok;
        const int col = chb + 32 * w2 + cc;
        const u16* tp = p.Hb + row * D + col;
        pt0[j] = __hip_atomic_load((const unsigned long long*)tp, __ATOMIC_RELAXED, __HIP_MEMORY_SCOPE_AGENT);
        pt1[j] = __hip_atomic_load((const unsigned long long*)tp + 1, __ATOMIC_RELAXED, __HIP_MEMORY_SCOPE_AGENT);
        pg[j] = *(const u32x4*)(p.Z + row * 3072 + col);
      }
    } else {
#pragma unroll
      for (int j = 0; j < 4; ++j) { pt0[j] = 0; pt1[j] = 0; pg[j] = u32x4{0u, 0u, 0u, 0u}; }
    }
    float av[2][16], bv[2][16];
    {
      f32x16 aR[2];
#pragma unroll
      for (int mt = 0; mt < 2; ++mt) {
#pragma unroll
        for (int x = 0; x < 16; ++x) aR[mt][x] = 0.f;
        const u16* ub = sUp + (mt * 32 + r) * 72 + hh * 8;
#pragma unroll
        for (int ks = 0; ks < 4; ++ks) aR[mt] = MFMA32(*(const bf16x8*)(ub + ks * 16), waf[ks], aR[mt]);
      }
#pragma unroll
      for (int mt = 0; mt < 2; ++mt)
#pragma unroll
        for (int x = 0; x < 16; ++x) {
          const float rg = sigmoidf_(aR[mt][x] + ba);
          av[mt][x] = -c8sp * rg;
        }
    }
    {
      f32x16 aI[2];
#pragma unroll
      for (int mt = 0; mt < 2; ++mt) {
#pragma unroll
        for (int x = 0; x < 16; ++x) aI[mt][x] = 0.f;
        const u16* ub = sUp + (mt * 32 + r) * 72 + hh * 8;
#pragma unroll
        for (int ks = 0; ks < 4; ++ks) aI[mt] = MFMA32(*(const bf16x8*)(ub + ks * 16), wxf[ks], aI[mt]);
      }
#pragma unroll
      for (int mt = 0; mt < 2; ++mt)
#pragma unroll
        for (int x = 0; x < 16; ++x) {
          const int tok = mt * 32 + crow(x, hh);
          const float up = bf2f(sUp[tok * 72 + 32 * w2 + r]);
          const float ig = sigmoidf_(aI[mt][x] + bx);
          const float la = av[mt][x];
          const float a_ = __expf(la);
          const float om = fmaxf(1.f - a_ * a_, 0.f);
          av[mt][x] = a_;
          bv[mt][x] = __builtin_amdgcn_sqrtf(om) * (ig * up);
        }
    }
    if (dir == 0) lru_scan<false>(av, bv, carry, hh); else lru_scan<true>(av, bv, carry, hh);
#pragma unroll
    for (int mt = 0; mt < 2; ++mt)
#pragma unroll
      for (int x = 0; x < 16; ++x) sH[(mt * 32 + crow(x, hh)) * 36 + r] = bv[mt][x];
    if (!(isctx && last)) {
#pragma unroll
      for (int j = 0; j < 4; ++j) {
        const int q = lane + 64 * j;
        const int tok = q >> 2, cc = (q & 3) * 8;
        const float4 h0 = *(const float4*)(sH + tok * 36 + cc);
        const float4 h1 = *(const float4*)(sH + tok * 36 + cc + 4);
        const size_t row = rowbase + t0 + tok;
        const int col = chb + 32 * w2 + cc;
        u16* tp = p.Hb + row * D + col;
        if (first) {
          uint4 o; o.x = pack2(h0.x, h0.y); o.y = pack2(h0.z, h0.w); o.z = pack2(h1.x, h1.y); o.w = pack2(h1.z, h1.w);
          if (!dry || h0.x != h0.x) *(uint4*)tp = o;
        } else {
          unsigned tx = (unsigned)pt0[j], ty = (unsigned)(pt0[j] >> 32), tz = (unsigned)pt1[j], tw = (unsigned)(pt1[j] >> 32);
          u16* zp = p.Z + row * 3072 + col;
          u32x4 g = pg[j];
          uint4 o;
          o.x = pack2((h0.x + bflo(tx)) * bflo(g.x), (h0.y + bfhi(tx)) * bfhi(g.x));
          o.y = pack2((h0.z + bflo(ty)) * bflo(g.y), (h0.w + bfhi(ty)) * bfhi(g.y));
          o.z = pack2((h1.x + bflo(tz)) * bflo(g.z), (h1.y + bfhi(tz)) * bfhi(g.z));
          o.w = pack2((h1.z + bflo(tw)) * bflo(g.w), (h1.w + bfhi(tw)) * bfhi(g.w));
          if (!dry || h0.x != h0.x) *(uint4*)zp = o;
        }
      }
    }
    __builtin_amdgcn_fence(__ATOMIC_RELEASE, "workgroup");
  }
}

DI void phase_mixers(const Params& p, int chunk, int l, char* lds, int dry = 0) {
  const int NB = p.NB, RL = NB * S;
  const bool last = (l == DEPTH - 1);
  const int nLRU = (dry == 1) ? 0 : NB * 8, nC = (dry == 2) ? 0 : NB * 8 * 16, nBw = (dry == 2) ? 0 : NB * 8 * 16, nCtx = (last || dry == 2) ? 0 : NB * 8 * 2;
  const int total = nLRU + nC + nBw + nCtx;
  int* ctr = p.ctr + chunk * DEPTH + l + (dry ? 32 : 0);
  int* s_item = (int*)(lds + LDS_BYTES - 16);
  int it;
  while (true) {
    __syncthreads();
    if (threadIdx.x == 0) *s_item = atomicAdd(ctr, 1);
    __syncthreads();
    it = __builtin_amdgcn_readfirstlane(*s_item);
    __syncthreads();
    if (it >= nLRU) break;
    lru_item(p, l, it >> 3, (it & 7) * 2, last, lds, dry);
  }
  bool have = true;
  while (true) {
    if (!have) {
      __syncthreads();
      if (threadIdx.x == 0) *s_item = atomicAdd(ctr, 1);
      __syncthreads();
      it = __builtin_amdgcn_readfirstlane(*s_item);
      __syncthreads();
    }
    have = false;
    if (it >= total) break;
    it -= nLRU;
    AttnArgs a;
    a.dry = dry;
    if (it < nC + nBw) {
      const bool isB = it >= nC;
      if (isB) it -= nC;
      const int b = it >> 7, h = (it >> 4) & 7, qb = it & 15;
      const int kvh = h >> 2;
      const int br = isB ? 0 : 1;
      const size_t qrow0 = (size_t)b * S + qb * 256;
      a.q = p.Q + qrow0 * 2048 + br * 1024 + h * 128;
      a.z = p.Z + qrow0 * 3072 + (br + 1) * 1024 + h * 128;
      const int kcol = br * 256 + kvh * 128, slot = br * 2 + kvh;
      a.kctx = p.Kb + ((size_t)RL + (size_t)b * L) * 512 + kcol;
      a.vctx = p.VtC + (size_t)(b * 4 + slot) * 128 * L;
      int k0, k1;
      if (isB) { k0 = qb * 256 - 128; if (k0 < 0) k0 = 0; k1 = qb * 256 + 384; if (k1 > S) k1 = S; }
      else { k0 = 0; k1 = S; }
      a.lat_key0 = k0;
      a.n_lat_tiles = (k1 - k0) >> 6;
      a.klat = p.Kb + ((size_t)b * S + k0) * 512 + kcol;
      a.vlat = p.VtL + (size_t)(b * 4 + slot) * 128 * S + k0;
      a.q_t0 = qb * 256;
      a.band = isB ? 1 : 0;
      a.has_sink = isB ? 1 : 0;
      a.sink_l2 = isB ? p.attn_sink[l * 8 + h] * LOG2E : 0.f;
    } else {
      it -= nC + nBw;
      const int h = it & 7, br = (it >> 3) & 1, b = it >> 4;
      const int kvh = h >> 2;
      const size_t qrow0 = (size_t)RL + (size_t)b * L;
      a.q = p.Q + qrow0 * 2048 + br * 1024 + h * 128;
      a.z = p.Z + qrow0 * 3072 + (br + 1) * 1024 + h * 128;
      const int kcol = br * 256 + kvh * 128, slot = br * 2 + kvh;
      a.kctx = p.Kb + ((size_t)RL + (size_t)b * L) * 512 + kcol;
      a.vctx = p.VtC + (size_t)(b * 4 + slot) * 128 * L;
      a.klat = a.kctx; a.vlat = a.vctx;
      a.n_lat_tiles = 0; a.lat_key0 = 0; a.q_t0 = 0; a.band = 0;
      a.has_sink = (br == 0) ? 1 : 0;
      a.sink_l2 = (br == 0) ? p.attn_sink[l * 8 + h] * LOG2E : 0.f;
    }
    attn_item(a, lds);
  }
}

DI void phase_merge(const Params& p, int chunk, int l, char* lds) {
  const int NB = p.NB, RL = NB * S, R = NB * (S + L);
  const bool last = (l == DEPTH - 1);
  const int MT = (last ? RL : R) / 256, NT = 8;
  const int tid = otid();
  const int lane = tid & 63, w = tid >> 6, wm = w >> 1, wn = w & 1, r = lane & 31, hh = lane >> 5;
  for (int ti = 0;; ++ti) {
    int mt, nt;
    if (!tile_map(ti, MT, NT, mt, nt)) break;
    const int m0 = mt * 256, n0 = nt * 128;
    f32x16 tot[2][2];
#pragma unroll
    for (int i = 0; i < 2; ++i)
#pragma unroll
      for (int j = 0; j < 2; ++j)
#pragma unroll
        for (int x = 0; x < 16; ++x) tot[i][j][x] = 0.f;
#pragma unroll 1
    for (int n = 0; n < 3; ++n) {
      f32x16 acc[2][2];
      gemm_core<128, false>(p.Z + (size_t)m0 * 3072 + n * 1024, 3072, 64, (size_t)128 * 3072,
                            p.WbT + ((size_t)(l * 3 + n) * D + n0) * D, 64, 8192, 0, D, lds, acc);
#pragma unroll
      for (int i = 0; i < 2; ++i)
#pragma unroll
        for (int j = 0; j < 2; ++j)
#pragma unroll
          for (int g = 0; g < 4; ++g) {
            const size_t row = (size_t)m0 + wm * 64 + i * 32 + r;
            const int col = n0 + wn * 64 + j * 32 + 8 * g + 4 * hh;
            uint2 sv = *(const uint2*)(p.Ms + row * 3072 + n * 1024 + col);
            tot[i][j][4 * g + 0] += bflo(sv.x) * acc[i][j][4 * g + 0];
            tot[i][j][4 * g + 1] += bfhi(sv.x) * acc[i][j][4 * g + 1];
            tot[i][j][4 * g + 2] += bflo(sv.y) * acc[i][j][4 * g + 2];
            tot[i][j][4 * g + 3] += bfhi(sv.y) * acc[i][j][4 * g + 3];
          }
    }
#pragma unroll
    for (int i = 0; i < 2; ++i)
#pragma unroll
      for (int j = 0; j < 2; ++j)
#pragma unroll
        for (int g = 0; g < 4; ++g) {
          const size_t row = (size_t)m0 + wm * 64 + i * 32 + r;
          const int col = n0 + wn * 64 + j * 32 + 8 * g + 4 * hh;
          uint2 o; o.x = pack2(tot[i][j][4 * g], tot[i][j][4 * g + 1]); o.y = pack2(tot[i][j][4 * g + 2], tot[i][j][4 * g + 3]);
          *(uint2*)(p.Hb + ((row >> 7) * 16 + (col >> 6)) * 8192 + (row & 127) * 64 + (col & 63)) = o;
        }
  }
}

DI void phase_outproj(const Params& p, int chunk, int l, char* lds) {
  const int NB = p.NB, RL = NB * S, R = NB * (S + L);
  const bool last = (l == DEPTH - 1);
  const int MT = (last ? RL : R) / 256, NT = 8;
  const int tid = otid();
  const int w = tid >> 6, wm = w >> 1, wn = w & 1;
  for (int ti = 0;; ++ti) {
    int mt, nt;
    if (!tile_map(ti, MT, NT, mt, nt)) break;
    const int m0 = mt * 256, n0 = nt * 128;
    f32x16 acc[2][2];
    gemm_core<128, true>(p.Hb + (size_t)m0 * D, 64, 8192, 131072, p.WoT + ((size_t)l * D + n0) * D, 64, 8192, 0, D, lds, acc);
    stage_acc<2>(lds, acc, wm, wn * 64, true);
    const int row = tid >> 1, half = tid & 1;
    const int gr = m0 + row;
    const float* src; float* dst; int mrow;
    if (gr < RL) {
      int b = gr / S, t = gr % S; int bg = chunk * NB + b;
      size_t off = ((size_t)bg * S + t) * D + n0 + half * 64;
      src = (l == 0 ? p.x : p.out) + off; dst = p.out + off; mrow = bg;
    } else {
      int rc = gr - RL; int b = rc / L, t = rc % L; int bg = chunk * NB + b;
      size_t off = ((size_t)bg * L + t) * D + n0 + half * 64;
      src = (l == 0 ? p.ctx : p.xc) + off; dst = p.xc + off; mrow = 16;
    }
    const float* gate = p.modv + ((size_t)l * 17 + mrow) * 3072 + 2048 + n0 + half * 64;
    const float* Cs = (const float*)lds + row * 132 + half * 64;
    float4 xv[16], gv[16];
#pragma unroll
    for (int j = 0; j < 16; ++j) { xv[j] = *(const float4*)(src + j * 4); gv[j] = *(const float4*)(gate + j * 4); }
#pragma unroll
    for (int j = 0; j < 16; ++j) {
      float4 cv = *(const float4*)(Cs + j * 4);
      float4 o;
      o.x = xv[j].x + gv[j].x * cv.x; o.y = xv[j].y + gv[j].y * cv.y; o.z = xv[j].z + gv[j].z * cv.z; o.w = xv[j].w + gv[j].w * cv.w;
      *(float4*)(dst + j * 4) = o;
    }
  }
}

DI void phase_final(const Params& p) {
  const int tid_ = otid();
  const int lane = tid_ & 63;
  const int wg = blockIdx.x * 8 + (tid_ >> 6), nw = gridDim.x * 8;
  for (int r = wg; r < NBATCH * S; r += nw) {
    float* src = p.out + (size_t)r * D;
    float4 v[4]; float ss = 0.f;
#pragma unroll
    for (int i = 0; i < 4; ++i) {
      v[i] = *(const float4*)(src + i * 256 + lane * 4);
      ss += v[i].x * v[i].x + v[i].y * v[i].y + v[i].z * v[i].z + v[i].w * v[i].w;
    }
#pragma unroll
    for (int o = 32; o >= 1; o >>= 1) ss += __shfl_xor(ss, o);
    float rstd = rsqrtf(ss * (1.f / D) + EPS);
#pragma unroll
    for (int i = 0; i < 4; ++i) {
      int cidx = i * 256 + lane * 4;
      float4 gg = *(const float4*)(p.final_g + cidx);
      float4 o;
      o.x = v[i].x * rstd * gg.x; o.y = v[i].y * rstd * gg.y; o.z = v[i].z * rstd * gg.z; o.w = v[i].w * rstd * gg.w;
      *(float4*)(src + cidx) = o;
    }
  }
}

#ifndef DUP_PHASE
#define DUP_PHASE 0
#endif
__global__ void __launch_bounds__(NTHR, 2) fwd_megakernel(Params p) {
  cg::grid_group grid = cg::this_grid();
  __shared__ __attribute__((aligned(16))) char lds[LDS_BYTES];
  phase0(p, lds);
  grid.sync();
  phase_mod(p, lds);
  grid.sync();
  for (int chunk = 0; chunk < p.nchunk; ++chunk) {
    for (int l = 0; l < DEPTH; ++l) {
      phase_prenorm(p, chunk, l);
      grid.sync();
      phase_gemm_in(p, chunk, l, lds);
      grid.sync();
#if DUP_PHASE == 3
      phase_gemm_in(p, chunk, l, lds);
      grid.sync();
#endif
#if DUP_PHASE == 4
      phase_mixers(p, chunk, l, lds, 1);
      grid.sync();
#endif
#if DUP_PHASE == 6
      phase_mixers(p, chunk, l, lds, 2);
      grid.sync();
#endif
      phase_mixers(p, chunk, l, lds);
      grid.sync();
      phase_merge(p, chunk, l, lds);
      grid.sync();
#if DUP_PHASE == 5
      phase_merge(p, chunk, l, lds);
      grid.sync();
#endif
      phase_outproj(p, chunk, l, lds);
      grid.sync();
    }
  }
  phase_final(p);
}

extern "C" void kernel_launch(void* const* d_in, const int* in_sizes, int n_in,
                              void* d_out, int out_size, void* d_ws, size_t ws_size,
                              hipStream_t stream) {
  static int grid_blocks = 0;
  if (!grid_blocks) {
    int dev = 0, cus = 0, per_cu = 0;
    (void)hipGetDevice(&dev);
    (void)hipDeviceGetAttribute(&cus, hipDeviceAttributeMultiprocessorCount, dev);
    (void)hipOccupancyMaxActiveBlocksPerMultiprocessor(&per_cu, fwd_megakernel, NTHR, 0);
    if (per_cu > 1) per_cu = 1;
    if (per_cu < 1) per_cu = 1;
    grid_blocks = cus * per_cu;
  }
  Params p{};
  const float* const* in = (const float* const*)d_in;
  p.x = in[0]; p.c = in[1]; p.ctx = in[2]; p.c_ctx = in[3]; p.norm_g = in[4]; p.w_mod = in[5]; p.b_mod = in[6];
  p.w_in = in[7]; p.conv_w = in[8]; p.conv_b = in[9]; p.lru_wa = in[10]; p.lru_ba = in[11]; p.lru_wx = in[12];
  p.lru_bx = in[13]; p.lru_lambda = in[14]; p.attn_sink = in[15]; p.q_norm_g = in[16]; p.k_norm_g = in[17];
  p.w_branch = in[18]; p.w_out = in[19]; p.final_g = in[20];
  p.out = (float*)d_out;
  char* ws = (char*)d_ws;
  size_t off = 0;
  auto take = [&](size_t bytes) { char* r = ws + off; off += (bytes + 255) & ~(size_t)255; return r; };
  p.ctr = (int*)take(256);
  p.modv = (float*)take((size_t)DEPTH * 17 * 3072 * 4);
  p.sc = (float*)take((size_t)17 * D * 4);
  p.rope = (float*)take(4096 * 4);
  p.xc = (float*)take((size_t)NBATCH * L * D * 4);
  p.WinT = (u16*)take((size_t)DEPTH * INW * D * 2);
  p.WbT = (u16*)take((size_t)DEPTH * 3 * D * D * 2);
  p.WoT = (u16*)take((size_t)DEPTH * D * D * 2);
  const size_t fixed = off;
  int NB = 8;
  while (NB > 1) {
    size_t R = (size_t)NB * (S + L);
    size_t need = fixed + R * (size_t)(1024 + 1024 + 3072 + 2048 + 512 + 512 + 3072) * 2 + 8 * 256;
    if (need <= ws_size) break;
    NB >>= 1;
  }
  p.NB = NB; p.nchunk = NBATCH / NB;
  const size_t R = (size_t)NB * (S + L);
  p.Hb = (u16*)take(R * 1024 * 2);
  p.U = (u16*)take(R * 1024 * 2);
  p.Z = (u16*)take(R * 3072 * 2);
  p.Q = (u16*)take(R * 2048 * 2);
  p.Kb = (u16*)take(R * 512 * 2);
  p.VtL = (u16*)take((size_t)NB * 4 * 128 * S * 2);
  p.VtC = (u16*)take((size_t)NB * 4 * 128 * L * 2);
  p.Ms = (u16*)take(R * 3072 * 2);
  void* args[] = {&p};
  hipError_t e = hipLaunchCooperativeKernel((void*)fwd_megakernel, dim3(grid_blocks), dim3(NTHR), args, 0, stream);
  if (e != hipSuccess) fprintf(stderr, "cooperative launch failed: %s (grid %d)\n", hipGetErrorString(e), grid_blocks);
}
```

```cpp
#include <hip/hip_runtime.h>
#include <hip/hip_cooperative_groups.h>
#include <cstdio>
#include <cstdint>
namespace cg = cooperative_groups;

typedef unsigned short u16;
typedef __attribute__((ext_vector_type(8))) short bf16x8;
typedef __attribute__((ext_vector_type(4))) short s16x4;
typedef __attribute__((ext_vector_type(16))) float f32x16;
typedef __bf16 bf16x2_t __attribute__((ext_vector_type(2)));
typedef float float2_t __attribute__((ext_vector_type(2)));
typedef __attribute__((ext_vector_type(4))) unsigned u32x4;
typedef __attribute__((ext_vector_type(2))) unsigned u32x2;

#define DI __device__ __forceinline__
#define MFMA32(a, b, c) __builtin_amdgcn_mfma_f32_32x32x16_bf16((a), (b), (c), 0, 0, 0)

constexpr int D = 1024, NBATCH = 16, S = 4096, L = 256, DEPTH = 4, INW = 10240;
constexpr int LDS_BYTES = 147456;
constexpr int NTHR = 512;
constexpr float EPS = 1e-6f;
constexpr float QSCALE = 0.08838834764831845f * 1.4426950408889634f;
constexpr float LOG2E = 1.4426950408889634f;

struct Params {
  const float *x, *c, *ctx, *c_ctx, *norm_g, *w_mod, *b_mod, *w_in, *conv_w, *conv_b, *lru_wa, *lru_ba, *lru_wx, *lru_bx,
      *lru_lambda, *attn_sink, *q_norm_g, *k_norm_g, *w_branch, *w_out, *final_g;
  float* out;
  u16 *WinT, *WbT, *WoT;
  u16 *Hb, *U, *Z, *Q, *Kb, *VtL, *VtC, *Ms;
  float *modv, *sc, *rope, *xc;
  int* ctr;
  int NB;
  int nchunk;
};

typedef const __attribute__((address_space(4))) Params CParams;
DI CParams* opaque_kp(CParams* q) { asm volatile("" : "+s"(q)); return q; }

DI unsigned pack2(float a, float b) {
  float2_t f = {a, b};
  bf16x2_t v = __builtin_convertvector(f, bf16x2_t);
  return __builtin_bit_cast(unsigned, v);
}
DI float bf2f(u16 v) { return __uint_as_float(((unsigned)v) << 16); }
DI float bflo(unsigned v) { return __uint_as_float(v << 16); }
DI float bfhi(unsigned v) { return __uint_as_float(v & 0xffff0000u); }
DI float sigmoidf_(float x) { return __builtin_amdgcn_rcpf(1.f + __expf(-x)); }
DI float siluf_(float x) { return x * __builtin_amdgcn_rcpf(1.f + __expf(-x)); }
DI int otid() { int t = threadIdx.x; asm volatile("" : "+v"(t)); return t; }
DI int crow(int i, int hh) { return (i & 3) + 8 * (i >> 2) + 4 * hh; }

DI void phase0(CParams& p, char* lds) {
  const int tid = otid();
  float* tile = (float*)lds;
  const int n_in = DEPTH * 16 * 160, n_b = DEPTH * 3 * 256, n_o = DEPTH * 256;
  for (int it = blockIdx.x; it < n_in + n_b + n_o; it += gridDim.x) {
    const float* src; u16* dst; int ldsrc;
    if (it < n_in) {
      int l = it / 2560, rem = it % 2560, kt = rem / 160, nt = rem % 160;
      src = p.w_in + (size_t)l * D * INW + (size_t)(kt * 64) * INW + nt * 64; ldsrc = INW;
      dst = p.WinT + (size_t)l * INW * D + ((size_t)(nt >> 1) * 16 + kt) * 8192 + (nt & 1) * 4096;
    } else if (it < n_in + n_b) {
      int i2 = it - n_in; int mat = i2 / 256, rem = i2 % 256, kt = rem / 16, nt = rem % 16;
      src = p.w_branch + (size_t)mat * D * D + (size_t)(kt * 64) * D + nt * 64; ldsrc = D;
      dst = p.WbT + (size_t)mat * D * D + ((size_t)(nt >> 1) * 16 + kt) * 8192 + (nt & 1) * 4096;
    } else {
      int i2 = it - n_in - n_b; int mat = i2 / 256, rem = i2 % 256, kt = rem / 16, nt = rem % 16;
      src = p.w_out + (size_t)mat * D * D + (size_t)(kt * 64) * D + nt * 64; ldsrc = D;
      dst = p.WoT + (size_t)mat * D * D + ((size_t)(nt >> 1) * 16 + kt) * 8192 + (nt & 1) * 4096;
    }
    __syncthreads();
#pragma unroll
    for (int i = 0; i < 2; ++i) {
      int c = tid + NTHR * i; int row = c >> 4, c4 = c & 15;
      float4 v = *(const float4*)(src + (size_t)row * ldsrc + c4 * 4);
      float* t = tile + row * 65 + c4 * 4;
      t[0] = v.x; t[1] = v.y; t[2] = v.z; t[3] = v.w;
    }
    __syncthreads();
    {
      int c = tid; int nrow = c >> 3, k8 = c & 7;
      float v[8];
#pragma unroll
      for (int j = 0; j < 8; ++j) v[j] = tile[(k8 * 8 + j) * 65 + nrow];
      uint4 o; o.x = pack2(v[0], v[1]); o.y = pack2(v[2], v[3]); o.z = pack2(v[4], v[5]); o.w = pack2(v[6], v[7]);
      *(uint4*)(dst + (size_t)nrow * 64 + k8 * 8) = o;
    }
  }
  const int gt = blockIdx.x * NTHR + tid, gn = gridDim.x * NTHR;
  for (int i = gt; i < 17 * D; i += gn) {
    int r = i / D, k = i % D;
    float v = (r < 16) ? p.c[r * D + k] : p.c_ctx[k];
    p.sc[i] = siluf_(v);
  }
  for (int i = gt; i < 64 * 32; i += gn) {
    int pos = i >> 5, pp = i & 31;
    float inv = powf(10000.f, -(float)pp / 32.f);
    float ang = (float)pos * inv;
    p.rope[i] = cosf(ang);
    p.rope[2048 + i] = sinf(ang);
  }
  if (blockIdx.x == 0 && tid < 64) p.ctr[tid] = 0;
}

DI void phase_mod(CParams& p, char* lds) {
  const int tid = otid();
  float* red = (float*)lds;
  const int col = tid & 63, kg = tid >> 6;
  for (int it = blockIdx.x; it < DEPTH * 48; it += gridDim.x) {
    int l = it / 48, cb = it % 48;
    float acc[17];
#pragma unroll
    for (int r = 0; r < 17; ++r) acc[r] = 0.f;
    const float* w = p.w_mod + (size_t)l * D * 3072 + cb * 64 + col;
    for (int k = kg * 128; k < kg * 128 + 128; ++k) {
      float wv = w[(size_t)k * 3072];
#pragma unroll
      for (int r = 0; r < 17; ++r) acc[r] += p.sc[r * D + k] * wv;
    }
    __syncthreads();
#pragma unroll
    for (int r = 0; r < 17; ++r) red[(kg * 17 + r) * 64 + col] = acc[r];
    __syncthreads();
    for (int i = tid; i < 17 * 64; i += NTHR) {
      int r = i >> 6, cc = i & 63;
      float s = 0.f;
#pragma unroll
      for (int g = 0; g < 8; ++g) s += red[(g * 17 + r) * 64 + cc];
      p.modv[((size_t)l * 17 + r) * 3072 + cb * 64 + cc] = s + p.b_mod[l * 3072 + cb * 64 + cc];
    }
  }
}

DI void phase_prenorm(CParams& p, int chunk, int l) {
  const int NB = p.NB, RL = NB * S, R = NB * (S + L);
  const int tid_ = otid();
  const int lane = tid_ & 63;
  const int wg = blockIdx.x * 8 + (tid_ >> 6), nw = gridDim.x * 8;
  const float* g = p.norm_g + l * D;
  for (int r = wg; r < R; r += nw) {
    const float* src; int mrow;
    if (r < RL) {
      int b = r / S, t = r % S; int bg = chunk * NB + b;
      src = (l == 0 ? p.x : p.out) + ((size_t)bg * S + t) * D; mrow = bg;
    } else {
      int rc = r - RL; int b = rc / L, t = rc % L; int bg = chunk * NB + b;
      src = (l == 0 ? p.ctx : p.xc) + ((size_t)bg * L + t) * D; mrow = 16;
    }
    const float* mv = p.modv + ((size_t)l * 17 + mrow) * 3072;
    float4 v[4]; float ss = 0.f;
#pragma unroll
    for (int i = 0; i < 4; ++i) {
      v[i] = *(const float4*)(src + i * 256 + lane * 4);
      ss += v[i].x * v[i].x + v[i].y * v[i].y + v[i].z * v[i].z + v[i].w * v[i].w;
    }
#pragma unroll
    for (int o = 32; o >= 1; o >>= 1) ss += __shfl_xor(ss, o);
    float rstd = rsqrtf(ss * (1.f / D) + EPS);
#pragma unroll
    for (int i = 0; i < 4; ++i) {
      int cidx = i * 256 + lane * 4;
      float4 gg = *(const float4*)(g + cidx);
      float4 sh = *(const float4*)(mv + cidx);
      float4 scl = *(const float4*)(mv + 1024 + cidx);
      float h0 = v[i].x * rstd * gg.x * (1.f + scl.x) + sh.x;
      float h1 = v[i].y * rstd * gg.y * (1.f + scl.y) + sh.y;
      float h2 = v[i].z * rstd * gg.z * (1.f + scl.z) + sh.z;
      float h3 = v[i].w * rstd * gg.w * (1.f + scl.w) + sh.w;
      uint2 o; o.x = pack2(h0, h1); o.y = pack2(h2, h3);
      *(uint2*)(p.Hb + ((size_t)(r >> 7) * 16 + (cidx >> 6)) * 8192 + (r & 127) * 64 + (cidx & 63)) = o;
    }
  }
}

template <int BN, bool PIPE>
DI void gemm_core(const u16* A, int lda, int ksa, size_t a_blk, const u16* Bt, int ldb, int ksb, size_t b_blk, int K, char* ldsc,
                  f32x16 (&acc)[BN / 64][2]) {
  constexpr int MI = BN / 64;
  constexpr int SS = 32768 + BN * 128;
  const int tid = otid(), lane = tid & 63, w = tid >> 6;
  const int wm = (BN == 256) ? (w >> 2) : (w >> 1), wn = (BN == 256) ? (w & 3) : (w & 1);
  const int r = lane & 31, hh = lane >> 5;
  const int drow = lane >> 3, dcp = lane & 7;
  const int chunk0 = dcp ^ (drow >> 1);
  const u16* gAe = A + (size_t)(w >> 2) * a_blk + (size_t)((w & 3) * 32 + drow) * lda + chunk0 * 8;
  const u16* gAo = gAe + (size_t)8 * lda + ((chunk0 ^ 4) - chunk0) * 8;
  const size_t a16 = (size_t)16 * lda;
  const int brow0 = (BN == 256) ? (w & 3) * 32 : w * 16;
  const u16* gBe = Bt + ((BN == 256) ? (size_t)(w >> 2) * b_blk : (size_t)0) + (size_t)(brow0 + drow) * ldb + chunk0 * 8;
  const u16* gBo = gBe + (size_t)8 * ldb + ((chunk0 ^ 4) - chunk0) * 8;
  const size_t b16 = (size_t)16 * ldb;
#pragma unroll
  for (int i = 0; i < MI; ++i)
#pragma unroll
    for (int j = 0; j < 2; ++j)
#pragma unroll
      for (int x = 0; x < 16; ++x) acc[i][j][x] = 0.f;
  auto DMA = [&](int kt, int stage) {
    char* sa = ldsc + stage * SS + (w * 4) * 1024;
    char* sb = ldsc + stage * SS + 32768 + ((BN == 256) ? (w * 4) : (w * 2)) * 1024;
    const size_t ka = (size_t)kt * ksa, kb = (size_t)kt * ksb;
    __builtin_amdgcn_global_load_lds((const unsigned*)(gAe + ka), (unsigned*)(sa), 16, 0, 0);
    __builtin_amdgcn_global_load_lds((const unsigned*)(gBe + kb), (unsigned*)(sb), 16, 0, 0);
    __builtin_amdgcn_global_load_lds((const unsigned*)(gAo + ka), (unsigned*)(sa + 1024), 16, 0, 0);
    __builtin_amdgcn_global_load_lds((const unsigned*)(gBo + kb), (unsigned*)(sb + 1024), 16, 0, 0);
    __builtin_amdgcn_global_load_lds((const unsigned*)(gAe + a16 + ka), (unsigned*)(sa + 2048), 16, 0, 0);
    __builtin_amdgcn_global_load_lds((const unsigned*)(gAo + a16 + ka), (unsigned*)(sa + 3072), 16, 0, 0);
    if (BN == 256) {
      __builtin_amdgcn_global_load_lds((const unsigned*)(gBe + b16 + kb), (unsigned*)(sb + 2048), 16, 0, 0);
      __builtin_amdgcn_global_load_lds((const unsigned*)(gBo + b16 + kb), (unsigned*)(sb + 3072), 16, 0, 0);
    }
  };
  const int sw = (r >> 1) & 7;
  int koff[4];
#pragma unroll
  for (int ks = 0; ks < 4; ++ks) koff[ks] = ((2 * ks + hh) ^ sw) << 4;
  auto COMPUTE = [&](int stage) {
    const char* ab = ldsc + stage * SS + (wm * (MI * 32) + r) * 128;
    const char* bb = ldsc + stage * SS + 32768 + (wn * 64 + r) * 128;
    bf16x8 fa[2][MI], fb[2][2];
    auto LDF = [&](int ks, int slot) {
#pragma unroll
      for (int i = 0; i < MI; ++i) fa[slot][i] = *(const bf16x8*)(ab + i * 32 * 128 + koff[ks]);
#pragma unroll
      for (int j = 0; j < 2; ++j) fb[slot][j] = *(const bf16x8*)(bb + j * 32 * 128 + koff[ks]);
    };
    auto MM = [&](int slot) {
#pragma unroll
      for (int i = 0; i < MI; ++i)
#pragma unroll
        for (int j = 0; j < 2; ++j) acc[i][j] = MFMA32(fb[slot][j], fa[slot][i], acc[i][j]);
    };
    if (!PIPE) {
#pragma unroll
      for (int ks = 0; ks < 4; ++ks) { LDF(ks, 0); MM(0); }
      return;
    }
    LDF(0, 0); LDF(1, 1);
    __builtin_amdgcn_sched_barrier(0);
    MM(0); LDF(2, 0);
    __builtin_amdgcn_sched_barrier(0);
    MM(1); LDF(3, 1);
    __builtin_amdgcn_sched_barrier(0);
    MM(0); MM(1);
  };
  const int KT = K >> 6;
  __syncthreads();
  DMA(0, 0);
  __syncthreads();
  for (int kt = 0; kt < KT; kt += 2) {
    DMA(kt + 1, 1);
    COMPUTE(0);
    __syncthreads();
    if (kt + 2 < KT) DMA(kt + 2, 0);
    COMPUTE(1);
    __syncthreads();
  }
}

template <int MI>
DI void stage_acc(char* ldsc, f32x16 (&acc)[MI][2], int wm, int ncol0, bool active) {
  const int tid = otid(), lane = tid & 63;
  const int r = lane & 31, hh = lane >> 5;
  float* Cs = (float*)ldsc;
  if (active) {
#pragma unroll
    for (int i = 0; i < MI; ++i)
#pragma unroll
      for (int j = 0; j < 2; ++j)
#pragma unroll
        for (int g = 0; g < 4; ++g) {
          int m = wm * (MI * 32) + i * 32 + r;
          int n = ncol0 + j * 32 + 8 * g + 4 * hh;
          float4 v; v.x = acc[i][j][4 * g]; v.y = acc[i][j][4 * g + 1]; v.z = acc[i][j][4 * g + 2]; v.w = acc[i][j][4 * g + 3];
          *(float4*)(Cs + m * 132 + n) = v;
        }
  }
  __syncthreads();
}

DI void read_row64(const char* ldsc, int row, int half, float (&v)[64]) {
  const float* Cs = (const float*)ldsc + row * 132 + half * 64;
#pragma unroll
  for (int j = 0; j < 16; ++j) {
    float4 t = *(const float4*)(Cs + j * 4);
    v[j * 4] = t.x; v[j * 4 + 1] = t.y; v[j * 4 + 2] = t.z; v[j * 4 + 3] = t.w;
  }
}

DI void store_row64_bf16(u16* dst, const float (&v)[64]) {
#pragma unroll
  for (int j = 0; j < 8; ++j) {
    uint4 o;
    o.x = pack2(v[j * 8], v[j * 8 + 1]); o.y = pack2(v[j * 8 + 2], v[j * 8 + 3]);
    o.z = pack2(v[j * 8 + 4], v[j * 8 + 5]); o.w = pack2(v[j * 8 + 6], v[j * 8 + 7]);
    *(uint4*)(dst + j * 8) = o;
  }
}

DI bool tile_map(int i, int MT, int NT, int& mt, int& nt) {
  const int G = gridDim.x, bid = blockIdx.x;
  if ((G & 63) == 0 && (MT & 7) == 0 && (NT % (G >> 6)) == 0) {
    const int SH = G >> 6;
    const int xcd = bid & 7, slot = bid >> 3;
    const int sx = slot & 7, sy = slot >> 3;
    const int nsn = NT / SH, nsm = MT >> 3;
    const int st = i * 8 + xcd;
    if (st >= nsm * nsn) return false;
    mt = (st / nsn) * 8 + sx;
    nt = (st % nsn) * SH + sy;
    return true;
  }
  const int it = bid + i * G;
  if (it >= MT * NT) return false;
  mt = it / NT; nt = it % NT;
  return true;
}

DI void phase_gemm_in(CParams& p, int chunk, int l, char* lds) {
  const int NB = p.NB, RL = NB * S, R = NB * (S + L);
  const int MT = R / 256, NT = 40;
  const int tid = otid();
  const int lane = tid & 63, w = tid >> 6, wm = w >> 2, wn = w & 3, r = lane & 31, hh = lane >> 5;
  const u16* Wt = p.WinT + (size_t)l * INW * D;
  for (int ti = 0;; ++ti) {
    int mt, nt;
    if (!tile_map(ti, MT, NT, mt, nt)) break;
    const int m0 = mt * 256, n0 = nt * 256;
    f32x16 acc[4][2];
    gemm_core<256, false>(p.Hb + (size_t)m0 * D, 64, 8192, 131072, Wt + (size_t)n0 * D, 64, 8192, 131072, D, lds, acc);
    {
      int mode = -1; u16* dbase = nullptr; int dld = 0;
      if (nt < 4) { mode = 0; dbase = p.U + nt * 256; dld = D; }
      else if (nt < 8) { mode = 1; dbase = p.Z + (nt - 4) * 256; dld = 3072; }
      else if (nt >= 14 && nt < 18) { mode = 1; dbase = p.Z + 1024 + (nt - 14) * 256; dld = 3072; }
      else if (nt >= 24 && nt < 28) { mode = 1; dbase = p.Z + 2048 + (nt - 24) * 256; dld = 3072; }
      else if (nt >= 28) { mode = 2; dbase = p.Ms + (nt - 28) * 256; dld = 3072; }
      if (mode >= 0) {
#pragma unroll
        for (int i = 0; i < 4; ++i)
#pragma unroll
          for (int j = 0; j < 2; ++j)
#pragma unroll
            for (int g = 0; g < 4; ++g) {
              float v0 = acc[i][j][4 * g], v1 = acc[i][j][4 * g + 1], v2 = acc[i][j][4 * g + 2], v3 = acc[i][j][4 * g + 3];
              if (mode == 1) { v0 = siluf_(v0); v1 = siluf_(v1); v2 = siluf_(v2); v3 = siluf_(v3); }
              else if (mode == 2) { v0 = sigmoidf_(v0); v1 = sigmoidf_(v1); v2 = sigmoidf_(v2); v3 = sigmoidf_(v3); }
              uint2 o; o.x = pack2(v0, v1); o.y = pack2(v2, v3);
              const size_t row = (size_t)m0 + wm * 128 + i * 32 + r;
              const int col = wn * 64 + j * 32 + 8 * g + 4 * hh;
              *(uint2*)(dbase + row * dld + col) = o;
            }
        continue;
      }
    }
    const bool lat = m0 < RL;
    int b, t0;
    if (lat) { b = m0 / S; t0 = m0 % S; } else { int rc = m0 - RL; b = rc / L; t0 = rc % L; }
    const bool isV = (nt == 13 || nt == 23);
    const bool isC = nt >= 18;
    const bool isQ = (nt >= 8 && nt < 12) || (nt >= 18 && nt < 22);
    auto process_unit = [&](int hsel, int u) {
      if (isV) {
        const int slot = (isC ? 2 : 0) + hsel;
        const int d = u >> 2, tq = u & 3;
        const float* Cs = (const float*)lds;
        u16* dst = lat ? p.VtL + ((size_t)(b * 4 + slot) * 128 + d) * S + t0 + tq * 64
                       : p.VtC + ((size_t)(b * 4 + slot) * 128 + d) * L + t0 + tq * 64;
#pragma unroll 1
        for (int c = 0; c < 4; ++c) {
          float v[16];
#pragma unroll
          for (int j = 0; j < 16; ++j) v[j] = Cs[(tq * 64 + c * 16 + j) * 132 + d];
          uint4 o0, o1;
          o0.x = pack2(v[0], v[1]); o0.y = pack2(v[2], v[3]); o0.z = pack2(v[4], v[5]); o0.w = pack2(v[6], v[7]);
          o1.x = pack2(v[8], v[9]); o1.y = pack2(v[10], v[11]); o1.z = pack2(v[12], v[13]); o1.w = pack2(v[14], v[15]);
          *(uint4*)(dst + c * 16) = o0;
          *(uint4*)(dst + c * 16 + 8) = o1;
        }
      } else {
        const int row = u >> 1, half = u & 1;
        const size_t gr = (size_t)m0 + row;
        const int t = t0 + row;
        const float* Cr = (const float*)lds + row * 132 + half * 64;
        float rstd = 1.f;
        const float* gn = (isQ ? p.q_norm_g : p.k_norm_g) + l * 128 + half * 64;
        if (isC) {
          float ss = 0.f;
#pragma unroll
          for (int j = 0; j < 16; ++j) {
            float4 tv = *(const float4*)(Cr + j * 4);
            ss += tv.x * tv.x + tv.y * tv.y + tv.z * tv.z + tv.w * tv.w;
          }
          ss += __shfl_xor(ss, 1);
          rstd = rsqrtf(ss * (1.f / 128.f) + EPS);
        }
        const int pos = (half == 0) ? (t >> 6) : (t & 63);
        const float* cs = p.rope + pos * 32;
        const float* sn = p.rope + 2048 + pos * 32;
        u16* dst;
        if (isQ) {
          const int head = (isC ? (nt - 18) : (nt - 8)) * 2 + hsel;
          dst = p.Q + gr * 2048 + (isC ? 1024 : 0) + head * 128 + half * 64;
        } else {
          dst = p.Kb + gr * 512 + (isC ? 256 : 0) + hsel * 128 + half * 64;
        }
#pragma unroll 1
        for (int c = 0; c < 2; ++c) {
          float x0[16], x1[16];
#pragma unroll
          for (int j = 0; j < 4; ++j) {
            float4 ta_ = *(const float4*)(Cr + c * 16 + j * 4);
            float4 tb_ = *(const float4*)(Cr + 32 + c * 16 + j * 4);
            x0[4 * j] = ta_.x; x0[4 * j + 1] = ta_.y; x0[4 * j + 2] = ta_.z; x0[4 * j + 3] = ta_.w;
            x1[4 * j] = tb_.x; x1[4 * j + 1] = tb_.y; x1[4 * j + 2] = tb_.z; x1[4 * j + 3] = tb_.w;
          }
          if (isC) {
#pragma unroll
            for (int j = 0; j < 16; ++j) { x0[j] = x0[j] * rstd * gn[c * 16 + j]; x1[j] = x1[j] * rstd * gn[32 + c * 16 + j]; }
          }
          if (lat) {
#pragma unroll
            for (int j = 0; j < 16; ++j) {
              float c_ = cs[c * 16 + j], s_ = sn[c * 16 + j];
              float a0 = x0[j], a1 = x1[j];
              x0[j] = a0 * c_ - a1 * s_;
              x1[j] = a1 * c_ + a0 * s_;
            }
          }
          if (isQ) {
#pragma unroll
            for (int j = 0; j < 16; ++j) { x0[j] *= QSCALE; x1[j] *= QSCALE; }
          }
          uint4 o0, o1, o2, o3;
          o0.x = pack2(x0[0], x0[1]); o0.y = pack2(x0[2], x0[3]); o0.z = pack2(x0[4], x0[5]); o0.w = pack2(x0[6], x0[7]);
          o1.x = pack2(x0[8], x0[9]); o1.y = pack2(x0[10], x0[11]); o1.z = pack2(x0[12], x0[13]); o1.w = pack2(x0[14], x0[15]);
          o2.x = pack2(x1[0], x1[1]); o2.y = pack2(x1[2], x1[3]); o2.z = pack2(x1[4], x1[5]); o2.w = pack2(x1[6], x1[7]);
          o3.x = pack2(x1[8], x1[9]); o3.y = pack2(x1[10], x1[11]); o3.z = pack2(x1[12], x1[13]); o3.w = pack2(x1[14], x1[15]);
          *(uint4*)(dst + c * 16) = o0;
          *(uint4*)(dst + c * 16 + 8) = o1;
          *(uint4*)(dst + 32 + c * 16) = o2;
          *(uint4*)(dst + 32 + c * 16 + 8) = o3;
        }
      }
    };
    auto stage_mine = [&]() {
      float* Cs = (float*)lds;
#pragma unroll
      for (int i = 0; i < 4; ++i)
#pragma unroll
        for (int j = 0; j < 2; ++j)
#pragma unroll
          for (int g = 0; g < 4; ++g) {
            int m = wm * 128 + i * 32 + r;
            int n = (wn & 1) * 64 + j * 32 + 8 * g + 4 * hh;
            float4 v; v.x = acc[i][j][4 * g]; v.y = acc[i][j][4 * g + 1]; v.z = acc[i][j][4 * g + 2]; v.w = acc[i][j][4 * g + 3];
            *(float4*)(Cs + m * 132 + n) = v;
          }
    };
    if ((wn >> 1) == 0) {
      const int ta = ((wm * 2 + (wn & 1)) << 6) + lane;
      stage_mine();
      __syncthreads();
      process_unit(0, ta);
      process_unit(0, ta + 256);
      __syncthreads();
      __syncthreads();
      process_unit(1, tid);
      __syncthreads();
    } else {
      __syncthreads();
      __syncthreads();
      stage_mine();
      __syncthreads();
      process_unit(1, tid);
      __syncthreads();
    }
  }
}

struct AttnArgs {
  const u16* q;
  u16* z;
  const u16* kctx;
  const u16* vctx;
  const u16* klat;
  const u16* vlat;
  int n_lat_tiles;
  int lat_key0;
  int q_t0;
  int band;
  int has_sink;
  float sink_l2;
  int dry;
  int fixedm;
  float mfix;
};

DI void attn_load_tile(const AttnArgs& a, int ti, u32x4 (&rk)[2], u32x4 (&rv)[2]) {
  const int tid = otid();
  const u16* kp; const u16* vp; int vs;
  if (ti < 4) { kp = a.kctx + (size_t)(ti * 64) * 512; vp = a.vctx + ti * 64; vs = L; }
  else { kp = a.klat + (size_t)((ti - 4) * 64) * 512; vp = a.vlat + (ti - 4) * 64; vs = S; }
#pragma unroll
  for (int i = 0; i < 2; ++i) {
    int c = tid + NTHR * i;
    rk[i] = *(const u32x4*)(kp + (size_t)(c >> 4) * 512 + (c & 15) * 8);
    rv[i] = *(const u32x4*)(vp + (size_t)(c >> 3) * vs + (c & 7) * 8);
  }
}
DI void attn_store_tile(u16* sK, u16* sV, const u32x4 (&rk)[2], const u32x4 (&rv)[2]) {
  const int tid = otid();
#pragma unroll
  for (int i = 0; i < 2; ++i) {
    int c = tid + NTHR * i;
    *(u32x4*)(sK + (c >> 4) * 136 + (c & 15) * 8) = rk[i];
    u16* vd = sV + (c >> 3) * 68 + (c & 7) * 8;
    { u32x2 t0 = {rv[i].x, rv[i].y}; *(u32x2*)(vd) = t0; }
    { u32x2 t1 = {rv[i].z, rv[i].w}; *(u32x2*)(vd + 4) = t1; }
  }
}

DI void attn_item(const AttnArgs& a, char* lds) {
  const int tid = otid(), lane = tid & 63, w = tid >> 6;
  const int r = lane & 31, hh = lane >> 5;
  constexpr int STG = 34816;
  const int ntiles = 4 + a.n_lat_tiles;

  bf16x8 qf[8];
  {
    const u16* qp = a.q + (size_t)(w * 32 + r) * 2048 + hh * 8;
#pragma unroll
    for (int ks = 0; ks < 8; ++ks) qf[ks] = *(const bf16x8*)(qp + ks * 16);
  }
  f32x16 O[4];
#pragma unroll
  for (int dt = 0; dt < 4; ++dt)
#pragma unroll
    for (int x = 0; x < 16; ++x) O[dt][x] = 0.f;
  float m = a.fixedm ? a.mfix : (a.has_sink ? a.sink_l2 : -1e30f);
  float lsum = (a.has_sink && hh == 0) ? 1.f : 0.f;
  const int qpos = a.q_t0 + w * 32 + r;

  auto QK = [&](int stage, f32x16 (&sc)[2]) {
    const u16* sK = (const u16*)(lds + stage * STG);
#pragma unroll
    for (int kt2 = 0; kt2 < 2; ++kt2) {
#pragma unroll
      for (int x = 0; x < 16; ++x) sc[kt2][x] = 0.f;
      const u16* kb = sK + (kt2 * 32 + r) * 136 + hh * 8;
#pragma unroll
      for (int ks = 0; ks < 8; ++ks) {
        bf16x8 ka = *(const bf16x8*)(kb + ks * 16);
        sc[kt2] = MFMA32(ka, qf[ks], sc[kt2]);
      }
    }
  };
  u32x4 rk[2], rv[2];
  auto STEP = [&](int ti, int st, f32x16 (&sc)[2], f32x16 (&sn)[2]) {
    const int st1 = (st == 2) ? 0 : st + 1, st2 = (st == 0) ? 2 : st - 1;
    if (ti + 2 < ntiles) attn_load_tile(a, ti + 2, rk, rv);
    if (ti + 1 < ntiles) QK(st1, sn);
    if (a.band && ti >= 4) {
      const int k0 = a.lat_key0 + (ti - 4) * 64;
#pragma unroll
      for (int kt2 = 0; kt2 < 2; ++kt2)
#pragma unroll
        for (int x = 0; x < 16; ++x) {
          int kp = k0 + kt2 * 32 + crow(x, hh);
          int dlt = kp - qpos; dlt = dlt < 0 ? -dlt : dlt;
          if (dlt > 128) sc[kt2][x] = -1e30f;
        }
    }
    if (!a.fixedm) {
      float mx = sc[0][0];
#pragma unroll
      for (int kt2 = 0; kt2 < 2; ++kt2)
#pragma unroll
        for (int x = 0; x < 16; ++x) mx = fmaxf(mx, sc[kt2][x]);
      mx = fmaxf(mx, __shfl_xor(mx, 32));
      if (__any(mx > m + 8.f)) {
        const float mnew = fmaxf(m, mx);
        const float alpha = __builtin_amdgcn_exp2f(m - mnew);
        m = mnew;
        lsum *= alpha;
#pragma unroll
        for (int dt = 0; dt < 4; ++dt)
#pragma unroll
          for (int x = 0; x < 16; ++x) O[dt][x] *= alpha;
      }
    }
    float ps = 0.f;
#pragma unroll
    for (int kt2 = 0; kt2 < 2; ++kt2)
#pragma unroll
      for (int x = 0; x < 16; ++x) { float pv = __builtin_amdgcn_exp2f(sc[kt2][x] - m); sc[kt2][x] = pv; ps += pv; }
    lsum += ps;
    const u16* sV = (const u16*)(lds + st * STG + 17408);
#pragma unroll
    for (int kt2 = 0; kt2 < 2; ++kt2)
#pragma unroll
      for (int s2 = 0; s2 < 2; ++s2) {
        union { unsigned u[4]; bf16x8 v; } pf;
#pragma unroll
        for (int j = 0; j < 4; ++j) pf.u[j] = pack2(sc[kt2][8 * s2 + 2 * j], sc[kt2][8 * s2 + 2 * j + 1]);
        const u16* vb = sV + r * 68 + kt2 * 32 + 16 * s2 + 4 * hh;
#pragma unroll
        for (int dt = 0; dt < 4; ++dt) {
          s16x4 lo = *(const s16x4*)(vb + dt * 32 * 68);
          s16x4 hi = *(const s16x4*)(vb + dt * 32 * 68 + 8);
          bf16x8 va = __builtin_shufflevector(lo, hi, 0, 1, 2, 3, 4, 5, 6, 7);
          O[dt] = MFMA32(va, pf.v, O[dt]);
        }
      }
    if (ti + 2 < ntiles) attn_store_tile((u16*)(lds + st2 * STG), (u16*)(lds + st2 * STG + 17408), rk, rv);
    __syncthreads();
  };

  attn_load_tile(a, 0, rk, rv);
  __syncthreads();
  attn_store_tile((u16*)lds, (u16*)(lds + 17408), rk, rv);
  attn_load_tile(a, 1, rk, rv);
  attn_store_tile((u16*)(lds + STG), (u16*)(lds + STG + 17408), rk, rv);
  __syncthreads();
  f32x16 sA[2], sB[2];
  QK(0, sA);
  int st = 0;
  for (int ti = 0; ti < ntiles; ti += 2) {
    STEP(ti, st, sA, sB);
    st = (st == 2) ? 0 : st + 1;
    if (ti + 1 < ntiles) {
      STEP(ti + 1, st, sB, sA);
      st = (st == 2) ? 0 : st + 1;
    }
  }
  float ltot = lsum + __shfl_xor(lsum, 32);
  const float inv = 1.f / ltot;
  u16* zp = a.z + (size_t)(w * 32 + r) * 3072;
  u32x2 gv[4][4];
#pragma unroll
  for (int dt = 0; dt < 4; ++dt)
#pragma unroll
    for (int g4 = 0; g4 < 4; ++g4) gv[dt][g4] = *(const u32x2*)(zp + dt * 32 + 8 * g4 + 4 * hh);
#pragma unroll
  for (int dt = 0; dt < 4; ++dt)
#pragma unroll
    for (int g4 = 0; g4 < 4; ++g4) {
      int d0 = dt * 32 + 8 * g4 + 4 * hh;
      float y0 = O[dt][4 * g4 + 0] * inv * bflo(gv[dt][g4].x);
      float y1 = O[dt][4 * g4 + 1] * inv * bfhi(gv[dt][g4].x);
      float y2 = O[dt][4 * g4 + 2] * inv * bflo(gv[dt][g4].y);
      float y3 = O[dt][4 * g4 + 3] * inv * bfhi(gv[dt][g4].y);
      uint2 o; o.x = pack2(y0, y1); o.y = pack2(y2, y3);
      if (!a.dry || y0 != y0) *(uint2*)(zp + d0) = o;
    }
}

template <bool REV>
DI void lru_scan(float (&av)[2][16], float (&bv)[2][16], float& carry, int hh) {
  float segA[8], segB[8];
#pragma unroll
  for (int k = 0; k < 8; ++k) {
    const int mt = k >> 2, q = k & 3;
    float cA = 1.f, hl = 0.f;
#pragma unroll
    for (int jj = 0; jj < 4; ++jj) {
      const int j = REV ? 3 - jj : jj;
      const int i = 4 * q + j;
      hl = av[mt][i] * hl + bv[mt][i];
      cA *= av[mt][i];
      av[mt][i] = cA; bv[mt][i] = hl;
    }
    segA[k] = cA; segB[k] = hl;
  }
  float oA[8], oB[8];
#pragma unroll
  for (int k = 0; k < 8; ++k) { oA[k] = __shfl_xor(segA[k], 32); oB[k] = __shfl_xor(segB[k], 32); }
  float init[8];
  float st = carry;
#pragma unroll
  for (int kk = 0; kk < 8; ++kk) {
    const int k = REV ? 7 - kk : kk;
    const int first = REV ? 1 : 0;
    float A1 = (hh == first) ? segA[k] : oA[k];
    float B1 = (hh == first) ? segB[k] : oB[k];
    float st0 = st;
    st = A1 * st + B1;
    float A2 = (hh == first) ? oA[k] : segA[k];
    float B2 = (hh == first) ? oB[k] : segB[k];
    float st1 = st;
    st = A2 * st + B2;
    init[k] = (hh == first) ? st0 : st1;
  }
  carry = st;
#pragma unroll
  for (int k = 0; k < 8; ++k) {
    const int mt = k >> 2, q = k & 3;
#pragma unroll
    for (int j = 0; j < 4; ++j) {
      const int i = 4 * q + j;
      bv[mt][i] = bv[mt][i] + av[mt][i] * init[k];
    }
  }
}

DI void lru_item(CParams& p, int l, int b, int n, bool last, char* lds, int dry = 0) {
  const int NB = p.NB, RL = NB * S;
  const int tid = otid(), lane = tid & 63, w8 = tid >> 6;
  const int sub = __builtin_amdgcn_readfirstlane(w8 >> 2), w = w8 & 3;
  n = n + sub;
  lds += sub * 73728;
  const int dir = w >> 1, w2 = w & 1;
  const int tl = tid & 127;
  const int r = lane & 31, hh = lane >> 5;
  u16* sRaw = (u16*)lds + dir * (8704 / 2);
  u16* sUp = (u16*)(lds + 17408) + dir * (9216 / 2);
  float* sH = (float*)(lds + 35840) + w * (64 * 36);

  const int chb = n * 64;
  const int cp = (tl & 31) * 2, tg = tl >> 5;
  float cw0[4], cw1[4], cb0, cb1;
#pragma unroll
  for (int k = 0; k < 4; ++k) {
    cw0[k] = p.conv_w[((size_t)l * 4 + k) * D + chb + cp];
    cw1[k] = p.conv_w[((size_t)l * 4 + k) * D + chb + cp + 1];
  }
  cb0 = p.conv_b[l * D + chb + cp]; cb1 = p.conv_b[l * D + chb + cp + 1];
  bf16x8 waf[4], wxf[4];
  {
    const float* wa = p.lru_wa + (((size_t)(l * 2 + dir) * 16 + n) * 64) * 64;
    const float* wx = p.lru_wx + (((size_t)(l * 2 + dir) * 16 + n) * 64) * 64;
    const int e = 32 * w2 + r;
#pragma unroll
    for (int ks = 0; ks < 4; ++ks) {
      union { unsigned u[4]; bf16x8 v; } fa, fx;
#pragma unroll
      for (int j = 0; j < 4; ++j) {
        int d0 = ks * 16 + 8 * hh + 2 * j;
        fa.u[j] = pack2(wa[d0 * 64 + e], wa[(d0 + 1) * 64 + e]);
        fx.u[j] = pack2(wx[d0 * 64 + e], wx[(d0 + 1) * 64 + e]);
      }
      waf[ks] = fa.v; wxf[ks] = fx.v;
    }
  }
  const int che = chb + 32 * w2 + r;
  const float ba = p.lru_ba[(l * 2 + dir) * D + che];
  const float bx = p.lru_bx[(l * 2 + dir) * D + che];
  float c8sp;
  {
    float lam = p.lru_lambda[(l * 2 + dir) * D + che];
    float sp = (lam < -20.f) ? -lam : log1pf(expf(-lam));
    c8sp = 8.f * sp;
  }
  float carry = 0.f;

  auto step_tile = [&](int st, bool& isctx, int& tt) {
    if (dir == 0) { if (st < 4) { isctx = true; tt = st; } else { isctx = false; tt = st - 4; } }
    else { if (st < 4) { isctx = true; tt = 3 - st; } else { isctx = false; tt = 63 - (st - 4); } }
  };
  u32x4 pre[5];
  auto load_raw = [&](int st) {
    bool isctx; int tt; step_tile(st, isctx, tt);
    const int seqlen = isctx ? L : S;
    const size_t rowbase = isctx ? (size_t)RL + (size_t)b * L : (size_t)b * S;
    const int t0 = tt * 64;
#pragma unroll
    for (int i = 0; i < 5; ++i) {
      int c = tl + 128 * i;
      int rr = c >> 3, c16 = c & 7;
      int t = t0 - 2 + rr;
      u32x4 v = {0u, 0u, 0u, 0u};
      if (rr < 67 && t >= 0 && t < seqlen) v = *(const u32x4*)(p.U + (rowbase + t) * D + chb + c16 * 8);
      pre[i] = v;
    }
  };
  load_raw(0);
  __syncthreads();
  for (int st = 0; st < 68; ++st) {
    bool isctx; int tt; step_tile(st, isctx, tt);
    const size_t rowbase = isctx ? (size_t)RL + (size_t)b * L : (size_t)b * S;
    const int t0 = tt * 64;
#pragma unroll
    for (int i = 0; i < 5; ++i) {
      int c = tl + 128 * i;
      int rr = c >> 3, c16 = c & 7;
      if (rr < 67) *(u32x4*)(sRaw + rr * 64 + c16 * 8) = pre[i];
    }
    if (st + 1 < 68) load_raw(st + 1);
    __syncthreads();
    {
      const u16* rp = sRaw + (tg * 16) * 64 + cp;
      unsigned r0 = *(const unsigned*)(rp), r1 = *(const unsigned*)(rp + 64), r2 = *(const unsigned*)(rp + 128);
#pragma unroll
      for (int i = 0; i < 16; ++i) {
        unsigned r3 = *(const unsigned*)(rp + (i + 3) * 64);
        float o0 = cb0 + cw0[0] * bflo(r0) + cw0[1] * bflo(r1) + cw0[2] * bflo(r2) + cw0[3] * bflo(r3);
        float o1 = cb1 + cw1[0] * bfhi(r0) + cw1[1] * bfhi(r1) + cw1[2] * bfhi(r2) + cw1[3] * bfhi(r3);
        *(unsigned*)(sUp + (tg * 16 + i) * 72 + cp) = pack2(o0, o1);
        r0 = r1; r1 = r2; r2 = r3;
      }
    }
    __syncthreads();
    const bool fwd_first = isctx ? (tt <= 1) : (tt <= 31);
    const bool first = (dir == 0) ? fwd_first : !fwd_first;
    unsigned long long pt0[4], pt1[4];
    u32x4 pg[4];
    if (!first && !(isctx && last)) {
#pragma unroll
      for (int j = 0; j < 4; ++j) {
        const int q = lane + 64 * j;
        const int tok = q >> 2, cc = (q & 3) * 8;
        const size_t row = rowbase + t0 + tok;
        const int col = chb + 32 * w2 + cc;
        const u16* tp = p.Hb + row * D + col;
        pt0[j] = __hip_atomic_load((const unsigned long long*)tp, __ATOMIC_RELAXED, __HIP_MEMORY_SCOPE_AGENT);
        pt1[j] = __hip_atomic_load((const unsigned long long*)tp + 1, __ATOMIC_RELAXED, __HIP_MEMORY_SCOPE_AGENT);
        pg[j] = *(const u32x4*)(p.Z + row * 3072 + col);
      }
    } else {
#pragma unroll
      for (int j = 0; j < 4; ++j) { pt0[j] = 0; pt1[j] = 0; pg[j] = u32x4{0u, 0u, 0u, 0u}; }
    }
    float av[2][16], bv[2][16];
    {
      f32x16 aR[2];
#pragma unroll
      for (int mt = 0; mt < 2; ++mt) {
#pragma unroll
        for (int x = 0; x < 16; ++x) aR[mt][x] = 0.f;
        const u16* ub = sUp + (mt * 32 + r) * 72 + hh * 8;
#pragma unroll
        for (int ks = 0; ks < 4; ++ks) aR[mt] = MFMA32(*(const bf16x8*)(ub + ks * 16), waf[ks], aR[mt]);
      }
#pragma unroll
      for (int mt = 0; mt < 2; ++mt)
#pragma unroll
        for (int x = 0; x < 16; ++x) {
          const float rg = sigmoidf_(aR[mt][x] + ba);
          av[mt][x] = -c8sp * rg;
        }
    }
    {
      f32x16 aI[2];
#pragma unroll
      for (int mt = 0; mt < 2; ++mt) {
#pragma unroll
        for (int x = 0; x < 16; ++x) aI[mt][x] = 0.f;
        const u16* ub = sUp + (mt * 32 + r) * 72 + hh * 8;
#pragma unroll
        for (int ks = 0; ks < 4; ++ks) aI[mt] = MFMA32(*(const bf16x8*)(ub + ks * 16), wxf[ks], aI[mt]);
      }
#pragma unroll
      for (int mt = 0; mt < 2; ++mt)
#pragma unroll
        for (int x = 0; x < 16; ++x) {
          const int tok = mt * 32 + crow(x, hh);
          const float up = bf2f(sUp[tok * 72 + 32 * w2 + r]);
          const float ig = sigmoidf_(aI[mt][x] + bx);
          const float la = av[mt][x];
          const float a_ = __expf(la);
          const float om = fmaxf(1.f - a_ * a_, 0.f);
          av[mt][x] = a_;
          bv[mt][x] = __builtin_amdgcn_sqrtf(om) * (ig * up);
        }
    }
    if (dir == 0) lru_scan<false>(av, bv, carry, hh); else lru_scan<true>(av, bv, carry, hh);
#pragma unroll
    for (int mt = 0; mt < 2; ++mt)
#pragma unroll
      for (int x = 0; x < 16; ++x) sH[(mt * 32 + crow(x, hh)) * 36 + r] = bv[mt][x];
    if (!(isctx && last)) {
#pragma unroll
      for (int j = 0; j < 4; ++j) {
        const int q = lane + 64 * j;
        const int tok = q >> 2, cc = (q & 3) * 8;
        const float4 h0 = *(const float4*)(sH + tok * 36 + cc);
        const float4 h1 = *(const float4*)(sH + tok * 36 + cc + 4);
        const size_t row = rowbase + t0 + tok;
        const int col = chb + 32 * w2 + cc;
        u16* tp = p.Hb + row * D + col;
        if (first) {
          uint4 o; o.x = pack2(h0.x, h0.y); o.y = pack2(h0.z, h0.w); o.z = pack2(h1.x, h1.y); o.w = pack2(h1.z, h1.w);
          if (!dry || h0.x != h0.x) *(uint4*)tp = o;
        } else {
          unsigned tx = (unsigned)pt0[j], ty = (unsigned)(pt0[j] >> 32), tz = (unsigned)pt1[j], tw = (unsigned)(pt1[j] >> 32);
          u16* zp = p.Z + row * 3072 + col;
          u32x4 g = pg[j];
          uint4 o;
          o.x = pack2((h0.x + bflo(tx)) * bflo(g.x), (h0.y + bfhi(tx)) * bfhi(g.x));
          o.y = pack2((h0.z + bflo(ty)) * bflo(g.y), (h0.w + bfhi(ty)) * bfhi(g.y));
          o.z = pack2((h1.x + bflo(tz)) * bflo(g.z), (h1.y + bfhi(tz)) * bfhi(g.z));
          o.w = pack2((h1.z + bflo(tw)) * bflo(g.w), (h1.w + bfhi(tw)) * bfhi(g.w));
          if (!dry || h0.x != h0.x) *(uint4*)zp = o;
        }
      }
    }
    __builtin_amdgcn_fence(__ATOMIC_RELEASE, "workgroup");
  }
}

DI void phase_mixers(CParams& p, int chunk, int l, char* lds, int dry = 0) {
  const int NB = p.NB, RL = NB * S;
  const bool last = (l == DEPTH - 1);
  const int nLRU = (dry == 1) ? 0 : NB * 8, nC = (dry == 2) ? 0 : NB * 8 * 16, nBw = (dry == 2) ? 0 : NB * 8 * 16, nCtx = (last || dry == 2) ? 0 : NB * 8 * 2;
  const int total = nLRU + nC + nBw + nCtx;
  int* ctr = p.ctr + chunk * DEPTH + l + (dry ? 32 : 0);
  int* s_item = (int*)(lds + LDS_BYTES - 16);
  int it;
  while (true) {
    __syncthreads();
    if (threadIdx.x == 0) *s_item = atomicAdd(ctr, 1);
    __syncthreads();
    it = __builtin_amdgcn_readfirstlane(*s_item);
    __syncthreads();
    if (it >= nLRU) break;
    lru_item(p, l, it >> 3, (it & 7) * 2, last, lds, dry);
  }
  bool have = true;
  while (true) {
    if (!have) {
      __syncthreads();
      if (threadIdx.x == 0) *s_item = atomicAdd(ctr, 1);
      __syncthreads();
      it = __builtin_amdgcn_readfirstlane(*s_item);
      __syncthreads();
    }
    have = false;
    if (it >= total) break;
    it -= nLRU;
    AttnArgs a;
    a.dry = dry;
    float gqm = 0.f, gkm = 0.f;
    {
      const int ln = otid() & 63;
      gqm = fmaxf(fabsf(p.q_norm_g[l * 128 + ln]), fabsf(p.q_norm_g[l * 128 + 64 + ln]));
      gkm = fmaxf(fabsf(p.k_norm_g[l * 128 + ln]), fabsf(p.k_norm_g[l * 128 + 64 + ln]));
#pragma unroll
      for (int o = 32; o >= 1; o >>= 1) { gqm = fmaxf(gqm, __shfl_xor(gqm, o)); gkm = fmaxf(gkm, __shfl_xor(gkm, o)); }
      gqm = __builtin_amdgcn_readfirstlane(gqm); gkm = __builtin_amdgcn_readfirstlane(gkm);
    }
    const float mfixC = 128.f * gqm * gkm * QSCALE;
    if (it < nC + nBw) {
      const bool isB = it >= nC;
      if (isB) it -= nC;
      const int b = it >> 7, h = (it >> 4) & 7, qb = it & 15;
      const int kvh = h >> 2;
      const int br = isB ? 0 : 1;
      const size_t qrow0 = (size_t)b * S + qb * 256;
      a.q = p.Q + qrow0 * 2048 + br * 1024 + h * 128;
      a.z = p.Z + qrow0 * 3072 + (br + 1) * 1024 + h * 128;
      const int kcol = br * 256 + kvh * 128, slot = br * 2 + kvh;
      a.kctx = p.Kb + ((size_t)RL + (size_t)b * L) * 512 + kcol;
      a.vctx = p.VtC + (size_t)(b * 4 + slot) * 128 * L;
      int k0, k1;
      if (isB) { k0 = qb * 256 - 128; if (k0 < 0) k0 = 0; k1 = qb * 256 + 384; if (k1 > S) k1 = S; }
      else { k0 = 0; k1 = S; }
      a.lat_key0 = k0;
      a.n_lat_tiles = (k1 - k0) >> 6;
      a.klat = p.Kb + ((size_t)b * S + k0) * 512 + kcol;
      a.vlat = p.VtL + (size_t)(b * 4 + slot) * 128 * S + k0;
      a.q_t0 = qb * 256;
      a.band = isB ? 1 : 0;
      a.has_sink = isB ? 1 : 0;
      a.sink_l2 = isB ? p.attn_sink[l * 8 + h] * LOG2E : 0.f;
      a.fixedm = isB ? 0 : 1; a.mfix = mfixC;
    } else {
      it -= nC + nBw;
      const int h = it & 7, br = (it >> 3) & 1, b = it >> 4;
      const int kvh = h >> 2;
      const size_t qrow0 = (size_t)RL + (size_t)b * L;
      a.q = p.Q + qrow0 * 2048 + br * 1024 + h * 128;
      a.z = p.Z + qrow0 * 3072 + (br + 1) * 1024 + h * 128;
      const int kcol = br * 256 + kvh * 128, slot = br * 2 + kvh;
      a.kctx = p.Kb + ((size_t)RL + (size_t)b * L) * 512 + kcol;
      a.vctx = p.VtC + (size_t)(b * 4 + slot) * 128 * L;
      a.klat = a.kctx; a.vlat = a.vctx;
      a.n_lat_tiles = 0; a.lat_key0 = 0; a.q_t0 = 0; a.band = 0;
      a.has_sink = (br == 0) ? 1 : 0;
      a.sink_l2 = (br == 0) ? p.attn_sink[l * 8 + h] * LOG2E : 0.f;
      a.fixedm = (br == 0) ? 0 : 1; a.mfix = mfixC;
    }
    attn_item(a, lds);
  }
}

DI void phase_merge(CParams& p, int chunk, int l, char* lds) {
  const int NB = p.NB, RL = NB * S, R = NB * (S + L);
  const bool last = (l == DEPTH - 1);
  const int MT = (last ? RL : R) / 256, NT = 8;
  const int tid = otid();
  const int lane = tid & 63, w = tid >> 6, wm = w >> 1, wn = w & 1, r = lane & 31, hh = lane >> 5;
  for (int ti = 0;; ++ti) {
    int mt, nt;
    if (!tile_map(ti, MT, NT, mt, nt)) break;
    const int m0 = mt * 256, n0 = nt * 128;
    f32x16 tot[2][2];
#pragma unroll
    for (int i = 0; i < 2; ++i)
#pragma unroll
      for (int j = 0; j < 2; ++j)
#pragma unroll
        for (int x = 0; x < 16; ++x) tot[i][j][x] = 0.f;
#pragma unroll 1
    for (int n = 0; n < 3; ++n) {
      f32x16 acc[2][2];
      gemm_core<128, false>(p.Z + (size_t)m0 * 3072 + n * 1024, 3072, 64, (size_t)128 * 3072,
                            p.WbT + ((size_t)(l * 3 + n) * D + n0) * D, 64, 8192, 0, D, lds, acc);
#pragma unroll
      for (int i = 0; i < 2; ++i)
#pragma unroll
        for (int j = 0; j < 2; ++j)
#pragma unroll
          for (int g = 0; g < 4; ++g) {
            const size_t row = (size_t)m0 + wm * 64 + i * 32 + r;
            const int col = n0 + wn * 64 + j * 32 + 8 * g + 4 * hh;
            uint2 sv = *(const uint2*)(p.Ms + row * 3072 + n * 1024 + col);
            tot[i][j][4 * g + 0] += bflo(sv.x) * acc[i][j][4 * g + 0];
            tot[i][j][4 * g + 1] += bfhi(sv.x) * acc[i][j][4 * g + 1];
            tot[i][j][4 * g + 2] += bflo(sv.y) * acc[i][j][4 * g + 2];
            tot[i][j][4 * g + 3] += bfhi(sv.y) * acc[i][j][4 * g + 3];
          }
    }
#pragma unroll
    for (int i = 0; i < 2; ++i)
#pragma unroll
      for (int j = 0; j < 2; ++j)
#pragma unroll
        for (int g = 0; g < 4; ++g) {
          const size_t row = (size_t)m0 + wm * 64 + i * 32 + r;
          const int col = n0 + wn * 64 + j * 32 + 8 * g + 4 * hh;
          uint2 o; o.x = pack2(tot[i][j][4 * g], tot[i][j][4 * g + 1]); o.y = pack2(tot[i][j][4 * g + 2], tot[i][j][4 * g + 3]);
          *(uint2*)(p.Hb + ((row >> 7) * 16 + (col >> 6)) * 8192 + (row & 127) * 64 + (col & 63)) = o;
        }
  }
}

DI void phase_outproj(CParams& p, int chunk, int l, char* lds) {
  const int NB = p.NB, RL = NB * S, R = NB * (S + L);
  const bool last = (l == DEPTH - 1);
  const int MT = (last ? RL : R) / 256, NT = 8;
  const int tid = otid();
  const int w = tid >> 6, wm = w >> 1, wn = w & 1;
  for (int ti = 0;; ++ti) {
    int mt, nt;
    if (!tile_map(ti, MT, NT, mt, nt)) break;
    const int m0 = mt * 256, n0 = nt * 128;
    f32x16 acc[2][2];
    gemm_core<128, true>(p.Hb + (size_t)m0 * D, 64, 8192, 131072, p.WoT + ((size_t)l * D + n0) * D, 64, 8192, 0, D, lds, acc);
    stage_acc<2>(lds, acc, wm, wn * 64, true);
    const int row = tid >> 1, half = tid & 1;
    const int gr = m0 + row;
    const float* src; float* dst; int mrow;
    if (gr < RL) {
      int b = gr / S, t = gr % S; int bg = chunk * NB + b;
      size_t off = ((size_t)bg * S + t) * D + n0 + half * 64;
      src = (l == 0 ? p.x : p.out) + off; dst = p.out + off; mrow = bg;
    } else {
      int rc = gr - RL; int b = rc / L, t = rc % L; int bg = chunk * NB + b;
      size_t off = ((size_t)bg * L + t) * D + n0 + half * 64;
      src = (l == 0 ? p.ctx : p.xc) + off; dst = p.xc + off; mrow = 16;
    }
    const float* gate = p.modv + ((size_t)l * 17 + mrow) * 3072 + 2048 + n0 + half * 64;
    const float* Cs = (const float*)lds + row * 132 + half * 64;
    float4 xv[16], gv[16];
#pragma unroll
    for (int j = 0; j < 16; ++j) { xv[j] = *(const float4*)(src + j * 4); gv[j] = *(const float4*)(gate + j * 4); }
#pragma unroll
    for (int j = 0; j < 16; ++j) {
      float4 cv = *(const float4*)(Cs + j * 4);
      float4 o;
      o.x = xv[j].x + gv[j].x * cv.x; o.y = xv[j].y + gv[j].y * cv.y; o.z = xv[j].z + gv[j].z * cv.z; o.w = xv[j].w + gv[j].w * cv.w;
      *(float4*)(dst + j * 4) = o;
    }
  }
}

DI void phase_final(CParams& p) {
  const int tid_ = otid();
  const int lane = tid_ & 63;
  const int wg = blockIdx.x * 8 + (tid_ >> 6), nw = gridDim.x * 8;
  for (int r = wg; r < NBATCH * S; r += nw) {
    float* src = p.out + (size_t)r * D;
    float4 v[4]; float ss = 0.f;
#pragma unroll
    for (int i = 0; i < 4; ++i) {
      v[i] = *(const float4*)(src + i * 256 + lane * 4);
      ss += v[i].x * v[i].x + v[i].y * v[i].y + v[i].z * v[i].z + v[i].w * v[i].w;
    }
#pragma unroll
    for (int o = 32; o >= 1; o >>= 1) ss += __shfl_xor(ss, o);
    float rstd = rsqrtf(ss * (1.f / D) + EPS);
#pragma unroll
    for (int i = 0; i < 4; ++i) {
      int cidx = i * 256 + lane * 4;
      float4 gg = *(const float4*)(p.final_g + cidx);
      float4 o;
      o.x = v[i].x * rstd * gg.x; o.y = v[i].y * rstd * gg.y; o.z = v[i].z * rstd * gg.z; o.w = v[i].w * rstd * gg.w;
      *(float4*)(src + cidx) = o;
    }
  }
}

#ifndef DUP_PHASE
#define DUP_PHASE 0
#endif
__global__ void __launch_bounds__(NTHR, 2) fwd_megakernel(Params p_unused) {
  CParams* kp = (CParams*)__builtin_amdgcn_kernarg_segment_ptr();
  cg::grid_group grid = cg::this_grid();
  __shared__ __attribute__((aligned(16))) char lds[LDS_BYTES];
  phase0(*opaque_kp(kp), lds);
  grid.sync();
  phase_mod(*opaque_kp(kp), lds);
  grid.sync();
  for (int chunk = 0; chunk < kp->nchunk; ++chunk) {
    for (int l = 0; l < DEPTH; ++l) {
      phase_prenorm(*opaque_kp(kp), chunk, l);
      grid.sync();
#if DUP_PHASE == 9
      grid.sync(); grid.sync(); grid.sync(); grid.sync(); grid.sync();
#endif
      phase_gemm_in(*opaque_kp(kp), chunk, l, lds);
      grid.sync();
#if DUP_PHASE == 3
      phase_gemm_in(*opaque_kp(kp), chunk, l, lds);
      grid.sync();
#endif
#if DUP_PHASE == 4
      phase_mixers(*opaque_kp(kp), chunk, l, lds, 1);
      grid.sync();
#endif
#if DUP_PHASE == 6
      phase_mixers(*opaque_kp(kp), chunk, l, lds, 2);
      grid.sync();
#endif
      phase_mixers(*opaque_kp(kp), chunk, l, lds);
      grid.sync();
      phase_merge(*opaque_kp(kp), chunk, l, lds);
      grid.sync();
#if DUP_PHASE == 5
      phase_merge(*opaque_kp(kp), chunk, l, lds);
      grid.sync();
#endif
      phase_outproj(*opaque_kp(kp), chunk, l, lds);
      grid.sync();
    }
  }
  phase_final(*opaque_kp(kp));
}

extern "C" void kernel_launch(void* const* d_in, const int* in_sizes, int n_in,
                              void* d_out, int out_size, void* d_ws, size_t ws_size,
                              hipStream_t stream) {
  static int grid_blocks = 0;
  if (!grid_blocks) {
    int dev = 0, cus = 0, per_cu = 0;
    (void)hipGetDevice(&dev);
    (void)hipDeviceGetAttribute(&cus, hipDeviceAttributeMultiprocessorCount, dev);
    (void)hipOccupancyMaxActiveBlocksPerMultiprocessor(&per_cu, fwd_megakernel, NTHR, 0);
    if (per_cu > 1) per_cu = 1;
    if (per_cu < 1) per_cu = 1;
    grid_blocks = cus * per_cu;
  }
  Params p{};
  const float* const* in = (const float* const*)d_in;
  p.x = in[0]; p.c = in[1]; p.ctx = in[2]; p.c_ctx = in[3]; p.norm_g = in[4]; p.w_mod = in[5]; p.b_mod = in[6];
  p.w_in = in[7]; p.conv_w = in[8]; p.conv_b = in[9]; p.lru_wa = in[10]; p.lru_ba = in[11]; p.lru_wx = in[12];
  p.lru_bx = in[13]; p.lru_lambda = in[14]; p.attn_sink = in[15]; p.q_norm_g = in[16]; p.k_norm_g = in[17];
  p.w_branch = in[18]; p.w_out = in[19]; p.final_g = in[20];
  p.out = (float*)d_out;
  char* ws = (char*)d_ws;
  size_t off = 0;
  auto take = [&](size_t bytes) { char* r = ws + off; off += (bytes + 255) & ~(size_t)255; return r; };
  p.ctr = (int*)take(256);
  p.modv = (float*)take((size_t)DEPTH * 17 * 3072 * 4);
  p.sc = (float*)take((size_t)17 * D * 4);
  p.rope = (float*)take(4096 * 4);
  p.xc = (float*)take((size_t)NBATCH * L * D * 4);
  p.WinT = (u16*)take((size_t)DEPTH * INW * D * 2);
  p.WbT = (u16*)take((size_t)DEPTH * 3 * D * D * 2);
  p.WoT = (u16*)take((size_t)DEPTH * D * D * 2);
  const size_t fixed = off;
  int NB = 8;
  while (NB > 1) {
    size_t R = (size_t)NB * (S + L);
    size_t need = fixed + R * (size_t)(1024 + 1024 + 3072 + 2048 + 512 + 512 + 3072) * 2 + 8 * 256;
    if (need <= ws_size) break;
    NB >>= 1;
  }
  p.NB = NB; p.nchunk = NBATCH / NB;
  const size_t R = (size_t)NB * (S + L);
  p.Hb = (u16*)take(R * 1024 * 2);
  p.U = (u16*)take(R * 1024 * 2);
  p.Z = (u16*)take(R * 3072 * 2);
  p.Q = (u16*)take(R * 2048 * 2);
  p.Kb = (u16*)take(R * 512 * 2);
  p.VtL = (u16*)take((size_t)NB * 4 * 128 * S * 2);
  p.VtC = (u16*)take((size_t)NB * 4 * 128 * L * 2);
  p.Ms = (u16*)take(R * 3072 * 2);
  void* args[] = {&p};
  hipError_t e = hipLaunchCooperativeKernel((void*)fwd_megakernel, dim3(grid_blocks), dim3(NTHR), args, 0, stream);
  if (e != hipSuccess) fprintf(stderr, "cooperative launch failed: %s (grid %d)\n", hipGetErrorString(e), grid_blocks);
}
```

```cpp
#include <hip/hip_runtime.h>
#include <hip/hip_cooperative_groups.h>
#include <cstdio>
#include <cstdint>
namespace cg = cooperative_groups;

typedef unsigned short u16;
typedef __attribute__((ext_vector_type(8))) short bf16x8;
typedef __attribute__((ext_vector_type(4))) short s16x4;
typedef __attribute__((ext_vector_type(16))) float f32x16;
typedef __bf16 bf16x2_t __attribute__((ext_vector_type(2)));
typedef float float2_t __attribute__((ext_vector_type(2)));
typedef __attribute__((ext_vector_type(4))) unsigned u32x4;
typedef __attribute__((ext_vector_type(2))) unsigned u32x2;

#define DI __device__ __forceinline__
#define MFMA32(a, b, c) __builtin_amdgcn_mfma_f32_32x32x16_bf16((a), (b), (c), 0, 0, 0)

constexpr int D = 1024, NBATCH = 16, S = 4096, L = 256, DEPTH = 4, INW = 10240;
constexpr int LDS_BYTES = 147456;
constexpr int NTHR = 512;
constexpr float EPS = 1e-6f;
constexpr float QSCALE = 0.08838834764831845f * 1.4426950408889634f;
constexpr float LOG2E = 1.4426950408889634f;

struct Params {
  const float *x, *c, *ctx, *c_ctx, *norm_g, *w_mod, *b_mod, *w_in, *conv_w, *conv_b, *lru_wa, *lru_ba, *lru_wx, *lru_bx,
      *lru_lambda, *attn_sink, *q_norm_g, *k_norm_g, *w_branch, *w_out, *final_g;
  float* out;
  u16 *WinT, *WbT, *WoT;
  u16 *Hb, *U, *Z, *Q, *Kb, *VtL, *VtC, *Ms;
  float *modv, *sc, *rope, *xc;
  int* ctr;
  int NB;
  int nchunk;
};

typedef const __attribute__((address_space(4))) Params CParams;
DI CParams* opaque_kp(CParams* q) { asm volatile("" : "+s"(q)); return q; }

DI unsigned pack2(float a, float b) {
  float2_t f = {a, b};
  bf16x2_t v = __builtin_convertvector(f, bf16x2_t);
  return __builtin_bit_cast(unsigned, v);
}
DI float bf2f(u16 v) { return __uint_as_float(((unsigned)v) << 16); }
DI float bflo(unsigned v) { return __uint_as_float(v << 16); }
DI float bfhi(unsigned v) { return __uint_as_float(v & 0xffff0000u); }
DI float sigmoidf_(float x) { return __builtin_amdgcn_rcpf(1.f + __expf(-x)); }
DI float siluf_(float x) { return x * __builtin_amdgcn_rcpf(1.f + __expf(-x)); }
DI int otid() { int t = threadIdx.x; asm volatile("" : "+v"(t)); return t; }
DI int crow(int i, int hh) { return (i & 3) + 8 * (i >> 2) + 4 * hh; }

DI void phase0(CParams& p, char* lds) {
  const int tid = otid();
  float* tile = (float*)lds;
  const int n_in = DEPTH * 16 * 160, n_b = DEPTH * 3 * 256, n_o = DEPTH * 256;
  for (int it = blockIdx.x; it < n_in + n_b + n_o; it += gridDim.x) {
    const float* src; u16* dst; int ldsrc; int dstride = 64;
    if (it < n_in) {
      int l = it / 2560, rem = it % 2560, kt = rem / 160, nt = rem % 160;
      src = p.w_in + (size_t)l * D * INW + (size_t)(kt * 64) * INW + nt * 64; ldsrc = INW;
      const int o = nt >> 2;
      const int n256 = (o < 8) ? o : (o >= 28) ? 16 + (o - 28) : (o >= 24) ? 12 + (o - 24) : (o == 23) ? 39 : (o == 22) ? 38
                     : (o >= 18) ? 34 + (o - 18) : (o >= 14) ? 8 + (o - 14) : (o == 13) ? 33 : (o == 12) ? 32 : 28 + (o - 8);
      dst = p.WinT + (size_t)l * INW * D + ((size_t)n256 * 256 + (nt & 3) * 64) * D + kt * 64; dstride = D;
    } else if (it < n_in + n_b) {
      int i2 = it - n_in; int mat = i2 / 256, rem = i2 % 256, kt = rem / 16, nt = rem % 16;
      src = p.w_branch + (size_t)mat * D * D + (size_t)(kt * 64) * D + nt * 64; ldsrc = D;
      dst = p.WbT + (size_t)mat * D * D + ((size_t)(nt >> 1) * 16 + kt) * 8192 + (nt & 1) * 4096;
    } else {
      int i2 = it - n_in - n_b; int mat = i2 / 256, rem = i2 % 256, kt = rem / 16, nt = rem % 16;
      src = p.w_out + (size_t)mat * D * D + (size_t)(kt * 64) * D + nt * 64; ldsrc = D;
      dst = p.WoT + (size_t)mat * D * D + ((size_t)(nt >> 1) * 16 + kt) * 8192 + (nt & 1) * 4096;
    }
    __syncthreads();
#pragma unroll
    for (int i = 0; i < 2; ++i) {
      int c = tid + NTHR * i; int row = c >> 4, c4 = c & 15;
      float4 v = *(const float4*)(src + (size_t)row * ldsrc + c4 * 4);
      float* t = tile + row * 65 + c4 * 4;
      t[0] = v.x; t[1] = v.y; t[2] = v.z; t[3] = v.w;
    }
    __syncthreads();
    {
      int c = tid; int nrow = c >> 3, k8 = c & 7;
      float v[8];
#pragma unroll
      for (int j = 0; j < 8; ++j) v[j] = tile[(k8 * 8 + j) * 65 + nrow];
      uint4 o; o.x = pack2(v[0], v[1]); o.y = pack2(v[2], v[3]); o.z = pack2(v[4], v[5]); o.w = pack2(v[6], v[7]);
      *(uint4*)(dst + (size_t)nrow * dstride + k8 * 8) = o;
    }
  }
  const int gt = blockIdx.x * NTHR + tid, gn = gridDim.x * NTHR;
  for (int i = gt; i < 17 * D; i += gn) {
    int r = i / D, k = i % D;
    float v = (r < 16) ? p.c[r * D + k] : p.c_ctx[k];
    p.sc[i] = siluf_(v);
  }
  for (int i = gt; i < 64 * 32; i += gn) {
    int pos = i >> 5, pp = i & 31;
    float inv = powf(10000.f, -(float)pp / 32.f);
    float ang = (float)pos * inv;
    p.rope[i] = cosf(ang);
    p.rope[2048 + i] = sinf(ang);
  }
  if (blockIdx.x == 0 && tid < 64) p.ctr[tid] = 0;
}

DI void phase_mod(CParams& p, char* lds) {
  const int tid = otid();
  float* red = (float*)lds;
  const int col = tid & 63, kg = tid >> 6;
  for (int it = blockIdx.x; it < DEPTH * 48; it += gridDim.x) {
    int l = it / 48, cb = it % 48;
    float acc[17];
#pragma unroll
    for (int r = 0; r < 17; ++r) acc[r] = 0.f;
    const float* w = p.w_mod + (size_t)l * D * 3072 + cb * 64 + col;
    for (int k = kg * 128; k < kg * 128 + 128; ++k) {
      float wv = w[(size_t)k * 3072];
#pragma unroll
      for (int r = 0; r < 17; ++r) acc[r] += p.sc[r * D + k] * wv;
    }
    __syncthreads();
#pragma unroll
    for (int r = 0; r < 17; ++r) red[(kg * 17 + r) * 64 + col] = acc[r];
    __syncthreads();
    for (int i = tid; i < 17 * 64; i += NTHR) {
      int r = i >> 6, cc = i & 63;
      float s = 0.f;
#pragma unroll
      for (int g = 0; g < 8; ++g) s += red[(g * 17 + r) * 64 + cc];
      p.modv[((size_t)l * 17 + r) * 3072 + cb * 64 + cc] = s + p.b_mod[l * 3072 + cb * 64 + cc];
    }
  }
}

DI void phase_prenorm(CParams& p, int chunk, int l) {
  const int NB = p.NB, RL = NB * S, R = NB * (S + L);
  const int tid_ = otid();
  const int lane = tid_ & 63;
  const int wg = blockIdx.x * 8 + (tid_ >> 6), nw = gridDim.x * 8;
  const float* g = p.norm_g + l * D;
  for (int r = wg; r < R; r += nw) {
    const float* src; int mrow;
    if (r < RL) {
      int b = r / S, t = r % S; int bg = chunk * NB + b;
      src = (l == 0 ? p.x : p.out) + ((size_t)bg * S + t) * D; mrow = bg;
    } else {
      int rc = r - RL; int b = rc / L, t = rc % L; int bg = chunk * NB + b;
      src = (l == 0 ? p.ctx : p.xc) + ((size_t)bg * L + t) * D; mrow = 16;
    }
    const float* mv = p.modv + ((size_t)l * 17 + mrow) * 3072;
    float4 v[4]; float ss = 0.f;
#pragma unroll
    for (int i = 0; i < 4; ++i) {
      v[i] = *(const float4*)(src + i * 256 + lane * 4);
      ss += v[i].x * v[i].x + v[i].y * v[i].y + v[i].z * v[i].z + v[i].w * v[i].w;
    }
#pragma unroll
    for (int o = 32; o >= 1; o >>= 1) ss += __shfl_xor(ss, o);
    float rstd = rsqrtf(ss * (1.f / D) + EPS);
#pragma unroll
    for (int i = 0; i < 4; ++i) {
      int cidx = i * 256 + lane * 4;
      float4 gg = *(const float4*)(g + cidx);
      float4 sh = *(const float4*)(mv + cidx);
      float4 scl = *(const float4*)(mv + 1024 + cidx);
      float h0 = v[i].x * rstd * gg.x * (1.f + scl.x) + sh.x;
      float h1 = v[i].y * rstd * gg.y * (1.f + scl.y) + sh.y;
      float h2 = v[i].z * rstd * gg.z * (1.f + scl.z) + sh.z;
      float h3 = v[i].w * rstd * gg.w * (1.f + scl.w) + sh.w;
      uint2 o; o.x = pack2(h0, h1); o.y = pack2(h2, h3);
      *(uint2*)(p.Hb + (size_t)r * D + cidx) = o;
    }
  }
}

template <int BN, bool PIPE>
DI void gemm_core(const u16* A, int lda, int ksa, size_t a_blk, const u16* Bt, int ldb, int ksb, size_t b_blk, int K, char* ldsc,
                  f32x16 (&acc)[BN / 64][2]) {
  constexpr int MI = BN / 64;
  constexpr int SS = 32768 + BN * 128;
  const int tid = otid(), lane = tid & 63, w = tid >> 6;
  const int wm = (BN == 256) ? (w >> 2) : (w >> 1), wn = (BN == 256) ? (w & 3) : (w & 1);
  const int r = lane & 31, hh = lane >> 5;
  const int drow = lane >> 3, dcp = lane & 7;
  const int chunk0 = dcp ^ (drow >> 1);
  const u16* gAe = A + (size_t)(w >> 2) * a_blk + (size_t)((w & 3) * 32 + drow) * lda + chunk0 * 8;
  const u16* gAo = gAe + (size_t)8 * lda + ((chunk0 ^ 4) - chunk0) * 8;
  const size_t a16 = (size_t)16 * lda;
  const int brow0 = (BN == 256) ? (w & 3) * 32 : w * 16;
  const u16* gBe = Bt + ((BN == 256) ? (size_t)(w >> 2) * b_blk : (size_t)0) + (size_t)(brow0 + drow) * ldb + chunk0 * 8;
  const u16* gBo = gBe + (size_t)8 * ldb + ((chunk0 ^ 4) - chunk0) * 8;
  const size_t b16 = (size_t)16 * ldb;
#pragma unroll
  for (int i = 0; i < MI; ++i)
#pragma unroll
    for (int j = 0; j < 2; ++j)
#pragma unroll
      for (int x = 0; x < 16; ++x) acc[i][j][x] = 0.f;
  auto DMA = [&](int kt, int stage) {
    char* sa = ldsc + stage * SS + (w * 4) * 1024;
    char* sb = ldsc + stage * SS + 32768 + ((BN == 256) ? (w * 4) : (w * 2)) * 1024;
    const size_t ka = (size_t)kt * ksa, kb = (size_t)kt * ksb;
    __builtin_amdgcn_global_load_lds((const unsigned*)(gAe + ka), (unsigned*)(sa), 16, 0, 0);
    __builtin_amdgcn_global_load_lds((const unsigned*)(gBe + kb), (unsigned*)(sb), 16, 0, 0);
    __builtin_amdgcn_global_load_lds((const unsigned*)(gAo + ka), (unsigned*)(sa + 1024), 16, 0, 0);
    __builtin_amdgcn_global_load_lds((const unsigned*)(gBo + kb), (unsigned*)(sb + 1024), 16, 0, 0);
    __builtin_amdgcn_global_load_lds((const unsigned*)(gAe + a16 + ka), (unsigned*)(sa + 2048), 16, 0, 0);
    __builtin_amdgcn_global_load_lds((const unsigned*)(gAo + a16 + ka), (unsigned*)(sa + 3072), 16, 0, 0);
    if (BN == 256) {
      __builtin_amdgcn_global_load_lds((const unsigned*)(gBe + b16 + kb), (unsigned*)(sb + 2048), 16, 0, 0);
      __builtin_amdgcn_global_load_lds((const unsigned*)(gBo + b16 + kb), (unsigned*)(sb + 3072), 16, 0, 0);
    }
  };
  const int sw = (r >> 1) & 7;
  int koff[4];
#pragma unroll
  for (int ks = 0; ks < 4; ++ks) koff[ks] = ((2 * ks + hh) ^ sw) << 4;
  auto COMPUTE = [&](int stage) {
    const char* ab = ldsc + stage * SS + (wm * (MI * 32) + r) * 128;
    const char* bb = ldsc + stage * SS + 32768 + (wn * 64 + r) * 128;
    bf16x8 fa[2][MI], fb[2][2];
    auto LDF = [&](int ks, int slot) {
#pragma unroll
      for (int i = 0; i < MI; ++i) fa[slot][i] = *(const bf16x8*)(ab + i * 32 * 128 + koff[ks]);
#pragma unroll
      for (int j = 0; j < 2; ++j) fb[slot][j] = *(const bf16x8*)(bb + j * 32 * 128 + koff[ks]);
    };
    auto MM = [&](int slot) {
#pragma unroll
      for (int i = 0; i < MI; ++i)
#pragma unroll
        for (int j = 0; j < 2; ++j) acc[i][j] = MFMA32(fb[slot][j], fa[slot][i], acc[i][j]);
    };
    if (!PIPE) {
#pragma unroll
      for (int ks = 0; ks < 4; ++ks) { LDF(ks, 0); MM(0); }
      return;
    }
    LDF(0, 0); LDF(1, 1);
    __builtin_amdgcn_sched_barrier(0);
    MM(0); LDF(2, 0);
    __builtin_amdgcn_sched_barrier(0);
    MM(1); LDF(3, 1);
    __builtin_amdgcn_sched_barrier(0);
    MM(0); MM(1);
  };
  const int KT = K >> 6;
  __syncthreads();
  DMA(0, 0);
  __syncthreads();
  for (int kt = 0; kt < KT; kt += 2) {
    DMA(kt + 1, 1);
    COMPUTE(0);
    __syncthreads();
    if (kt + 2 < KT) DMA(kt + 2, 0);
    COMPUTE(1);
    __syncthreads();
  }
}

template <int MI>
DI void stage_acc(char* ldsc, f32x16 (&acc)[MI][2], int wm, int ncol0, bool active) {
  const int tid = otid(), lane = tid & 63;
  const int r = lane & 31, hh = lane >> 5;
  float* Cs = (float*)ldsc;
  if (active) {
#pragma unroll
    for (int i = 0; i < MI; ++i)
#pragma unroll
      for (int j = 0; j < 2; ++j)
#pragma unroll
        for (int g = 0; g < 4; ++g) {
          int m = wm * (MI * 32) + i * 32 + r;
          int n = ncol0 + j * 32 + 8 * g + 4 * hh;
          float4 v; v.x = acc[i][j][4 * g]; v.y = acc[i][j][4 * g + 1]; v.z = acc[i][j][4 * g + 2]; v.w = acc[i][j][4 * g + 3];
          *(float4*)(Cs + m * 132 + n) = v;
        }
  }
  __syncthreads();
}

DI void read_row64(const char* ldsc, int row, int half, float (&v)[64]) {
  const float* Cs = (const float*)ldsc + row * 132 + half * 64;
#pragma unroll
  for (int j = 0; j < 16; ++j) {
    float4 t = *(const float4*)(Cs + j * 4);
    v[j * 4] = t.x; v[j * 4 + 1] = t.y; v[j * 4 + 2] = t.z; v[j * 4 + 3] = t.w;
  }
}

DI void store_row64_bf16(u16* dst, const float (&v)[64]) {
#pragma unroll
  for (int j = 0; j < 8; ++j) {
    uint4 o;
    o.x = pack2(v[j * 8], v[j * 8 + 1]); o.y = pack2(v[j * 8 + 2], v[j * 8 + 3]);
    o.z = pack2(v[j * 8 + 4], v[j * 8 + 5]); o.w = pack2(v[j * 8 + 6], v[j * 8 + 7]);
    *(uint4*)(dst + j * 8) = o;
  }
}

namespace pg8 {
#define PG8_LAS __attribute__((address_space(3)))
typedef unsigned short bf16_t;
typedef short bf16x8 __attribute__((ext_vector_type(8)));
typedef float f32x4 __attribute__((ext_vector_type(4)));
typedef unsigned u32x4 __attribute__((ext_vector_type(4)));
constexpr int BM = 256, BK = 64, HALF = 128, HTB = HALF * BK * 2  , STAGE_BYTES = 8 * HTB, NXCD = 8, WGM = 8;

__host__ __device__ __forceinline__ int lds_byte(int r, int c) { const int st = (r >> 4) * 2 + (c >> 5), rr = r & 15, cc = c & 31, ob = rr * 64 + cc * 2; return st * 1024 + (ob ^ (((ob >> 9) & 1) << 5)); }
__host__ __device__ __forceinline__ void stage_rc(int b, int& R, int& C) { const int st = b / 1024, sb = b % 1024, swz = sb ^ (((sb >> 9) & 1) << 5); R = (st >> 1) * 16 + swz / 64; C = (st & 1) * 32 + (swz % 64) / 2; }
__host__ __device__ __forceinline__ int perm32(int rho) { const int n = rho >> 4, i = rho & 15; return 8 * (i >> 2) + 4 * n + (i & 3); }
struct Unit { int pm, pn; };
struct Gemm { const bf16_t* A; const bf16_t* Bt; int M, N, K; };
struct StaticOrder {
    int nM, nN, nwg, G, c;
    __host__ __device__ void init(int M, int N, int G_, int c_) { nM = M / BM; nN = N / BM; nwg = nM * nN; G = G_; c = c_; }
    __host__ __device__ bool next(int i, Unit& u) const {
        const long L = (long)i * G + c; if (L >= nwg) return false;
        int wgid = (int)L; { const int q = nwg / NXCD, r = nwg % NXCD, xcd = wgid % NXCD, off = wgid / NXCD; wgid = (xcd < r ? xcd * (q + 1) : r * (q + 1) + (xcd - r) * q) + off; }
        const int nig = WGM * nN, gid = wgid / nig, fm = gid * WGM, gsz = (nM - fm) < WGM ? (nM - fm) : WGM;
        u.pm = fm + ((wgid % nig) % gsz); u.pn = (wgid % nig) / gsz; return true;
    }
    __device__ __forceinline__ void a_ready(const Unit&) const {}
    __device__ __forceinline__ void done(const Unit&) const {}
};
template <class Epi, class Sched, bool STAMP = false>
__device__ __forceinline__ void gemm_phase(PG8_LAS unsigned char* lds, const Gemm g, const Sched& S, const Epi& E, unsigned long long* stamps) {
    int tid_raw = threadIdx.x; asm volatile("" : "+v"(tid_raw));
    const int tid = tid_raw, wid = __builtin_amdgcn_readfirstlane(tid >> 6), lane = tid & 63, wr = wid >> 2, wc = wid & 3, fr = lane & 15, fq = lane >> 4;
    const int K = g.K, nt = K / BK;
    int ts_lo = 0, ts_hi = 0, nts = 0; const unsigned long long rt_entry = STAMP ? (unsigned long long)wall_clock64() : 0ull;
#define PG8_STAMP() do { if (STAMP && wid == 0 && nts < 64) { const unsigned long long _c = (unsigned long long)clock64(); \
        ts_lo = (lane == nts) ? (int)(unsigned)_c : ts_lo; ts_hi = (lane == nts) ? (int)(unsigned)(_c >> 32) : ts_hi; ++nts; } } while (0)
    PG8_STAMP();
    unsigned voffA[2], voffB[2];
#pragma unroll
    for (int i = 0; i < 2; ++i) { int R, C; stage_rc(tid * 16 + i * 8192, R, C); const int Rb = Epi::PERM ? ((R & ~31) + perm32(R & 31)) : R;
        voffA[i] = (unsigned)(R * K + C) * 2u; voffB[i] = (unsigned)(Rb * K + C) * 2u; }
    const size_t kstep = (size_t)(BK * 2);
    const size_t hstep = (size_t)HALF * K * 2;
    const size_t tstep = 2 * hstep;
    const unsigned ldsw = (unsigned)wid * 1024u;
    const int aoff = lds_byte(wr * 64 + fr, fq * 8), boff = lds_byte(wc * 32 + fr, fq * 8);
#define PG8_SA(b, h) (((b) * 2 + (h)) * HTB)
#define PG8_SB(b, h) ((4 + (b) * 2 + (h)) * HTB)
#define PG8_STAGE(bufoff, gbase, voff) do { _Pragma("unroll") for (int _i = 0; _i < 2; ++_i) \
        __builtin_amdgcn_global_load_lds((const unsigned*)((const char*)(gbase) + (voff)[_i]), (PG8_LAS unsigned*)(lds + (bufoff) + ldsw + _i * 8192), 16, 0, 0); } while (0)
#define PG8_LDA(dst, b, h) do { _Pragma("unroll") for (int m = 0; m < 4; ++m) _Pragma("unroll") for (int k = 0; k < 2; ++k) dst[m][k] = *(const PG8_LAS bf16x8*)(lds + PG8_SA(b, h) + aoff + m * 2048 + k * 1024); } while (0)
#define PG8_LDB(dst, b, h) do { _Pragma("unroll") for (int n = 0; n < 2; ++n) _Pragma("unroll") for (int k = 0; k < 2; ++k) dst[n][k] = *(const PG8_LAS bf16x8*)(lds + PG8_SB(b, h) + boff + n * 2048 + k * 1024); } while (0)
#define PG8_MMA(ai, bj, At, Bt) do { __builtin_amdgcn_s_setprio(1); _Pragma("unroll") for (int m = 0; m < 4; ++m) _Pragma("unroll") for (int n = 0; n < 2; ++n) _Pragma("unroll") for (int k = 0; k < 2; ++k) \
        acc[ai][bj][m][n] = __builtin_amdgcn_mfma_f32_16x16x32_bf16(Bt[n][k], At[m][k], acc[ai][bj][m][n], 0, 0, 0); __builtin_amdgcn_s_setprio(0); } while (0)
#define PG8_WAIT_V(n) asm volatile("s_waitcnt vmcnt(" #n ")" ::: "memory")
#define PG8_WAIT_L(n) asm volatile("s_waitcnt lgkmcnt(" #n ")" ::: "memory")
#define PG8_BAR __builtin_amdgcn_s_barrier()
#define PG8_SCHED __builtin_amdgcn_sched_barrier(0)
    Unit cur, nxt; int ui = 0;
    if (!S.next(0, cur)) return;
    f32x4 acc[2][2][4][2];
#pragma unroll
    for (int a = 0; a < 2; ++a)
#pragma unroll
        for (int b = 0; b < 2; ++b)
#pragma unroll
            for (int m = 0; m < 4; ++m)
#pragma unroll
                for (int n = 0; n < 2; ++n) acc[a][b][m][n] = (f32x4){0.f, 0.f, 0.f, 0.f};
    bf16x8 At[4][2], B0[2][2], B1[2][2];
    const char* cA = (const char*)g.A + (size_t)cur.pm * tstep; const char* cB = (const char*)g.Bt + (size_t)cur.pn * tstep;
    S.a_ready(cur);
    PG8_STAGE(PG8_SB(0, 0), cB, voffB); PG8_STAGE(PG8_SA(0, 0), cA, voffA); PG8_STAGE(PG8_SB(0, 1), cB + hstep, voffB); PG8_STAGE(PG8_SA(0, 1), cA + hstep, voffA);
    if (wr == 1) PG8_BAR;
    PG8_WAIT_V(4); PG8_BAR;
    PG8_STAGE(PG8_SB(1, 0), cB + kstep, voffB); PG8_STAGE(PG8_SA(1, 0), cA + kstep, voffA); PG8_STAGE(PG8_SB(1, 1), cB + hstep + kstep, voffB);
    PG8_WAIT_V(6); PG8_BAR;
    PG8_STAMP();
    for (;;) {
        const bool has_next = S.next(ui + 1, nxt);
        const char* nA = has_next ? (const char*)g.A + (size_t)nxt.pm * tstep : cA; const char* nB = has_next ? (const char*)g.Bt + (size_t)nxt.pn * tstep : cB;
        for (int t = 0; t < nt; t += 2) {
            const bool last = (t == nt - 2);
            const char* a1 = cA + (size_t)(t + 1) * kstep;
            const char* a2 = last ? nA : cA + (size_t)(t + 2) * kstep; const char* b2 = last ? nB : cB + (size_t)(t + 2) * kstep;
            const char* a3 = a2 + kstep; const char* b3 = b2 + kstep;
            if (last && has_next) S.a_ready(nxt);
            PG8_LDB(B0, 0, 0); PG8_SCHED; PG8_LDA(At, 0, 0); PG8_STAGE(PG8_SA(1, 1), a1 + hstep, voffA);
            PG8_WAIT_L(8); PG8_BAR; PG8_WAIT_L(0); PG8_MMA(0, 0, At, B0); PG8_BAR; PG8_SCHED;
            PG8_LDB(B1, 0, 1); PG8_STAGE(PG8_SB(0, 0), b2, voffB);
            PG8_BAR; PG8_WAIT_L(0); PG8_MMA(0, 1, At, B1); PG8_BAR;
            PG8_LDA(At, 0, 1); PG8_STAGE(PG8_SA(0, 0), a2, voffA);
            PG8_BAR; PG8_WAIT_L(0); PG8_MMA(1, 0, At, B0); PG8_BAR; PG8_SCHED;
            PG8_STAGE(PG8_SB(0, 1), b2 + hstep, voffB);
            PG8_WAIT_V(6); PG8_BAR; PG8_MMA(1, 1, At, B1); PG8_BAR;
            PG8_LDB(B0, 1, 0); PG8_SCHED; PG8_LDA(At, 1, 0); PG8_STAGE(PG8_SA(0, 1), a2 + hstep, voffA);
            PG8_WAIT_L(8); PG8_BAR; PG8_WAIT_L(0); PG8_MMA(0, 0, At, B0); PG8_BAR; PG8_SCHED;
            PG8_LDB(B1, 1, 1); PG8_STAGE(PG8_SB(1, 0), b3, voffB);
            PG8_BAR; PG8_WAIT_L(0); PG8_MMA(0, 1, At, B1); PG8_BAR;
            PG8_LDA(At, 1, 1); PG8_STAGE(PG8_SA(1, 0), a3, voffA);
            PG8_BAR; PG8_WAIT_L(0); PG8_MMA(1, 0, At, B0); PG8_BAR; PG8_SCHED;
            PG8_STAGE(PG8_SB(1, 1), b3 + hstep, voffB);
            PG8_WAIT_V(6); PG8_BAR; PG8_MMA(1, 1, At, B1); PG8_BAR;
        }
        PG8_STAMP();
        if constexpr (!Epi::AFTER_DRAIN) { E(acc, cur, wr, wc, fr, fq); S.done(cur); }
        PG8_STAMP();
        if (!has_next) break;
#pragma unroll
        for (int a = 0; a < 2; ++a)
#pragma unroll
            for (int b = 0; b < 2; ++b)
#pragma unroll
                for (int m = 0; m < 4; ++m)
#pragma unroll
                    for (int n = 0; n < 2; ++n) acc[a][b][m][n] = (f32x4){0.f, 0.f, 0.f, 0.f};
        cur = nxt; cA = nA; cB = nB; ++ui;
    }
    PG8_WAIT_V(0);
    if (wr == 0) PG8_BAR;
    PG8_BAR;
    if constexpr (Epi::AFTER_DRAIN) { E.fused(acc, cur, wr, wc, fr, fq, lds, wid, lane); S.done(cur); }
    PG8_STAMP();
    if (STAMP && wid == 0) { stamps[lane] = lane < nts ? (((unsigned long long)(unsigned)ts_hi << 32) | (unsigned)ts_lo) : 0ull;
        if (lane == 62) stamps[62] = rt_entry; if (lane == 63) stamps[63] = (unsigned long long)wall_clock64(); }
#undef PG8_STAMP
#undef PG8_SA
#undef PG8_SB
#undef PG8_STAGE
#undef PG8_LDA
#undef PG8_LDB
#undef PG8_MMA
#undef PG8_WAIT_V
#undef PG8_WAIT_L
#undef PG8_BAR
#undef PG8_SCHED
}
}

struct EpiIn {
  static constexpr bool PERM = true, AFTER_DRAIN = false;
  CParams* kp;
  __device__ __forceinline__ void operator()(const pg8::f32x4 (&acc)[2][2][4][2], const pg8::Unit& u, int wr, int wc, int fr, int fq) const {
    const int pn = u.pn;
    u16* base; int ld, mode;
    if (pn < 4) { base = kp->U + pn * 256; ld = D; mode = 0; }
    else if (pn < 16) { base = kp->Z + (pn - 4) * 256; ld = 3072; mode = 1; }
    else { base = kp->Ms + (pn - 16) * 256; ld = 3072; mode = 2; }
    const int row0 = u.pm * 256 + wr * 64 + fr;
    const int col0 = wc * 32 + 8 * fq;
    u16* rowp0 = base + (size_t)row0 * ld + col0;
#pragma unroll
    for (int ai = 0; ai < 2; ++ai)
#pragma unroll
      for (int m = 0; m < 4; ++m)
#pragma unroll
        for (int bj = 0; bj < 2; ++bj)
#pragma unroll
          for (int n = 0; n < 2; ++n) {
            pg8::f32x4 v0 = acc[ai][bj][m][n];
            if (mode == 1) {
#pragma unroll
              for (int j = 0; j < 4; ++j) v0[j] = siluf_(v0[j]);
            } else if (mode == 2) {
#pragma unroll
              for (int j = 0; j < 4; ++j) v0[j] = sigmoidf_(v0[j]);
            }
            u32x2 w; w.x = pack2(v0[0], v0[1]); w.y = pack2(v0[2], v0[3]);
            *(u32x2*)(rowp0 + (size_t)(ai * 128 + m * 16) * ld + bj * 128 + n * 4) = w;
          }
  }
};

DI bool tile_map(int i, int MT, int NT, int& mt, int& nt) {
  const int G = gridDim.x, bid = blockIdx.x;
  if ((G & 63) == 0 && (MT & 7) == 0 && (NT % (G >> 6)) == 0) {
    const int SH = G >> 6;
    const int xcd = bid & 7, slot = bid >> 3;
    const int sx = slot & 7, sy = slot >> 3;
    const int nsn = NT / SH, nsm = MT >> 3;
    const int st = i * 8 + xcd;
    if (st >= nsm * nsn) return false;
    mt = (st / nsn) * 8 + sx;
    nt = (st % nsn) * SH + sy;
    return true;
  }
  const int it = bid + i * G;
  if (it >= MT * NT) return false;
  mt = it / NT; nt = it % NT;
  return true;
}

DI void phase_gemm_in(CParams& p, int chunk, int l, char* lds) {
  const int NB = p.NB, RL = NB * S, R = NB * (S + L);
  const int MT = R / 256;
  const u16* Wt = p.WinT + (size_t)l * INW * D;
  {
    pg8::Gemm g{p.Hb, Wt, R, 7168, D};
    pg8::StaticOrder So; So.init(R, 7168, (int)gridDim.x, (int)blockIdx.x);
    EpiIn E{&p};
    pg8::gemm_phase<EpiIn, pg8::StaticOrder, false>((PG8_LAS unsigned char*)lds, g, So, E, nullptr);
  }
  const int tid = otid();
  const int lane = tid & 63, w = tid >> 6, wm = w >> 2, wn = w & 3, r = lane & 31, hh = lane >> 5;
  for (int ti = 0;; ++ti) {
    int mt, jt;
    if (!tile_map(ti, MT, 12, mt, jt)) break;
    const int nt = (jt < 6) ? 8 + jt : 12 + jt;
    const int m0 = mt * 256;
    f32x16 acc[4][2];
    gemm_core<256, false>(p.Hb + (size_t)m0 * D, D, 64, (size_t)128 * D, Wt + (size_t)(28 + jt) * 256 * D, D, 64, (size_t)128 * D, D, lds, acc);
    const bool lat = m0 < RL;
    int b, t0;
    if (lat) { b = m0 / S; t0 = m0 % S; } else { int rc = m0 - RL; b = rc / L; t0 = rc % L; }
    const bool isV = (nt == 13 || nt == 23);
    const bool isC = nt >= 18;
    const bool isQ = (nt >= 8 && nt < 12) || (nt >= 18 && nt < 22);
    auto process_unit = [&](int hsel, int u) {
      if (isV) {
        const int slot = (isC ? 2 : 0) + hsel;
        const int d = u >> 2, tq = u & 3;
        const float* Cs = (const float*)lds;
        u16* dst = lat ? p.VtL + ((size_t)(b * 4 + slot) * 128 + d) * S + t0 + tq * 64
                       : p.VtC + ((size_t)(b * 4 + slot) * 128 + d) * L + t0 + tq * 64;
#pragma unroll 1
        for (int c = 0; c < 4; ++c) {
          float v[16];
#pragma unroll
          for (int j = 0; j < 16; ++j) v[j] = Cs[(tq * 64 + c * 16 + j) * 132 + d];
          uint4 o0, o1;
          o0.x = pack2(v[0], v[1]); o0.y = pack2(v[2], v[3]); o0.z = pack2(v[4], v[5]); o0.w = pack2(v[6], v[7]);
          o1.x = pack2(v[8], v[9]); o1.y = pack2(v[10], v[11]); o1.z = pack2(v[12], v[13]); o1.w = pack2(v[14], v[15]);
          *(uint4*)(dst + c * 16) = o0;
          *(uint4*)(dst + c * 16 + 8) = o1;
        }
      } else {
        const int row = u >> 1, half = u & 1;
        const size_t gr = (size_t)m0 + row;
        const int t = t0 + row;
        const float* Cr = (const float*)lds + row * 132 + half * 64;
        float rstd = 1.f;
        const float* gn = (isQ ? p.q_norm_g : p.k_norm_g) + l * 128 + half * 64;
        if (isC) {
          float ss = 0.f;
#pragma unroll
          for (int j = 0; j < 16; ++j) {
            float4 tv = *(const float4*)(Cr + j * 4);
            ss += tv.x * tv.x + tv.y * tv.y + tv.z * tv.z + tv.w * tv.w;
          }
          ss += __shfl_xor(ss, 1);
          rstd = rsqrtf(ss * (1.f / 128.f) + EPS);
        }
        const int pos = (half == 0) ? (t >> 6) : (t & 63);
        const float* cs = p.rope + pos * 32;
        const float* sn = p.rope + 2048 + pos * 32;
        u16* dst;
        if (isQ) {
          const int head = (isC ? (nt - 18) : (nt - 8)) * 2 + hsel;
          dst = p.Q + gr * 2048 + (isC ? 1024 : 0) + head * 128 + half * 64;
        } else {
          dst = p.Kb + gr * 512 + (isC ? 256 : 0) + hsel * 128 + half * 64;
        }
#pragma unroll 1
        for (int c = 0; c < 2; ++c) {
          float x0[16], x1[16];
#pragma unroll
          for (int j = 0; j < 4; ++j) {
            float4 ta_ = *(const float4*)(Cr + c * 16 + j * 4);
            float4 tb_ = *(const float4*)(Cr + 32 + c * 16 + j * 4);
            x0[4 * j] = ta_.x; x0[4 * j + 1] = ta_.y; x0[4 * j + 2] = ta_.z; x0[4 * j + 3] = ta_.w;
            x1[4 * j] = tb_.x; x1[4 * j + 1] = tb_.y; x1[4 * j + 2] = tb_.z; x1[4 * j + 3] = tb_.w;
          }
          if (isC) {
#pragma unroll
            for (int j = 0; j < 16; ++j) { x0[j] = x0[j] * rstd * gn[c * 16 + j]; x1[j] = x1[j] * rstd * gn[32 + c * 16 + j]; }
          }
          if (lat) {
#pragma unroll
            for (int j = 0; j < 16; ++j) {
              float c_ = cs[c * 16 + j], s_ = sn[c * 16 + j];
              float a0 = x0[j], a1 = x1[j];
              x0[j] = a0 * c_ - a1 * s_;
              x1[j] = a1 * c_ + a0 * s_;
            }
          }
          if (isQ) {
#pragma unroll
            for (int j = 0; j < 16; ++j) { x0[j] *= QSCALE; x1[j] *= QSCALE; }
          }
          uint4 o0, o1, o2, o3;
          o0.x = pack2(x0[0], x0[1]); o0.y = pack2(x0[2], x0[3]); o0.z = pack2(x0[4], x0[5]); o0.w = pack2(x0[6], x0[7]);
          o1.x = pack2(x0[8], x0[9]); o1.y = pack2(x0[10], x0[11]); o1.z = pack2(x0[12], x0[13]); o1.w = pack2(x0[14], x0[15]);
          o2.x = pack2(x1[0], x1[1]); o2.y = pack2(x1[2], x1[3]); o2.z = pack2(x1[4], x1[5]); o2.w = pack2(x1[6], x1[7]);
          o3.x = pack2(x1[8], x1[9]); o3.y = pack2(x1[10], x1[11]); o3.z = pack2(x1[12], x1[13]); o3.w = pack2(x1[14], x1[15]);
          *(uint4*)(dst + c * 16) = o0;
          *(uint4*)(dst + c * 16 + 8) = o1;
          *(uint4*)(dst + 32 + c * 16) = o2;
          *(uint4*)(dst + 32 + c * 16 + 8) = o3;
        }
      }
    };
    auto stage_mine = [&]() {
      float* Cs = (float*)lds;
#pragma unroll
      for (int i = 0; i < 4; ++i)
#pragma unroll
        for (int j = 0; j < 2; ++j)
#pragma unroll
          for (int g = 0; g < 4; ++g) {
            int m = wm * 128 + i * 32 + r;
            int n = (wn & 1) * 64 + j * 32 + 8 * g + 4 * hh;
            float4 v; v.x = acc[i][j][4 * g]; v.y = acc[i][j][4 * g + 1]; v.z = acc[i][j][4 * g + 2]; v.w = acc[i][j][4 * g + 3];
            *(float4*)(Cs + m * 132 + n) = v;
          }
    };
    if ((wn >> 1) == 0) {
      const int ta = ((wm * 2 + (wn & 1)) << 6) + lane;
      stage_mine();
      __syncthreads();
      process_unit(0, ta);
      process_unit(0, ta + 256);
      __syncthreads();
      __syncthreads();
      process_unit(1, tid);
      __syncthreads();
    } else {
      __syncthreads();
      __syncthreads();
      stage_mine();
      __syncthreads();
      process_unit(1, tid);
      __syncthreads();
    }
  }
}

struct AttnArgs {
  const u16* q;
  u16* z;
  const u16* kctx;
  const u16* vctx;
  const u16* klat;
  const u16* vlat;
  int n_lat_tiles;
  int lat_key0;
  int q_t0;
  int band;
  int has_sink;
  float sink_l2;
  int dry;
  int fixedm;
  float mfix;
};

DI void attn_load_tile(const AttnArgs& a, int ti, u32x4 (&rk)[2], u32x4 (&rv)[2]) {
  const int tid = otid();
  const u16* kp; const u16* vp; int vs;
  if (ti < 4) { kp = a.kctx + (size_t)(ti * 64) * 512; vp = a.vctx + ti * 64; vs = L; }
  else { kp = a.klat + (size_t)((ti - 4) * 64) * 512; vp = a.vlat + (ti - 4) * 64; vs = S; }
#pragma unroll
  for (int i = 0; i < 2; ++i) {
    int c = tid + NTHR * i;
    rk[i] = *(const u32x4*)(kp + (size_t)(c >> 4) * 512 + (c & 15) * 8);
    rv[i] = *(const u32x4*)(vp + (size_t)(c >> 3) * vs + (c & 7) * 8);
  }
}
DI void attn_store_tile(u16* sK, u16* sV, const u32x4 (&rk)[2], const u32x4 (&rv)[2]) {
  const int tid = otid();
#pragma unroll
  for (int i = 0; i < 2; ++i) {
    int c = tid + NTHR * i;
    *(u32x4*)(sK + (c >> 4) * 136 + (c & 15) * 8) = rk[i];
    u16* vd = sV + (c >> 3) * 68 + (c & 7) * 8;
    { u32x2 t0 = {rv[i].x, rv[i].y}; *(u32x2*)(vd) = t0; }
    { u32x2 t1 = {rv[i].z, rv[i].w}; *(u32x2*)(vd + 4) = t1; }
  }
}

DI void attn_item(const AttnArgs& a, char* lds) {
  const int tid = otid(), lane = tid & 63, w = tid >> 6;
  const int r = lane & 31, hh = lane >> 5;
  constexpr int STG = 34816;
  const int ntiles = 4 + a.n_lat_tiles;

  bf16x8 qf[8];
  {
    const u16* qp = a.q + (size_t)(w * 32 + r) * 2048 + hh * 8;
#pragma unroll
    for (int ks = 0; ks < 8; ++ks) qf[ks] = *(const bf16x8*)(qp + ks * 16);
  }
  f32x16 O[4];
#pragma unroll
  for (int dt = 0; dt < 4; ++dt)
#pragma unroll
    for (int x = 0; x < 16; ++x) O[dt][x] = 0.f;
  float m = a.fixedm ? a.mfix : (a.has_sink ? a.sink_l2 : -1e30f);
  float lsum = (a.has_sink && hh == 0) ? 1.f : 0.f;
  const int qpos = a.q_t0 + w * 32 + r;

  auto QK = [&](int stage, f32x16 (&sc)[2]) {
    const u16* sK = (const u16*)(lds + stage * STG);
#pragma unroll
    for (int kt2 = 0; kt2 < 2; ++kt2) {
#pragma unroll
      for (int x = 0; x < 16; ++x) sc[kt2][x] = 0.f;
      const u16* kb = sK + (kt2 * 32 + r) * 136 + hh * 8;
#pragma unroll
      for (int ks = 0; ks < 8; ++ks) {
        bf16x8 ka = *(const bf16x8*)(kb + ks * 16);
        sc[kt2] = MFMA32(ka, qf[ks], sc[kt2]);
      }
    }
  };
  u32x4 rk[2], rv[2];
  auto STEP = [&](int ti, int st, f32x16 (&sc)[2], f32x16 (&sn)[2]) {
    const int st1 = (st == 2) ? 0 : st + 1, st2 = (st == 0) ? 2 : st - 1;
    if (ti + 2 < ntiles) attn_load_tile(a, ti + 2, rk, rv);
    if (ti + 1 < ntiles) QK(st1, sn);
    if (a.band && ti >= 4) {
      const int k0 = a.lat_key0 + (ti - 4) * 64;
#pragma unroll
      for (int kt2 = 0; kt2 < 2; ++kt2)
#pragma unroll
        for (int x = 0; x < 16; ++x) {
          int kp = k0 + kt2 * 32 + crow(x, hh);
          int dlt = kp - qpos; dlt = dlt < 0 ? -dlt : dlt;
          if (dlt > 128) sc[kt2][x] = -1e30f;
        }
    }
    if (!a.fixedm) {
      float mx = sc[0][0];
#pragma unroll
      for (int kt2 = 0; kt2 < 2; ++kt2)
#pragma unroll
        for (int x = 0; x < 16; ++x) mx = fmaxf(mx, sc[kt2][x]);
      mx = fmaxf(mx, __shfl_xor(mx, 32));
      if (__any(mx > m + 8.f)) {
        const float mnew = fmaxf(m, mx);
        const float alpha = __builtin_amdgcn_exp2f(m - mnew);
        m = mnew;
        lsum *= alpha;
#pragma unroll
        for (int dt = 0; dt < 4; ++dt)
#pragma unroll
          for (int x = 0; x < 16; ++x) O[dt][x] *= alpha;
      }
    }
    float ps = 0.f;
#pragma unroll
    for (int kt2 = 0; kt2 < 2; ++kt2)
#pragma unroll
      for (int x = 0; x < 16; ++x) { float pv = __builtin_amdgcn_exp2f(sc[kt2][x] - m); sc[kt2][x] = pv; ps += pv; }
    lsum += ps;
    const u16* sV = (const u16*)(lds + st * STG + 17408);
#pragma unroll
    for (int kt2 = 0; kt2 < 2; ++kt2)
#pragma unroll
      for (int s2 = 0; s2 < 2; ++s2) {
        union { unsigned u[4]; bf16x8 v; } pf;
#pragma unroll
        for (int j = 0; j < 4; ++j) pf.u[j] = pack2(sc[kt2][8 * s2 + 2 * j], sc[kt2][8 * s2 + 2 * j + 1]);
        const u16* vb = sV + r * 68 + kt2 * 32 + 16 * s2 + 4 * hh;
#pragma unroll
        for (int dt = 0; dt < 4; ++dt) {
          s16x4 lo = *(const s16x4*)(vb + dt * 32 * 68);
          s16x4 hi = *(const s16x4*)(vb + dt * 32 * 68 + 8);
          bf16x8 va = __builtin_shufflevector(lo, hi, 0, 1, 2, 3, 4, 5, 6, 7);
          O[dt] = MFMA32(va, pf.v, O[dt]);
        }
      }
    if (ti + 2 < ntiles) attn_store_tile((u16*)(lds + st2 * STG), (u16*)(lds + st2 * STG + 17408), rk, rv);
    __syncthreads();
  };

  attn_load_tile(a, 0, rk, rv);
  __syncthreads();
  attn_store_tile((u16*)lds, (u16*)(lds + 17408), rk, rv);
  attn_load_tile(a, 1, rk, rv);
  attn_store_tile((u16*)(lds + STG), (u16*)(lds + STG + 17408), rk, rv);
  __syncthreads();
  f32x16 sA[2], sB[2];
  QK(0, sA);
  int st = 0;
  for (int ti = 0; ti < ntiles; ti += 2) {
    STEP(ti, st, sA, sB);
    st = (st == 2) ? 0 : st + 1;
    if (ti + 1 < ntiles) {
      STEP(ti + 1, st, sB, sA);
      st = (st == 2) ? 0 : st + 1;
    }
  }
  float ltot = lsum + __shfl_xor(lsum, 32);
  const float inv = 1.f / ltot;
  u16* zp = a.z + (size_t)(w * 32 + r) * 3072;
  u32x2 gv[4][4];
#pragma unroll
  for (int dt = 0; dt < 4; ++dt)
#pragma unroll
    for (int g4 = 0; g4 < 4; ++g4) gv[dt][g4] = *(const u32x2*)(zp + dt * 32 + 8 * g4 + 4 * hh);
#pragma unroll
  for (int dt = 0; dt < 4; ++dt)
#pragma unroll
    for (int g4 = 0; g4 < 4; ++g4) {
      int d0 = dt * 32 + 8 * g4 + 4 * hh;
      float y0 = O[dt][4 * g4 + 0] * inv * bflo(gv[dt][g4].x);
      float y1 = O[dt][4 * g4 + 1] * inv * bfhi(gv[dt][g4].x);
      float y2 = O[dt][4 * g4 + 2] * inv * bflo(gv[dt][g4].y);
      float y3 = O[dt][4 * g4 + 3] * inv * bfhi(gv[dt][g4].y);
      uint2 o; o.x = pack2(y0, y1); o.y = pack2(y2, y3);
      if (!a.dry || y0 != y0) *(uint2*)(zp + d0) = o;
    }
}

template <bool REV>
DI void lru_scan(float (&av)[2][16], float (&bv)[2][16], float& carry, int hh) {
  float segA[8], segB[8];
#pragma unroll
  for (int k = 0; k < 8; ++k) {
    const int mt = k >> 2, q = k & 3;
    float cA = 1.f, hl = 0.f;
#pragma unroll
    for (int jj = 0; jj < 4; ++jj) {
      const int j = REV ? 3 - jj : jj;
      const int i = 4 * q + j;
      hl = av[mt][i] * hl + bv[mt][i];
      cA *= av[mt][i];
      av[mt][i] = cA; bv[mt][i] = hl;
    }
    segA[k] = cA; segB[k] = hl;
  }
  float oA[8], oB[8];
#pragma unroll
  for (int k = 0; k < 8; ++k) { oA[k] = __shfl_xor(segA[k], 32); oB[k] = __shfl_xor(segB[k], 32); }
  float init[8];
  float st = carry;
#pragma unroll
  for (int kk = 0; kk < 8; ++kk) {
    const int k = REV ? 7 - kk : kk;
    const int first = REV ? 1 : 0;
    float A1 = (hh == first) ? segA[k] : oA[k];
    float B1 = (hh == first) ? segB[k] : oB[k];
    float st0 = st;
    st = A1 * st + B1;
    float A2 = (hh == first) ? oA[k] : segA[k];
    float B2 = (hh == first) ? oB[k] : segB[k];
    float st1 = st;
    st = A2 * st + B2;
    init[k] = (hh == first) ? st0 : st1;
  }
  carry = st;
#pragma unroll
  for (int k = 0; k < 8; ++k) {
    const int mt = k >> 2, q = k & 3;
#pragma unroll
    for (int j = 0; j < 4; ++j) {
      const int i = 4 * q + j;
      bv[mt][i] = bv[mt][i] + av[mt][i] * init[k];
    }
  }
}

DI void lru_item(CParams& p, int l, int b, int n, bool last, char* lds, int dry = 0) {
  const int NB = p.NB, RL = NB * S;
  const int tid = otid(), lane = tid & 63, w8 = tid >> 6;
  const int sub = __builtin_amdgcn_readfirstlane(w8 >> 2), w = w8 & 3;
  n = n + sub;
  lds += sub * 73728;
  const int dir = w >> 1, w2 = w & 1;
  const int tl = tid & 127;
  const int r = lane & 31, hh = lane >> 5;
  u16* sRaw = (u16*)lds + dir * (8704 / 2);
  u16* sUp = (u16*)(lds + 17408) + dir * (9216 / 2);
  float* sH = (float*)(lds + 35840) + w * (64 * 36);

  const int chb = n * 64;
  const int cp = (tl & 31) * 2, tg = tl >> 5;
  float cw0[4], cw1[4], cb0, cb1;
#pragma unroll
  for (int k = 0; k < 4; ++k) {
    cw0[k] = p.conv_w[((size_t)l * 4 + k) * D + chb + cp];
    cw1[k] = p.conv_w[((size_t)l * 4 + k) * D + chb + cp + 1];
  }
  cb0 = p.conv_b[l * D + chb + cp]; cb1 = p.conv_b[l * D + chb + cp + 1];
  bf16x8 waf[4], wxf[4];
  {
    const float* wa = p.lru_wa + (((size_t)(l * 2 + dir) * 16 + n) * 64) * 64;
    const float* wx = p.lru_wx + (((size_t)(l * 2 + dir) * 16 + n) * 64) * 64;
    const int e = 32 * w2 + r;
#pragma unroll
    for (int ks = 0; ks < 4; ++ks) {
      union { unsigned u[4]; bf16x8 v; } fa, fx;
#pragma unroll
      for (int j = 0; j < 4; ++j) {
        int d0 = ks * 16 + 8 * hh + 2 * j;
        fa.u[j] = pack2(wa[d0 * 64 + e], wa[(d0 + 1) * 64 + e]);
        fx.u[j] = pack2(wx[d0 * 64 + e], wx[(d0 + 1) * 64 + e]);
      }
      waf[ks] = fa.v; wxf[ks] = fx.v;
    }
  }
  const int che = chb + 32 * w2 + r;
  const float ba = p.lru_ba[(l * 2 + dir) * D + che];
  const float bx = p.lru_bx[(l * 2 + dir) * D + che];
  float c8sp;
  {
    float lam = p.lru_lambda[(l * 2 + dir) * D + che];
    float sp = (lam < -20.f) ? -lam : log1pf(expf(-lam));
    c8sp = 8.f * sp;
  }
  float carry = 0.f;

  auto step_tile = [&](int st, bool& isctx, int& tt) {
    if (dir == 0) { if (st < 4) { isctx = true; tt = st; } else { isctx = false; tt = st - 4; } }
    else { if (st < 4) { isctx = true; tt = 3 - st; } else { isctx = false; tt = 63 - (st - 4); } }
  };
  u32x4 pre[5];
  auto load_raw = [&](int st) {
    bool isctx; int tt; step_tile(st, isctx, tt);
    const int seqlen = isctx ? L : S;
    const size_t rowbase = isctx ? (size_t)RL + (size_t)b * L : (size_t)b * S;
    const int t0 = tt * 64;
#pragma unroll
    for (int i = 0; i < 5; ++i) {
      int c = tl + 128 * i;
      int rr = c >> 3, c16 = c & 7;
      int t = t0 - 2 + rr;
      u32x4 v = {0u, 0u, 0u, 0u};
      if (rr < 67 && t >= 0 && t < seqlen) v = *(const u32x4*)(p.U + (rowbase + t) * D + chb + c16 * 8);
      pre[i] = v;
    }
  };
  load_raw(0);
  __syncthreads();
  for (int st = 0; st < 68; ++st) {
    bool isctx; int tt; step_tile(st, isctx, tt);
    const size_t rowbase = isctx ? (size_t)RL + (size_t)b * L : (size_t)b * S;
    const int t0 = tt * 64;
#pragma unroll
    for (int i = 0; i < 5; ++i) {
      int c = tl + 128 * i;
      int rr = c >> 3, c16 = c & 7;
      if (rr < 67) *(u32x4*)(sRaw + rr * 64 + c16 * 8) = pre[i];
    }
    if (st + 1 < 68) load_raw(st + 1);
    __syncthreads();
    {
      const u16* rp = sRaw + (tg * 16) * 64 + cp;
      unsigned r0 = *(const unsigned*)(rp), r1 = *(const unsigned*)(rp + 64), r2 = *(const unsigned*)(rp + 128);
#pragma unroll
      for (int i = 0; i < 16; ++i) {
        unsigned r3 = *(const unsigned*)(rp + (i + 3) * 64);
        float o0 = cb0 + cw0[0] * bflo(r0) + cw0[1] * bflo(r1) + cw0[2] * bflo(r2) + cw0[3] * bflo(r3);
        float o1 = cb1 + cw1[0] * bfhi(r0) + cw1[1] * bfhi(r1) + cw1[2] * bfhi(r2) + cw1[3] * bfhi(r3);
        *(unsigned*)(sUp + (tg * 16 + i) * 72 + cp) = pack2(o0, o1);
        r0 = r1; r1 = r2; r2 = r3;
      }
    }
    __syncthreads();
    const bool fwd_first = isctx ? (tt <= 1) : (tt <= 31);
    const bool first = (dir == 0) ? fwd_first : !fwd_first;
    unsigned long long pt0[4], pt1[4];
    u32x4 pg[4];
    if (!first && !(isctx && last)) {
#pragma unroll
      for (int j = 0; j < 4; ++j) {
        const int q = lane + 64 * j;
        const int tok = q >> 2, cc = (q & 3) * 8;
        const size_t row = rowbase + t0 + tok;
        const int col = chb + 32 * w2 + cc;
        const u16* tp = p.Hb + row * D + col;
        pt0[j] = __hip_atomic_load((const unsigned long long*)tp, __ATOMIC_RELAXED, __HIP_MEMORY_SCOPE_AGENT);
        pt1[j] = __hip_atomic_load((const unsigned long long*)tp + 1, __ATOMIC_RELAXED, __HIP_MEMORY_SCOPE_AGENT);
        pg[j] = *(const u32x4*)(p.Z + row * 3072 + col);
      }
    } else {
#pragma unroll
      for (int j = 0; j < 4; ++j) { pt0[j] = 0; pt1[j] = 0; pg[j] = u32x4{0u, 0u, 0u, 0u}; }
    }
    float av[2][16], bv[2][16];
    {
      f32x16 aR[2];
#pragma unroll
      for (int mt = 0; mt < 2; ++mt) {
#pragma unroll
        for (int x = 0; x < 16; ++x) aR[mt][x] = 0.f;
        const u16* ub = sUp + (mt * 32 + r) * 72 + hh * 8;
#pragma unroll
        for (int ks = 0; ks < 4; ++ks) aR[mt] = MFMA32(*(const bf16x8*)(ub + ks * 16), waf[ks], aR[mt]);
      }
#pragma unroll
      for (int mt = 0; mt < 2; ++mt)
#pragma unroll
        for (int x = 0; x < 16; ++x) {
          const float rg = sigmoidf_(aR[mt][x] + ba);
          av[mt][x] = -c8sp * rg;
        }
    }
    {
      f32x16 aI[2];
#pragma unroll
      for (int mt = 0; mt < 2; ++mt) {
#pragma unroll
        for (int x = 0; x < 16; ++x) aI[mt][x] = 0.f;
        const u16* ub = sUp + (mt * 32 + r) * 72 + hh * 8;
#pragma unroll
        for (int ks = 0; ks < 4; ++ks) aI[mt] = MFMA32(*(const bf16x8*)(ub + ks * 16), wxf[ks], aI[mt]);
      }
#pragma unroll
      for (int mt = 0; mt < 2; ++mt)
#pragma unroll
        for (int x = 0; x < 16; ++x) {
          const int tok = mt * 32 + crow(x, hh);
          const float up = bf2f(sUp[tok * 72 + 32 * w2 + r]);
          const float ig = sigmoidf_(aI[mt][x] + bx);
          const float la = av[mt][x];
          const float a_ = __expf(la);
          const float om = fmaxf(1.f - a_ * a_, 0.f);
          av[mt][x] = a_;
          bv[mt][x] = __builtin_amdgcn_sqrtf(om) * (ig * up);
        }
    }
    if (dir == 0) lru_scan<false>(av, bv, carry, hh); else lru_scan<true>(av, bv, carry, hh);
#pragma unroll
    for (int mt = 0; mt < 2; ++mt)
#pragma unroll
      for (int x = 0; x < 16; ++x) sH[(mt * 32 + crow(x, hh)) * 36 + r] = bv[mt][x];
    if (!(isctx && last)) {
#pragma unroll
      for (int j = 0; j < 4; ++j) {
        const int q = lane + 64 * j;
        const int tok = q >> 2, cc = (q & 3) * 8;
        const float4 h0 = *(const float4*)(sH + tok * 36 + cc);
        const float4 h1 = *(const float4*)(sH + tok * 36 + cc + 4);
        const size_t row = rowbase + t0 + tok;
        const int col = chb + 32 * w2 + cc;
        u16* tp = p.Hb + row * D + col;
        if (first) {
          uint4 o; o.x = pack2(h0.x, h0.y); o.y = pack2(h0.z, h0.w); o.z = pack2(h1.x, h1.y); o.w = pack2(h1.z, h1.w);
          if (!dry || h0.x != h0.x) *(uint4*)tp = o;
        } else {
          unsigned tx = (unsigned)pt0[j], ty = (unsigned)(pt0[j] >> 32), tz = (unsigned)pt1[j], tw = (unsigned)(pt1[j] >> 32);
          u16* zp = p.Z + row * 3072 + col;
          u32x4 g = pg[j];
          uint4 o;
          o.x = pack2((h0.x + bflo(tx)) * bflo(g.x), (h0.y + bfhi(tx)) * bfhi(g.x));
          o.y = pack2((h0.z + bflo(ty)) * bflo(g.y), (h0.w + bfhi(ty)) * bfhi(g.y));
          o.z = pack2((h1.x + bflo(tz)) * bflo(g.z), (h1.y + bfhi(tz)) * bfhi(g.z));
          o.w = pack2((h1.z + bflo(tw)) * bflo(g.w), (h1.w + bfhi(tw)) * bfhi(g.w));
          if (!dry || h0.x != h0.x) *(uint4*)zp = o;
        }
      }
    }
    __builtin_amdgcn_fence(__ATOMIC_RELEASE, "workgroup");
  }
}

DI void phase_mixers(CParams& p, int chunk, int l, char* lds, int dry = 0) {
  const int NB = p.NB, RL = NB * S;
  const bool last = (l == DEPTH - 1);
  const int nLRU = (dry == 1) ? 0 : NB * 8, nC = (dry == 2) ? 0 : NB * 8 * 16, nBw = (dry == 2) ? 0 : NB * 8 * 16, nCtx = (last || dry == 2) ? 0 : NB * 8 * 2;
  const int total = nLRU + nC + nBw + nCtx;
  int* ctr = p.ctr + chunk * DEPTH + l + (dry ? 32 : 0);
  int* s_item = (int*)(lds + LDS_BYTES - 16);
  int it;
  while (true) {
    __syncthreads();
    if (threadIdx.x == 0) *s_item = atomicAdd(ctr, 1);
    __syncthreads();
    it = __builtin_amdgcn_readfirstlane(*s_item);
    __syncthreads();
    if (it >= nLRU) break;
    lru_item(p, l, it >> 3, (it & 7) * 2, last, lds, dry);
  }
  bool have = true;
  while (true) {
    if (!have) {
      __syncthreads();
      if (threadIdx.x == 0) *s_item = atomicAdd(ctr, 1);
      __syncthreads();
      it = __builtin_amdgcn_readfirstlane(*s_item);
      __syncthreads();
    }
    have = false;
    if (it >= total) break;
    it -= nLRU;
    AttnArgs a;
    a.dry = dry;
    float gqm = 0.f, gkm = 0.f;
    {
      const int ln = otid() & 63;
      gqm = fmaxf(fabsf(p.q_norm_g[l * 128 + ln]), fabsf(p.q_norm_g[l * 128 + 64 + ln]));
      gkm = fmaxf(fabsf(p.k_norm_g[l * 128 + ln]), fabsf(p.k_norm_g[l * 128 + 64 + ln]));
#pragma unroll
      for (int o = 32; o >= 1; o >>= 1) { gqm = fmaxf(gqm, __shfl_xor(gqm, o)); gkm = fmaxf(gkm, __shfl_xor(gkm, o)); }
      gqm = __builtin_amdgcn_readfirstlane(gqm); gkm = __builtin_amdgcn_readfirstlane(gkm);
    }
    const float mfixC = 128.f * gqm * gkm * QSCALE;
    if (it < nC + nBw) {
      const bool isB = it >= nC;
      if (isB) it -= nC;
      const int b = it >> 7, h = (it >> 4) & 7, qb = it & 15;
      const int kvh = h >> 2;
      const int br = isB ? 0 : 1;
      const size_t qrow0 = (size_t)b * S + qb * 256;
      a.q = p.Q + qrow0 * 2048 + br * 1024 + h * 128;
      a.z = p.Z + qrow0 * 3072 + (br + 1) * 1024 + h * 128;
      const int kcol = br * 256 + kvh * 128, slot = br * 2 + kvh;
      a.kctx = p.Kb + ((size_t)RL + (size_t)b * L) * 512 + kcol;
      a.vctx = p.VtC + (size_t)(b * 4 + slot) * 128 * L;
      int k0, k1;
      if (isB) { k0 = qb * 256 - 128; if (k0 < 0) k0 = 0; k1 = qb * 256 + 384; if (k1 > S) k1 = S; }
      else { k0 = 0; k1 = S; }
      a.lat_key0 = k0;
      a.n_lat_tiles = (k1 - k0) >> 6;
      a.klat = p.Kb + ((size_t)b * S + k0) * 512 + kcol;
      a.vlat = p.VtL + (size_t)(b * 4 + slot) * 128 * S + k0;
      a.q_t0 = qb * 256;
      a.band = isB ? 1 : 0;
      a.has_sink = isB ? 1 : 0;
      a.sink_l2 = isB ? p.attn_sink[l * 8 + h] * LOG2E : 0.f;
      a.fixedm = isB ? 0 : 1; a.mfix = mfixC;
    } else {
      it -= nC + nBw;
      const int h = it & 7, br = (it >> 3) & 1, b = it >> 4;
      const int kvh = h >> 2;
      const size_t qrow0 = (size_t)RL + (size_t)b * L;
      a.q = p.Q + qrow0 * 2048 + br * 1024 + h * 128;
      a.z = p.Z + qrow0 * 3072 + (br + 1) * 1024 + h * 128;
      const int kcol = br * 256 + kvh * 128, slot = br * 2 + kvh;
      a.kctx = p.Kb + ((size_t)RL + (size_t)b * L) * 512 + kcol;
      a.vctx = p.VtC + (size_t)(b * 4 + slot) * 128 * L;
      a.klat = a.kctx; a.vlat = a.vctx;
      a.n_lat_tiles = 0; a.lat_key0 = 0; a.q_t0 = 0; a.band = 0;
      a.has_sink = (br == 0) ? 1 : 0;
      a.sink_l2 = (br == 0) ? p.attn_sink[l * 8 + h] * LOG2E : 0.f;
      a.fixedm = (br == 0) ? 0 : 1; a.mfix = mfixC;
    }
    attn_item(a, lds);
  }
}

DI void phase_merge(CParams& p, int chunk, int l, char* lds) {
  const int NB = p.NB, RL = NB * S, R = NB * (S + L);
  const bool last = (l == DEPTH - 1);
  const int MT = (last ? RL : R) / 256, NT = 8;
  const int tid = otid();
  const int lane = tid & 63, w = tid >> 6, wm = w >> 1, wn = w & 1, r = lane & 31, hh = lane >> 5;
  for (int ti = 0;; ++ti) {
    int mt, nt;
    if (!tile_map(ti, MT, NT, mt, nt)) break;
    const int m0 = mt * 256, n0 = nt * 128;
    f32x16 tot[2][2];
#pragma unroll
    for (int i = 0; i < 2; ++i)
#pragma unroll
      for (int j = 0; j < 2; ++j)
#pragma unroll
        for (int x = 0; x < 16; ++x) tot[i][j][x] = 0.f;
#pragma unroll 1
    for (int n = 0; n < 3; ++n) {
      f32x16 acc[2][2];
      gemm_core<128, false>(p.Z + (size_t)m0 * 3072 + n * 1024, 3072, 64, (size_t)128 * 3072,
                            p.WbT + ((size_t)(l * 3 + n) * D + n0) * D, 64, 8192, 0, D, lds, acc);
#pragma unroll
      for (int i = 0; i < 2; ++i)
#pragma unroll
        for (int j = 0; j < 2; ++j)
#pragma unroll
          for (int g = 0; g < 4; ++g) {
            const size_t row = (size_t)m0 + wm * 64 + i * 32 + r;
            const int col = n0 + wn * 64 + j * 32 + 8 * g + 4 * hh;
            uint2 sv = *(const uint2*)(p.Ms + row * 3072 + n * 1024 + col);
            tot[i][j][4 * g + 0] += bflo(sv.x) * acc[i][j][4 * g + 0];
            tot[i][j][4 * g + 1] += bfhi(sv.x) * acc[i][j][4 * g + 1];
            tot[i][j][4 * g + 2] += bflo(sv.y) * acc[i][j][4 * g + 2];
            tot[i][j][4 * g + 3] += bfhi(sv.y) * acc[i][j][4 * g + 3];
          }
    }
#pragma unroll
    for (int i = 0; i < 2; ++i)
#pragma unroll
      for (int j = 0; j < 2; ++j)
#pragma unroll
        for (int g = 0; g < 4; ++g) {
          const size_t row = (size_t)m0 + wm * 64 + i * 32 + r;
          const int col = n0 + wn * 64 + j * 32 + 8 * g + 4 * hh;
          uint2 o; o.x = pack2(tot[i][j][4 * g], tot[i][j][4 * g + 1]); o.y = pack2(tot[i][j][4 * g + 2], tot[i][j][4 * g + 3]);
          *(uint2*)(p.Hb + ((row >> 7) * 16 + (col >> 6)) * 8192 + (row & 127) * 64 + (col & 63)) = o;
        }
  }
}

DI void phase_outproj(CParams& p, int chunk, int l, char* lds) {
  const int NB = p.NB, RL = NB * S, R = NB * (S + L);
  const bool last = (l == DEPTH - 1);
  const int MT = (last ? RL : R) / 256, NT = 8;
  const int tid = otid();
  const int w = tid >> 6, wm = w >> 1, wn = w & 1;
  for (int ti = 0;; ++ti) {
    int mt, nt;
    if (!tile_map(ti, MT, NT, mt, nt)) break;
    const int m0 = mt * 256, n0 = nt * 128;
    f32x16 acc[2][2];
    gemm_core<128, true>(p.Hb + (size_t)m0 * D, 64, 8192, 131072, p.WoT + ((size_t)l * D + n0) * D, 64, 8192, 0, D, lds, acc);
    stage_acc<2>(lds, acc, wm, wn * 64, true);
    const int row = tid >> 1, half = tid & 1;
    const int gr = m0 + row;
    const float* src; float* dst; int mrow;
    if (gr < RL) {
      int b = gr / S, t = gr % S; int bg = chunk * NB + b;
      size_t off = ((size_t)bg * S + t) * D + n0 + half * 64;
      src = (l == 0 ? p.x : p.out) + off; dst = p.out + off; mrow = bg;
    } else {
      int rc = gr - RL; int b = rc / L, t = rc % L; int bg = chunk * NB + b;
      size_t off = ((size_t)bg * L + t) * D + n0 + half * 64;
      src = (l == 0 ? p.ctx : p.xc) + off; dst = p.xc + off; mrow = 16;
    }
    const float* gate = p.modv + ((size_t)l * 17 + mrow) * 3072 + 2048 + n0 + half * 64;
    const float* Cs = (const float*)lds + row * 132 + half * 64;
    float4 xv[16], gv[16];
#pragma unroll
    for (int j = 0; j < 16; ++j) { xv[j] = *(const float4*)(src + j * 4); gv[j] = *(const float4*)(gate + j * 4); }
#pragma unroll
    for (int j = 0; j < 16; ++j) {
      float4 cv = *(const float4*)(Cs + j * 4);
      float4 o;
      o.x = xv[j].x + gv[j].x * cv.x; o.y = xv[j].y + gv[j].y * cv.y; o.z = xv[j].z + gv[j].z * cv.z; o.w = xv[j].w + gv[j].w * cv.w;
      *(float4*)(dst + j * 4) = o;
    }
  }
}

DI void phase_final(CParams& p) {
  const int tid_ = otid();
  const int lane = tid_ & 63;
  const int wg = blockIdx.x * 8 + (tid_ >> 6), nw = gridDim.x * 8;
  for (int r = wg; r < NBATCH * S; r += nw) {
    float* src = p.out + (size_t)r * D;
    float4 v[4]; float ss = 0.f;
#pragma unroll
    for (int i = 0; i < 4; ++i) {
      v[i] = *(const float4*)(src + i * 256 + lane * 4);
      ss += v[i].x * v[i].x + v[i].y * v[i].y + v[i].z * v[i].z + v[i].w * v[i].w;
    }
#pragma unroll
    for (int o = 32; o >= 1; o >>= 1) ss += __shfl_xor(ss, o);
    float rstd = rsqrtf(ss * (1.f / D) + EPS);
#pragma unroll
    for (int i = 0; i < 4; ++i) {
      int cidx = i * 256 + lane * 4;
      float4 gg = *(const float4*)(p.final_g + cidx);
      float4 o;
      o.x = v[i].x * rstd * gg.x; o.y = v[i].y * rstd * gg.y; o.z = v[i].z * rstd * gg.z; o.w = v[i].w * rstd * gg.w;
      *(float4*)(src + cidx) = o;
    }
  }
}

#ifndef DUP_PHASE
#define DUP_PHASE 0
#endif
__global__ void __launch_bounds__(NTHR, 2) fwd_megakernel(Params p_unused) {
  CParams* kp = (CParams*)__builtin_amdgcn_kernarg_segment_ptr();
  cg::grid_group grid = cg::this_grid();
  __shared__ __attribute__((aligned(16))) char lds[LDS_BYTES];
  phase0(*opaque_kp(kp), lds);
  grid.sync();
  phase_mod(*opaque_kp(kp), lds);
  grid.sync();
  for (int chunk = 0; chunk < kp->nchunk; ++chunk) {
    for (int l = 0; l < DEPTH; ++l) {
      phase_prenorm(*opaque_kp(kp), chunk, l);
      grid.sync();
#if DUP_PHASE == 9
      grid.sync(); grid.sync(); grid.sync(); grid.sync(); grid.sync();
#endif
      phase_gemm_in(*opaque_kp(kp), chunk, l, lds);
      grid.sync();
#if DUP_PHASE == 3
      phase_gemm_in(*opaque_kp(kp), chunk, l, lds);
      grid.sync();
#endif
#if DUP_PHASE == 4
      phase_mixers(*opaque_kp(kp), chunk, l, lds, 1);
      grid.sync();
#endif
#if DUP_PHASE == 6
      phase_mixers(*opaque_kp(kp), chunk, l, lds, 2);
      grid.sync();
#endif
      phase_mixers(*opaque_kp(kp), chunk, l, lds);
      grid.sync();
      phase_merge(*opaque_kp(kp), chunk, l, lds);
      grid.sync();
#if DUP_PHASE == 5
      phase_merge(*opaque_kp(kp), chunk, l, lds);
      grid.sync();
#endif
      phase_outproj(*opaque_kp(kp), chunk, l, lds);
      grid.sync();
    }
  }
  phase_final(*opaque_kp(kp));
}

extern "C" void kernel_launch(void* const* d_in, const int* in_sizes, int n_in,
                              void* d_out, int out_size, void* d_ws, size_t ws_size,
                              hipStream_t stream) {
  static int grid_blocks = 0;
  if (!grid_blocks) {
    int dev = 0, cus = 0, per_cu = 0;
    (void)hipGetDevice(&dev);
    (void)hipDeviceGetAttribute(&cus, hipDeviceAttributeMultiprocessorCount, dev);
    (void)hipOccupancyMaxActiveBlocksPerMultiprocessor(&per_cu, fwd_megakernel, NTHR, 0);
    if (per_cu > 1) per_cu = 1;
    if (per_cu < 1) per_cu = 1;
    grid_blocks = cus * per_cu;
  }
  Params p{};
  const float* const* in = (const float* const*)d_in;
  p.x = in[0]; p.c = in[1]; p.ctx = in[2]; p.c_ctx = in[3]; p.norm_g = in[4]; p.w_mod = in[5]; p.b_mod = in[6];
  p.w_in = in[7]; p.conv_w = in[8]; p.conv_b = in[9]; p.lru_wa = in[10]; p.lru_ba = in[11]; p.lru_wx = in[12];
  p.lru_bx = in[13]; p.lru_lambda = in[14]; p.attn_sink = in[15]; p.q_norm_g = in[16]; p.k_norm_g = in[17];
  p.w_branch = in[18]; p.w_out = in[19]; p.final_g = in[20];
  p.out = (float*)d_out;
  char* ws = (char*)d_ws;
  size_t off = 0;
  auto take = [&](size_t bytes) { char* r = ws + off; off += (bytes + 255) & ~(size_t)255; return r; };
  p.ctr = (int*)take(256);
  p.modv = (float*)take((size_t)DEPTH * 17 * 3072 * 4);
  p.sc = (float*)take((size_t)17 * D * 4);
  p.rope = (float*)take(4096 * 4);
  p.xc = (float*)take((size_t)NBATCH * L * D * 4);
  p.WinT = (u16*)take((size_t)DEPTH * INW * D * 2);
  p.WbT = (u16*)take((size_t)DEPTH * 3 * D * D * 2);
  p.WoT = (u16*)take((size_t)DEPTH * D * D * 2);
  const size_t fixed = off;
  int NB = 8;
  while (NB > 1) {
    size_t R = (size_t)NB * (S + L);
    size_t need = fixed + R * (size_t)(1024 + 1024 + 3072 + 2048 + 512 + 512 + 3072) * 2 + 8 * 256;
    if (need <= ws_size) break;
    NB >>= 1;
  }
  p.NB = NB; p.nchunk = NBATCH / NB;
  const size_t R = (size_t)NB * (S + L);
  p.Hb = (u16*)take(R * 1024 * 2);
  p.U = (u16*)take(R * 1024 * 2);
  p.Z = (u16*)take(R * 3072 * 2);
  p.Q = (u16*)take(R * 2048 * 2);
  p.Kb = (u16*)take(R * 512 * 2);
  p.VtL = (u16*)take((size_t)NB * 4 * 128 * S * 2);
  p.VtC = (u16*)take((size_t)NB * 4 * 128 * L * 2);
  p.Ms = (u16*)take(R * 3072 * 2);
  void* args[] = {&p};
  hipError_t e = hipLaunchCooperativeKernel((void*)fwd_megakernel, dim3(grid_blocks), dim3(NTHR), args, 0, stream);
  if (e != hipSuccess) fprintf(stderr, "cooperative launch failed: %s (grid %d)\n", hipGetErrorString(e), grid_blocks);
}
```

```cpp
#include <hip/hip_runtime.h>
#include <hip/hip_cooperative_groups.h>
#include <cstdio>
#include <cstdint>
namespace cg = cooperative_groups;

typedef unsigned short u16;
typedef __attribute__((ext_vector_type(8))) short bf16x8;
typedef __attribute__((ext_vector_type(4))) short s16x4;
typedef __attribute__((ext_vector_type(16))) float f32x16;
typedef __bf16 bf16x2_t __attribute__((ext_vector_type(2)));
typedef float float2_t __attribute__((ext_vector_type(2)));
typedef __attribute__((ext_vector_type(4))) unsigned u32x4;
typedef __attribute__((ext_vector_type(2))) unsigned u32x2;

#define DI __device__ __forceinline__
#define MFMA32(a, b, c) __builtin_amdgcn_mfma_f32_32x32x16_bf16((a), (b), (c), 0, 0, 0)

constexpr int D = 1024, NBATCH = 16, S = 4096, L = 256, DEPTH = 4, INW = 10240;
constexpr int LDS_BYTES = 147456;
constexpr int NTHR = 512;
constexpr float EPS = 1e-6f;
constexpr float QSCALE = 0.08838834764831845f * 1.4426950408889634f;
constexpr float LOG2E = 1.4426950408889634f;

struct Params {
  const float *x, *c, *ctx, *c_ctx, *norm_g, *w_mod, *b_mod, *w_in, *conv_w, *conv_b, *lru_wa, *lru_ba, *lru_wx, *lru_bx,
      *lru_lambda, *attn_sink, *q_norm_g, *k_norm_g, *w_branch, *w_out, *final_g;
  float* out;
  u16 *WinT, *WbT, *WoT;
  u16 *Hb, *U, *Z, *Q, *Kb, *VtL, *VtC, *Ms;
  float *modv, *sc, *rope, *xc;
  int* ctr;
  int NB;
  int nchunk;
};

typedef const __attribute__((address_space(4))) Params CParams;
DI CParams* opaque_kp(CParams* q) { asm volatile("" : "+s"(q)); return q; }

DI unsigned pack2(float a, float b) {
  float2_t f = {a, b};
  bf16x2_t v = __builtin_convertvector(f, bf16x2_t);
  return __builtin_bit_cast(unsigned, v);
}
DI float bf2f(u16 v) { return __uint_as_float(((unsigned)v) << 16); }
DI float bflo(unsigned v) { return __uint_as_float(v << 16); }
DI float bfhi(unsigned v) { return __uint_as_float(v & 0xffff0000u); }
DI float sigmoidf_(float x) { return __builtin_amdgcn_rcpf(1.f + __expf(-x)); }
DI float siluf_(float x) { return x * __builtin_amdgcn_rcpf(1.f + __expf(-x)); }
DI int otid() { int t = threadIdx.x; asm volatile("" : "+v"(t)); return t; }
DI int crow(int i, int hh) { return (i & 3) + 8 * (i >> 2) + 4 * hh; }

DI void phase0(CParams& p, char* lds) {
  const int tid = otid();
  float* tile = (float*)lds;
  const int n_in = DEPTH * 16 * 160, n_b = DEPTH * 3 * 256, n_o = DEPTH * 256;
  for (int it = blockIdx.x; it < n_in + n_b + n_o; it += gridDim.x) {
    const float* src; u16* dst; int ldsrc; int dstride = 64;
    if (it < n_in) {
      int l = it / 2560, rem = it % 2560, kt = rem / 160, nt = rem % 160;
      src = p.w_in + (size_t)l * D * INW + (size_t)(kt * 64) * INW + nt * 64; ldsrc = INW;
      const int o = nt >> 2;
      const int n256 = (o < 8) ? o : (o >= 28) ? 16 + (o - 28) : (o >= 24) ? 12 + (o - 24) : (o == 23) ? 39 : (o == 22) ? 38
                     : (o >= 18) ? 34 + (o - 18) : (o >= 14) ? 8 + (o - 14) : (o == 13) ? 33 : (o == 12) ? 32 : 28 + (o - 8);
      dst = p.WinT + (size_t)l * INW * D + ((size_t)n256 * 256 + (nt & 3) * 64) * D + kt * 64; dstride = D;
    } else if (it < n_in + n_b) {
      int i2 = it - n_in; int mat = i2 / 256, rem = i2 % 256, kt = rem / 16, nt = rem % 16;
      src = p.w_branch + (size_t)mat * D * D + (size_t)(kt * 64) * D + nt * 64; ldsrc = D;
      dst = p.WbT + (size_t)mat * D * D + ((size_t)(nt >> 1) * 16 + kt) * 8192 + (nt & 1) * 4096;
    } else {
      int i2 = it - n_in - n_b; int mat = i2 / 256, rem = i2 % 256, kt = rem / 16, nt = rem % 16;
      src = p.w_out + (size_t)mat * D * D + (size_t)(kt * 64) * D + nt * 64; ldsrc = D;
      dst = p.WoT + (size_t)mat * D * D + (size_t)(nt * 64) * D + kt * 64; dstride = D;
    }
    __syncthreads();
#pragma unroll
    for (int i = 0; i < 2; ++i) {
      int c = tid + NTHR * i; int row = c >> 4, c4 = c & 15;
      float4 v = *(const float4*)(src + (size_t)row * ldsrc + c4 * 4);
      float* t = tile + row * 65 + c4 * 4;
      t[0] = v.x; t[1] = v.y; t[2] = v.z; t[3] = v.w;
    }
    __syncthreads();
    {
      int c = tid; int nrow = c >> 3, k8 = c & 7;
      float v[8];
#pragma unroll
      for (int j = 0; j < 8; ++j) v[j] = tile[(k8 * 8 + j) * 65 + nrow];
      uint4 o; o.x = pack2(v[0], v[1]); o.y = pack2(v[2], v[3]); o.z = pack2(v[4], v[5]); o.w = pack2(v[6], v[7]);
      *(uint4*)(dst + (size_t)nrow * dstride + k8 * 8) = o;
    }
  }
  const int gt = blockIdx.x * NTHR + tid, gn = gridDim.x * NTHR;
  for (int i = gt; i < 17 * D; i += gn) {
    int r = i / D, k = i % D;
    float v = (r < 16) ? p.c[r * D + k] : p.c_ctx[k];
    p.sc[i] = siluf_(v);
  }
  for (int i = gt; i < 64 * 32; i += gn) {
    int pos = i >> 5, pp = i & 31;
    float inv = powf(10000.f, -(float)pp / 32.f);
    float ang = (float)pos * inv;
    p.rope[i] = cosf(ang);
    p.rope[2048 + i] = sinf(ang);
  }
  if (blockIdx.x == 0 && tid < 64) p.ctr[tid] = 0;
}

DI void phase_mod(CParams& p, char* lds) {
  const int tid = otid();
  float* red = (float*)lds;
  const int col = tid & 63, kg = tid >> 6;
  for (int it = blockIdx.x; it < DEPTH * 48; it += gridDim.x) {
    int l = it / 48, cb = it % 48;
    float acc[17];
#pragma unroll
    for (int r = 0; r < 17; ++r) acc[r] = 0.f;
    const float* w = p.w_mod + (size_t)l * D * 3072 + cb * 64 + col;
    for (int k = kg * 128; k < kg * 128 + 128; ++k) {
      float wv = w[(size_t)k * 3072];
#pragma unroll
      for (int r = 0; r < 17; ++r) acc[r] += p.sc[r * D + k] * wv;
    }
    __syncthreads();
#pragma unroll
    for (int r = 0; r < 17; ++r) red[(kg * 17 + r) * 64 + col] = acc[r];
    __syncthreads();
    for (int i = tid; i < 17 * 64; i += NTHR) {
      int r = i >> 6, cc = i & 63;
      float s = 0.f;
#pragma unroll
      for (int g = 0; g < 8; ++g) s += red[(g * 17 + r) * 64 + cc];
      p.modv[((size_t)l * 17 + r) * 3072 + cb * 64 + cc] = s + p.b_mod[l * 3072 + cb * 64 + cc];
    }
  }
}

DI void phase_prenorm(CParams& p, int chunk, int l) {
  const int NB = p.NB, RL = NB * S, R = NB * (S + L);
  const int tid_ = otid();
  const int lane = tid_ & 63;
  const int wg = blockIdx.x * 8 + (tid_ >> 6), nw = gridDim.x * 8;
  const float* g = p.norm_g + l * D;
  for (int r = wg; r < R; r += nw) {
    const float* src; int mrow;
    if (r < RL) {
      int b = r / S, t = r % S; int bg = chunk * NB + b;
      src = (l == 0 ? p.x : p.out) + ((size_t)bg * S + t) * D; mrow = bg;
    } else {
      int rc = r - RL; int b = rc / L, t = rc % L; int bg = chunk * NB + b;
      src = (l == 0 ? p.ctx : p.xc) + ((size_t)bg * L + t) * D; mrow = 16;
    }
    const float* mv = p.modv + ((size_t)l * 17 + mrow) * 3072;
    float4 v[4]; float ss = 0.f;
#pragma unroll
    for (int i = 0; i < 4; ++i) {
      v[i] = *(const float4*)(src + i * 256 + lane * 4);
      ss += v[i].x * v[i].x + v[i].y * v[i].y + v[i].z * v[i].z + v[i].w * v[i].w;
    }
#pragma unroll
    for (int o = 32; o >= 1; o >>= 1) ss += __shfl_xor(ss, o);
    float rstd = rsqrtf(ss * (1.f / D) + EPS);
#pragma unroll
    for (int i = 0; i < 4; ++i) {
      int cidx = i * 256 + lane * 4;
      float4 gg = *(const float4*)(g + cidx);
      float4 sh = *(const float4*)(mv + cidx);
      float4 scl = *(const float4*)(mv + 1024 + cidx);
      float h0 = v[i].x * rstd * gg.x * (1.f + scl.x) + sh.x;
      float h1 = v[i].y * rstd * gg.y * (1.f + scl.y) + sh.y;
      float h2 = v[i].z * rstd * gg.z * (1.f + scl.z) + sh.z;
      float h3 = v[i].w * rstd * gg.w * (1.f + scl.w) + sh.w;
      uint2 o; o.x = pack2(h0, h1); o.y = pack2(h2, h3);
      *(uint2*)(p.Hb + (size_t)r * D + cidx) = o;
    }
  }
}

template <int BN, bool PIPE>
DI void gemm_core(const u16* A, int lda, int ksa, size_t a_blk, const u16* Bt, int ldb, int ksb, size_t b_blk, int K, char* ldsc,
                  f32x16 (&acc)[BN / 64][2]) {
  constexpr int MI = BN / 64;
  constexpr int SS = 32768 + BN * 128;
  const int tid = otid(), lane = tid & 63, w = tid >> 6;
  const int wm = (BN == 256) ? (w >> 2) : (w >> 1), wn = (BN == 256) ? (w & 3) : (w & 1);
  const int r = lane & 31, hh = lane >> 5;
  const int drow = lane >> 3, dcp = lane & 7;
  const int chunk0 = dcp ^ (drow >> 1);
  const u16* gAe = A + (size_t)(w >> 2) * a_blk + (size_t)((w & 3) * 32 + drow) * lda + chunk0 * 8;
  const u16* gAo = gAe + (size_t)8 * lda + ((chunk0 ^ 4) - chunk0) * 8;
  const size_t a16 = (size_t)16 * lda;
  const int brow0 = (BN == 256) ? (w & 3) * 32 : w * 16;
  const u16* gBe = Bt + ((BN == 256) ? (size_t)(w >> 2) * b_blk : (size_t)0) + (size_t)(brow0 + drow) * ldb + chunk0 * 8;
  const u16* gBo = gBe + (size_t)8 * ldb + ((chunk0 ^ 4) - chunk0) * 8;
  const size_t b16 = (size_t)16 * ldb;
#pragma unroll
  for (int i = 0; i < MI; ++i)
#pragma unroll
    for (int j = 0; j < 2; ++j)
#pragma unroll
      for (int x = 0; x < 16; ++x) acc[i][j][x] = 0.f;
  auto DMA = [&](int kt, int stage) {
    char* sa = ldsc + stage * SS + (w * 4) * 1024;
    char* sb = ldsc + stage * SS + 32768 + ((BN == 256) ? (w * 4) : (w * 2)) * 1024;
    const size_t ka = (size_t)kt * ksa, kb = (size_t)kt * ksb;
    __builtin_amdgcn_global_load_lds((const unsigned*)(gAe + ka), (unsigned*)(sa), 16, 0, 0);
    __builtin_amdgcn_global_load_lds((const unsigned*)(gBe + kb), (unsigned*)(sb), 16, 0, 0);
    __builtin_amdgcn_global_load_lds((const unsigned*)(gAo + ka), (unsigned*)(sa + 1024), 16, 0, 0);
    __builtin_amdgcn_global_load_lds((const unsigned*)(gBo + kb), (unsigned*)(sb + 1024), 16, 0, 0);
    __builtin_amdgcn_global_load_lds((const unsigned*)(gAe + a16 + ka), (unsigned*)(sa + 2048), 16, 0, 0);
    __builtin_amdgcn_global_load_lds((const unsigned*)(gAo + a16 + ka), (unsigned*)(sa + 3072), 16, 0, 0);
    if (BN == 256) {
      __builtin_amdgcn_global_load_lds((const unsigned*)(gBe + b16 + kb), (unsigned*)(sb + 2048), 16, 0, 0);
      __builtin_amdgcn_global_load_lds((const unsigned*)(gBo + b16 + kb), (unsigned*)(sb + 3072), 16, 0, 0);
    }
  };
  const int sw = (r >> 1) & 7;
  int koff[4];
#pragma unroll
  for (int ks = 0; ks < 4; ++ks) koff[ks] = ((2 * ks + hh) ^ sw) << 4;
  auto COMPUTE = [&](int stage) {
    const char* ab = ldsc + stage * SS + (wm * (MI * 32) + r) * 128;
    const char* bb = ldsc + stage * SS + 32768 + (wn * 64 + r) * 128;
    bf16x8 fa[2][MI], fb[2][2];
    auto LDF = [&](int ks, int slot) {
#pragma unroll
      for (int i = 0; i < MI; ++i) fa[slot][i] = *(const bf16x8*)(ab + i * 32 * 128 + koff[ks]);
#pragma unroll
      for (int j = 0; j < 2; ++j) fb[slot][j] = *(const bf16x8*)(bb + j * 32 * 128 + koff[ks]);
    };
    auto MM = [&](int slot) {
#pragma unroll
      for (int i = 0; i < MI; ++i)
#pragma unroll
        for (int j = 0; j < 2; ++j) acc[i][j] = MFMA32(fb[slot][j], fa[slot][i], acc[i][j]);
    };
    if (!PIPE) {
#pragma unroll
      for (int ks = 0; ks < 4; ++ks) { LDF(ks, 0); MM(0); }
      return;
    }
    LDF(0, 0); LDF(1, 1);
    __builtin_amdgcn_sched_barrier(0);
    MM(0); LDF(2, 0);
    __builtin_amdgcn_sched_barrier(0);
    MM(1); LDF(3, 1);
    __builtin_amdgcn_sched_barrier(0);
    MM(0); MM(1);
  };
  const int KT = K >> 6;
  __syncthreads();
  DMA(0, 0);
  __syncthreads();
  for (int kt = 0; kt < KT; kt += 2) {
    DMA(kt + 1, 1);
    COMPUTE(0);
    __syncthreads();
    if (kt + 2 < KT) DMA(kt + 2, 0);
    COMPUTE(1);
    __syncthreads();
  }
}

template <int MI>
DI void stage_acc(char* ldsc, f32x16 (&acc)[MI][2], int wm, int ncol0, bool active) {
  const int tid = otid(), lane = tid & 63;
  const int r = lane & 31, hh = lane >> 5;
  float* Cs = (float*)ldsc;
  if (active) {
#pragma unroll
    for (int i = 0; i < MI; ++i)
#pragma unroll
      for (int j = 0; j < 2; ++j)
#pragma unroll
        for (int g = 0; g < 4; ++g) {
          int m = wm * (MI * 32) + i * 32 + r;
          int n = ncol0 + j * 32 + 8 * g + 4 * hh;
          float4 v; v.x = acc[i][j][4 * g]; v.y = acc[i][j][4 * g + 1]; v.z = acc[i][j][4 * g + 2]; v.w = acc[i][j][4 * g + 3];
          *(float4*)(Cs + m * 132 + n) = v;
        }
  }
  __syncthreads();
}

DI void read_row64(const char* ldsc, int row, int half, float (&v)[64]) {
  const float* Cs = (const float*)ldsc + row * 132 + half * 64;
#pragma unroll
  for (int j = 0; j < 16; ++j) {
    float4 t = *(const float4*)(Cs + j * 4);
    v[j * 4] = t.x; v[j * 4 + 1] = t.y; v[j * 4 + 2] = t.z; v[j * 4 + 3] = t.w;
  }
}

DI void store_row64_bf16(u16* dst, const float (&v)[64]) {
#pragma unroll
  for (int j = 0; j < 8; ++j) {
    uint4 o;
    o.x = pack2(v[j * 8], v[j * 8 + 1]); o.y = pack2(v[j * 8 + 2], v[j * 8 + 3]);
    o.z = pack2(v[j * 8 + 4], v[j * 8 + 5]); o.w = pack2(v[j * 8 + 6], v[j * 8 + 7]);
    *(uint4*)(dst + j * 8) = o;
  }
}

namespace pg8 {
#define PG8_LAS __attribute__((address_space(3)))
typedef unsigned short bf16_t;
typedef short bf16x8 __attribute__((ext_vector_type(8)));
typedef float f32x4 __attribute__((ext_vector_type(4)));
typedef unsigned u32x4 __attribute__((ext_vector_type(4)));
constexpr int BM = 256, BK = 64, HALF = 128, HTB = HALF * BK * 2  , STAGE_BYTES = 8 * HTB, NXCD = 8, WGM = 8;

__host__ __device__ __forceinline__ int lds_byte(int r, int c) { const int st = (r >> 4) * 2 + (c >> 5), rr = r & 15, cc = c & 31, ob = rr * 64 + cc * 2; return st * 1024 + (ob ^ (((ob >> 9) & 1) << 5)); }
__host__ __device__ __forceinline__ void stage_rc(int b, int& R, int& C) { const int st = b / 1024, sb = b % 1024, swz = sb ^ (((sb >> 9) & 1) << 5); R = (st >> 1) * 16 + swz / 64; C = (st & 1) * 32 + (swz % 64) / 2; }
__host__ __device__ __forceinline__ int perm32(int rho) { const int n = rho >> 4, i = rho & 15; return 8 * (i >> 2) + 4 * n + (i & 3); }
struct Unit { int pm, pn; };
struct Gemm { const bf16_t* A; const bf16_t* Bt; int M, N, K; };
struct StaticOrder {
    int nM, nN, nwg, G, c;
    __host__ __device__ void init(int M, int N, int G_, int c_) { nM = M / BM; nN = N / BM; nwg = nM * nN; G = G_; c = c_; }
    __host__ __device__ bool next(int i, Unit& u) const {
        const long L = (long)i * G + c; if (L >= nwg) return false;
        int wgid = (int)L; { const int q = nwg / NXCD, r = nwg % NXCD, xcd = wgid % NXCD, off = wgid / NXCD; wgid = (xcd < r ? xcd * (q + 1) : r * (q + 1) + (xcd - r) * q) + off; }
        const int nig = WGM * nN, gid = wgid / nig, fm = gid * WGM, gsz = (nM - fm) < WGM ? (nM - fm) : WGM;
        u.pm = fm + ((wgid % nig) % gsz); u.pn = (wgid % nig) / gsz; return true;
    }
    __device__ __forceinline__ void a_ready(const Unit&) const {}
    __device__ __forceinline__ void done(const Unit&) const {}
};
template <class Epi, class Sched, bool STAMP = false>
__device__ __forceinline__ void gemm_phase(PG8_LAS unsigned char* lds, const Gemm g, const Sched& S, const Epi& E, unsigned long long* stamps) {
    int tid_raw = threadIdx.x; asm volatile("" : "+v"(tid_raw));
    const int tid = tid_raw, wid = __builtin_amdgcn_readfirstlane(tid >> 6), lane = tid & 63, wr = wid >> 2, wc = wid & 3, fr = lane & 15, fq = lane >> 4;
    const int K = g.K, nt = K / BK;
    int ts_lo = 0, ts_hi = 0, nts = 0; const unsigned long long rt_entry = STAMP ? (unsigned long long)wall_clock64() : 0ull;
#define PG8_STAMP() do { if (STAMP && wid == 0 && nts < 64) { const unsigned long long _c = (unsigned long long)clock64(); \
        ts_lo = (lane == nts) ? (int)(unsigned)_c : ts_lo; ts_hi = (lane == nts) ? (int)(unsigned)(_c >> 32) : ts_hi; ++nts; } } while (0)
    PG8_STAMP();
    unsigned voffA[2], voffB[2];
#pragma unroll
    for (int i = 0; i < 2; ++i) { int R, C; stage_rc(tid * 16 + i * 8192, R, C); const int Rb = Epi::PERM ? ((R & ~31) + perm32(R & 31)) : R;
        voffA[i] = (unsigned)(R * K + C) * 2u; voffB[i] = (unsigned)(Rb * K + C) * 2u; }
    const size_t kstep = (size_t)(BK * 2);
    const size_t hstep = (size_t)HALF * K * 2;
    const size_t tstep = 2 * hstep;
    const unsigned ldsw = (unsigned)wid * 1024u;
    const int aoff = lds_byte(wr * 64 + fr, fq * 8), boff = lds_byte(wc * 32 + fr, fq * 8);
#define PG8_SA(b, h) (((b) * 2 + (h)) * HTB)
#define PG8_SB(b, h) ((4 + (b) * 2 + (h)) * HTB)
#define PG8_STAGE(bufoff, gbase, voff) do { _Pragma("unroll") for (int _i = 0; _i < 2; ++_i) \
        __builtin_amdgcn_global_load_lds((const unsigned*)((const char*)(gbase) + (voff)[_i]), (PG8_LAS unsigned*)(lds + (bufoff) + ldsw + _i * 8192), 16, 0, 0); } while (0)
#define PG8_LDA(dst, b, h) do { _Pragma("unroll") for (int m = 0; m < 4; ++m) _Pragma("unroll") for (int k = 0; k < 2; ++k) dst[m][k] = *(const PG8_LAS bf16x8*)(lds + PG8_SA(b, h) + aoff + m * 2048 + k * 1024); } while (0)
#define PG8_LDB(dst, b, h) do { _Pragma("unroll") for (int n = 0; n < 2; ++n) _Pragma("unroll") for (int k = 0; k < 2; ++k) dst[n][k] = *(const PG8_LAS bf16x8*)(lds + PG8_SB(b, h) + boff + n * 2048 + k * 1024); } while (0)
#define PG8_MMA(ai, bj, At, Bt) do { __builtin_amdgcn_s_setprio(1); _Pragma("unroll") for (int m = 0; m < 4; ++m) _Pragma("unroll") for (int n = 0; n < 2; ++n) _Pragma("unroll") for (int k = 0; k < 2; ++k) \
        acc[ai][bj][m][n] = __builtin_amdgcn_mfma_f32_16x16x32_bf16(Bt[n][k], At[m][k], acc[ai][bj][m][n], 0, 0, 0); __builtin_amdgcn_s_setprio(0); } while (0)
#define PG8_WAIT_V(n) asm volatile("s_waitcnt vmcnt(" #n ")" ::: "memory")
#define PG8_WAIT_L(n) asm volatile("s_waitcnt lgkmcnt(" #n ")" ::: "memory")
#define PG8_BAR __builtin_amdgcn_s_barrier()
#define PG8_SCHED __builtin_amdgcn_sched_barrier(0)
    Unit cur, nxt; int ui = 0;
    if (!S.next(0, cur)) return;
    f32x4 acc[2][2][4][2];
#pragma unroll
    for (int a = 0; a < 2; ++a)
#pragma unroll
        for (int b = 0; b < 2; ++b)
#pragma unroll
            for (int m = 0; m < 4; ++m)
#pragma unroll
                for (int n = 0; n < 2; ++n) acc[a][b][m][n] = (f32x4){0.f, 0.f, 0.f, 0.f};
    bf16x8 At[4][2], B0[2][2], B1[2][2];
    const char* cA = (const char*)g.A + (size_t)cur.pm * tstep; const char* cB = (const char*)g.Bt + (size_t)cur.pn * tstep;
    S.a_ready(cur);
    PG8_STAGE(PG8_SB(0, 0), cB, voffB); PG8_STAGE(PG8_SA(0, 0), cA, voffA); PG8_STAGE(PG8_SB(0, 1), cB + hstep, voffB); PG8_STAGE(PG8_SA(0, 1), cA + hstep, voffA);
    if (wr == 1) PG8_BAR;
    PG8_WAIT_V(4); PG8_BAR;
    PG8_STAGE(PG8_SB(1, 0), cB + kstep, voffB); PG8_STAGE(PG8_SA(1, 0), cA + kstep, voffA); PG8_STAGE(PG8_SB(1, 1), cB + hstep + kstep, voffB);
    PG8_WAIT_V(6); PG8_BAR;
    PG8_STAMP();
    for (;;) {
        const bool has_next = S.next(ui + 1, nxt);
        const char* nA = has_next ? (const char*)g.A + (size_t)nxt.pm * tstep : cA; const char* nB = has_next ? (const char*)g.Bt + (size_t)nxt.pn * tstep : cB;
        for (int t = 0; t < nt; t += 2) {
            const bool last = (t == nt - 2);
            const char* a1 = cA + (size_t)(t + 1) * kstep;
            const char* a2 = last ? nA : cA + (size_t)(t + 2) * kstep; const char* b2 = last ? nB : cB + (size_t)(t + 2) * kstep;
            const char* a3 = a2 + kstep; const char* b3 = b2 + kstep;
            if (last && has_next) S.a_ready(nxt);
            PG8_LDB(B0, 0, 0); PG8_SCHED; PG8_LDA(At, 0, 0); PG8_STAGE(PG8_SA(1, 1), a1 + hstep, voffA);
            PG8_WAIT_L(8); PG8_BAR; PG8_WAIT_L(0); PG8_MMA(0, 0, At, B0); PG8_BAR; PG8_SCHED;
            PG8_LDB(B1, 0, 1); PG8_STAGE(PG8_SB(0, 0), b2, voffB);
            PG8_BAR; PG8_WAIT_L(0); PG8_MMA(0, 1, At, B1); PG8_BAR;
            PG8_LDA(At, 0, 1); PG8_STAGE(PG8_SA(0, 0), a2, voffA);
            PG8_BAR; PG8_WAIT_L(0); PG8_MMA(1, 0, At, B0); PG8_BAR; PG8_SCHED;
            PG8_STAGE(PG8_SB(0, 1), b2 + hstep, voffB);
            PG8_WAIT_V(6); PG8_BAR; PG8_MMA(1, 1, At, B1); PG8_BAR;
            PG8_LDB(B0, 1, 0); PG8_SCHED; PG8_LDA(At, 1, 0); PG8_STAGE(PG8_SA(0, 1), a2 + hstep, voffA);
            PG8_WAIT_L(8); PG8_BAR; PG8_WAIT_L(0); PG8_MMA(0, 0, At, B0); PG8_BAR; PG8_SCHED;
            PG8_LDB(B1, 1, 1); PG8_STAGE(PG8_SB(1, 0), b3, voffB);
            PG8_BAR; PG8_WAIT_L(0); PG8_MMA(0, 1, At, B1); PG8_BAR;
            PG8_LDA(At, 1, 1); PG8_STAGE(PG8_SA(1, 0), a3, voffA);
            PG8_BAR; PG8_WAIT_L(0); PG8_MMA(1, 0, At, B0); PG8_BAR; PG8_SCHED;
            PG8_STAGE(PG8_SB(1, 1), b3 + hstep, voffB);
            PG8_WAIT_V(6); PG8_BAR; PG8_MMA(1, 1, At, B1); PG8_BAR;
        }
        PG8_STAMP();
        if constexpr (!Epi::AFTER_DRAIN) { E(acc, cur, wr, wc, fr, fq); S.done(cur); }
        PG8_STAMP();
        if (!has_next) break;
#pragma unroll
        for (int a = 0; a < 2; ++a)
#pragma unroll
            for (int b = 0; b < 2; ++b)
#pragma unroll
                for (int m = 0; m < 4; ++m)
#pragma unroll
                    for (int n = 0; n < 2; ++n) acc[a][b][m][n] = (f32x4){0.f, 0.f, 0.f, 0.f};
        cur = nxt; cA = nA; cB = nB; ++ui;
    }
    PG8_WAIT_V(0);
    if (wr == 0) PG8_BAR;
    PG8_BAR;
    if constexpr (Epi::AFTER_DRAIN) { E.fused(acc, cur, wr, wc, fr, fq, lds, wid, lane); S.done(cur); }
    PG8_STAMP();
    if (STAMP && wid == 0) { stamps[lane] = lane < nts ? (((unsigned long long)(unsigned)ts_hi << 32) | (unsigned)ts_lo) : 0ull;
        if (lane == 62) stamps[62] = rt_entry; if (lane == 63) stamps[63] = (unsigned long long)wall_clock64(); }
#undef PG8_STAMP
#undef PG8_SA
#undef PG8_SB
#undef PG8_STAGE
#undef PG8_LDA
#undef PG8_LDB
#undef PG8_MMA
#undef PG8_WAIT_V
#undef PG8_WAIT_L
#undef PG8_BAR
#undef PG8_SCHED
}
}

struct EpiIn {
  static constexpr bool PERM = true, AFTER_DRAIN = false;
  CParams* kp;
  __device__ __forceinline__ void operator()(const pg8::f32x4 (&acc)[2][2][4][2], const pg8::Unit& u, int wr, int wc, int fr, int fq) const {
    const int pn = u.pn;
    u16* base; int ld, mode;
    if (pn < 4) { base = kp->U + pn * 256; ld = D; mode = 0; }
    else if (pn < 16) { base = kp->Z + (pn - 4) * 256; ld = 3072; mode = 1; }
    else { base = kp->Ms + (pn - 16) * 256; ld = 3072; mode = 2; }
    const int row0 = u.pm * 256 + wr * 64 + fr;
    const int col0 = wc * 32 + 8 * fq;
    u16* rowp0 = base + (size_t)row0 * ld + col0;
#pragma unroll
    for (int ai = 0; ai < 2; ++ai)
#pragma unroll
      for (int m = 0; m < 4; ++m)
#pragma unroll
        for (int bj = 0; bj < 2; ++bj)
#pragma unroll
          for (int n = 0; n < 2; ++n) {
            pg8::f32x4 v0 = acc[ai][bj][m][n];
            if (mode == 1) {
#pragma unroll
              for (int j = 0; j < 4; ++j) v0[j] = siluf_(v0[j]);
            } else if (mode == 2) {
#pragma unroll
              for (int j = 0; j < 4; ++j) v0[j] = sigmoidf_(v0[j]);
            }
            u32x2 w; w.x = pack2(v0[0], v0[1]); w.y = pack2(v0[2], v0[3]);
            *(u32x2*)(rowp0 + (size_t)(ai * 128 + m * 16) * ld + bj * 128 + n * 4) = w;
          }
  }
};

DI bool tile_map(int i, int MT, int NT, int& mt, int& nt) {
  const int G = gridDim.x, bid = blockIdx.x;
  if ((G & 63) == 0 && (MT & 7) == 0 && (NT % (G >> 6)) == 0) {
    const int SH = G >> 6;
    const int xcd = bid & 7, slot = bid >> 3;
    const int sx = slot & 7, sy = slot >> 3;
    const int nsn = NT / SH, nsm = MT >> 3;
    const int st = i * 8 + xcd;
    if (st >= nsm * nsn) return false;
    mt = (st / nsn) * 8 + sx;
    nt = (st % nsn) * SH + sy;
    return true;
  }
  const int it = bid + i * G;
  if (it >= MT * NT) return false;
  mt = it / NT; nt = it % NT;
  return true;
}


struct OneUnit {
  int pm, pn;
  __device__ bool next(int i, pg8::Unit& u) const { if (i) return false; u.pm = pm; u.pn = pn; return true; }
  __device__ __forceinline__ void a_ready(const pg8::Unit&) const {}
  __device__ __forceinline__ void done(const pg8::Unit&) const {}
  __device__ __forceinline__ size_t a_off(const pg8::Unit&) const { return 0; }
};
struct EpiQKV {
  static constexpr bool PERM = false, AFTER_DRAIN = true;
  CParams* kp; char* lds; int l, nt, m0;
  __device__ __forceinline__ void fused(const pg8::f32x4 (&acc)[2][2][4][2], const pg8::Unit&, int wr, int wc, int fr, int fq,
                                        PG8_LAS unsigned char*, int, int) const {
    CParams& p = *kp;
    const int NB = p.NB, RL = NB * S;
    const int tid = otid();
    const bool lat = m0 < RL;
    int b, t0;
    if (lat) { b = m0 / S; t0 = m0 % S; } else { int rc = m0 - RL; b = rc / L; t0 = rc % L; }
    const bool isV = (nt == 13 || nt == 23);
    const bool isC = nt >= 18;
    const bool isQ = (nt >= 8 && nt < 12) || (nt >= 18 && nt < 22);
    auto process_unit = [&](int hsel, int u) {
      if (isV) {
        const int slot = (isC ? 2 : 0) + hsel;
        const int d = u >> 2, tq = u & 3;
        const float* Cs = (const float*)lds;
        u16* dst = lat ? p.VtL + ((size_t)(b * 4 + slot) * 128 + d) * S + t0 + tq * 64
                       : p.VtC + ((size_t)(b * 4 + slot) * 128 + d) * L + t0 + tq * 64;
#pragma unroll 1
        for (int c = 0; c < 4; ++c) {
          float v[16];
#pragma unroll
          for (int j = 0; j < 16; ++j) v[j] = Cs[(tq * 64 + c * 16 + j) * 132 + d];
          uint4 o0, o1;
          o0.x = pack2(v[0], v[1]); o0.y = pack2(v[2], v[3]); o0.z = pack2(v[4], v[5]); o0.w = pack2(v[6], v[7]);
          o1.x = pack2(v[8], v[9]); o1.y = pack2(v[10], v[11]); o1.z = pack2(v[12], v[13]); o1.w = pack2(v[14], v[15]);
          *(uint4*)(dst + c * 16) = o0;
          *(uint4*)(dst + c * 16 + 8) = o1;
        }
      } else {
        const int row = u >> 1, half = u & 1;
        const size_t gr = (size_t)m0 + row;
        const int t = t0 + row;
        const float* Cr = (const float*)lds + row * 132 + half * 64;
        float rstd = 1.f;
        const float* gn = (isQ ? p.q_norm_g : p.k_norm_g) + l * 128 + half * 64;
        if (isC) {
          float ss = 0.f;
#pragma unroll
          for (int j = 0; j < 16; ++j) {
            float4 tv = *(const float4*)(Cr + j * 4);
            ss += tv.x * tv.x + tv.y * tv.y + tv.z * tv.z + tv.w * tv.w;
          }
          ss += __shfl_xor(ss, 1);
          rstd = rsqrtf(ss * (1.f / 128.f) + EPS);
        }
        const int pos = (half == 0) ? (t >> 6) : (t & 63);
        const float* cs = p.rope + pos * 32;
        const float* sn = p.rope + 2048 + pos * 32;
        u16* dst;
        if (isQ) {
          const int head = (isC ? (nt - 18) : (nt - 8)) * 2 + hsel;
          dst = p.Q + gr * 2048 + (isC ? 1024 : 0) + head * 128 + half * 64;
        } else {
          dst = p.Kb + gr * 512 + (isC ? 256 : 0) + hsel * 128 + half * 64;
        }
#pragma unroll 1
        for (int c = 0; c < 2; ++c) {
          float x0[16], x1[16];
#pragma unroll
          for (int j = 0; j < 4; ++j) {
            float4 ta_ = *(const float4*)(Cr + c * 16 + j * 4);
            float4 tb_ = *(const float4*)(Cr + 32 + c * 16 + j * 4);
            x0[4 * j] = ta_.x; x0[4 * j + 1] = ta_.y; x0[4 * j + 2] = ta_.z; x0[4 * j + 3] = ta_.w;
            x1[4 * j] = tb_.x; x1[4 * j + 1] = tb_.y; x1[4 * j + 2] = tb_.z; x1[4 * j + 3] = tb_.w;
          }
          if (isC) {
#pragma unroll
            for (int j = 0; j < 16; ++j) { x0[j] = x0[j] * rstd * gn[c * 16 + j]; x1[j] = x1[j] * rstd * gn[32 + c * 16 + j]; }
          }
          if (lat) {
#pragma unroll
            for (int j = 0; j < 16; ++j) {
              float c_ = cs[c * 16 + j], s_ = sn[c * 16 + j];
              float a0 = x0[j], a1 = x1[j];
              x0[j] = a0 * c_ - a1 * s_;
              x1[j] = a1 * c_ + a0 * s_;
            }
          }
          if (isQ) {
#pragma unroll
            for (int j = 0; j < 16; ++j) { x0[j] *= QSCALE; x1[j] *= QSCALE; }
          }
          uint4 o0, o1, o2, o3;
          o0.x = pack2(x0[0], x0[1]); o0.y = pack2(x0[2], x0[3]); o0.z = pack2(x0[4], x0[5]); o0.w = pack2(x0[6], x0[7]);
          o1.x = pack2(x0[8], x0[9]); o1.y = pack2(x0[10], x0[11]); o1.z = pack2(x0[12], x0[13]); o1.w = pack2(x0[14], x0[15]);
          o2.x = pack2(x1[0], x1[1]); o2.y = pack2(x1[2], x1[3]); o2.z = pack2(x1[4], x1[5]); o2.w = pack2(x1[6], x1[7]);
          o3.x = pack2(x1[8], x1[9]); o3.y = pack2(x1[10], x1[11]); o3.z = pack2(x1[12], x1[13]); o3.w = pack2(x1[14], x1[15]);
          *(uint4*)(dst + c * 16) = o0;
          *(uint4*)(dst + c * 16 + 8) = o1;
          *(uint4*)(dst + 32 + c * 16) = o2;
          *(uint4*)(dst + 32 + c * 16 + 8) = o3;
        }
      }
    };

#pragma unroll
    for (int bj = 0; bj < 2; ++bj) {
      float* Cs = (float*)lds;
#pragma unroll
      for (int ai = 0; ai < 2; ++ai)
#pragma unroll
        for (int m = 0; m < 4; ++m)
#pragma unroll
          for (int n = 0; n < 2; ++n) {
            const int row = ai * 128 + wr * 64 + m * 16 + fr;
            const int col = wc * 32 + n * 16 + fq * 4;
            pg8::f32x4 v = acc[ai][bj][m][n];
            float4 o; o.x = v[0]; o.y = v[1]; o.z = v[2]; o.w = v[3];
            *(float4*)(Cs + row * 132 + col) = o;
          }
      __syncthreads();
      process_unit(bj, tid);
      __syncthreads();
    }
  }
};

DI void phase_gemm_in(CParams& p, int chunk, int l, char* lds) {
  const int NB = p.NB, RL = NB * S, R = NB * (S + L);
  const int MT = R / 256;
  const u16* Wt = p.WinT + (size_t)l * INW * D;
  {
    pg8::Gemm g{p.Hb, Wt, R, 7168, D};
    pg8::StaticOrder So; So.init(R, 7168, (int)gridDim.x, (int)blockIdx.x);
    EpiIn E{&p};
    pg8::gemm_phase<EpiIn, pg8::StaticOrder, false>((PG8_LAS unsigned char*)lds, g, So, E, nullptr);
  }
  for (int ti = 0;; ++ti) {
    int mt, jt;
    if (!tile_map(ti, MT, 12, mt, jt)) break;
    const int nt = (jt < 6) ? 8 + jt : 12 + jt;
    pg8::Gemm g{p.Hb, Wt + (size_t)28 * 256 * D, R, 3072, D};
    OneUnit One{mt, jt};
    EpiQKV E{&p, lds, l, nt, mt * 256};
    pg8::gemm_phase<EpiQKV, OneUnit, false>((PG8_LAS unsigned char*)lds, g, One, E, nullptr);
  }
}

struct AttnArgs {
  const u16* q;
  u16* z;
  const u16* kctx;
  const u16* vctx;
  const u16* klat;
  const u16* vlat;
  int n_lat_tiles;
  int lat_key0;
  int q_t0;
  int band;
  int has_sink;
  float sink_l2;
  int dry;
  int fixedm;
  float mfix;
};

DI void attn_load_tile(const AttnArgs& a, int ti, u32x4 (&rk)[2], u32x4 (&rv)[2]) {
  const int tid = otid();
  const u16* kp; const u16* vp; int vs;
  if (ti < 4) { kp = a.kctx + (size_t)(ti * 64) * 512; vp = a.vctx + ti * 64; vs = L; }
  else { kp = a.klat + (size_t)((ti - 4) * 64) * 512; vp = a.vlat + (ti - 4) * 64; vs = S; }
#pragma unroll
  for (int i = 0; i < 2; ++i) {
    int c = tid + NTHR * i;
    rk[i] = *(const u32x4*)(kp + (size_t)(c >> 4) * 512 + (c & 15) * 8);
    rv[i] = *(const u32x4*)(vp + (size_t)(c >> 3) * vs + (c & 7) * 8);
  }
}
DI void attn_store_tile(u16* sK, u16* sV, const u32x4 (&rk)[2], const u32x4 (&rv)[2]) {
  const int tid = otid();
#pragma unroll
  for (int i = 0; i < 2; ++i) {
    int c = tid + NTHR * i;
    *(u32x4*)(sK + (c >> 4) * 136 + (c & 15) * 8) = rk[i];
    u16* vd = sV + (c >> 3) * 68 + (c & 7) * 8;
    { u32x2 t0 = {rv[i].x, rv[i].y}; *(u32x2*)(vd) = t0; }
    { u32x2 t1 = {rv[i].z, rv[i].w}; *(u32x2*)(vd + 4) = t1; }
  }
}

DI void attn_item(const AttnArgs& a, char* lds) {
  const int tid = otid(), lane = tid & 63, w = tid >> 6;
  const int r = lane & 31, hh = lane >> 5;
  constexpr int STG = 34816;
  const int ntiles = 4 + a.n_lat_tiles;

  bf16x8 qf[8];
  {
    const u16* qp = a.q + (size_t)(w * 32 + r) * 2048 + hh * 8;
#pragma unroll
    for (int ks = 0; ks < 8; ++ks) qf[ks] = *(const bf16x8*)(qp + ks * 16);
  }
  f32x16 O[4];
#pragma unroll
  for (int dt = 0; dt < 4; ++dt)
#pragma unroll
    for (int x = 0; x < 16; ++x) O[dt][x] = 0.f;
  float m = a.fixedm ? a.mfix : (a.has_sink ? a.sink_l2 : -1e30f);
  float lsum = (a.has_sink && hh == 0) ? 1.f : 0.f;
  const int qpos = a.q_t0 + w * 32 + r;

  auto QK = [&](int stage, f32x16 (&sc)[2]) {
    const u16* sK = (const u16*)(lds + stage * STG);
#pragma unroll
    for (int kt2 = 0; kt2 < 2; ++kt2) {
#pragma unroll
      for (int x = 0; x < 16; ++x) sc[kt2][x] = 0.f;
      const u16* kb = sK + (kt2 * 32 + r) * 136 + hh * 8;
#pragma unroll
      for (int ks = 0; ks < 8; ++ks) {
        bf16x8 ka = *(const bf16x8*)(kb + ks * 16);
        sc[kt2] = MFMA32(ka, qf[ks], sc[kt2]);
      }
    }
  };
  u32x4 rk[2], rv[2];
  auto STEP = [&](int ti, int st, f32x16 (&sc)[2], f32x16 (&sn)[2]) {
    const int st1 = (st == 2) ? 0 : st + 1, st2 = (st == 0) ? 2 : st - 1;
    if (ti + 2 < ntiles) attn_load_tile(a, ti + 2, rk, rv);
    if (ti + 1 < ntiles) QK(st1, sn);
    if (a.band && ti >= 4) {
      const int k0 = a.lat_key0 + (ti - 4) * 64;
#pragma unroll
      for (int kt2 = 0; kt2 < 2; ++kt2)
#pragma unroll
        for (int x = 0; x < 16; ++x) {
          int kp = k0 + kt2 * 32 + crow(x, hh);
          int dlt = kp - qpos; dlt = dlt < 0 ? -dlt : dlt;
          if (dlt > 128) sc[kt2][x] = -1e30f;
        }
    }
    if (!a.fixedm) {
      float mx = sc[0][0];
#pragma unroll
      for (int kt2 = 0; kt2 < 2; ++kt2)
#pragma unroll
        for (int x = 0; x < 16; ++x) mx = fmaxf(mx, sc[kt2][x]);
      mx = fmaxf(mx, __shfl_xor(mx, 32));
      if (__any(mx > m + 8.f)) {
        const float mnew = fmaxf(m, mx);
        const float alpha = __builtin_amdgcn_exp2f(m - mnew);
        m = mnew;
        lsum *= alpha;
#pragma unroll
        for (int dt = 0; dt < 4; ++dt)
#pragma unroll
          for (int x = 0; x < 16; ++x) O[dt][x] *= alpha;
      }
    }
    float ps = 0.f;
#pragma unroll
    for (int kt2 = 0; kt2 < 2; ++kt2)
#pragma unroll
      for (int x = 0; x < 16; ++x) { float pv = __builtin_amdgcn_exp2f(sc[kt2][x] - m); sc[kt2][x] = pv; ps += pv; }
    lsum += ps;
    const u16* sV = (const u16*)(lds + st * STG + 17408);
#pragma unroll
    for (int kt2 = 0; kt2 < 2; ++kt2)
#pragma unroll
      for (int s2 = 0; s2 < 2; ++s2) {
        union { unsigned u[4]; bf16x8 v; } pf;
#pragma unroll
        for (int j = 0; j < 4; ++j) pf.u[j] = pack2(sc[kt2][8 * s2 + 2 * j], sc[kt2][8 * s2 + 2 * j + 1]);
        const u16* vb = sV + r * 68 + kt2 * 32 + 16 * s2 + 4 * hh;
#pragma unroll
        for (int dt = 0; dt < 4; ++dt) {
          s16x4 lo = *(const s16x4*)(vb + dt * 32 * 68);
          s16x4 hi = *(const s16x4*)(vb + dt * 32 * 68 + 8);
          bf16x8 va = __builtin_shufflevector(lo, hi, 0, 1, 2, 3, 4, 5, 6, 7);
          O[dt] = MFMA32(va, pf.v, O[dt]);
        }
      }
    if (ti + 2 < ntiles) attn_store_tile((u16*)(lds + st2 * STG), (u16*)(lds + st2 * STG + 17408), rk, rv);
    __syncthreads();
  };

  attn_load_tile(a, 0, rk, rv);
  __syncthreads();
  attn_store_tile((u16*)lds, (u16*)(lds + 17408), rk, rv);
  attn_load_tile(a, 1, rk, rv);
  attn_store_tile((u16*)(lds + STG), (u16*)(lds + STG + 17408), rk, rv);
  __syncthreads();
  f32x16 sA[2], sB[2];
  QK(0, sA);
  int st = 0;
  for (int ti = 0; ti < ntiles; ti += 2) {
    STEP(ti, st, sA, sB);
    st = (st == 2) ? 0 : st + 1;
    if (ti + 1 < ntiles) {
      STEP(ti + 1, st, sB, sA);
      st = (st == 2) ? 0 : st + 1;
    }
  }
  float ltot = lsum + __shfl_xor(lsum, 32);
  const float inv = 1.f / ltot;
  u16* zp = a.z + (size_t)(w * 32 + r) * 3072;
  u32x2 gv[4][4];
#pragma unroll
  for (int dt = 0; dt < 4; ++dt)
#pragma unroll
    for (int g4 = 0; g4 < 4; ++g4) gv[dt][g4] = *(const u32x2*)(zp + dt * 32 + 8 * g4 + 4 * hh);
#pragma unroll
  for (int dt = 0; dt < 4; ++dt)
#pragma unroll
    for (int g4 = 0; g4 < 4; ++g4) {
      int d0 = dt * 32 + 8 * g4 + 4 * hh;
      float y0 = O[dt][4 * g4 + 0] * inv * bflo(gv[dt][g4].x);
      float y1 = O[dt][4 * g4 + 1] * inv * bfhi(gv[dt][g4].x);
      float y2 = O[dt][4 * g4 + 2] * inv * bflo(gv[dt][g4].y);
      float y3 = O[dt][4 * g4 + 3] * inv * bfhi(gv[dt][g4].y);
      uint2 o; o.x = pack2(y0, y1); o.y = pack2(y2, y3);
      if (!a.dry || y0 != y0) *(uint2*)(zp + d0) = o;
    }
}

template <bool REV>
DI void lru_scan(float (&av)[2][16], float (&bv)[2][16], float& carry, int hh) {
  float segA[8], segB[8];
#pragma unroll
  for (int k = 0; k < 8; ++k) {
    const int mt = k >> 2, q = k & 3;
    float cA = 1.f, hl = 0.f;
#pragma unroll
    for (int jj = 0; jj < 4; ++jj) {
      const int j = REV ? 3 - jj : jj;
      const int i = 4 * q + j;
      hl = av[mt][i] * hl + bv[mt][i];
      cA *= av[mt][i];
      av[mt][i] = cA; bv[mt][i] = hl;
    }
    segA[k] = cA; segB[k] = hl;
  }
  float oA[8], oB[8];
#pragma unroll
  for (int k = 0; k < 8; ++k) { oA[k] = __shfl_xor(segA[k], 32); oB[k] = __shfl_xor(segB[k], 32); }
  float init[8];
  float st = carry;
#pragma unroll
  for (int kk = 0; kk < 8; ++kk) {
    const int k = REV ? 7 - kk : kk;
    const int first = REV ? 1 : 0;
    float A1 = (hh == first) ? segA[k] : oA[k];
    float B1 = (hh == first) ? segB[k] : oB[k];
    float st0 = st;
    st = A1 * st + B1;
    float A2 = (hh == first) ? oA[k] : segA[k];
    float B2 = (hh == first) ? oB[k] : segB[k];
    float st1 = st;
    st = A2 * st + B2;
    init[k] = (hh == first) ? st0 : st1;
  }
  carry = st;
#pragma unroll
  for (int k = 0; k < 8; ++k) {
    const int mt = k >> 2, q = k & 3;
#pragma unroll
    for (int j = 0; j < 4; ++j) {
      const int i = 4 * q + j;
      bv[mt][i] = bv[mt][i] + av[mt][i] * init[k];
    }
  }
}

DI void lru_item(CParams& p, int l, int b, int n, bool last, char* lds, int dry = 0) {
  const int NB = p.NB, RL = NB * S;
  const int tid = otid(), lane = tid & 63, w8 = tid >> 6;
  const int sub = __builtin_amdgcn_readfirstlane(w8 >> 2), w = w8 & 3;
  n = n + sub;
  lds += sub * 73728;
  const int dir = w >> 1, w2 = w & 1;
  const int tl = tid & 127;
  const int r = lane & 31, hh = lane >> 5;
  u16* sRaw = (u16*)lds + dir * (8704 / 2);
  u16* sUp = (u16*)(lds + 17408) + dir * (9216 / 2);
  float* sH = (float*)(lds + 35840) + w * (64 * 36);

  const int chb = n * 64;
  const int cp = (tl & 31) * 2, tg = tl >> 5;
  float cw0[4], cw1[4], cb0, cb1;
#pragma unroll
  for (int k = 0; k < 4; ++k) {
    cw0[k] = p.conv_w[((size_t)l * 4 + k) * D + chb + cp];
    cw1[k] = p.conv_w[((size_t)l * 4 + k) * D + chb + cp + 1];
  }
  cb0 = p.conv_b[l * D + chb + cp]; cb1 = p.conv_b[l * D + chb + cp + 1];
  bf16x8 waf[4], wxf[4];
  {
    const float* wa = p.lru_wa + (((size_t)(l * 2 + dir) * 16 + n) * 64) * 64;
    const float* wx = p.lru_wx + (((size_t)(l * 2 + dir) * 16 + n) * 64) * 64;
    const int e = 32 * w2 + r;
#pragma unroll
    for (int ks = 0; ks < 4; ++ks) {
      union { unsigned u[4]; bf16x8 v; } fa, fx;
#pragma unroll
      for (int j = 0; j < 4; ++j) {
        int d0 = ks * 16 + 8 * hh + 2 * j;
        fa.u[j] = pack2(wa[d0 * 64 + e], wa[(d0 + 1) * 64 + e]);
        fx.u[j] = pack2(wx[d0 * 64 + e], wx[(d0 + 1) * 64 + e]);
      }
      waf[ks] = fa.v; wxf[ks] = fx.v;
    }
  }
  const int che = chb + 32 * w2 + r;
  const float ba = p.lru_ba[(l * 2 + dir) * D + che];
  const float bx = p.lru_bx[(l * 2 + dir) * D + che];
  float c8sp;
  {
    float lam = p.lru_lambda[(l * 2 + dir) * D + che];
    float sp = (lam < -20.f) ? -lam : log1pf(expf(-lam));
    c8sp = 8.f * sp;
  }
  float carry = 0.f;

  auto step_tile = [&](int st, bool& isctx, int& tt) {
    if (dir == 0) { if (st < 4) { isctx = true; tt = st; } else { isctx = false; tt = st - 4; } }
    else { if (st < 4) { isctx = true; tt = 3 - st; } else { isctx = false; tt = 63 - (st - 4); } }
  };
  u32x4 pre[5];
  auto load_raw = [&](int st) {
    bool isctx; int tt; step_tile(st, isctx, tt);
    const int seqlen = isctx ? L : S;
    const size_t rowbase = isctx ? (size_t)RL + (size_t)b * L : (size_t)b * S;
    const int t0 = tt * 64;
#pragma unroll
    for (int i = 0; i < 5; ++i) {
      int c = tl + 128 * i;
      int rr = c >> 3, c16 = c & 7;
      int t = t0 - 2 + rr;
      u32x4 v = {0u, 0u, 0u, 0u};
      if (rr < 67 && t >= 0 && t < seqlen) v = *(const u32x4*)(p.U + (rowbase + t) * D + chb + c16 * 8);
      pre[i] = v;
    }
  };
  load_raw(0);
  __syncthreads();
  for (int st = 0; st < 68; ++st) {
    bool isctx; int tt; step_tile(st, isctx, tt);
    const size_t rowbase = isctx ? (size_t)RL + (size_t)b * L : (size_t)b * S;
    const int t0 = tt * 64;
#pragma unroll
    for (int i = 0; i < 5; ++i) {
      int c = tl + 128 * i;
      int rr = c >> 3, c16 = c & 7;
      if (rr < 67) *(u32x4*)(sRaw + rr * 64 + c16 * 8) = pre[i];
    }
    if (st + 1 < 68) load_raw(st + 1);
    __syncthreads();
    {
      const u16* rp = sRaw + (tg * 16) * 64 + cp;
      unsigned r0 = *(const unsigned*)(rp), r1 = *(const unsigned*)(rp + 64), r2 = *(const unsigned*)(rp + 128);
#pragma unroll
      for (int i = 0; i < 16; ++i) {
        unsigned r3 = *(const unsigned*)(rp + (i + 3) * 64);
        float o0 = cb0 + cw0[0] * bflo(r0) + cw0[1] * bflo(r1) + cw0[2] * bflo(r2) + cw0[3] * bflo(r3);
        float o1 = cb1 + cw1[0] * bfhi(r0) + cw1[1] * bfhi(r1) + cw1[2] * bfhi(r2) + cw1[3] * bfhi(r3);
        *(unsigned*)(sUp + (tg * 16 + i) * 72 + cp) = pack2(o0, o1);
        r0 = r1; r1 = r2; r2 = r3;
      }
    }
    __syncthreads();
    const bool fwd_first = isctx ? (tt <= 1) : (tt <= 31);
    const bool first = (dir == 0) ? fwd_first : !fwd_first;
    unsigned long long pt0[4], pt1[4];
    u32x4 pg[4];
    if (!first && !(isctx && last)) {
#pragma unroll
      for (int j = 0; j < 4; ++j) {
        const int q = lane + 64 * j;
        const int tok = q >> 2, cc = (q & 3) * 8;
        const size_t row = rowbase + t0 + tok;
        const int col = chb + 32 * w2 + cc;
        const u16* tp = p.Hb + row * D + col;
        pt0[j] = __hip_atomic_load((const unsigned long long*)tp, __ATOMIC_RELAXED, __HIP_MEMORY_SCOPE_AGENT);
        pt1[j] = __hip_atomic_load((const unsigned long long*)tp + 1, __ATOMIC_RELAXED, __HIP_MEMORY_SCOPE_AGENT);
        pg[j] = *(const u32x4*)(p.Z + row * 3072 + col);
      }
    } else {
#pragma unroll
      for (int j = 0; j < 4; ++j) { pt0[j] = 0; pt1[j] = 0; pg[j] = u32x4{0u, 0u, 0u, 0u}; }
    }
    float av[2][16], bv[2][16];
    {
      f32x16 aR[2];
#pragma unroll
      for (int mt = 0; mt < 2; ++mt) {
#pragma unroll
        for (int x = 0; x < 16; ++x) aR[mt][x] = 0.f;
        const u16* ub = sUp + (mt * 32 + r) * 72 + hh * 8;
#pragma unroll
        for (int ks = 0; ks < 4; ++ks) aR[mt] = MFMA32(*(const bf16x8*)(ub + ks * 16), waf[ks], aR[mt]);
      }
#pragma unroll
      for (int mt = 0; mt < 2; ++mt)
#pragma unroll
        for (int x = 0; x < 16; ++x) {
          const float rg = sigmoidf_(aR[mt][x] + ba);
          av[mt][x] = -c8sp * rg;
        }
    }
    {
      f32x16 aI[2];
#pragma unroll
      for (int mt = 0; mt < 2; ++mt) {
#pragma unroll
        for (int x = 0; x < 16; ++x) aI[mt][x] = 0.f;
        const u16* ub = sUp + (mt * 32 + r) * 72 + hh * 8;
#pragma unroll
        for (int ks = 0; ks < 4; ++ks) aI[mt] = MFMA32(*(const bf16x8*)(ub + ks * 16), wxf[ks], aI[mt]);
      }
#pragma unroll
      for (int mt = 0; mt < 2; ++mt)
#pragma unroll
        for (int x = 0; x < 16; ++x) {
          const int tok = mt * 32 + crow(x, hh);
          const float up = bf2f(sUp[tok * 72 + 32 * w2 + r]);
          const float ig = sigmoidf_(aI[mt][x] + bx);
          const float la = av[mt][x];
          const float a_ = __expf(la);
          const float om = fmaxf(1.f - a_ * a_, 0.f);
          av[mt][x] = a_;
          bv[mt][x] = __builtin_amdgcn_sqrtf(om) * (ig * up);
        }
    }
    if (dir == 0) lru_scan<false>(av, bv, carry, hh); else lru_scan<true>(av, bv, carry, hh);
#pragma unroll
    for (int mt = 0; mt < 2; ++mt)
#pragma unroll
      for (int x = 0; x < 16; ++x) sH[(mt * 32 + crow(x, hh)) * 36 + r] = bv[mt][x];
    if (!(isctx && last)) {
#pragma unroll
      for (int j = 0; j < 4; ++j) {
        const int q = lane + 64 * j;
        const int tok = q >> 2, cc = (q & 3) * 8;
        const float4 h0 = *(const float4*)(sH + tok * 36 + cc);
        const float4 h1 = *(const float4*)(sH + tok * 36 + cc + 4);
        const size_t row = rowbase + t0 + tok;
        const int col = chb + 32 * w2 + cc;
        u16* tp = p.Hb + row * D + col;
        if (first) {
          uint4 o; o.x = pack2(h0.x, h0.y); o.y = pack2(h0.z, h0.w); o.z = pack2(h1.x, h1.y); o.w = pack2(h1.z, h1.w);
          if (!dry || h0.x != h0.x) *(uint4*)tp = o;
        } else {
          unsigned tx = (unsigned)pt0[j], ty = (unsigned)(pt0[j] >> 32), tz = (unsigned)pt1[j], tw = (unsigned)(pt1[j] >> 32);
          u16* zp = p.Z + row * 3072 + col;
          u32x4 g = pg[j];
          uint4 o;
          o.x = pack2((h0.x + bflo(tx)) * bflo(g.x), (h0.y + bfhi(tx)) * bfhi(g.x));
          o.y = pack2((h0.z + bflo(ty)) * bflo(g.y), (h0.w + bfhi(ty)) * bfhi(g.y));
          o.z = pack2((h1.x + bflo(tz)) * bflo(g.z), (h1.y + bfhi(tz)) * bfhi(g.z));
          o.w = pack2((h1.z + bflo(tw)) * bflo(g.w), (h1.w + bfhi(tw)) * bfhi(g.w));
          if (!dry || h0.x != h0.x) *(uint4*)zp = o;
        }
      }
    }
    __builtin_amdgcn_fence(__ATOMIC_RELEASE, "workgroup");
  }
}

DI void phase_mixers(CParams& p, int chunk, int l, char* lds, int dry = 0) {
  const int NB = p.NB, RL = NB * S;
  const bool last = (l == DEPTH - 1);
  const int nLRU = (dry == 1) ? 0 : NB * 8, nC = (dry == 2) ? 0 : NB * 8 * 16, nBw = (dry == 2) ? 0 : NB * 8 * 16, nCtx = (last || dry == 2) ? 0 : NB * 8 * 2;
  const int total = nLRU + nC + nBw + nCtx;
  int* ctr = p.ctr + chunk * DEPTH + l + (dry ? 32 : 0);
  int* s_item = (int*)(lds + LDS_BYTES - 16);
  int it;
  while (true) {
    __syncthreads();
    if (threadIdx.x == 0) *s_item = atomicAdd(ctr, 1);
    __syncthreads();
    it = __builtin_amdgcn_readfirstlane(*s_item);
    __syncthreads();
    if (it >= nLRU) break;
    lru_item(p, l, it >> 3, (it & 7) * 2, last, lds, dry);
  }
  bool have = true;
  while (true) {
    if (!have) {
      __syncthreads();
      if (threadIdx.x == 0) *s_item = atomicAdd(ctr, 1);
      __syncthreads();
      it = __builtin_amdgcn_readfirstlane(*s_item);
      __syncthreads();
    }
    have = false;
    if (it >= total) break;
    it -= nLRU;
    AttnArgs a;
    a.dry = dry;
    float gqm = 0.f, gkm = 0.f;
    {
      const int ln = otid() & 63;
      gqm = fmaxf(fabsf(p.q_norm_g[l * 128 + ln]), fabsf(p.q_norm_g[l * 128 + 64 + ln]));
      gkm = fmaxf(fabsf(p.k_norm_g[l * 128 + ln]), fabsf(p.k_norm_g[l * 128 + 64 + ln]));
#pragma unroll
      for (int o = 32; o >= 1; o >>= 1) { gqm = fmaxf(gqm, __shfl_xor(gqm, o)); gkm = fmaxf(gkm, __shfl_xor(gkm, o)); }
      gqm = __builtin_amdgcn_readfirstlane(gqm); gkm = __builtin_amdgcn_readfirstlane(gkm);
    }
    const float mfixC = 128.f * gqm * gkm * QSCALE;
    if (it < nC + nBw) {
      const bool isB = it >= nC;
      if (isB) it -= nC;
      const int b = it >> 7, h = (it >> 4) & 7, qb = it & 15;
      const int kvh = h >> 2;
      const int br = isB ? 0 : 1;
      const size_t qrow0 = (size_t)b * S + qb * 256;
      a.q = p.Q + qrow0 * 2048 + br * 1024 + h * 128;
      a.z = p.Z + qrow0 * 3072 + (br + 1) * 1024 + h * 128;
      const int kcol = br * 256 + kvh * 128, slot = br * 2 + kvh;
      a.kctx = p.Kb + ((size_t)RL + (size_t)b * L) * 512 + kcol;
      a.vctx = p.VtC + (size_t)(b * 4 + slot) * 128 * L;
      int k0, k1;
      if (isB) { k0 = qb * 256 - 128; if (k0 < 0) k0 = 0; k1 = qb * 256 + 384; if (k1 > S) k1 = S; }
      else { k0 = 0; k1 = S; }
      a.lat_key0 = k0;
      a.n_lat_tiles = (k1 - k0) >> 6;
      a.klat = p.Kb + ((size_t)b * S + k0) * 512 + kcol;
      a.vlat = p.VtL + (size_t)(b * 4 + slot) * 128 * S + k0;
      a.q_t0 = qb * 256;
      a.band = isB ? 1 : 0;
      a.has_sink = isB ? 1 : 0;
      a.sink_l2 = isB ? p.attn_sink[l * 8 + h] * LOG2E : 0.f;
      a.fixedm = isB ? 0 : 1; a.mfix = mfixC;
    } else {
      it -= nC + nBw;
      const int h = it & 7, br = (it >> 3) & 1, b = it >> 4;
      const int kvh = h >> 2;
      const size_t qrow0 = (size_t)RL + (size_t)b * L;
      a.q = p.Q + qrow0 * 2048 + br * 1024 + h * 128;
      a.z = p.Z + qrow0 * 3072 + (br + 1) * 1024 + h * 128;
      const int kcol = br * 256 + kvh * 128, slot = br * 2 + kvh;
      a.kctx = p.Kb + ((size_t)RL + (size_t)b * L) * 512 + kcol;
      a.vctx = p.VtC + (size_t)(b * 4 + slot) * 128 * L;
      a.klat = a.kctx; a.vlat = a.vctx;
      a.n_lat_tiles = 0; a.lat_key0 = 0; a.q_t0 = 0; a.band = 0;
      a.has_sink = (br == 0) ? 1 : 0;
      a.sink_l2 = (br == 0) ? p.attn_sink[l * 8 + h] * LOG2E : 0.f;
      a.fixedm = (br == 0) ? 0 : 1; a.mfix = mfixC;
    }
    attn_item(a, lds);
  }
}

DI void phase_merge(CParams& p, int chunk, int l, char* lds) {
  const int NB = p.NB, RL = NB * S, R = NB * (S + L);
  const bool last = (l == DEPTH - 1);
  const int MT = (last ? RL : R) / 256, NT = 8;
  const int tid = otid();
  const int lane = tid & 63, w = tid >> 6, wm = w >> 1, wn = w & 1, r = lane & 31, hh = lane >> 5;
  for (int ti = 0;; ++ti) {
    int mt, nt;
    if (!tile_map(ti, MT, NT, mt, nt)) break;
    const int m0 = mt * 256, n0 = nt * 128;
    f32x16 tot[2][2];
#pragma unroll
    for (int i = 0; i < 2; ++i)
#pragma unroll
      for (int j = 0; j < 2; ++j)
#pragma unroll
        for (int x = 0; x < 16; ++x) tot[i][j][x] = 0.f;
#pragma unroll 1
    for (int n = 0; n < 3; ++n) {
      f32x16 acc[2][2];
      gemm_core<128, false>(p.Z + (size_t)m0 * 3072 + n * 1024, 3072, 64, (size_t)128 * 3072,
                            p.WbT + ((size_t)(l * 3 + n) * D + n0) * D, 64, 8192, 0, D, lds, acc);
#pragma unroll
      for (int i = 0; i < 2; ++i)
#pragma unroll
        for (int j = 0; j < 2; ++j)
#pragma unroll
          for (int g = 0; g < 4; ++g) {
            const size_t row = (size_t)m0 + wm * 64 + i * 32 + r;
            const int col = n0 + wn * 64 + j * 32 + 8 * g + 4 * hh;
            uint2 sv = *(const uint2*)(p.Ms + row * 3072 + n * 1024 + col);
            tot[i][j][4 * g + 0] += bflo(sv.x) * acc[i][j][4 * g + 0];
            tot[i][j][4 * g + 1] += bfhi(sv.x) * acc[i][j][4 * g + 1];
            tot[i][j][4 * g + 2] += bflo(sv.y) * acc[i][j][4 * g + 2];
            tot[i][j][4 * g + 3] += bfhi(sv.y) * acc[i][j][4 * g + 3];
          }
    }
#pragma unroll
    for (int i = 0; i < 2; ++i)
#pragma unroll
      for (int j = 0; j < 2; ++j)
#pragma unroll
        for (int g = 0; g < 4; ++g) {
          const size_t row = (size_t)m0 + wm * 64 + i * 32 + r;
          const int col = n0 + wn * 64 + j * 32 + 8 * g + 4 * hh;
          uint2 o; o.x = pack2(tot[i][j][4 * g], tot[i][j][4 * g + 1]); o.y = pack2(tot[i][j][4 * g + 2], tot[i][j][4 * g + 3]);
          *(uint2*)(p.Hb + row * D + col) = o;
        }
  }
}

struct EpiOut {
  static constexpr bool PERM = false, AFTER_DRAIN = false;
  CParams* kp; int chunk, l;
  __device__ __forceinline__ void operator()(const pg8::f32x4 (&acc)[2][2][4][2], const pg8::Unit& u, int wr, int wc, int fr, int fq) const {
    const int NB = kp->NB, RL = NB * S;
    const int gr0 = u.pm * 256;
    const float* src; float* dst; int mrow;
    if (gr0 < RL) {
      const int b = gr0 / S, t = gr0 % S, bg = chunk * NB + b;
      const size_t off = ((size_t)bg * S + t) * D;
      src = (l == 0 ? kp->x : kp->out) + off; dst = kp->out + off; mrow = bg;
    } else {
      const int rc = gr0 - RL, b = rc / L, t = rc % L, bg = chunk * NB + b;
      const size_t off = ((size_t)bg * L + t) * D;
      src = (l == 0 ? kp->ctx : kp->xc) + off; dst = kp->xc + off; mrow = 16;
    }
    const int col0 = u.pn * 256 + wc * 32 + 4 * fq;
    const float* gate = kp->modv + ((size_t)l * 17 + mrow) * 3072 + 2048 + col0;
    pg8::f32x4 gv[2][2];
#pragma unroll
    for (int bj = 0; bj < 2; ++bj)
#pragma unroll
      for (int n = 0; n < 2; ++n) gv[bj][n] = *(const pg8::f32x4*)(gate + bj * 128 + n * 16);
    const int row0 = wr * 64 + fr;
#pragma unroll
    for (int ai = 0; ai < 2; ++ai)
#pragma unroll
      for (int m = 0; m < 4; ++m) {
        const size_t ro = (size_t)(row0 + ai * 128 + m * 16) * D + col0;
        pg8::f32x4 xv[2][2];
#pragma unroll
        for (int bj = 0; bj < 2; ++bj)
#pragma unroll
          for (int n = 0; n < 2; ++n) xv[bj][n] = *(const pg8::f32x4*)(src + ro + bj * 128 + n * 16);
#pragma unroll
        for (int bj = 0; bj < 2; ++bj)
#pragma unroll
          for (int n = 0; n < 2; ++n) {
            pg8::f32x4 o = xv[bj][n] + gv[bj][n] * acc[ai][bj][m][n];
            *(pg8::f32x4*)(dst + ro + bj * 128 + n * 16) = o;
          }
      }
  }
};

DI void phase_outproj(CParams& p, int chunk, int l, char* lds) {
  const int NB = p.NB, RL = NB * S, R = NB * (S + L);
  const bool last = (l == DEPTH - 1);
  const int rows = last ? RL : R;
  pg8::Gemm g{p.Hb, p.WoT + (size_t)l * D * D, rows, D, D};
  pg8::StaticOrder So; So.init(rows, D, (int)gridDim.x, (int)blockIdx.x);
  EpiOut E{&p, chunk, l};
  pg8::gemm_phase<EpiOut, pg8::StaticOrder, false>((PG8_LAS unsigned char*)lds, g, So, E, nullptr);
}

DI void phase_final(CParams& p) {
  const int tid_ = otid();
  const int lane = tid_ & 63;
  const int wg = blockIdx.x * 8 + (tid_ >> 6), nw = gridDim.x * 8;
  for (int r = wg; r < NBATCH * S; r += nw) {
    float* src = p.out + (size_t)r * D;
    float4 v[4]; float ss = 0.f;
#pragma unroll
    for (int i = 0; i < 4; ++i) {
      v[i] = *(const float4*)(src + i * 256 + lane * 4);
      ss += v[i].x * v[i].x + v[i].y * v[i].y + v[i].z * v[i].z + v[i].w * v[i].w;
    }
#pragma unroll
    for (int o = 32; o >= 1; o >>= 1) ss += __shfl_xor(ss, o);
    float rstd = rsqrtf(ss * (1.f / D) + EPS);
#pragma unroll
    for (int i = 0; i < 4; ++i) {
      int cidx = i * 256 + lane * 4;
      float4 gg = *(const float4*)(p.final_g + cidx);
      float4 o;
      o.x = v[i].x * rstd * gg.x; o.y = v[i].y * rstd * gg.y; o.z = v[i].z * rstd * gg.z; o.w = v[i].w * rstd * gg.w;
      *(float4*)(src + cidx) = o;
    }
  }
}

#ifndef DUP_PHASE
#define DUP_PHASE 0
#endif
__global__ void __launch_bounds__(NTHR, 2) fwd_megakernel(Params p_unused) {
  CParams* kp = (CParams*)__builtin_amdgcn_kernarg_segment_ptr();
  cg::grid_group grid = cg::this_grid();
  __shared__ __attribute__((aligned(16))) char lds[LDS_BYTES];
  phase0(*opaque_kp(kp), lds);
  grid.sync();
  phase_mod(*opaque_kp(kp), lds);
  grid.sync();
  for (int chunk = 0; chunk < kp->nchunk; ++chunk) {
    for (int l = 0; l < DEPTH; ++l) {
      phase_prenorm(*opaque_kp(kp), chunk, l);
      grid.sync();
#if DUP_PHASE == 9
      grid.sync(); grid.sync(); grid.sync(); grid.sync(); grid.sync();
#endif
      phase_gemm_in(*opaque_kp(kp), chunk, l, lds);
      grid.sync();
#if DUP_PHASE == 3
      phase_gemm_in(*opaque_kp(kp), chunk, l, lds);
      grid.sync();
#endif
#if DUP_PHASE == 4
      phase_mixers(*opaque_kp(kp), chunk, l, lds, 1);
      grid.sync();
#endif
#if DUP_PHASE == 6
      phase_mixers(*opaque_kp(kp), chunk, l, lds, 2);
      grid.sync();
#endif
      phase_mixers(*opaque_kp(kp), chunk, l, lds);
      grid.sync();
      phase_merge(*opaque_kp(kp), chunk, l, lds);
      grid.sync();
#if DUP_PHASE == 5
      phase_merge(*opaque_kp(kp), chunk, l, lds);
      grid.sync();
#endif
      phase_outproj(*opaque_kp(kp), chunk, l, lds);
      grid.sync();
    }
  }
  phase_final(*opaque_kp(kp));
}

extern "C" void kernel_launch(void* const* d_in, const int* in_sizes, int n_in,
                              void* d_out, int out_size, void* d_ws, size_t ws_size,
                              hipStream_t stream) {
  static int grid_blocks = 0;
  if (!grid_blocks) {
    int dev = 0, cus = 0, per_cu = 0;
    (void)hipGetDevice(&dev);
    (void)hipDeviceGetAttribute(&cus, hipDeviceAttributeMultiprocessorCount, dev);
    (void)hipOccupancyMaxActiveBlocksPerMultiprocessor(&per_cu, fwd_megakernel, NTHR, 0);
    if (per_cu > 1) per_cu = 1;
    if (per_cu < 1) per_cu = 1;
    grid_blocks = cus * per_cu;
  }
  Params p{};
  const float* const* in = (const float* const*)d_in;
  p.x = in[0]; p.c = in[1]; p.ctx = in[2]; p.c_ctx = in[3]; p.norm_g = in[4]; p.w_mod = in[5]; p.b_mod = in[6];
  p.w_in = in[7]; p.conv_w = in[8]; p.conv_b = in[9]; p.lru_wa = in[10]; p.lru_ba = in[11]; p.lru_wx = in[12];
  p.lru_bx = in[13]; p.lru_lambda = in[14]; p.attn_sink = in[15]; p.q_norm_g = in[16]; p.k_norm_g = in[17];
  p.w_branch = in[18]; p.w_out = in[19]; p.final_g = in[20];
  p.out = (float*)d_out;
  char* ws = (char*)d_ws;
  size_t off = 0;
  auto take = [&](size_t bytes) { char* r = ws + off; off += (bytes + 255) & ~(size_t)255; return r; };
  p.ctr = (int*)take(256);
  p.modv = (float*)take((size_t)DEPTH * 17 * 3072 * 4);
  p.sc = (float*)take((size_t)17 * D * 4);
  p.rope = (float*)take(4096 * 4);
  p.xc = (float*)take((size_t)NBATCH * L * D * 4);
  p.WinT = (u16*)take((size_t)DEPTH * INW * D * 2);
  p.WbT = (u16*)take((size_t)DEPTH * 3 * D * D * 2);
  p.WoT = (u16*)take((size_t)DEPTH * D * D * 2);
  const size_t fixed = off;
  int NB = 8;
  while (NB > 1) {
    size_t R = (size_t)NB * (S + L);
    size_t need = fixed + R * (size_t)(1024 + 1024 + 3072 + 2048 + 512 + 512 + 3072) * 2 + 8 * 256;
    if (need <= ws_size) break;
    NB >>= 1;
  }
  p.NB = NB; p.nchunk = NBATCH / NB;
  const size_t R = (size_t)NB * (S + L);
  p.Hb = (u16*)take(R * 1024 * 2);
  p.U = (u16*)take(R * 1024 * 2);
  p.Z = (u16*)take(R * 3072 * 2);
  p.Q = (u16*)take(R * 2048 * 2);
  p.Kb = (u16*)take(R * 512 * 2);
  p.VtL = (u16*)take((size_t)NB * 4 * 128 * S * 2);
  p.VtC = (u16*)take((size_t)NB * 4 * 128 * L * 2);
  p.Ms = (u16*)take(R * 3072 * 2);
  void* args[] = {&p};
  hipError_t e = hipLaunchCooperativeKernel((void*)fwd_megakernel, dim3(grid_blocks), dim3(NTHR), args, 0, stream);
  if (e != hipSuccess) fprintf(stderr, "cooperative launch failed: %s (grid %d)\n", hipGetErrorString(e), grid_blocks);
}
```

```cpp
#include <hip/hip_runtime.h>
#include <hip/hip_cooperative_groups.h>
#include <cstdio>
#include <cstdint>
namespace cg = cooperative_groups;

typedef unsigned short u16;
typedef __attribute__((ext_vector_type(8))) short bf16x8;
typedef __attribute__((ext_vector_type(4))) short s16x4;
typedef __attribute__((ext_vector_type(16))) float f32x16;
typedef __bf16 bf16x2_t __attribute__((ext_vector_type(2)));
typedef float float2_t __attribute__((ext_vector_type(2)));
typedef __attribute__((ext_vector_type(4))) unsigned u32x4;
typedef __attribute__((ext_vector_type(2))) unsigned u32x2;

#define DI __device__ __forceinline__
#define MFMA32(a, b, c) __builtin_amdgcn_mfma_f32_32x32x16_bf16((a), (b), (c), 0, 0, 0)

constexpr int D = 1024, NBATCH = 16, S = 4096, L = 256, DEPTH = 4, INW = 10240;
constexpr int LDS_BYTES = 147456;
constexpr int NTHR = 512;
constexpr float EPS = 1e-6f;
constexpr float QSCALE = 0.08838834764831845f * 1.4426950408889634f;
constexpr float LOG2E = 1.4426950408889634f;

struct Params {
  const float *x, *c, *ctx, *c_ctx, *norm_g, *w_mod, *b_mod, *w_in, *conv_w, *conv_b, *lru_wa, *lru_ba, *lru_wx, *lru_bx,
      *lru_lambda, *attn_sink, *q_norm_g, *k_norm_g, *w_branch, *w_out, *final_g;
  float* out;
  u16 *WinT, *WbT, *WoT;
  u16 *Hb, *U, *Z, *Q, *Kb, *VtL, *VtC, *Ms;
  float *modv, *sc, *rope, *xc;
  int* ctr;
  int NB;
  int nchunk;
};

typedef const __attribute__((address_space(4))) Params CParams;
DI CParams* opaque_kp(CParams* q) { asm volatile("" : "+s"(q)); return q; }

DI unsigned pack2(float a, float b) {
  float2_t f = {a, b};
  bf16x2_t v = __builtin_convertvector(f, bf16x2_t);
  return __builtin_bit_cast(unsigned, v);
}
DI float bf2f(u16 v) { return __uint_as_float(((unsigned)v) << 16); }
DI float bflo(unsigned v) { return __uint_as_float(v << 16); }
DI float bfhi(unsigned v) { return __uint_as_float(v & 0xffff0000u); }
DI float sigmoidf_(float x) { return __builtin_amdgcn_rcpf(1.f + __expf(-x)); }
DI float siluf_(float x) { return x * __builtin_amdgcn_rcpf(1.f + __expf(-x)); }
DI int otid() { int t = threadIdx.x; asm volatile("" : "+v"(t)); return t; }
DI int crow(int i, int hh) { return (i & 3) + 8 * (i >> 2) + 4 * hh; }

DI void phase0(CParams& p, char* lds) {
  const int tid = otid();
  float* tile = (float*)lds;
  const int n_in = DEPTH * 16 * 160, n_b = DEPTH * 3 * 256, n_o = DEPTH * 256;
  for (int it = blockIdx.x; it < n_in + n_b + n_o; it += gridDim.x) {
    const float* src; u16* dst; int ldsrc; int dstride = 64;
    if (it < n_in) {
      int l = it / 2560, rem = it % 2560, kt = rem / 160, nt = rem % 160;
      src = p.w_in + (size_t)l * D * INW + (size_t)(kt * 64) * INW + nt * 64; ldsrc = INW;
      const int o = nt >> 2;
      const int n256 = (o < 8) ? o : (o >= 28) ? 16 + (o - 28) : (o >= 24) ? 12 + (o - 24) : (o == 23) ? 39 : (o == 22) ? 38
                     : (o >= 18) ? 34 + (o - 18) : (o >= 14) ? 8 + (o - 14) : (o == 13) ? 33 : (o == 12) ? 32 : 28 + (o - 8);
      dst = p.WinT + (size_t)l * INW * D + ((size_t)n256 * 256 + (nt & 3) * 64) * D + kt * 64; dstride = D;
    } else if (it < n_in + n_b) {
      int i2 = it - n_in; int mat = i2 / 256, rem = i2 % 256, kt = rem / 16, nt = rem % 16;
      src = p.w_branch + (size_t)mat * D * D + (size_t)(kt * 64) * D + nt * 64; ldsrc = D;
      dst = p.WbT + (size_t)mat * D * D + (size_t)(nt * 64) * D + kt * 64; dstride = D;
    } else {
      int i2 = it - n_in - n_b; int mat = i2 / 256, rem = i2 % 256, kt = rem / 16, nt = rem % 16;
      src = p.w_out + (size_t)mat * D * D + (size_t)(kt * 64) * D + nt * 64; ldsrc = D;
      dst = p.WoT + (size_t)mat * D * D + (size_t)(nt * 64) * D + kt * 64; dstride = D;
    }
    __syncthreads();
#pragma unroll
    for (int i = 0; i < 2; ++i) {
      int c = tid + NTHR * i; int row = c >> 4, c4 = c & 15;
      float4 v = *(const float4*)(src + (size_t)row * ldsrc + c4 * 4);
      float* t = tile + row * 65 + c4 * 4;
      t[0] = v.x; t[1] = v.y; t[2] = v.z; t[3] = v.w;
    }
    __syncthreads();
    {
      int c = tid; int nrow = c >> 3, k8 = c & 7;
      float v[8];
#pragma unroll
      for (int j = 0; j < 8; ++j) v[j] = tile[(k8 * 8 + j) * 65 + nrow];
      uint4 o; o.x = pack2(v[0], v[1]); o.y = pack2(v[2], v[3]); o.z = pack2(v[4], v[5]); o.w = pack2(v[6], v[7]);
      *(uint4*)(dst + (size_t)nrow * dstride + k8 * 8) = o;
    }
  }
  const int gt = blockIdx.x * NTHR + tid, gn = gridDim.x * NTHR;
  for (int i = gt; i < 17 * D; i += gn) {
    int r = i / D, k = i % D;
    float v = (r < 16) ? p.c[r * D + k] : p.c_ctx[k];
    p.sc[i] = siluf_(v);
  }
  for (int i = gt; i < 64 * 32; i += gn) {
    int pos = i >> 5, pp = i & 31;
    float inv = powf(10000.f, -(float)pp / 32.f);
    float ang = (float)pos * inv;
    p.rope[i] = cosf(ang);
    p.rope[2048 + i] = sinf(ang);
  }
  if (blockIdx.x == 0 && tid < 64) p.ctr[tid] = 0;
}

DI void phase_mod(CParams& p, char* lds) {
  const int tid = otid();
  float* red = (float*)lds;
  const int col = tid & 63, kg = tid >> 6;
  for (int it = blockIdx.x; it < DEPTH * 48; it += gridDim.x) {
    int l = it / 48, cb = it % 48;
    float acc[17];
#pragma unroll
    for (int r = 0; r < 17; ++r) acc[r] = 0.f;
    const float* w = p.w_mod + (size_t)l * D * 3072 + cb * 64 + col;
    for (int k = kg * 128; k < kg * 128 + 128; ++k) {
      float wv = w[(size_t)k * 3072];
#pragma unroll
      for (int r = 0; r < 17; ++r) acc[r] += p.sc[r * D + k] * wv;
    }
    __syncthreads();
#pragma unroll
    for (int r = 0; r < 17; ++r) red[(kg * 17 + r) * 64 + col] = acc[r];
    __syncthreads();
    for (int i = tid; i < 17 * 64; i += NTHR) {
      int r = i >> 6, cc = i & 63;
      float s = 0.f;
#pragma unroll
      for (int g = 0; g < 8; ++g) s += red[(g * 17 + r) * 64 + cc];
      p.modv[((size_t)l * 17 + r) * 3072 + cb * 64 + cc] = s + p.b_mod[l * 3072 + cb * 64 + cc];
    }
  }
}

DI void phase_prenorm(CParams& p, int chunk, int l) {
  const int NB = p.NB, RL = NB * S, R = NB * (S + L);
  const int tid_ = otid();
  const int lane = tid_ & 63;
  const int wg = blockIdx.x * 8 + (tid_ >> 6), nw = gridDim.x * 8;
  const float* g = p.norm_g + l * D;
  for (int r = wg; r < R; r += nw) {
    const float* src; int mrow;
    if (r < RL) {
      int b = r / S, t = r % S; int bg = chunk * NB + b;
      src = (l == 0 ? p.x : p.out) + ((size_t)bg * S + t) * D; mrow = bg;
    } else {
      int rc = r - RL; int b = rc / L, t = rc % L; int bg = chunk * NB + b;
      src = (l == 0 ? p.ctx : p.xc) + ((size_t)bg * L + t) * D; mrow = 16;
    }
    const float* mv = p.modv + ((size_t)l * 17 + mrow) * 3072;
    float4 v[4]; float ss = 0.f;
#pragma unroll
    for (int i = 0; i < 4; ++i) {
      v[i] = *(const float4*)(src + i * 256 + lane * 4);
      ss += v[i].x * v[i].x + v[i].y * v[i].y + v[i].z * v[i].z + v[i].w * v[i].w;
    }
#pragma unroll
    for (int o = 32; o >= 1; o >>= 1) ss += __shfl_xor(ss, o);
    float rstd = rsqrtf(ss * (1.f / D) + EPS);
#pragma unroll
    for (int i = 0; i < 4; ++i) {
      int cidx = i * 256 + lane * 4;
      float4 gg = *(const float4*)(g + cidx);
      float4 sh = *(const float4*)(mv + cidx);
      float4 scl = *(const float4*)(mv + 1024 + cidx);
      float h0 = v[i].x * rstd * gg.x * (1.f + scl.x) + sh.x;
      float h1 = v[i].y * rstd * gg.y * (1.f + scl.y) + sh.y;
      float h2 = v[i].z * rstd * gg.z * (1.f + scl.z) + sh.z;
      float h3 = v[i].w * rstd * gg.w * (1.f + scl.w) + sh.w;
      uint2 o; o.x = pack2(h0, h1); o.y = pack2(h2, h3);
      *(uint2*)(p.Hb + (size_t)r * D + cidx) = o;
    }
  }
}

template <int BN, bool PIPE>
DI void gemm_core(const u16* A, int lda, int ksa, size_t a_blk, const u16* Bt, int ldb, int ksb, size_t b_blk, int K, char* ldsc,
                  f32x16 (&acc)[BN / 64][2]) {
  constexpr int MI = BN / 64;
  constexpr int SS = 32768 + BN * 128;
  const int tid = otid(), lane = tid & 63, w = tid >> 6;
  const int wm = (BN == 256) ? (w >> 2) : (w >> 1), wn = (BN == 256) ? (w & 3) : (w & 1);
  const int r = lane & 31, hh = lane >> 5;
  const int drow = lane >> 3, dcp = lane & 7;
  const int chunk0 = dcp ^ (drow >> 1);
  const u16* gAe = A + (size_t)(w >> 2) * a_blk + (size_t)((w & 3) * 32 + drow) * lda + chunk0 * 8;
  const u16* gAo = gAe + (size_t)8 * lda + ((chunk0 ^ 4) - chunk0) * 8;
  const size_t a16 = (size_t)16 * lda;
  const int brow0 = (BN == 256) ? (w & 3) * 32 : w * 16;
  const u16* gBe = Bt + ((BN == 256) ? (size_t)(w >> 2) * b_blk : (size_t)0) + (size_t)(brow0 + drow) * ldb + chunk0 * 8;
  const u16* gBo = gBe + (size_t)8 * ldb + ((chunk0 ^ 4) - chunk0) * 8;
  const size_t b16 = (size_t)16 * ldb;
#pragma unroll
  for (int i = 0; i < MI; ++i)
#pragma unroll
    for (int j = 0; j < 2; ++j)
#pragma unroll
      for (int x = 0; x < 16; ++x) acc[i][j][x] = 0.f;
  auto DMA = [&](int kt, int stage) {
    char* sa = ldsc + stage * SS + (w * 4) * 1024;
    char* sb = ldsc + stage * SS + 32768 + ((BN == 256) ? (w * 4) : (w * 2)) * 1024;
    const size_t ka = (size_t)kt * ksa, kb = (size_t)kt * ksb;
    __builtin_amdgcn_global_load_lds((const unsigned*)(gAe + ka), (unsigned*)(sa), 16, 0, 0);
    __builtin_amdgcn_global_load_lds((const unsigned*)(gBe + kb), (unsigned*)(sb), 16, 0, 0);
    __builtin_amdgcn_global_load_lds((const unsigned*)(gAo + ka), (unsigned*)(sa + 1024), 16, 0, 0);
    __builtin_amdgcn_global_load_lds((const unsigned*)(gBo + kb), (unsigned*)(sb + 1024), 16, 0, 0);
    __builtin_amdgcn_global_load_lds((const unsigned*)(gAe + a16 + ka), (unsigned*)(sa + 2048), 16, 0, 0);
    __builtin_amdgcn_global_load_lds((const unsigned*)(gAo + a16 + ka), (unsigned*)(sa + 3072), 16, 0, 0);
    if (BN == 256) {
      __builtin_amdgcn_global_load_lds((const unsigned*)(gBe + b16 + kb), (unsigned*)(sb + 2048), 16, 0, 0);
      __builtin_amdgcn_global_load_lds((const unsigned*)(gBo + b16 + kb), (unsigned*)(sb + 3072), 16, 0, 0);
    }
  };
  const int sw = (r >> 1) & 7;
  int koff[4];
#pragma unroll
  for (int ks = 0; ks < 4; ++ks) koff[ks] = ((2 * ks + hh) ^ sw) << 4;
  auto COMPUTE = [&](int stage) {
    const char* ab = ldsc + stage * SS + (wm * (MI * 32) + r) * 128;
    const char* bb = ldsc + stage * SS + 32768 + (wn * 64 + r) * 128;
    bf16x8 fa[2][MI], fb[2][2];
    auto LDF = [&](int ks, int slot) {
#pragma unroll
      for (int i = 0; i < MI; ++i) fa[slot][i] = *(const bf16x8*)(ab + i * 32 * 128 + koff[ks]);
#pragma unroll
      for (int j = 0; j < 2; ++j) fb[slot][j] = *(const bf16x8*)(bb + j * 32 * 128 + koff[ks]);
    };
    auto MM = [&](int slot) {
#pragma unroll
      for (int i = 0; i < MI; ++i)
#pragma unroll
        for (int j = 0; j < 2; ++j) acc[i][j] = MFMA32(fb[slot][j], fa[slot][i], acc[i][j]);
    };
    if (!PIPE) {
#pragma unroll
      for (int ks = 0; ks < 4; ++ks) { LDF(ks, 0); MM(0); }
      return;
    }
    LDF(0, 0); LDF(1, 1);
    __builtin_amdgcn_sched_barrier(0);
    MM(0); LDF(2, 0);
    __builtin_amdgcn_sched_barrier(0);
    MM(1); LDF(3, 1);
    __builtin_amdgcn_sched_barrier(0);
    MM(0); MM(1);
  };
  const int KT = K >> 6;
  __syncthreads();
  DMA(0, 0);
  __syncthreads();
  for (int kt = 0; kt < KT; kt += 2) {
    DMA(kt + 1, 1);
    COMPUTE(0);
    __syncthreads();
    if (kt + 2 < KT) DMA(kt + 2, 0);
    COMPUTE(1);
    __syncthreads();
  }
}

template <int MI>
DI void stage_acc(char* ldsc, f32x16 (&acc)[MI][2], int wm, int ncol0, bool active) {
  const int tid = otid(), lane = tid & 63;
  const int r = lane & 31, hh = lane >> 5;
  float* Cs = (float*)ldsc;
  if (active) {
#pragma unroll
    for (int i = 0; i < MI; ++i)
#pragma unroll
      for (int j = 0; j < 2; ++j)
#pragma unroll
        for (int g = 0; g < 4; ++g) {
          int m = wm * (MI * 32) + i * 32 + r;
          int n = ncol0 + j * 32 + 8 * g + 4 * hh;
          float4 v; v.x = acc[i][j][4 * g]; v.y = acc[i][j][4 * g + 1]; v.z = acc[i][j][4 * g + 2]; v.w = acc[i][j][4 * g + 3];
          *(float4*)(Cs + m * 132 + n) = v;
        }
  }
  __syncthreads();
}

DI void read_row64(const char* ldsc, int row, int half, float (&v)[64]) {
  const float* Cs = (const float*)ldsc + row * 132 + half * 64;
#pragma unroll
  for (int j = 0; j < 16; ++j) {
    float4 t = *(const float4*)(Cs + j * 4);
    v[j * 4] = t.x; v[j * 4 + 1] = t.y; v[j * 4 + 2] = t.z; v[j * 4 + 3] = t.w;
  }
}

DI void store_row64_bf16(u16* dst, const float (&v)[64]) {
#pragma unroll
  for (int j = 0; j < 8; ++j) {
    uint4 o;
    o.x = pack2(v[j * 8], v[j * 8 + 1]); o.y = pack2(v[j * 8 + 2], v[j * 8 + 3]);
    o.z = pack2(v[j * 8 + 4], v[j * 8 + 5]); o.w = pack2(v[j * 8 + 6], v[j * 8 + 7]);
    *(uint4*)(dst + j * 8) = o;
  }
}

namespace pg8 {
#define PG8_LAS __attribute__((address_space(3)))
typedef unsigned short bf16_t;
typedef short bf16x8 __attribute__((ext_vector_type(8)));
typedef float f32x4 __attribute__((ext_vector_type(4)));
typedef unsigned u32x4 __attribute__((ext_vector_type(4)));
constexpr int BM = 256, BK = 64, HALF = 128, HTB = HALF * BK * 2  , STAGE_BYTES = 8 * HTB, NXCD = 8, WGM = 8;

__host__ __device__ __forceinline__ int lds_byte(int r, int c) { const int st = (r >> 4) * 2 + (c >> 5), rr = r & 15, cc = c & 31, ob = rr * 64 + cc * 2; return st * 1024 + (ob ^ (((ob >> 9) & 1) << 5)); }
__host__ __device__ __forceinline__ void stage_rc(int b, int& R, int& C) { const int st = b / 1024, sb = b % 1024, swz = sb ^ (((sb >> 9) & 1) << 5); R = (st >> 1) * 16 + swz / 64; C = (st & 1) * 32 + (swz % 64) / 2; }
__host__ __device__ __forceinline__ int perm32(int rho) { const int n = rho >> 4, i = rho & 15; return 8 * (i >> 2) + 4 * n + (i & 3); }
struct Unit { int pm, pn; };
struct Gemm { const bf16_t* A; const bf16_t* Bt; int M, N, K; int lda; };
struct StaticOrder {
    int nM, nN, nwg, G, c;
    __host__ __device__ void init(int M, int N, int G_, int c_) { nM = M / BM; nN = N / BM; nwg = nM * nN; G = G_; c = c_; }
    __host__ __device__ bool next(int i, Unit& u) const {
        const long L = (long)i * G + c; if (L >= nwg) return false;
        int wgid = (int)L; { const int q = nwg / NXCD, r = nwg % NXCD, xcd = wgid % NXCD, off = wgid / NXCD; wgid = (xcd < r ? xcd * (q + 1) : r * (q + 1) + (xcd - r) * q) + off; }
        const int nig = WGM * nN, gid = wgid / nig, fm = gid * WGM, gsz = (nM - fm) < WGM ? (nM - fm) : WGM;
        u.pm = fm + ((wgid % nig) % gsz); u.pn = (wgid % nig) / gsz; return true;
    }
    __device__ __forceinline__ void a_ready(const Unit&) const {}
    __device__ __forceinline__ void done(const Unit&) const {}
    __device__ __forceinline__ size_t a_off(const Unit&) const { return 0; }
};
template <class Epi, class Sched, bool STAMP = false>
__device__ __forceinline__ void gemm_phase(PG8_LAS unsigned char* lds, const Gemm g, const Sched& S, const Epi& E, unsigned long long* stamps) {
    int tid_raw = threadIdx.x; asm volatile("" : "+v"(tid_raw));
    const int tid = tid_raw, wid = __builtin_amdgcn_readfirstlane(tid >> 6), lane = tid & 63, wr = wid >> 2, wc = wid & 3, fr = lane & 15, fq = lane >> 4;
    const int K = g.K, nt = K / BK;
    int ts_lo = 0, ts_hi = 0, nts = 0; const unsigned long long rt_entry = STAMP ? (unsigned long long)wall_clock64() : 0ull;
#define PG8_STAMP() do { if (STAMP && wid == 0 && nts < 64) { const unsigned long long _c = (unsigned long long)clock64(); \
        ts_lo = (lane == nts) ? (int)(unsigned)_c : ts_lo; ts_hi = (lane == nts) ? (int)(unsigned)(_c >> 32) : ts_hi; ++nts; } } while (0)
    PG8_STAMP();
    unsigned voffA[2], voffB[2];
#pragma unroll
    for (int i = 0; i < 2; ++i) { int R, C; stage_rc(tid * 16 + i * 8192, R, C); const int Rb = Epi::PERM ? ((R & ~31) + perm32(R & 31)) : R;
        voffA[i] = (unsigned)(R * g.lda + C) * 2u; voffB[i] = (unsigned)(Rb * K + C) * 2u; }
    const size_t kstep = (size_t)(BK * 2);
    const size_t hstep = (size_t)HALF * K * 2;
    const size_t tstep = 2 * hstep;
    const size_t hstepA = (size_t)HALF * g.lda * 2, tstepA = 2 * hstepA;
    const unsigned ldsw = (unsigned)wid * 1024u;
    const int aoff = lds_byte(wr * 64 + fr, fq * 8), boff = lds_byte(wc * 32 + fr, fq * 8);
#define PG8_SA(b, h) (((b) * 2 + (h)) * HTB)
#define PG8_SB(b, h) ((4 + (b) * 2 + (h)) * HTB)
#define PG8_STAGE(bufoff, gbase, voff) do { _Pragma("unroll") for (int _i = 0; _i < 2; ++_i) \
        __builtin_amdgcn_global_load_lds((const unsigned*)((const char*)(gbase) + (voff)[_i]), (PG8_LAS unsigned*)(lds + (bufoff) + ldsw + _i * 8192), 16, 0, 0); } while (0)
#define PG8_LDA(dst, b, h) do { _Pragma("unroll") for (int m = 0; m < 4; ++m) _Pragma("unroll") for (int k = 0; k < 2; ++k) dst[m][k] = *(const PG8_LAS bf16x8*)(lds + PG8_SA(b, h) + aoff + m * 2048 + k * 1024); } while (0)
#define PG8_LDB(dst, b, h) do { _Pragma("unroll") for (int n = 0; n < 2; ++n) _Pragma("unroll") for (int k = 0; k < 2; ++k) dst[n][k] = *(const PG8_LAS bf16x8*)(lds + PG8_SB(b, h) + boff + n * 2048 + k * 1024); } while (0)
#define PG8_MMA(ai, bj, At, Bt) do { __builtin_amdgcn_s_setprio(1); _Pragma("unroll") for (int m = 0; m < 4; ++m) _Pragma("unroll") for (int n = 0; n < 2; ++n) _Pragma("unroll") for (int k = 0; k < 2; ++k) \
        acc[ai][bj][m][n] = __builtin_amdgcn_mfma_f32_16x16x32_bf16(Bt[n][k], At[m][k], acc[ai][bj][m][n], 0, 0, 0); __builtin_amdgcn_s_setprio(0); } while (0)
#define PG8_WAIT_V(n) asm volatile("s_waitcnt vmcnt(" #n ")" ::: "memory")
#define PG8_WAIT_L(n) asm volatile("s_waitcnt lgkmcnt(" #n ")" ::: "memory")
#define PG8_BAR __builtin_amdgcn_s_barrier()
#define PG8_SCHED __builtin_amdgcn_sched_barrier(0)
    Unit cur, nxt; int ui = 0;
    if (!S.next(0, cur)) return;
    f32x4 acc[2][2][4][2];
#pragma unroll
    for (int a = 0; a < 2; ++a)
#pragma unroll
        for (int b = 0; b < 2; ++b)
#pragma unroll
            for (int m = 0; m < 4; ++m)
#pragma unroll
                for (int n = 0; n < 2; ++n) acc[a][b][m][n] = (f32x4){0.f, 0.f, 0.f, 0.f};
    bf16x8 At[4][2], B0[2][2], B1[2][2];
    const char* cA = (const char*)g.A + (size_t)cur.pm * tstepA + S.a_off(cur); const char* cB = (const char*)g.Bt + (size_t)cur.pn * tstep;
    S.a_ready(cur);
    PG8_STAGE(PG8_SB(0, 0), cB, voffB); PG8_STAGE(PG8_SA(0, 0), cA, voffA); PG8_STAGE(PG8_SB(0, 1), cB + hstep, voffB); PG8_STAGE(PG8_SA(0, 1), cA + hstepA, voffA);
    if (wr == 1) PG8_BAR;
    PG8_WAIT_V(4); PG8_BAR;
    PG8_STAGE(PG8_SB(1, 0), cB + kstep, voffB); PG8_STAGE(PG8_SA(1, 0), cA + kstep, voffA); PG8_STAGE(PG8_SB(1, 1), cB + hstep + kstep, voffB);
    PG8_WAIT_V(6); PG8_BAR;
    PG8_STAMP();
    for (;;) {
        const bool has_next = S.next(ui + 1, nxt);
        const char* nA = has_next ? (const char*)g.A + (size_t)nxt.pm * tstepA + S.a_off(nxt) : cA; const char* nB = has_next ? (const char*)g.Bt + (size_t)nxt.pn * tstep : cB;
        for (int t = 0; t < nt; t += 2) {
            const bool last = (t == nt - 2);
            const char* a1 = cA + (size_t)(t + 1) * kstep;
            const char* a2 = last ? nA : cA + (size_t)(t + 2) * kstep; const char* b2 = last ? nB : cB + (size_t)(t + 2) * kstep;
            const char* a3 = a2 + kstep; const char* b3 = b2 + kstep;
            if (last && has_next) S.a_ready(nxt);
            PG8_LDB(B0, 0, 0); PG8_SCHED; PG8_LDA(At, 0, 0); PG8_STAGE(PG8_SA(1, 1), a1 + hstepA, voffA);
            PG8_WAIT_L(8); PG8_BAR; PG8_WAIT_L(0); PG8_MMA(0, 0, At, B0); PG8_BAR; PG8_SCHED;
            PG8_LDB(B1, 0, 1); PG8_STAGE(PG8_SB(0, 0), b2, voffB);
            PG8_BAR; PG8_WAIT_L(0); PG8_MMA(0, 1, At, B1); PG8_BAR;
            PG8_LDA(At, 0, 1); PG8_STAGE(PG8_SA(0, 0), a2, voffA);
            PG8_BAR; PG8_WAIT_L(0); PG8_MMA(1, 0, At, B0); PG8_BAR; PG8_SCHED;
            PG8_STAGE(PG8_SB(0, 1), b2 + hstep, voffB);
            PG8_WAIT_V(6); PG8_BAR; PG8_MMA(1, 1, At, B1); PG8_BAR;
            PG8_LDB(B0, 1, 0); PG8_SCHED; PG8_LDA(At, 1, 0); PG8_STAGE(PG8_SA(0, 1), a2 + hstepA, voffA);
            PG8_WAIT_L(8); PG8_BAR; PG8_WAIT_L(0); PG8_MMA(0, 0, At, B0); PG8_BAR; PG8_SCHED;
            PG8_LDB(B1, 1, 1); PG8_STAGE(PG8_SB(1, 0), b3, voffB);
            PG8_BAR; PG8_WAIT_L(0); PG8_MMA(0, 1, At, B1); PG8_BAR;
            PG8_LDA(At, 1, 1); PG8_STAGE(PG8_SA(1, 0), a3, voffA);
            PG8_BAR; PG8_WAIT_L(0); PG8_MMA(1, 0, At, B0); PG8_BAR; PG8_SCHED;
            PG8_STAGE(PG8_SB(1, 1), b3 + hstep, voffB);
            PG8_WAIT_V(6); PG8_BAR; PG8_MMA(1, 1, At, B1); PG8_BAR;
        }
        PG8_STAMP();
        if constexpr (!Epi::AFTER_DRAIN) { E(acc, cur, wr, wc, fr, fq); S.done(cur); }
        PG8_STAMP();
        if (!has_next) break;
#pragma unroll
        for (int a = 0; a < 2; ++a)
#pragma unroll
            for (int b = 0; b < 2; ++b)
#pragma unroll
                for (int m = 0; m < 4; ++m)
#pragma unroll
                    for (int n = 0; n < 2; ++n) acc[a][b][m][n] = (f32x4){0.f, 0.f, 0.f, 0.f};
        cur = nxt; cA = nA; cB = nB; ++ui;
    }
    PG8_WAIT_V(0);
    if (wr == 0) PG8_BAR;
    PG8_BAR;
    if constexpr (Epi::AFTER_DRAIN) { E.fused(acc, cur, wr, wc, fr, fq, lds, wid, lane); S.done(cur); }
    PG8_STAMP();
    if (STAMP && wid == 0) { stamps[lane] = lane < nts ? (((unsigned long long)(unsigned)ts_hi << 32) | (unsigned)ts_lo) : 0ull;
        if (lane == 62) stamps[62] = rt_entry; if (lane == 63) stamps[63] = (unsigned long long)wall_clock64(); }
#undef PG8_STAMP
#undef PG8_SA
#undef PG8_SB
#undef PG8_STAGE
#undef PG8_LDA
#undef PG8_LDB
#undef PG8_MMA
#undef PG8_WAIT_V
#undef PG8_WAIT_L
#undef PG8_BAR
#undef PG8_SCHED
}
}

struct EpiIn {
  static constexpr bool PERM = true, AFTER_DRAIN = false;
  CParams* kp;
  __device__ __forceinline__ void operator()(const pg8::f32x4 (&acc)[2][2][4][2], const pg8::Unit& u, int wr, int wc, int fr, int fq) const {
    const int pn = u.pn;
    u16* base; int ld, mode;
    if (pn < 4) { base = kp->U + pn * 256; ld = D; mode = 0; }
    else if (pn < 16) { base = kp->Z + (pn - 4) * 256; ld = 3072; mode = 1; }
    else { base = kp->Ms + (pn - 16) * 256; ld = 3072; mode = 2; }
    const int row0 = u.pm * 256 + wr * 64 + fr;
    const int col0 = wc * 32 + 8 * fq;
    u16* rowp0 = base + (size_t)row0 * ld + col0;
#pragma unroll
    for (int ai = 0; ai < 2; ++ai)
#pragma unroll
      for (int m = 0; m < 4; ++m)
#pragma unroll
        for (int bj = 0; bj < 2; ++bj)
#pragma unroll
          for (int n = 0; n < 2; ++n) {
            pg8::f32x4 v0 = acc[ai][bj][m][n];
            if (mode == 1) {
#pragma unroll
              for (int j = 0; j < 4; ++j) v0[j] = siluf_(v0[j]);
            } else if (mode == 2) {
#pragma unroll
              for (int j = 0; j < 4; ++j) v0[j] = sigmoidf_(v0[j]);
            }
            u32x2 w; w.x = pack2(v0[0], v0[1]); w.y = pack2(v0[2], v0[3]);
            *(u32x2*)(rowp0 + (size_t)(ai * 128 + m * 16) * ld + bj * 128 + n * 4) = w;
          }
  }
};

DI bool tile_map(int i, int MT, int NT, int& mt, int& nt) {
  const int G = gridDim.x, bid = blockIdx.x;
  if ((G & 63) == 0 && (MT & 7) == 0 && (NT % (G >> 6)) == 0) {
    const int SH = G >> 6;
    const int xcd = bid & 7, slot = bid >> 3;
    const int sx = slot & 7, sy = slot >> 3;
    const int nsn = NT / SH, nsm = MT >> 3;
    const int st = i * 8 + xcd;
    if (st >= nsm * nsn) return false;
    mt = (st / nsn) * 8 + sx;
    nt = (st % nsn) * SH + sy;
    return true;
  }
  const int it = bid + i * G;
  if (it >= MT * NT) return false;
  mt = it / NT; nt = it % NT;
  return true;
}


struct OneUnit {
  int pm, pn;
  __device__ bool next(int i, pg8::Unit& u) const { if (i) return false; u.pm = pm; u.pn = pn; return true; }
  __device__ __forceinline__ void a_ready(const pg8::Unit&) const {}
  __device__ __forceinline__ void done(const pg8::Unit&) const {}
  __device__ __forceinline__ size_t a_off(const pg8::Unit&) const { return 0; }
};
struct EpiQKV {
  static constexpr bool PERM = false, AFTER_DRAIN = true;
  CParams* kp; char* lds; int l, nt, m0;
  __device__ __forceinline__ void fused(const pg8::f32x4 (&acc)[2][2][4][2], const pg8::Unit&, int wr, int wc, int fr, int fq,
                                        PG8_LAS unsigned char*, int, int) const {
    CParams& p = *kp;
    const int NB = p.NB, RL = NB * S;
    const int tid = otid();
    const bool lat = m0 < RL;
    int b, t0;
    if (lat) { b = m0 / S; t0 = m0 % S; } else { int rc = m0 - RL; b = rc / L; t0 = rc % L; }
    const bool isV = (nt == 13 || nt == 23);
    const bool isC = nt >= 18;
    const bool isQ = (nt >= 8 && nt < 12) || (nt >= 18 && nt < 22);
    auto process_unit = [&](int hsel, int u) {
      if (isV) {
        const int slot = (isC ? 2 : 0) + hsel;
        const int d = u >> 2, tq = u & 3;
        const float* Cs = (const float*)lds;
        u16* dst = lat ? p.VtL + ((size_t)(b * 4 + slot) * 128 + d) * S + t0 + tq * 64
                       : p.VtC + ((size_t)(b * 4 + slot) * 128 + d) * L + t0 + tq * 64;
#pragma unroll 1
        for (int c = 0; c < 4; ++c) {
          float v[16];
#pragma unroll
          for (int j = 0; j < 16; ++j) v[j] = Cs[(tq * 64 + c * 16 + j) * 132 + d];
          uint4 o0, o1;
          o0.x = pack2(v[0], v[1]); o0.y = pack2(v[2], v[3]); o0.z = pack2(v[4], v[5]); o0.w = pack2(v[6], v[7]);
          o1.x = pack2(v[8], v[9]); o1.y = pack2(v[10], v[11]); o1.z = pack2(v[12], v[13]); o1.w = pack2(v[14], v[15]);
          *(uint4*)(dst + c * 16) = o0;
          *(uint4*)(dst + c * 16 + 8) = o1;
        }
      } else {
        const int row = u >> 1, half = u & 1;
        const size_t gr = (size_t)m0 + row;
        const int t = t0 + row;
        const float* Cr = (const float*)lds + row * 132 + half * 64;
        float rstd = 1.f;
        const float* gn = (isQ ? p.q_norm_g : p.k_norm_g) + l * 128 + half * 64;
        if (isC) {
          float ss = 0.f;
#pragma unroll
          for (int j = 0; j < 16; ++j) {
            float4 tv = *(const float4*)(Cr + j * 4);
            ss += tv.x * tv.x + tv.y * tv.y + tv.z * tv.z + tv.w * tv.w;
          }
          ss += __shfl_xor(ss, 1);
          rstd = rsqrtf(ss * (1.f / 128.f) + EPS);
        }
        const int pos = (half == 0) ? (t >> 6) : (t & 63);
        const float* cs = p.rope + pos * 32;
        const float* sn = p.rope + 2048 + pos * 32;
        u16* dst;
        if (isQ) {
          const int head = (isC ? (nt - 18) : (nt - 8)) * 2 + hsel;
          dst = p.Q + gr * 2048 + (isC ? 1024 : 0) + head * 128 + half * 64;
        } else {
          dst = p.Kb + gr * 512 + (isC ? 256 : 0) + hsel * 128 + half * 64;
        }
#pragma unroll 1
        for (int c = 0; c < 2; ++c) {
          float x0[16], x1[16];
#pragma unroll
          for (int j = 0; j < 4; ++j) {
            float4 ta_ = *(const float4*)(Cr + c * 16 + j * 4);
            float4 tb_ = *(const float4*)(Cr + 32 + c * 16 + j * 4);
            x0[4 * j] = ta_.x; x0[4 * j + 1] = ta_.y; x0[4 * j + 2] = ta_.z; x0[4 * j + 3] = ta_.w;
            x1[4 * j] = tb_.x; x1[4 * j + 1] = tb_.y; x1[4 * j + 2] = tb_.z; x1[4 * j + 3] = tb_.w;
          }
          if (isC) {
#pragma unroll
            for (int j = 0; j < 16; ++j) { x0[j] = x0[j] * rstd * gn[c * 16 + j]; x1[j] = x1[j] * rstd * gn[32 + c * 16 + j]; }
          }
          if (lat) {
#pragma unroll
            for (int j = 0; j < 16; ++j) {
              float c_ = cs[c * 16 + j], s_ = sn[c * 16 + j];
              float a0 = x0[j], a1 = x1[j];
              x0[j] = a0 * c_ - a1 * s_;
              x1[j] = a1 * c_ + a0 * s_;
            }
          }
          if (isQ) {
#pragma unroll
            for (int j = 0; j < 16; ++j) { x0[j] *= QSCALE; x1[j] *= QSCALE; }
          }
          uint4 o0, o1, o2, o3;
          o0.x = pack2(x0[0], x0[1]); o0.y = pack2(x0[2], x0[3]); o0.z = pack2(x0[4], x0[5]); o0.w = pack2(x0[6], x0[7]);
          o1.x = pack2(x0[8], x0[9]); o1.y = pack2(x0[10], x0[11]); o1.z = pack2(x0[12], x0[13]); o1.w = pack2(x0[14], x0[15]);
          o2.x = pack2(x1[0], x1[1]); o2.y = pack2(x1[2], x1[3]); o2.z = pack2(x1[4], x1[5]); o2.w = pack2(x1[6], x1[7]);
          o3.x = pack2(x1[8], x1[9]); o3.y = pack2(x1[10], x1[11]); o3.z = pack2(x1[12], x1[13]); o3.w = pack2(x1[14], x1[15]);
          *(uint4*)(dst + c * 16) = o0;
          *(uint4*)(dst + c * 16 + 8) = o1;
          *(uint4*)(dst + 32 + c * 16) = o2;
          *(uint4*)(dst + 32 + c * 16 + 8) = o3;
        }
      }
    };

#pragma unroll
    for (int bj = 0; bj < 2; ++bj) {
      float* Cs = (float*)lds;
#pragma unroll
      for (int ai = 0; ai < 2; ++ai)
#pragma unroll
        for (int m = 0; m < 4; ++m)
#pragma unroll
          for (int n = 0; n < 2; ++n) {
            const int row = ai * 128 + wr * 64 + m * 16 + fr;
            const int col = wc * 32 + n * 16 + fq * 4;
            pg8::f32x4 v = acc[ai][bj][m][n];
            float4 o; o.x = v[0]; o.y = v[1]; o.z = v[2]; o.w = v[3];
            *(float4*)(Cs + row * 132 + col) = o;
          }
      __syncthreads();
      process_unit(bj, tid);
      __syncthreads();
    }
  }
};

DI void phase_gemm_in(CParams& p, int chunk, int l, char* lds) {
  const int NB = p.NB, RL = NB * S, R = NB * (S + L);
  const int MT = R / 256;
  const u16* Wt = p.WinT + (size_t)l * INW * D;
  {
    pg8::Gemm g{p.Hb, Wt, R, 7168, D, D};
    pg8::StaticOrder So; So.init(R, 7168, (int)gridDim.x, (int)blockIdx.x);
    EpiIn E{&p};
    pg8::gemm_phase<EpiIn, pg8::StaticOrder, false>((PG8_LAS unsigned char*)lds, g, So, E, nullptr);
  }
  for (int ti = 0;; ++ti) {
    int mt, jt;
    if (!tile_map(ti, MT, 12, mt, jt)) break;
    const int nt = (jt < 6) ? 8 + jt : 12 + jt;
    pg8::Gemm g{p.Hb, Wt + (size_t)28 * 256 * D, R, 3072, D, D};
    OneUnit One{mt, jt};
    EpiQKV E{&p, lds, l, nt, mt * 256};
    pg8::gemm_phase<EpiQKV, OneUnit, false>((PG8_LAS unsigned char*)lds, g, One, E, nullptr);
  }
}

struct AttnArgs {
  const u16* q;
  u16* z;
  const u16* kctx;
  const u16* vctx;
  const u16* klat;
  const u16* vlat;
  int n_lat_tiles;
  int lat_key0;
  int q_t0;
  int band;
  int has_sink;
  float sink_l2;
  int dry;
  int fixedm;
  float mfix;
};

DI void attn_load_tile(const AttnArgs& a, int ti, u32x4 (&rk)[2], u32x4 (&rv)[2]) {
  const int tid = otid();
  const u16* kp; const u16* vp; int vs;
  if (ti < 4) { kp = a.kctx + (size_t)(ti * 64) * 512; vp = a.vctx + ti * 64; vs = L; }
  else { kp = a.klat + (size_t)((ti - 4) * 64) * 512; vp = a.vlat + (ti - 4) * 64; vs = S; }
#pragma unroll
  for (int i = 0; i < 2; ++i) {
    int c = tid + NTHR * i;
    rk[i] = *(const u32x4*)(kp + (size_t)(c >> 4) * 512 + (c & 15) * 8);
    rv[i] = *(const u32x4*)(vp + (size_t)(c >> 3) * vs + (c & 7) * 8);
  }
}
DI void attn_store_tile(u16* sK, u16* sV, const u32x4 (&rk)[2], const u32x4 (&rv)[2]) {
  const int tid = otid();
#pragma unroll
  for (int i = 0; i < 2; ++i) {
    int c = tid + NTHR * i;
    *(u32x4*)(sK + (c >> 4) * 136 + (c & 15) * 8) = rk[i];
    u16* vd = sV + (c >> 3) * 68 + (c & 7) * 8;
    { u32x2 t0 = {rv[i].x, rv[i].y}; *(u32x2*)(vd) = t0; }
    { u32x2 t1 = {rv[i].z, rv[i].w}; *(u32x2*)(vd + 4) = t1; }
  }
}

DI void attn_item(const AttnArgs& a, char* lds) {
  const int tid = otid(), lane = tid & 63, w = tid >> 6;
  const int r = lane & 31, hh = lane >> 5;
  constexpr int STG = 34816;
  const int ntiles = 4 + a.n_lat_tiles;

  bf16x8 qf[8];
  {
    const u16* qp = a.q + (size_t)(w * 32 + r) * 2048 + hh * 8;
#pragma unroll
    for (int ks = 0; ks < 8; ++ks) qf[ks] = *(const bf16x8*)(qp + ks * 16);
  }
  f32x16 O[4];
#pragma unroll
  for (int dt = 0; dt < 4; ++dt)
#pragma unroll
    for (int x = 0; x < 16; ++x) O[dt][x] = 0.f;
  float m = a.fixedm ? a.mfix : (a.has_sink ? a.sink_l2 : -1e30f);
  float lsum = (a.has_sink && hh == 0) ? 1.f : 0.f;
  const int qpos = a.q_t0 + w * 32 + r;

  auto QK = [&](int stage, f32x16 (&sc)[2]) {
    const u16* sK = (const u16*)(lds + stage * STG);
#pragma unroll
    for (int kt2 = 0; kt2 < 2; ++kt2) {
#pragma unroll
      for (int x = 0; x < 16; ++x) sc[kt2][x] = 0.f;
      const u16* kb = sK + (kt2 * 32 + r) * 136 + hh * 8;
#pragma unroll
      for (int ks = 0; ks < 8; ++ks) {
        bf16x8 ka = *(const bf16x8*)(kb + ks * 16);
        sc[kt2] = MFMA32(ka, qf[ks], sc[kt2]);
      }
    }
  };
  u32x4 rk[2], rv[2];
  auto STEP = [&](int ti, int st, f32x16 (&sc)[2], f32x16 (&sn)[2]) {
    const int st1 = (st == 2) ? 0 : st + 1, st2 = (st == 0) ? 2 : st - 1;
    if (ti + 2 < ntiles) attn_load_tile(a, ti + 2, rk, rv);
    if (ti + 1 < ntiles) QK(st1, sn);
    if (a.band && ti >= 4) {
      const int k0 = a.lat_key0 + (ti - 4) * 64;
#pragma unroll
      for (int kt2 = 0; kt2 < 2; ++kt2)
#pragma unroll
        for (int x = 0; x < 16; ++x) {
          int kp = k0 + kt2 * 32 + crow(x, hh);
          int dlt = kp - qpos; dlt = dlt < 0 ? -dlt : dlt;
          if (dlt > 128) sc[kt2][x] = -1e30f;
        }
    }
    if (!a.fixedm) {
      float mx = sc[0][0];
#pragma unroll
      for (int kt2 = 0; kt2 < 2; ++kt2)
#pragma unroll
        for (int x = 0; x < 16; ++x) mx = fmaxf(mx, sc[kt2][x]);
      mx = fmaxf(mx, __shfl_xor(mx, 32));
      if (__any(mx > m + 8.f)) {
        const float mnew = fmaxf(m, mx);
        const float alpha = __builtin_amdgcn_exp2f(m - mnew);
        m = mnew;
        lsum *= alpha;
#pragma unroll
        for (int dt = 0; dt < 4; ++dt)
#pragma unroll
          for (int x = 0; x < 16; ++x) O[dt][x] *= alpha;
      }
    }
    float ps = 0.f;
#pragma unroll
    for (int kt2 = 0; kt2 < 2; ++kt2)
#pragma unroll
      for (int x = 0; x < 16; ++x) { float pv = __builtin_amdgcn_exp2f(sc[kt2][x] - m); sc[kt2][x] = pv; ps += pv; }
    lsum += ps;
    const u16* sV = (const u16*)(lds + st * STG + 17408);
#pragma unroll
    for (int kt2 = 0; kt2 < 2; ++kt2)
#pragma unroll
      for (int s2 = 0; s2 < 2; ++s2) {
        union { unsigned u[4]; bf16x8 v; } pf;
#pragma unroll
        for (int j = 0; j < 4; ++j) pf.u[j] = pack2(sc[kt2][8 * s2 + 2 * j], sc[kt2][8 * s2 + 2 * j + 1]);
        const u16* vb = sV + r * 68 + kt2 * 32 + 16 * s2 + 4 * hh;
#pragma unroll
        for (int dt = 0; dt < 4; ++dt) {
          s16x4 lo = *(const s16x4*)(vb + dt * 32 * 68);
          s16x4 hi = *(const s16x4*)(vb + dt * 32 * 68 + 8);
          bf16x8 va = __builtin_shufflevector(lo, hi, 0, 1, 2, 3, 4, 5, 6, 7);
          O[dt] = MFMA32(va, pf.v, O[dt]);
        }
      }
    if (ti + 2 < ntiles) attn_store_tile((u16*)(lds + st2 * STG), (u16*)(lds + st2 * STG + 17408), rk, rv);
    __syncthreads();
  };

  attn_load_tile(a, 0, rk, rv);
  __syncthreads();
  attn_store_tile((u16*)lds, (u16*)(lds + 17408), rk, rv);
  attn_load_tile(a, 1, rk, rv);
  attn_store_tile((u16*)(lds + STG), (u16*)(lds + STG + 17408), rk, rv);
  __syncthreads();
  f32x16 sA[2], sB[2];
  QK(0, sA);
  int st = 0;
  for (int ti = 0; ti < ntiles; ti += 2) {
    STEP(ti, st, sA, sB);
    st = (st == 2) ? 0 : st + 1;
    if (ti + 1 < ntiles) {
      STEP(ti + 1, st, sB, sA);
      st = (st == 2) ? 0 : st + 1;
    }
  }
  float ltot = lsum + __shfl_xor(lsum, 32);
  const float inv = 1.f / ltot;
  u16* zp = a.z + (size_t)(w * 32 + r) * 3072;
  u32x2 gv[4][4];
#pragma unroll
  for (int dt = 0; dt < 4; ++dt)
#pragma unroll
    for (int g4 = 0; g4 < 4; ++g4) gv[dt][g4] = *(const u32x2*)(zp + dt * 32 + 8 * g4 + 4 * hh);
#pragma unroll
  for (int dt = 0; dt < 4; ++dt)
#pragma unroll
    for (int g4 = 0; g4 < 4; ++g4) {
      int d0 = dt * 32 + 8 * g4 + 4 * hh;
      float y0 = O[dt][4 * g4 + 0] * inv * bflo(gv[dt][g4].x);
      float y1 = O[dt][4 * g4 + 1] * inv * bfhi(gv[dt][g4].x);
      float y2 = O[dt][4 * g4 + 2] * inv * bflo(gv[dt][g4].y);
      float y3 = O[dt][4 * g4 + 3] * inv * bfhi(gv[dt][g4].y);
      uint2 o; o.x = pack2(y0, y1); o.y = pack2(y2, y3);
      if (!a.dry || y0 != y0) *(uint2*)(zp + d0) = o;
    }
}

template <bool REV>
DI void lru_scan(float (&av)[2][16], float (&bv)[2][16], float& carry, int hh) {
  float segA[8], segB[8];
#pragma unroll
  for (int k = 0; k < 8; ++k) {
    const int mt = k >> 2, q = k & 3;
    float cA = 1.f, hl = 0.f;
#pragma unroll
    for (int jj = 0; jj < 4; ++jj) {
      const int j = REV ? 3 - jj : jj;
      const int i = 4 * q + j;
      hl = av[mt][i] * hl + bv[mt][i];
      cA *= av[mt][i];
      av[mt][i] = cA; bv[mt][i] = hl;
    }
    segA[k] = cA; segB[k] = hl;
  }
  float oA[8], oB[8];
#pragma unroll
  for (int k = 0; k < 8; ++k) { oA[k] = __shfl_xor(segA[k], 32); oB[k] = __shfl_xor(segB[k], 32); }
  float init[8];
  float st = carry;
#pragma unroll
  for (int kk = 0; kk < 8; ++kk) {
    const int k = REV ? 7 - kk : kk;
    const int first = REV ? 1 : 0;
    float A1 = (hh == first) ? segA[k] : oA[k];
    float B1 = (hh == first) ? segB[k] : oB[k];
    float st0 = st;
    st = A1 * st + B1;
    float A2 = (hh == first) ? oA[k] : segA[k];
    float B2 = (hh == first) ? oB[k] : segB[k];
    float st1 = st;
    st = A2 * st + B2;
    init[k] = (hh == first) ? st0 : st1;
  }
  carry = st;
#pragma unroll
  for (int k = 0; k < 8; ++k) {
    const int mt = k >> 2, q = k & 3;
#pragma unroll
    for (int j = 0; j < 4; ++j) {
      const int i = 4 * q + j;
      bv[mt][i] = bv[mt][i] + av[mt][i] * init[k];
    }
  }
}

DI void lru_item(CParams& p, int l, int b, int n, bool last, char* lds, int dry = 0) {
  const int NB = p.NB, RL = NB * S;
  const int tid = otid(), lane = tid & 63, w8 = tid >> 6;
  const int sub = __builtin_amdgcn_readfirstlane(w8 >> 2), w = w8 & 3;
  n = n + sub;
  lds += sub * 73728;
  const int dir = w >> 1, w2 = w & 1;
  const int tl = tid & 127;
  const int r = lane & 31, hh = lane >> 5;
  u16* sRaw = (u16*)lds + dir * (8704 / 2);
  u16* sUp = (u16*)(lds + 17408) + dir * (9216 / 2);
  float* sH = (float*)(lds + 35840) + w * (64 * 36);

  const int chb = n * 64;
  const int cp = (tl & 31) * 2, tg = tl >> 5;
  float cw0[4], cw1[4], cb0, cb1;
#pragma unroll
  for (int k = 0; k < 4; ++k) {
    cw0[k] = p.conv_w[((size_t)l * 4 + k) * D + chb + cp];
    cw1[k] = p.conv_w[((size_t)l * 4 + k) * D + chb + cp + 1];
  }
  cb0 = p.conv_b[l * D + chb + cp]; cb1 = p.conv_b[l * D + chb + cp + 1];
  bf16x8 waf[4], wxf[4];
  {
    const float* wa = p.lru_wa + (((size_t)(l * 2 + dir) * 16 + n) * 64) * 64;
    const float* wx = p.lru_wx + (((size_t)(l * 2 + dir) * 16 + n) * 64) * 64;
    const int e = 32 * w2 + r;
#pragma unroll
    for (int ks = 0; ks < 4; ++ks) {
      union { unsigned u[4]; bf16x8 v; } fa, fx;
#pragma unroll
      for (int j = 0; j < 4; ++j) {
        int d0 = ks * 16 + 8 * hh + 2 * j;
        fa.u[j] = pack2(wa[d0 * 64 + e], wa[(d0 + 1) * 64 + e]);
        fx.u[j] = pack2(wx[d0 * 64 + e], wx[(d0 + 1) * 64 + e]);
      }
      waf[ks] = fa.v; wxf[ks] = fx.v;
    }
  }
  const int che = chb + 32 * w2 + r;
  const float ba = p.lru_ba[(l * 2 + dir) * D + che];
  const float bx = p.lru_bx[(l * 2 + dir) * D + che];
  float c8sp;
  {
    float lam = p.lru_lambda[(l * 2 + dir) * D + che];
    float sp = (lam < -20.f) ? -lam : log1pf(expf(-lam));
    c8sp = 8.f * sp;
  }
  float carry = 0.f;

  auto step_tile = [&](int st, bool& isctx, int& tt) {
    if (dir == 0) { if (st < 4) { isctx = true; tt = st; } else { isctx = false; tt = st - 4; } }
    else { if (st < 4) { isctx = true; tt = 3 - st; } else { isctx = false; tt = 63 - (st - 4); } }
  };
  u32x4 pre[5];
  auto load_raw = [&](int st) {
    bool isctx; int tt; step_tile(st, isctx, tt);
    const int seqlen = isctx ? L : S;
    const size_t rowbase = isctx ? (size_t)RL + (size_t)b * L : (size_t)b * S;
    const int t0 = tt * 64;
#pragma unroll
    for (int i = 0; i < 5; ++i) {
      int c = tl + 128 * i;
      int rr = c >> 3, c16 = c & 7;
      int t = t0 - 2 + rr;
      u32x4 v = {0u, 0u, 0u, 0u};
      if (rr < 67 && t >= 0 && t < seqlen) v = *(const u32x4*)(p.U + (rowbase + t) * D + chb + c16 * 8);
      pre[i] = v;
    }
  };
  load_raw(0);
  __syncthreads();
  for (int st = 0; st < 68; ++st) {
    bool isctx; int tt; step_tile(st, isctx, tt);
    const size_t rowbase = isctx ? (size_t)RL + (size_t)b * L : (size_t)b * S;
    const int t0 = tt * 64;
#pragma unroll
    for (int i = 0; i < 5; ++i) {
      int c = tl + 128 * i;
      int rr = c >> 3, c16 = c & 7;
      if (rr < 67) *(u32x4*)(sRaw + rr * 64 + c16 * 8) = pre[i];
    }
    if (st + 1 < 68) load_raw(st + 1);
    __syncthreads();
    {
      const u16* rp = sRaw + (tg * 16) * 64 + cp;
      unsigned r0 = *(const unsigned*)(rp), r1 = *(const unsigned*)(rp + 64), r2 = *(const unsigned*)(rp + 128);
#pragma unroll
      for (int i = 0; i < 16; ++i) {
        unsigned r3 = *(const unsigned*)(rp + (i + 3) * 64);
        float o0 = cb0 + cw0[0] * bflo(r0) + cw0[1] * bflo(r1) + cw0[2] * bflo(r2) + cw0[3] * bflo(r3);
        float o1 = cb1 + cw1[0] * bfhi(r0) + cw1[1] * bfhi(r1) + cw1[2] * bfhi(r2) + cw1[3] * bfhi(r3);
        *(unsigned*)(sUp + (tg * 16 + i) * 72 + cp) = pack2(o0, o1);
        r0 = r1; r1 = r2; r2 = r3;
      }
    }
    __syncthreads();
    const bool fwd_first = isctx ? (tt <= 1) : (tt <= 31);
    const bool first = (dir == 0) ? fwd_first : !fwd_first;
    unsigned long long pt0[4], pt1[4];
    u32x4 pg[4];
    if (!first && !(isctx && last)) {
#pragma unroll
      for (int j = 0; j < 4; ++j) {
        const int q = lane + 64 * j;
        const int tok = q >> 2, cc = (q & 3) * 8;
        const size_t row = rowbase + t0 + tok;
        const int col = chb + 32 * w2 + cc;
        const u16* tp = p.Hb + row * D + col;
        pt0[j] = __hip_atomic_load((const unsigned long long*)tp, __ATOMIC_RELAXED, __HIP_MEMORY_SCOPE_AGENT);
        pt1[j] = __hip_atomic_load((const unsigned long long*)tp + 1, __ATOMIC_RELAXED, __HIP_MEMORY_SCOPE_AGENT);
        pg[j] = *(const u32x4*)(p.Z + row * 3072 + col);
      }
    } else {
#pragma unroll
      for (int j = 0; j < 4; ++j) { pt0[j] = 0; pt1[j] = 0; pg[j] = u32x4{0u, 0u, 0u, 0u}; }
    }
    float av[2][16], bv[2][16];
    {
      f32x16 aR[2];
#pragma unroll
      for (int mt = 0; mt < 2; ++mt) {
#pragma unroll
        for (int x = 0; x < 16; ++x) aR[mt][x] = 0.f;
        const u16* ub = sUp + (mt * 32 + r) * 72 + hh * 8;
#pragma unroll
        for (int ks = 0; ks < 4; ++ks) aR[mt] = MFMA32(*(const bf16x8*)(ub + ks * 16), waf[ks], aR[mt]);
      }
#pragma unroll
      for (int mt = 0; mt < 2; ++mt)
#pragma unroll
        for (int x = 0; x < 16; ++x) {
          const float rg = sigmoidf_(aR[mt][x] + ba);
          av[mt][x] = -c8sp * rg;
        }
    }
    {
      f32x16 aI[2];
#pragma unroll
      for (int mt = 0; mt < 2; ++mt) {
#pragma unroll
        for (int x = 0; x < 16; ++x) aI[mt][x] = 0.f;
        const u16* ub = sUp + (mt * 32 + r) * 72 + hh * 8;
#pragma unroll
        for (int ks = 0; ks < 4; ++ks) aI[mt] = MFMA32(*(const bf16x8*)(ub + ks * 16), wxf[ks], aI[mt]);
      }
#pragma unroll
      for (int mt = 0; mt < 2; ++mt)
#pragma unroll
        for (int x = 0; x < 16; ++x) {
          const int tok = mt * 32 + crow(x, hh);
          const float up = bf2f(sUp[tok * 72 + 32 * w2 + r]);
          const float ig = sigmoidf_(aI[mt][x] + bx);
          const float la = av[mt][x];
          const float a_ = __expf(la);
          const float om = fmaxf(1.f - a_ * a_, 0.f);
          av[mt][x] = a_;
          bv[mt][x] = __builtin_amdgcn_sqrtf(om) * (ig * up);
        }
    }
    if (dir == 0) lru_scan<false>(av, bv, carry, hh); else lru_scan<true>(av, bv, carry, hh);
#pragma unroll
    for (int mt = 0; mt < 2; ++mt)
#pragma unroll
      for (int x = 0; x < 16; ++x) sH[(mt * 32 + crow(x, hh)) * 36 + r] = bv[mt][x];
    if (!(isctx && last)) {
#pragma unroll
      for (int j = 0; j < 4; ++j) {
        const int q = lane + 64 * j;
        const int tok = q >> 2, cc = (q & 3) * 8;
        const float4 h0 = *(const float4*)(sH + tok * 36 + cc);
        const float4 h1 = *(const float4*)(sH + tok * 36 + cc + 4);
        const size_t row = rowbase + t0 + tok;
        const int col = chb + 32 * w2 + cc;
        u16* tp = p.Hb + row * D + col;
        if (first) {
          uint4 o; o.x = pack2(h0.x, h0.y); o.y = pack2(h0.z, h0.w); o.z = pack2(h1.x, h1.y); o.w = pack2(h1.z, h1.w);
          if (!dry || h0.x != h0.x) *(uint4*)tp = o;
        } else {
          unsigned tx = (unsigned)pt0[j], ty = (unsigned)(pt0[j] >> 32), tz = (unsigned)pt1[j], tw = (unsigned)(pt1[j] >> 32);
          u16* zp = p.Z + row * 3072 + col;
          u32x4 g = pg[j];
          uint4 o;
          o.x = pack2((h0.x + bflo(tx)) * bflo(g.x), (h0.y + bfhi(tx)) * bfhi(g.x));
          o.y = pack2((h0.z + bflo(ty)) * bflo(g.y), (h0.w + bfhi(ty)) * bfhi(g.y));
          o.z = pack2((h1.x + bflo(tz)) * bflo(g.z), (h1.y + bfhi(tz)) * bfhi(g.z));
          o.w = pack2((h1.z + bflo(tw)) * bflo(g.w), (h1.w + bfhi(tw)) * bfhi(g.w));
          if (!dry || h0.x != h0.x) *(uint4*)zp = o;
        }
      }
    }
    __builtin_amdgcn_fence(__ATOMIC_RELEASE, "workgroup");
  }
}

DI void phase_mixers(CParams& p, int chunk, int l, char* lds, int dry = 0) {
  const int NB = p.NB, RL = NB * S;
  const bool last = (l == DEPTH - 1);
  const int nLRU = (dry == 1) ? 0 : NB * 8, nC = (dry == 2) ? 0 : NB * 8 * 16, nBw = (dry == 2) ? 0 : NB * 8 * 16, nCtx = (last || dry == 2) ? 0 : NB * 8 * 2;
  const int total = nLRU + nC + nBw + nCtx;
  int* ctr = p.ctr + chunk * DEPTH + l + (dry ? 32 : 0);
  int* s_item = (int*)(lds + LDS_BYTES - 16);
  int it;
  while (true) {
    __syncthreads();
    if (threadIdx.x == 0) *s_item = atomicAdd(ctr, 1);
    __syncthreads();
    it = __builtin_amdgcn_readfirstlane(*s_item);
    __syncthreads();
    if (it >= nLRU) break;
    lru_item(p, l, it >> 3, (it & 7) * 2, last, lds, dry);
  }
  bool have = true;
  while (true) {
    if (!have) {
      __syncthreads();
      if (threadIdx.x == 0) *s_item = atomicAdd(ctr, 1);
      __syncthreads();
      it = __builtin_amdgcn_readfirstlane(*s_item);
      __syncthreads();
    }
    have = false;
    if (it >= total) break;
    it -= nLRU;
    AttnArgs a;
    a.dry = dry;
    float gqm = 0.f, gkm = 0.f;
    {
      const int ln = otid() & 63;
      gqm = fmaxf(fabsf(p.q_norm_g[l * 128 + ln]), fabsf(p.q_norm_g[l * 128 + 64 + ln]));
      gkm = fmaxf(fabsf(p.k_norm_g[l * 128 + ln]), fabsf(p.k_norm_g[l * 128 + 64 + ln]));
#pragma unroll
      for (int o = 32; o >= 1; o >>= 1) { gqm = fmaxf(gqm, __shfl_xor(gqm, o)); gkm = fmaxf(gkm, __shfl_xor(gkm, o)); }
      gqm = __builtin_amdgcn_readfirstlane(gqm); gkm = __builtin_amdgcn_readfirstlane(gkm);
    }
    const float mfixC = 128.f * gqm * gkm * QSCALE;
    if (it < nC + nBw) {
      const bool isB = it >= nC;
      if (isB) it -= nC;
      const int b = it >> 7, h = (it >> 4) & 7, qb = it & 15;
      const int kvh = h >> 2;
      const int br = isB ? 0 : 1;
      const size_t qrow0 = (size_t)b * S + qb * 256;
      a.q = p.Q + qrow0 * 2048 + br * 1024 + h * 128;
      a.z = p.Z + qrow0 * 3072 + (br + 1) * 1024 + h * 128;
      const int kcol = br * 256 + kvh * 128, slot = br * 2 + kvh;
      a.kctx = p.Kb + ((size_t)RL + (size_t)b * L) * 512 + kcol;
      a.vctx = p.VtC + (size_t)(b * 4 + slot) * 128 * L;
      int k0, k1;
      if (isB) { k0 = qb * 256 - 128; if (k0 < 0) k0 = 0; k1 = qb * 256 + 384; if (k1 > S) k1 = S; }
      else { k0 = 0; k1 = S; }
      a.lat_key0 = k0;
      a.n_lat_tiles = (k1 - k0) >> 6;
      a.klat = p.Kb + ((size_t)b * S + k0) * 512 + kcol;
      a.vlat = p.VtL + (size_t)(b * 4 + slot) * 128 * S + k0;
      a.q_t0 = qb * 256;
      a.band = isB ? 1 : 0;
      a.has_sink = isB ? 1 : 0;
      a.sink_l2 = isB ? p.attn_sink[l * 8 + h] * LOG2E : 0.f;
      a.fixedm = isB ? 0 : 1; a.mfix = mfixC;
    } else {
      it -= nC + nBw;
      const int h = it & 7, br = (it >> 3) & 1, b = it >> 4;
      const int kvh = h >> 2;
      const size_t qrow0 = (size_t)RL + (size_t)b * L;
      a.q = p.Q + qrow0 * 2048 + br * 1024 + h * 128;
      a.z = p.Z + qrow0 * 3072 + (br + 1) * 1024 + h * 128;
      const int kcol = br * 256 + kvh * 128, slot = br * 2 + kvh;
      a.kctx = p.Kb + ((size_t)RL + (size_t)b * L) * 512 + kcol;
      a.vctx = p.VtC + (size_t)(b * 4 + slot) * 128 * L;
      a.klat = a.kctx; a.vlat = a.vctx;
      a.n_lat_tiles = 0; a.lat_key0 = 0; a.q_t0 = 0; a.band = 0;
      a.has_sink = (br == 0) ? 1 : 0;
      a.sink_l2 = (br == 0) ? p.attn_sink[l * 8 + h] * LOG2E : 0.f;
      a.fixedm = (br == 0) ? 0 : 1; a.mfix = mfixC;
    }
    attn_item(a, lds);
  }
}

DI void merge_tiles_ctx(CParams& p, int l, char* lds) {
  const int NB = p.NB, RL = NB * S, R = NB * (S + L);
  const int MT = (R - RL) / 256, NT = 8;
  const int tid = otid();
  const int lane = tid & 63, w = tid >> 6, wm = w >> 1, wn = w & 1, r = lane & 31, hh = lane >> 5;
  for (int ti = 0;; ++ti) {
    int mt, nt;
    if (!tile_map(ti, MT, NT, mt, nt)) break;
    const int m0 = RL + mt * 256, n0 = nt * 128;
    f32x16 tot[2][2];
#pragma unroll
    for (int i = 0; i < 2; ++i)
#pragma unroll
      for (int j = 0; j < 2; ++j)
#pragma unroll
        for (int x = 0; x < 16; ++x) tot[i][j][x] = 0.f;
#pragma unroll 1
    for (int n = 0; n < 3; ++n) {
      f32x16 acc[2][2];
      gemm_core<128, false>(p.Z + (size_t)m0 * 3072 + n * 1024, 3072, 64, (size_t)128 * 3072,
                            p.WbT + ((size_t)(l * 3 + n) * D + n0) * D, D, 64, 0, D, lds, acc);
#pragma unroll
      for (int i = 0; i < 2; ++i)
#pragma unroll
        for (int j = 0; j < 2; ++j)
#pragma unroll
          for (int g = 0; g < 4; ++g) {
            const size_t row = (size_t)m0 + wm * 64 + i * 32 + r;
            const int col = n0 + wn * 64 + j * 32 + 8 * g + 4 * hh;
            uint2 sv = *(const uint2*)(p.Ms + row * 3072 + n * 1024 + col);
            tot[i][j][4 * g + 0] += bflo(sv.x) * acc[i][j][4 * g + 0];
            tot[i][j][4 * g + 1] += bfhi(sv.x) * acc[i][j][4 * g + 1];
            tot[i][j][4 * g + 2] += bflo(sv.y) * acc[i][j][4 * g + 2];
            tot[i][j][4 * g + 3] += bfhi(sv.y) * acc[i][j][4 * g + 3];
          }
    }
#pragma unroll
    for (int i = 0; i < 2; ++i)
#pragma unroll
      for (int j = 0; j < 2; ++j)
#pragma unroll
        for (int g = 0; g < 4; ++g) {
          const size_t row = (size_t)m0 + wm * 64 + i * 32 + r;
          const int col = n0 + wn * 64 + j * 32 + 8 * g + 4 * hh;
          uint2 o; o.x = pack2(tot[i][j][4 * g], tot[i][j][4 * g + 1]); o.y = pack2(tot[i][j][4 * g + 2], tot[i][j][4 * g + 3]);
          *(uint2*)(p.Hb + row * D + col) = o;
        }
  }
}

struct MergeOrder {
  pg8::StaticOrder inner;
  __device__ void init(int M, int G, int c) { inner.init(M, 1024, G, c); }
  __device__ bool next(int i, pg8::Unit& u) const {
    const int j = i / 3, n = i - 3 * j;
    pg8::Unit t;
    if (!inner.next(j, t)) return false;
    u.pm = t.pm; u.pn = n * 4 + t.pn;
    return true;
  }
  __device__ __forceinline__ void a_ready(const pg8::Unit&) const {}
  __device__ __forceinline__ void done(const pg8::Unit&) const {}
  __device__ __forceinline__ size_t a_off(const pg8::Unit& u) const { return (size_t)(u.pn >> 2) * 1024 * 2; }
};
struct EpiMerge {
  static constexpr bool PERM = true, AFTER_DRAIN = false;
  CParams* kp;
  __device__ __forceinline__ void operator()(const pg8::f32x4 (&acc)[2][2][4][2], const pg8::Unit& u, int wr, int wc, int fr, int fq) const {
    const int n = u.pn >> 2, ct = u.pn & 3;
    const int row0 = u.pm * 256 + wr * 64 + fr;
    const int col0 = ct * 256 + wc * 32 + 8 * fq;
    const u16* __restrict__ sg = kp->Ms + n * 1024;
    const float* __restrict__ mrd = (const float*)kp->Q;
    float* __restrict__ mwr = (float*)kp->Q;
    u16* __restrict__ hb = kp->Hb;
#pragma unroll
    for (int am = 0; am < 4; ++am) {
      const int ai = am >> 1, mb = (am & 1) * 2;
      u32x4 sv[2][2];
      pg8::f32x4 pa[2][2][2];
#pragma unroll
      for (int mm = 0; mm < 2; ++mm) {
        const size_t row = (size_t)(row0 + ai * 128 + (mb + mm) * 16);
#pragma unroll
        for (int bj = 0; bj < 2; ++bj) {
          sv[mm][bj] = *(const u32x4*)(sg + row * 3072 + col0 + bj * 128);
          if (n > 0) {
            pa[mm][bj][0] = *(const pg8::f32x4*)(mrd + row * D + col0 + bj * 128);
            pa[mm][bj][1] = *(const pg8::f32x4*)(mrd + row * D + col0 + bj * 128 + 4);
          }
        }
      }
#pragma unroll
      for (int mm = 0; mm < 2; ++mm) {
        const size_t row = (size_t)(row0 + ai * 128 + (mb + mm) * 16);
#pragma unroll
        for (int bj = 0; bj < 2; ++bj) {
          pg8::f32x4 v0 = acc[ai][bj][mb + mm][0], v1 = acc[ai][bj][mb + mm][1];
          v0[0] *= bflo(sv[mm][bj].x); v0[1] *= bfhi(sv[mm][bj].x); v0[2] *= bflo(sv[mm][bj].y); v0[3] *= bfhi(sv[mm][bj].y);
          v1[0] *= bflo(sv[mm][bj].z); v1[1] *= bfhi(sv[mm][bj].z); v1[2] *= bflo(sv[mm][bj].w); v1[3] *= bfhi(sv[mm][bj].w);
          if (n > 0) { v0 += pa[mm][bj][0]; v1 += pa[mm][bj][1]; }
          if (n < 2) {
            *(pg8::f32x4*)(mwr + row * D + col0 + bj * 128) = v0;
            *(pg8::f32x4*)(mwr + row * D + col0 + bj * 128 + 4) = v1;
          } else {
            u32x4 w; w.x = pack2(v0[0], v0[1]); w.y = pack2(v0[2], v0[3]); w.z = pack2(v1[0], v1[1]); w.w = pack2(v1[2], v1[3]);
            *(u32x4*)(hb + row * D + col0 + bj * 128) = w;
          }
        }
      }
    }
  }
};

DI void phase_merge(CParams& p, int chunk, int l, char* lds) {
  const int NB = p.NB, RL = NB * S;
  const bool last = (l == DEPTH - 1);
  pg8::Gemm g{p.Z, p.WbT + (size_t)l * 3 * D * D, RL, 3 * D, D, 3072};
  MergeOrder Mo; Mo.init(RL, (int)gridDim.x, (int)blockIdx.x);
  EpiMerge E{&p};
  pg8::gemm_phase<EpiMerge, MergeOrder, false>((PG8_LAS unsigned char*)lds, g, Mo, E, nullptr);
  if (!last) merge_tiles_ctx(p, l, lds);
}

struct EpiOut {
  static constexpr bool PERM = false, AFTER_DRAIN = false;
  CParams* kp; int chunk, l;
  __device__ __forceinline__ void operator()(const pg8::f32x4 (&acc)[2][2][4][2], const pg8::Unit& u, int wr, int wc, int fr, int fq) const {
    const int NB = kp->NB, RL = NB * S;
    const int gr0 = u.pm * 256;
    const float* src; float* dst; int mrow;
    if (gr0 < RL) {
      const int b = gr0 / S, t = gr0 % S, bg = chunk * NB + b;
      const size_t off = ((size_t)bg * S + t) * D;
      src = (l == 0 ? kp->x : kp->out) + off; dst = kp->out + off; mrow = bg;
    } else {
      const int rc = gr0 - RL, b = rc / L, t = rc % L, bg = chunk * NB + b;
      const size_t off = ((size_t)bg * L + t) * D;
      src = (l == 0 ? kp->ctx : kp->xc) + off; dst = kp->xc + off; mrow = 16;
    }
    const int col0 = u.pn * 256 + wc * 32 + 4 * fq;
    const float* gate = kp->modv + ((size_t)l * 17 + mrow) * 3072 + 2048 + col0;
    pg8::f32x4 gv[2][2];
#pragma unroll
    for (int bj = 0; bj < 2; ++bj)
#pragma unroll
      for (int n = 0; n < 2; ++n) gv[bj][n] = *(const pg8::f32x4*)(gate + bj * 128 + n * 16);
    const int row0 = wr * 64 + fr;
#pragma unroll
    for (int ai = 0; ai < 2; ++ai)
#pragma unroll
      for (int m = 0; m < 4; ++m) {
        const size_t ro = (size_t)(row0 + ai * 128 + m * 16) * D + col0;
        pg8::f32x4 xv[2][2];
#pragma unroll
        for (int bj = 0; bj < 2; ++bj)
#pragma unroll
          for (int n = 0; n < 2; ++n) xv[bj][n] = *(const pg8::f32x4*)(src + ro + bj * 128 + n * 16);
#pragma unroll
        for (int bj = 0; bj < 2; ++bj)
#pragma unroll
          for (int n = 0; n < 2; ++n) {
            pg8::f32x4 o = xv[bj][n] + gv[bj][n] * acc[ai][bj][m][n];
            *(pg8::f32x4*)(dst + ro + bj * 128 + n * 16) = o;
          }
      }
  }
};

DI void phase_outproj(CParams& p, int chunk, int l, char* lds) {
  const int NB = p.NB, RL = NB * S, R = NB * (S + L);
  const bool last = (l == DEPTH - 1);
  const int rows = last ? RL : R;
  pg8::Gemm g{p.Hb, p.WoT + (size_t)l * D * D, rows, D, D, D};
  pg8::StaticOrder So; So.init(rows, D, (int)gridDim.x, (int)blockIdx.x);
  EpiOut E{&p, chunk, l};
  pg8::gemm_phase<EpiOut, pg8::StaticOrder, false>((PG8_LAS unsigned char*)lds, g, So, E, nullptr);
}

DI void phase_final(CParams& p) {
  const int tid_ = otid();
  const int lane = tid_ & 63;
  const int wg = blockIdx.x * 8 + (tid_ >> 6), nw = gridDim.x * 8;
  for (int r = wg; r < NBATCH * S; r += nw) {
    float* src = p.out + (size_t)r * D;
    float4 v[4]; float ss = 0.f;
#pragma unroll
    for (int i = 0; i < 4; ++i) {
      v[i] = *(const float4*)(src + i * 256 + lane * 4);
      ss += v[i].x * v[i].x + v[i].y * v[i].y + v[i].z * v[i].z + v[i].w * v[i].w;
    }
#pragma unroll
    for (int o = 32; o >= 1; o >>= 1) ss += __shfl_xor(ss, o);
    float rstd = rsqrtf(ss * (1.f / D) + EPS);
#pragma unroll
    for (int i = 0; i < 4; ++i) {
      int cidx = i * 256 + lane * 4;
      float4 gg = *(const float4*)(p.final_g + cidx);
      float4 o;
      o.x = v[i].x * rstd * gg.x; o.y = v[i].y * rstd * gg.y; o.z = v[i].z * rstd * gg.z; o.w = v[i].w * rstd * gg.w;
      *(float4*)(src + cidx) = o;
    }
  }
}

#ifndef DUP_PHASE
#define DUP_PHASE 0
#endif
__global__ void __launch_bounds__(NTHR, 2) fwd_megakernel(Params p_unused) {
  CParams* kp = (CParams*)__builtin_amdgcn_kernarg_segment_ptr();
  cg::grid_group grid = cg::this_grid();
  __shared__ __attribute__((aligned(16))) char lds[LDS_BYTES];
  phase0(*opaque_kp(kp), lds);
  grid.sync();
  phase_mod(*opaque_kp(kp), lds);
  grid.sync();
  for (int chunk = 0; chunk < kp->nchunk; ++chunk) {
    for (int l = 0; l < DEPTH; ++l) {
      phase_prenorm(*opaque_kp(kp), chunk, l);
      grid.sync();
#if DUP_PHASE == 9
      grid.sync(); grid.sync(); grid.sync(); grid.sync(); grid.sync();
#endif
      phase_gemm_in(*opaque_kp(kp), chunk, l, lds);
      grid.sync();
#if DUP_PHASE == 3
      phase_gemm_in(*opaque_kp(kp), chunk, l, lds);
      grid.sync();
#endif
#if DUP_PHASE == 4
      phase_mixers(*opaque_kp(kp), chunk, l, lds, 1);
      grid.sync();
#endif
#if DUP_PHASE == 6
      phase_mixers(*opaque_kp(kp), chunk, l, lds, 2);
      grid.sync();
#endif
      phase_mixers(*opaque_kp(kp), chunk, l, lds);
      grid.sync();
      phase_merge(*opaque_kp(kp), chunk, l, lds);
      grid.sync();
#if DUP_PHASE == 5
      phase_merge(*opaque_kp(kp), chunk, l, lds);
      grid.sync();
#endif
      phase_outproj(*opaque_kp(kp), chunk, l, lds);
      grid.sync();
    }
  }
  phase_final(*opaque_kp(kp));
}

extern "C" void kernel_launch(void* const* d_in, const int* in_sizes, int n_in,
                              void* d_out, int out_size, void* d_ws, size_t ws_size,
                              hipStream_t stream) {
  static int grid_blocks = 0;
  if (!grid_blocks) {
    int dev = 0, cus = 0, per_cu = 0;
    (void)hipGetDevice(&dev);
    (void)hipDeviceGetAttribute(&cus, hipDeviceAttributeMultiprocessorCount, dev);
    (void)hipOccupancyMaxActiveBlocksPerMultiprocessor(&per_cu, fwd_megakernel, NTHR, 0);
    if (per_cu > 1) per_cu = 1;
    if (per_cu < 1) per_cu = 1;
    grid_blocks = cus * per_cu;
  }
  Params p{};
  const float* const* in = (const float* const*)d_in;
  p.x = in[0]; p.c = in[1]; p.ctx = in[2]; p.c_ctx = in[3]; p.norm_g = in[4]; p.w_mod = in[5]; p.b_mod = in[6];
  p.w_in = in[7]; p.conv_w = in[8]; p.conv_b = in[9]; p.lru_wa = in[10]; p.lru_ba = in[11]; p.lru_wx = in[12];
  p.lru_bx = in[13]; p.lru_lambda = in[14]; p.attn_sink = in[15]; p.q_norm_g = in[16]; p.k_norm_g = in[17];
  p.w_branch = in[18]; p.w_out = in[19]; p.final_g = in[20];
  p.out = (float*)d_out;
  char* ws = (char*)d_ws;
  size_t off = 0;
  auto take = [&](size_t bytes) { char* r = ws + off; off += (bytes + 255) & ~(size_t)255; return r; };
  p.ctr = (int*)take(256);
  p.modv = (float*)take((size_t)DEPTH * 17 * 3072 * 4);
  p.sc = (float*)take((size_t)17 * D * 4);
  p.rope = (float*)take(4096 * 4);
  p.xc = (float*)take((size_t)NBATCH * L * D * 4);
  p.WinT = (u16*)take((size_t)DEPTH * INW * D * 2);
  p.WbT = (u16*)take((size_t)DEPTH * 3 * D * D * 2);
  p.WoT = (u16*)take((size_t)DEPTH * D * D * 2);
  const size_t fixed = off;
  int NB = 8;
  while (NB > 1) {
    size_t R = (size_t)NB * (S + L);
    size_t need = fixed + R * (size_t)(1024 + 1024 + 3072 + 2048 + 512 + 512 + 3072) * 2 + 8 * 256;
    if (need <= ws_size) break;
    NB >>= 1;
  }
  p.NB = NB; p.nchunk = NBATCH / NB;
  const size_t R = (size_t)NB * (S + L);
  p.Hb = (u16*)take(R * 1024 * 2);
  p.U = (u16*)take(R * 1024 * 2);
  p.Z = (u16*)take(R * 3072 * 2);
  p.Q = (u16*)take(R * 2048 * 2);
  p.Kb = (u16*)take(R * 512 * 2);
  p.VtL = (u16*)take((size_t)NB * 4 * 128 * S * 2);
  p.VtC = (u16*)take((size_t)NB * 4 * 128 * L * 2);
  p.Ms = (u16*)take(R * 3072 * 2);
  void* args[] = {&p};
  hipError_t e = hipLaunchCooperativeKernel((void*)fwd_megakernel, dim3(grid_blocks), dim3(NTHR), args, 0, stream);
  if (e != hipSuccess) fprintf(stderr, "cooperative launch failed: %s (grid %d)\n", hipGetErrorString(e), grid_blocks);
}
```

```cpp
#include <hip/hip_runtime.h>
#include <hip/hip_cooperative_groups.h>
#include <cstdio>
#include <cstdint>
namespace cg = cooperative_groups;

typedef unsigned short u16;
typedef __attribute__((ext_vector_type(8))) short bf16x8;
typedef __attribute__((ext_vector_type(4))) short s16x4;
typedef __attribute__((ext_vector_type(16))) float f32x16;
typedef __bf16 bf16x2_t __attribute__((ext_vector_type(2)));
typedef float float2_t __attribute__((ext_vector_type(2)));
typedef __attribute__((ext_vector_type(4))) unsigned u32x4;
typedef __attribute__((ext_vector_type(2))) unsigned u32x2;

#define DI __device__ __forceinline__
#define MFMA32(a, b, c) __builtin_amdgcn_mfma_f32_32x32x16_bf16((a), (b), (c), 0, 0, 0)

constexpr int D = 1024, NBATCH = 16, S = 4096, L = 256, DEPTH = 4, INW = 10240;
constexpr int LDS_BYTES = 147456;
constexpr int NTHR = 512;
constexpr float EPS = 1e-6f;
constexpr float QSCALE = 0.08838834764831845f * 1.4426950408889634f;
constexpr float LOG2E = 1.4426950408889634f;

struct Params {
  const float *x, *c, *ctx, *c_ctx, *norm_g, *w_mod, *b_mod, *w_in, *conv_w, *conv_b, *lru_wa, *lru_ba, *lru_wx, *lru_bx,
      *lru_lambda, *attn_sink, *q_norm_g, *k_norm_g, *w_branch, *w_out, *final_g;
  float* out;
  u16 *WinT, *WbT, *WoT;
  u16 *Hb, *U, *Z, *Q, *Kb, *VtL, *VtC, *Ms;
  float *modv, *sc, *rope, *xc;
  int* ctr;
  int NB;
  int nchunk;
};

typedef const __attribute__((address_space(4))) Params CParams;
DI CParams* opaque_kp(CParams* q) { asm volatile("" : "+s"(q)); return q; }

DI unsigned pack2(float a, float b) {
  float2_t f = {a, b};
  bf16x2_t v = __builtin_convertvector(f, bf16x2_t);
  return __builtin_bit_cast(unsigned, v);
}
DI float bf2f(u16 v) { return __uint_as_float(((unsigned)v) << 16); }
DI float bflo(unsigned v) { return __uint_as_float(v << 16); }
DI float bfhi(unsigned v) { return __uint_as_float(v & 0xffff0000u); }
DI float sigmoidf_(float x) { return __builtin_amdgcn_rcpf(1.f + __expf(-x)); }
DI float siluf_(float x) { return x * __builtin_amdgcn_rcpf(1.f + __expf(-x)); }
DI int otid() { int t = threadIdx.x; asm volatile("" : "+v"(t)); return t; }
DI int crow(int i, int hh) { return (i & 3) + 8 * (i >> 2) + 4 * hh; }

DI void phase0(CParams& p, char* lds) {
  const int tid = otid();
  float* tile = (float*)lds;
  const int n_in = DEPTH * 16 * 160, n_b = DEPTH * 3 * 256, n_o = DEPTH * 256;
  for (int it = blockIdx.x; it < n_in + n_b + n_o; it += gridDim.x) {
    const float* src; u16* dst; int ldsrc; int dstride = 64;
    if (it < n_in) {
      int l = it / 2560, rem = it % 2560, kt = rem / 160, nt = rem % 160;
      src = p.w_in + (size_t)l * D * INW + (size_t)(kt * 64) * INW + nt * 64; ldsrc = INW;
      const int o = nt >> 2;
      const int n256 = (o < 8) ? o : (o >= 28) ? 16 + (o - 28) : (o >= 24) ? 12 + (o - 24) : (o == 23) ? 39 : (o == 22) ? 38
                     : (o >= 18) ? 34 + (o - 18) : (o >= 14) ? 8 + (o - 14) : (o == 13) ? 33 : (o == 12) ? 32 : 28 + (o - 8);
      dst = p.WinT + (size_t)l * INW * D + ((size_t)n256 * 256 + (nt & 3) * 64) * D + kt * 64; dstride = D;
    } else if (it < n_in + n_b) {
      int i2 = it - n_in; int mat = i2 / 256, rem = i2 % 256, kt = rem / 16, nt = rem % 16;
      src = p.w_branch + (size_t)mat * D * D + (size_t)(kt * 64) * D + nt * 64; ldsrc = D;
      dst = p.WbT + (size_t)mat * D * D + (size_t)(nt * 64) * D + kt * 64; dstride = D;
    } else {
      int i2 = it - n_in - n_b; int mat = i2 / 256, rem = i2 % 256, kt = rem / 16, nt = rem % 16;
      src = p.w_out + (size_t)mat * D * D + (size_t)(kt * 64) * D + nt * 64; ldsrc = D;
      dst = p.WoT + (size_t)mat * D * D + (size_t)(nt * 64) * D + kt * 64; dstride = D;
    }
    __syncthreads();
#pragma unroll
    for (int i = 0; i < 2; ++i) {
      int c = tid + NTHR * i; int row = c >> 4, c4 = c & 15;
      float4 v = *(const float4*)(src + (size_t)row * ldsrc + c4 * 4);
      float* t = tile + row * 65 + c4 * 4;
      t[0] = v.x; t[1] = v.y; t[2] = v.z; t[3] = v.w;
    }
    __syncthreads();
    {
      int c = tid; int nrow = c >> 3, k8 = c & 7;
      float v[8];
#pragma unroll
      for (int j = 0; j < 8; ++j) v[j] = tile[(k8 * 8 + j) * 65 + nrow];
      uint4 o; o.x = pack2(v[0], v[1]); o.y = pack2(v[2], v[3]); o.z = pack2(v[4], v[5]); o.w = pack2(v[6], v[7]);
      *(uint4*)(dst + (size_t)nrow * dstride + k8 * 8) = o;
    }
  }
  const int gt = blockIdx.x * NTHR + tid, gn = gridDim.x * NTHR;
  for (int i = gt; i < 17 * D; i += gn) {
    int r = i / D, k = i % D;
    float v = (r < 16) ? p.c[r * D + k] : p.c_ctx[k];
    p.sc[i] = siluf_(v);
  }
  for (int i = gt; i < 64 * 32; i += gn) {
    int pos = i >> 5, pp = i & 31;
    float inv = powf(10000.f, -(float)pp / 32.f);
    float ang = (float)pos * inv;
    p.rope[i] = cosf(ang);
    p.rope[2048 + i] = sinf(ang);
  }
  if (blockIdx.x == 0 && tid < 64) p.ctr[tid] = 0;
}

DI void phase_mod(CParams& p, char* lds) {
  const int tid = otid();
  float* red = (float*)lds;
  const int col = tid & 63, kg = tid >> 6;
  for (int it = blockIdx.x; it < DEPTH * 48; it += gridDim.x) {
    int l = it / 48, cb = it % 48;
    float acc[17];
#pragma unroll
    for (int r = 0; r < 17; ++r) acc[r] = 0.f;
    const float* w = p.w_mod + (size_t)l * D * 3072 + cb * 64 + col;
    for (int k = kg * 128; k < kg * 128 + 128; ++k) {
      float wv = w[(size_t)k * 3072];
#pragma unroll
      for (int r = 0; r < 17; ++r) acc[r] += p.sc[r * D + k] * wv;
    }
    __syncthreads();
#pragma unroll
    for (int r = 0; r < 17; ++r) red[(kg * 17 + r) * 64 + col] = acc[r];
    __syncthreads();
    for (int i = tid; i < 17 * 64; i += NTHR) {
      int r = i >> 6, cc = i & 63;
      float s = 0.f;
#pragma unroll
      for (int g = 0; g < 8; ++g) s += red[(g * 17 + r) * 64 + cc];
      p.modv[((size_t)l * 17 + r) * 3072 + cb * 64 + cc] = s + p.b_mod[l * 3072 + cb * 64 + cc];
    }
  }
}

DI void phase_prenorm(CParams& p, int chunk, int l) {
  const int NB = p.NB, RL = NB * S, R = NB * (S + L);
  const int tid_ = otid();
  const int lane = tid_ & 63;
  const int wg = blockIdx.x * 8 + (tid_ >> 6), nw = gridDim.x * 8;
  const float* g = p.norm_g + l * D;
  for (int r = wg; r < R; r += nw) {
    const float* src; int mrow;
    if (r < RL) {
      int b = r / S, t = r % S; int bg = chunk * NB + b;
      src = (l == 0 ? p.x : p.out) + ((size_t)bg * S + t) * D; mrow = bg;
    } else {
      int rc = r - RL; int b = rc / L, t = rc % L; int bg = chunk * NB + b;
      src = (l == 0 ? p.ctx : p.xc) + ((size_t)bg * L + t) * D; mrow = 16;
    }
    const float* mv = p.modv + ((size_t)l * 17 + mrow) * 3072;
    float4 v[4]; float ss = 0.f;
#pragma unroll
    for (int i = 0; i < 4; ++i) {
      v[i] = *(const float4*)(src + i * 256 + lane * 4);
      ss += v[i].x * v[i].x + v[i].y * v[i].y + v[i].z * v[i].z + v[i].w * v[i].w;
    }
#pragma unroll
    for (int o = 32; o >= 1; o >>= 1) ss += __shfl_xor(ss, o);
    float rstd = rsqrtf(ss * (1.f / D) + EPS);
#pragma unroll
    for (int i = 0; i < 4; ++i) {
      int cidx = i * 256 + lane * 4;
      float4 gg = *(const float4*)(g + cidx);
      float4 sh = *(const float4*)(mv + cidx);
      float4 scl = *(const float4*)(mv + 1024 + cidx);
      float h0 = v[i].x * rstd * gg.x * (1.f + scl.x) + sh.x;
      float h1 = v[i].y * rstd * gg.y * (1.f + scl.y) + sh.y;
      float h2 = v[i].z * rstd * gg.z * (1.f + scl.z) + sh.z;
      float h3 = v[i].w * rstd * gg.w * (1.f + scl.w) + sh.w;
      uint2 o; o.x = pack2(h0, h1); o.y = pack2(h2, h3);
      *(uint2*)(p.Hb + (size_t)r * D + cidx) = o;
    }
  }
}

template <int BN, bool PIPE>
DI void gemm_core(const u16* A, int lda, int ksa, size_t a_blk, const u16* Bt, int ldb, int ksb, size_t b_blk, int K, char* ldsc,
                  f32x16 (&acc)[BN / 64][2]) {
  constexpr int MI = BN / 64;
  constexpr int SS = 32768 + BN * 128;
  const int tid = otid(), lane = tid & 63, w = tid >> 6;
  const int wm = (BN == 256) ? (w >> 2) : (w >> 1), wn = (BN == 256) ? (w & 3) : (w & 1);
  const int r = lane & 31, hh = lane >> 5;
  const int drow = lane >> 3, dcp = lane & 7;
  const int chunk0 = dcp ^ (drow >> 1);
  const u16* gAe = A + (size_t)(w >> 2) * a_blk + (size_t)((w & 3) * 32 + drow) * lda + chunk0 * 8;
  const u16* gAo = gAe + (size_t)8 * lda + ((chunk0 ^ 4) - chunk0) * 8;
  const size_t a16 = (size_t)16 * lda;
  const int brow0 = (BN == 256) ? (w & 3) * 32 : w * 16;
  const u16* gBe = Bt + ((BN == 256) ? (size_t)(w >> 2) * b_blk : (size_t)0) + (size_t)(brow0 + drow) * ldb + chunk0 * 8;
  const u16* gBo = gBe + (size_t)8 * ldb + ((chunk0 ^ 4) - chunk0) * 8;
  const size_t b16 = (size_t)16 * ldb;
#pragma unroll
  for (int i = 0; i < MI; ++i)
#pragma unroll
    for (int j = 0; j < 2; ++j)
#pragma unroll
      for (int x = 0; x < 16; ++x) acc[i][j][x] = 0.f;
  auto DMA = [&](int kt, int stage) {
    char* sa = ldsc + stage * SS + (w * 4) * 1024;
    char* sb = ldsc + stage * SS + 32768 + ((BN == 256) ? (w * 4) : (w * 2)) * 1024;
    const size_t ka = (size_t)kt * ksa, kb = (size_t)kt * ksb;
    __builtin_amdgcn_global_load_lds((const unsigned*)(gAe + ka), (unsigned*)(sa), 16, 0, 0);
    __builtin_amdgcn_global_load_lds((const unsigned*)(gBe + kb), (unsigned*)(sb), 16, 0, 0);
    __builtin_amdgcn_global_load_lds((const unsigned*)(gAo + ka), (unsigned*)(sa + 1024), 16, 0, 0);
    __builtin_amdgcn_global_load_lds((const unsigned*)(gBo + kb), (unsigned*)(sb + 1024), 16, 0, 0);
    __builtin_amdgcn_global_load_lds((const unsigned*)(gAe + a16 + ka), (unsigned*)(sa + 2048), 16, 0, 0);
    __builtin_amdgcn_global_load_lds((const unsigned*)(gAo + a16 + ka), (unsigned*)(sa + 3072), 16, 0, 0);
    if (BN == 256) {
      __builtin_amdgcn_global_load_lds((const unsigned*)(gBe + b16 + kb), (unsigned*)(sb + 2048), 16, 0, 0);
      __builtin_amdgcn_global_load_lds((const unsigned*)(gBo + b16 + kb), (unsigned*)(sb + 3072), 16, 0, 0);
    }
  };
  const int sw = (r >> 1) & 7;
  int koff[4];
#pragma unroll
  for (int ks = 0; ks < 4; ++ks) koff[ks] = ((2 * ks + hh) ^ sw) << 4;
  auto COMPUTE = [&](int stage) {
    const char* ab = ldsc + stage * SS + (wm * (MI * 32) + r) * 128;
    const char* bb = ldsc + stage * SS + 32768 + (wn * 64 + r) * 128;
    bf16x8 fa[2][MI], fb[2][2];
    auto LDF = [&](int ks, int slot) {
#pragma unroll
      for (int i = 0; i < MI; ++i) fa[slot][i] = *(const bf16x8*)(ab + i * 32 * 128 + koff[ks]);
#pragma unroll
      for (int j = 0; j < 2; ++j) fb[slot][j] = *(const bf16x8*)(bb + j * 32 * 128 + koff[ks]);
    };
    auto MM = [&](int slot) {
#pragma unroll
      for (int i = 0; i < MI; ++i)
#pragma unroll
        for (int j = 0; j < 2; ++j) acc[i][j] = MFMA32(fb[slot][j], fa[slot][i], acc[i][j]);
    };
    if (!PIPE) {
#pragma unroll
      for (int ks = 0; ks < 4; ++ks) { LDF(ks, 0); MM(0); }
      return;
    }
    LDF(0, 0); LDF(1, 1);
    __builtin_amdgcn_sched_barrier(0);
    MM(0); LDF(2, 0);
    __builtin_amdgcn_sched_barrier(0);
    MM(1); LDF(3, 1);
    __builtin_amdgcn_sched_barrier(0);
    MM(0); MM(1);
  };
  const int KT = K >> 6;
  __syncthreads();
  DMA(0, 0);
  __syncthreads();
  for (int kt = 0; kt < KT; kt += 2) {
    DMA(kt + 1, 1);
    COMPUTE(0);
    __syncthreads();
    if (kt + 2 < KT) DMA(kt + 2, 0);
    COMPUTE(1);
    __syncthreads();
  }
}

template <int MI>
DI void stage_acc(char* ldsc, f32x16 (&acc)[MI][2], int wm, int ncol0, bool active) {
  const int tid = otid(), lane = tid & 63;
  const int r = lane & 31, hh = lane >> 5;
  float* Cs = (float*)ldsc;
  if (active) {
#pragma unroll
    for (int i = 0; i < MI; ++i)
#pragma unroll
      for (int j = 0; j < 2; ++j)
#pragma unroll
        for (int g = 0; g < 4; ++g) {
          int m = wm * (MI * 32) + i * 32 + r;
          int n = ncol0 + j * 32 + 8 * g + 4 * hh;
          float4 v; v.x = acc[i][j][4 * g]; v.y = acc[i][j][4 * g + 1]; v.z = acc[i][j][4 * g + 2]; v.w = acc[i][j][4 * g + 3];
          *(float4*)(Cs + m * 132 + n) = v;
        }
  }
  __syncthreads();
}

DI void read_row64(const char* ldsc, int row, int half, float (&v)[64]) {
  const float* Cs = (const float*)ldsc + row * 132 + half * 64;
#pragma unroll
  for (int j = 0; j < 16; ++j) {
    float4 t = *(const float4*)(Cs + j * 4);
    v[j * 4] = t.x; v[j * 4 + 1] = t.y; v[j * 4 + 2] = t.z; v[j * 4 + 3] = t.w;
  }
}

DI void store_row64_bf16(u16* dst, const float (&v)[64]) {
#pragma unroll
  for (int j = 0; j < 8; ++j) {
    uint4 o;
    o.x = pack2(v[j * 8], v[j * 8 + 1]); o.y = pack2(v[j * 8 + 2], v[j * 8 + 3]);
    o.z = pack2(v[j * 8 + 4], v[j * 8 + 5]); o.w = pack2(v[j * 8 + 6], v[j * 8 + 7]);
    *(uint4*)(dst + j * 8) = o;
  }
}

namespace pg8 {
#define PG8_LAS __attribute__((address_space(3)))
typedef unsigned short bf16_t;
typedef short bf16x8 __attribute__((ext_vector_type(8)));
typedef float f32x4 __attribute__((ext_vector_type(4)));
typedef unsigned u32x4 __attribute__((ext_vector_type(4)));
constexpr int BM = 256, BK = 64, HALF = 128, HTB = HALF * BK * 2  , STAGE_BYTES = 8 * HTB, NXCD = 8, WGM = 8;

__host__ __device__ __forceinline__ int lds_byte(int r, int c) { const int st = (r >> 4) * 2 + (c >> 5), rr = r & 15, cc = c & 31, ob = rr * 64 + cc * 2; return st * 1024 + (ob ^ (((ob >> 9) & 1) << 5)); }
__host__ __device__ __forceinline__ void stage_rc(int b, int& R, int& C) { const int st = b / 1024, sb = b % 1024, swz = sb ^ (((sb >> 9) & 1) << 5); R = (st >> 1) * 16 + swz / 64; C = (st & 1) * 32 + (swz % 64) / 2; }
__host__ __device__ __forceinline__ int perm32(int rho) { const int n = rho >> 4, i = rho & 15; return 8 * (i >> 2) + 4 * n + (i & 3); }
struct Unit { int pm, pn; };
struct Gemm { const bf16_t* A; const bf16_t* Bt; int M, N, K; int lda; };
struct StaticOrder {
    int nM, nN, nwg, G, c;
    __host__ __device__ void init(int M, int N, int G_, int c_) { nM = M / BM; nN = N / BM; nwg = nM * nN; G = G_; c = c_; }
    __host__ __device__ bool next(int i, Unit& u) const {
        const long L = (long)i * G + c; if (L >= nwg) return false;
        int wgid = (int)L; { const int q = nwg / NXCD, r = nwg % NXCD, xcd = wgid % NXCD, off = wgid / NXCD; wgid = (xcd < r ? xcd * (q + 1) : r * (q + 1) + (xcd - r) * q) + off; }
        const int nig = WGM * nN, gid = wgid / nig, fm = gid * WGM, gsz = (nM - fm) < WGM ? (nM - fm) : WGM;
        u.pm = fm + ((wgid % nig) % gsz); u.pn = (wgid % nig) / gsz; return true;
    }
    __device__ __forceinline__ void a_ready(const Unit&) const {}
    __device__ __forceinline__ void done(const Unit&) const {}
    __device__ __forceinline__ size_t a_off(const Unit&) const { return 0; }
};
template <class Epi, class Sched, bool STAMP = false>
__device__ __forceinline__ void gemm_phase(PG8_LAS unsigned char* lds, const Gemm g, const Sched& S, const Epi& E, unsigned long long* stamps) {
    int tid_raw = threadIdx.x; asm volatile("" : "+v"(tid_raw));
    const int tid = tid_raw, wid = __builtin_amdgcn_readfirstlane(tid >> 6), lane = tid & 63, wr = wid >> 2, wc = wid & 3, fr = lane & 15, fq = lane >> 4;
    const int K = g.K, nt = K / BK;
    int ts_lo = 0, ts_hi = 0, nts = 0; const unsigned long long rt_entry = STAMP ? (unsigned long long)wall_clock64() : 0ull;
#define PG8_STAMP() do { if (STAMP && wid == 0 && nts < 64) { const unsigned long long _c = (unsigned long long)clock64(); \
        ts_lo = (lane == nts) ? (int)(unsigned)_c : ts_lo; ts_hi = (lane == nts) ? (int)(unsigned)(_c >> 32) : ts_hi; ++nts; } } while (0)
    PG8_STAMP();
    unsigned voffA[2], voffB[2];
#pragma unroll
    for (int i = 0; i < 2; ++i) { int R, C; stage_rc(tid * 16 + i * 8192, R, C); const int Rb = Epi::PERM ? ((R & ~31) + perm32(R & 31)) : R;
        voffA[i] = (unsigned)(R * g.lda + C) * 2u; voffB[i] = (unsigned)(Rb * K + C) * 2u; }
    const size_t kstep = (size_t)(BK * 2);
    const size_t hstep = (size_t)HALF * K * 2;
    const size_t tstep = 2 * hstep;
    const size_t hstepA = (size_t)HALF * g.lda * 2, tstepA = 2 * hstepA;
    const unsigned ldsw = (unsigned)wid * 1024u;
    const int aoff = lds_byte(wr * 64 + fr, fq * 8), boff = lds_byte(wc * 32 + fr, fq * 8);
#define PG8_SA(b, h) (((b) * 2 + (h)) * HTB)
#define PG8_SB(b, h) ((4 + (b) * 2 + (h)) * HTB)
#define PG8_STAGE(bufoff, gbase, voff) do { _Pragma("unroll") for (int _i = 0; _i < 2; ++_i) \
        __builtin_amdgcn_global_load_lds((const unsigned*)((const char*)(gbase) + (voff)[_i]), (PG8_LAS unsigned*)(lds + (bufoff) + ldsw + _i * 8192), 16, 0, 0); } while (0)
#define PG8_LDA(dst, b, h) do { _Pragma("unroll") for (int m = 0; m < 4; ++m) _Pragma("unroll") for (int k = 0; k < 2; ++k) dst[m][k] = *(const PG8_LAS bf16x8*)(lds + PG8_SA(b, h) + aoff + m * 2048 + k * 1024); } while (0)
#define PG8_LDB(dst, b, h) do { _Pragma("unroll") for (int n = 0; n < 2; ++n) _Pragma("unroll") for (int k = 0; k < 2; ++k) dst[n][k] = *(const PG8_LAS bf16x8*)(lds + PG8_SB(b, h) + boff + n * 2048 + k * 1024); } while (0)
#define PG8_MMA(ai, bj, At, Bt) do { __builtin_amdgcn_s_setprio(1); _Pragma("unroll") for (int m = 0; m < 4; ++m) _Pragma("unroll") for (int n = 0; n < 2; ++n) _Pragma("unroll") for (int k = 0; k < 2; ++k) \
        acc[ai][bj][m][n] = __builtin_amdgcn_mfma_f32_16x16x32_bf16(Bt[n][k], At[m][k], acc[ai][bj][m][n], 0, 0, 0); __builtin_amdgcn_s_setprio(0); } while (0)
#define PG8_WAIT_V(n) asm volatile("s_waitcnt vmcnt(" #n ")" ::: "memory")
#define PG8_WAIT_L(n) asm volatile("s_waitcnt lgkmcnt(" #n ")" ::: "memory")
#define PG8_BAR __builtin_amdgcn_s_barrier()
#define PG8_SCHED __builtin_amdgcn_sched_barrier(0)
    Unit cur, nxt; int ui = 0;
    if (!S.next(0, cur)) return;
    f32x4 acc[2][2][4][2];
#pragma unroll
    for (int a = 0; a < 2; ++a)
#pragma unroll
        for (int b = 0; b < 2; ++b)
#pragma unroll
            for (int m = 0; m < 4; ++m)
#pragma unroll
                for (int n = 0; n < 2; ++n) acc[a][b][m][n] = (f32x4){0.f, 0.f, 0.f, 0.f};
    bf16x8 At[4][2], B0[2][2], B1[2][2];
    const char* cA = (const char*)g.A + (size_t)cur.pm * tstepA + S.a_off(cur); const char* cB = (const char*)g.Bt + (size_t)cur.pn * tstep;
    S.a_ready(cur);
    PG8_STAGE(PG8_SB(0, 0), cB, voffB); PG8_STAGE(PG8_SA(0, 0), cA, voffA); PG8_STAGE(PG8_SB(0, 1), cB + hstep, voffB); PG8_STAGE(PG8_SA(0, 1), cA + hstepA, voffA);
    if (wr == 1) PG8_BAR;
    PG8_WAIT_V(4); PG8_BAR;
    PG8_STAGE(PG8_SB(1, 0), cB + kstep, voffB); PG8_STAGE(PG8_SA(1, 0), cA + kstep, voffA); PG8_STAGE(PG8_SB(1, 1), cB + hstep + kstep, voffB);
    PG8_WAIT_V(6); PG8_BAR;
    PG8_STAMP();
    for (;;) {
        const bool has_next = S.next(ui + 1, nxt);
        const char* nA = has_next ? (const char*)g.A + (size_t)nxt.pm * tstepA + S.a_off(nxt) : cA; const char* nB = has_next ? (const char*)g.Bt + (size_t)nxt.pn * tstep : cB;
        for (int t = 0; t < nt; t += 2) {
            const bool last = (t == nt - 2);
            const char* a1 = cA + (size_t)(t + 1) * kstep;
            const char* a2 = last ? nA : cA + (size_t)(t + 2) * kstep; const char* b2 = last ? nB : cB + (size_t)(t + 2) * kstep;
            const char* a3 = a2 + kstep; const char* b3 = b2 + kstep;
            if (last && has_next) S.a_ready(nxt);
            PG8_LDB(B0, 0, 0); PG8_SCHED; PG8_LDA(At, 0, 0); PG8_STAGE(PG8_SA(1, 1), a1 + hstepA, voffA);
            PG8_WAIT_L(8); PG8_BAR; PG8_WAIT_L(0); PG8_MMA(0, 0, At, B0); PG8_BAR; PG8_SCHED;
            PG8_LDB(B1, 0, 1); PG8_STAGE(PG8_SB(0, 0), b2, voffB);
            PG8_BAR; PG8_WAIT_L(0); PG8_MMA(0, 1, At, B1); PG8_BAR;
            PG8_LDA(At, 0, 1); PG8_STAGE(PG8_SA(0, 0), a2, voffA);
            PG8_BAR; PG8_WAIT_L(0); PG8_MMA(1, 0, At, B0); PG8_BAR; PG8_SCHED;
            PG8_STAGE(PG8_SB(0, 1), b2 + hstep, voffB);
            PG8_WAIT_V(6); PG8_BAR; PG8_MMA(1, 1, At, B1); PG8_BAR;
            PG8_LDB(B0, 1, 0); PG8_SCHED; PG8_LDA(At, 1, 0); PG8_STAGE(PG8_SA(0, 1), a2 + hstepA, voffA);
            PG8_WAIT_L(8); PG8_BAR; PG8_WAIT_L(0); PG8_MMA(0, 0, At, B0); PG8_BAR; PG8_SCHED;
            PG8_LDB(B1, 1, 1); PG8_STAGE(PG8_SB(1, 0), b3, voffB);
            PG8_BAR; PG8_WAIT_L(0); PG8_MMA(0, 1, At, B1); PG8_BAR;
            PG8_LDA(At, 1, 1); PG8_STAGE(PG8_SA(1, 0), a3, voffA);
            PG8_BAR; PG8_WAIT_L(0); PG8_MMA(1, 0, At, B0); PG8_BAR; PG8_SCHED;
            PG8_STAGE(PG8_SB(1, 1), b3 + hstep, voffB);
            PG8_WAIT_V(6); PG8_BAR; PG8_MMA(1, 1, At, B1); PG8_BAR;
        }
        PG8_STAMP();
        if constexpr (!Epi::AFTER_DRAIN) { E(acc, cur, wr, wc, fr, fq); S.done(cur); }
        PG8_STAMP();
        if (!has_next) break;
#pragma unroll
        for (int a = 0; a < 2; ++a)
#pragma unroll
            for (int b = 0; b < 2; ++b)
#pragma unroll
                for (int m = 0; m < 4; ++m)
#pragma unroll
                    for (int n = 0; n < 2; ++n) acc[a][b][m][n] = (f32x4){0.f, 0.f, 0.f, 0.f};
        cur = nxt; cA = nA; cB = nB; ++ui;
    }
    PG8_WAIT_V(0);
    if (wr == 0) PG8_BAR;
    PG8_BAR;
    if constexpr (Epi::AFTER_DRAIN) { E.fused(acc, cur, wr, wc, fr, fq, lds, wid, lane); S.done(cur); }
    PG8_STAMP();
    if (STAMP && wid == 0) { stamps[lane] = lane < nts ? (((unsigned long long)(unsigned)ts_hi << 32) | (unsigned)ts_lo) : 0ull;
        if (lane == 62) stamps[62] = rt_entry; if (lane == 63) stamps[63] = (unsigned long long)wall_clock64(); }
#undef PG8_STAMP
#undef PG8_SA
#undef PG8_SB
#undef PG8_STAGE
#undef PG8_LDA
#undef PG8_LDB
#undef PG8_MMA
#undef PG8_WAIT_V
#undef PG8_WAIT_L
#undef PG8_BAR
#undef PG8_SCHED
}
}

struct EpiIn {
  static constexpr bool PERM = true, AFTER_DRAIN = false;
  CParams* kp;
  __device__ __forceinline__ void operator()(const pg8::f32x4 (&acc)[2][2][4][2], const pg8::Unit& u, int wr, int wc, int fr, int fq) const {
    const int pn = u.pn;
    u16* base; int ld, mode;
    if (pn < 4) { base = kp->U + pn * 256; ld = D; mode = 0; }
    else if (pn < 16) { base = kp->Z + (pn - 4) * 256; ld = 3072; mode = 1; }
    else { base = kp->Ms + (pn - 16) * 256; ld = 3072; mode = 2; }
    const int row0 = u.pm * 256 + wr * 64 + fr;
    const int col0 = wc * 32 + 8 * fq;
    u16* rowp0 = base + (size_t)row0 * ld + col0;
#pragma unroll
    for (int ai = 0; ai < 2; ++ai)
#pragma unroll
      for (int m = 0; m < 4; ++m)
#pragma unroll
        for (int bj = 0; bj < 2; ++bj)
#pragma unroll
          for (int n = 0; n < 2; ++n) {
            pg8::f32x4 v0 = acc[ai][bj][m][n];
            if (mode == 1) {
#pragma unroll
              for (int j = 0; j < 4; ++j) v0[j] = siluf_(v0[j]);
            } else if (mode == 2) {
#pragma unroll
              for (int j = 0; j < 4; ++j) v0[j] = sigmoidf_(v0[j]);
            }
            u32x2 w; w.x = pack2(v0[0], v0[1]); w.y = pack2(v0[2], v0[3]);
            *(u32x2*)(rowp0 + (size_t)(ai * 128 + m * 16) * ld + bj * 128 + n * 4) = w;
          }
  }
};

DI bool tile_map(int i, int MT, int NT, int& mt, int& nt) {
  const int G = gridDim.x, bid = blockIdx.x;
  if ((G & 63) == 0 && (MT & 7) == 0 && (NT % (G >> 6)) == 0) {
    const int SH = G >> 6;
    const int xcd = bid & 7, slot = bid >> 3;
    const int sx = slot & 7, sy = slot >> 3;
    const int nsn = NT / SH, nsm = MT >> 3;
    const int st = i * 8 + xcd;
    if (st >= nsm * nsn) return false;
    mt = (st / nsn) * 8 + sx;
    nt = (st % nsn) * SH + sy;
    return true;
  }
  const int it = bid + i * G;
  if (it >= MT * NT) return false;
  mt = it / NT; nt = it % NT;
  return true;
}


struct OneUnit {
  int pm, pn;
  __device__ bool next(int i, pg8::Unit& u) const { if (i) return false; u.pm = pm; u.pn = pn; return true; }
  __device__ __forceinline__ void a_ready(const pg8::Unit&) const {}
  __device__ __forceinline__ void done(const pg8::Unit&) const {}
  __device__ __forceinline__ size_t a_off(const pg8::Unit&) const { return 0; }
};
struct EpiQKV {
  static constexpr bool PERM = false, AFTER_DRAIN = true;
  CParams* kp; char* lds; int l, nt, m0;
  __device__ __forceinline__ void fused(const pg8::f32x4 (&acc)[2][2][4][2], const pg8::Unit&, int wr, int wc, int fr, int fq,
                                        PG8_LAS unsigned char*, int, int) const {
    CParams& p = *kp;
    const int NB = p.NB, RL = NB * S;
    const int tid = otid();
    const bool lat = m0 < RL;
    int b, t0;
    if (lat) { b = m0 / S; t0 = m0 % S; } else { int rc = m0 - RL; b = rc / L; t0 = rc % L; }
    const bool isV = (nt == 13 || nt == 23);
    const bool isC = nt >= 18;
    const bool isQ = (nt >= 8 && nt < 12) || (nt >= 18 && nt < 22);
    auto process_unit = [&](int hsel, int u) {
      if (isV) {
        const int slot = (isC ? 2 : 0) + hsel;
        const int d = u >> 2, tq = u & 3;
        const float* Cs = (const float*)lds;
        u16* dst = lat ? p.VtL + ((size_t)(b * 4 + slot) * 128 + d) * S + t0 + tq * 64
                       : p.VtC + ((size_t)(b * 4 + slot) * 128 + d) * L + t0 + tq * 64;
#pragma unroll 1
        for (int c = 0; c < 4; ++c) {
          float v[16];
#pragma unroll
          for (int j = 0; j < 16; ++j) v[j] = Cs[(tq * 64 + c * 16 + j) * 132 + d];
          uint4 o0, o1;
          o0.x = pack2(v[0], v[1]); o0.y = pack2(v[2], v[3]); o0.z = pack2(v[4], v[5]); o0.w = pack2(v[6], v[7]);
          o1.x = pack2(v[8], v[9]); o1.y = pack2(v[10], v[11]); o1.z = pack2(v[12], v[13]); o1.w = pack2(v[14], v[15]);
          *(uint4*)(dst + c * 16) = o0;
          *(uint4*)(dst + c * 16 + 8) = o1;
        }
      } else {
        const int row = u >> 1, half = u & 1;
        const size_t gr = (size_t)m0 + row;
        const int t = t0 + row;
        const float* Cr = (const float*)lds + row * 132 + half * 64;
        float rstd = 1.f;
        const float* gn = (isQ ? p.q_norm_g : p.k_norm_g) + l * 128 + half * 64;
        if (isC) {
          float ss = 0.f;
#pragma unroll
          for (int j = 0; j < 16; ++j) {
            float4 tv = *(const float4*)(Cr + j * 4);
            ss += tv.x * tv.x + tv.y * tv.y + tv.z * tv.z + tv.w * tv.w;
          }
          ss += __shfl_xor(ss, 1);
          rstd = rsqrtf(ss * (1.f / 128.f) + EPS);
        }
        const int pos = (half == 0) ? (t >> 6) : (t & 63);
        const float* cs = p.rope + pos * 32;
        const float* sn = p.rope + 2048 + pos * 32;
        u16* dst;
        if (isQ) {
          const int head = (isC ? (nt - 18) : (nt - 8)) * 2 + hsel;
          dst = p.Q + gr * 2048 + (isC ? 1024 : 0) + head * 128 + half * 64;
        } else {
          dst = p.Kb + gr * 512 + (isC ? 256 : 0) + hsel * 128 + half * 64;
        }
#pragma unroll 1
        for (int c = 0; c < 2; ++c) {
          float x0[16], x1[16];
#pragma unroll
          for (int j = 0; j < 4; ++j) {
            float4 ta_ = *(const float4*)(Cr + c * 16 + j * 4);
            float4 tb_ = *(const float4*)(Cr + 32 + c * 16 + j * 4);
            x0[4 * j] = ta_.x; x0[4 * j + 1] = ta_.y; x0[4 * j + 2] = ta_.z; x0[4 * j + 3] = ta_.w;
            x1[4 * j] = tb_.x; x1[4 * j + 1] = tb_.y; x1[4 * j + 2] = tb_.z; x1[4 * j + 3] = tb_.w;
          }
          if (isC) {
#pragma unroll
            for (int j = 0; j < 16; ++j) { x0[j] = x0[j] * rstd * gn[c * 16 + j]; x1[j] = x1[j] * rstd * gn[32 + c * 16 + j]; }
          }
          if (lat) {
#pragma unroll
            for (int j = 0; j < 16; ++j) {
              float c_ = cs[c * 16 + j], s_ = sn[c * 16 + j];
              float a0 = x0[j], a1 = x1[j];
              x0[j] = a0 * c_ - a1 * s_;
              x1[j] = a1 * c_ + a0 * s_;
            }
          }
          if (isQ) {
#pragma unroll
            for (int j = 0; j < 16; ++j) { x0[j] *= QSCALE; x1[j] *= QSCALE; }
          }
          uint4 o0, o1, o2, o3;
          o0.x = pack2(x0[0], x0[1]); o0.y = pack2(x0[2], x0[3]); o0.z = pack2(x0[4], x0[5]); o0.w = pack2(x0[6], x0[7]);
          o1.x = pack2(x0[8], x0[9]); o1.y = pack2(x0[10], x0[11]); o1.z = pack2(x0[12], x0[13]); o1.w = pack2(x0[14], x0[15]);
          o2.x = pack2(x1[0], x1[1]); o2.y = pack2(x1[2], x1[3]); o2.z = pack2(x1[4], x1[5]); o2.w = pack2(x1[6], x1[7]);
          o3.x = pack2(x1[8], x1[9]); o3.y = pack2(x1[10], x1[11]); o3.z = pack2(x1[12], x1[13]); o3.w = pack2(x1[14], x1[15]);
          *(uint4*)(dst + c * 16) = o0;
          *(uint4*)(dst + c * 16 + 8) = o1;
          *(uint4*)(dst + 32 + c * 16) = o2;
          *(uint4*)(dst + 32 + c * 16 + 8) = o3;
        }
      }
    };

#pragma unroll
    for (int bj = 0; bj < 2; ++bj) {
      float* Cs = (float*)lds;
#pragma unroll
      for (int ai = 0; ai < 2; ++ai)
#pragma unroll
        for (int m = 0; m < 4; ++m)
#pragma unroll
          for (int n = 0; n < 2; ++n) {
            const int row = ai * 128 + wr * 64 + m * 16 + fr;
            const int col = wc * 32 + n * 16 + fq * 4;
            pg8::f32x4 v = acc[ai][bj][m][n];
            float4 o; o.x = v[0]; o.y = v[1]; o.z = v[2]; o.w = v[3];
            *(float4*)(Cs + row * 132 + col) = o;
          }
      __syncthreads();
      process_unit(bj, tid);
      __syncthreads();
    }
  }
};

DI void phase_gemm_in(CParams& p, int chunk, int l, char* lds) {
  const int NB = p.NB, RL = NB * S, R = NB * (S + L);
  const int MT = R / 256;
  const u16* Wt = p.WinT + (size_t)l * INW * D;
  {
    pg8::Gemm g{p.Hb, Wt, R, 7168, D, D};
    pg8::StaticOrder So; So.init(R, 7168, (int)gridDim.x, (int)blockIdx.x);
    EpiIn E{&p};
    pg8::gemm_phase<EpiIn, pg8::StaticOrder, false>((PG8_LAS unsigned char*)lds, g, So, E, nullptr);
  }
  for (int ti = 0;; ++ti) {
    int mt, jt;
    if (!tile_map(ti, MT, 12, mt, jt)) break;
    const int nt = (jt < 6) ? 8 + jt : 12 + jt;
    pg8::Gemm g{p.Hb, Wt + (size_t)28 * 256 * D, R, 3072, D, D};
    OneUnit One{mt, jt};
    EpiQKV E{&p, lds, l, nt, mt * 256};
    pg8::gemm_phase<EpiQKV, OneUnit, false>((PG8_LAS unsigned char*)lds, g, One, E, nullptr);
  }
}

struct AttnArgs {
  const u16* q;
  u16* z;
  const u16* kctx;
  const u16* vctx;
  const u16* klat;
  const u16* vlat;
  int n_lat_tiles;
  int lat_key0;
  int q_t0;
  int band;
  int has_sink;
  float sink_l2;
  int dry;
  int fixedm;
  float mfix;
};

DI void attn_load_tile(const AttnArgs& a, int ti, u32x4 (&rk)[2], u32x4 (&rv)[2]) {
  const int tid = otid();
  const u16* kp; const u16* vp; int vs;
  if (ti < 4) { kp = a.kctx + (size_t)(ti * 64) * 512; vp = a.vctx + ti * 64; vs = L; }
  else { kp = a.klat + (size_t)((ti - 4) * 64) * 512; vp = a.vlat + (ti - 4) * 64; vs = S; }
#pragma unroll
  for (int i = 0; i < 2; ++i) {
    int c = tid + NTHR * i;
    rk[i] = *(const u32x4*)(kp + (size_t)(c >> 4) * 512 + (c & 15) * 8);
    rv[i] = *(const u32x4*)(vp + (size_t)(c >> 3) * vs + (c & 7) * 8);
  }
}
DI void attn_store_tile(u16* sK, u16* sV, const u32x4 (&rk)[2], const u32x4 (&rv)[2]) {
  const int tid = otid();
#pragma unroll
  for (int i = 0; i < 2; ++i) {
    int c = tid + NTHR * i;
    *(u32x4*)(sK + (c >> 4) * 136 + (c & 15) * 8) = rk[i];
    u16* vd = sV + (c >> 3) * 68 + (c & 7) * 8;
    { u32x2 t0 = {rv[i].x, rv[i].y}; *(u32x2*)(vd) = t0; }
    { u32x2 t1 = {rv[i].z, rv[i].w}; *(u32x2*)(vd + 4) = t1; }
  }
}

template <bool NS>
DI void attn_item(const AttnArgs& a, char* lds) {
  const int tid = otid(), lane = tid & 63, w = tid >> 6;
  const int r = lane & 31, hh = lane >> 5;
  constexpr int STG = 34816;
  const int ntiles = 4 + a.n_lat_tiles;

  bf16x8 qf[8];
  {
    const u16* qp = a.q + (size_t)(w * 32 + r) * 2048 + hh * 8;
#pragma unroll
    for (int ks = 0; ks < 8; ++ks) qf[ks] = *(const bf16x8*)(qp + ks * 16);
  }
  f32x16 O[4];
#pragma unroll
  for (int dt = 0; dt < 4; ++dt)
#pragma unroll
    for (int x = 0; x < 16; ++x) O[dt][x] = 0.f;
  float m = a.fixedm ? a.mfix : (a.has_sink ? a.sink_l2 : -1e30f);
  float lsum = (a.has_sink && hh == 0) ? 1.f : 0.f;
  const int qpos = a.q_t0 + w * 32 + r;

  auto QK = [&](int stage, f32x16 (&sc)[2]) {
    const u16* sK = (const u16*)(lds + stage * STG);
#pragma unroll
    for (int kt2 = 0; kt2 < 2; ++kt2) {
#pragma unroll
      for (int x = 0; x < 16; ++x) sc[kt2][x] = 0.f;
      const u16* kb = sK + (kt2 * 32 + r) * 136 + hh * 8;
#pragma unroll
      for (int ks = 0; ks < 8; ++ks) {
        bf16x8 ka = *(const bf16x8*)(kb + ks * 16);
        sc[kt2] = MFMA32(ka, qf[ks], sc[kt2]);
      }
    }
  };
  u32x4 rk[2], rv[2];
  auto STEP = [&](int ti, int st, f32x16 (&sc)[2], f32x16 (&sn)[2]) {
    const int st1 = (st == 2) ? 0 : st + 1, st2 = (st == 0) ? 2 : st - 1;
    if (ti + 2 < ntiles) attn_load_tile(a, ti + 2, rk, rv);
    if (ti + 1 < ntiles) QK(st1, sn);
    if (a.band && ti >= 4) {
      const int k0 = a.lat_key0 + (ti - 4) * 64;
#pragma unroll
      for (int kt2 = 0; kt2 < 2; ++kt2)
#pragma unroll
        for (int x = 0; x < 16; ++x) {
          int kp = k0 + kt2 * 32 + crow(x, hh);
          int dlt = kp - qpos; dlt = dlt < 0 ? -dlt : dlt;
          if (dlt > 128) sc[kt2][x] = -1e30f;
        }
    }
    if (!NS && !a.fixedm) {
      float mx = sc[0][0];
#pragma unroll
      for (int kt2 = 0; kt2 < 2; ++kt2)
#pragma unroll
        for (int x = 0; x < 16; ++x) mx = fmaxf(mx, sc[kt2][x]);
      mx = fmaxf(mx, __shfl_xor(mx, 32));
      if (__any(mx > m + 8.f)) {
        const float mnew = fmaxf(m, mx);
        const float alpha = __builtin_amdgcn_exp2f(m - mnew);
        m = mnew;
        lsum *= alpha;
#pragma unroll
        for (int dt = 0; dt < 4; ++dt)
#pragma unroll
          for (int x = 0; x < 16; ++x) O[dt][x] *= alpha;
      }
    }
    float ps = 0.f;
#pragma unroll
    for (int kt2 = 0; kt2 < 2; ++kt2)
#pragma unroll
      for (int x = 0; x < 16; ++x) { float pv = NS ? __builtin_amdgcn_exp2f(sc[kt2][x]) : __builtin_amdgcn_exp2f(sc[kt2][x] - m); sc[kt2][x] = pv; ps += pv; }
    lsum += ps;
    const u16* sV = (const u16*)(lds + st * STG + 17408);
#pragma unroll
    for (int kt2 = 0; kt2 < 2; ++kt2)
#pragma unroll
      for (int s2 = 0; s2 < 2; ++s2) {
        union { unsigned u[4]; bf16x8 v; } pf;
#pragma unroll
        for (int j = 0; j < 4; ++j) pf.u[j] = pack2(sc[kt2][8 * s2 + 2 * j], sc[kt2][8 * s2 + 2 * j + 1]);
        const u16* vb = sV + r * 68 + kt2 * 32 + 16 * s2 + 4 * hh;
#pragma unroll
        for (int dt = 0; dt < 4; ++dt) {
          s16x4 lo = *(const s16x4*)(vb + dt * 32 * 68);
          s16x4 hi = *(const s16x4*)(vb + dt * 32 * 68 + 8);
          bf16x8 va = __builtin_shufflevector(lo, hi, 0, 1, 2, 3, 4, 5, 6, 7);
          O[dt] = MFMA32(va, pf.v, O[dt]);
        }
      }
    if (ti + 2 < ntiles) attn_store_tile((u16*)(lds + st2 * STG), (u16*)(lds + st2 * STG + 17408), rk, rv);
    __syncthreads();
  };

  attn_load_tile(a, 0, rk, rv);
  __syncthreads();
  attn_store_tile((u16*)lds, (u16*)(lds + 17408), rk, rv);
  attn_load_tile(a, 1, rk, rv);
  attn_store_tile((u16*)(lds + STG), (u16*)(lds + STG + 17408), rk, rv);
  __syncthreads();
  f32x16 sA[2], sB[2];
  QK(0, sA);
  int st = 0;
  for (int ti = 0; ti < ntiles; ti += 2) {
    STEP(ti, st, sA, sB);
    st = (st == 2) ? 0 : st + 1;
    if (ti + 1 < ntiles) {
      STEP(ti + 1, st, sB, sA);
      st = (st == 2) ? 0 : st + 1;
    }
  }
  float ltot = lsum + __shfl_xor(lsum, 32);
  const float inv = 1.f / ltot;
  u16* zp = a.z + (size_t)(w * 32 + r) * 3072;
  u32x2 gv[4][4];
#pragma unroll
  for (int dt = 0; dt < 4; ++dt)
#pragma unroll
    for (int g4 = 0; g4 < 4; ++g4) gv[dt][g4] = *(const u32x2*)(zp + dt * 32 + 8 * g4 + 4 * hh);
#pragma unroll
  for (int dt = 0; dt < 4; ++dt)
#pragma unroll
    for (int g4 = 0; g4 < 4; ++g4) {
      int d0 = dt * 32 + 8 * g4 + 4 * hh;
      float y0 = O[dt][4 * g4 + 0] * inv * bflo(gv[dt][g4].x);
      float y1 = O[dt][4 * g4 + 1] * inv * bfhi(gv[dt][g4].x);
      float y2 = O[dt][4 * g4 + 2] * inv * bflo(gv[dt][g4].y);
      float y3 = O[dt][4 * g4 + 3] * inv * bfhi(gv[dt][g4].y);
      uint2 o; o.x = pack2(y0, y1); o.y = pack2(y2, y3);
      if (!a.dry || y0 != y0) *(uint2*)(zp + d0) = o;
    }
}

template <bool REV>
DI void lru_scan(float (&av)[2][16], float (&bv)[2][16], float& carry, int hh) {
  float segA[8], segB[8];
#pragma unroll
  for (int k = 0; k < 8; ++k) {
    const int mt = k >> 2, q = k & 3;
    float cA = 1.f, hl = 0.f;
#pragma unroll
    for (int jj = 0; jj < 4; ++jj) {
      const int j = REV ? 3 - jj : jj;
      const int i = 4 * q + j;
      hl = av[mt][i] * hl + bv[mt][i];
      cA *= av[mt][i];
      av[mt][i] = cA; bv[mt][i] = hl;
    }
    segA[k] = cA; segB[k] = hl;
  }
  float oA[8], oB[8];
#pragma unroll
  for (int k = 0; k < 8; ++k) { oA[k] = __shfl_xor(segA[k], 32); oB[k] = __shfl_xor(segB[k], 32); }
  float init[8];
  float st = carry;
#pragma unroll
  for (int kk = 0; kk < 8; ++kk) {
    const int k = REV ? 7 - kk : kk;
    const int first = REV ? 1 : 0;
    float A1 = (hh == first) ? segA[k] : oA[k];
    float B1 = (hh == first) ? segB[k] : oB[k];
    float st0 = st;
    st = A1 * st + B1;
    float A2 = (hh == first) ? oA[k] : segA[k];
    float B2 = (hh == first) ? oB[k] : segB[k];
    float st1 = st;
    st = A2 * st + B2;
    init[k] = (hh == first) ? st0 : st1;
  }
  carry = st;
#pragma unroll
  for (int k = 0; k < 8; ++k) {
    const int mt = k >> 2, q = k & 3;
#pragma unroll
    for (int j = 0; j < 4; ++j) {
      const int i = 4 * q + j;
      bv[mt][i] = bv[mt][i] + av[mt][i] * init[k];
    }
  }
}

DI void lru_item(CParams& p, int l, int b, int n, bool last, char* lds, int dry = 0) {
  const int NB = p.NB, RL = NB * S;
  const int tid = otid(), lane = tid & 63, w8 = tid >> 6;
  const int sub = __builtin_amdgcn_readfirstlane(w8 >> 2), w = w8 & 3;
  n = n + sub;
  lds += sub * 73728;
  const int dir = w >> 1, w2 = w & 1;
  const int tl = tid & 127;
  const int r = lane & 31, hh = lane >> 5;
  u16* sRaw = (u16*)lds + dir * (8704 / 2);
  u16* sUp = (u16*)(lds + 17408) + dir * (9216 / 2);
  float* sH = (float*)(lds + 35840) + w * (64 * 36);

  const int chb = n * 64;
  const int cp = (tl & 31) * 2, tg = tl >> 5;
  float cw0[4], cw1[4], cb0, cb1;
#pragma unroll
  for (int k = 0; k < 4; ++k) {
    cw0[k] = p.conv_w[((size_t)l * 4 + k) * D + chb + cp];
    cw1[k] = p.conv_w[((size_t)l * 4 + k) * D + chb + cp + 1];
  }
  cb0 = p.conv_b[l * D + chb + cp]; cb1 = p.conv_b[l * D + chb + cp + 1];
  bf16x8 waf[4], wxf[4];
  {
    const float* wa = p.lru_wa + (((size_t)(l * 2 + dir) * 16 + n) * 64) * 64;
    const float* wx = p.lru_wx + (((size_t)(l * 2 + dir) * 16 + n) * 64) * 64;
    const int e = 32 * w2 + r;
#pragma unroll
    for (int ks = 0; ks < 4; ++ks) {
      union { unsigned u[4]; bf16x8 v; } fa, fx;
#pragma unroll
      for (int j = 0; j < 4; ++j) {
        int d0 = ks * 16 + 8 * hh + 2 * j;
        fa.u[j] = pack2(wa[d0 * 64 + e], wa[(d0 + 1) * 64 + e]);
        fx.u[j] = pack2(wx[d0 * 64 + e], wx[(d0 + 1) * 64 + e]);
      }
      waf[ks] = fa.v; wxf[ks] = fx.v;
    }
  }
  const int che = chb + 32 * w2 + r;
  const float ba = p.lru_ba[(l * 2 + dir) * D + che];
  const float bx = p.lru_bx[(l * 2 + dir) * D + che];
  float c8sp;
  {
    float lam = p.lru_lambda[(l * 2 + dir) * D + che];
    float sp = (lam < -20.f) ? -lam : log1pf(expf(-lam));
    c8sp = 8.f * sp;
  }
  float carry = 0.f;

  auto step_tile = [&](int st, bool& isctx, int& tt) {
    if (dir == 0) { if (st < 4) { isctx = true; tt = st; } else { isctx = false; tt = st - 4; } }
    else { if (st < 4) { isctx = true; tt = 3 - st; } else { isctx = false; tt = 63 - (st - 4); } }
  };
  u32x4 pre[5];
  auto load_raw = [&](int st) {
    bool isctx; int tt; step_tile(st, isctx, tt);
    const int seqlen = isctx ? L : S;
    const size_t rowbase = isctx ? (size_t)RL + (size_t)b * L : (size_t)b * S;
    const int t0 = tt * 64;
#pragma unroll
    for (int i = 0; i < 5; ++i) {
      int c = tl + 128 * i;
      int rr = c >> 3, c16 = c & 7;
      int t = t0 - 2 + rr;
      u32x4 v = {0u, 0u, 0u, 0u};
      if (rr < 67 && t >= 0 && t < seqlen) v = *(const u32x4*)(p.U + (rowbase + t) * D + chb + c16 * 8);
      pre[i] = v;
    }
  };
  load_raw(0);
  __syncthreads();
  for (int st = 0; st < 68; ++st) {
    bool isctx; int tt; step_tile(st, isctx, tt);
    const size_t rowbase = isctx ? (size_t)RL + (size_t)b * L : (size_t)b * S;
    const int t0 = tt * 64;
#pragma unroll
    for (int i = 0; i < 5; ++i) {
      int c = tl + 128 * i;
      int rr = c >> 3, c16 = c & 7;
      if (rr < 67) *(u32x4*)(sRaw + rr * 64 + c16 * 8) = pre[i];
    }
    if (st + 1 < 68) load_raw(st + 1);
    __syncthreads();
    {
      const u16* rp = sRaw + (tg * 16) * 64 + cp;
      unsigned r0 = *(const unsigned*)(rp), r1 = *(const unsigned*)(rp + 64), r2 = *(const unsigned*)(rp + 128);
#pragma unroll
      for (int i = 0; i < 16; ++i) {
        unsigned r3 = *(const unsigned*)(rp + (i + 3) * 64);
        float o0 = cb0 + cw0[0] * bflo(r0) + cw0[1] * bflo(r1) + cw0[2] * bflo(r2) + cw0[3] * bflo(r3);
        float o1 = cb1 + cw1[0] * bfhi(r0) + cw1[1] * bfhi(r1) + cw1[2] * bfhi(r2) + cw1[3] * bfhi(r3);
        *(unsigned*)(sUp + (tg * 16 + i) * 72 + cp) = pack2(o0, o1);
        r0 = r1; r1 = r2; r2 = r3;
      }
    }
    __syncthreads();
    const bool fwd_first = isctx ? (tt <= 1) : (tt <= 31);
    const bool first = (dir == 0) ? fwd_first : !fwd_first;
    unsigned long long pt0[4], pt1[4];
    u32x4 pg[4];
    if (!first && !(isctx && last)) {
#pragma unroll
      for (int j = 0; j < 4; ++j) {
        const int q = lane + 64 * j;
        const int tok = q >> 2, cc = (q & 3) * 8;
        const size_t row = rowbase + t0 + tok;
        const int col = chb + 32 * w2 + cc;
        const u16* tp = p.Hb + row * D + col;
        pt0[j] = __hip_atomic_load((const unsigned long long*)tp, __ATOMIC_RELAXED, __HIP_MEMORY_SCOPE_AGENT);
        pt1[j] = __hip_atomic_load((const unsigned long long*)tp + 1, __ATOMIC_RELAXED, __HIP_MEMORY_SCOPE_AGENT);
        pg[j] = *(const u32x4*)(p.Z + row * 3072 + col);
      }
    } else {
#pragma unroll
      for (int j = 0; j < 4; ++j) { pt0[j] = 0; pt1[j] = 0; pg[j] = u32x4{0u, 0u, 0u, 0u}; }
    }
    float av[2][16], bv[2][16];
    {
      f32x16 aR[2];
#pragma unroll
      for (int mt = 0; mt < 2; ++mt) {
#pragma unroll
        for (int x = 0; x < 16; ++x) aR[mt][x] = 0.f;
        const u16* ub = sUp + (mt * 32 + r) * 72 + hh * 8;
#pragma unroll
        for (int ks = 0; ks < 4; ++ks) aR[mt] = MFMA32(*(const bf16x8*)(ub + ks * 16), waf[ks], aR[mt]);
      }
#pragma unroll
      for (int mt = 0; mt < 2; ++mt)
#pragma unroll
        for (int x = 0; x < 16; ++x) {
          const float rg = sigmoidf_(aR[mt][x] + ba);
          av[mt][x] = -c8sp * rg;
        }
    }
    {
      f32x16 aI[2];
#pragma unroll
      for (int mt = 0; mt < 2; ++mt) {
#pragma unroll
        for (int x = 0; x < 16; ++x) aI[mt][x] = 0.f;
        const u16* ub = sUp + (mt * 32 + r) * 72 + hh * 8;
#pragma unroll
        for (int ks = 0; ks < 4; ++ks) aI[mt] = MFMA32(*(const bf16x8*)(ub + ks * 16), wxf[ks], aI[mt]);
      }
#pragma unroll
      for (int mt = 0; mt < 2; ++mt)
#pragma unroll
        for (int x = 0; x < 16; ++x) {
          const int tok = mt * 32 + crow(x, hh);
          const float up = bf2f(sUp[tok * 72 + 32 * w2 + r]);
          const float ig = sigmoidf_(aI[mt][x] + bx);
          const float la = av[mt][x];
          const float a_ = __expf(la);
          const float om = fmaxf(1.f - a_ * a_, 0.f);
          av[mt][x] = a_;
          bv[mt][x] = __builtin_amdgcn_sqrtf(om) * (ig * up);
        }
    }
    if (dir == 0) lru_scan<false>(av, bv, carry, hh); else lru_scan<true>(av, bv, carry, hh);
#pragma unroll
    for (int mt = 0; mt < 2; ++mt)
#pragma unroll
      for (int x = 0; x < 16; ++x) sH[(mt * 32 + crow(x, hh)) * 36 + r] = bv[mt][x];
    if (!(isctx && last)) {
#pragma unroll
      for (int j = 0; j < 4; ++j) {
        const int q = lane + 64 * j;
        const int tok = q >> 2, cc = (q & 3) * 8;
        const float4 h0 = *(const float4*)(sH + tok * 36 + cc);
        const float4 h1 = *(const float4*)(sH + tok * 36 + cc + 4);
        const size_t row = rowbase + t0 + tok;
        const int col = chb + 32 * w2 + cc;
        u16* tp = p.Hb + row * D + col;
        if (first) {
          uint4 o; o.x = pack2(h0.x, h0.y); o.y = pack2(h0.z, h0.w); o.z = pack2(h1.x, h1.y); o.w = pack2(h1.z, h1.w);
          if (!dry || h0.x != h0.x) *(uint4*)tp = o;
        } else {
          unsigned tx = (unsigned)pt0[j], ty = (unsigned)(pt0[j] >> 32), tz = (unsigned)pt1[j], tw = (unsigned)(pt1[j] >> 32);
          u16* zp = p.Z + row * 3072 + col;
          u32x4 g = pg[j];
          uint4 o;
          o.x = pack2((h0.x + bflo(tx)) * bflo(g.x), (h0.y + bfhi(tx)) * bfhi(g.x));
          o.y = pack2((h0.z + bflo(ty)) * bflo(g.y), (h0.w + bfhi(ty)) * bfhi(g.y));
          o.z = pack2((h1.x + bflo(tz)) * bflo(g.z), (h1.y + bfhi(tz)) * bfhi(g.z));
          o.w = pack2((h1.z + bflo(tw)) * bflo(g.w), (h1.w + bfhi(tw)) * bfhi(g.w));
          if (!dry || h0.x != h0.x) *(uint4*)zp = o;
        }
      }
    }
    __builtin_amdgcn_fence(__ATOMIC_RELEASE, "workgroup");
  }
}

DI void phase_mixers(CParams& p, int chunk, int l, char* lds, int dry = 0) {
  const int NB = p.NB, RL = NB * S;
  const bool last = (l == DEPTH - 1);
  const int nLRU = (dry == 1) ? 0 : NB * 8, nC = (dry == 2) ? 0 : NB * 8 * 16, nBw = (dry == 2) ? 0 : NB * 8 * 16, nCtx = (last || dry == 2) ? 0 : NB * 8 * 2;
  const int total = nLRU + nC + nBw + nCtx;
  int* ctr = p.ctr + chunk * DEPTH + l + (dry ? 32 : 0);
  int* s_item = (int*)(lds + LDS_BYTES - 16);
  int it;
  while (true) {
    __syncthreads();
    if (threadIdx.x == 0) *s_item = atomicAdd(ctr, 1);
    __syncthreads();
    it = __builtin_amdgcn_readfirstlane(*s_item);
    __syncthreads();
    if (it >= nLRU) break;
    lru_item(p, l, it >> 3, (it & 7) * 2, last, lds, dry);
  }
  float gqm = 0.f, gkm = 0.f;
  {
    const int ln = otid() & 63;
    gqm = fmaxf(fabsf(p.q_norm_g[l * 128 + ln]), fabsf(p.q_norm_g[l * 128 + 64 + ln]));
    gkm = fmaxf(fabsf(p.k_norm_g[l * 128 + ln]), fabsf(p.k_norm_g[l * 128 + 64 + ln]));
#pragma unroll
    for (int o = 32; o >= 1; o >>= 1) { gqm = fmaxf(gqm, __shfl_xor(gqm, o)); gkm = fmaxf(gkm, __shfl_xor(gkm, o)); }
    gqm = __builtin_amdgcn_readfirstlane(gqm); gkm = __builtin_amdgcn_readfirstlane(gkm);
  }
  const float mfixC = 128.f * gqm * gkm * QSCALE;
  const int nCfast = (mfixC < 60.f) ? nC : 0;
  auto fetch = [&]() {
    __syncthreads();
    if (threadIdx.x == 0) *s_item = atomicAdd(ctr, 1);
    __syncthreads();
    it = __builtin_amdgcn_readfirstlane(*s_item);
    __syncthreads();
  };
  auto build = [&](int ir, AttnArgs& a) {
    a.dry = dry;
    if (ir < nC + nBw) {
      const bool isB = ir >= nC;
      if (isB) ir -= nC;
      const int b = ir >> 7, h = (ir >> 4) & 7, qb = ir & 15;
      const int kvh = h >> 2;
      const int br = isB ? 0 : 1;
      const size_t qrow0 = (size_t)b * S + qb * 256;
      a.q = p.Q + qrow0 * 2048 + br * 1024 + h * 128;
      a.z = p.Z + qrow0 * 3072 + (br + 1) * 1024 + h * 128;
      const int kcol = br * 256 + kvh * 128, slot = br * 2 + kvh;
      a.kctx = p.Kb + ((size_t)RL + (size_t)b * L) * 512 + kcol;
      a.vctx = p.VtC + (size_t)(b * 4 + slot) * 128 * L;
      int k0, k1;
      if (isB) { k0 = qb * 256 - 128; if (k0 < 0) k0 = 0; k1 = qb * 256 + 384; if (k1 > S) k1 = S; }
      else { k0 = 0; k1 = S; }
      a.lat_key0 = k0;
      a.n_lat_tiles = (k1 - k0) >> 6;
      a.klat = p.Kb + ((size_t)b * S + k0) * 512 + kcol;
      a.vlat = p.VtL + (size_t)(b * 4 + slot) * 128 * S + k0;
      a.q_t0 = qb * 256;
      a.band = isB ? 1 : 0;
      a.has_sink = isB ? 1 : 0;
      a.sink_l2 = isB ? p.attn_sink[l * 8 + h] * LOG2E : 0.f;
      a.fixedm = isB ? 0 : 1; a.mfix = mfixC;
    } else {
      ir -= nC + nBw;
      const int h = ir & 7, br = (ir >> 3) & 1, b = ir >> 4;
      const int kvh = h >> 2;
      const size_t qrow0 = (size_t)RL + (size_t)b * L;
      a.q = p.Q + qrow0 * 2048 + br * 1024 + h * 128;
      a.z = p.Z + qrow0 * 3072 + (br + 1) * 1024 + h * 128;
      const int kcol = br * 256 + kvh * 128, slot = br * 2 + kvh;
      a.kctx = p.Kb + ((size_t)RL + (size_t)b * L) * 512 + kcol;
      a.vctx = p.VtC + (size_t)(b * 4 + slot) * 128 * L;
      a.klat = a.kctx; a.vlat = a.vctx;
      a.n_lat_tiles = 0; a.lat_key0 = 0; a.q_t0 = 0; a.band = 0;
      a.has_sink = (br == 0) ? 1 : 0;
      a.sink_l2 = (br == 0) ? p.attn_sink[l * 8 + h] * LOG2E : 0.f;
      a.fixedm = (br == 0) ? 0 : 1; a.mfix = mfixC;
    }
  };
  while (it < nLRU + nCfast) {
    AttnArgs a;
    build(it - nLRU, a);
    attn_item<true>(a, lds);
    fetch();
  }
  while (it < total) {
    AttnArgs a;
    build(it - nLRU, a);
    attn_item<false>(a, lds);
    fetch();
  }
}

DI void merge_tiles_ctx(CParams& p, int l, char* lds) {
  const int NB = p.NB, RL = NB * S, R = NB * (S + L);
  const int MT = (R - RL) / 256, NT = 8;
  const int tid = otid();
  const int lane = tid & 63, w = tid >> 6, wm = w >> 1, wn = w & 1, r = lane & 31, hh = lane >> 5;
  for (int ti = 0;; ++ti) {
    int mt, nt;
    if (!tile_map(ti, MT, NT, mt, nt)) break;
    const int m0 = RL + mt * 256, n0 = nt * 128;
    f32x16 tot[2][2];
#pragma unroll
    for (int i = 0; i < 2; ++i)
#pragma unroll
      for (int j = 0; j < 2; ++j)
#pragma unroll
        for (int x = 0; x < 16; ++x) tot[i][j][x] = 0.f;
#pragma unroll 1
    for (int n = 0; n < 3; ++n) {
      f32x16 acc[2][2];
      gemm_core<128, false>(p.Z + (size_t)m0 * 3072 + n * 1024, 3072, 64, (size_t)128 * 3072,
                            p.WbT + ((size_t)(l * 3 + n) * D + n0) * D, D, 64, 0, D, lds, acc);
#pragma unroll
      for (int i = 0; i < 2; ++i)
#pragma unroll
        for (int j = 0; j < 2; ++j)
#pragma unroll
          for (int g = 0; g < 4; ++g) {
            const size_t row = (size_t)m0 + wm * 64 + i * 32 + r;
            const int col = n0 + wn * 64 + j * 32 + 8 * g + 4 * hh;
            uint2 sv = *(const uint2*)(p.Ms + row * 3072 + n * 1024 + col);
            tot[i][j][4 * g + 0] += bflo(sv.x) * acc[i][j][4 * g + 0];
            tot[i][j][4 * g + 1] += bfhi(sv.x) * acc[i][j][4 * g + 1];
            tot[i][j][4 * g + 2] += bflo(sv.y) * acc[i][j][4 * g + 2];
            tot[i][j][4 * g + 3] += bfhi(sv.y) * acc[i][j][4 * g + 3];
          }
    }
#pragma unroll
    for (int i = 0; i < 2; ++i)
#pragma unroll
      for (int j = 0; j < 2; ++j)
#pragma unroll
        for (int g = 0; g < 4; ++g) {
          const size_t row = (size_t)m0 + wm * 64 + i * 32 + r;
          const int col = n0 + wn * 64 + j * 32 + 8 * g + 4 * hh;
          uint2 o; o.x = pack2(tot[i][j][4 * g], tot[i][j][4 * g + 1]); o.y = pack2(tot[i][j][4 * g + 2], tot[i][j][4 * g + 3]);
          *(uint2*)(p.Hb + row * D + col) = o;
        }
  }
}

struct MergeOrder {
  pg8::StaticOrder inner;
  __device__ void init(int M, int G, int c) { inner.init(M, 1024, G, c); }
  __device__ bool next(int i, pg8::Unit& u) const {
    const int j = i / 3, n = i - 3 * j;
    pg8::Unit t;
    if (!inner.next(j, t)) return false;
    u.pm = t.pm; u.pn = n * 4 + t.pn;
    return true;
  }
  __device__ __forceinline__ void a_ready(const pg8::Unit&) const {}
  __device__ __forceinline__ void done(const pg8::Unit&) const {}
  __device__ __forceinline__ size_t a_off(const pg8::Unit& u) const { return (size_t)(u.pn >> 2) * 1024 * 2; }
};
struct EpiMerge {
  static constexpr bool PERM = true, AFTER_DRAIN = false;
  CParams* kp;
  __device__ __forceinline__ void operator()(const pg8::f32x4 (&acc)[2][2][4][2], const pg8::Unit& u, int wr, int wc, int fr, int fq) const {
    const int n = u.pn >> 2, ct = u.pn & 3;
    const int row0 = u.pm * 256 + wr * 64 + fr;
    const int col0 = ct * 256 + wc * 32 + 8 * fq;
    const u16* __restrict__ sg = kp->Ms + n * 1024;
    const float* __restrict__ mrd = (const float*)kp->Q;
    float* __restrict__ mwr = (float*)kp->Q;
    u16* __restrict__ hb = kp->Hb;
#pragma unroll
    for (int am = 0; am < 4; ++am) {
      const int ai = am >> 1, mb = (am & 1) * 2;
      u32x4 sv[2][2];
      pg8::f32x4 pa[2][2][2];
#pragma unroll
      for (int mm = 0; mm < 2; ++mm) {
        const size_t row = (size_t)(row0 + ai * 128 + (mb + mm) * 16);
#pragma unroll
        for (int bj = 0; bj < 2; ++bj) {
          sv[mm][bj] = *(const u32x4*)(sg + row * 3072 + col0 + bj * 128);
          if (n > 0) {
            pa[mm][bj][0] = *(const pg8::f32x4*)(mrd + row * D + col0 + bj * 128);
            pa[mm][bj][1] = *(const pg8::f32x4*)(mrd + row * D + col0 + bj * 128 + 4);
          }
        }
      }
#pragma unroll
      for (int mm = 0; mm < 2; ++mm) {
        const size_t row = (size_t)(row0 + ai * 128 + (mb + mm) * 16);
#pragma unroll
        for (int bj = 0; bj < 2; ++bj) {
          pg8::f32x4 v0 = acc[ai][bj][mb + mm][0], v1 = acc[ai][bj][mb + mm][1];
          v0[0] *= bflo(sv[mm][bj].x); v0[1] *= bfhi(sv[mm][bj].x); v0[2] *= bflo(sv[mm][bj].y); v0[3] *= bfhi(sv[mm][bj].y);
          v1[0] *= bflo(sv[mm][bj].z); v1[1] *= bfhi(sv[mm][bj].z); v1[2] *= bflo(sv[mm][bj].w); v1[3] *= bfhi(sv[mm][bj].w);
          if (n > 0) { v0 += pa[mm][bj][0]; v1 += pa[mm][bj][1]; }
          if (n < 2) {
            *(pg8::f32x4*)(mwr + row * D + col0 + bj * 128) = v0;
            *(pg8::f32x4*)(mwr + row * D + col0 + bj * 128 + 4) = v1;
          } else {
            u32x4 w; w.x = pack2(v0[0], v0[1]); w.y = pack2(v0[2], v0[3]); w.z = pack2(v1[0], v1[1]); w.w = pack2(v1[2], v1[3]);
            *(u32x4*)(hb + row * D + col0 + bj * 128) = w;
          }
        }
      }
    }
  }
};

DI void phase_merge(CParams& p, int chunk, int l, char* lds) {
  const int NB = p.NB, RL = NB * S;
  const bool last = (l == DEPTH - 1);
  pg8::Gemm g{p.Z, p.WbT + (size_t)l * 3 * D * D, RL, 3 * D, D, 3072};
  MergeOrder Mo; Mo.init(RL, (int)gridDim.x, (int)blockIdx.x);
  EpiMerge E{&p};
  pg8::gemm_phase<EpiMerge, MergeOrder, false>((PG8_LAS unsigned char*)lds, g, Mo, E, nullptr);
  if (!last) merge_tiles_ctx(p, l, lds);
}

struct EpiOut {
  static constexpr bool PERM = false, AFTER_DRAIN = false;
  CParams* kp; int chunk, l;
  __device__ __forceinline__ void operator()(const pg8::f32x4 (&acc)[2][2][4][2], const pg8::Unit& u, int wr, int wc, int fr, int fq) const {
    const int NB = kp->NB, RL = NB * S;
    const int gr0 = u.pm * 256;
    const float* src; float* dst; int mrow;
    if (gr0 < RL) {
      const int b = gr0 / S, t = gr0 % S, bg = chunk * NB + b;
      const size_t off = ((size_t)bg * S + t) * D;
      src = (l == 0 ? kp->x : kp->out) + off; dst = kp->out + off; mrow = bg;
    } else {
      const int rc = gr0 - RL, b = rc / L, t = rc % L, bg = chunk * NB + b;
      const size_t off = ((size_t)bg * L + t) * D;
      src = (l == 0 ? kp->ctx : kp->xc) + off; dst = kp->xc + off; mrow = 16;
    }
    const int col0 = u.pn * 256 + wc * 32 + 4 * fq;
    const float* gate = kp->modv + ((size_t)l * 17 + mrow) * 3072 + 2048 + col0;
    pg8::f32x4 gv[2][2];
#pragma unroll
    for (int bj = 0; bj < 2; ++bj)
#pragma unroll
      for (int n = 0; n < 2; ++n) gv[bj][n] = *(const pg8::f32x4*)(gate + bj * 128 + n * 16);
    const int row0 = wr * 64 + fr;
#pragma unroll
    for (int ai = 0; ai < 2; ++ai)
#pragma unroll
      for (int m = 0; m < 4; ++m) {
        const size_t ro = (size_t)(row0 + ai * 128 + m * 16) * D + col0;
        pg8::f32x4 xv[2][2];
#pragma unroll
        for (int bj = 0; bj < 2; ++bj)
#pragma unroll
          for (int n = 0; n < 2; ++n) xv[bj][n] = *(const pg8::f32x4*)(src + ro + bj * 128 + n * 16);
#pragma unroll
        for (int bj = 0; bj < 2; ++bj)
#pragma unroll
          for (int n = 0; n < 2; ++n) {
            pg8::f32x4 o = xv[bj][n] + gv[bj][n] * acc[ai][bj][m][n];
            *(pg8::f32x4*)(dst + ro + bj * 128 + n * 16) = o;
          }
      }
  }
};

DI void phase_outproj(CParams& p, int chunk, int l, char* lds) {
  const int NB = p.NB, RL = NB * S, R = NB * (S + L);
  const bool last = (l == DEPTH - 1);
  const int rows = last ? RL : R;
  pg8::Gemm g{p.Hb, p.WoT + (size_t)l * D * D, rows, D, D, D};
  pg8::StaticOrder So; So.init(rows, D, (int)gridDim.x, (int)blockIdx.x);
  EpiOut E{&p, chunk, l};
  pg8::gemm_phase<EpiOut, pg8::StaticOrder, false>((PG8_LAS unsigned char*)lds, g, So, E, nullptr);
}

DI void phase_final(CParams& p) {
  const int tid_ = otid();
  const int lane = tid_ & 63;
  const int wg = blockIdx.x * 8 + (tid_ >> 6), nw = gridDim.x * 8;
  for (int r = wg; r < NBATCH * S; r += nw) {
    float* src = p.out + (size_t)r * D;
    float4 v[4]; float ss = 0.f;
#pragma unroll
    for (int i = 0; i < 4; ++i) {
      v[i] = *(const float4*)(src + i * 256 + lane * 4);
      ss += v[i].x * v[i].x + v[i].y * v[i].y + v[i].z * v[i].z + v[i].w * v[i].w;
    }
#pragma unroll
    for (int o = 32; o >= 1; o >>= 1) ss += __shfl_xor(ss, o);
    float rstd = rsqrtf(ss * (1.f / D) + EPS);
#pragma unroll
    for (int i = 0; i < 4; ++i) {
      int cidx = i * 256 + lane * 4;
      float4 gg = *(const float4*)(p.final_g + cidx);
      float4 o;
      o.x = v[i].x * rstd * gg.x; o.y = v[i].y * rstd * gg.y; o.z = v[i].z * rstd * gg.z; o.w = v[i].w * rstd * gg.w;
      *(float4*)(src + cidx) = o;
    }
  }
}

#ifndef DUP_PHASE
#define DUP_PHASE 0
#endif
__global__ void __launch_bounds__(NTHR, 2) fwd_megakernel(Params p_unused) {
  CParams* kp = (CParams*)__builtin_amdgcn_kernarg_segment_ptr();
  cg::grid_group grid = cg::this_grid();
  __shared__ __attribute__((aligned(16))) char lds[LDS_BYTES];
  phase0(*opaque_kp(kp), lds);
  grid.sync();
  phase_mod(*opaque_kp(kp), lds);
  grid.sync();
  for (int chunk = 0; chunk < kp->nchunk; ++chunk) {
    for (int l = 0; l < DEPTH; ++l) {
      phase_prenorm(*opaque_kp(kp), chunk, l);
      grid.sync();
#if DUP_PHASE == 9
      grid.sync(); grid.sync(); grid.sync(); grid.sync(); grid.sync();
#endif
      phase_gemm_in(*opaque_kp(kp), chunk, l, lds);
      grid.sync();
#if DUP_PHASE == 3
      phase_gemm_in(*opaque_kp(kp), chunk, l, lds);
      grid.sync();
#endif
#if DUP_PHASE == 4
      phase_mixers(*opaque_kp(kp), chunk, l, lds, 1);
      grid.sync();
#endif
#if DUP_PHASE == 6
      phase_mixers(*opaque_kp(kp), chunk, l, lds, 2);
      grid.sync();
#endif
      phase_mixers(*opaque_kp(kp), chunk, l, lds);
      grid.sync();
      phase_merge(*opaque_kp(kp), chunk, l, lds);
      grid.sync();
#if DUP_PHASE == 5
      phase_merge(*opaque_kp(kp), chunk, l, lds);
      grid.sync();
#endif
      phase_outproj(*opaque_kp(kp), chunk, l, lds);
      grid.sync();
    }
  }
  phase_final(*opaque_kp(kp));
}

extern "C" void kernel_launch(void* const* d_in, const int* in_sizes, int n_in,
                              void* d_out, int out_size, void* d_ws, size_t ws_size,
                              hipStream_t stream) {
  static int grid_blocks = 0;
  if (!grid_blocks) {
    int dev = 0, cus = 0, per_cu = 0;
    (void)hipGetDevice(&dev);
    (void)hipDeviceGetAttribute(&cus, hipDeviceAttributeMultiprocessorCount, dev);
    (void)hipOccupancyMaxActiveBlocksPerMultiprocessor(&per_cu, fwd_megakernel, NTHR, 0);
    if (per_cu > 1) per_cu = 1;
    if (per_cu < 1) per_cu = 1;
    grid_blocks = cus * per_cu;
  }
  Params p{};
  const float* const* in = (const float* const*)d_in;
  p.x = in[0]; p.c = in[1]; p.ctx = in[2]; p.c_ctx = in[3]; p.norm_g = in[4]; p.w_mod = in[5]; p.b_mod = in[6];
  p.w_in = in[7]; p.conv_w = in[8]; p.conv_b = in[9]; p.lru_wa = in[10]; p.lru_ba = in[11]; p.lru_wx = in[12];
  p.lru_bx = in[13]; p.lru_lambda = in[14]; p.attn_sink = in[15]; p.q_norm_g = in[16]; p.k_norm_g = in[17];
  p.w_branch = in[18]; p.w_out = in[19]; p.final_g = in[20];
  p.out = (float*)d_out;
  char* ws = (char*)d_ws;
  size_t off = 0;
  auto take = [&](size_t bytes) { char* r = ws + off; off += (bytes + 255) & ~(size_t)255; return r; };
  p.ctr = (int*)take(256);
  p.modv = (float*)take((size_t)DEPTH * 17 * 3072 * 4);
  p.sc = (float*)take((size_t)17 * D * 4);
  p.rope = (float*)take(4096 * 4);
  p.xc = (float*)take((size_t)NBATCH * L * D * 4);
  p.WinT = (u16*)take((size_t)DEPTH * INW * D * 2);
  p.WbT = (u16*)take((size_t)DEPTH * 3 * D * D * 2);
  p.WoT = (u16*)take((size_t)DEPTH * D * D * 2);
  const size_t fixed = off;
  int NB = 8;
  while (NB > 1) {
    size_t R = (size_t)NB * (S + L);
    size_t need = fixed + R * (size_t)(1024 + 1024 + 3072 + 2048 + 512 + 512 + 3072) * 2 + 8 * 256;
    if (need <= ws_size) break;
    NB >>= 1;
  }
  p.NB = NB; p.nchunk = NBATCH / NB;
  const size_t R = (size_t)NB * (S + L);
  p.Hb = (u16*)take(R * 1024 * 2);
  p.U = (u16*)take(R * 1024 * 2);
  p.Z = (u16*)take(R * 3072 * 2);
  p.Q = (u16*)take(R * 2048 * 2);
  p.Kb = (u16*)take(R * 512 * 2);
  p.VtL = (u16*)take((size_t)NB * 4 * 128 * S * 2);
  p.VtC = (u16*)take((size_t)NB * 4 * 128 * L * 2);
  p.Ms = (u16*)take(R * 3072 * 2);
  void* args[] = {&p};
  hipError_t e = hipLaunchCooperativeKernel((void*)fwd_megakernel, dim3(grid_blocks), dim3(NTHR), args, 0, stream);
  if (e != hipSuccess) fprintf(stderr, "cooperative launch failed: %s (grid %d)\n", hipGetErrorString(e), grid_blocks);
}
```

```cpp
#include <hip/hip_runtime.h>
#include <hip/hip_cooperative_groups.h>
#include <cstdio>
#include <cstdint>
namespace cg = cooperative_groups;

typedef unsigned short u16;
typedef __attribute__((ext_vector_type(8))) short bf16x8;
typedef __attribute__((ext_vector_type(4))) short s16x4;
typedef __attribute__((ext_vector_type(16))) float f32x16;
typedef __bf16 bf16x2_t __attribute__((ext_vector_type(2)));
typedef float float2_t __attribute__((ext_vector_type(2)));
typedef __attribute__((ext_vector_type(4))) unsigned u32x4;
typedef __attribute__((ext_vector_type(2))) unsigned u32x2;

#define DI __device__ __forceinline__
#define MFMA32(a, b, c) __builtin_amdgcn_mfma_f32_32x32x16_bf16((a), (b), (c), 0, 0, 0)

constexpr int D = 1024, NBATCH = 16, S = 4096, L = 256, DEPTH = 4, INW = 10240;
constexpr int LDS_BYTES = 147456;
constexpr int NTHR = 512;
constexpr float EPS = 1e-6f;
constexpr float QSCALE = 0.08838834764831845f * 1.4426950408889634f;
constexpr float LOG2E = 1.4426950408889634f;

struct Params {
  const float *x, *c, *ctx, *c_ctx, *norm_g, *w_mod, *b_mod, *w_in, *conv_w, *conv_b, *lru_wa, *lru_ba, *lru_wx, *lru_bx,
      *lru_lambda, *attn_sink, *q_norm_g, *k_norm_g, *w_branch, *w_out, *final_g;
  float* out;
  u16 *WinT, *WbT, *WoT;
  u16 *Hb, *U, *Z, *Q, *Kb, *VtL, *VtC, *Ms;
  float *modv, *sc, *rope, *xc;
  int* ctr;
  int NB;
  int nchunk;
};

typedef const __attribute__((address_space(4))) Params CParams;
DI CParams* opaque_kp(CParams* q) { asm volatile("" : "+s"(q)); return q; }

DI unsigned pack2(float a, float b) {
  float2_t f = {a, b};
  bf16x2_t v = __builtin_convertvector(f, bf16x2_t);
  return __builtin_bit_cast(unsigned, v);
}
DI float bf2f(u16 v) { return __uint_as_float(((unsigned)v) << 16); }
DI float bflo(unsigned v) { return __uint_as_float(v << 16); }
DI float bfhi(unsigned v) { return __uint_as_float(v & 0xffff0000u); }
DI float sigmoidf_(float x) { return __builtin_amdgcn_rcpf(1.f + __expf(-x)); }
DI float siluf_(float x) { return x * __builtin_amdgcn_rcpf(1.f + __expf(-x)); }
DI int otid() { int t = threadIdx.x; asm volatile("" : "+v"(t)); return t; }
DI int crow(int i, int hh) { return (i & 3) + 8 * (i >> 2) + 4 * hh; }

DI void phase0(CParams& p, char* lds) {
  const int tid = otid();
  float* tile = (float*)lds;
  const int n_in = DEPTH * 16 * 160, n_b = DEPTH * 3 * 256, n_o = DEPTH * 256;
  for (int it = blockIdx.x; it < n_in + n_b + n_o; it += gridDim.x) {
    const float* src; u16* dst; int ldsrc; int dstride = 64;
    if (it < n_in) {
      int l = it / 2560, rem = it % 2560, kt = rem / 160, nt = rem % 160;
      src = p.w_in + (size_t)l * D * INW + (size_t)(kt * 64) * INW + nt * 64; ldsrc = INW;
      const int o = nt >> 2;
      const int n256 = (o < 8) ? o : (o >= 28) ? 16 + (o - 28) : (o >= 24) ? 12 + (o - 24) : (o == 23) ? 39 : (o == 22) ? 38
                     : (o >= 18) ? 34 + (o - 18) : (o >= 14) ? 8 + (o - 14) : (o == 13) ? 33 : (o == 12) ? 32 : 28 + (o - 8);
      dst = p.WinT + (size_t)l * INW * D + ((size_t)n256 * 256 + (nt & 3) * 64) * D + kt * 64; dstride = D;
    } else if (it < n_in + n_b) {
      int i2 = it - n_in; int mat = i2 / 256, rem = i2 % 256, kt = rem / 16, nt = rem % 16;
      src = p.w_branch + (size_t)mat * D * D + (size_t)(kt * 64) * D + nt * 64; ldsrc = D;
      dst = p.WbT + (size_t)mat * D * D + (size_t)(nt * 64) * D + kt * 64; dstride = D;
    } else {
      int i2 = it - n_in - n_b; int mat = i2 / 256, rem = i2 % 256, kt = rem / 16, nt = rem % 16;
      src = p.w_out + (size_t)mat * D * D + (size_t)(kt * 64) * D + nt * 64; ldsrc = D;
      dst = p.WoT + (size_t)mat * D * D + (size_t)(nt * 64) * D + kt * 64; dstride = D;
    }
    __syncthreads();
#pragma unroll
    for (int i = 0; i < 2; ++i) {
      int c = tid + NTHR * i; int row = c >> 4, c4 = c & 15;
      float4 v = *(const float4*)(src + (size_t)row * ldsrc + c4 * 4);
      float* t = tile + row * 65 + c4 * 4;
      t[0] = v.x; t[1] = v.y; t[2] = v.z; t[3] = v.w;
    }
    __syncthreads();
    {
      int c = tid; int nrow = c >> 3, k8 = c & 7;
      float v[8];
#pragma unroll
      for (int j = 0; j < 8; ++j) v[j] = tile[(k8 * 8 + j) * 65 + nrow];
      uint4 o; o.x = pack2(v[0], v[1]); o.y = pack2(v[2], v[3]); o.z = pack2(v[4], v[5]); o.w = pack2(v[6], v[7]);
      *(uint4*)(dst + (size_t)nrow * dstride + k8 * 8) = o;
    }
  }
  const int gt = blockIdx.x * NTHR + tid, gn = gridDim.x * NTHR;
  for (int i = gt; i < 17 * D; i += gn) {
    int r = i / D, k = i % D;
    float v = (r < 16) ? p.c[r * D + k] : p.c_ctx[k];
    p.sc[i] = siluf_(v);
  }
  for (int i = gt; i < 64 * 32; i += gn) {
    int pos = i >> 5, pp = i & 31;
    float inv = powf(10000.f, -(float)pp / 32.f);
    float ang = (float)pos * inv;
    p.rope[i] = cosf(ang);
    p.rope[2048 + i] = sinf(ang);
  }
  if (blockIdx.x == 0 && tid < 64) p.ctr[tid] = 0;
}

DI void phase_mod(CParams& p, char* lds) {
  const int tid = otid();
  float* red = (float*)lds;
  const int col = tid & 63, kg = tid >> 6;
  for (int it = blockIdx.x; it < DEPTH * 48; it += gridDim.x) {
    int l = it / 48, cb = it % 48;
    float acc[17];
#pragma unroll
    for (int r = 0; r < 17; ++r) acc[r] = 0.f;
    const float* w = p.w_mod + (size_t)l * D * 3072 + cb * 64 + col;
    for (int k = kg * 128; k < kg * 128 + 128; ++k) {
      float wv = w[(size_t)k * 3072];
#pragma unroll
      for (int r = 0; r < 17; ++r) acc[r] += p.sc[r * D + k] * wv;
    }
    __syncthreads();
#pragma unroll
    for (int r = 0; r < 17; ++r) red[(kg * 17 + r) * 64 + col] = acc[r];
    __syncthreads();
    for (int i = tid; i < 17 * 64; i += NTHR) {
      int r = i >> 6, cc = i & 63;
      float s = 0.f;
#pragma unroll
      for (int g = 0; g < 8; ++g) s += red[(g * 17 + r) * 64 + cc];
      p.modv[((size_t)l * 17 + r) * 3072 + cb * 64 + cc] = s + p.b_mod[l * 3072 + cb * 64 + cc];
    }
  }
}

DI void phase_prenorm(CParams& p, int chunk, int l) {
  const int NB = p.NB, RL = NB * S, R = NB * (S + L);
  const int tid_ = otid();
  const int lane = tid_ & 63;
  const int wg = blockIdx.x * 8 + (tid_ >> 6), nw = gridDim.x * 8;
  const float* g = p.norm_g + l * D;
  for (int r = wg; r < R; r += nw) {
    const float* src; int mrow;
    if (r < RL) {
      int b = r / S, t = r % S; int bg = chunk * NB + b;
      src = (l == 0 ? p.x : p.out) + ((size_t)bg * S + t) * D; mrow = bg;
    } else {
      int rc = r - RL; int b = rc / L, t = rc % L; int bg = chunk * NB + b;
      src = (l == 0 ? p.ctx : p.xc) + ((size_t)bg * L + t) * D; mrow = 16;
    }
    const float* mv = p.modv + ((size_t)l * 17 + mrow) * 3072;
    float4 v[4]; float ss = 0.f;
#pragma unroll
    for (int i = 0; i < 4; ++i) {
      v[i] = *(const float4*)(src + i * 256 + lane * 4);
      ss += v[i].x * v[i].x + v[i].y * v[i].y + v[i].z * v[i].z + v[i].w * v[i].w;
    }
#pragma unroll
    for (int o = 32; o >= 1; o >>= 1) ss += __shfl_xor(ss, o);
    float rstd = rsqrtf(ss * (1.f / D) + EPS);
#pragma unroll
    for (int i = 0; i < 4; ++i) {
      int cidx = i * 256 + lane * 4;
      float4 gg = *(const float4*)(g + cidx);
      float4 sh = *(const float4*)(mv + cidx);
      float4 scl = *(const float4*)(mv + 1024 + cidx);
      float h0 = v[i].x * rstd * gg.x * (1.f + scl.x) + sh.x;
      float h1 = v[i].y * rstd * gg.y * (1.f + scl.y) + sh.y;
      float h2 = v[i].z * rstd * gg.z * (1.f + scl.z) + sh.z;
      float h3 = v[i].w * rstd * gg.w * (1.f + scl.w) + sh.w;
      uint2 o; o.x = pack2(h0, h1); o.y = pack2(h2, h3);
      *(uint2*)(p.Hb + (size_t)r * D + cidx) = o;
    }
  }
}

template <int BN, bool PIPE>
DI void gemm_core(const u16* A, int lda, int ksa, size_t a_blk, const u16* Bt, int ldb, int ksb, size_t b_blk, int K, char* ldsc,
                  f32x16 (&acc)[BN / 64][2]) {
  constexpr int MI = BN / 64;
  constexpr int SS = 32768 + BN * 128;
  const int tid = otid(), lane = tid & 63, w = tid >> 6;
  const int wm = (BN == 256) ? (w >> 2) : (w >> 1), wn = (BN == 256) ? (w & 3) : (w & 1);
  const int r = lane & 31, hh = lane >> 5;
  const int drow = lane >> 3, dcp = lane & 7;
  const int chunk0 = dcp ^ (drow >> 1);
  const u16* gAe = A + (size_t)(w >> 2) * a_blk + (size_t)((w & 3) * 32 + drow) * lda + chunk0 * 8;
  const u16* gAo = gAe + (size_t)8 * lda + ((chunk0 ^ 4) - chunk0) * 8;
  const size_t a16 = (size_t)16 * lda;
  const int brow0 = (BN == 256) ? (w & 3) * 32 : w * 16;
  const u16* gBe = Bt + ((BN == 256) ? (size_t)(w >> 2) * b_blk : (size_t)0) + (size_t)(brow0 + drow) * ldb + chunk0 * 8;
  const u16* gBo = gBe + (size_t)8 * ldb + ((chunk0 ^ 4) - chunk0) * 8;
  const size_t b16 = (size_t)16 * ldb;
#pragma unroll
  for (int i = 0; i < MI; ++i)
#pragma unroll
    for (int j = 0; j < 2; ++j)
#pragma unroll
      for (int x = 0; x < 16; ++x) acc[i][j][x] = 0.f;
  auto DMA = [&](int kt, int stage) {
    char* sa = ldsc + stage * SS + (w * 4) * 1024;
    char* sb = ldsc + stage * SS + 32768 + ((BN == 256) ? (w * 4) : (w * 2)) * 1024;
    const size_t ka = (size_t)kt * ksa, kb = (size_t)kt * ksb;
    __builtin_amdgcn_global_load_lds((const unsigned*)(gAe + ka), (unsigned*)(sa), 16, 0, 0);
    __builtin_amdgcn_global_load_lds((const unsigned*)(gBe + kb), (unsigned*)(sb), 16, 0, 0);
    __builtin_amdgcn_global_load_lds((const unsigned*)(gAo + ka), (unsigned*)(sa + 1024), 16, 0, 0);
    __builtin_amdgcn_global_load_lds((const unsigned*)(gBo + kb), (unsigned*)(sb + 1024), 16, 0, 0);
    __builtin_amdgcn_global_load_lds((const unsigned*)(gAe + a16 + ka), (unsigned*)(sa + 2048), 16, 0, 0);
    __builtin_amdgcn_global_load_lds((const unsigned*)(gAo + a16 + ka), (unsigned*)(sa + 3072), 16, 0, 0);
    if (BN == 256) {
      __builtin_amdgcn_global_load_lds((const unsigned*)(gBe + b16 + kb), (unsigned*)(sb + 2048), 16, 0, 0);
      __builtin_amdgcn_global_load_lds((const unsigned*)(gBo + b16 + kb), (unsigned*)(sb + 3072), 16, 0, 0);
    }
  };
  const int sw = (r >> 1) & 7;
  int koff[4];
#pragma unroll
  for (int ks = 0; ks < 4; ++ks) koff[ks] = ((2 * ks + hh) ^ sw) << 4;
  auto COMPUTE = [&](int stage) {
    const char* ab = ldsc + stage * SS + (wm * (MI * 32) + r) * 128;
    const char* bb = ldsc + stage * SS + 32768 + (wn * 64 + r) * 128;
    bf16x8 fa[2][MI], fb[2][2];
    auto LDF = [&](int ks, int slot) {
#pragma unroll
      for (int i = 0; i < MI; ++i) fa[slot][i] = *(const bf16x8*)(ab + i * 32 * 128 + koff[ks]);
#pragma unroll
      for (int j = 0; j < 2; ++j) fb[slot][j] = *(const bf16x8*)(bb + j * 32 * 128 + koff[ks]);
    };
    auto MM = [&](int slot) {
#pragma unroll
      for (int i = 0; i < MI; ++i)
#pragma unroll
        for (int j = 0; j < 2; ++j) acc[i][j] = MFMA32(fb[slot][j], fa[slot][i], acc[i][j]);
    };
    if (!PIPE) {
#pragma unroll
      for (int ks = 0; ks < 4; ++ks) { LDF(ks, 0); MM(0); }
      return;
    }
    LDF(0, 0); LDF(1, 1);
    __builtin_amdgcn_sched_barrier(0);
    MM(0); LDF(2, 0);
    __builtin_amdgcn_sched_barrier(0);
    MM(1); LDF(3, 1);
    __builtin_amdgcn_sched_barrier(0);
    MM(0); MM(1);
  };
  const int KT = K >> 6;
  __syncthreads();
  DMA(0, 0);
  __syncthreads();
  for (int kt = 0; kt < KT; kt += 2) {
    DMA(kt + 1, 1);
    COMPUTE(0);
    __syncthreads();
    if (kt + 2 < KT) DMA(kt + 2, 0);
    COMPUTE(1);
    __syncthreads();
  }
}

template <int MI>
DI void stage_acc(char* ldsc, f32x16 (&acc)[MI][2], int wm, int ncol0, bool active) {
  const int tid = otid(), lane = tid & 63;
  const int r = lane & 31, hh = lane >> 5;
  float* Cs = (float*)ldsc;
  if (active) {
#pragma unroll
    for (int i = 0; i < MI; ++i)
#pragma unroll
      for (int j = 0; j < 2; ++j)
#pragma unroll
        for (int g = 0; g < 4; ++g) {
          int m = wm * (MI * 32) + i * 32 + r;
          int n = ncol0 + j * 32 + 8 * g + 4 * hh;
          float4 v; v.x = acc[i][j][4 * g]; v.y = acc[i][j][4 * g + 1]; v.z = acc[i][j][4 * g + 2]; v.w = acc[i][j][4 * g + 3];
          *(float4*)(Cs + m * 132 + n) = v;
        }
  }
  __syncthreads();
}

DI void read_row64(const char* ldsc, int row, int half, float (&v)[64]) {
  const float* Cs = (const float*)ldsc + row * 132 + half * 64;
#pragma unroll
  for (int j = 0; j < 16; ++j) {
    float4 t = *(const float4*)(Cs + j * 4);
    v[j * 4] = t.x; v[j * 4 + 1] = t.y; v[j * 4 + 2] = t.z; v[j * 4 + 3] = t.w;
  }
}

DI void store_row64_bf16(u16* dst, const float (&v)[64]) {
#pragma unroll
  for (int j = 0; j < 8; ++j) {
    uint4 o;
    o.x = pack2(v[j * 8], v[j * 8 + 1]); o.y = pack2(v[j * 8 + 2], v[j * 8 + 3]);
    o.z = pack2(v[j * 8 + 4], v[j * 8 + 5]); o.w = pack2(v[j * 8 + 6], v[j * 8 + 7]);
    *(uint4*)(dst + j * 8) = o;
  }
}

namespace pg8 {
#define PG8_LAS __attribute__((address_space(3)))
typedef unsigned short bf16_t;
typedef short bf16x8 __attribute__((ext_vector_type(8)));
typedef float f32x4 __attribute__((ext_vector_type(4)));
typedef unsigned u32x4 __attribute__((ext_vector_type(4)));
constexpr int BM = 256, BK = 64, HALF = 128, HTB = HALF * BK * 2  , STAGE_BYTES = 8 * HTB, NXCD = 8, WGM = 8;

__host__ __device__ __forceinline__ int lds_byte(int r, int c) { const int st = (r >> 4) * 2 + (c >> 5), rr = r & 15, cc = c & 31, ob = rr * 64 + cc * 2; return st * 1024 + (ob ^ (((ob >> 9) & 1) << 5)); }
__host__ __device__ __forceinline__ void stage_rc(int b, int& R, int& C) { const int st = b / 1024, sb = b % 1024, swz = sb ^ (((sb >> 9) & 1) << 5); R = (st >> 1) * 16 + swz / 64; C = (st & 1) * 32 + (swz % 64) / 2; }
__host__ __device__ __forceinline__ int perm32(int rho) { const int n = rho >> 4, i = rho & 15; return 8 * (i >> 2) + 4 * n + (i & 3); }
struct Unit { int pm, pn; };
struct Gemm { const bf16_t* A; const bf16_t* Bt; int M, N, K; int lda; };
struct StaticOrder {
    int nM, nN, nwg, G, c;
    __host__ __device__ void init(int M, int N, int G_, int c_) { nM = M / BM; nN = N / BM; nwg = nM * nN; G = G_; c = c_; }
    __host__ __device__ bool next(int i, Unit& u) const {
        const long L = (long)i * G + c; if (L >= nwg) return false;
        int wgid = (int)L; { const int q = nwg / NXCD, r = nwg % NXCD, xcd = wgid % NXCD, off = wgid / NXCD; wgid = (xcd < r ? xcd * (q + 1) : r * (q + 1) + (xcd - r) * q) + off; }
        const int nig = WGM * nN, gid = wgid / nig, fm = gid * WGM, gsz = (nM - fm) < WGM ? (nM - fm) : WGM;
        u.pm = fm + ((wgid % nig) % gsz); u.pn = (wgid % nig) / gsz; return true;
    }
    __device__ __forceinline__ void a_ready(const Unit&) const {}
    __device__ __forceinline__ void done(const Unit&) const {}
    __device__ __forceinline__ size_t a_off(const Unit&) const { return 0; }
};
template <class Epi, class Sched, bool STAMP = false>
__device__ __forceinline__ void gemm_phase(PG8_LAS unsigned char* lds, const Gemm g, const Sched& S, const Epi& E, unsigned long long* stamps) {
    int tid_raw = threadIdx.x; asm volatile("" : "+v"(tid_raw));
    const int tid = tid_raw, wid = __builtin_amdgcn_readfirstlane(tid >> 6), lane = tid & 63, wr = wid >> 2, wc = wid & 3, fr = lane & 15, fq = lane >> 4;
    const int K = g.K, nt = K / BK;
    int ts_lo = 0, ts_hi = 0, nts = 0; const unsigned long long rt_entry = STAMP ? (unsigned long long)wall_clock64() : 0ull;
#define PG8_STAMP() do { if (STAMP && wid == 0 && nts < 64) { const unsigned long long _c = (unsigned long long)clock64(); \
        ts_lo = (lane == nts) ? (int)(unsigned)_c : ts_lo; ts_hi = (lane == nts) ? (int)(unsigned)(_c >> 32) : ts_hi; ++nts; } } while (0)
    PG8_STAMP();
    unsigned voffA[2], voffB[2];
#pragma unroll
    for (int i = 0; i < 2; ++i) { int R, C; stage_rc(tid * 16 + i * 8192, R, C); const int Rb = Epi::PERM ? ((R & ~31) + perm32(R & 31)) : R;
        voffA[i] = (unsigned)(R * g.lda + C) * 2u; voffB[i] = (unsigned)(Rb * K + C) * 2u; }
    const size_t kstep = (size_t)(BK * 2);
    const size_t hstep = (size_t)HALF * K * 2;
    const size_t tstep = 2 * hstep;
    const size_t hstepA = (size_t)HALF * g.lda * 2, tstepA = 2 * hstepA;
    const unsigned ldsw = (unsigned)wid * 1024u;
    const int aoff = lds_byte(wr * 64 + fr, fq * 8), boff = lds_byte(wc * 32 + fr, fq * 8);
#define PG8_SA(b, h) (((b) * 2 + (h)) * HTB)
#define PG8_SB(b, h) ((4 + (b) * 2 + (h)) * HTB)
#define PG8_STAGE(bufoff, gbase, voff) do { _Pragma("unroll") for (int _i = 0; _i < 2; ++_i) \
        __builtin_amdgcn_global_load_lds((const unsigned*)((const char*)(gbase) + (voff)[_i]), (PG8_LAS unsigned*)(lds + (bufoff) + ldsw + _i * 8192), 16, 0, 0); } while (0)
#define PG8_LDA(dst, b, h) do { _Pragma("unroll") for (int m = 0; m < 4; ++m) _Pragma("unroll") for (int k = 0; k < 2; ++k) dst[m][k] = *(const PG8_LAS bf16x8*)(lds + PG8_SA(b, h) + aoff + m * 2048 + k * 1024); } while (0)
#define PG8_LDB(dst, b, h) do { _Pragma("unroll") for (int n = 0; n < 2; ++n) _Pragma("unroll") for (int k = 0; k < 2; ++k) dst[n][k] = *(const PG8_LAS bf16x8*)(lds + PG8_SB(b, h) + boff + n * 2048 + k * 1024); } while (0)
#define PG8_MMA(ai, bj, At, Bt) do { __builtin_amdgcn_s_setprio(1); _Pragma("unroll") for (int m = 0; m < 4; ++m) _Pragma("unroll") for (int n = 0; n < 2; ++n) _Pragma("unroll") for (int k = 0; k < 2; ++k) \
        acc[ai][bj][m][n] = __builtin_amdgcn_mfma_f32_16x16x32_bf16(Bt[n][k], At[m][k], acc[ai][bj][m][n], 0, 0, 0); __builtin_amdgcn_s_setprio(0); } while (0)
#define PG8_WAIT_V(n) asm volatile("s_waitcnt vmcnt(" #n ")" ::: "memory")
#define PG8_WAIT_L(n) asm volatile("s_waitcnt lgkmcnt(" #n ")" ::: "memory")
#define PG8_BAR __builtin_amdgcn_s_barrier()
#define PG8_SCHED __builtin_amdgcn_sched_barrier(0)
    Unit cur, nxt; int ui = 0;
    if (!S.next(0, cur)) return;
    f32x4 acc[2][2][4][2];
#pragma unroll
    for (int a = 0; a < 2; ++a)
#pragma unroll
        for (int b = 0; b < 2; ++b)
#pragma unroll
            for (int m = 0; m < 4; ++m)
#pragma unroll
                for (int n = 0; n < 2; ++n) acc[a][b][m][n] = (f32x4){0.f, 0.f, 0.f, 0.f};
    bf16x8 At[4][2], B0[2][2], B1[2][2];
    const char* cA = (const char*)g.A + (size_t)cur.pm * tstepA + S.a_off(cur); const char* cB = (const char*)g.Bt + (size_t)cur.pn * tstep;
    S.a_ready(cur);
    PG8_STAGE(PG8_SB(0, 0), cB, voffB); PG8_STAGE(PG8_SA(0, 0), cA, voffA); PG8_STAGE(PG8_SB(0, 1), cB + hstep, voffB); PG8_STAGE(PG8_SA(0, 1), cA + hstepA, voffA);
    if (wr == 1) PG8_BAR;
    PG8_WAIT_V(4); PG8_BAR;
    PG8_STAGE(PG8_SB(1, 0), cB + kstep, voffB); PG8_STAGE(PG8_SA(1, 0), cA + kstep, voffA); PG8_STAGE(PG8_SB(1, 1), cB + hstep + kstep, voffB);
    PG8_WAIT_V(6); PG8_BAR;
    PG8_STAMP();
    for (;;) {
        const bool has_next = S.next(ui + 1, nxt);
        const char* nA = has_next ? (const char*)g.A + (size_t)nxt.pm * tstepA + S.a_off(nxt) : cA; const char* nB = has_next ? (const char*)g.Bt + (size_t)nxt.pn * tstep : cB;
        for (int t = 0; t < nt; t += 2) {
            const bool last = (t == nt - 2);
            const char* a1 = cA + (size_t)(t + 1) * kstep;
            const char* a2 = last ? nA : cA + (size_t)(t + 2) * kstep; const char* b2 = last ? nB : cB + (size_t)(t + 2) * kstep;
            const char* a3 = a2 + kstep; const char* b3 = b2 + kstep;
            if (last && has_next) S.a_ready(nxt);
            PG8_LDB(B0, 0, 0); PG8_SCHED; PG8_LDA(At, 0, 0); PG8_STAGE(PG8_SA(1, 1), a1 + hstepA, voffA);
            PG8_WAIT_L(8); PG8_BAR; PG8_WAIT_L(0); PG8_MMA(0, 0, At, B0); PG8_BAR; PG8_SCHED;
            PG8_LDB(B1, 0, 1); PG8_STAGE(PG8_SB(0, 0), b2, voffB);
            PG8_BAR; PG8_WAIT_L(0); PG8_MMA(0, 1, At, B1); PG8_BAR;
            PG8_LDA(At, 0, 1); PG8_STAGE(PG8_SA(0, 0), a2, voffA);
            PG8_BAR; PG8_WAIT_L(0); PG8_MMA(1, 0, At, B0); PG8_BAR; PG8_SCHED;
            PG8_STAGE(PG8_SB(0, 1), b2 + hstep, voffB);
            PG8_WAIT_V(6); PG8_BAR; PG8_MMA(1, 1, At, B1); PG8_BAR;
            PG8_LDB(B0, 1, 0); PG8_SCHED; PG8_LDA(At, 1, 0); PG8_STAGE(PG8_SA(0, 1), a2 + hstepA, voffA);
            PG8_WAIT_L(8); PG8_BAR; PG8_WAIT_L(0); PG8_MMA(0, 0, At, B0); PG8_BAR; PG8_SCHED;
            PG8_LDB(B1, 1, 1); PG8_STAGE(PG8_SB(1, 0), b3, voffB);
            PG8_BAR; PG8_WAIT_L(0); PG8_MMA(0, 1, At, B1); PG8_BAR;
            PG8_LDA(At, 1, 1); PG8_STAGE(PG8_SA(1, 0), a3, voffA);
            PG8_BAR; PG8_WAIT_L(0); PG8_MMA(1, 0, At, B0); PG8_BAR; PG8_SCHED;
            PG8_STAGE(PG8_SB(1, 1), b3 + hstep, voffB);
            PG8_WAIT_V(6); PG8_BAR; PG8_MMA(1, 1, At, B1); PG8_BAR;
        }
        PG8_STAMP();
        if constexpr (!Epi::AFTER_DRAIN) { E(acc, cur, wr, wc, fr, fq); S.done(cur); }
        PG8_STAMP();
        if (!has_next) break;
#pragma unroll
        for (int a = 0; a < 2; ++a)
#pragma unroll
            for (int b = 0; b < 2; ++b)
#pragma unroll
                for (int m = 0; m < 4; ++m)
#pragma unroll
                    for (int n = 0; n < 2; ++n) acc[a][b][m][n] = (f32x4){0.f, 0.f, 0.f, 0.f};
        cur = nxt; cA = nA; cB = nB; ++ui;
    }
    PG8_WAIT_V(0);
    if (wr == 0) PG8_BAR;
    PG8_BAR;
    if constexpr (Epi::AFTER_DRAIN) { E.fused(acc, cur, wr, wc, fr, fq, lds, wid, lane); S.done(cur); }
    PG8_STAMP();
    if (STAMP && wid == 0) { stamps[lane] = lane < nts ? (((unsigned long long)(unsigned)ts_hi << 32) | (unsigned)ts_lo) : 0ull;
        if (lane == 62) stamps[62] = rt_entry; if (lane == 63) stamps[63] = (unsigned long long)wall_clock64(); }
#undef PG8_STAMP
#undef PG8_SA
#undef PG8_SB
#undef PG8_STAGE
#undef PG8_LDA
#undef PG8_LDB
#undef PG8_MMA
#undef PG8_WAIT_V
#undef PG8_WAIT_L
#undef PG8_BAR
#undef PG8_SCHED
}
}

struct EpiIn {
  static constexpr bool PERM = true, AFTER_DRAIN = false;
  CParams* kp;
  __device__ __forceinline__ void operator()(const pg8::f32x4 (&acc)[2][2][4][2], const pg8::Unit& u, int wr, int wc, int fr, int fq) const {
    const int pn = u.pn;
    u16* base; int ld, mode;
    if (pn < 4) { base = kp->U + pn * 256; ld = D; mode = 0; }
    else if (pn < 16) { base = kp->Z + (pn - 4) * 256; ld = 3072; mode = 1; }
    else { base = kp->Ms + (pn - 16) * 256; ld = 3072; mode = 2; }
    const int row0 = u.pm * 256 + wr * 64 + fr;
    const int col0 = wc * 32 + 8 * fq;
    u16* rowp0 = base + (size_t)row0 * ld + col0;
#pragma unroll
    for (int ai = 0; ai < 2; ++ai)
#pragma unroll
      for (int m = 0; m < 4; ++m)
#pragma unroll
        for (int bj = 0; bj < 2; ++bj)
#pragma unroll
          for (int n = 0; n < 2; ++n) {
            pg8::f32x4 v0 = acc[ai][bj][m][n];
            if (mode == 1) {
#pragma unroll
              for (int j = 0; j < 4; ++j) v0[j] = siluf_(v0[j]);
            } else if (mode == 2) {
#pragma unroll
              for (int j = 0; j < 4; ++j) v0[j] = sigmoidf_(v0[j]);
            }
            u32x2 w; w.x = pack2(v0[0], v0[1]); w.y = pack2(v0[2], v0[3]);
            *(u32x2*)(rowp0 + (size_t)(ai * 128 + m * 16) * ld + bj * 128 + n * 4) = w;
          }
  }
};

DI bool tile_map(int i, int MT, int NT, int& mt, int& nt) {
  const int G = gridDim.x, bid = blockIdx.x;
  if ((G & 63) == 0 && (MT & 7) == 0 && (NT % (G >> 6)) == 0) {
    const int SH = G >> 6;
    const int xcd = bid & 7, slot = bid >> 3;
    const int sx = slot & 7, sy = slot >> 3;
    const int nsn = NT / SH, nsm = MT >> 3;
    const int st = i * 8 + xcd;
    if (st >= nsm * nsn) return false;
    mt = (st / nsn) * 8 + sx;
    nt = (st % nsn) * SH + sy;
    return true;
  }
  const int it = bid + i * G;
  if (it >= MT * NT) return false;
  mt = it / NT; nt = it % NT;
  return true;
}


struct OneUnit {
  int pm, pn;
  __device__ bool next(int i, pg8::Unit& u) const { if (i) return false; u.pm = pm; u.pn = pn; return true; }
  __device__ __forceinline__ void a_ready(const pg8::Unit&) const {}
  __device__ __forceinline__ void done(const pg8::Unit&) const {}
  __device__ __forceinline__ size_t a_off(const pg8::Unit&) const { return 0; }
};
struct EpiQKV {
  static constexpr bool PERM = false, AFTER_DRAIN = true;
  CParams* kp; char* lds; int l, nt, m0;
  __device__ __forceinline__ void fused(const pg8::f32x4 (&acc)[2][2][4][2], const pg8::Unit&, int wr, int wc, int fr, int fq,
                                        PG8_LAS unsigned char*, int, int) const {
    CParams& p = *kp;
    const int NB = p.NB, RL = NB * S;
    const int tid = otid();
    const bool lat = m0 < RL;
    int b, t0;
    if (lat) { b = m0 / S; t0 = m0 % S; } else { int rc = m0 - RL; b = rc / L; t0 = rc % L; }
    const bool isV = (nt == 13 || nt == 23);
    const bool isC = nt >= 18;
    const bool isQ = (nt >= 8 && nt < 12) || (nt >= 18 && nt < 22);
    auto process_unit = [&](int hsel, int u) {
      if (isV) {
        const int slot = (isC ? 2 : 0) + hsel;
        const int d = u >> 2, tq = u & 3;
        const float* Cs = (const float*)lds;
        u16* dst = lat ? p.VtL + ((size_t)(b * 4 + slot) * 128 + d) * S + t0 + tq * 64
                       : p.VtC + ((size_t)(b * 4 + slot) * 128 + d) * L + t0 + tq * 64;
#pragma unroll 1
        for (int c = 0; c < 4; ++c) {
          float v[16];
#pragma unroll
          for (int j = 0; j < 16; ++j) v[j] = Cs[(tq * 64 + c * 16 + j) * 132 + d];
          uint4 o0, o1;
          o0.x = pack2(v[0], v[1]); o0.y = pack2(v[2], v[3]); o0.z = pack2(v[4], v[5]); o0.w = pack2(v[6], v[7]);
          o1.x = pack2(v[8], v[9]); o1.y = pack2(v[10], v[11]); o1.z = pack2(v[12], v[13]); o1.w = pack2(v[14], v[15]);
          *(uint4*)(dst + c * 16) = o0;
          *(uint4*)(dst + c * 16 + 8) = o1;
        }
      } else {
        const int row = u >> 1, half = u & 1;
        const size_t gr = (size_t)m0 + row;
        const int t = t0 + row;
        const float* Cr = (const float*)lds + row * 132 + half * 64;
        float rstd = 1.f;
        const float* gn = (isQ ? p.q_norm_g : p.k_norm_g) + l * 128 + half * 64;
        if (isC) {
          float ss = 0.f;
#pragma unroll
          for (int j = 0; j < 16; ++j) {
            float4 tv = *(const float4*)(Cr + j * 4);
            ss += tv.x * tv.x + tv.y * tv.y + tv.z * tv.z + tv.w * tv.w;
          }
          ss += __shfl_xor(ss, 1);
          rstd = rsqrtf(ss * (1.f / 128.f) + EPS);
        }
        const int pos = (half == 0) ? (t >> 6) : (t & 63);
        const float* cs = p.rope + pos * 32;
        const float* sn = p.rope + 2048 + pos * 32;
        u16* dst;
        if (isQ) {
          const int head = (isC ? (nt - 18) : (nt - 8)) * 2 + hsel;
          dst = p.Q + gr * 2048 + (isC ? 1024 : 0) + head * 128 + half * 64;
        } else {
          dst = p.Kb + gr * 512 + (isC ? 256 : 0) + hsel * 128 + half * 64;
        }
#pragma unroll 1
        for (int c = 0; c < 2; ++c) {
          float x0[16], x1[16];
#pragma unroll
          for (int j = 0; j < 4; ++j) {
            float4 ta_ = *(const float4*)(Cr + c * 16 + j * 4);
            float4 tb_ = *(const float4*)(Cr + 32 + c * 16 + j * 4);
            x0[4 * j] = ta_.x; x0[4 * j + 1] = ta_.y; x0[4 * j + 2] = ta_.z; x0[4 * j + 3] = ta_.w;
            x1[4 * j] = tb_.x; x1[4 * j + 1] = tb_.y; x1[4 * j + 2] = tb_.z; x1[4 * j + 3] = tb_.w;
          }
          if (isC) {
#pragma unroll
            for (int j = 0; j < 16; ++j) { x0[j] = x0[j] * rstd * gn[c * 16 + j]; x1[j] = x1[j] * rstd * gn[32 + c * 16 + j]; }
          }
          if (lat) {
#pragma unroll
            for (int j = 0; j < 16; ++j) {
              float c_ = cs[c * 16 + j], s_ = sn[c * 16 + j];
              float a0 = x0[j], a1 = x1[j];
              x0[j] = a0 * c_ - a1 * s_;
              x1[j] = a1 * c_ + a0 * s_;
            }
          }
          if (isQ) {
#pragma unroll
            for (int j = 0; j < 16; ++j) { x0[j] *= QSCALE; x1[j] *= QSCALE; }
          }
          uint4 o0, o1, o2, o3;
          o0.x = pack2(x0[0], x0[1]); o0.y = pack2(x0[2], x0[3]); o0.z = pack2(x0[4], x0[5]); o0.w = pack2(x0[6], x0[7]);
          o1.x = pack2(x0[8], x0[9]); o1.y = pack2(x0[10], x0[11]); o1.z = pack2(x0[12], x0[13]); o1.w = pack2(x0[14], x0[15]);
          o2.x = pack2(x1[0], x1[1]); o2.y = pack2(x1[2], x1[3]); o2.z = pack2(x1[4], x1[5]); o2.w = pack2(x1[6], x1[7]);
          o3.x = pack2(x1[8], x1[9]); o3.y = pack2(x1[10], x1[11]); o3.z = pack2(x1[12], x1[13]); o3.w = pack2(x1[14], x1[15]);
          *(uint4*)(dst + c * 16) = o0;
          *(uint4*)(dst + c * 16 + 8) = o1;
          *(uint4*)(dst + 32 + c * 16) = o2;
          *(uint4*)(dst + 32 + c * 16 + 8) = o3;
        }
      }
    };

#pragma unroll
    for (int bj = 0; bj < 2; ++bj) {
      float* Cs = (float*)lds;
#pragma unroll
      for (int ai = 0; ai < 2; ++ai)
#pragma unroll
        for (int m = 0; m < 4; ++m)
#pragma unroll
          for (int n = 0; n < 2; ++n) {
            const int row = ai * 128 + wr * 64 + m * 16 + fr;
            const int col = wc * 32 + n * 16 + fq * 4;
            pg8::f32x4 v = acc[ai][bj][m][n];
            float4 o; o.x = v[0]; o.y = v[1]; o.z = v[2]; o.w = v[3];
            *(float4*)(Cs + row * 132 + col) = o;
          }
      __syncthreads();
      process_unit(bj, tid);
      __syncthreads();
    }
  }
};

DI void phase_gemm_in(CParams& p, int chunk, int l, char* lds) {
  const int NB = p.NB, RL = NB * S, R = NB * (S + L);
  const int MT = R / 256;
  const u16* Wt = p.WinT + (size_t)l * INW * D;
  {
    pg8::Gemm g{p.Hb, Wt, R, 7168, D, D};
    pg8::StaticOrder So; So.init(R, 7168, (int)gridDim.x, (int)blockIdx.x);
    EpiIn E{&p};
    pg8::gemm_phase<EpiIn, pg8::StaticOrder, false>((PG8_LAS unsigned char*)lds, g, So, E, nullptr);
  }
  for (int ti = 0;; ++ti) {
    int mt, jt;
    if (!tile_map(ti, MT, 12, mt, jt)) break;
    const int nt = (jt < 6) ? 8 + jt : 12 + jt;
    pg8::Gemm g{p.Hb, Wt + (size_t)28 * 256 * D, R, 3072, D, D};
    OneUnit One{mt, jt};
    EpiQKV E{&p, lds, l, nt, mt * 256};
    pg8::gemm_phase<EpiQKV, OneUnit, false>((PG8_LAS unsigned char*)lds, g, One, E, nullptr);
  }
}

struct AttnArgs {
  const u16* q;
  u16* z;
  const u16* kctx;
  const u16* vctx;
  const u16* klat;
  const u16* vlat;
  int n_lat_tiles;
  int lat_key0;
  int q_t0;
  int band;
  int has_sink;
  float sink_l2;
  int dry;
  int fixedm;
  float mfix;
};

DI void attn_load_tile(const AttnArgs& a, int ti, u32x4 (&rk)[2], u32x4 (&rv)[2]) {
  const int tid = otid();
  const u16* kp; const u16* vp; int vs;
  if (ti < 4) { kp = a.kctx + (size_t)(ti * 64) * 512; vp = a.vctx + ti * 64; vs = L; }
  else { kp = a.klat + (size_t)((ti - 4) * 64) * 512; vp = a.vlat + (ti - 4) * 64; vs = S; }
#pragma unroll
  for (int i = 0; i < 2; ++i) {
    int c = tid + NTHR * i;
    rk[i] = *(const u32x4*)(kp + (size_t)(c >> 4) * 512 + (c & 15) * 8);
    rv[i] = *(const u32x4*)(vp + (size_t)(c >> 3) * vs + (c & 7) * 8);
  }
}
DI void attn_store_tile(u16* sK, u16* sV, const u32x4 (&rk)[2], const u32x4 (&rv)[2]) {
  const int tid = otid();
#pragma unroll
  for (int i = 0; i < 2; ++i) {
    int c = tid + NTHR * i;
    *(u32x4*)(sK + (c >> 4) * 136 + (c & 15) * 8) = rk[i];
    u16* vd = sV + (c >> 3) * 68 + (c & 7) * 8;
    { u32x2 t0 = {rv[i].x, rv[i].y}; *(u32x2*)(vd) = t0; }
    { u32x2 t1 = {rv[i].z, rv[i].w}; *(u32x2*)(vd + 4) = t1; }
  }
}

template <bool NS>
DI void attn_item(const AttnArgs& a, char* lds) {
  const int tid = otid(), lane = tid & 63, w = tid >> 6;
  const int r = lane & 31, hh = lane >> 5;
  constexpr int STG = 34816;
  const int ntiles = 4 + a.n_lat_tiles;

  bf16x8 qf[8];
  {
    const u16* qp = a.q + (size_t)(w * 32 + r) * 2048 + hh * 8;
#pragma unroll
    for (int ks = 0; ks < 8; ++ks) qf[ks] = *(const bf16x8*)(qp + ks * 16);
  }
  f32x16 O[4];
#pragma unroll
  for (int dt = 0; dt < 4; ++dt)
#pragma unroll
    for (int x = 0; x < 16; ++x) O[dt][x] = 0.f;
  float m = a.fixedm ? a.mfix : (a.has_sink ? a.sink_l2 : -1e30f);
  float lsum = (a.has_sink && hh == 0) ? 1.f : 0.f;
  const int qpos = a.q_t0 + w * 32 + r;

  auto QK = [&](int stage, f32x16 (&sc)[2]) {
    const u16* sK = (const u16*)(lds + stage * STG);
#pragma unroll
    for (int kt2 = 0; kt2 < 2; ++kt2) {
#pragma unroll
      for (int x = 0; x < 16; ++x) sc[kt2][x] = 0.f;
      const u16* kb = sK + (kt2 * 32 + r) * 136 + hh * 8;
#pragma unroll
      for (int ks = 0; ks < 8; ++ks) {
        bf16x8 ka = *(const bf16x8*)(kb + ks * 16);
        sc[kt2] = MFMA32(ka, qf[ks], sc[kt2]);
      }
    }
  };
  u32x4 rk[2], rv[2], rk1[2], rv1[2];
  auto STEP = [&](int ti, int st, f32x16 (&sc)[2], f32x16 (&sn)[2], u32x4 (&lk)[2], u32x4 (&lv)[2], u32x4 (&sk)[2], u32x4 (&sv)[2]) {
    const int st1 = (st == 2) ? 0 : st + 1, st2 = (st == 0) ? 2 : st - 1;
    if (ti + 3 < ntiles) attn_load_tile(a, ti + 3, lk, lv);
    if (ti + 1 < ntiles) QK(st1, sn);
    if (a.band && ti >= 4) {
      const int k0 = a.lat_key0 + (ti - 4) * 64;
#pragma unroll
      for (int kt2 = 0; kt2 < 2; ++kt2)
#pragma unroll
        for (int x = 0; x < 16; ++x) {
          int kp = k0 + kt2 * 32 + crow(x, hh);
          int dlt = kp - qpos; dlt = dlt < 0 ? -dlt : dlt;
          if (dlt > 128) sc[kt2][x] = -1e30f;
        }
    }
    if (!NS && !a.fixedm) {
      float mx = sc[0][0];
#pragma unroll
      for (int kt2 = 0; kt2 < 2; ++kt2)
#pragma unroll
        for (int x = 0; x < 16; ++x) mx = fmaxf(mx, sc[kt2][x]);
      mx = fmaxf(mx, __shfl_xor(mx, 32));
      if (__any(mx > m + 8.f)) {
        const float mnew = fmaxf(m, mx);
        const float alpha = __builtin_amdgcn_exp2f(m - mnew);
        m = mnew;
        lsum *= alpha;
#pragma unroll
        for (int dt = 0; dt < 4; ++dt)
#pragma unroll
          for (int x = 0; x < 16; ++x) O[dt][x] *= alpha;
      }
    }
    float ps = 0.f;
#pragma unroll
    for (int kt2 = 0; kt2 < 2; ++kt2)
#pragma unroll
      for (int x = 0; x < 16; ++x) { float pv = NS ? __builtin_amdgcn_exp2f(sc[kt2][x]) : __builtin_amdgcn_exp2f(sc[kt2][x] - m); sc[kt2][x] = pv; ps += pv; }
    lsum += ps;
    const u16* sV = (const u16*)(lds + st * STG + 17408);
#pragma unroll
    for (int kt2 = 0; kt2 < 2; ++kt2)
#pragma unroll
      for (int s2 = 0; s2 < 2; ++s2) {
        union { unsigned u[4]; bf16x8 v; } pf;
#pragma unroll
        for (int j = 0; j < 4; ++j) pf.u[j] = pack2(sc[kt2][8 * s2 + 2 * j], sc[kt2][8 * s2 + 2 * j + 1]);
        const u16* vb = sV + r * 68 + kt2 * 32 + 16 * s2 + 4 * hh;
#pragma unroll
        for (int dt = 0; dt < 4; ++dt) {
          s16x4 lo = *(const s16x4*)(vb + dt * 32 * 68);
          s16x4 hi = *(const s16x4*)(vb + dt * 32 * 68 + 8);
          bf16x8 va = __builtin_shufflevector(lo, hi, 0, 1, 2, 3, 4, 5, 6, 7);
          O[dt] = MFMA32(va, pf.v, O[dt]);
        }
      }
    if (ti + 2 < ntiles) attn_store_tile((u16*)(lds + st2 * STG), (u16*)(lds + st2 * STG + 17408), sk, sv);
    __syncthreads();
  };

  attn_load_tile(a, 0, rk, rv);
  __syncthreads();
  attn_store_tile((u16*)lds, (u16*)(lds + 17408), rk, rv);
  attn_load_tile(a, 1, rk, rv);
  attn_store_tile((u16*)(lds + STG), (u16*)(lds + STG + 17408), rk, rv);
  attn_load_tile(a, 2, rk, rv);
  __syncthreads();
  f32x16 sA[2], sB[2];
  QK(0, sA);
  int st = 0;
  for (int ti = 0; ti < ntiles; ti += 2) {
    STEP(ti, st, sA, sB, rk1, rv1, rk, rv);
    st = (st == 2) ? 0 : st + 1;
    if (ti + 1 < ntiles) {
      STEP(ti + 1, st, sB, sA, rk, rv, rk1, rv1);
      st = (st == 2) ? 0 : st + 1;
    }
  }
  float ltot = lsum + __shfl_xor(lsum, 32);
  const float inv = 1.f / ltot;
  u16* zp = a.z + (size_t)(w * 32 + r) * 3072;
  u32x2 gv[4][4];
#pragma unroll
  for (int dt = 0; dt < 4; ++dt)
#pragma unroll
    for (int g4 = 0; g4 < 4; ++g4) gv[dt][g4] = *(const u32x2*)(zp + dt * 32 + 8 * g4 + 4 * hh);
#pragma unroll
  for (int dt = 0; dt < 4; ++dt)
#pragma unroll
    for (int g4 = 0; g4 < 4; ++g4) {
      int d0 = dt * 32 + 8 * g4 + 4 * hh;
      float y0 = O[dt][4 * g4 + 0] * inv * bflo(gv[dt][g4].x);
      float y1 = O[dt][4 * g4 + 1] * inv * bfhi(gv[dt][g4].x);
      float y2 = O[dt][4 * g4 + 2] * inv * bflo(gv[dt][g4].y);
      float y3 = O[dt][4 * g4 + 3] * inv * bfhi(gv[dt][g4].y);
      uint2 o; o.x = pack2(y0, y1); o.y = pack2(y2, y3);
      if (!a.dry || y0 != y0) *(uint2*)(zp + d0) = o;
    }
}

template <bool REV>
DI void lru_scan(float (&av)[2][16], float (&bv)[2][16], float& carry, int hh) {
  float segA[8], segB[8];
#pragma unroll
  for (int k = 0; k < 8; ++k) {
    const int mt = k >> 2, q = k & 3;
    float cA = 1.f, hl = 0.f;
#pragma unroll
    for (int jj = 0; jj < 4; ++jj) {
      const int j = REV ? 3 - jj : jj;
      const int i = 4 * q + j;
      hl = av[mt][i] * hl + bv[mt][i];
      cA *= av[mt][i];
      av[mt][i] = cA; bv[mt][i] = hl;
    }
    segA[k] = cA; segB[k] = hl;
  }
  float oA[8], oB[8];
#pragma unroll
  for (int k = 0; k < 8; ++k) { oA[k] = __shfl_xor(segA[k], 32); oB[k] = __shfl_xor(segB[k], 32); }
  float init[8];
  float st = carry;
#pragma unroll
  for (int kk = 0; kk < 8; ++kk) {
    const int k = REV ? 7 - kk : kk;
    const int first = REV ? 1 : 0;
    float A1 = (hh == first) ? segA[k] : oA[k];
    float B1 = (hh == first) ? segB[k] : oB[k];
    float st0 = st;
    st = A1 * st + B1;
    float A2 = (hh == first) ? oA[k] : segA[k];
    float B2 = (hh == first) ? oB[k] : segB[k];
    float st1 = st;
    st = A2 * st + B2;
    init[k] = (hh == first) ? st0 : st1;
  }
  carry = st;
#pragma unroll
  for (int k = 0; k < 8; ++k) {
    const int mt = k >> 2, q = k & 3;
#pragma unroll
    for (int j = 0; j < 4; ++j) {
      const int i = 4 * q + j;
      bv[mt][i] = bv[mt][i] + av[mt][i] * init[k];
    }
  }
}

DI void lru_item(CParams& p, int l, int b, int n, bool last, char* lds, int dry = 0) {
  const int NB = p.NB, RL = NB * S;
  const int tid = otid(), lane = tid & 63, w8 = tid >> 6;
  const int sub = __builtin_amdgcn_readfirstlane(w8 >> 2), w = w8 & 3;
  n = n + sub;
  lds += sub * 73728;
  const int dir = w >> 1, w2 = w & 1;
  const int tl = tid & 127;
  const int r = lane & 31, hh = lane >> 5;
  u16* sRaw = (u16*)lds + dir * (8704 / 2);
  u16* sUp = (u16*)(lds + 17408) + dir * (9216 / 2);
  float* sH = (float*)(lds + 35840) + w * (64 * 36);

  const int chb = n * 64;
  const int cp = (tl & 31) * 2, tg = tl >> 5;
  float cw0[4], cw1[4], cb0, cb1;
#pragma unroll
  for (int k = 0; k < 4; ++k) {
    cw0[k] = p.conv_w[((size_t)l * 4 + k) * D + chb + cp];
    cw1[k] = p.conv_w[((size_t)l * 4 + k) * D + chb + cp + 1];
  }
  cb0 = p.conv_b[l * D + chb + cp]; cb1 = p.conv_b[l * D + chb + cp + 1];
  bf16x8 waf[4], wxf[4];
  {
    const float* wa = p.lru_wa + (((size_t)(l * 2 + dir) * 16 + n) * 64) * 64;
    const float* wx = p.lru_wx + (((size_t)(l * 2 + dir) * 16 + n) * 64) * 64;
    const int e = 32 * w2 + r;
#pragma unroll
    for (int ks = 0; ks < 4; ++ks) {
      union { unsigned u[4]; bf16x8 v; } fa, fx;
#pragma unroll
      for (int j = 0; j < 4; ++j) {
        int d0 = ks * 16 + 8 * hh + 2 * j;
        fa.u[j] = pack2(wa[d0 * 64 + e], wa[(d0 + 1) * 64 + e]);
        fx.u[j] = pack2(wx[d0 * 64 + e], wx[(d0 + 1) * 64 + e]);
      }
      waf[ks] = fa.v; wxf[ks] = fx.v;
    }
  }
  const int che = chb + 32 * w2 + r;
  const float ba = p.lru_ba[(l * 2 + dir) * D + che];
  const float bx = p.lru_bx[(l * 2 + dir) * D + che];
  float c8sp;
  {
    float lam = p.lru_lambda[(l * 2 + dir) * D + che];
    float sp = (lam < -20.f) ? -lam : log1pf(expf(-lam));
    c8sp = 8.f * sp;
  }
  float carry = 0.f;

  auto step_tile = [&](int st, bool& isctx, int& tt) {
    if (dir == 0) { if (st < 4) { isctx = true; tt = st; } else { isctx = false; tt = st - 4; } }
    else { if (st < 4) { isctx = true; tt = 3 - st; } else { isctx = false; tt = 63 - (st - 4); } }
  };
  u32x4 pre[5];
  auto load_raw = [&](int st) {
    bool isctx; int tt; step_tile(st, isctx, tt);
    const int seqlen = isctx ? L : S;
    const size_t rowbase = isctx ? (size_t)RL + (size_t)b * L : (size_t)b * S;
    const int t0 = tt * 64;
#pragma unroll
    for (int i = 0; i < 5; ++i) {
      int c = tl + 128 * i;
      int rr = c >> 3, c16 = c & 7;
      int t = t0 - 2 + rr;
      u32x4 v = {0u, 0u, 0u, 0u};
      if (rr < 67 && t >= 0 && t < seqlen) v = *(const u32x4*)(p.U + (rowbase + t) * D + chb + c16 * 8);
      pre[i] = v;
    }
  };
  load_raw(0);
  __syncthreads();
  for (int st = 0; st < 68; ++st) {
    bool isctx; int tt; step_tile(st, isctx, tt);
    const size_t rowbase = isctx ? (size_t)RL + (size_t)b * L : (size_t)b * S;
    const int t0 = tt * 64;
#pragma unroll
    for (int i = 0; i < 5; ++i) {
      int c = tl + 128 * i;
      int rr = c >> 3, c16 = c & 7;
      if (rr < 67) *(u32x4*)(sRaw + rr * 64 + c16 * 8) = pre[i];
    }
    if (st + 1 < 68) load_raw(st + 1);
    __syncthreads();
    {
      const u16* rp = sRaw + (tg * 16) * 64 + cp;
      unsigned r0 = *(const unsigned*)(rp), r1 = *(const unsigned*)(rp + 64), r2 = *(const unsigned*)(rp + 128);
#pragma unroll
      for (int i = 0; i < 16; ++i) {
        unsigned r3 = *(const unsigned*)(rp + (i + 3) * 64);
        float o0 = cb0 + cw0[0] * bflo(r0) + cw0[1] * bflo(r1) + cw0[2] * bflo(r2) + cw0[3] * bflo(r3);
        float o1 = cb1 + cw1[0] * bfhi(r0) + cw1[1] * bfhi(r1) + cw1[2] * bfhi(r2) + cw1[3] * bfhi(r3);
        *(unsigned*)(sUp + (tg * 16 + i) * 72 + cp) = pack2(o0, o1);
        r0 = r1; r1 = r2; r2 = r3;
      }
    }
    __syncthreads();
    const bool fwd_first = isctx ? (tt <= 1) : (tt <= 31);
    const bool first = (dir == 0) ? fwd_first : !fwd_first;
    unsigned long long pt0[4], pt1[4];
    u32x4 pg[4];
    if (!first && !(isctx && last)) {
#pragma unroll
      for (int j = 0; j < 4; ++j) {
        const int q = lane + 64 * j;
        const int tok = q >> 2, cc = (q & 3) * 8;
        const size_t row = rowbase + t0 + tok;
        const int col = chb + 32 * w2 + cc;
        const u16* tp = p.Hb + row * D + col;
        pt0[j] = __hip_atomic_load((const unsigned long long*)tp, __ATOMIC_RELAXED, __HIP_MEMORY_SCOPE_AGENT);
        pt1[j] = __hip_atomic_load((const unsigned long long*)tp + 1, __ATOMIC_RELAXED, __HIP_MEMORY_SCOPE_AGENT);
        pg[j] = *(const u32x4*)(p.Z + row * 3072 + col);
      }
    } else {
#pragma unroll
      for (int j = 0; j < 4; ++j) { pt0[j] = 0; pt1[j] = 0; pg[j] = u32x4{0u, 0u, 0u, 0u}; }
    }
    float av[2][16], bv[2][16];
    {
      f32x16 aR[2];
#pragma unroll
      for (int mt = 0; mt < 2; ++mt) {
#pragma unroll
        for (int x = 0; x < 16; ++x) aR[mt][x] = 0.f;
        const u16* ub = sUp + (mt * 32 + r) * 72 + hh * 8;
#pragma unroll
        for (int ks = 0; ks < 4; ++ks) aR[mt] = MFMA32(*(const bf16x8*)(ub + ks * 16), waf[ks], aR[mt]);
      }
#pragma unroll
      for (int mt = 0; mt < 2; ++mt)
#pragma unroll
        for (int x = 0; x < 16; ++x) {
          const float rg = sigmoidf_(aR[mt][x] + ba);
          av[mt][x] = -c8sp * rg;
        }
    }
    {
      f32x16 aI[2];
#pragma unroll
      for (int mt = 0; mt < 2; ++mt) {
#pragma unroll
        for (int x = 0; x < 16; ++x) aI[mt][x] = 0.f;
        const u16* ub = sUp + (mt * 32 + r) * 72 + hh * 8;
#pragma unroll
        for (int ks = 0; ks < 4; ++ks) aI[mt] = MFMA32(*(const bf16x8*)(ub + ks * 16), wxf[ks], aI[mt]);
      }
#pragma unroll
      for (int mt = 0; mt < 2; ++mt)
#pragma unroll
        for (int x = 0; x < 16; ++x) {
          const int tok = mt * 32 + crow(x, hh);
          const float up = bf2f(sUp[tok * 72 + 32 * w2 + r]);
          const float ig = sigmoidf_(aI[mt][x] + bx);
          const float la = av[mt][x];
          const float a_ = __expf(la);
          const float om = fmaxf(1.f - a_ * a_, 0.f);
          av[mt][x] = a_;
          bv[mt][x] = __builtin_amdgcn_sqrtf(om) * (ig * up);
        }
    }
    if (dir == 0) lru_scan<false>(av, bv, carry, hh); else lru_scan<true>(av, bv, carry, hh);
#pragma unroll
    for (int mt = 0; mt < 2; ++mt)
#pragma unroll
      for (int x = 0; x < 16; ++x) sH[(mt * 32 + crow(x, hh)) * 36 + r] = bv[mt][x];
    if (!(isctx && last)) {
#pragma unroll
      for (int j = 0; j < 4; ++j) {
        const int q = lane + 64 * j;
        const int tok = q >> 2, cc = (q & 3) * 8;
        const float4 h0 = *(const float4*)(sH + tok * 36 + cc);
        const float4 h1 = *(const float4*)(sH + tok * 36 + cc + 4);
        const size_t row = rowbase + t0 + tok;
        const int col = chb + 32 * w2 + cc;
        u16* tp = p.Hb + row * D + col;
        if (first) {
          uint4 o; o.x = pack2(h0.x, h0.y); o.y = pack2(h0.z, h0.w); o.z = pack2(h1.x, h1.y); o.w = pack2(h1.z, h1.w);
          if (!dry || h0.x != h0.x) *(uint4*)tp = o;
        } else {
          unsigned tx = (unsigned)pt0[j], ty = (unsigned)(pt0[j] >> 32), tz = (unsigned)pt1[j], tw = (unsigned)(pt1[j] >> 32);
          u16* zp = p.Z + row * 3072 + col;
          u32x4 g = pg[j];
          uint4 o;
          o.x = pack2((h0.x + bflo(tx)) * bflo(g.x), (h0.y + bfhi(tx)) * bfhi(g.x));
          o.y = pack2((h0.z + bflo(ty)) * bflo(g.y), (h0.w + bfhi(ty)) * bfhi(g.y));
          o.z = pack2((h1.x + bflo(tz)) * bflo(g.z), (h1.y + bfhi(tz)) * bfhi(g.z));
          o.w = pack2((h1.z + bflo(tw)) * bflo(g.w), (h1.w + bfhi(tw)) * bfhi(g.w));
          if (!dry || h0.x != h0.x) *(uint4*)zp = o;
        }
      }
    }
    __builtin_amdgcn_fence(__ATOMIC_RELEASE, "workgroup");
  }
}

DI void phase_mixers(CParams& p, int chunk, int l, char* lds, int dry = 0) {
  const int NB = p.NB, RL = NB * S;
  const bool last = (l == DEPTH - 1);
  const int nLRU = (dry == 1) ? 0 : NB * 8, nC = (dry == 2) ? 0 : NB * 8 * 16, nBw = (dry == 2) ? 0 : NB * 8 * 16, nCtx = (last || dry == 2) ? 0 : NB * 8 * 2;
  const int total = nLRU + nC + nBw + nCtx;
  int* ctr = p.ctr + chunk * DEPTH + l + (dry ? 32 : 0);
  int* s_item = (int*)(lds + LDS_BYTES - 16);
  int it;
  while (true) {
    __syncthreads();
    if (threadIdx.x == 0) *s_item = atomicAdd(ctr, 1);
    __syncthreads();
    it = __builtin_amdgcn_readfirstlane(*s_item);
    __syncthreads();
    if (it >= nLRU) break;
    lru_item(p, l, it >> 3, (it & 7) * 2, last, lds, dry);
  }
  float gqm = 0.f, gkm = 0.f;
  {
    const int ln = otid() & 63;
    gqm = fmaxf(fabsf(p.q_norm_g[l * 128 + ln]), fabsf(p.q_norm_g[l * 128 + 64 + ln]));
    gkm = fmaxf(fabsf(p.k_norm_g[l * 128 + ln]), fabsf(p.k_norm_g[l * 128 + 64 + ln]));
#pragma unroll
    for (int o = 32; o >= 1; o >>= 1) { gqm = fmaxf(gqm, __shfl_xor(gqm, o)); gkm = fmaxf(gkm, __shfl_xor(gkm, o)); }
    gqm = __builtin_amdgcn_readfirstlane(gqm); gkm = __builtin_amdgcn_readfirstlane(gkm);
  }
  const float mfixC = 128.f * gqm * gkm * QSCALE;
  const int nCfast = (mfixC < 60.f) ? nC : 0;
  auto fetch = [&]() {
    __syncthreads();
    if (threadIdx.x == 0) *s_item = atomicAdd(ctr, 1);
    __syncthreads();
    it = __builtin_amdgcn_readfirstlane(*s_item);
    __syncthreads();
  };
  auto build = [&](int ir, AttnArgs& a) {
    a.dry = dry;
    if (ir < nC + nBw) {
      const bool isB = ir >= nC;
      if (isB) ir -= nC;
      const int b = ir >> 7, h = (ir >> 4) & 7, qb = ir & 15;
      const int kvh = h >> 2;
      const int br = isB ? 0 : 1;
      const size_t qrow0 = (size_t)b * S + qb * 256;
      a.q = p.Q + qrow0 * 2048 + br * 1024 + h * 128;
      a.z = p.Z + qrow0 * 3072 + (br + 1) * 1024 + h * 128;
      const int kcol = br * 256 + kvh * 128, slot = br * 2 + kvh;
      a.kctx = p.Kb + ((size_t)RL + (size_t)b * L) * 512 + kcol;
      a.vctx = p.VtC + (size_t)(b * 4 + slot) * 128 * L;
      int k0, k1;
      if (isB) { k0 = qb * 256 - 128; if (k0 < 0) k0 = 0; k1 = qb * 256 + 384; if (k1 > S) k1 = S; }
      else { k0 = 0; k1 = S; }
      a.lat_key0 = k0;
      a.n_lat_tiles = (k1 - k0) >> 6;
      a.klat = p.Kb + ((size_t)b * S + k0) * 512 + kcol;
      a.vlat = p.VtL + (size_t)(b * 4 + slot) * 128 * S + k0;
      a.q_t0 = qb * 256;
      a.band = isB ? 1 : 0;
      a.has_sink = isB ? 1 : 0;
      a.sink_l2 = isB ? p.attn_sink[l * 8 + h] * LOG2E : 0.f;
      a.fixedm = isB ? 0 : 1; a.mfix = mfixC;
    } else {
      ir -= nC + nBw;
      const int h = ir & 7, br = (ir >> 3) & 1, b = ir >> 4;
      const int kvh = h >> 2;
      const size_t qrow0 = (size_t)RL + (size_t)b * L;
      a.q = p.Q + qrow0 * 2048 + br * 1024 + h * 128;
      a.z = p.Z + qrow0 * 3072 + (br + 1) * 1024 + h * 128;
      const int kcol = br * 256 + kvh * 128, slot = br * 2 + kvh;
      a.kctx = p.Kb + ((size_t)RL + (size_t)b * L) * 512 + kcol;
      a.vctx = p.VtC + (size_t)(b * 4 + slot) * 128 * L;
      a.klat = a.kctx; a.vlat = a.vctx;
      a.n_lat_tiles = 0; a.lat_key0 = 0; a.q_t0 = 0; a.band = 0;
      a.has_sink = (br == 0) ? 1 : 0;
      a.sink_l2 = (br == 0) ? p.attn_sink[l * 8 + h] * LOG2E : 0.f;
      a.fixedm = (br == 0) ? 0 : 1; a.mfix = mfixC;
    }
  };
  while (it < nLRU + nCfast) {
    AttnArgs a;
    build(it - nLRU, a);
    attn_item<true>(a, lds);
    fetch();
  }
  while (it < total) {
    AttnArgs a;
    build(it - nLRU, a);
    attn_item<false>(a, lds);
    fetch();
  }
}

DI void merge_tiles_ctx(CParams& p, int l, char* lds) {
  const int NB = p.NB, RL = NB * S, R = NB * (S + L);
  const int MT = (R - RL) / 256, NT = 8;
  const int tid = otid();
  const int lane = tid & 63, w = tid >> 6, wm = w >> 1, wn = w & 1, r = lane & 31, hh = lane >> 5;
  for (int ti = 0;; ++ti) {
    int mt, nt;
    if (!tile_map(ti, MT, NT, mt, nt)) break;
    const int m0 = RL + mt * 256, n0 = nt * 128;
    f32x16 tot[2][2];
#pragma unroll
    for (int i = 0; i < 2; ++i)
#pragma unroll
      for (int j = 0; j < 2; ++j)
#pragma unroll
        for (int x = 0; x < 16; ++x) tot[i][j][x] = 0.f;
#pragma unroll 1
    for (int n = 0; n < 3; ++n) {
      f32x16 acc[2][2];
      gemm_core<128, false>(p.Z + (size_t)m0 * 3072 + n * 1024, 3072, 64, (size_t)128 * 3072,
                            p.WbT + ((size_t)(l * 3 + n) * D + n0) * D, D, 64, 0, D, lds, acc);
#pragma unroll
      for (int i = 0; i < 2; ++i)
#pragma unroll
        for (int j = 0; j < 2; ++j)
#pragma unroll
          for (int g = 0; g < 4; ++g) {
            const size_t row = (size_t)m0 + wm * 64 + i * 32 + r;
            const int col = n0 + wn * 64 + j * 32 + 8 * g + 4 * hh;
            uint2 sv = *(const uint2*)(p.Ms + row * 3072 + n * 1024 + col);
            tot[i][j][4 * g + 0] += bflo(sv.x) * acc[i][j][4 * g + 0];
            tot[i][j][4 * g + 1] += bfhi(sv.x) * acc[i][j][4 * g + 1];
            tot[i][j][4 * g + 2] += bflo(sv.y) * acc[i][j][4 * g + 2];
            tot[i][j][4 * g + 3] += bfhi(sv.y) * acc[i][j][4 * g + 3];
          }
    }
#pragma unroll
    for (int i = 0; i < 2; ++i)
#pragma unroll
      for (int j = 0; j < 2; ++j)
#pragma unroll
        for (int g = 0; g < 4; ++g) {
          const size_t row = (size_t)m0 + wm * 64 + i * 32 + r;
          const int col = n0 + wn * 64 + j * 32 + 8 * g + 4 * hh;
          uint2 o; o.x = pack2(tot[i][j][4 * g], tot[i][j][4 * g + 1]); o.y = pack2(tot[i][j][4 * g + 2], tot[i][j][4 * g + 3]);
          *(uint2*)(p.Hb + row * D + col) = o;
        }
  }
}

struct MergeOrder {
  pg8::StaticOrder inner;
  __device__ void init(int M, int G, int c) { inner.init(M, 1024, G, c); }
  __device__ bool next(int i, pg8::Unit& u) const {
    const int j = i / 3, n = i - 3 * j;
    pg8::Unit t;
    if (!inner.next(j, t)) return false;
    u.pm = t.pm; u.pn = n * 4 + t.pn;
    return true;
  }
  __device__ __forceinline__ void a_ready(const pg8::Unit&) const {}
  __device__ __forceinline__ void done(const pg8::Unit&) const {}
  __device__ __forceinline__ size_t a_off(const pg8::Unit& u) const { return (size_t)(u.pn >> 2) * 1024 * 2; }
};
struct EpiMerge {
  static constexpr bool PERM = true, AFTER_DRAIN = false;
  CParams* kp;
  __device__ __forceinline__ void operator()(const pg8::f32x4 (&acc)[2][2][4][2], const pg8::Unit& u, int wr, int wc, int fr, int fq) const {
    const int n = u.pn >> 2, ct = u.pn & 3;
    const int row0 = u.pm * 256 + wr * 64 + fr;
    const int col0 = ct * 256 + wc * 32 + 8 * fq;
    const u16* __restrict__ sg = kp->Ms + n * 1024;
    const float* __restrict__ mrd = (const float*)kp->Q;
    float* __restrict__ mwr = (float*)kp->Q;
    u16* __restrict__ hb = kp->Hb;
#pragma unroll
    for (int am = 0; am < 4; ++am) {
      const int ai = am >> 1, mb = (am & 1) * 2;
      u32x4 sv[2][2];
      pg8::f32x4 pa[2][2][2];
#pragma unroll
      for (int mm = 0; mm < 2; ++mm) {
        const size_t row = (size_t)(row0 + ai * 128 + (mb + mm) * 16);
#pragma unroll
        for (int bj = 0; bj < 2; ++bj) {
          sv[mm][bj] = *(const u32x4*)(sg + row * 3072 + col0 + bj * 128);
          if (n > 0) {
            pa[mm][bj][0] = *(const pg8::f32x4*)(mrd + row * D + col0 + bj * 128);
            pa[mm][bj][1] = *(const pg8::f32x4*)(mrd + row * D + col0 + bj * 128 + 4);
          }
        }
      }
#pragma unroll
      for (int mm = 0; mm < 2; ++mm) {
        const size_t row = (size_t)(row0 + ai * 128 + (mb + mm) * 16);
#pragma unroll
        for (int bj = 0; bj < 2; ++bj) {
          pg8::f32x4 v0 = acc[ai][bj][mb + mm][0], v1 = acc[ai][bj][mb + mm][1];
          v0[0] *= bflo(sv[mm][bj].x); v0[1] *= bfhi(sv[mm][bj].x); v0[2] *= bflo(sv[mm][bj].y); v0[3] *= bfhi(sv[mm][bj].y);
          v1[0] *= bflo(sv[mm][bj].z); v1[1] *= bfhi(sv[mm][bj].z); v1[2] *= bflo(sv[mm][bj].w); v1[3] *= bfhi(sv[mm][bj].w);
          if (n > 0) { v0 += pa[mm][bj][0]; v1 += pa[mm][bj][1]; }
          if (n < 2) {
            *(pg8::f32x4*)(mwr + row * D + col0 + bj * 128) = v0;
            *(pg8::f32x4*)(mwr + row * D + col0 + bj * 128 + 4) = v1;
          } else {
            u32x4 w; w.x = pack2(v0[0], v0[1]); w.y = pack2(v0[2], v0[3]); w.z = pack2(v1[0], v1[1]); w.w = pack2(v1[2], v1[3]);
            *(u32x4*)(hb + row * D + col0 + bj * 128) = w;
          }
        }
      }
    }
  }
};

DI void phase_merge(CParams& p, int chunk, int l, char* lds) {
  const int NB = p.NB, RL = NB * S;
  const bool last = (l == DEPTH - 1);
  pg8::Gemm g{p.Z, p.WbT + (size_t)l * 3 * D * D, RL, 3 * D, D, 3072};
  MergeOrder Mo; Mo.init(RL, (int)gridDim.x, (int)blockIdx.x);
  EpiMerge E{&p};
  pg8::gemm_phase<EpiMerge, MergeOrder, false>((PG8_LAS unsigned char*)lds, g, Mo, E, nullptr);
  if (!last) merge_tiles_ctx(p, l, lds);
}

struct EpiOut {
  static constexpr bool PERM = false, AFTER_DRAIN = false;
  CParams* kp; int chunk, l;
  __device__ __forceinline__ void operator()(const pg8::f32x4 (&acc)[2][2][4][2], const pg8::Unit& u, int wr, int wc, int fr, int fq) const {
    const int NB = kp->NB, RL = NB * S;
    const int gr0 = u.pm * 256;
    const float* src; float* dst; int mrow;
    if (gr0 < RL) {
      const int b = gr0 / S, t = gr0 % S, bg = chunk * NB + b;
      const size_t off = ((size_t)bg * S + t) * D;
      src = (l == 0 ? kp->x : kp->out) + off; dst = kp->out + off; mrow = bg;
    } else {
      const int rc = gr0 - RL, b = rc / L, t = rc % L, bg = chunk * NB + b;
      const size_t off = ((size_t)bg * L + t) * D;
      src = (l == 0 ? kp->ctx : kp->xc) + off; dst = kp->xc + off; mrow = 16;
    }
    const int col0 = u.pn * 256 + wc * 32 + 4 * fq;
    const float* gate = kp->modv + ((size_t)l * 17 + mrow) * 3072 + 2048 + col0;
    pg8::f32x4 gv[2][2];
#pragma unroll
    for (int bj = 0; bj < 2; ++bj)
#pragma unroll
      for (int n = 0; n < 2; ++n) gv[bj][n] = *(const pg8::f32x4*)(gate + bj * 128 + n * 16);
    const int row0 = wr * 64 + fr;
#pragma unroll
    for (int ai = 0; ai < 2; ++ai)
#pragma unroll
      for (int m = 0; m < 4; ++m) {
        const size_t ro = (size_t)(row0 + ai * 128 + m * 16) * D + col0;
        pg8::f32x4 xv[2][2];
#pragma unroll
        for (int bj = 0; bj < 2; ++bj)
#pragma unroll
          for (int n = 0; n < 2; ++n) xv[bj][n] = *(const pg8::f32x4*)(src + ro + bj * 128 + n * 16);
#pragma unroll
        for (int bj = 0; bj < 2; ++bj)
#pragma unroll
          for (int n = 0; n < 2; ++n) {
            pg8::f32x4 o = xv[bj][n] + gv[bj][n] * acc[ai][bj][m][n];
            *(pg8::f32x4*)(dst + ro + bj * 128 + n * 16) = o;
          }
      }
  }
};

DI void phase_outproj(CParams& p, int chunk, int l, char* lds) {
  const int NB = p.NB, RL = NB * S, R = NB * (S + L);
  const bool last = (l == DEPTH - 1);
  const int rows = last ? RL : R;
  pg8::Gemm g{p.Hb, p.WoT + (size_t)l * D * D, rows, D, D, D};
  pg8::StaticOrder So; So.init(rows, D, (int)gridDim.x, (int)blockIdx.x);
  EpiOut E{&p, chunk, l};
  pg8::gemm_phase<EpiOut, pg8::StaticOrder, false>((PG8_LAS unsigned char*)lds, g, So, E, nullptr);
}

DI void phase_final(CParams& p) {
  const int tid_ = otid();
  const int lane = tid_ & 63;
  const int wg = blockIdx.x * 8 + (tid_ >> 6), nw = gridDim.x * 8;
  for (int r = wg; r < NBATCH * S; r += nw) {
    float* src = p.out + (size_t)r * D;
    float4 v[4]; float ss = 0.f;
#pragma unroll
    for (int i = 0; i < 4; ++i) {
      v[i] = *(const float4*)(src + i * 256 + lane * 4);
      ss += v[i].x * v[i].x + v[i].y * v[i].y + v[i].z * v[i].z + v[i].w * v[i].w;
    }
#pragma unroll
    for (int o = 32; o >= 1; o >>= 1) ss += __shfl_xor(ss, o);
    float rstd = rsqrtf(ss * (1.f / D) + EPS);
#pragma unroll
    for (int i = 0; i < 4; ++i) {
      int cidx = i * 256 + lane * 4;
      float4 gg = *(const float4*)(p.final_g + cidx);
      float4 o;
      o.x = v[i].x * rstd * gg.x; o.y = v[i].y * rstd * gg.y; o.z = v[i].z * rstd * gg.z; o.w = v[i].w * rstd * gg.w;
      *(float4*)(src + cidx) = o;
    }
  }
}

#ifndef DUP_PHASE
#define DUP_PHASE 0
#endif
__global__ void __launch_bounds__(NTHR, 2) fwd_megakernel(Params p_unused) {
  CParams* kp = (CParams*)__builtin_amdgcn_kernarg_segment_ptr();
  cg::grid_group grid = cg::this_grid();
  __shared__ __attribute__((aligned(16))) char lds[LDS_BYTES];
  phase0(*opaque_kp(kp), lds);
  grid.sync();
  phase_mod(*opaque_kp(kp), lds);
  grid.sync();
  for (int chunk = 0; chunk < kp->nchunk; ++chunk) {
    for (int l = 0; l < DEPTH; ++l) {
      phase_prenorm(*opaque_kp(kp), chunk, l);
      grid.sync();
#if DUP_PHASE == 9
      grid.sync(); grid.sync(); grid.sync(); grid.sync(); grid.sync();
#endif
      phase_gemm_in(*opaque_kp(kp), chunk, l, lds);
      grid.sync();
#if DUP_PHASE == 3
      phase_gemm_in(*opaque_kp(kp), chunk, l, lds);
      grid.sync();
#endif
#if DUP_PHASE == 4
      phase_mixers(*opaque_kp(kp), chunk, l, lds, 1);
      grid.sync();
#endif
#if DUP_PHASE == 6
      phase_mixers(*opaque_kp(kp), chunk, l, lds, 2);
      grid.sync();
#endif
      phase_mixers(*opaque_kp(kp), chunk, l, lds);
      grid.sync();
      phase_merge(*opaque_kp(kp), chunk, l, lds);
      grid.sync();
#if DUP_PHASE == 5
      phase_merge(*opaque_kp(kp), chunk, l, lds);
      grid.sync();
#endif
      phase_outproj(*opaque_kp(kp), chunk, l, lds);
      grid.sync();
    }
  }
  phase_final(*opaque_kp(kp));
}

extern "C" void kernel_launch(void* const* d_in, const int* in_sizes, int n_in,
                              void* d_out, int out_size, void* d_ws, size_t ws_size,
                              hipStream_t stream) {
  static int grid_blocks = 0;
  if (!grid_blocks) {
    int dev = 0, cus = 0, per_cu = 0;
    (void)hipGetDevice(&dev);
    (void)hipDeviceGetAttribute(&cus, hipDeviceAttributeMultiprocessorCount, dev);
    (void)hipOccupancyMaxActiveBlocksPerMultiprocessor(&per_cu, fwd_megakernel, NTHR, 0);
    if (per_cu > 1) per_cu = 1;
    if (per_cu < 1) per_cu = 1;
    grid_blocks = cus * per_cu;
  }
  Params p{};
  const float* const* in = (const float* const*)d_in;
  p.x = in[0]; p.c = in[1]; p.ctx = in[2]; p.c_ctx = in[3]; p.norm_g = in[4]; p.w_mod = in[5]; p.b_mod = in[6];
  p.w_in = in[7]; p.conv_w = in[8]; p.conv_b = in[9]; p.lru_wa = in[10]; p.lru_ba = in[11]; p.lru_wx = in[12];
  p.lru_bx = in[13]; p.lru_lambda = in[14]; p.attn_sink = in[15]; p.q_norm_g = in[16]; p.k_norm_g = in[17];
  p.w_branch = in[18]; p.w_out = in[19]; p.final_g = in[20];
  p.out = (float*)d_out;
  char* ws = (char*)d_ws;
  size_t off = 0;
  auto take = [&](size_t bytes) { char* r = ws + off; off += (bytes + 255) & ~(size_t)255; return r; };
  p.ctr = (int*)take(256);
  p.modv = (float*)take((size_t)DEPTH * 17 * 3072 * 4);
  p.sc = (float*)take((size_t)17 * D * 4);
  p.rope = (float*)take(4096 * 4);
  p.xc = (float*)take((size_t)NBATCH * L * D * 4);
  p.WinT = (u16*)take((size_t)DEPTH * INW * D * 2);
  p.WbT = (u16*)take((size_t)DEPTH * 3 * D * D * 2);
  p.WoT = (u16*)take((size_t)DEPTH * D * D * 2);
  const size_t fixed = off;
  int NB = 8;
  while (NB > 1) {
    size_t R = (size_t)NB * (S + L);
    size_t need = fixed + R * (size_t)(1024 + 1024 + 3072 + 2048 + 512 + 512 + 3072) * 2 + 8 * 256;
    if (need <= ws_size) break;
    NB >>= 1;
  }
  p.NB = NB; p.nchunk = NBATCH / NB;
  const size_t R = (size_t)NB * (S + L);
  p.Hb = (u16*)take(R * 1024 * 2);
  p.U = (u16*)take(R * 1024 * 2);
  p.Z = (u16*)take(R * 3072 * 2);
  p.Q = (u16*)take(R * 2048 * 2);
  p.Kb = (u16*)take(R * 512 * 2);
  p.VtL = (u16*)take((size_t)NB * 4 * 128 * S * 2);
  p.VtC = (u16*)take((size_t)NB * 4 * 128 * L * 2);
  p.Ms = (u16*)take(R * 3072 * 2);
  void* args[] = {&p};
  hipError_t e = hipLaunchCooperativeKernel((void*)fwd_megakernel, dim3(grid_blocks), dim3(NTHR), args, 0, stream);
  if (e != hipSuccess) fprintf(stderr, "cooperative launch failed: %s (grid %d)\n", hipGetErrorString(e), grid_blocks);
}
```

```cpp
#include <hip/hip_runtime.h>
#include <hip/hip_cooperative_groups.h>
#include <cstdio>
#include <cstdint>
namespace cg = cooperative_groups;

typedef unsigned short u16;
typedef __attribute__((ext_vector_type(8))) short bf16x8;
typedef __attribute__((ext_vector_type(4))) short s16x4;
typedef __attribute__((ext_vector_type(16))) float f32x16;
typedef __bf16 bf16x2_t __attribute__((ext_vector_type(2)));
typedef float float2_t __attribute__((ext_vector_type(2)));
typedef __attribute__((ext_vector_type(4))) unsigned u32x4;
typedef __attribute__((ext_vector_type(2))) unsigned u32x2;

#define DI __device__ __forceinline__
#define MFMA32(a, b, c) __builtin_amdgcn_mfma_f32_32x32x16_bf16((a), (b), (c), 0, 0, 0)

constexpr int D = 1024, NBATCH = 16, S = 4096, L = 256, DEPTH = 4, INW = 10240;
constexpr int LDS_BYTES = 147456;
constexpr int NTHR = 512;
constexpr float EPS = 1e-6f;
constexpr float QSCALE = 0.08838834764831845f * 1.4426950408889634f;
constexpr float LOG2E = 1.4426950408889634f;

struct Params {
  const float *x, *c, *ctx, *c_ctx, *norm_g, *w_mod, *b_mod, *w_in, *conv_w, *conv_b, *lru_wa, *lru_ba, *lru_wx, *lru_bx,
      *lru_lambda, *attn_sink, *q_norm_g, *k_norm_g, *w_branch, *w_out, *final_g;
  float* out;
  u16 *WinT, *WbT, *WoT;
  u16 *Hb, *U, *Z, *Q, *Kb, *VtL, *VtC, *Ms;
  float *modv, *sc, *rope, *xc;
  int* ctr;
  int NB;
  int nchunk;
};

typedef const __attribute__((address_space(4))) Params CParams;
DI CParams* opaque_kp(CParams* q) { asm volatile("" : "+s"(q)); return q; }

DI unsigned pack2(float a, float b) {
  float2_t f = {a, b};
  bf16x2_t v = __builtin_convertvector(f, bf16x2_t);
  return __builtin_bit_cast(unsigned, v);
}
DI float bf2f(u16 v) { return __uint_as_float(((unsigned)v) << 16); }
DI float bflo(unsigned v) { return __uint_as_float(v << 16); }
DI float bfhi(unsigned v) { return __uint_as_float(v & 0xffff0000u); }
DI float sigmoidf_(float x) { return __builtin_amdgcn_rcpf(1.f + __expf(-x)); }
DI float siluf_(float x) { return x * __builtin_amdgcn_rcpf(1.f + __expf(-x)); }
DI int otid() { int t = threadIdx.x; asm volatile("" : "+v"(t)); return t; }
DI int crow(int i, int hh) { return (i & 3) + 8 * (i >> 2) + 4 * hh; }

DI void phase0(CParams& p, char* lds) {
  const int tid = otid();
  float* tile = (float*)lds;
  const int n_in = DEPTH * 16 * 160, n_b = DEPTH * 3 * 256, n_o = DEPTH * 256;
  for (int it = blockIdx.x; it < n_in + n_b + n_o; it += gridDim.x) {
    const float* src; u16* dst; int ldsrc; int dstride = 64;
    if (it < n_in) {
      int l = it / 2560, rem = it % 2560, kt = rem / 160, nt = rem % 160;
      src = p.w_in + (size_t)l * D * INW + (size_t)(kt * 64) * INW + nt * 64; ldsrc = INW;
      const int o = nt >> 2;
      const int n256 = (o < 8) ? o : (o >= 28) ? 16 + (o - 28) : (o >= 24) ? 12 + (o - 24) : (o == 23) ? 39 : (o == 22) ? 38
                     : (o >= 18) ? 34 + (o - 18) : (o >= 14) ? 8 + (o - 14) : (o == 13) ? 33 : (o == 12) ? 32 : 28 + (o - 8);
      dst = p.WinT + (size_t)l * INW * D + ((size_t)n256 * 256 + (nt & 3) * 64) * D + kt * 64; dstride = D;
    } else if (it < n_in + n_b) {
      int i2 = it - n_in; int mat = i2 / 256, rem = i2 % 256, kt = rem / 16, nt = rem % 16;
      src = p.w_branch + (size_t)mat * D * D + (size_t)(kt * 64) * D + nt * 64; ldsrc = D;
      dst = p.WbT + (size_t)mat * D * D + (size_t)(nt * 64) * D + kt * 64; dstride = D;
    } else {
      int i2 = it - n_in - n_b; int mat = i2 / 256, rem = i2 % 256, kt = rem / 16, nt = rem % 16;
      src = p.w_out + (size_t)mat * D * D + (size_t)(kt * 64) * D + nt * 64; ldsrc = D;
      dst = p.WoT + (size_t)mat * D * D + (size_t)(nt * 64) * D + kt * 64; dstride = D;
    }
    __syncthreads();
#pragma unroll
    for (int i = 0; i < 2; ++i) {
      int c = tid + NTHR * i; int row = c >> 4, c4 = c & 15;
      float4 v = *(const float4*)(src + (size_t)row * ldsrc + c4 * 4);
      float* t = tile + row * 65 + c4 * 4;
      t[0] = v.x; t[1] = v.y; t[2] = v.z; t[3] = v.w;
    }
    __syncthreads();
    {
      int c = tid; int nrow = c >> 3, k8 = c & 7;
      float v[8];
#pragma unroll
      for (int j = 0; j < 8; ++j) v[j] = tile[(k8 * 8 + j) * 65 + nrow];
      uint4 o; o.x = pack2(v[0], v[1]); o.y = pack2(v[2], v[3]); o.z = pack2(v[4], v[5]); o.w = pack2(v[6], v[7]);
      *(uint4*)(dst + (size_t)nrow * dstride + k8 * 8) = o;
    }
  }
  const int gt = blockIdx.x * NTHR + tid, gn = gridDim.x * NTHR;
  for (int i = gt; i < 17 * D; i += gn) {
    int r = i / D, k = i % D;
    float v = (r < 16) ? p.c[r * D + k] : p.c_ctx[k];
    p.sc[i] = siluf_(v);
  }
  for (int i = gt; i < 64 * 32; i += gn) {
    int pos = i >> 5, pp = i & 31;
    float inv = powf(10000.f, -(float)pp / 32.f);
    float ang = (float)pos * inv;
    p.rope[i] = cosf(ang);
    p.rope[2048 + i] = sinf(ang);
  }
  if (blockIdx.x == 0 && tid < 64) p.ctr[tid] = 0;
}

DI void phase_mod(CParams& p, char* lds) {
  const int tid = otid();
  float* red = (float*)lds;
  const int col = tid & 63, kg = tid >> 6;
  for (int it = blockIdx.x; it < DEPTH * 48; it += gridDim.x) {
    int l = it / 48, cb = it % 48;
    float acc[17];
#pragma unroll
    for (int r = 0; r < 17; ++r) acc[r] = 0.f;
    const float* w = p.w_mod + (size_t)l * D * 3072 + cb * 64 + col;
    for (int k = kg * 128; k < kg * 128 + 128; ++k) {
      float wv = w[(size_t)k * 3072];
#pragma unroll
      for (int r = 0; r < 17; ++r) acc[r] += p.sc[r * D + k] * wv;
    }
    __syncthreads();
#pragma unroll
    for (int r = 0; r < 17; ++r) red[(kg * 17 + r) * 64 + col] = acc[r];
    __syncthreads();
    for (int i = tid; i < 17 * 64; i += NTHR) {
      int r = i >> 6, cc = i & 63;
      float s = 0.f;
#pragma unroll
      for (int g = 0; g < 8; ++g) s += red[(g * 17 + r) * 64 + cc];
      p.modv[((size_t)l * 17 + r) * 3072 + cb * 64 + cc] = s + p.b_mod[l * 3072 + cb * 64 + cc];
    }
  }
}

DI void phase_prenorm(CParams& p, int chunk, int l) {
  const int NB = p.NB, RL = NB * S, R = NB * (S + L);
  const int tid_ = otid();
  const int lane = tid_ & 63;
  const int wg = blockIdx.x * 8 + (tid_ >> 6), nw = gridDim.x * 8;
  const float* g = p.norm_g + l * D;
  for (int r = wg; r < R; r += nw) {
    const float* src; int mrow;
    if (r < RL) {
      int b = r / S, t = r % S; int bg = chunk * NB + b;
      src = (l == 0 ? p.x : p.out) + ((size_t)bg * S + t) * D; mrow = bg;
    } else {
      int rc = r - RL; int b = rc / L, t = rc % L; int bg = chunk * NB + b;
      src = (l == 0 ? p.ctx : p.xc) + ((size_t)bg * L + t) * D; mrow = 16;
    }
    const float* mv = p.modv + ((size_t)l * 17 + mrow) * 3072;
    float4 v[4]; float ss = 0.f;
#pragma unroll
    for (int i = 0; i < 4; ++i) {
      v[i] = *(const float4*)(src + i * 256 + lane * 4);
      ss += v[i].x * v[i].x + v[i].y * v[i].y + v[i].z * v[i].z + v[i].w * v[i].w;
    }
#pragma unroll
    for (int o = 32; o >= 1; o >>= 1) ss += __shfl_xor(ss, o);
    float rstd = rsqrtf(ss * (1.f / D) + EPS);
#pragma unroll
    for (int i = 0; i < 4; ++i) {
      int cidx = i * 256 + lane * 4;
      float4 gg = *(const float4*)(g + cidx);
      float4 sh = *(const float4*)(mv + cidx);
      float4 scl = *(const float4*)(mv + 1024 + cidx);
      float h0 = v[i].x * rstd * gg.x * (1.f + scl.x) + sh.x;
      float h1 = v[i].y * rstd * gg.y * (1.f + scl.y) + sh.y;
      float h2 = v[i].z * rstd * gg.z * (1.f + scl.z) + sh.z;
      float h3 = v[i].w * rstd * gg.w * (1.f + scl.w) + sh.w;
      uint2 o; o.x = pack2(h0, h1); o.y = pack2(h2, h3);
      *(uint2*)(p.Hb + (size_t)r * D + cidx) = o;
    }
  }
}

template <int BN, bool PIPE>
DI void gemm_core(const u16* A, int lda, int ksa, size_t a_blk, const u16* Bt, int ldb, int ksb, size_t b_blk, int K, char* ldsc,
                  f32x16 (&acc)[BN / 64][2]) {
  constexpr int MI = BN / 64;
  constexpr int SS = 32768 + BN * 128;
  const int tid = otid(), lane = tid & 63, w = tid >> 6;
  const int wm = (BN == 256) ? (w >> 2) : (w >> 1), wn = (BN == 256) ? (w & 3) : (w & 1);
  const int r = lane & 31, hh = lane >> 5;
  const int drow = lane >> 3, dcp = lane & 7;
  const int chunk0 = dcp ^ (drow >> 1);
  const u16* gAe = A + (size_t)(w >> 2) * a_blk + (size_t)((w & 3) * 32 + drow) * lda + chunk0 * 8;
  const u16* gAo = gAe + (size_t)8 * lda + ((chunk0 ^ 4) - chunk0) * 8;
  const size_t a16 = (size_t)16 * lda;
  const int brow0 = (BN == 256) ? (w & 3) * 32 : w * 16;
  const u16* gBe = Bt + ((BN == 256) ? (size_t)(w >> 2) * b_blk : (size_t)0) + (size_t)(brow0 + drow) * ldb + chunk0 * 8;
  const u16* gBo = gBe + (size_t)8 * ldb + ((chunk0 ^ 4) - chunk0) * 8;
  const size_t b16 = (size_t)16 * ldb;
#pragma unroll
  for (int i = 0; i < MI; ++i)
#pragma unroll
    for (int j = 0; j < 2; ++j)
#pragma unroll
      for (int x = 0; x < 16; ++x) acc[i][j][x] = 0.f;
  auto DMA = [&](int kt, int stage) {
    char* sa = ldsc + stage * SS + (w * 4) * 1024;
    char* sb = ldsc + stage * SS + 32768 + ((BN == 256) ? (w * 4) : (w * 2)) * 1024;
    const size_t ka = (size_t)kt * ksa, kb = (size_t)kt * ksb;
    __builtin_amdgcn_global_load_lds((const unsigned*)(gAe + ka), (unsigned*)(sa), 16, 0, 0);
    __builtin_amdgcn_global_load_lds((const unsigned*)(gBe + kb), (unsigned*)(sb), 16, 0, 0);
    __builtin_amdgcn_global_load_lds((const unsigned*)(gAo + ka), (unsigned*)(sa + 1024), 16, 0, 0);
    __builtin_amdgcn_global_load_lds((const unsigned*)(gBo + kb), (unsigned*)(sb + 1024), 16, 0, 0);
    __builtin_amdgcn_global_load_lds((const unsigned*)(gAe + a16 + ka), (unsigned*)(sa + 2048), 16, 0, 0);
    __builtin_amdgcn_global_load_lds((const unsigned*)(gAo + a16 + ka), (unsigned*)(sa + 3072), 16, 0, 0);
    if (BN == 256) {
      __builtin_amdgcn_global_load_lds((const unsigned*)(gBe + b16 + kb), (unsigned*)(sb + 2048), 16, 0, 0);
      __builtin_amdgcn_global_load_lds((const unsigned*)(gBo + b16 + kb), (unsigned*)(sb + 3072), 16, 0, 0);
    }
  };
  const int sw = (r >> 1) & 7;
  int koff[4];
#pragma unroll
  for (int ks = 0; ks < 4; ++ks) koff[ks] = ((2 * ks + hh) ^ sw) << 4;
  auto COMPUTE = [&](int stage) {
    const char* ab = ldsc + stage * SS + (wm * (MI * 32) + r) * 128;
    const char* bb = ldsc + stage * SS + 32768 + (wn * 64 + r) * 128;
    bf16x8 fa[2][MI], fb[2][2];
    auto LDF = [&](int ks, int slot) {
#pragma unroll
      for (int i = 0; i < MI; ++i) fa[slot][i] = *(const bf16x8*)(ab + i * 32 * 128 + koff[ks]);
#pragma unroll
      for (int j = 0; j < 2; ++j) fb[slot][j] = *(const bf16x8*)(bb + j * 32 * 128 + koff[ks]);
    };
    auto MM = [&](int slot) {
#pragma unroll
      for (int i = 0; i < MI; ++i)
#pragma unroll
        for (int j = 0; j < 2; ++j) acc[i][j] = MFMA32(fb[slot][j], fa[slot][i], acc[i][j]);
    };
    if (!PIPE) {
#pragma unroll
      for (int ks = 0; ks < 4; ++ks) { LDF(ks, 0); MM(0); }
      return;
    }
    LDF(0, 0); LDF(1, 1);
    __builtin_amdgcn_sched_barrier(0);
    MM(0); LDF(2, 0);
    __builtin_amdgcn_sched_barrier(0);
    MM(1); LDF(3, 1);
    __builtin_amdgcn_sched_barrier(0);
    MM(0); MM(1);
  };
  const int KT = K >> 6;
  __syncthreads();
  DMA(0, 0);
  __syncthreads();
  for (int kt = 0; kt < KT; kt += 2) {
    DMA(kt + 1, 1);
    COMPUTE(0);
    __syncthreads();
    if (kt + 2 < KT) DMA(kt + 2, 0);
    COMPUTE(1);
    __syncthreads();
  }
}

template <int MI>
DI void stage_acc(char* ldsc, f32x16 (&acc)[MI][2], int wm, int ncol0, bool active) {
  const int tid = otid(), lane = tid & 63;
  const int r = lane & 31, hh = lane >> 5;
  float* Cs = (float*)ldsc;
  if (active) {
#pragma unroll
    for (int i = 0; i < MI; ++i)
#pragma unroll
      for (int j = 0; j < 2; ++j)
#pragma unroll
        for (int g = 0; g < 4; ++g) {
          int m = wm * (MI * 32) + i * 32 + r;
          int n = ncol0 + j * 32 + 8 * g + 4 * hh;
          float4 v; v.x = acc[i][j][4 * g]; v.y = acc[i][j][4 * g + 1]; v.z = acc[i][j][4 * g + 2]; v.w = acc[i][j][4 * g + 3];
          *(float4*)(Cs + m * 132 + n) = v;
        }
  }
  __syncthreads();
}

DI void read_row64(const char* ldsc, int row, int half, float (&v)[64]) {
  const float* Cs = (const float*)ldsc + row * 132 + half * 64;
#pragma unroll
  for (int j = 0; j < 16; ++j) {
    float4 t = *(const float4*)(Cs + j * 4);
    v[j * 4] = t.x; v[j * 4 + 1] = t.y; v[j * 4 + 2] = t.z; v[j * 4 + 3] = t.w;
  }
}

DI void store_row64_bf16(u16* dst, const float (&v)[64]) {
#pragma unroll
  for (int j = 0; j < 8; ++j) {
    uint4 o;
    o.x = pack2(v[j * 8], v[j * 8 + 1]); o.y = pack2(v[j * 8 + 2], v[j * 8 + 3]);
    o.z = pack2(v[j * 8 + 4], v[j * 8 + 5]); o.w = pack2(v[j * 8 + 6], v[j * 8 + 7]);
    *(uint4*)(dst + j * 8) = o;
  }
}

namespace pg8 {
#define PG8_LAS __attribute__((address_space(3)))
typedef unsigned short bf16_t;
typedef short bf16x8 __attribute__((ext_vector_type(8)));
typedef float f32x4 __attribute__((ext_vector_type(4)));
typedef unsigned u32x4 __attribute__((ext_vector_type(4)));
constexpr int BM = 256, BK = 64, HALF = 128, HTB = HALF * BK * 2  , STAGE_BYTES = 8 * HTB, NXCD = 8, WGM = 8;

__host__ __device__ __forceinline__ int lds_byte(int r, int c) { const int st = (r >> 4) * 2 + (c >> 5), rr = r & 15, cc = c & 31, ob = rr * 64 + cc * 2; return st * 1024 + (ob ^ (((ob >> 9) & 1) << 5)); }
__host__ __device__ __forceinline__ void stage_rc(int b, int& R, int& C) { const int st = b / 1024, sb = b % 1024, swz = sb ^ (((sb >> 9) & 1) << 5); R = (st >> 1) * 16 + swz / 64; C = (st & 1) * 32 + (swz % 64) / 2; }
__host__ __device__ __forceinline__ int perm32(int rho) { const int n = rho >> 4, i = rho & 15; return 8 * (i >> 2) + 4 * n + (i & 3); }
struct Unit { int pm, pn; };
struct Gemm { const bf16_t* A; const bf16_t* Bt; int M, N, K; int lda; };
struct StaticOrder {
    int nM, nN, nwg, G, c;
    __host__ __device__ void init(int M, int N, int G_, int c_) { nM = M / BM; nN = N / BM; nwg = nM * nN; G = G_; c = c_; }
    __host__ __device__ bool next(int i, Unit& u) const {
        const long L = (long)i * G + c; if (L >= nwg) return false;
        int wgid = (int)L; { const int q = nwg / NXCD, r = nwg % NXCD, xcd = wgid % NXCD, off = wgid / NXCD; wgid = (xcd < r ? xcd * (q + 1) : r * (q + 1) + (xcd - r) * q) + off; }
        const int nig = WGM * nN, gid = wgid / nig, fm = gid * WGM, gsz = (nM - fm) < WGM ? (nM - fm) : WGM;
        u.pm = fm + ((wgid % nig) % gsz); u.pn = (wgid % nig) / gsz; return true;
    }
    __device__ __forceinline__ void a_ready(const Unit&) const {}
    __device__ __forceinline__ void done(const Unit&) const {}
    __device__ __forceinline__ size_t a_off(const Unit&) const { return 0; }
};
template <class Epi, class Sched, bool STAMP = false>
__device__ __forceinline__ void gemm_phase(PG8_LAS unsigned char* lds, const Gemm g, const Sched& S, const Epi& E, unsigned long long* stamps) {
    int tid_raw = threadIdx.x; asm volatile("" : "+v"(tid_raw));
    const int tid = tid_raw, wid = __builtin_amdgcn_readfirstlane(tid >> 6), lane = tid & 63, wr = wid >> 2, wc = wid & 3, fr = lane & 15, fq = lane >> 4;
    const int K = g.K, nt = K / BK;
    int ts_lo = 0, ts_hi = 0, nts = 0; const unsigned long long rt_entry = STAMP ? (unsigned long long)wall_clock64() : 0ull;
#define PG8_STAMP() do { if (STAMP && wid == 0 && nts < 64) { const unsigned long long _c = (unsigned long long)clock64(); \
        ts_lo = (lane == nts) ? (int)(unsigned)_c : ts_lo; ts_hi = (lane == nts) ? (int)(unsigned)(_c >> 32) : ts_hi; ++nts; } } while (0)
    PG8_STAMP();
    unsigned voffA[2], voffB[2];
#pragma unroll
    for (int i = 0; i < 2; ++i) { int R, C; stage_rc(tid * 16 + i * 8192, R, C); const int Rb = Epi::PERM ? ((R & ~31) + perm32(R & 31)) : R;
        voffA[i] = (unsigned)(R * g.lda + C) * 2u; voffB[i] = (unsigned)(Rb * K + C) * 2u; }
    const size_t kstep = (size_t)(BK * 2);
    const size_t hstep = (size_t)HALF * K * 2;
    const size_t tstep = 2 * hstep;
    const size_t hstepA = (size_t)HALF * g.lda * 2, tstepA = 2 * hstepA;
    const unsigned ldsw = (unsigned)wid * 1024u;
    const int aoff = lds_byte(wr * 64 + fr, fq * 8), boff = lds_byte(wc * 32 + fr, fq * 8);
#define PG8_SA(b, h) (((b) * 2 + (h)) * HTB)
#define PG8_SB(b, h) ((4 + (b) * 2 + (h)) * HTB)
#define PG8_STAGE(bufoff, gbase, voff) do { _Pragma("unroll") for (int _i = 0; _i < 2; ++_i) \
        __builtin_amdgcn_global_load_lds((const unsigned*)((const char*)(gbase) + (voff)[_i]), (PG8_LAS unsigned*)(lds + (bufoff) + ldsw + _i * 8192), 16, 0, 0); } while (0)
#define PG8_LDA(dst, b, h) do { _Pragma("unroll") for (int m = 0; m < 4; ++m) _Pragma("unroll") for (int k = 0; k < 2; ++k) dst[m][k] = *(const PG8_LAS bf16x8*)(lds + PG8_SA(b, h) + aoff + m * 2048 + k * 1024); } while (0)
#define PG8_LDB(dst, b, h) do { _Pragma("unroll") for (int n = 0; n < 2; ++n) _Pragma("unroll") for (int k = 0; k < 2; ++k) dst[n][k] = *(const PG8_LAS bf16x8*)(lds + PG8_SB(b, h) + boff + n * 2048 + k * 1024); } while (0)
#define PG8_MMA(ai, bj, At, Bt) do { __builtin_amdgcn_s_setprio(1); _Pragma("unroll") for (int m = 0; m < 4; ++m) _Pragma("unroll") for (int n = 0; n < 2; ++n) _Pragma("unroll") for (int k = 0; k < 2; ++k) \
        acc[ai][bj][m][n] = __builtin_amdgcn_mfma_f32_16x16x32_bf16(Bt[n][k], At[m][k], acc[ai][bj][m][n], 0, 0, 0); __builtin_amdgcn_s_setprio(0); } while (0)
#define PG8_WAIT_V(n) asm volatile("s_waitcnt vmcnt(" #n ")" ::: "memory")
#define PG8_WAIT_L(n) asm volatile("s_waitcnt lgkmcnt(" #n ")" ::: "memory")
#define PG8_BAR __builtin_amdgcn_s_barrier()
#define PG8_SCHED __builtin_amdgcn_sched_barrier(0)
    Unit cur, nxt; int ui = 0;
    if (!S.next(0, cur)) return;
    f32x4 acc[2][2][4][2];
#pragma unroll
    for (int a = 0; a < 2; ++a)
#pragma unroll
        for (int b = 0; b < 2; ++b)
#pragma unroll
            for (int m = 0; m < 4; ++m)
#pragma unroll
                for (int n = 0; n < 2; ++n) acc[a][b][m][n] = (f32x4){0.f, 0.f, 0.f, 0.f};
    bf16x8 At[4][2], B0[2][2], B1[2][2];
    const char* cA = (const char*)g.A + (size_t)cur.pm * tstepA + S.a_off(cur); const char* cB = (const char*)g.Bt + (size_t)cur.pn * tstep;
    S.a_ready(cur);
    PG8_STAGE(PG8_SB(0, 0), cB, voffB); PG8_STAGE(PG8_SA(0, 0), cA, voffA); PG8_STAGE(PG8_SB(0, 1), cB + hstep, voffB); PG8_STAGE(PG8_SA(0, 1), cA + hstepA, voffA);
    if (wr == 1) PG8_BAR;
    PG8_WAIT_V(4); PG8_BAR;
    PG8_STAGE(PG8_SB(1, 0), cB + kstep, voffB); PG8_STAGE(PG8_SA(1, 0), cA + kstep, voffA); PG8_STAGE(PG8_SB(1, 1), cB + hstep + kstep, voffB);
    PG8_WAIT_V(6); PG8_BAR;
    PG8_STAMP();
    for (;;) {
        const bool has_next = S.next(ui + 1, nxt);
        const char* nA = has_next ? (const char*)g.A + (size_t)nxt.pm * tstepA + S.a_off(nxt) : cA; const char* nB = has_next ? (const char*)g.Bt + (size_t)nxt.pn * tstep : cB;
        for (int t = 0; t < nt; t += 2) {
            const bool last = (t == nt - 2);
            const char* a1 = cA + (size_t)(t + 1) * kstep;
            const char* a2 = last ? nA : cA + (size_t)(t + 2) * kstep; const char* b2 = last ? nB : cB + (size_t)(t + 2) * kstep;
            const char* a3 = a2 + kstep; const char* b3 = b2 + kstep;
            if (last && has_next) S.a_ready(nxt);
            PG8_LDB(B0, 0, 0); PG8_SCHED; PG8_LDA(At, 0, 0); PG8_STAGE(PG8_SA(1, 1), a1 + hstepA, voffA);
            PG8_WAIT_L(8); PG8_BAR; PG8_WAIT_L(0); PG8_MMA(0, 0, At, B0); PG8_BAR; PG8_SCHED;
            PG8_LDB(B1, 0, 1); PG8_STAGE(PG8_SB(0, 0), b2, voffB);
            PG8_BAR; PG8_WAIT_L(0); PG8_MMA(0, 1, At, B1); PG8_BAR;
            PG8_LDA(At, 0, 1); PG8_STAGE(PG8_SA(0, 0), a2, voffA);
            PG8_BAR; PG8_WAIT_L(0); PG8_MMA(1, 0, At, B0); PG8_BAR; PG8_SCHED;
            PG8_STAGE(PG8_SB(0, 1), b2 + hstep, voffB);
            PG8_WAIT_V(6); PG8_BAR; PG8_MMA(1, 1, At, B1); PG8_BAR;
            PG8_LDB(B0, 1, 0); PG8_SCHED; PG8_LDA(At, 1, 0); PG8_STAGE(PG8_SA(0, 1), a2 + hstepA, voffA);
            PG8_WAIT_L(8); PG8_BAR; PG8_WAIT_L(0); PG8_MMA(0, 0, At, B0); PG8_BAR; PG8_SCHED;
            PG8_LDB(B1, 1, 1); PG8_STAGE(PG8_SB(1, 0), b3, voffB);
            PG8_BAR; PG8_WAIT_L(0); PG8_MMA(0, 1, At, B1); PG8_BAR;
            PG8_LDA(At, 1, 1); PG8_STAGE(PG8_SA(1, 0), a3, voffA);
            PG8_BAR; PG8_WAIT_L(0); PG8_MMA(1, 0, At, B0); PG8_BAR; PG8_SCHED;
            PG8_STAGE(PG8_SB(1, 1), b3 + hstep, voffB);
            PG8_WAIT_V(6); PG8_BAR; PG8_MMA(1, 1, At, B1); PG8_BAR;
        }
        PG8_STAMP();
        if constexpr (!Epi::AFTER_DRAIN) { E(acc, cur, wr, wc, fr, fq); S.done(cur); }
        PG8_STAMP();
        if (!has_next) break;
#pragma unroll
        for (int a = 0; a < 2; ++a)
#pragma unroll
            for (int b = 0; b < 2; ++b)
#pragma unroll
                for (int m = 0; m < 4; ++m)
#pragma unroll
                    for (int n = 0; n < 2; ++n) acc[a][b][m][n] = (f32x4){0.f, 0.f, 0.f, 0.f};
        cur = nxt; cA = nA; cB = nB; ++ui;
    }
    PG8_WAIT_V(0);
    if (wr == 0) PG8_BAR;
    PG8_BAR;
    if constexpr (Epi::AFTER_DRAIN) { E.fused(acc, cur, wr, wc, fr, fq, lds, wid, lane); S.done(cur); }
    PG8_STAMP();
    if (STAMP && wid == 0) { stamps[lane] = lane < nts ? (((unsigned long long)(unsigned)ts_hi << 32) | (unsigned)ts_lo) : 0ull;
        if (lane == 62) stamps[62] = rt_entry; if (lane == 63) stamps[63] = (unsigned long long)wall_clock64(); }
#undef PG8_STAMP
#undef PG8_SA
#undef PG8_SB
#undef PG8_STAGE
#undef PG8_LDA
#undef PG8_LDB
#undef PG8_MMA
#undef PG8_WAIT_V
#undef PG8_WAIT_L
#undef PG8_BAR
#undef PG8_SCHED
}
}

struct EpiIn {
  static constexpr bool PERM = true, AFTER_DRAIN = false;
  CParams* kp;
  __device__ __forceinline__ void operator()(const pg8::f32x4 (&acc)[2][2][4][2], const pg8::Unit& u, int wr, int wc, int fr, int fq) const {
    const int pn = u.pn;
    u16* base; int ld, mode;
    if (pn < 4) { base = kp->U + pn * 256; ld = D; mode = 0; }
    else if (pn < 16) { base = kp->Z + (pn - 4) * 256; ld = 3072; mode = 1; }
    else { base = kp->Ms + (pn - 16) * 256; ld = 3072; mode = 2; }
    const int row0 = u.pm * 256 + wr * 64 + fr;
    const int col0 = wc * 32 + 8 * fq;
    u16* rowp0 = base + (size_t)row0 * ld + col0;
#pragma unroll
    for (int ai = 0; ai < 2; ++ai)
#pragma unroll
      for (int m = 0; m < 4; ++m)
#pragma unroll
        for (int bj = 0; bj < 2; ++bj)
#pragma unroll
          for (int n = 0; n < 2; ++n) {
            pg8::f32x4 v0 = acc[ai][bj][m][n];
            if (mode == 1) {
#pragma unroll
              for (int j = 0; j < 4; ++j) v0[j] = siluf_(v0[j]);
            } else if (mode == 2) {
#pragma unroll
              for (int j = 0; j < 4; ++j) v0[j] = sigmoidf_(v0[j]);
            }
            u32x2 w; w.x = pack2(v0[0], v0[1]); w.y = pack2(v0[2], v0[3]);
            *(u32x2*)(rowp0 + (size_t)(ai * 128 + m * 16) * ld + bj * 128 + n * 4) = w;
          }
  }
};

DI bool tile_map(int i, int MT, int NT, int& mt, int& nt) {
  const int G = gridDim.x, bid = blockIdx.x;
  if ((G & 63) == 0 && (MT & 7) == 0 && (NT % (G >> 6)) == 0) {
    const int SH = G >> 6;
    const int xcd = bid & 7, slot = bid >> 3;
    const int sx = slot & 7, sy = slot >> 3;
    const int nsn = NT / SH, nsm = MT >> 3;
    const int st = i * 8 + xcd;
    if (st >= nsm * nsn) return false;
    mt = (st / nsn) * 8 + sx;
    nt = (st % nsn) * SH + sy;
    return true;
  }
  const int it = bid + i * G;
  if (it >= MT * NT) return false;
  mt = it / NT; nt = it % NT;
  return true;
}


struct OneUnit {
  int pm, pn;
  __device__ bool next(int i, pg8::Unit& u) const { if (i) return false; u.pm = pm; u.pn = pn; return true; }
  __device__ __forceinline__ void a_ready(const pg8::Unit&) const {}
  __device__ __forceinline__ void done(const pg8::Unit&) const {}
  __device__ __forceinline__ size_t a_off(const pg8::Unit&) const { return 0; }
};
struct EpiQKV {
  static constexpr bool PERM = false, AFTER_DRAIN = true;
  CParams* kp; char* lds; int l, nt, m0;
  __device__ __forceinline__ void fused(const pg8::f32x4 (&acc)[2][2][4][2], const pg8::Unit&, int wr, int wc, int fr, int fq,
                                        PG8_LAS unsigned char*, int, int) const {
    CParams& p = *kp;
    const int NB = p.NB, RL = NB * S;
    const int tid = otid();
    const bool lat = m0 < RL;
    int b, t0;
    if (lat) { b = m0 / S; t0 = m0 % S; } else { int rc = m0 - RL; b = rc / L; t0 = rc % L; }
    const bool isV = (nt == 13 || nt == 23);
    const bool isC = nt >= 18;
    const bool isQ = (nt >= 8 && nt < 12) || (nt >= 18 && nt < 22);
    auto process_unit = [&](int hsel, int u) {
      if (isV) {
        const int slot = (isC ? 2 : 0) + hsel;
        const int d = u >> 2, tq = u & 3;
        const float* Cs = (const float*)lds;
        u16* dst = lat ? p.VtL + ((size_t)(b * 4 + slot) * 128 + d) * S + t0 + tq * 64
                       : p.VtC + ((size_t)(b * 4 + slot) * 128 + d) * L + t0 + tq * 64;
#pragma unroll 1
        for (int c = 0; c < 4; ++c) {
          float v[16];
#pragma unroll
          for (int j = 0; j < 16; ++j) v[j] = Cs[(tq * 64 + c * 16 + j) * 132 + d];
          uint4 o0, o1;
          o0.x = pack2(v[0], v[1]); o0.y = pack2(v[2], v[3]); o0.z = pack2(v[4], v[5]); o0.w = pack2(v[6], v[7]);
          o1.x = pack2(v[8], v[9]); o1.y = pack2(v[10], v[11]); o1.z = pack2(v[12], v[13]); o1.w = pack2(v[14], v[15]);
          *(uint4*)(dst + c * 16) = o0;
          *(uint4*)(dst + c * 16 + 8) = o1;
        }
      } else {
        const int row = u >> 1, half = u & 1;
        const size_t gr = (size_t)m0 + row;
        const int t = t0 + row;
        const float* Cr = (const float*)lds + row * 132 + half * 64;
        float rstd = 1.f;
        const float* gn = (isQ ? p.q_norm_g : p.k_norm_g) + l * 128 + half * 64;
        if (isC) {
          float ss = 0.f;
#pragma unroll
          for (int j = 0; j < 16; ++j) {
            float4 tv = *(const float4*)(Cr + j * 4);
            ss += tv.x * tv.x + tv.y * tv.y + tv.z * tv.z + tv.w * tv.w;
          }
          ss += __shfl_xor(ss, 1);
          rstd = rsqrtf(ss * (1.f / 128.f) + EPS);
        }
        const int pos = (half == 0) ? (t >> 6) : (t & 63);
        const float* cs = p.rope + pos * 32;
        const float* sn = p.rope + 2048 + pos * 32;
        u16* dst;
        if (isQ) {
          const int head = (isC ? (nt - 18) : (nt - 8)) * 2 + hsel;
          dst = p.Q + gr * 2048 + (isC ? 1024 : 0) + head * 128 + half * 64;
        } else {
          dst = p.Kb + gr * 512 + (isC ? 256 : 0) + hsel * 128 + half * 64;
        }
#pragma unroll 1
        for (int c = 0; c < 2; ++c) {
          float x0[16], x1[16];
#pragma unroll
          for (int j = 0; j < 4; ++j) {
            float4 ta_ = *(const float4*)(Cr + c * 16 + j * 4);
            float4 tb_ = *(const float4*)(Cr + 32 + c * 16 + j * 4);
            x0[4 * j] = ta_.x; x0[4 * j + 1] = ta_.y; x0[4 * j + 2] = ta_.z; x0[4 * j + 3] = ta_.w;
            x1[4 * j] = tb_.x; x1[4 * j + 1] = tb_.y; x1[4 * j + 2] = tb_.z; x1[4 * j + 3] = tb_.w;
          }
          if (isC) {
#pragma unroll
            for (int j = 0; j < 16; ++j) { x0[j] = x0[j] * rstd * gn[c * 16 + j]; x1[j] = x1[j] * rstd * gn[32 + c * 16 + j]; }
          }
          if (lat) {
#pragma unroll
            for (int j = 0; j < 16; ++j) {
              float c_ = cs[c * 16 + j], s_ = sn[c * 16 + j];
              float a0 = x0[j], a1 = x1[j];
              x0[j] = a0 * c_ - a1 * s_;
              x1[j] = a1 * c_ + a0 * s_;
            }
          }
          if (isQ) {
#pragma unroll
            for (int j = 0; j < 16; ++j) { x0[j] *= QSCALE; x1[j] *= QSCALE; }
          }
          uint4 o0, o1, o2, o3;
          o0.x = pack2(x0[0], x0[1]); o0.y = pack2(x0[2], x0[3]); o0.z = pack2(x0[4], x0[5]); o0.w = pack2(x0[6], x0[7]);
          o1.x = pack2(x0[8], x0[9]); o1.y = pack2(x0[10], x0[11]); o1.z = pack2(x0[12], x0[13]); o1.w = pack2(x0[14], x0[15]);
          o2.x = pack2(x1[0], x1[1]); o2.y = pack2(x1[2], x1[3]); o2.z = pack2(x1[4], x1[5]); o2.w = pack2(x1[6], x1[7]);
          o3.x = pack2(x1[8], x1[9]); o3.y = pack2(x1[10], x1[11]); o3.z = pack2(x1[12], x1[13]); o3.w = pack2(x1[14], x1[15]);
          *(uint4*)(dst + c * 16) = o0;
          *(uint4*)(dst + c * 16 + 8) = o1;
          *(uint4*)(dst + 32 + c * 16) = o2;
          *(uint4*)(dst + 32 + c * 16 + 8) = o3;
        }
      }
    };

#pragma unroll
    for (int bj = 0; bj < 2; ++bj) {
      float* Cs = (float*)lds;
#pragma unroll
      for (int ai = 0; ai < 2; ++ai)
#pragma unroll
        for (int m = 0; m < 4; ++m)
#pragma unroll
          for (int n = 0; n < 2; ++n) {
            const int row = ai * 128 + wr * 64 + m * 16 + fr;
            const int col = wc * 32 + n * 16 + fq * 4;
            pg8::f32x4 v = acc[ai][bj][m][n];
            float4 o; o.x = v[0]; o.y = v[1]; o.z = v[2]; o.w = v[3];
            *(float4*)(Cs + row * 132 + col) = o;
          }
      __syncthreads();
      process_unit(bj, tid);
      __syncthreads();
    }
  }
};

DI void phase_gemm_in(CParams& p, int chunk, int l, char* lds) {
  const int NB = p.NB, RL = NB * S, R = NB * (S + L);
  const int MT = R / 256;
  const u16* Wt = p.WinT + (size_t)l * INW * D;
  {
    pg8::Gemm g{p.Hb, Wt, R, 7168, D, D};
    pg8::StaticOrder So; So.init(R, 7168, (int)gridDim.x, (int)blockIdx.x);
    EpiIn E{&p};
    pg8::gemm_phase<EpiIn, pg8::StaticOrder, false>((PG8_LAS unsigned char*)lds, g, So, E, nullptr);
  }
  for (int ti = 0;; ++ti) {
    int mt, jt;
    if (!tile_map(ti, MT, 12, mt, jt)) break;
    const int nt = (jt < 6) ? 8 + jt : 12 + jt;
    pg8::Gemm g{p.Hb, Wt + (size_t)28 * 256 * D, R, 3072, D, D};
    OneUnit One{mt, jt};
    EpiQKV E{&p, lds, l, nt, mt * 256};
    pg8::gemm_phase<EpiQKV, OneUnit, false>((PG8_LAS unsigned char*)lds, g, One, E, nullptr);
  }
}

struct AttnArgs {
  const u16* q;
  u16* z;
  const u16* kctx;
  const u16* vctx;
  const u16* klat;
  const u16* vlat;
  int n_lat_tiles;
  int lat_key0;
  int q_t0;
  int band;
  int has_sink;
  float sink_l2;
  int dry;
  int fixedm;
  float mfix;
};

DI void attn_load_tile(const AttnArgs& a, int ti, u32x4 (&rk)[2], u32x4 (&rv)[2]) {
  const int tid = otid();
  const u16* kp; const u16* vp; int vs;
  if (ti < 4) { kp = a.kctx + (size_t)(ti * 64) * 512; vp = a.vctx + ti * 64; vs = L; }
  else { kp = a.klat + (size_t)((ti - 4) * 64) * 512; vp = a.vlat + (ti - 4) * 64; vs = S; }
#pragma unroll
  for (int i = 0; i < 2; ++i) {
    int c = tid + NTHR * i;
    rk[i] = *(const u32x4*)(kp + (size_t)(c >> 4) * 512 + (c & 15) * 8);
    rv[i] = *(const u32x4*)(vp + (size_t)(c >> 3) * vs + (c & 7) * 8);
  }
}
DI void attn_store_tile(u16* sK, u16* sV, const u32x4 (&rk)[2], const u32x4 (&rv)[2]) {
  const int tid = otid();
#pragma unroll
  for (int i = 0; i < 2; ++i) {
    int c = tid + NTHR * i;
    *(u32x4*)(sK + (c >> 4) * 136 + (c & 15) * 8) = rk[i];
    u16* vd = sV + (c >> 3) * 72 + ((c & 7) >> 1) * 16 + ((c & 7) & 1) * 4;
    { u32x2 t0 = {rv[i].x, rv[i].y}; *(u32x2*)(vd) = t0; }
    { u32x2 t1 = {rv[i].z, rv[i].w}; *(u32x2*)(vd + 8) = t1; }
  }
}

template <bool NS>
DI void attn_item(const AttnArgs& a, char* lds) {
  const int tid = otid(), lane = tid & 63, w = tid >> 6;
  const int r = lane & 31, hh = lane >> 5;
  constexpr int STG = 17408 + 128 * 144;
  const int ntiles = 4 + a.n_lat_tiles;

  bf16x8 qf[8];
  {
    const u16* qp = a.q + (size_t)(w * 32 + r) * 2048 + hh * 8;
#pragma unroll
    for (int ks = 0; ks < 8; ++ks) qf[ks] = *(const bf16x8*)(qp + ks * 16);
  }
  f32x16 O[4];
#pragma unroll
  for (int dt = 0; dt < 4; ++dt)
#pragma unroll
    for (int x = 0; x < 16; ++x) O[dt][x] = 0.f;
  float m = a.fixedm ? a.mfix : (a.has_sink ? a.sink_l2 : -1e30f);
  float lsum = (a.has_sink && hh == 0) ? 1.f : 0.f;
  const int qpos = a.q_t0 + w * 32 + r;

  auto QK = [&](int stage, f32x16 (&sc)[2]) {
    const u16* sK = (const u16*)(lds + stage * STG);
#pragma unroll
    for (int x = 0; x < 16; ++x) { sc[0][x] = 0.f; sc[1][x] = 0.f; }
    const u16* kb0 = sK + r * 136 + hh * 8;
    const u16* kb1 = sK + (32 + r) * 136 + hh * 8;
#pragma unroll
    for (int ks = 0; ks < 8; ++ks) {
      bf16x8 ka0 = *(const bf16x8*)(kb0 + ks * 16);
      bf16x8 ka1 = *(const bf16x8*)(kb1 + ks * 16);
      sc[0] = MFMA32(ka0, qf[ks], sc[0]);
      sc[1] = MFMA32(ka1, qf[ks], sc[1]);
    }
  };
  u32x4 rk[2], rv[2], rk1[2], rv1[2];
  auto STEP = [&](int ti, int st, f32x16 (&sc)[2], f32x16 (&sn)[2], u32x4 (&lk)[2], u32x4 (&lv)[2], u32x4 (&sk)[2], u32x4 (&sv)[2]) {
    const int st1 = (st == 2) ? 0 : st + 1, st2 = (st == 0) ? 2 : st - 1;
    if (ti + 3 < ntiles) attn_load_tile(a, ti + 3, lk, lv);
    if (ti + 1 < ntiles) QK(st1, sn);
    if (a.band && ti >= 4) {
      const int k0 = a.lat_key0 + (ti - 4) * 64;
#pragma unroll
      for (int kt2 = 0; kt2 < 2; ++kt2)
#pragma unroll
        for (int x = 0; x < 16; ++x) {
          int kp = k0 + kt2 * 32 + crow(x, hh);
          int dlt = kp - qpos; dlt = dlt < 0 ? -dlt : dlt;
          if (dlt > 128) sc[kt2][x] = -1e30f;
        }
    }
    if (!NS && !a.fixedm) {
      float mx = sc[0][0];
#pragma unroll
      for (int kt2 = 0; kt2 < 2; ++kt2)
#pragma unroll
        for (int x = 0; x < 16; ++x) mx = fmaxf(mx, sc[kt2][x]);
      mx = fmaxf(mx, __shfl_xor(mx, 32));
      if (__any(mx > m + 8.f)) {
        const float mnew = fmaxf(m, mx);
        const float alpha = __builtin_amdgcn_exp2f(m - mnew);
        m = mnew;
        lsum *= alpha;
#pragma unroll
        for (int dt = 0; dt < 4; ++dt)
#pragma unroll
          for (int x = 0; x < 16; ++x) O[dt][x] *= alpha;
      }
    }
    float ps = 0.f;
#pragma unroll
    for (int kt2 = 0; kt2 < 2; ++kt2)
#pragma unroll
      for (int x = 0; x < 16; ++x) { float pv = NS ? __builtin_amdgcn_exp2f(sc[kt2][x]) : __builtin_amdgcn_exp2f(sc[kt2][x] - m); sc[kt2][x] = pv; ps += pv; }
    lsum += ps;
    const u16* sV = (const u16*)(lds + st * STG + 17408);
#pragma unroll
    for (int kt2 = 0; kt2 < 2; ++kt2)
#pragma unroll
      for (int s2 = 0; s2 < 2; ++s2) {
        union { unsigned u[4]; bf16x8 v; } pf;
#pragma unroll
        for (int j = 0; j < 4; ++j) pf.u[j] = pack2(sc[kt2][8 * s2 + 2 * j], sc[kt2][8 * s2 + 2 * j + 1]);
        const u16* vb = sV + r * 72 + kt2 * 32 + 16 * s2 + 8 * hh;
#pragma unroll
        for (int dt = 0; dt < 4; ++dt) {
          bf16x8 va = *(const bf16x8*)(vb + dt * 32 * 72);
          O[dt] = MFMA32(va, pf.v, O[dt]);
        }
      }
    if (ti + 2 < ntiles) attn_store_tile((u16*)(lds + st2 * STG), (u16*)(lds + st2 * STG + 17408), sk, sv);
    asm volatile("s_waitcnt lgkmcnt(0)" ::: "memory");
    __builtin_amdgcn_s_barrier();
    asm volatile("" ::: "memory");
  };

  attn_load_tile(a, 0, rk, rv);
  __syncthreads();
  attn_store_tile((u16*)lds, (u16*)(lds + 17408), rk, rv);
  attn_load_tile(a, 1, rk, rv);
  attn_store_tile((u16*)(lds + STG), (u16*)(lds + STG + 17408), rk, rv);
  attn_load_tile(a, 2, rk, rv);
  __syncthreads();
  f32x16 sA[2], sB[2];
  QK(0, sA);
  int st = 0;
  for (int ti = 0; ti < ntiles; ti += 2) {
    STEP(ti, st, sA, sB, rk1, rv1, rk, rv);
    st = (st == 2) ? 0 : st + 1;
    if (ti + 1 < ntiles) {
      STEP(ti + 1, st, sB, sA, rk, rv, rk1, rv1);
      st = (st == 2) ? 0 : st + 1;
    }
  }
  float ltot = lsum + __shfl_xor(lsum, 32);
  const float inv = 1.f / ltot;
  u16* zp = a.z + (size_t)(w * 32 + r) * 3072;
  u32x2 gv[4][4];
#pragma unroll
  for (int dt = 0; dt < 4; ++dt)
#pragma unroll
    for (int g4 = 0; g4 < 4; ++g4) gv[dt][g4] = *(const u32x2*)(zp + dt * 32 + 8 * g4 + 4 * hh);
#pragma unroll
  for (int dt = 0; dt < 4; ++dt)
#pragma unroll
    for (int g4 = 0; g4 < 4; ++g4) {
      int d0 = dt * 32 + 8 * g4 + 4 * hh;
      float y0 = O[dt][4 * g4 + 0] * inv * bflo(gv[dt][g4].x);
      float y1 = O[dt][4 * g4 + 1] * inv * bfhi(gv[dt][g4].x);
      float y2 = O[dt][4 * g4 + 2] * inv * bflo(gv[dt][g4].y);
      float y3 = O[dt][4 * g4 + 3] * inv * bfhi(gv[dt][g4].y);
      uint2 o; o.x = pack2(y0, y1); o.y = pack2(y2, y3);
      if (!a.dry || y0 != y0) *(uint2*)(zp + d0) = o;
    }
}

template <bool REV>
DI void lru_scan(float (&av)[2][16], float (&bv)[2][16], float& carry, int hh) {
  float segA[8], segB[8];
#pragma unroll
  for (int k = 0; k < 8; ++k) {
    const int mt = k >> 2, q = k & 3;
    float cA = 1.f, hl = 0.f;
#pragma unroll
    for (int jj = 0; jj < 4; ++jj) {
      const int j = REV ? 3 - jj : jj;
      const int i = 4 * q + j;
      hl = av[mt][i] * hl + bv[mt][i];
      cA *= av[mt][i];
      av[mt][i] = cA; bv[mt][i] = hl;
    }
    segA[k] = cA; segB[k] = hl;
  }
  float oA[8], oB[8];
#pragma unroll
  for (int k = 0; k < 8; ++k) { oA[k] = __shfl_xor(segA[k], 32); oB[k] = __shfl_xor(segB[k], 32); }
  float init[8];
  float st = carry;
#pragma unroll
  for (int kk = 0; kk < 8; ++kk) {
    const int k = REV ? 7 - kk : kk;
    const int first = REV ? 1 : 0;
    float A1 = (hh == first) ? segA[k] : oA[k];
    float B1 = (hh == first) ? segB[k] : oB[k];
    float st0 = st;
    st = A1 * st + B1;
    float A2 = (hh == first) ? oA[k] : segA[k];
    float B2 = (hh == first) ? oB[k] : segB[k];
    float st1 = st;
    st = A2 * st + B2;
    init[k] = (hh == first) ? st0 : st1;
  }
  carry = st;
#pragma unroll
  for (int k = 0; k < 8; ++k) {
    const int mt = k >> 2, q = k & 3;
#pragma unroll
    for (int j = 0; j < 4; ++j) {
      const int i = 4 * q + j;
      bv[mt][i] = bv[mt][i] + av[mt][i] * init[k];
    }
  }
}

DI void lru_item(CParams& p, int l, int b, int n, bool last, char* lds, int dry = 0) {
  const int NB = p.NB, RL = NB * S;
  const int tid = otid(), lane = tid & 63, w8 = tid >> 6;
  const int sub = __builtin_amdgcn_readfirstlane(w8 >> 2), w = w8 & 3;
  n = n + sub;
  lds += sub * 73728;
  const int dir = w >> 1, w2 = w & 1;
  const int tl = tid & 127;
  const int r = lane & 31, hh = lane >> 5;
  u16* sRaw = (u16*)lds + dir * (8704 / 2);
  u16* sUp = (u16*)(lds + 17408) + dir * (9216 / 2);
  float* sH = (float*)(lds + 35840) + w * (64 * 36);

  const int chb = n * 64;
  const int cp = (tl & 31) * 2, tg = tl >> 5;
  float cw0[4], cw1[4], cb0, cb1;
#pragma unroll
  for (int k = 0; k < 4; ++k) {
    cw0[k] = p.conv_w[((size_t)l * 4 + k) * D + chb + cp];
    cw1[k] = p.conv_w[((size_t)l * 4 + k) * D + chb + cp + 1];
  }
  cb0 = p.conv_b[l * D + chb + cp]; cb1 = p.conv_b[l * D + chb + cp + 1];
  bf16x8 waf[4], wxf[4];
  {
    const float* wa = p.lru_wa + (((size_t)(l * 2 + dir) * 16 + n) * 64) * 64;
    const float* wx = p.lru_wx + (((size_t)(l * 2 + dir) * 16 + n) * 64) * 64;
    const int e = 32 * w2 + r;
#pragma unroll
    for (int ks = 0; ks < 4; ++ks) {
      union { unsigned u[4]; bf16x8 v; } fa, fx;
#pragma unroll
      for (int j = 0; j < 4; ++j) {
        int d0 = ks * 16 + 8 * hh + 2 * j;
        fa.u[j] = pack2(wa[d0 * 64 + e], wa[(d0 + 1) * 64 + e]);
        fx.u[j] = pack2(wx[d0 * 64 + e], wx[(d0 + 1) * 64 + e]);
      }
      waf[ks] = fa.v; wxf[ks] = fx.v;
    }
  }
  const int che = chb + 32 * w2 + r;
  const float ba = p.lru_ba[(l * 2 + dir) * D + che];
  const float bx = p.lru_bx[(l * 2 + dir) * D + che];
  float c8sp;
  {
    float lam = p.lru_lambda[(l * 2 + dir) * D + che];
    float sp = (lam < -20.f) ? -lam : log1pf(expf(-lam));
    c8sp = 8.f * sp;
  }
  float carry = 0.f;

  auto step_tile = [&](int st, bool& isctx, int& tt) {
    if (dir == 0) { if (st < 4) { isctx = true; tt = st; } else { isctx = false; tt = st - 4; } }
    else { if (st < 4) { isctx = true; tt = 3 - st; } else { isctx = false; tt = 63 - (st - 4); } }
  };
  u32x4 pre[5];
  auto load_raw = [&](int st) {
    bool isctx; int tt; step_tile(st, isctx, tt);
    const int seqlen = isctx ? L : S;
    const size_t rowbase = isctx ? (size_t)RL + (size_t)b * L : (size_t)b * S;
    const int t0 = tt * 64;
#pragma unroll
    for (int i = 0; i < 5; ++i) {
      int c = tl + 128 * i;
      int rr = c >> 3, c16 = c & 7;
      int t = t0 - 2 + rr;
      u32x4 v = {0u, 0u, 0u, 0u};
      if (rr < 67 && t >= 0 && t < seqlen) v = *(const u32x4*)(p.U + (rowbase + t) * D + chb + c16 * 8);
      pre[i] = v;
    }
  };
  load_raw(0);
  __syncthreads();
  for (int st = 0; st < 68; ++st) {
    bool isctx; int tt; step_tile(st, isctx, tt);
    const size_t rowbase = isctx ? (size_t)RL + (size_t)b * L : (size_t)b * S;
    const int t0 = tt * 64;
#pragma unroll
    for (int i = 0; i < 5; ++i) {
      int c = tl + 128 * i;
      int rr = c >> 3, c16 = c & 7;
      if (rr < 67) *(u32x4*)(sRaw + rr * 64 + c16 * 8) = pre[i];
    }
    if (st + 1 < 68) load_raw(st + 1);
    asm volatile("s_waitcnt lgkmcnt(0)" ::: "memory"); __builtin_amdgcn_s_barrier(); asm volatile("" ::: "memory");
    {
      const u16* rp = sRaw + (tg * 16) * 64 + cp;
      unsigned r0 = *(const unsigned*)(rp), r1 = *(const unsigned*)(rp + 64), r2 = *(const unsigned*)(rp + 128);
#pragma unroll
      for (int i = 0; i < 16; ++i) {
        unsigned r3 = *(const unsigned*)(rp + (i + 3) * 64);
        float o0 = cb0 + cw0[0] * bflo(r0) + cw0[1] * bflo(r1) + cw0[2] * bflo(r2) + cw0[3] * bflo(r3);
        float o1 = cb1 + cw1[0] * bfhi(r0) + cw1[1] * bfhi(r1) + cw1[2] * bfhi(r2) + cw1[3] * bfhi(r3);
        *(unsigned*)(sUp + (tg * 16 + i) * 72 + cp) = pack2(o0, o1);
        r0 = r1; r1 = r2; r2 = r3;
      }
    }
    asm volatile("s_waitcnt lgkmcnt(0)" ::: "memory"); __builtin_amdgcn_s_barrier(); asm volatile("" ::: "memory");
    const bool fwd_first = isctx ? (tt <= 1) : (tt <= 31);
    const bool first = (dir == 0) ? fwd_first : !fwd_first;
    unsigned long long pt0[4], pt1[4];
    u32x4 pg[4];
    if (!first && !(isctx && last)) {
#pragma unroll
      for (int j = 0; j < 4; ++j) {
        const int q = lane + 64 * j;
        const int tok = q >> 2, cc = (q & 3) * 8;
        const size_t row = rowbase + t0 + tok;
        const int col = chb + 32 * w2 + cc;
        const u16* tp = p.Hb + row * D + col;
        pt0[j] = __hip_atomic_load((const unsigned long long*)tp, __ATOMIC_RELAXED, __HIP_MEMORY_SCOPE_AGENT);
        pt1[j] = __hip_atomic_load((const unsigned long long*)tp + 1, __ATOMIC_RELAXED, __HIP_MEMORY_SCOPE_AGENT);
        pg[j] = *(const u32x4*)(p.Z + row * 3072 + col);
      }
    } else {
#pragma unroll
      for (int j = 0; j < 4; ++j) { pt0[j] = 0; pt1[j] = 0; pg[j] = u32x4{0u, 0u, 0u, 0u}; }
    }
    float av[2][16], bv[2][16];
    {
      f32x16 aR[2];
#pragma unroll
      for (int mt = 0; mt < 2; ++mt) {
#pragma unroll
        for (int x = 0; x < 16; ++x) aR[mt][x] = 0.f;
        const u16* ub = sUp + (mt * 32 + r) * 72 + hh * 8;
#pragma unroll
        for (int ks = 0; ks < 4; ++ks) aR[mt] = MFMA32(*(const bf16x8*)(ub + ks * 16), waf[ks], aR[mt]);
      }
#pragma unroll
      for (int mt = 0; mt < 2; ++mt)
#pragma unroll
        for (int x = 0; x < 16; ++x) {
          const float rg = sigmoidf_(aR[mt][x] + ba);
          av[mt][x] = -c8sp * rg;
        }
    }
    {
      f32x16 aI[2];
#pragma unroll
      for (int mt = 0; mt < 2; ++mt) {
#pragma unroll
        for (int x = 0; x < 16; ++x) aI[mt][x] = 0.f;
        const u16* ub = sUp + (mt * 32 + r) * 72 + hh * 8;
#pragma unroll
        for (int ks = 0; ks < 4; ++ks) aI[mt] = MFMA32(*(const bf16x8*)(ub + ks * 16), wxf[ks], aI[mt]);
      }
#pragma unroll
      for (int mt = 0; mt < 2; ++mt)
#pragma unroll
        for (int x = 0; x < 16; ++x) {
          const int tok = mt * 32 + crow(x, hh);
          const float up = bf2f(sUp[tok * 72 + 32 * w2 + r]);
          const float ig = sigmoidf_(aI[mt][x] + bx);
          const float la = av[mt][x];
          const float a_ = __expf(la);
          const float om = fmaxf(1.f - a_ * a_, 0.f);
          av[mt][x] = a_;
          bv[mt][x] = __builtin_amdgcn_sqrtf(om) * (ig * up);
        }
    }
    if (dir == 0) lru_scan<false>(av, bv, carry, hh); else lru_scan<true>(av, bv, carry, hh);
#pragma unroll
    for (int mt = 0; mt < 2; ++mt)
#pragma unroll
      for (int x = 0; x < 16; ++x) sH[(mt * 32 + crow(x, hh)) * 36 + r] = bv[mt][x];
    if (!(isctx && last)) {
#pragma unroll
      for (int j = 0; j < 4; ++j) {
        const int q = lane + 64 * j;
        const int tok = q >> 2, cc = (q & 3) * 8;
        const float4 h0 = *(const float4*)(sH + tok * 36 + cc);
        const float4 h1 = *(const float4*)(sH + tok * 36 + cc + 4);
        const size_t row = rowbase + t0 + tok;
        const int col = chb + 32 * w2 + cc;
        u16* tp = p.Hb + row * D + col;
        if (first) {
          uint4 o; o.x = pack2(h0.x, h0.y); o.y = pack2(h0.z, h0.w); o.z = pack2(h1.x, h1.y); o.w = pack2(h1.z, h1.w);
          if (!dry || h0.x != h0.x) *(uint4*)tp = o;
        } else {
          unsigned tx = (unsigned)pt0[j], ty = (unsigned)(pt0[j] >> 32), tz = (unsigned)pt1[j], tw = (unsigned)(pt1[j] >> 32);
          u16* zp = p.Z + row * 3072 + col;
          u32x4 g = pg[j];
          uint4 o;
          o.x = pack2((h0.x + bflo(tx)) * bflo(g.x), (h0.y + bfhi(tx)) * bfhi(g.x));
          o.y = pack2((h0.z + bflo(ty)) * bflo(g.y), (h0.w + bfhi(ty)) * bfhi(g.y));
          o.z = pack2((h1.x + bflo(tz)) * bflo(g.z), (h1.y + bfhi(tz)) * bfhi(g.z));
          o.w = pack2((h1.z + bflo(tw)) * bflo(g.w), (h1.w + bfhi(tw)) * bfhi(g.w));
          if (!dry || h0.x != h0.x) *(uint4*)zp = o;
        }
      }
    }
    __builtin_amdgcn_fence(__ATOMIC_RELEASE, "workgroup");
  }
}

DI void phase_mixers(CParams& p, int chunk, int l, char* lds, int dry = 0) {
  const int NB = p.NB, RL = NB * S;
  const bool last = (l == DEPTH - 1);
  const int nLRU = (dry == 1) ? 0 : NB * 8, nC = (dry == 2) ? 0 : NB * 8 * 16, nBw = (dry == 2) ? 0 : NB * 8 * 16, nCtx = (last || dry == 2) ? 0 : NB * 8 * 2;
  const int total = nLRU + nC + nBw + nCtx;
  int* ctr = p.ctr + chunk * DEPTH + l + (dry ? 32 : 0);
  int* s_item = (int*)(lds + LDS_BYTES - 16);
  int it;
  while (true) {
    __syncthreads();
    if (threadIdx.x == 0) *s_item = atomicAdd(ctr, 1);
    __syncthreads();
    it = __builtin_amdgcn_readfirstlane(*s_item);
    __syncthreads();
    if (it >= nLRU) break;
    lru_item(p, l, it >> 3, (it & 7) * 2, last, lds, dry);
  }
  float gqm = 0.f, gkm = 0.f;
  {
    const int ln = otid() & 63;
    gqm = fmaxf(fabsf(p.q_norm_g[l * 128 + ln]), fabsf(p.q_norm_g[l * 128 + 64 + ln]));
    gkm = fmaxf(fabsf(p.k_norm_g[l * 128 + ln]), fabsf(p.k_norm_g[l * 128 + 64 + ln]));
#pragma unroll
    for (int o = 32; o >= 1; o >>= 1) { gqm = fmaxf(gqm, __shfl_xor(gqm, o)); gkm = fmaxf(gkm, __shfl_xor(gkm, o)); }
    gqm = __builtin_amdgcn_readfirstlane(gqm); gkm = __builtin_amdgcn_readfirstlane(gkm);
  }
  const float mfixC = 128.f * gqm * gkm * QSCALE;
  const int nCfast = (mfixC < 60.f) ? nC : 0;
  auto fetch = [&]() {
    __syncthreads();
    if (threadIdx.x == 0) *s_item = atomicAdd(ctr, 1);
    __syncthreads();
    it = __builtin_amdgcn_readfirstlane(*s_item);
    __syncthreads();
  };
  auto build = [&](int ir, AttnArgs& a) {
    a.dry = dry;
    if (ir < nC + nBw) {
      const bool isB = ir >= nC;
      if (isB) ir -= nC;
      const int b = ir >> 7, h = (ir >> 4) & 7, qb = ir & 15;
      const int kvh = h >> 2;
      const int br = isB ? 0 : 1;
      const size_t qrow0 = (size_t)b * S + qb * 256;
      a.q = p.Q + qrow0 * 2048 + br * 1024 + h * 128;
      a.z = p.Z + qrow0 * 3072 + (br + 1) * 1024 + h * 128;
      const int kcol = br * 256 + kvh * 128, slot = br * 2 + kvh;
      a.kctx = p.Kb + ((size_t)RL + (size_t)b * L) * 512 + kcol;
      a.vctx = p.VtC + (size_t)(b * 4 + slot) * 128 * L;
      int k0, k1;
      if (isB) { k0 = qb * 256 - 128; if (k0 < 0) k0 = 0; k1 = qb * 256 + 384; if (k1 > S) k1 = S; }
      else { k0 = 0; k1 = S; }
      a.lat_key0 = k0;
      a.n_lat_tiles = (k1 - k0) >> 6;
      a.klat = p.Kb + ((size_t)b * S + k0) * 512 + kcol;
      a.vlat = p.VtL + (size_t)(b * 4 + slot) * 128 * S + k0;
      a.q_t0 = qb * 256;
      a.band = isB ? 1 : 0;
      a.has_sink = isB ? 1 : 0;
      a.sink_l2 = isB ? p.attn_sink[l * 8 + h] * LOG2E : 0.f;
      a.fixedm = isB ? 0 : 1; a.mfix = mfixC;
    } else {
      ir -= nC + nBw;
      const int h = ir & 7, br = (ir >> 3) & 1, b = ir >> 4;
      const int kvh = h >> 2;
      const size_t qrow0 = (size_t)RL + (size_t)b * L;
      a.q = p.Q + qrow0 * 2048 + br * 1024 + h * 128;
      a.z = p.Z + qrow0 * 3072 + (br + 1) * 1024 + h * 128;
      const int kcol = br * 256 + kvh * 128, slot = br * 2 + kvh;
      a.kctx = p.Kb + ((size_t)RL + (size_t)b * L) * 512 + kcol;
      a.vctx = p.VtC + (size_t)(b * 4 + slot) * 128 * L;
      a.klat = a.kctx; a.vlat = a.vctx;
      a.n_lat_tiles = 0; a.lat_key0 = 0; a.q_t0 = 0; a.band = 0;
      a.has_sink = (br == 0) ? 1 : 0;
      a.sink_l2 = (br == 0) ? p.attn_sink[l * 8 + h] * LOG2E : 0.f;
      a.fixedm = (br == 0) ? 0 : 1; a.mfix = mfixC;
    }
  };
  while (it < nLRU + nCfast) {
    AttnArgs a;
    build(it - nLRU, a);
    attn_item<true>(a, lds);
    fetch();
  }
  while (it < total) {
    AttnArgs a;
    build(it - nLRU, a);
    attn_item<false>(a, lds);
    fetch();
  }
}

DI void merge_tiles_ctx(CParams& p, int l, char* lds) {
  const int NB = p.NB, RL = NB * S, R = NB * (S + L);
  const int MT = (R - RL) / 256, NT = 8;
  const int tid = otid();
  const int lane = tid & 63, w = tid >> 6, wm = w >> 1, wn = w & 1, r = lane & 31, hh = lane >> 5;
  for (int ti = 0;; ++ti) {
    int mt, nt;
    if (!tile_map(ti, MT, NT, mt, nt)) break;
    const int m0 = RL + mt * 256, n0 = nt * 128;
    f32x16 tot[2][2];
#pragma unroll
    for (int i = 0; i < 2; ++i)
#pragma unroll
      for (int j = 0; j < 2; ++j)
#pragma unroll
        for (int x = 0; x < 16; ++x) tot[i][j][x] = 0.f;
#pragma unroll 1
    for (int n = 0; n < 3; ++n) {
      f32x16 acc[2][2];
      gemm_core<128, false>(p.Z + (size_t)m0 * 3072 + n * 1024, 3072, 64, (size_t)128 * 3072,
                            p.WbT + ((size_t)(l * 3 + n) * D + n0) * D, D, 64, 0, D, lds, acc);
#pragma unroll
      for (int i = 0; i < 2; ++i)
#pragma unroll
        for (int j = 0; j < 2; ++j)
#pragma unroll
          for (int g = 0; g < 4; ++g) {
            const size_t row = (size_t)m0 + wm * 64 + i * 32 + r;
            const int col = n0 + wn * 64 + j * 32 + 8 * g + 4 * hh;
            uint2 sv = *(const uint2*)(p.Ms + row * 3072 + n * 1024 + col);
            tot[i][j][4 * g + 0] += bflo(sv.x) * acc[i][j][4 * g + 0];
            tot[i][j][4 * g + 1] += bfhi(sv.x) * acc[i][j][4 * g + 1];
            tot[i][j][4 * g + 2] += bflo(sv.y) * acc[i][j][4 * g + 2];
            tot[i][j][4 * g + 3] += bfhi(sv.y) * acc[i][j][4 * g + 3];
          }
    }
#pragma unroll
    for (int i = 0; i < 2; ++i)
#pragma unroll
      for (int j = 0; j < 2; ++j)
#pragma unroll
        for (int g = 0; g < 4; ++g) {
          const size_t row = (size_t)m0 + wm * 64 + i * 32 + r;
          const int col = n0 + wn * 64 + j * 32 + 8 * g + 4 * hh;
          uint2 o; o.x = pack2(tot[i][j][4 * g], tot[i][j][4 * g + 1]); o.y = pack2(tot[i][j][4 * g + 2], tot[i][j][4 * g + 3]);
          *(uint2*)(p.Hb + row * D + col) = o;
        }
  }
}

struct MergeOrder {
  pg8::StaticOrder inner;
  __device__ void init(int M, int G, int c) { inner.init(M, 1024, G, c); }
  __device__ bool next(int i, pg8::Unit& u) const {
    const int j = i / 3, n = i - 3 * j;
    pg8::Unit t;
    if (!inner.next(j, t)) return false;
    u.pm = t.pm; u.pn = n * 4 + t.pn;
    return true;
  }
  __device__ __forceinline__ void a_ready(const pg8::Unit&) const {}
  __device__ __forceinline__ void done(const pg8::Unit&) const {}
  __device__ __forceinline__ size_t a_off(const pg8::Unit& u) const { return (size_t)(u.pn >> 2) * 1024 * 2; }
};
struct EpiMerge {
  static constexpr bool PERM = true, AFTER_DRAIN = false;
  CParams* kp;
  __device__ __forceinline__ void operator()(const pg8::f32x4 (&acc)[2][2][4][2], const pg8::Unit& u, int wr, int wc, int fr, int fq) const {
    const int n = u.pn >> 2, ct = u.pn & 3;
    const int row0 = u.pm * 256 + wr * 64 + fr;
    const int col0 = ct * 256 + wc * 32 + 8 * fq;
    const u16* __restrict__ sg = kp->Ms + n * 1024;
    const float* __restrict__ mrd = (const float*)kp->Q;
    float* __restrict__ mwr = (float*)kp->Q;
    u16* __restrict__ hb = kp->Hb;
#pragma unroll
    for (int am = 0; am < 4; ++am) {
      const int ai = am >> 1, mb = (am & 1) * 2;
      u32x4 sv[2][2];
      pg8::f32x4 pa[2][2][2];
#pragma unroll
      for (int mm = 0; mm < 2; ++mm) {
        const size_t row = (size_t)(row0 + ai * 128 + (mb + mm) * 16);
#pragma unroll
        for (int bj = 0; bj < 2; ++bj) {
          sv[mm][bj] = *(const u32x4*)(sg + row * 3072 + col0 + bj * 128);
          if (n > 0) {
            pa[mm][bj][0] = *(const pg8::f32x4*)(mrd + row * D + col0 + bj * 128);
            pa[mm][bj][1] = *(const pg8::f32x4*)(mrd + row * D + col0 + bj * 128 + 4);
          }
        }
      }
#pragma unroll
      for (int mm = 0; mm < 2; ++mm) {
        const size_t row = (size_t)(row0 + ai * 128 + (mb + mm) * 16);
#pragma unroll
        for (int bj = 0; bj < 2; ++bj) {
          pg8::f32x4 v0 = acc[ai][bj][mb + mm][0], v1 = acc[ai][bj][mb + mm][1];
          v0[0] *= bflo(sv[mm][bj].x); v0[1] *= bfhi(sv[mm][bj].x); v0[2] *= bflo(sv[mm][bj].y); v0[3] *= bfhi(sv[mm][bj].y);
          v1[0] *= bflo(sv[mm][bj].z); v1[1] *= bfhi(sv[mm][bj].z); v1[2] *= bflo(sv[mm][bj].w); v1[3] *= bfhi(sv[mm][bj].w);
          if (n > 0) { v0 += pa[mm][bj][0]; v1 += pa[mm][bj][1]; }
          if (n < 2) {
            *(pg8::f32x4*)(mwr + row * D + col0 + bj * 128) = v0;
            *(pg8::f32x4*)(mwr + row * D + col0 + bj * 128 + 4) = v1;
          } else {
            u32x4 w; w.x = pack2(v0[0], v0[1]); w.y = pack2(v0[2], v0[3]); w.z = pack2(v1[0], v1[1]); w.w = pack2(v1[2], v1[3]);
            *(u32x4*)(hb + row * D + col0 + bj * 128) = w;
          }
        }
      }
    }
  }
};

DI void phase_merge(CParams& p, int chunk, int l, char* lds) {
  const int NB = p.NB, RL = NB * S;
  const bool last = (l == DEPTH - 1);
  pg8::Gemm g{p.Z, p.WbT + (size_t)l * 3 * D * D, RL, 3 * D, D, 3072};
  MergeOrder Mo; Mo.init(RL, (int)gridDim.x, (int)blockIdx.x);
  EpiMerge E{&p};
  pg8::gemm_phase<EpiMerge, MergeOrder, false>((PG8_LAS unsigned char*)lds, g, Mo, E, nullptr);
  if (!last) merge_tiles_ctx(p, l, lds);
}

struct EpiOut {
  static constexpr bool PERM = false, AFTER_DRAIN = false;
  CParams* kp; int chunk, l;
  __device__ __forceinline__ void operator()(const pg8::f32x4 (&acc)[2][2][4][2], const pg8::Unit& u, int wr, int wc, int fr, int fq) const {
    const int NB = kp->NB, RL = NB * S;
    const int gr0 = u.pm * 256;
    const float* src; float* dst; int mrow;
    if (gr0 < RL) {
      const int b = gr0 / S, t = gr0 % S, bg = chunk * NB + b;
      const size_t off = ((size_t)bg * S + t) * D;
      src = (l == 0 ? kp->x : kp->out) + off; dst = kp->out + off; mrow = bg;
    } else {
      const int rc = gr0 - RL, b = rc / L, t = rc % L, bg = chunk * NB + b;
      const size_t off = ((size_t)bg * L + t) * D;
      src = (l == 0 ? kp->ctx : kp->xc) + off; dst = kp->xc + off; mrow = 16;
    }
    const int col0 = u.pn * 256 + wc * 32 + 4 * fq;
    const float* gate = kp->modv + ((size_t)l * 17 + mrow) * 3072 + 2048 + col0;
    pg8::f32x4 gv[2][2];
#pragma unroll
    for (int bj = 0; bj < 2; ++bj)
#pragma unroll
      for (int n = 0; n < 2; ++n) gv[bj][n] = *(const pg8::f32x4*)(gate + bj * 128 + n * 16);
    const int row0 = wr * 64 + fr;
#pragma unroll
    for (int ai = 0; ai < 2; ++ai)
#pragma unroll
      for (int m = 0; m < 4; ++m) {
        const size_t ro = (size_t)(row0 + ai * 128 + m * 16) * D + col0;
        pg8::f32x4 xv[2][2];
#pragma unroll
        for (int bj = 0; bj < 2; ++bj)
#pragma unroll
          for (int n = 0; n < 2; ++n) xv[bj][n] = *(const pg8::f32x4*)(src + ro + bj * 128 + n * 16);
#pragma unroll
        for (int bj = 0; bj < 2; ++bj)
#pragma unroll
          for (int n = 0; n < 2; ++n) {
            pg8::f32x4 o = xv[bj][n] + gv[bj][n] * acc[ai][bj][m][n];
            *(pg8::f32x4*)(dst + ro + bj * 128 + n * 16) = o;
          }
      }
  }
};

DI void phase_outproj(CParams& p, int chunk, int l, char* lds) {
  const int NB = p.NB, RL = NB * S, R = NB * (S + L);
  const bool last = (l == DEPTH - 1);
  const int rows = last ? RL : R;
  pg8::Gemm g{p.Hb, p.WoT + (size_t)l * D * D, rows, D, D, D};
  pg8::StaticOrder So; So.init(rows, D, (int)gridDim.x, (int)blockIdx.x);
  EpiOut E{&p, chunk, l};
  pg8::gemm_phase<EpiOut, pg8::StaticOrder, false>((PG8_LAS unsigned char*)lds, g, So, E, nullptr);
}

DI void phase_final(CParams& p) {
  const int tid_ = otid();
  const int lane = tid_ & 63;
  const int wg = blockIdx.x * 8 + (tid_ >> 6), nw = gridDim.x * 8;
  for (int r = wg; r < NBATCH * S; r += nw) {
    float* src = p.out + (size_t)r * D;
    float4 v[4]; float ss = 0.f;
#pragma unroll
    for (int i = 0; i < 4; ++i) {
      v[i] = *(const float4*)(src + i * 256 + lane * 4);
      ss += v[i].x * v[i].x + v[i].y * v[i].y + v[i].z * v[i].z + v[i].w * v[i].w;
    }
#pragma unroll
    for (int o = 32; o >= 1; o >>= 1) ss += __shfl_xor(ss, o);
    float rstd = rsqrtf(ss * (1.f / D) + EPS);
#pragma unroll
    for (int i = 0; i < 4; ++i) {
      int cidx = i * 256 + lane * 4;
      float4 gg = *(const float4*)(p.final_g + cidx);
      float4 o;
      o.x = v[i].x * rstd * gg.x; o.y = v[i].y * rstd * gg.y; o.z = v[i].z * rstd * gg.z; o.w = v[i].w * rstd * gg.w;
      *(float4*)(src + cidx) = o;
    }
  }
}

#ifndef DUP_PHASE
#define DUP_PHASE 0
#endif
__global__ void __launch_bounds__(NTHR, 2) fwd_megakernel(Params p_unused) {
  CParams* kp = (CParams*)__builtin_amdgcn_kernarg_segment_ptr();
  cg::grid_group grid = cg::this_grid();
  __shared__ __attribute__((aligned(16))) char lds[LDS_BYTES];
  phase0(*opaque_kp(kp), lds);
  grid.sync();
  phase_mod(*opaque_kp(kp), lds);
  grid.sync();
  for (int chunk = 0; chunk < kp->nchunk; ++chunk) {
    for (int l = 0; l < DEPTH; ++l) {
      phase_prenorm(*opaque_kp(kp), chunk, l);
      grid.sync();
#if DUP_PHASE == 9
      grid.sync(); grid.sync(); grid.sync(); grid.sync(); grid.sync();
#endif
      phase_gemm_in(*opaque_kp(kp), chunk, l, lds);
      grid.sync();
#if DUP_PHASE == 3
      phase_gemm_in(*opaque_kp(kp), chunk, l, lds);
      grid.sync();
#endif
#if DUP_PHASE == 4
      phase_mixers(*opaque_kp(kp), chunk, l, lds, 1);
      grid.sync();
#endif
#if DUP_PHASE == 6
      phase_mixers(*opaque_kp(kp), chunk, l, lds, 2);
      grid.sync();
#endif
      phase_mixers(*opaque_kp(kp), chunk, l, lds);
      grid.sync();
      phase_merge(*opaque_kp(kp), chunk, l, lds);
      grid.sync();
#if DUP_PHASE == 5
      phase_merge(*opaque_kp(kp), chunk, l, lds);
      grid.sync();
#endif
      phase_outproj(*opaque_kp(kp), chunk, l, lds);
      grid.sync();
    }
  }
  phase_final(*opaque_kp(kp));
}

extern "C" void kernel_launch(void* const* d_in, const int* in_sizes, int n_in,
                              void* d_out, int out_size, void* d_ws, size_t ws_size,
                              hipStream_t stream) {
  static int grid_blocks = 0;
  if (!grid_blocks) {
    int dev = 0, cus = 0, per_cu = 0;
    (void)hipGetDevice(&dev);
    (void)hipDeviceGetAttribute(&cus, hipDeviceAttributeMultiprocessorCount, dev);
    (void)hipOccupancyMaxActiveBlocksPerMultiprocessor(&per_cu, fwd_megakernel, NTHR, 0);
    if (per_cu > 1) per_cu = 1;
    if (per_cu < 1) per_cu = 1;
    grid_blocks = cus * per_cu;
  }
  Params p{};
  const float* const* in = (const float* const*)d_in;
  p.x = in[0]; p.c = in[1]; p.ctx = in[2]; p.c_ctx = in[3]; p.norm_g = in[4]; p.w_mod = in[5]; p.b_mod = in[6];
  p.w_in = in[7]; p.conv_w = in[8]; p.conv_b = in[9]; p.lru_wa = in[10]; p.lru_ba = in[11]; p.lru_wx = in[12];
  p.lru_bx = in[13]; p.lru_lambda = in[14]; p.attn_sink = in[15]; p.q_norm_g = in[16]; p.k_norm_g = in[17];
  p.w_branch = in[18]; p.w_out = in[19]; p.final_g = in[20];
  p.out = (float*)d_out;
  char* ws = (char*)d_ws;
  size_t off = 0;
  auto take = [&](size_t bytes) { char* r = ws + off; off += (bytes + 255) & ~(size_t)255; return r; };
  p.ctr = (int*)take(256);
  p.modv = (float*)take((size_t)DEPTH * 17 * 3072 * 4);
  p.sc = (float*)take((size_t)17 * D * 4);
  p.rope = (float*)take(4096 * 4);
  p.xc = (float*)take((size_t)NBATCH * L * D * 4);
  p.WinT = (u16*)take((size_t)DEPTH * INW * D * 2);
  p.WbT = (u16*)take((size_t)DEPTH * 3 * D * D * 2);
  p.WoT = (u16*)take((size_t)DEPTH * D * D * 2);
  const size_t fixed = off;
  int NB = 8;
  while (NB > 1) {
    size_t R = (size_t)NB * (S + L);
    size_t need = fixed + R * (size_t)(1024 + 1024 + 3072 + 2048 + 512 + 512 + 3072) * 2 + 8 * 256;
    if (need <= ws_size) break;
    NB >>= 1;
  }
  p.NB = NB; p.nchunk = NBATCH / NB;
  const size_t R = (size_t)NB * (S + L);
  p.Hb = (u16*)take(R * 1024 * 2);
  p.U = (u16*)take(R * 1024 * 2);
  p.Z = (u16*)take(R * 3072 * 2);
  p.Q = (u16*)take(R * 2048 * 2);
  p.Kb = (u16*)take(R * 512 * 2);
  p.VtL = (u16*)take((size_t)NB * 4 * 128 * S * 2);
  p.VtC = (u16*)take((size_t)NB * 4 * 128 * L * 2);
  p.Ms = (u16*)take(R * 3072 * 2);
  void* args[] = {&p};
  hipError_t e = hipLaunchCooperativeKernel((void*)fwd_megakernel, dim3(grid_blocks), dim3(NTHR), args, 0, stream);
  if (e != hipSuccess) fprintf(stderr, "cooperative launch failed: %s (grid %d)\n", hipGetErrorString(e), grid_blocks);
}
```

```cpp
#include <hip/hip_runtime.h>
#include <hip/hip_cooperative_groups.h>
#include <cstdio>
#include <cstdint>
namespace cg = cooperative_groups;

typedef unsigned short u16;
typedef __attribute__((ext_vector_type(8))) short bf16x8;
typedef __attribute__((ext_vector_type(4))) short s16x4;
typedef __attribute__((ext_vector_type(16))) float f32x16;
typedef __bf16 bf16x2_t __attribute__((ext_vector_type(2)));
typedef float float2_t __attribute__((ext_vector_type(2)));
typedef __attribute__((ext_vector_type(4))) unsigned u32x4;
typedef __attribute__((ext_vector_type(2))) unsigned u32x2;

#define DI __device__ __forceinline__
#define MFMA32(a, b, c) __builtin_amdgcn_mfma_f32_32x32x16_bf16((a), (b), (c), 0, 0, 0)

constexpr int D = 1024, NBATCH = 16, S = 4096, L = 256, DEPTH = 4, INW = 10240;
constexpr int LDS_BYTES = 147456;
constexpr int NTHR = 512;
constexpr float EPS = 1e-6f;
constexpr float QSCALE = 0.08838834764831845f * 1.4426950408889634f;
constexpr float LOG2E = 1.4426950408889634f;

struct Params {
  const float *x, *c, *ctx, *c_ctx, *norm_g, *w_mod, *b_mod, *w_in, *conv_w, *conv_b, *lru_wa, *lru_ba, *lru_wx, *lru_bx,
      *lru_lambda, *attn_sink, *q_norm_g, *k_norm_g, *w_branch, *w_out, *final_g;
  float* out;
  u16 *WinT, *WbT, *WoT;
  u16 *Hb, *U, *Z, *Q, *Kb, *VtL, *VtC, *Ms;
  float *modv, *sc, *rope, *xc;
  int* ctr;
  int NB;
  int nchunk;
};

typedef const __attribute__((address_space(4))) Params CParams;
DI CParams* opaque_kp(CParams* q) { asm volatile("" : "+s"(q)); return q; }

DI unsigned pack2(float a, float b) {
  float2_t f = {a, b};
  bf16x2_t v = __builtin_convertvector(f, bf16x2_t);
  return __builtin_bit_cast(unsigned, v);
}
DI float bf2f(u16 v) { return __uint_as_float(((unsigned)v) << 16); }
DI float bflo(unsigned v) { return __uint_as_float(v << 16); }
DI float bfhi(unsigned v) { return __uint_as_float(v & 0xffff0000u); }
DI float sigmoidf_(float x) { return __builtin_amdgcn_rcpf(1.f + __expf(-x)); }
DI float siluf_(float x) { return x * __builtin_amdgcn_rcpf(1.f + __expf(-x)); }
DI int otid() { int t = threadIdx.x; asm volatile("" : "+v"(t)); return t; }
DI int crow(int i, int hh) { return (i & 3) + 8 * (i >> 2) + 4 * hh; }

DI void phase0(CParams& p, char* lds) {
  const int tid = otid();
  float* tile = (float*)lds;
  const int n_in = DEPTH * 16 * 160, n_b = DEPTH * 3 * 256, n_o = DEPTH * 256;
  for (int it = blockIdx.x; it < n_in + n_b + n_o; it += gridDim.x) {
    const float* src; u16* dst; int ldsrc; int dstride = 64;
    if (it < n_in) {
      int l = it / 2560, rem = it % 2560, kt = rem / 160, nt = rem % 160;
      src = p.w_in + (size_t)l * D * INW + (size_t)(kt * 64) * INW + nt * 64; ldsrc = INW;
      const int o = nt >> 2;
      const int n256 = (o < 8) ? o : (o >= 28) ? 16 + (o - 28) : (o >= 24) ? 12 + (o - 24) : (o == 23) ? 39 : (o == 22) ? 38
                     : (o >= 18) ? 34 + (o - 18) : (o >= 14) ? 8 + (o - 14) : (o == 13) ? 33 : (o == 12) ? 32 : 28 + (o - 8);
      dst = p.WinT + (size_t)l * INW * D + ((size_t)n256 * 256 + (nt & 3) * 64) * D + kt * 64; dstride = D;
    } else if (it < n_in + n_b) {
      int i2 = it - n_in; int mat = i2 / 256, rem = i2 % 256, kt = rem / 16, nt = rem % 16;
      src = p.w_branch + (size_t)mat * D * D + (size_t)(kt * 64) * D + nt * 64; ldsrc = D;
      dst = p.WbT + (size_t)mat * D * D + (size_t)(nt * 64) * D + kt * 64; dstride = D;
    } else {
      int i2 = it - n_in - n_b; int mat = i2 / 256, rem = i2 % 256, kt = rem / 16, nt = rem % 16;
      src = p.w_out + (size_t)mat * D * D + (size_t)(kt * 64) * D + nt * 64; ldsrc = D;
      dst = p.WoT + (size_t)mat * D * D + (size_t)(nt * 64) * D + kt * 64; dstride = D;
    }
    __syncthreads();
#pragma unroll
    for (int i = 0; i < 2; ++i) {
      int c = tid + NTHR * i; int row = c >> 4, c4 = c & 15;
      float4 v = *(const float4*)(src + (size_t)row * ldsrc + c4 * 4);
      float* t = tile + row * 65 + c4 * 4;
      t[0] = v.x; t[1] = v.y; t[2] = v.z; t[3] = v.w;
    }
    __syncthreads();
    {
      int c = tid; int nrow = c >> 3, k8 = c & 7;
      float v[8];
#pragma unroll
      for (int j = 0; j < 8; ++j) v[j] = tile[(k8 * 8 + j) * 65 + nrow];
      uint4 o; o.x = pack2(v[0], v[1]); o.y = pack2(v[2], v[3]); o.z = pack2(v[4], v[5]); o.w = pack2(v[6], v[7]);
      *(uint4*)(dst + (size_t)nrow * dstride + k8 * 8) = o;
    }
  }
  const int gt = blockIdx.x * NTHR + tid, gn = gridDim.x * NTHR;
  for (int i = gt; i < 17 * D; i += gn) {
    int r = i / D, k = i % D;
    float v = (r < 16) ? p.c[r * D + k] : p.c_ctx[k];
    p.sc[i] = siluf_(v);
  }
  for (int i = gt; i < 64 * 32; i += gn) {
    int pos = i >> 5, pp = i & 31;
    float inv = powf(10000.f, -(float)pp / 32.f);
    float ang = (float)pos * inv;
    p.rope[i] = cosf(ang);
    p.rope[2048 + i] = sinf(ang);
  }
  if (blockIdx.x == 0 && tid < 64) p.ctr[tid] = 0;
}

DI void phase_mod(CParams& p, char* lds) {
  const int tid = otid();
  float* red = (float*)lds;
  const int col = tid & 63, kg = tid >> 6;
  for (int it = blockIdx.x; it < DEPTH * 48; it += gridDim.x) {
    int l = it / 48, cb = it % 48;
    float acc[17];
#pragma unroll
    for (int r = 0; r < 17; ++r) acc[r] = 0.f;
    const float* w = p.w_mod + (size_t)l * D * 3072 + cb * 64 + col;
    for (int k = kg * 128; k < kg * 128 + 128; ++k) {
      float wv = w[(size_t)k * 3072];
#pragma unroll
      for (int r = 0; r < 17; ++r) acc[r] += p.sc[r * D + k] * wv;
    }
    __syncthreads();
#pragma unroll
    for (int r = 0; r < 17; ++r) red[(kg * 17 + r) * 64 + col] = acc[r];
    __syncthreads();
    for (int i = tid; i < 17 * 64; i += NTHR) {
      int r = i >> 6, cc = i & 63;
      float s = 0.f;
#pragma unroll
      for (int g = 0; g < 8; ++g) s += red[(g * 17 + r) * 64 + cc];
      p.modv[((size_t)l * 17 + r) * 3072 + cb * 64 + cc] = s + p.b_mod[l * 3072 + cb * 64 + cc];
    }
  }
}

DI void phase_prenorm(CParams& p, int chunk, int l) {
  const int NB = p.NB, RL = NB * S, R = NB * (S + L);
  const int tid_ = otid();
  const int lane = tid_ & 63;
  const int wg = blockIdx.x * 8 + (tid_ >> 6), nw = gridDim.x * 8;
  const float* g = p.norm_g + l * D;
  for (int r = wg; r < R; r += nw) {
    const float* src; int mrow;
    if (r < RL) {
      int b = r / S, t = r % S; int bg = chunk * NB + b;
      src = (l == 0 ? p.x : p.out) + ((size_t)bg * S + t) * D; mrow = bg;
    } else {
      int rc = r - RL; int b = rc / L, t = rc % L; int bg = chunk * NB + b;
      src = (l == 0 ? p.ctx : p.xc) + ((size_t)bg * L + t) * D; mrow = 16;
    }
    const float* mv = p.modv + ((size_t)l * 17 + mrow) * 3072;
    float4 v[4]; float ss = 0.f;
#pragma unroll
    for (int i = 0; i < 4; ++i) {
      v[i] = *(const float4*)(src + i * 256 + lane * 4);
      ss += v[i].x * v[i].x + v[i].y * v[i].y + v[i].z * v[i].z + v[i].w * v[i].w;
    }
#pragma unroll
    for (int o = 32; o >= 1; o >>= 1) ss += __shfl_xor(ss, o);
    float rstd = rsqrtf(ss * (1.f / D) + EPS);
#pragma unroll
    for (int i = 0; i < 4; ++i) {
      int cidx = i * 256 + lane * 4;
      float4 gg = *(const float4*)(g + cidx);
      float4 sh = *(const float4*)(mv + cidx);
      float4 scl = *(const float4*)(mv + 1024 + cidx);
      float h0 = v[i].x * rstd * gg.x * (1.f + scl.x) + sh.x;
      float h1 = v[i].y * rstd * gg.y * (1.f + scl.y) + sh.y;
      float h2 = v[i].z * rstd * gg.z * (1.f + scl.z) + sh.z;
      float h3 = v[i].w * rstd * gg.w * (1.f + scl.w) + sh.w;
      uint2 o; o.x = pack2(h0, h1); o.y = pack2(h2, h3);
      *(uint2*)(p.Hb + (size_t)r * D + cidx) = o;
    }
  }
}

template <int BN, bool PIPE>
DI void gemm_core(const u16* A, int lda, int ksa, size_t a_blk, const u16* Bt, int ldb, int ksb, size_t b_blk, int K, char* ldsc,
                  f32x16 (&acc)[BN / 64][2]) {
  constexpr int MI = BN / 64;
  constexpr int SS = 32768 + BN * 128;
  const int tid = otid(), lane = tid & 63, w = tid >> 6;
  const int wm = (BN == 256) ? (w >> 2) : (w >> 1), wn = (BN == 256) ? (w & 3) : (w & 1);
  const int r = lane & 31, hh = lane >> 5;
  const int drow = lane >> 3, dcp = lane & 7;
  const int chunk0 = dcp ^ (drow >> 1);
  const u16* gAe = A + (size_t)(w >> 2) * a_blk + (size_t)((w & 3) * 32 + drow) * lda + chunk0 * 8;
  const u16* gAo = gAe + (size_t)8 * lda + ((chunk0 ^ 4) - chunk0) * 8;
  const size_t a16 = (size_t)16 * lda;
  const int brow0 = (BN == 256) ? (w & 3) * 32 : w * 16;
  const u16* gBe = Bt + ((BN == 256) ? (size_t)(w >> 2) * b_blk : (size_t)0) + (size_t)(brow0 + drow) * ldb + chunk0 * 8;
  const u16* gBo = gBe + (size_t)8 * ldb + ((chunk0 ^ 4) - chunk0) * 8;
  const size_t b16 = (size_t)16 * ldb;
#pragma unroll
  for (int i = 0; i < MI; ++i)
#pragma unroll
    for (int j = 0; j < 2; ++j)
#pragma unroll
      for (int x = 0; x < 16; ++x) acc[i][j][x] = 0.f;
  auto DMA = [&](int kt, int stage) {
    char* sa = ldsc + stage * SS + (w * 4) * 1024;
    char* sb = ldsc + stage * SS + 32768 + ((BN == 256) ? (w * 4) : (w * 2)) * 1024;
    const size_t ka = (size_t)kt * ksa, kb = (size_t)kt * ksb;
    __builtin_amdgcn_global_load_lds((const unsigned*)(gAe + ka), (unsigned*)(sa), 16, 0, 0);
    __builtin_amdgcn_global_load_lds((const unsigned*)(gBe + kb), (unsigned*)(sb), 16, 0, 0);
    __builtin_amdgcn_global_load_lds((const unsigned*)(gAo + ka), (unsigned*)(sa + 1024), 16, 0, 0);
    __builtin_amdgcn_global_load_lds((const unsigned*)(gBo + kb), (unsigned*)(sb + 1024), 16, 0, 0);
    __builtin_amdgcn_global_load_lds((const unsigned*)(gAe + a16 + ka), (unsigned*)(sa + 2048), 16, 0, 0);
    __builtin_amdgcn_global_load_lds((const unsigned*)(gAo + a16 + ka), (unsigned*)(sa + 3072), 16, 0, 0);
    if (BN == 256) {
      __builtin_amdgcn_global_load_lds((const unsigned*)(gBe + b16 + kb), (unsigned*)(sb + 2048), 16, 0, 0);
      __builtin_amdgcn_global_load_lds((const unsigned*)(gBo + b16 + kb), (unsigned*)(sb + 3072), 16, 0, 0);
    }
  };
  const int sw = (r >> 1) & 7;
  int koff[4];
#pragma unroll
  for (int ks = 0; ks < 4; ++ks) koff[ks] = ((2 * ks + hh) ^ sw) << 4;
  auto COMPUTE = [&](int stage) {
    const char* ab = ldsc + stage * SS + (wm * (MI * 32) + r) * 128;
    const char* bb = ldsc + stage * SS + 32768 + (wn * 64 + r) * 128;
    bf16x8 fa[2][MI], fb[2][2];
    auto LDF = [&](int ks, int slot) {
#pragma unroll
      for (int i = 0; i < MI; ++i) fa[slot][i] = *(const bf16x8*)(ab + i * 32 * 128 + koff[ks]);
#pragma unroll
      for (int j = 0; j < 2; ++j) fb[slot][j] = *(const bf16x8*)(bb + j * 32 * 128 + koff[ks]);
    };
    auto MM = [&](int slot) {
#pragma unroll
      for (int i = 0; i < MI; ++i)
#pragma unroll
        for (int j = 0; j < 2; ++j) acc[i][j] = MFMA32(fb[slot][j], fa[slot][i], acc[i][j]);
    };
    if (!PIPE) {
#pragma unroll
      for (int ks = 0; ks < 4; ++ks) { LDF(ks, 0); MM(0); }
      return;
    }
    LDF(0, 0); LDF(1, 1);
    __builtin_amdgcn_sched_barrier(0);
    MM(0); LDF(2, 0);
    __builtin_amdgcn_sched_barrier(0);
    MM(1); LDF(3, 1);
    __builtin_amdgcn_sched_barrier(0);
    MM(0); MM(1);
  };
  const int KT = K >> 6;
  __syncthreads();
  DMA(0, 0);
  __syncthreads();
  for (int kt = 0; kt < KT; kt += 2) {
    DMA(kt + 1, 1);
    COMPUTE(0);
    __syncthreads();
    if (kt + 2 < KT) DMA(kt + 2, 0);
    COMPUTE(1);
    __syncthreads();
  }
}

template <int MI>
DI void stage_acc(char* ldsc, f32x16 (&acc)[MI][2], int wm, int ncol0, bool active) {
  const int tid = otid(), lane = tid & 63;
  const int r = lane & 31, hh = lane >> 5;
  float* Cs = (float*)ldsc;
  if (active) {
#pragma unroll
    for (int i = 0; i < MI; ++i)
#pragma unroll
      for (int j = 0; j < 2; ++j)
#pragma unroll
        for (int g = 0; g < 4; ++g) {
          int m = wm * (MI * 32) + i * 32 + r;
          int n = ncol0 + j * 32 + 8 * g + 4 * hh;
          float4 v; v.x = acc[i][j][4 * g]; v.y = acc[i][j][4 * g + 1]; v.z = acc[i][j][4 * g + 2]; v.w = acc[i][j][4 * g + 3];
          *(float4*)(Cs + m * 132 + n) = v;
        }
  }
  __syncthreads();
}

DI void read_row64(const char* ldsc, int row, int half, float (&v)[64]) {
  const float* Cs = (const float*)ldsc + row * 132 + half * 64;
#pragma unroll
  for (int j = 0; j < 16; ++j) {
    float4 t = *(const float4*)(Cs + j * 4);
    v[j * 4] = t.x; v[j * 4 + 1] = t.y; v[j * 4 + 2] = t.z; v[j * 4 + 3] = t.w;
  }
}

DI void store_row64_bf16(u16* dst, const float (&v)[64]) {
#pragma unroll
  for (int j = 0; j < 8; ++j) {
    uint4 o;
    o.x = pack2(v[j * 8], v[j * 8 + 1]); o.y = pack2(v[j * 8 + 2], v[j * 8 + 3]);
    o.z = pack2(v[j * 8 + 4], v[j * 8 + 5]); o.w = pack2(v[j * 8 + 6], v[j * 8 + 7]);
    *(uint4*)(dst + j * 8) = o;
  }
}

namespace pg8 {
#define PG8_LAS __attribute__((address_space(3)))
typedef unsigned short bf16_t;
typedef short bf16x8 __attribute__((ext_vector_type(8)));
typedef float f32x4 __attribute__((ext_vector_type(4)));
typedef unsigned u32x4 __attribute__((ext_vector_type(4)));
constexpr int BM = 256, BK = 64, HALF = 128, HTB = HALF * BK * 2  , STAGE_BYTES = 8 * HTB, NXCD = 8, WGM = 8;

__host__ __device__ __forceinline__ int lds_byte(int r, int c) { const int st = (r >> 4) * 2 + (c >> 5), rr = r & 15, cc = c & 31, ob = rr * 64 + cc * 2; return st * 1024 + (ob ^ (((ob >> 9) & 1) << 5)); }
__host__ __device__ __forceinline__ void stage_rc(int b, int& R, int& C) { const int st = b / 1024, sb = b % 1024, swz = sb ^ (((sb >> 9) & 1) << 5); R = (st >> 1) * 16 + swz / 64; C = (st & 1) * 32 + (swz % 64) / 2; }
__host__ __device__ __forceinline__ int perm32(int rho) { const int n = rho >> 4, i = rho & 15; return 8 * (i >> 2) + 4 * n + (i & 3); }
struct Unit { int pm, pn; };
struct Gemm { const bf16_t* A; const bf16_t* Bt; int M, N, K; int lda; };
struct StaticOrder {
    int nM, nN, nwg, G, c;
    __host__ __device__ void init(int M, int N, int G_, int c_) { nM = M / BM; nN = N / BM; nwg = nM * nN; G = G_; c = c_; }
    __host__ __device__ bool next(int i, Unit& u) const {
        const long L = (long)i * G + c; if (L >= nwg) return false;
        int wgid = (int)L; { const int q = nwg / NXCD, r = nwg % NXCD, xcd = wgid % NXCD, off = wgid / NXCD; wgid = (xcd < r ? xcd * (q + 1) : r * (q + 1) + (xcd - r) * q) + off; }
        const int nig = WGM * nN, gid = wgid / nig, fm = gid * WGM, gsz = (nM - fm) < WGM ? (nM - fm) : WGM;
        u.pm = fm + ((wgid % nig) % gsz); u.pn = (wgid % nig) / gsz; return true;
    }
    __device__ __forceinline__ void a_ready(const Unit&) const {}
    __device__ __forceinline__ void done(const Unit&) const {}
    __device__ __forceinline__ size_t a_off(const Unit&) const { return 0; }
};
template <class Epi, class Sched, bool STAMP = false>
__device__ __forceinline__ void gemm_phase(PG8_LAS unsigned char* lds, const Gemm g, const Sched& S, const Epi& E, unsigned long long* stamps) {
    int tid_raw = threadIdx.x; asm volatile("" : "+v"(tid_raw));
    const int tid = tid_raw, wid = __builtin_amdgcn_readfirstlane(tid >> 6), lane = tid & 63, wr = wid >> 2, wc = wid & 3, fr = lane & 15, fq = lane >> 4;
    const int K = g.K, nt = K / BK;
    int ts_lo = 0, ts_hi = 0, nts = 0; const unsigned long long rt_entry = STAMP ? (unsigned long long)wall_clock64() : 0ull;
#define PG8_STAMP() do { if (STAMP && wid == 0 && nts < 64) { const unsigned long long _c = (unsigned long long)clock64(); \
        ts_lo = (lane == nts) ? (int)(unsigned)_c : ts_lo; ts_hi = (lane == nts) ? (int)(unsigned)(_c >> 32) : ts_hi; ++nts; } } while (0)
    PG8_STAMP();
    unsigned voffA[2], voffB[2];
#pragma unroll
    for (int i = 0; i < 2; ++i) { int R, C; stage_rc(tid * 16 + i * 8192, R, C); const int Rb = Epi::PERM ? ((R & ~31) + perm32(R & 31)) : R;
        voffA[i] = (unsigned)(R * g.lda + C) * 2u; voffB[i] = (unsigned)(Rb * K + C) * 2u; }
    const size_t kstep = (size_t)(BK * 2);
    const size_t hstep = (size_t)HALF * K * 2;
    const size_t tstep = 2 * hstep;
    const size_t hstepA = (size_t)HALF * g.lda * 2, tstepA = 2 * hstepA;
    const unsigned ldsw = (unsigned)wid * 1024u;
    const int aoff = lds_byte(wr * 64 + fr, fq * 8), boff = lds_byte(wc * 32 + fr, fq * 8);
#define PG8_SA(b, h) (((b) * 2 + (h)) * HTB)
#define PG8_SB(b, h) ((4 + (b) * 2 + (h)) * HTB)
#define PG8_STAGE(bufoff, gbase, voff) do { _Pragma("unroll") for (int _i = 0; _i < 2; ++_i) \
        __builtin_amdgcn_global_load_lds((const unsigned*)((const char*)(gbase) + (voff)[_i]), (PG8_LAS unsigned*)(lds + (bufoff) + ldsw + _i * 8192), 16, 0, 0); } while (0)
#define PG8_LDA(dst, b, h) do { _Pragma("unroll") for (int m = 0; m < 4; ++m) _Pragma("unroll") for (int k = 0; k < 2; ++k) dst[m][k] = *(const PG8_LAS bf16x8*)(lds + PG8_SA(b, h) + aoff + m * 2048 + k * 1024); } while (0)
#define PG8_LDB(dst, b, h) do { _Pragma("unroll") for (int n = 0; n < 2; ++n) _Pragma("unroll") for (int k = 0; k < 2; ++k) dst[n][k] = *(const PG8_LAS bf16x8*)(lds + PG8_SB(b, h) + boff + n * 2048 + k * 1024); } while (0)
#define PG8_MMA(ai, bj, At, Bt) do { __builtin_amdgcn_s_setprio(1); _Pragma("unroll") for (int m = 0; m < 4; ++m) _Pragma("unroll") for (int n = 0; n < 2; ++n) _Pragma("unroll") for (int k = 0; k < 2; ++k) \
        acc[ai][bj][m][n] = __builtin_amdgcn_mfma_f32_16x16x32_bf16(Bt[n][k], At[m][k], acc[ai][bj][m][n], 0, 0, 0); __builtin_amdgcn_s_setprio(0); } while (0)
#define PG8_WAIT_V(n) asm volatile("s_waitcnt vmcnt(" #n ")" ::: "memory")
#define PG8_WAIT_L(n) asm volatile("s_waitcnt lgkmcnt(" #n ")" ::: "memory")
#define PG8_BAR __builtin_amdgcn_s_barrier()
#define PG8_SCHED __builtin_amdgcn_sched_barrier(0)
    Unit cur, nxt; int ui = 0;
    if (!S.next(0, cur)) return;
    f32x4 acc[2][2][4][2];
#pragma unroll
    for (int a = 0; a < 2; ++a)
#pragma unroll
        for (int b = 0; b < 2; ++b)
#pragma unroll
            for (int m = 0; m < 4; ++m)
#pragma unroll
                for (int n = 0; n < 2; ++n) acc[a][b][m][n] = (f32x4){0.f, 0.f, 0.f, 0.f};
    bf16x8 At[4][2], B0[2][2], B1[2][2];
    const char* cA = (const char*)g.A + (size_t)cur.pm * tstepA + S.a_off(cur); const char* cB = (const char*)g.Bt + (size_t)cur.pn * tstep;
    S.a_ready(cur);
    PG8_STAGE(PG8_SB(0, 0), cB, voffB); PG8_STAGE(PG8_SA(0, 0), cA, voffA); PG8_STAGE(PG8_SB(0, 1), cB + hstep, voffB); PG8_STAGE(PG8_SA(0, 1), cA + hstepA, voffA);
    if (wr == 1) PG8_BAR;
    PG8_WAIT_V(4); PG8_BAR;
    PG8_STAGE(PG8_SB(1, 0), cB + kstep, voffB); PG8_STAGE(PG8_SA(1, 0), cA + kstep, voffA); PG8_STAGE(PG8_SB(1, 1), cB + hstep + kstep, voffB);
    PG8_WAIT_V(6); PG8_BAR;
    PG8_STAMP();
    for (;;) {
        const bool has_next = S.next(ui + 1, nxt);
        const char* nA = has_next ? (const char*)g.A + (size_t)nxt.pm * tstepA + S.a_off(nxt) : cA; const char* nB = has_next ? (const char*)g.Bt + (size_t)nxt.pn * tstep : cB;
        for (int t = 0; t < nt; t += 2) {
            const bool last = (t == nt - 2);
            const char* a1 = cA + (size_t)(t + 1) * kstep;
            const char* a2 = last ? nA : cA + (size_t)(t + 2) * kstep; const char* b2 = last ? nB : cB + (size_t)(t + 2) * kstep;
            const char* a3 = a2 + kstep; const char* b3 = b2 + kstep;
            if (last && has_next) S.a_ready(nxt);
            PG8_LDB(B0, 0, 0); PG8_SCHED; PG8_LDA(At, 0, 0); PG8_STAGE(PG8_SA(1, 1), a1 + hstepA, voffA);
            PG8_WAIT_L(8); PG8_BAR; PG8_WAIT_L(0); PG8_MMA(0, 0, At, B0); PG8_BAR; PG8_SCHED;
            PG8_LDB(B1, 0, 1); PG8_STAGE(PG8_SB(0, 0), b2, voffB);
            PG8_BAR; PG8_WAIT_L(0); PG8_MMA(0, 1, At, B1); PG8_BAR;
            PG8_LDA(At, 0, 1); PG8_STAGE(PG8_SA(0, 0), a2, voffA);
            PG8_BAR; PG8_WAIT_L(0); PG8_MMA(1, 0, At, B0); PG8_BAR; PG8_SCHED;
            PG8_STAGE(PG8_SB(0, 1), b2 + hstep, voffB);
            PG8_WAIT_V(6); PG8_BAR; PG8_MMA(1, 1, At, B1); PG8_BAR;
            PG8_LDB(B0, 1, 0); PG8_SCHED; PG8_LDA(At, 1, 0); PG8_STAGE(PG8_SA(0, 1), a2 + hstepA, voffA);
            PG8_WAIT_L(8); PG8_BAR; PG8_WAIT_L(0); PG8_MMA(0, 0, At, B0); PG8_BAR; PG8_SCHED;
            PG8_LDB(B1, 1, 1); PG8_STAGE(PG8_SB(1, 0), b3, voffB);
            PG8_BAR; PG8_WAIT_L(0); PG8_MMA(0, 1, At, B1); PG8_BAR;
            PG8_LDA(At, 1, 1); PG8_STAGE(PG8_SA(1, 0), a3, voffA);
            PG8_BAR; PG8_WAIT_L(0); PG8_MMA(1, 0, At, B0); PG8_BAR; PG8_SCHED;
            PG8_STAGE(PG8_SB(1, 1), b3 + hstep, voffB);
            PG8_WAIT_V(6); PG8_BAR; PG8_MMA(1, 1, At, B1); PG8_BAR;
        }
        PG8_STAMP();
        if constexpr (!Epi::AFTER_DRAIN) { E(acc, cur, wr, wc, fr, fq); S.done(cur); }
        PG8_STAMP();
        if (!has_next) break;
#pragma unroll
        for (int a = 0; a < 2; ++a)
#pragma unroll
            for (int b = 0; b < 2; ++b)
#pragma unroll
                for (int m = 0; m < 4; ++m)
#pragma unroll
                    for (int n = 0; n < 2; ++n) acc[a][b][m][n] = (f32x4){0.f, 0.f, 0.f, 0.f};
        cur = nxt; cA = nA; cB = nB; ++ui;
    }
    PG8_WAIT_V(0);
    if (wr == 0) PG8_BAR;
    PG8_BAR;
    if constexpr (Epi::AFTER_DRAIN) { E.fused(acc, cur, wr, wc, fr, fq, lds, wid, lane); S.done(cur); }
    PG8_STAMP();
    if (STAMP && wid == 0) { stamps[lane] = lane < nts ? (((unsigned long long)(unsigned)ts_hi << 32) | (unsigned)ts_lo) : 0ull;
        if (lane == 62) stamps[62] = rt_entry; if (lane == 63) stamps[63] = (unsigned long long)wall_clock64(); }
#undef PG8_STAMP
#undef PG8_SA
#undef PG8_SB
#undef PG8_STAGE
#undef PG8_LDA
#undef PG8_LDB
#undef PG8_MMA
#undef PG8_WAIT_V
#undef PG8_WAIT_L
#undef PG8_BAR
#undef PG8_SCHED
}
}

struct EpiIn {
  static constexpr bool PERM = true, AFTER_DRAIN = false;
  CParams* kp;
  __device__ __forceinline__ void operator()(const pg8::f32x4 (&acc)[2][2][4][2], const pg8::Unit& u, int wr, int wc, int fr, int fq) const {
    const int pn = u.pn;
    u16* base; int ld, mode;
    if (pn < 4) { base = kp->U + pn * 256; ld = D; mode = 0; }
    else if (pn < 16) { base = kp->Z + (pn - 4) * 256; ld = 3072; mode = 1; }
    else { base = kp->Ms + (pn - 16) * 256; ld = 3072; mode = 2; }
    const int row0 = u.pm * 256 + wr * 64 + fr;
    const int col0 = wc * 32 + 8 * fq;
    u16* rowp0 = base + (size_t)row0 * ld + col0;
#pragma unroll
    for (int ai = 0; ai < 2; ++ai)
#pragma unroll
      for (int m = 0; m < 4; ++m)
#pragma unroll
        for (int bj = 0; bj < 2; ++bj) {
          pg8::f32x4 v0 = acc[ai][bj][m][0], v1 = acc[ai][bj][m][1];
          if (mode == 1) {
#pragma unroll
            for (int j = 0; j < 4; ++j) { v0[j] = siluf_(v0[j]); v1[j] = siluf_(v1[j]); }
          } else if (mode == 2) {
#pragma unroll
            for (int j = 0; j < 4; ++j) { v0[j] = sigmoidf_(v0[j]); v1[j] = sigmoidf_(v1[j]); }
          }
          u32x4 w; w.x = pack2(v0[0], v0[1]); w.y = pack2(v0[2], v0[3]); w.z = pack2(v1[0], v1[1]); w.w = pack2(v1[2], v1[3]);
          *(u32x4*)(rowp0 + (size_t)(ai * 128 + m * 16) * ld + bj * 128) = w;
        }
  }
};


DI bool tile_map(int i, int MT, int NT, int& mt, int& nt) {
  const int G = gridDim.x, bid = blockIdx.x;
  if ((G & 63) == 0 && (MT & 7) == 0 && (NT % (G >> 6)) == 0) {
    const int SH = G >> 6;
    const int xcd = bid & 7, slot = bid >> 3;
    const int sx = slot & 7, sy = slot >> 3;
    const int nsn = NT / SH, nsm = MT >> 3;
    const int st = i * 8 + xcd;
    if (st >= nsm * nsn) return false;
    mt = (st / nsn) * 8 + sx;
    nt = (st % nsn) * SH + sy;
    return true;
  }
  const int it = bid + i * G;
  if (it >= MT * NT) return false;
  mt = it / NT; nt = it % NT;
  return true;
}


struct OneUnit {
  int pm, pn;
  __device__ bool next(int i, pg8::Unit& u) const { if (i) return false; u.pm = pm; u.pn = pn; return true; }
  __device__ __forceinline__ void a_ready(const pg8::Unit&) const {}
  __device__ __forceinline__ void done(const pg8::Unit&) const {}
  __device__ __forceinline__ size_t a_off(const pg8::Unit&) const { return 0; }
};
struct EpiQKV {
  static constexpr bool PERM = false, AFTER_DRAIN = true;
  CParams* kp; char* lds; int l, nt, m0;
  __device__ __forceinline__ void fused(const pg8::f32x4 (&acc)[2][2][4][2], const pg8::Unit&, int wr, int wc, int fr, int fq,
                                        PG8_LAS unsigned char*, int, int) const {
    CParams& p = *kp;
    const int NB = p.NB, RL = NB * S;
    const int tid = otid();
    const bool lat = m0 < RL;
    int b, t0;
    if (lat) { b = m0 / S; t0 = m0 % S; } else { int rc = m0 - RL; b = rc / L; t0 = rc % L; }
    const bool isV = (nt == 13 || nt == 23);
    const bool isC = nt >= 18;
    const bool isQ = (nt >= 8 && nt < 12) || (nt >= 18 && nt < 22);
    auto process_unit = [&](int hsel, int u) {
      if (isV) {
        const int slot = (isC ? 2 : 0) + hsel;
        const int d = u >> 2, tq = u & 3;
        const float* Cs = (const float*)lds;
        u16* dst = lat ? p.VtL + ((size_t)(b * 4 + slot) * 128 + d) * S + t0 + tq * 64
                       : p.VtC + ((size_t)(b * 4 + slot) * 128 + d) * L + t0 + tq * 64;
#pragma unroll 1
        for (int c = 0; c < 4; ++c) {
          float v[16];
#pragma unroll
          for (int j = 0; j < 16; ++j) v[j] = Cs[(tq * 64 + c * 16 + j) * 132 + d];
          uint4 o0, o1;
          o0.x = pack2(v[0], v[1]); o0.y = pack2(v[2], v[3]); o0.z = pack2(v[4], v[5]); o0.w = pack2(v[6], v[7]);
          o1.x = pack2(v[8], v[9]); o1.y = pack2(v[10], v[11]); o1.z = pack2(v[12], v[13]); o1.w = pack2(v[14], v[15]);
          *(uint4*)(dst + c * 16) = o0;
          *(uint4*)(dst + c * 16 + 8) = o1;
        }
      } else {
        const int row = u >> 1, half = u & 1;
        const size_t gr = (size_t)m0 + row;
        const int t = t0 + row;
        const float* Cr = (const float*)lds + row * 132 + half * 64;
        float rstd = 1.f;
        const float* gn = (isQ ? p.q_norm_g : p.k_norm_g) + l * 128 + half * 64;
        if (isC) {
          float ss = 0.f;
#pragma unroll
          for (int j = 0; j < 16; ++j) {
            float4 tv = *(const float4*)(Cr + j * 4);
            ss += tv.x * tv.x + tv.y * tv.y + tv.z * tv.z + tv.w * tv.w;
          }
          ss += __shfl_xor(ss, 1);
          rstd = rsqrtf(ss * (1.f / 128.f) + EPS);
        }
        const int pos = (half == 0) ? (t >> 6) : (t & 63);
        const float* cs = p.rope + pos * 32;
        const float* sn = p.rope + 2048 + pos * 32;
        u16* dst;
        if (isQ) {
          const int head = (isC ? (nt - 18) : (nt - 8)) * 2 + hsel;
          dst = p.Q + gr * 2048 + (isC ? 1024 : 0) + head * 128 + half * 64;
        } else {
          dst = p.Kb + gr * 512 + (isC ? 256 : 0) + hsel * 128 + half * 64;
        }
#pragma unroll 1
        for (int c = 0; c < 2; ++c) {
          float x0[16], x1[16];
#pragma unroll
          for (int j = 0; j < 4; ++j) {
            float4 ta_ = *(const float4*)(Cr + c * 16 + j * 4);
            float4 tb_ = *(const float4*)(Cr + 32 + c * 16 + j * 4);
            x0[4 * j] = ta_.x; x0[4 * j + 1] = ta_.y; x0[4 * j + 2] = ta_.z; x0[4 * j + 3] = ta_.w;
            x1[4 * j] = tb_.x; x1[4 * j + 1] = tb_.y; x1[4 * j + 2] = tb_.z; x1[4 * j + 3] = tb_.w;
          }
          if (isC) {
#pragma unroll
            for (int j = 0; j < 16; ++j) { x0[j] = x0[j] * rstd * gn[c * 16 + j]; x1[j] = x1[j] * rstd * gn[32 + c * 16 + j]; }
          }
          if (lat) {
#pragma unroll
            for (int j = 0; j < 16; ++j) {
              float c_ = cs[c * 16 + j], s_ = sn[c * 16 + j];
              float a0 = x0[j], a1 = x1[j];
              x0[j] = a0 * c_ - a1 * s_;
              x1[j] = a1 * c_ + a0 * s_;
            }
          }
          if (isQ) {
#pragma unroll
            for (int j = 0; j < 16; ++j) { x0[j] *= QSCALE; x1[j] *= QSCALE; }
          }
          uint4 o0, o1, o2, o3;
          o0.x = pack2(x0[0], x0[1]); o0.y = pack2(x0[2], x0[3]); o0.z = pack2(x0[4], x0[5]); o0.w = pack2(x0[6], x0[7]);
          o1.x = pack2(x0[8], x0[9]); o1.y = pack2(x0[10], x0[11]); o1.z = pack2(x0[12], x0[13]); o1.w = pack2(x0[14], x0[15]);
          o2.x = pack2(x1[0], x1[1]); o2.y = pack2(x1[2], x1[3]); o2.z = pack2(x1[4], x1[5]); o2.w = pack2(x1[6], x1[7]);
          o3.x = pack2(x1[8], x1[9]); o3.y = pack2(x1[10], x1[11]); o3.z = pack2(x1[12], x1[13]); o3.w = pack2(x1[14], x1[15]);
          *(uint4*)(dst + c * 16) = o0;
          *(uint4*)(dst + c * 16 + 8) = o1;
          *(uint4*)(dst + 32 + c * 16) = o2;
          *(uint4*)(dst + 32 + c * 16 + 8) = o3;
        }
      }
    };

#pragma unroll
    for (int bj = 0; bj < 2; ++bj) {
      float* Cs = (float*)lds;
#pragma unroll
      for (int ai = 0; ai < 2; ++ai)
#pragma unroll
        for (int m = 0; m < 4; ++m)
#pragma unroll
          for (int n = 0; n < 2; ++n) {
            const int row = ai * 128 + wr * 64 + m * 16 + fr;
            const int col = wc * 32 + n * 16 + fq * 4;
            pg8::f32x4 v = acc[ai][bj][m][n];
            float4 o; o.x = v[0]; o.y = v[1]; o.z = v[2]; o.w = v[3];
            *(float4*)(Cs + row * 132 + col) = o;
          }
      __syncthreads();
      process_unit(bj, tid);
      __syncthreads();
    }
  }
};

DI void phase_gemm_in(CParams& p, int chunk, int l, char* lds) {
  const int NB = p.NB, RL = NB * S, R = NB * (S + L);
  const int MT = R / 256;
  const u16* Wt = p.WinT + (size_t)l * INW * D;
  {
    pg8::Gemm g{p.Hb, Wt, R, 7168, D, D};
    pg8::StaticOrder So; So.init(R, 7168, (int)gridDim.x, (int)blockIdx.x);
    EpiIn E{&p};
    pg8::gemm_phase<EpiIn, pg8::StaticOrder, false>((PG8_LAS unsigned char*)lds, g, So, E, nullptr);
  }
  for (int ti = 0;; ++ti) {
    int mt, jt;
    if (!tile_map(ti, MT, 12, mt, jt)) break;
    const int nt = (jt < 6) ? 8 + jt : 12 + jt;
    pg8::Gemm g{p.Hb, Wt + (size_t)28 * 256 * D, R, 3072, D, D};
    OneUnit One{mt, jt};
    EpiQKV E{&p, lds, l, nt, mt * 256};
    pg8::gemm_phase<EpiQKV, OneUnit, false>((PG8_LAS unsigned char*)lds, g, One, E, nullptr);
  }
}

struct AttnArgs {
  const u16* q;
  u16* z;
  const u16* kctx;
  const u16* vctx;
  const u16* klat;
  const u16* vlat;
  int n_lat_tiles;
  int lat_key0;
  int q_t0;
  int band;
  int has_sink;
  float sink_l2;
  int dry;
  int fixedm;
  float mfix;
};

DI void attn_load_tile(const AttnArgs& a, int ti, u32x4 (&rk)[2], u32x4 (&rv)[2]) {
  const int tid = otid();
  const u16* kp; const u16* vp; int vs;
  if (ti < 4) { kp = a.kctx + (size_t)(ti * 64) * 512; vp = a.vctx + ti * 64; vs = L; }
  else { kp = a.klat + (size_t)((ti - 4) * 64) * 512; vp = a.vlat + (ti - 4) * 64; vs = S; }
#pragma unroll
  for (int i = 0; i < 2; ++i) {
    int c = tid + NTHR * i;
    rk[i] = *(const u32x4*)(kp + (size_t)(c >> 4) * 512 + (c & 15) * 8);
    rv[i] = *(const u32x4*)(vp + (size_t)(c >> 3) * vs + (c & 7) * 8);
  }
}
DI void attn_store_tile(u16* sK, u16* sV, const u32x4 (&rk)[2], const u32x4 (&rv)[2]) {
  const int tid = otid();
#pragma unroll
  for (int i = 0; i < 2; ++i) {
    int c = tid + NTHR * i;
    *(u32x4*)(sK + (c >> 4) * 136 + (c & 15) * 8) = rk[i];
    u16* vd = sV + (c >> 3) * 72 + ((c & 7) >> 1) * 16 + ((c & 7) & 1) * 4;
    { u32x2 t0 = {rv[i].x, rv[i].y}; *(u32x2*)(vd) = t0; }
    { u32x2 t1 = {rv[i].z, rv[i].w}; *(u32x2*)(vd + 8) = t1; }
  }
}

template <bool NS>
DI void attn_item(const AttnArgs& a, char* lds) {
  const int tid = otid(), lane = tid & 63, w = tid >> 6;
  const int r = lane & 31, hh = lane >> 5;
  constexpr int STG = 17408 + 128 * 144;
  const int ntiles = 4 + a.n_lat_tiles;

  bf16x8 qf[8];
  {
    const u16* qp = a.q + (size_t)(w * 32 + r) * 2048 + hh * 8;
#pragma unroll
    for (int ks = 0; ks < 8; ++ks) qf[ks] = *(const bf16x8*)(qp + ks * 16);
  }
  f32x16 O[4];
#pragma unroll
  for (int dt = 0; dt < 4; ++dt)
#pragma unroll
    for (int x = 0; x < 16; ++x) O[dt][x] = 0.f;
  float m = a.fixedm ? a.mfix : (a.has_sink ? a.sink_l2 : -1e30f);
  float lsum = (a.has_sink && hh == 0) ? 1.f : 0.f;
  const int qpos = a.q_t0 + w * 32 + r;

  auto QK = [&](int stage, f32x16 (&sc)[2]) {
    const u16* sK = (const u16*)(lds + stage * STG);
#pragma unroll
    for (int x = 0; x < 16; ++x) { sc[0][x] = 0.f; sc[1][x] = 0.f; }
    const u16* kb0 = sK + r * 136 + hh * 8;
    const u16* kb1 = sK + (32 + r) * 136 + hh * 8;
#pragma unroll
    for (int ks = 0; ks < 8; ++ks) {
      bf16x8 ka0 = *(const bf16x8*)(kb0 + ks * 16);
      bf16x8 ka1 = *(const bf16x8*)(kb1 + ks * 16);
      sc[0] = MFMA32(ka0, qf[ks], sc[0]);
      sc[1] = MFMA32(ka1, qf[ks], sc[1]);
    }
  };
  u32x4 rk[2], rv[2], rk1[2], rv1[2];
  auto STEP = [&](int ti, int st, f32x16 (&sc)[2], f32x16 (&sn)[2], u32x4 (&lk)[2], u32x4 (&lv)[2], u32x4 (&sk)[2], u32x4 (&sv)[2]) {
    const int st1 = (st == 2) ? 0 : st + 1, st2 = (st == 0) ? 2 : st - 1;
    if (ti + 3 < ntiles) attn_load_tile(a, ti + 3, lk, lv);
    if (ti + 1 < ntiles) QK(st1, sn);
    if (a.band && ti >= 4) {
      const int k0 = a.lat_key0 + (ti - 4) * 64;
#pragma unroll
      for (int kt2 = 0; kt2 < 2; ++kt2)
#pragma unroll
        for (int x = 0; x < 16; ++x) {
          int kp = k0 + kt2 * 32 + crow(x, hh);
          int dlt = kp - qpos; dlt = dlt < 0 ? -dlt : dlt;
          if (dlt > 128) sc[kt2][x] = -1e30f;
        }
    }
    if (!NS && !a.fixedm) {
      float mx = sc[0][0];
#pragma unroll
      for (int kt2 = 0; kt2 < 2; ++kt2)
#pragma unroll
        for (int x = 0; x < 16; ++x) mx = fmaxf(mx, sc[kt2][x]);
      mx = fmaxf(mx, __shfl_xor(mx, 32));
      if (__any(mx > m + 8.f)) {
        const float mnew = fmaxf(m, mx);
        const float alpha = __builtin_amdgcn_exp2f(m - mnew);
        m = mnew;
        lsum *= alpha;
#pragma unroll
        for (int dt = 0; dt < 4; ++dt)
#pragma unroll
          for (int x = 0; x < 16; ++x) O[dt][x] *= alpha;
      }
    }
    float ps = 0.f;
#pragma unroll
    for (int kt2 = 0; kt2 < 2; ++kt2)
#pragma unroll
      for (int x = 0; x < 16; ++x) { float pv = NS ? __builtin_amdgcn_exp2f(sc[kt2][x]) : __builtin_amdgcn_exp2f(sc[kt2][x] - m); sc[kt2][x] = pv; ps += pv; }
    lsum += ps;
    const u16* sV = (const u16*)(lds + st * STG + 17408);
#pragma unroll
    for (int kt2 = 0; kt2 < 2; ++kt2)
#pragma unroll
      for (int s2 = 0; s2 < 2; ++s2) {
        union { unsigned u[4]; bf16x8 v; } pf;
#pragma unroll
        for (int j = 0; j < 4; ++j) pf.u[j] = pack2(sc[kt2][8 * s2 + 2 * j], sc[kt2][8 * s2 + 2 * j + 1]);
        const u16* vb = sV + r * 72 + kt2 * 32 + 16 * s2 + 8 * hh;
#pragma unroll
        for (int dt = 0; dt < 4; ++dt) {
          bf16x8 va = *(const bf16x8*)(vb + dt * 32 * 72);
          O[dt] = MFMA32(va, pf.v, O[dt]);
        }
      }
    if (ti + 2 < ntiles) attn_store_tile((u16*)(lds + st2 * STG), (u16*)(lds + st2 * STG + 17408), sk, sv);
    asm volatile("s_waitcnt lgkmcnt(0)" ::: "memory");
    __builtin_amdgcn_s_barrier();
    asm volatile("" ::: "memory");
  };

  attn_load_tile(a, 0, rk, rv);
  __syncthreads();
  attn_store_tile((u16*)lds, (u16*)(lds + 17408), rk, rv);
  attn_load_tile(a, 1, rk, rv);
  attn_store_tile((u16*)(lds + STG), (u16*)(lds + STG + 17408), rk, rv);
  attn_load_tile(a, 2, rk, rv);
  __syncthreads();
  f32x16 sA[2], sB[2];
  QK(0, sA);
  int st = 0;
  for (int ti = 0; ti < ntiles; ti += 2) {
    STEP(ti, st, sA, sB, rk1, rv1, rk, rv);
    st = (st == 2) ? 0 : st + 1;
    if (ti + 1 < ntiles) {
      STEP(ti + 1, st, sB, sA, rk, rv, rk1, rv1);
      st = (st == 2) ? 0 : st + 1;
    }
  }
  float ltot = lsum + __shfl_xor(lsum, 32);
  const float inv = 1.f / ltot;
  u16* zp = a.z + (size_t)(w * 32 + r) * 3072;
  u32x2 gv[4][4];
#pragma unroll
  for (int dt = 0; dt < 4; ++dt)
#pragma unroll
    for (int g4 = 0; g4 < 4; ++g4) gv[dt][g4] = *(const u32x2*)(zp + dt * 32 + 8 * g4 + 4 * hh);
#pragma unroll
  for (int dt = 0; dt < 4; ++dt)
#pragma unroll
    for (int g4 = 0; g4 < 4; ++g4) {
      int d0 = dt * 32 + 8 * g4 + 4 * hh;
      float y0 = O[dt][4 * g4 + 0] * inv * bflo(gv[dt][g4].x);
      float y1 = O[dt][4 * g4 + 1] * inv * bfhi(gv[dt][g4].x);
      float y2 = O[dt][4 * g4 + 2] * inv * bflo(gv[dt][g4].y);
      float y3 = O[dt][4 * g4 + 3] * inv * bfhi(gv[dt][g4].y);
      uint2 o; o.x = pack2(y0, y1); o.y = pack2(y2, y3);
      if (!a.dry || y0 != y0) *(uint2*)(zp + d0) = o;
    }
}

template <bool REV>
DI void lru_scan(float (&av)[2][16], float (&bv)[2][16], float& carry, int hh) {
  float segA[8], segB[8];
#pragma unroll
  for (int k = 0; k < 8; ++k) {
    const int mt = k >> 2, q = k & 3;
    float cA = 1.f, hl = 0.f;
#pragma unroll
    for (int jj = 0; jj < 4; ++jj) {
      const int j = REV ? 3 - jj : jj;
      const int i = 4 * q + j;
      hl = av[mt][i] * hl + bv[mt][i];
      cA *= av[mt][i];
      av[mt][i] = cA; bv[mt][i] = hl;
    }
    segA[k] = cA; segB[k] = hl;
  }
  float oA[8], oB[8];
#pragma unroll
  for (int k = 0; k < 8; ++k) { oA[k] = __shfl_xor(segA[k], 32); oB[k] = __shfl_xor(segB[k], 32); }
  float init[8];
  float st = carry;
#pragma unroll
  for (int kk = 0; kk < 8; ++kk) {
    const int k = REV ? 7 - kk : kk;
    const int first = REV ? 1 : 0;
    float A1 = (hh == first) ? segA[k] : oA[k];
    float B1 = (hh == first) ? segB[k] : oB[k];
    float st0 = st;
    st = A1 * st + B1;
    float A2 = (hh == first) ? oA[k] : segA[k];
    float B2 = (hh == first) ? oB[k] : segB[k];
    float st1 = st;
    st = A2 * st + B2;
    init[k] = (hh == first) ? st0 : st1;
  }
  carry = st;
#pragma unroll
  for (int k = 0; k < 8; ++k) {
    const int mt = k >> 2, q = k & 3;
#pragma unroll
    for (int j = 0; j < 4; ++j) {
      const int i = 4 * q + j;
      bv[mt][i] = bv[mt][i] + av[mt][i] * init[k];
    }
  }
}

DI void lru_item(CParams& p, int l, int b, int n, bool last, char* lds, int dry = 0) {
  const int NB = p.NB, RL = NB * S;
  const int tid = otid(), lane = tid & 63, w8 = tid >> 6;
  const int sub = __builtin_amdgcn_readfirstlane(w8 >> 2), w = w8 & 3;
  n = n + sub;
  lds += sub * 73728;
  const int dir = w >> 1, w2 = w & 1;
  const int tl = tid & 127;
  const int r = lane & 31, hh = lane >> 5;
  u16* sRaw = (u16*)lds + dir * (8704 / 2);
  u16* sUp = (u16*)(lds + 17408) + dir * (9216 / 2);
  float* sH = (float*)(lds + 35840) + w * (64 * 36);

  const int chb = n * 64;
  const int cp = (tl & 31) * 2, tg = tl >> 5;
  float cw0[4], cw1[4], cb0, cb1;
#pragma unroll
  for (int k = 0; k < 4; ++k) {
    cw0[k] = p.conv_w[((size_t)l * 4 + k) * D + chb + cp];
    cw1[k] = p.conv_w[((size_t)l * 4 + k) * D + chb + cp + 1];
  }
  cb0 = p.conv_b[l * D + chb + cp]; cb1 = p.conv_b[l * D + chb + cp + 1];
  bf16x8 waf[4], wxf[4];
  {
    const float* wa = p.lru_wa + (((size_t)(l * 2 + dir) * 16 + n) * 64) * 64;
    const float* wx = p.lru_wx + (((size_t)(l * 2 + dir) * 16 + n) * 64) * 64;
    const int e = 32 * w2 + r;
#pragma unroll
    for (int ks = 0; ks < 4; ++ks) {
      union { unsigned u[4]; bf16x8 v; } fa, fx;
#pragma unroll
      for (int j = 0; j < 4; ++j) {
        int d0 = ks * 16 + 8 * hh + 2 * j;
        fa.u[j] = pack2(wa[d0 * 64 + e], wa[(d0 + 1) * 64 + e]);
        fx.u[j] = pack2(wx[d0 * 64 + e], wx[(d0 + 1) * 64 + e]);
      }
      waf[ks] = fa.v; wxf[ks] = fx.v;
    }
  }
  const int che = chb + 32 * w2 + r;
  const float ba = p.lru_ba[(l * 2 + dir) * D + che];
  const float bx = p.lru_bx[(l * 2 + dir) * D + che];
  float c8sp;
  {
    float lam = p.lru_lambda[(l * 2 + dir) * D + che];
    float sp = (lam < -20.f) ? -lam : log1pf(expf(-lam));
    c8sp = 8.f * sp;
  }
  float carry = 0.f;

  auto step_tile = [&](int st, bool& isctx, int& tt) {
    if (dir == 0) { if (st < 4) { isctx = true; tt = st; } else { isctx = false; tt = st - 4; } }
    else { if (st < 4) { isctx = true; tt = 3 - st; } else { isctx = false; tt = 63 - (st - 4); } }
  };
  u32x4 pre[5];
  auto load_raw = [&](int st) {
    bool isctx; int tt; step_tile(st, isctx, tt);
    const int seqlen = isctx ? L : S;
    const size_t rowbase = isctx ? (size_t)RL + (size_t)b * L : (size_t)b * S;
    const int t0 = tt * 64;
#pragma unroll
    for (int i = 0; i < 5; ++i) {
      int c = tl + 128 * i;
      int rr = c >> 3, c16 = c & 7;
      int t = t0 - 2 + rr;
      u32x4 v = {0u, 0u, 0u, 0u};
      if (rr < 67 && t >= 0 && t < seqlen) v = *(const u32x4*)(p.U + (rowbase + t) * D + chb + c16 * 8);
      pre[i] = v;
    }
  };
  load_raw(0);
  __syncthreads();
  for (int st = 0; st < 68; ++st) {
    bool isctx; int tt; step_tile(st, isctx, tt);
    const size_t rowbase = isctx ? (size_t)RL + (size_t)b * L : (size_t)b * S;
    const int t0 = tt * 64;
#pragma unroll
    for (int i = 0; i < 5; ++i) {
      int c = tl + 128 * i;
      int rr = c >> 3, c16 = c & 7;
      if (rr < 67) *(u32x4*)(sRaw + rr * 64 + c16 * 8) = pre[i];
    }
    if (st + 1 < 68) load_raw(st + 1);
    asm volatile("s_waitcnt lgkmcnt(0)" ::: "memory"); __builtin_amdgcn_s_barrier(); asm volatile("" ::: "memory");
    {
      const u16* rp = sRaw + (tg * 16) * 64 + cp;
      unsigned r0 = *(const unsigned*)(rp), r1 = *(const unsigned*)(rp + 64), r2 = *(const unsigned*)(rp + 128);
#pragma unroll
      for (int i = 0; i < 16; ++i) {
        unsigned r3 = *(const unsigned*)(rp + (i + 3) * 64);
        float o0 = cb0 + cw0[0] * bflo(r0) + cw0[1] * bflo(r1) + cw0[2] * bflo(r2) + cw0[3] * bflo(r3);
        float o1 = cb1 + cw1[0] * bfhi(r0) + cw1[1] * bfhi(r1) + cw1[2] * bfhi(r2) + cw1[3] * bfhi(r3);
        *(unsigned*)(sUp + (tg * 16 + i) * 72 + cp) = pack2(o0, o1);
        r0 = r1; r1 = r2; r2 = r3;
      }
    }
    asm volatile("s_waitcnt lgkmcnt(0)" ::: "memory"); __builtin_amdgcn_s_barrier(); asm volatile("" ::: "memory");
    const bool fwd_first = isctx ? (tt <= 1) : (tt <= 31);
    const bool first = (dir == 0) ? fwd_first : !fwd_first;
    unsigned long long pt0[4], pt1[4];
    u32x4 pg[4];
    if (!first && !(isctx && last)) {
#pragma unroll
      for (int j = 0; j < 4; ++j) {
        const int q = lane + 64 * j;
        const int tok = q >> 2, cc = (q & 3) * 8;
        const size_t row = rowbase + t0 + tok;
        const int col = chb + 32 * w2 + cc;
        const u16* tp = p.Hb + row * D + col;
        pt0[j] = __hip_atomic_load((const unsigned long long*)tp, __ATOMIC_RELAXED, __HIP_MEMORY_SCOPE_AGENT);
        pt1[j] = __hip_atomic_load((const unsigned long long*)tp + 1, __ATOMIC_RELAXED, __HIP_MEMORY_SCOPE_AGENT);
        pg[j] = *(const u32x4*)(p.Z + row * 3072 + col);
      }
    } else {
#pragma unroll
      for (int j = 0; j < 4; ++j) { pt0[j] = 0; pt1[j] = 0; pg[j] = u32x4{0u, 0u, 0u, 0u}; }
    }
    float av[2][16], bv[2][16];
    {
      f32x16 aR[2];
#pragma unroll
      for (int mt = 0; mt < 2; ++mt) {
#pragma unroll
        for (int x = 0; x < 16; ++x) aR[mt][x] = 0.f;
        const u16* ub = sUp + (mt * 32 + r) * 72 + hh * 8;
#pragma unroll
        for (int ks = 0; ks < 4; ++ks) aR[mt] = MFMA32(*(const bf16x8*)(ub + ks * 16), waf[ks], aR[mt]);
      }
#pragma unroll
      for (int mt = 0; mt < 2; ++mt)
#pragma unroll
        for (int x = 0; x < 16; ++x) {
          const float rg = sigmoidf_(aR[mt][x] + ba);
          av[mt][x] = -c8sp * rg;
        }
    }
    {
      f32x16 aI[2];
#pragma unroll
      for (int mt = 0; mt < 2; ++mt) {
#pragma unroll
        for (int x = 0; x < 16; ++x) aI[mt][x] = 0.f;
        const u16* ub = sUp + (mt * 32 + r) * 72 + hh * 8;
#pragma unroll
        for (int ks = 0; ks < 4; ++ks) aI[mt] = MFMA32(*(const bf16x8*)(ub + ks * 16), wxf[ks], aI[mt]);
      }
#pragma unroll
      for (int mt = 0; mt < 2; ++mt)
#pragma unroll
        for (int x = 0; x < 16; ++x) {
          const int tok = mt * 32 + crow(x, hh);
          const float up = bf2f(sUp[tok * 72 + 32 * w2 + r]);
          const float ig = sigmoidf_(aI[mt][x] + bx);
          const float la = av[mt][x];
          const float a_ = __expf(la);
          const float om = fmaxf(1.f - a_ * a_, 0.f);
          av[mt][x] = a_;
          bv[mt][x] = __builtin_amdgcn_sqrtf(om) * (ig * up);
        }
    }
    if (dir == 0) lru_scan<false>(av, bv, carry, hh); else lru_scan<true>(av, bv, carry, hh);
#pragma unroll
    for (int mt = 0; mt < 2; ++mt)
#pragma unroll
      for (int x = 0; x < 16; ++x) sH[(mt * 32 + crow(x, hh)) * 36 + r] = bv[mt][x];
    if (!(isctx && last)) {
#pragma unroll
      for (int j = 0; j < 4; ++j) {
        const int q = lane + 64 * j;
        const int tok = q >> 2, cc = (q & 3) * 8;
        const float4 h0 = *(const float4*)(sH + tok * 36 + cc);
        const float4 h1 = *(const float4*)(sH + tok * 36 + cc + 4);
        const size_t row = rowbase + t0 + tok;
        const int col = chb + 32 * w2 + cc;
        u16* tp = p.Hb + row * D + col;
        if (first) {
          uint4 o; o.x = pack2(h0.x, h0.y); o.y = pack2(h0.z, h0.w); o.z = pack2(h1.x, h1.y); o.w = pack2(h1.z, h1.w);
          if (!dry || h0.x != h0.x) *(uint4*)tp = o;
        } else {
          unsigned tx = (unsigned)pt0[j], ty = (unsigned)(pt0[j] >> 32), tz = (unsigned)pt1[j], tw = (unsigned)(pt1[j] >> 32);
          u16* zp = p.Z + row * 3072 + col;
          u32x4 g = pg[j];
          uint4 o;
          o.x = pack2((h0.x + bflo(tx)) * bflo(g.x), (h0.y + bfhi(tx)) * bfhi(g.x));
          o.y = pack2((h0.z + bflo(ty)) * bflo(g.y), (h0.w + bfhi(ty)) * bfhi(g.y));
          o.z = pack2((h1.x + bflo(tz)) * bflo(g.z), (h1.y + bfhi(tz)) * bfhi(g.z));
          o.w = pack2((h1.z + bflo(tw)) * bflo(g.w), (h1.w + bfhi(tw)) * bfhi(g.w));
          if (!dry || h0.x != h0.x) *(uint4*)zp = o;
        }
      }
    }
    __builtin_amdgcn_fence(__ATOMIC_RELEASE, "workgroup");
  }
}

DI void phase_mixers(CParams& p, int chunk, int l, char* lds, int dry = 0) {
  const int NB = p.NB, RL = NB * S;
  const bool last = (l == DEPTH - 1);
  const int nLRU = (dry == 1) ? 0 : NB * 8, nC = (dry == 2) ? 0 : NB * 8 * 16, nBw = (dry == 2) ? 0 : NB * 8 * 16, nCtx = (last || dry == 2) ? 0 : NB * 8 * 2;
  const int total = nLRU + nC + nBw + nCtx;
  int* ctr = p.ctr + chunk * DEPTH + l + (dry ? 32 : 0);
  int* s_item = (int*)(lds + LDS_BYTES - 16);
  int it;
  while (true) {
    __syncthreads();
    if (threadIdx.x == 0) *s_item = atomicAdd(ctr, 1);
    __syncthreads();
    it = __builtin_amdgcn_readfirstlane(*s_item);
    __syncthreads();
    if (it >= nLRU) break;
    lru_item(p, l, it >> 3, (it & 7) * 2, last, lds, dry);
  }
  float gqm = 0.f, gkm = 0.f;
  {
    const int ln = otid() & 63;
    gqm = fmaxf(fabsf(p.q_norm_g[l * 128 + ln]), fabsf(p.q_norm_g[l * 128 + 64 + ln]));
    gkm = fmaxf(fabsf(p.k_norm_g[l * 128 + ln]), fabsf(p.k_norm_g[l * 128 + 64 + ln]));
#pragma unroll
    for (int o = 32; o >= 1; o >>= 1) { gqm = fmaxf(gqm, __shfl_xor(gqm, o)); gkm = fmaxf(gkm, __shfl_xor(gkm, o)); }
    gqm = __builtin_amdgcn_readfirstlane(gqm); gkm = __builtin_amdgcn_readfirstlane(gkm);
  }
  const float mfixC = 128.f * gqm * gkm * QSCALE;
  const int nCfast = (mfixC < 60.f) ? nC : 0;
  auto fetch = [&]() {
    __syncthreads();
    if (threadIdx.x == 0) *s_item = atomicAdd(ctr, 1);
    __syncthreads();
    it = __builtin_amdgcn_readfirstlane(*s_item);
    __syncthreads();
  };
  auto build = [&](int ir, AttnArgs& a) {
    a.dry = dry;
    if (ir < nC + nBw) {
      const bool isB = ir >= nC;
      if (isB) ir -= nC;
      const int b = ir >> 7, h = (ir >> 4) & 7, qb = ir & 15;
      const int kvh = h >> 2;
      const int br = isB ? 0 : 1;
      const size_t qrow0 = (size_t)b * S + qb * 256;
      a.q = p.Q + qrow0 * 2048 + br * 1024 + h * 128;
      a.z = p.Z + qrow0 * 3072 + (br + 1) * 1024 + h * 128;
      const int kcol = br * 256 + kvh * 128, slot = br * 2 + kvh;
      a.kctx = p.Kb + ((size_t)RL + (size_t)b * L) * 512 + kcol;
      a.vctx = p.VtC + (size_t)(b * 4 + slot) * 128 * L;
      int k0, k1;
      if (isB) { k0 = qb * 256 - 128; if (k0 < 0) k0 = 0; k1 = qb * 256 + 384; if (k1 > S) k1 = S; }
      else { k0 = 0; k1 = S; }
      a.lat_key0 = k0;
      a.n_lat_tiles = (k1 - k0) >> 6;
      a.klat = p.Kb + ((size_t)b * S + k0) * 512 + kcol;
      a.vlat = p.VtL + (size_t)(b * 4 + slot) * 128 * S + k0;
      a.q_t0 = qb * 256;
      a.band = isB ? 1 : 0;
      a.has_sink = isB ? 1 : 0;
      a.sink_l2 = isB ? p.attn_sink[l * 8 + h] * LOG2E : 0.f;
      a.fixedm = isB ? 0 : 1; a.mfix = mfixC;
    } else {
      ir -= nC + nBw;
      const int h = ir & 7, br = (ir >> 3) & 1, b = ir >> 4;
      const int kvh = h >> 2;
      const size_t qrow0 = (size_t)RL + (size_t)b * L;
      a.q = p.Q + qrow0 * 2048 + br * 1024 + h * 128;
      a.z = p.Z + qrow0 * 3072 + (br + 1) * 1024 + h * 128;
      const int kcol = br * 256 + kvh * 128, slot = br * 2 + kvh;
      a.kctx = p.Kb + ((size_t)RL + (size_t)b * L) * 512 + kcol;
      a.vctx = p.VtC + (size_t)(b * 4 + slot) * 128 * L;
      a.klat = a.kctx; a.vlat = a.vctx;
      a.n_lat_tiles = 0; a.lat_key0 = 0; a.q_t0 = 0; a.band = 0;
      a.has_sink = (br == 0) ? 1 : 0;
      a.sink_l2 = (br == 0) ? p.attn_sink[l * 8 + h] * LOG2E : 0.f;
      a.fixedm = (br == 0) ? 0 : 1; a.mfix = mfixC;
    }
  };
  while (it < nLRU + nCfast) {
    AttnArgs a;
    build(it - nLRU, a);
    attn_item<true>(a, lds);
    fetch();
  }
  while (it < total) {
    AttnArgs a;
    build(it - nLRU, a);
    attn_item<false>(a, lds);
    fetch();
  }
}

DI void merge_tiles_ctx(CParams& p, int l, char* lds) {
  const int NB = p.NB, RL = NB * S, R = NB * (S + L);
  const int MT = (R - RL) / 256, NT = 8;
  const int tid = otid();
  const int lane = tid & 63, w = tid >> 6, wm = w >> 1, wn = w & 1, r = lane & 31, hh = lane >> 5;
  for (int ti = 0;; ++ti) {
    int mt, nt;
    if (!tile_map(ti, MT, NT, mt, nt)) break;
    const int m0 = RL + mt * 256, n0 = nt * 128;
    f32x16 tot[2][2];
#pragma unroll
    for (int i = 0; i < 2; ++i)
#pragma unroll
      for (int j = 0; j < 2; ++j)
#pragma unroll
        for (int x = 0; x < 16; ++x) tot[i][j][x] = 0.f;
#pragma unroll 1
    for (int n = 0; n < 3; ++n) {
      f32x16 acc[2][2];
      gemm_core<128, false>(p.Z + (size_t)m0 * 3072 + n * 1024, 3072, 64, (size_t)128 * 3072,
                            p.WbT + ((size_t)(l * 3 + n) * D + n0) * D, D, 64, 0, D, lds, acc);
#pragma unroll
      for (int i = 0; i < 2; ++i)
#pragma unroll
        for (int j = 0; j < 2; ++j)
#pragma unroll
          for (int g = 0; g < 4; ++g) {
            const size_t row = (size_t)m0 + wm * 64 + i * 32 + r;
            const int col = n0 + wn * 64 + j * 32 + 8 * g + 4 * hh;
            uint2 sv = *(const uint2*)(p.Ms + row * 3072 + n * 1024 + col);
            tot[i][j][4 * g + 0] += bflo(sv.x) * acc[i][j][4 * g + 0];
            tot[i][j][4 * g + 1] += bfhi(sv.x) * acc[i][j][4 * g + 1];
            tot[i][j][4 * g + 2] += bflo(sv.y) * acc[i][j][4 * g + 2];
            tot[i][j][4 * g + 3] += bfhi(sv.y) * acc[i][j][4 * g + 3];
          }
    }
#pragma unroll
    for (int i = 0; i < 2; ++i)
#pragma unroll
      for (int j = 0; j < 2; ++j)
#pragma unroll
        for (int g = 0; g < 4; ++g) {
          const size_t row = (size_t)m0 + wm * 64 + i * 32 + r;
          const int col = n0 + wn * 64 + j * 32 + 8 * g + 4 * hh;
          uint2 o; o.x = pack2(tot[i][j][4 * g], tot[i][j][4 * g + 1]); o.y = pack2(tot[i][j][4 * g + 2], tot[i][j][4 * g + 3]);
          *(uint2*)(p.Hb + row * D + col) = o;
        }
  }
}

struct MergeOrder {
  pg8::StaticOrder inner;
  __device__ void init(int M, int G, int c) { inner.init(M, 1024, G, c); }
  __device__ bool next(int i, pg8::Unit& u) const {
    const int j = i / 3, n = i - 3 * j;
    pg8::Unit t;
    if (!inner.next(j, t)) return false;
    u.pm = t.pm; u.pn = n * 4 + t.pn;
    return true;
  }
  __device__ __forceinline__ void a_ready(const pg8::Unit&) const {}
  __device__ __forceinline__ void done(const pg8::Unit&) const {}
  __device__ __forceinline__ size_t a_off(const pg8::Unit& u) const { return (size_t)(u.pn >> 2) * 1024 * 2; }
};
struct EpiMerge {
  static constexpr bool PERM = true, AFTER_DRAIN = false;
  CParams* kp;
  __device__ __forceinline__ void operator()(const pg8::f32x4 (&acc)[2][2][4][2], const pg8::Unit& u, int wr, int wc, int fr, int fq) const {
    const int n = u.pn >> 2, ct = u.pn & 3;
    const int row0 = u.pm * 256 + wr * 64 + fr;
    const int col0 = ct * 256 + wc * 32 + 8 * fq;
    const u16* __restrict__ sg = kp->Ms + n * 1024;
    const float* __restrict__ mrd = (const float*)kp->Q;
    float* __restrict__ mwr = (float*)kp->Q;
    u16* __restrict__ hb = kp->Hb;
#pragma unroll
    for (int am = 0; am < 4; ++am) {
      const int ai = am >> 1, mb = (am & 1) * 2;
      u32x4 sv[2][2];
      pg8::f32x4 pa[2][2][2];
#pragma unroll
      for (int mm = 0; mm < 2; ++mm) {
        const size_t row = (size_t)(row0 + ai * 128 + (mb + mm) * 16);
#pragma unroll
        for (int bj = 0; bj < 2; ++bj) {
          sv[mm][bj] = *(const u32x4*)(sg + row * 3072 + col0 + bj * 128);
          if (n > 0) {
            pa[mm][bj][0] = *(const pg8::f32x4*)(mrd + row * D + col0 + bj * 128);
            pa[mm][bj][1] = *(const pg8::f32x4*)(mrd + row * D + col0 + bj * 128 + 4);
          }
        }
      }
#pragma unroll
      for (int mm = 0; mm < 2; ++mm) {
        const size_t row = (size_t)(row0 + ai * 128 + (mb + mm) * 16);
#pragma unroll
        for (int bj = 0; bj < 2; ++bj) {
          pg8::f32x4 v0 = acc[ai][bj][mb + mm][0], v1 = acc[ai][bj][mb + mm][1];
          v0[0] *= bflo(sv[mm][bj].x); v0[1] *= bfhi(sv[mm][bj].x); v0[2] *= bflo(sv[mm][bj].y); v0[3] *= bfhi(sv[mm][bj].y);
          v1[0] *= bflo(sv[mm][bj].z); v1[1] *= bfhi(sv[mm][bj].z); v1[2] *= bflo(sv[mm][bj].w); v1[3] *= bfhi(sv[mm][bj].w);
          if (n > 0) { v0 += pa[mm][bj][0]; v1 += pa[mm][bj][1]; }
          if (n < 2) {
            *(pg8::f32x4*)(mwr + row * D + col0 + bj * 128) = v0;
            *(pg8::f32x4*)(mwr + row * D + col0 + bj * 128 + 4) = v1;
          } else {
            u32x4 w; w.x = pack2(v0[0], v0[1]); w.y = pack2(v0[2], v0[3]); w.z = pack2(v1[0], v1[1]); w.w = pack2(v1[2], v1[3]);
            *(u32x4*)(hb + row * D + col0 + bj * 128) = w;
          }
        }
      }
    }
  }
};

DI void phase_merge(CParams& p, int chunk, int l, char* lds) {
  const int NB = p.NB, RL = NB * S;
  const bool last = (l == DEPTH - 1);
  pg8::Gemm g{p.Z, p.WbT + (size_t)l * 3 * D * D, RL, 3 * D, D, 3072};
  MergeOrder Mo; Mo.init(RL, (int)gridDim.x, (int)blockIdx.x);
  EpiMerge E{&p};
  pg8::gemm_phase<EpiMerge, MergeOrder, false>((PG8_LAS unsigned char*)lds, g, Mo, E, nullptr);
  if (!last) merge_tiles_ctx(p, l, lds);
}

struct EpiOut {
  static constexpr bool PERM = false, AFTER_DRAIN = false;
  CParams* kp; int chunk, l;
  __device__ __forceinline__ void operator()(const pg8::f32x4 (&acc)[2][2][4][2], const pg8::Unit& u, int wr, int wc, int fr, int fq) const {
    const int NB = kp->NB, RL = NB * S;
    const int gr0 = u.pm * 256;
    const float* src; float* dst; int mrow;
    if (gr0 < RL) {
      const int b = gr0 / S, t = gr0 % S, bg = chunk * NB + b;
      const size_t off = ((size_t)bg * S + t) * D;
      src = (l == 0 ? kp->x : kp->out) + off; dst = kp->out + off; mrow = bg;
    } else {
      const int rc = gr0 - RL, b = rc / L, t = rc % L, bg = chunk * NB + b;
      const size_t off = ((size_t)bg * L + t) * D;
      src = (l == 0 ? kp->ctx : kp->xc) + off; dst = kp->xc + off; mrow = 16;
    }
    const int col0 = u.pn * 256 + wc * 32 + 4 * fq;
    const float* gate = kp->modv + ((size_t)l * 17 + mrow) * 3072 + 2048 + col0;
    pg8::f32x4 gv[2][2];
#pragma unroll
    for (int bj = 0; bj < 2; ++bj)
#pragma unroll
      for (int n = 0; n < 2; ++n) gv[bj][n] = *(const pg8::f32x4*)(gate + bj * 128 + n * 16);
    const int row0 = wr * 64 + fr;
#pragma unroll
    for (int ai = 0; ai < 2; ++ai)
#pragma unroll
      for (int m = 0; m < 4; ++m) {
        const size_t ro = (size_t)(row0 + ai * 128 + m * 16) * D + col0;
        pg8::f32x4 xv[2][2];
#pragma unroll
        for (int bj = 0; bj < 2; ++bj)
#pragma unroll
          for (int n = 0; n < 2; ++n) xv[bj][n] = *(const pg8::f32x4*)(src + ro + bj * 128 + n * 16);
#pragma unroll
        for (int bj = 0; bj < 2; ++bj)
#pragma unroll
          for (int n = 0; n < 2; ++n) {
            pg8::f32x4 o = xv[bj][n] + gv[bj][n] * acc[ai][bj][m][n];
            *(pg8::f32x4*)(dst + ro + bj * 128 + n * 16) = o;
          }
      }
  }
};

DI void phase_outproj(CParams& p, int chunk, int l, char* lds) {
  const int NB = p.NB, RL = NB * S, R = NB * (S + L);
  const bool last = (l == DEPTH - 1);
  const int rows = last ? RL : R;
  pg8::Gemm g{p.Hb, p.WoT + (size_t)l * D * D, rows, D, D, D};
  pg8::StaticOrder So; So.init(rows, D, (int)gridDim.x, (int)blockIdx.x);
  EpiOut E{&p, chunk, l};
  pg8::gemm_phase<EpiOut, pg8::StaticOrder, false>((PG8_LAS unsigned char*)lds, g, So, E, nullptr);
}

DI void phase_final(CParams& p) {
  const int tid_ = otid();
  const int lane = tid_ & 63;
  const int wg = blockIdx.x * 8 + (tid_ >> 6), nw = gridDim.x * 8;
  for (int r = wg; r < NBATCH * S; r += nw) {
    float* src = p.out + (size_t)r * D;
    float4 v[4]; float ss = 0.f;
#pragma unroll
    for (int i = 0; i < 4; ++i) {
      v[i] = *(const float4*)(src + i * 256 + lane * 4);
      ss += v[i].x * v[i].x + v[i].y * v[i].y + v[i].z * v[i].z + v[i].w * v[i].w;
    }
#pragma unroll
    for (int o = 32; o >= 1; o >>= 1) ss += __shfl_xor(ss, o);
    float rstd = rsqrtf(ss * (1.f / D) + EPS);
#pragma unroll
    for (int i = 0; i < 4; ++i) {
      int cidx = i * 256 + lane * 4;
      float4 gg = *(const float4*)(p.final_g + cidx);
      float4 o;
      o.x = v[i].x * rstd * gg.x; o.y = v[i].y * rstd * gg.y; o.z = v[i].z * rstd * gg.z; o.w = v[i].w * rstd * gg.w;
      *(float4*)(src + cidx) = o;
    }
  }
}

#ifndef DUP_PHASE
#define DUP_PHASE 0
#endif
__global__ void __launch_bounds__(NTHR, 2) fwd_megakernel(Params p_unused) {
  CParams* kp = (CParams*)__builtin_amdgcn_kernarg_segment_ptr();
  cg::grid_group grid = cg::this_grid();
  __shared__ __attribute__((aligned(16))) char lds[LDS_BYTES];
  phase0(*opaque_kp(kp), lds);
  grid.sync();
  phase_mod(*opaque_kp(kp), lds);
  grid.sync();
  for (int chunk = 0; chunk < kp->nchunk; ++chunk) {
    for (int l = 0; l < DEPTH; ++l) {
      phase_prenorm(*opaque_kp(kp), chunk, l);
      grid.sync();
#if DUP_PHASE == 9
      grid.sync(); grid.sync(); grid.sync(); grid.sync(); grid.sync();
#endif
      phase_gemm_in(*opaque_kp(kp), chunk, l, lds);
      grid.sync();
#if DUP_PHASE == 3
      phase_gemm_in(*opaque_kp(kp), chunk, l, lds);
      grid.sync();
#endif
#if DUP_PHASE == 4
      phase_mixers(*opaque_kp(kp), chunk, l, lds, 1);
      grid.sync();
#endif
#if DUP_PHASE == 6
      phase_mixers(*opaque_kp(kp), chunk, l, lds, 2);
      grid.sync();
#endif
      phase_mixers(*opaque_kp(kp), chunk, l, lds);
      grid.sync();
      phase_merge(*opaque_kp(kp), chunk, l, lds);
      grid.sync();
#if DUP_PHASE == 5
      phase_merge(*opaque_kp(kp), chunk, l, lds);
      grid.sync();
#endif
      phase_outproj(*opaque_kp(kp), chunk, l, lds);
      grid.sync();
    }
  }
  phase_final(*opaque_kp(kp));
}

extern "C" void kernel_launch(void* const* d_in, const int* in_sizes, int n_in,
                              void* d_out, int out_size, void* d_ws, size_t ws_size,
                              hipStream_t stream) {
  static int grid_blocks = 0;
  if (!grid_blocks) {
    int dev = 0, cus = 0, per_cu = 0;
    (void)hipGetDevice(&dev);
    (void)hipDeviceGetAttribute(&cus, hipDeviceAttributeMultiprocessorCount, dev);
    (void)hipOccupancyMaxActiveBlocksPerMultiprocessor(&per_cu, fwd_megakernel, NTHR, 0);
    if (per_cu > 1) per_cu = 1;
    if (per_cu < 1) per_cu = 1;
    grid_blocks = cus * per_cu;
  }
  Params p{};
  const float* const* in = (const float* const*)d_in;
  p.x = in[0]; p.c = in[1]; p.ctx = in[2]; p.c_ctx = in[3]; p.norm_g = in[4]; p.w_mod = in[5]; p.b_mod = in[6];
  p.w_in = in[7]; p.conv_w = in[8]; p.conv_b = in[9]; p.lru_wa = in[10]; p.lru_ba = in[11]; p.lru_wx = in[12];
  p.lru_bx = in[13]; p.lru_lambda = in[14]; p.attn_sink = in[15]; p.q_norm_g = in[16]; p.k_norm_g = in[17];
  p.w_branch = in[18]; p.w_out = in[19]; p.final_g = in[20];
  p.out = (float*)d_out;
  char* ws = (char*)d_ws;
  size_t off = 0;
  auto take = [&](size_t bytes) { char* r = ws + off; off += (bytes + 255) & ~(size_t)255; return r; };
  p.ctr = (int*)take(256);
  p.modv = (float*)take((size_t)DEPTH * 17 * 3072 * 4);
  p.sc = (float*)take((size_t)17 * D * 4);
  p.rope = (float*)take(4096 * 4);
  p.xc = (float*)take((size_t)NBATCH * L * D * 4);
  p.WinT = (u16*)take((size_t)DEPTH * INW * D * 2);
  p.WbT = (u16*)take((size_t)DEPTH * 3 * D * D * 2);
  p.WoT = (u16*)take((size_t)DEPTH * D * D * 2);
  const size_t fixed = off;
  int NB = 8;
  while (NB > 1) {
    size_t R = (size_t)NB * (S + L);
    size_t need = fixed + R * (size_t)(1024 + 1024 + 3072 + 2048 + 512 + 512 + 3072) * 2 + 8 * 256;
    if (need <= ws_size) break;
    NB >>= 1;
  }
  p.NB = NB; p.nchunk = NBATCH / NB;
  const size_t R = (size_t)NB * (S + L);
  p.Hb = (u16*)take(R * 1024 * 2);
  p.U = (u16*)take(R * 1024 * 2);
  p.Z = (u16*)take(R * 3072 * 2);
  p.Q = (u16*)take(R * 2048 * 2);
  p.Kb = (u16*)take(R * 512 * 2);
  p.VtL = (u16*)take((size_t)NB * 4 * 128 * S * 2);
  p.VtC = (u16*)take((size_t)NB * 4 * 128 * L * 2);
  p.Ms = (u16*)take(R * 3072 * 2);
  void* args[] = {&p};
  hipError_t e = hipLaunchCooperativeKernel((void*)fwd_megakernel, dim3(grid_blocks), dim3(NTHR), args, 0, stream);
  if (e != hipSuccess) fprintf(stderr, "cooperative launch failed: %s (grid %d)\n", hipGetErrorString(e), grid_blocks);
}
```

```cpp
#include <hip/hip_runtime.h>
#include <hip/hip_cooperative_groups.h>
#include <cstdio>
#include <cstdint>
namespace cg = cooperative_groups;

typedef unsigned short u16;
typedef __attribute__((ext_vector_type(8))) short bf16x8;
typedef __attribute__((ext_vector_type(4))) short s16x4;
typedef __attribute__((ext_vector_type(16))) float f32x16;
typedef __bf16 bf16x2_t __attribute__((ext_vector_type(2)));
typedef float float2_t __attribute__((ext_vector_type(2)));
typedef __attribute__((ext_vector_type(4))) unsigned u32x4;
typedef __attribute__((ext_vector_type(2))) unsigned u32x2;

#define DI __device__ __forceinline__
#define MFMA32(a, b, c) __builtin_amdgcn_mfma_f32_32x32x16_bf16((a), (b), (c), 0, 0, 0)

constexpr int D = 1024, NBATCH = 16, S = 4096, L = 256, DEPTH = 4, INW = 10240;
constexpr int LDS_BYTES = 147456;
constexpr int NTHR = 512;
constexpr float EPS = 1e-6f;
constexpr float QSCALE = 0.08838834764831845f * 1.4426950408889634f;
constexpr float LOG2E = 1.4426950408889634f;

struct Params {
  const float *x, *c, *ctx, *c_ctx, *norm_g, *w_mod, *b_mod, *w_in, *conv_w, *conv_b, *lru_wa, *lru_ba, *lru_wx, *lru_bx,
      *lru_lambda, *attn_sink, *q_norm_g, *k_norm_g, *w_branch, *w_out, *final_g;
  float* out;
  u16 *WinT, *WbT, *WoT;
  u16 *Hb, *U, *Z, *Q, *Kb, *VtL, *VtC, *Ms;
  float *modv, *sc, *rope, *xc;
  int* ctr;
  int NB;
  int nchunk;
};

typedef const __attribute__((address_space(4))) Params CParams;
DI CParams* opaque_kp(CParams* q) { asm volatile("" : "+s"(q)); return q; }

DI unsigned pack2(float a, float b) {
  float2_t f = {a, b};
  bf16x2_t v = __builtin_convertvector(f, bf16x2_t);
  return __builtin_bit_cast(unsigned, v);
}
DI float bf2f(u16 v) { return __uint_as_float(((unsigned)v) << 16); }
DI float bflo(unsigned v) { return __uint_as_float(v << 16); }
DI float bfhi(unsigned v) { return __uint_as_float(v & 0xffff0000u); }
DI float sigmoidf_(float x) { return __builtin_amdgcn_rcpf(1.f + __expf(-x)); }
DI float siluf_(float x) { return x * __builtin_amdgcn_rcpf(1.f + __expf(-x)); }
DI int otid() { int t = threadIdx.x; asm volatile("" : "+v"(t)); return t; }
DI int crow(int i, int hh) { return (i & 3) + 8 * (i >> 2) + 4 * hh; }

DI void phase0(CParams& p, char* lds) {
  const int tid = otid();
  float* tile = (float*)lds;
  const int n_in = DEPTH * 16 * 160, n_b = DEPTH * 3 * 256, n_o = DEPTH * 256;
  for (int it = blockIdx.x; it < n_in + n_b + n_o; it += gridDim.x) {
    const float* src; u16* dst; int ldsrc; int dstride = 64;
    if (it < n_in) {
      int l = it / 2560, rem = it % 2560, kt = rem / 160, nt = rem % 160;
      src = p.w_in + (size_t)l * D * INW + (size_t)(kt * 64) * INW + nt * 64; ldsrc = INW;
      const int o = nt >> 2;
      const int n256 = (o < 8) ? o : (o >= 28) ? 16 + (o - 28) : (o >= 24) ? 12 + (o - 24) : (o == 23) ? 39 : (o == 22) ? 38
                     : (o >= 18) ? 34 + (o - 18) : (o >= 14) ? 8 + (o - 14) : (o == 13) ? 33 : (o == 12) ? 32 : 28 + (o - 8);
      dst = p.WinT + (size_t)l * INW * D + ((size_t)n256 * 256 + (nt & 3) * 64) * D + kt * 64; dstride = D;
    } else if (it < n_in + n_b) {
      int i2 = it - n_in; int mat = i2 / 256, rem = i2 % 256, kt = rem / 16, nt = rem % 16;
      src = p.w_branch + (size_t)mat * D * D + (size_t)(kt * 64) * D + nt * 64; ldsrc = D;
      dst = p.WbT + (size_t)mat * D * D + (size_t)(nt * 64) * D + kt * 64; dstride = D;
    } else {
      int i2 = it - n_in - n_b; int mat = i2 / 256, rem = i2 % 256, kt = rem / 16, nt = rem % 16;
      src = p.w_out + (size_t)mat * D * D + (size_t)(kt * 64) * D + nt * 64; ldsrc = D;
      dst = p.WoT + (size_t)mat * D * D + (size_t)(nt * 64) * D + kt * 64; dstride = D;
    }
    __syncthreads();
#pragma unroll
    for (int i = 0; i < 2; ++i) {
      int c = tid + NTHR * i; int row = c >> 4, c4 = c & 15;
      float4 v = *(const float4*)(src + (size_t)row * ldsrc + c4 * 4);
      float* t = tile + row * 65 + c4 * 4;
      t[0] = v.x; t[1] = v.y; t[2] = v.z; t[3] = v.w;
    }
    __syncthreads();
    {
      int c = tid; int nrow = c >> 3, k8 = c & 7;
      float v[8];
#pragma unroll
      for (int j = 0; j < 8; ++j) v[j] = tile[(k8 * 8 + j) * 65 + nrow];
      uint4 o; o.x = pack2(v[0], v[1]); o.y = pack2(v[2], v[3]); o.z = pack2(v[4], v[5]); o.w = pack2(v[6], v[7]);
      *(uint4*)(dst + (size_t)nrow * dstride + k8 * 8) = o;
    }
  }
  const int gt = blockIdx.x * NTHR + tid, gn = gridDim.x * NTHR;
  for (int i = gt; i < 17 * D; i += gn) {
    int r = i / D, k = i % D;
    float v = (r < 16) ? p.c[r * D + k] : p.c_ctx[k];
    p.sc[i] = siluf_(v);
  }
  for (int i = gt; i < 64 * 32; i += gn) {
    int pos = i >> 5, pp = i & 31;
    float inv = powf(10000.f, -(float)pp / 32.f);
    float ang = (float)pos * inv;
    p.rope[i] = cosf(ang);
    p.rope[2048 + i] = sinf(ang);
  }
  if (blockIdx.x == 0 && tid < 64) p.ctr[tid] = 0;
}

DI void phase_mod(CParams& p, char* lds) {
  const int tid = otid();
  float* red = (float*)lds;
  const int col = tid & 63, kg = tid >> 6;
  for (int it = blockIdx.x; it < DEPTH * 48; it += gridDim.x) {
    int l = it / 48, cb = it % 48;
    float acc[17];
#pragma unroll
    for (int r = 0; r < 17; ++r) acc[r] = 0.f;
    const float* w = p.w_mod + (size_t)l * D * 3072 + cb * 64 + col;
    for (int k = kg * 128; k < kg * 128 + 128; ++k) {
      float wv = w[(size_t)k * 3072];
#pragma unroll
      for (int r = 0; r < 17; ++r) acc[r] += p.sc[r * D + k] * wv;
    }
    __syncthreads();
#pragma unroll
    for (int r = 0; r < 17; ++r) red[(kg * 17 + r) * 64 + col] = acc[r];
    __syncthreads();
    for (int i = tid; i < 17 * 64; i += NTHR) {
      int r = i >> 6, cc = i & 63;
      float s = 0.f;
#pragma unroll
      for (int g = 0; g < 8; ++g) s += red[(g * 17 + r) * 64 + cc];
      p.modv[((size_t)l * 17 + r) * 3072 + cb * 64 + cc] = s + p.b_mod[l * 3072 + cb * 64 + cc];
    }
  }
}

DI void phase_prenorm(CParams& p, int chunk, int l) {
  const int NB = p.NB, RL = NB * S, R = NB * (S + L);
  const int tid_ = otid();
  const int lane = tid_ & 63;
  const int wg = blockIdx.x * 8 + (tid_ >> 6), nw = gridDim.x * 8;
  const float* g = p.norm_g + l * D;
  for (int r = wg; r < R; r += nw) {
    const float* src; int mrow;
    if (r < RL) {
      int b = r / S, t = r % S; int bg = chunk * NB + b;
      src = (l == 0 ? p.x : p.out) + ((size_t)bg * S + t) * D; mrow = bg;
    } else {
      int rc = r - RL; int b = rc / L, t = rc % L; int bg = chunk * NB + b;
      src = (l == 0 ? p.ctx : p.xc) + ((size_t)bg * L + t) * D; mrow = 16;
    }
    const float* mv = p.modv + ((size_t)l * 17 + mrow) * 3072;
    float4 v[4]; float ss = 0.f;
#pragma unroll
    for (int i = 0; i < 4; ++i) {
      v[i] = *(const float4*)(src + i * 256 + lane * 4);
      ss += v[i].x * v[i].x + v[i].y * v[i].y + v[i].z * v[i].z + v[i].w * v[i].w;
    }
#pragma unroll
    for (int o = 32; o >= 1; o >>= 1) ss += __shfl_xor(ss, o);
    float rstd = rsqrtf(ss * (1.f / D) + EPS);
#pragma unroll
    for (int i = 0; i < 4; ++i) {
      int cidx = i * 256 + lane * 4;
      float4 gg = *(const float4*)(g + cidx);
      float4 sh = *(const float4*)(mv + cidx);
      float4 scl = *(const float4*)(mv + 1024 + cidx);
      float h0 = v[i].x * rstd * gg.x * (1.f + scl.x) + sh.x;
      float h1 = v[i].y * rstd * gg.y * (1.f + scl.y) + sh.y;
      float h2 = v[i].z * rstd * gg.z * (1.f + scl.z) + sh.z;
      float h3 = v[i].w * rstd * gg.w * (1.f + scl.w) + sh.w;
      uint2 o; o.x = pack2(h0, h1); o.y = pack2(h2, h3);
      *(uint2*)(p.Hb + (size_t)r * D + cidx) = o;
    }
  }
}

template <int BN, bool PIPE>
DI void gemm_core(const u16* A, int lda, int ksa, size_t a_blk, const u16* Bt, int ldb, int ksb, size_t b_blk, int K, char* ldsc,
                  f32x16 (&acc)[BN / 64][2]) {
  constexpr int MI = BN / 64;
  constexpr int SS = 32768 + BN * 128;
  const int tid = otid(), lane = tid & 63, w = tid >> 6;
  const int wm = (BN == 256) ? (w >> 2) : (w >> 1), wn = (BN == 256) ? (w & 3) : (w & 1);
  const int r = lane & 31, hh = lane >> 5;
  const int drow = lane >> 3, dcp = lane & 7;
  const int chunk0 = dcp ^ (drow >> 1);
  const u16* gAe = A + (size_t)(w >> 2) * a_blk + (size_t)((w & 3) * 32 + drow) * lda + chunk0 * 8;
  const u16* gAo = gAe + (size_t)8 * lda + ((chunk0 ^ 4) - chunk0) * 8;
  const size_t a16 = (size_t)16 * lda;
  const int brow0 = (BN == 256) ? (w & 3) * 32 : w * 16;
  const u16* gBe = Bt + ((BN == 256) ? (size_t)(w >> 2) * b_blk : (size_t)0) + (size_t)(brow0 + drow) * ldb + chunk0 * 8;
  const u16* gBo = gBe + (size_t)8 * ldb + ((chunk0 ^ 4) - chunk0) * 8;
  const size_t b16 = (size_t)16 * ldb;
#pragma unroll
  for (int i = 0; i < MI; ++i)
#pragma unroll
    for (int j = 0; j < 2; ++j)
#pragma unroll
      for (int x = 0; x < 16; ++x) acc[i][j][x] = 0.f;
  auto DMA = [&](int kt, int stage) {
    char* sa = ldsc + stage * SS + (w * 4) * 1024;
    char* sb = ldsc + stage * SS + 32768 + ((BN == 256) ? (w * 4) : (w * 2)) * 1024;
    const size_t ka = (size_t)kt * ksa, kb = (size_t)kt * ksb;
    __builtin_amdgcn_global_load_lds((const unsigned*)(gAe + ka), (unsigned*)(sa), 16, 0, 0);
    __builtin_amdgcn_global_load_lds((const unsigned*)(gBe + kb), (unsigned*)(sb), 16, 0, 0);
    __builtin_amdgcn_global_load_lds((const unsigned*)(gAo + ka), (unsigned*)(sa + 1024), 16, 0, 0);
    __builtin_amdgcn_global_load_lds((const unsigned*)(gBo + kb), (unsigned*)(sb + 1024), 16, 0, 0);
    __builtin_amdgcn_global_load_lds((const unsigned*)(gAe + a16 + ka), (unsigned*)(sa + 2048), 16, 0, 0);
    __builtin_amdgcn_global_load_lds((const unsigned*)(gAo + a16 + ka), (unsigned*)(sa + 3072), 16, 0, 0);
    if (BN == 256) {
      __builtin_amdgcn_global_load_lds((const unsigned*)(gBe + b16 + kb), (unsigned*)(sb + 2048), 16, 0, 0);
      __builtin_amdgcn_global_load_lds((const unsigned*)(gBo + b16 + kb), (unsigned*)(sb + 3072), 16, 0, 0);
    }
  };
  const int sw = (r >> 1) & 7;
  int koff[4];
#pragma unroll
  for (int ks = 0; ks < 4; ++ks) koff[ks] = ((2 * ks + hh) ^ sw) << 4;
  auto COMPUTE = [&](int stage) {
    const char* ab = ldsc + stage * SS + (wm * (MI * 32) + r) * 128;
    const char* bb = ldsc + stage * SS + 32768 + (wn * 64 + r) * 128;
    bf16x8 fa[2][MI], fb[2][2];
    auto LDF = [&](int ks, int slot) {
#pragma unroll
      for (int i = 0; i < MI; ++i) fa[slot][i] = *(const bf16x8*)(ab + i * 32 * 128 + koff[ks]);
#pragma unroll
      for (int j = 0; j < 2; ++j) fb[slot][j] = *(const bf16x8*)(bb + j * 32 * 128 + koff[ks]);
    };
    auto MM = [&](int slot) {
#pragma unroll
      for (int i = 0; i < MI; ++i)
#pragma unroll
        for (int j = 0; j < 2; ++j) acc[i][j] = MFMA32(fb[slot][j], fa[slot][i], acc[i][j]);
    };
    if (!PIPE) {
#pragma unroll
      for (int ks = 0; ks < 4; ++ks) { LDF(ks, 0); MM(0); }
      return;
    }
    LDF(0, 0); LDF(1, 1);
    __builtin_amdgcn_sched_barrier(0);
    MM(0); LDF(2, 0);
    __builtin_amdgcn_sched_barrier(0);
    MM(1); LDF(3, 1);
    __builtin_amdgcn_sched_barrier(0);
    MM(0); MM(1);
  };
  const int KT = K >> 6;
  __syncthreads();
  DMA(0, 0);
  __syncthreads();
  for (int kt = 0; kt < KT; kt += 2) {
    DMA(kt + 1, 1);
    COMPUTE(0);
    __syncthreads();
    if (kt + 2 < KT) DMA(kt + 2, 0);
    COMPUTE(1);
    __syncthreads();
  }
}

template <int MI>
DI void stage_acc(char* ldsc, f32x16 (&acc)[MI][2], int wm, int ncol0, bool active) {
  const int tid = otid(), lane = tid & 63;
  const int r = lane & 31, hh = lane >> 5;
  float* Cs = (float*)ldsc;
  if (active) {
#pragma unroll
    for (int i = 0; i < MI; ++i)
#pragma unroll
      for (int j = 0; j < 2; ++j)
#pragma unroll
        for (int g = 0; g < 4; ++g) {
          int m = wm * (MI * 32) + i * 32 + r;
          int n = ncol0 + j * 32 + 8 * g + 4 * hh;
          float4 v; v.x = acc[i][j][4 * g]; v.y = acc[i][j][4 * g + 1]; v.z = acc[i][j][4 * g + 2]; v.w = acc[i][j][4 * g + 3];
          *(float4*)(Cs + m * 132 + n) = v;
        }
  }
  __syncthreads();
}

DI void read_row64(const char* ldsc, int row, int half, float (&v)[64]) {
  const float* Cs = (const float*)ldsc + row * 132 + half * 64;
#pragma unroll
  for (int j = 0; j < 16; ++j) {
    float4 t = *(const float4*)(Cs + j * 4);
    v[j * 4] = t.x; v[j * 4 + 1] = t.y; v[j * 4 + 2] = t.z; v[j * 4 + 3] = t.w;
  }
}

DI void store_row64_bf16(u16* dst, const float (&v)[64]) {
#pragma unroll
  for (int j = 0; j < 8; ++j) {
    uint4 o;
    o.x = pack2(v[j * 8], v[j * 8 + 1]); o.y = pack2(v[j * 8 + 2], v[j * 8 + 3]);
    o.z = pack2(v[j * 8 + 4], v[j * 8 + 5]); o.w = pack2(v[j * 8 + 6], v[j * 8 + 7]);
    *(uint4*)(dst + j * 8) = o;
  }
}

namespace pg8 {
#define PG8_LAS __attribute__((address_space(3)))
typedef unsigned short bf16_t;
typedef short bf16x8 __attribute__((ext_vector_type(8)));
typedef float f32x4 __attribute__((ext_vector_type(4)));
typedef unsigned u32x4 __attribute__((ext_vector_type(4)));
constexpr int BM = 256, BK = 64, HALF = 128, HTB = HALF * BK * 2  , STAGE_BYTES = 8 * HTB, NXCD = 8, WGM = 8;

__host__ __device__ __forceinline__ int lds_byte(int r, int c) { const int st = (r >> 4) * 2 + (c >> 5), rr = r & 15, cc = c & 31, ob = rr * 64 + cc * 2; return st * 1024 + (ob ^ (((ob >> 9) & 1) << 5)); }
__host__ __device__ __forceinline__ void stage_rc(int b, int& R, int& C) { const int st = b / 1024, sb = b % 1024, swz = sb ^ (((sb >> 9) & 1) << 5); R = (st >> 1) * 16 + swz / 64; C = (st & 1) * 32 + (swz % 64) / 2; }
__host__ __device__ __forceinline__ int perm32(int rho) { const int n = rho >> 4, i = rho & 15; return 8 * (i >> 2) + 4 * n + (i & 3); }
struct Unit { int pm, pn; };
struct Gemm { const bf16_t* A; const bf16_t* Bt; int M, N, K; int lda; };
struct StaticOrder {
    int nM, nN, nwg, G, c;
    __host__ __device__ void init(int M, int N, int G_, int c_) { nM = M / BM; nN = N / BM; nwg = nM * nN; G = G_; c = c_; }
    __host__ __device__ bool next(int i, Unit& u) const {
        const long L = (long)i * G + c; if (L >= nwg) return false;
        int wgid = (int)L; { const int q = nwg / NXCD, r = nwg % NXCD, xcd = wgid % NXCD, off = wgid / NXCD; wgid = (xcd < r ? xcd * (q + 1) : r * (q + 1) + (xcd - r) * q) + off; }
        const int nig = WGM * nN, gid = wgid / nig, fm = gid * WGM, gsz = (nM - fm) < WGM ? (nM - fm) : WGM;
        u.pm = fm + ((wgid % nig) % gsz); u.pn = (wgid % nig) / gsz; return true;
    }
    __device__ __forceinline__ void a_ready(const Unit&) const {}
    __device__ __forceinline__ void done(const Unit&) const {}
    __device__ __forceinline__ size_t a_off(const Unit&) const { return 0; }
};
template <class Epi, class Sched, bool STAMP = false>
__device__ __forceinline__ void gemm_phase(PG8_LAS unsigned char* lds, const Gemm g, const Sched& S, const Epi& E, unsigned long long* stamps) {
    int tid_raw = threadIdx.x; asm volatile("" : "+v"(tid_raw));
    const int tid = tid_raw, wid = __builtin_amdgcn_readfirstlane(tid >> 6), lane = tid & 63, wr = wid >> 2, wc = wid & 3, fr = lane & 15, fq = lane >> 4;
    const int K = g.K, nt = K / BK;
    int ts_lo = 0, ts_hi = 0, nts = 0; const unsigned long long rt_entry = STAMP ? (unsigned long long)wall_clock64() : 0ull;
#define PG8_STAMP() do { if (STAMP && wid == 0 && nts < 64) { const unsigned long long _c = (unsigned long long)clock64(); \
        ts_lo = (lane == nts) ? (int)(unsigned)_c : ts_lo; ts_hi = (lane == nts) ? (int)(unsigned)(_c >> 32) : ts_hi; ++nts; } } while (0)
    PG8_STAMP();
    unsigned voffA[2], voffB[2];
#pragma unroll
    for (int i = 0; i < 2; ++i) { int R, C; stage_rc(tid * 16 + i * 8192, R, C); const int Rb = Epi::PERM ? ((R & ~31) + perm32(R & 31)) : R;
        voffA[i] = (unsigned)(R * g.lda + C) * 2u; voffB[i] = (unsigned)(Rb * K + C) * 2u; }
    const size_t kstep = (size_t)(BK * 2);
    const size_t hstep = (size_t)HALF * K * 2;
    const size_t tstep = 2 * hstep;
    const size_t hstepA = (size_t)HALF * g.lda * 2, tstepA = 2 * hstepA;
    const unsigned ldsw = (unsigned)wid * 1024u;
    const int aoff = lds_byte(wr * 64 + fr, fq * 8), boff = lds_byte(wc * 32 + fr, fq * 8);
#define PG8_SA(b, h) (((b) * 2 + (h)) * HTB)
#define PG8_SB(b, h) ((4 + (b) * 2 + (h)) * HTB)
#define PG8_STAGE(bufoff, gbase, voff) do { _Pragma("unroll") for (int _i = 0; _i < 2; ++_i) \
        __builtin_amdgcn_global_load_lds((const unsigned*)((const char*)(gbase) + (voff)[_i]), (PG8_LAS unsigned*)(lds + (bufoff) + ldsw + _i * 8192), 16, 0, 0); } while (0)
#define PG8_LDA(dst, b, h) do { _Pragma("unroll") for (int m = 0; m < 4; ++m) _Pragma("unroll") for (int k = 0; k < 2; ++k) dst[m][k] = *(const PG8_LAS bf16x8*)(lds + PG8_SA(b, h) + aoff + m * 2048 + k * 1024); } while (0)
#define PG8_LDB(dst, b, h) do { _Pragma("unroll") for (int n = 0; n < 2; ++n) _Pragma("unroll") for (int k = 0; k < 2; ++k) dst[n][k] = *(const PG8_LAS bf16x8*)(lds + PG8_SB(b, h) + boff + n * 2048 + k * 1024); } while (0)
#define PG8_MMA(ai, bj, At, Bt) do { __builtin_amdgcn_s_setprio(1); _Pragma("unroll") for (int m = 0; m < 4; ++m) _Pragma("unroll") for (int n = 0; n < 2; ++n) _Pragma("unroll") for (int k = 0; k < 2; ++k) \
        acc[ai][bj][m][n] = __builtin_amdgcn_mfma_f32_16x16x32_bf16(Bt[n][k], At[m][k], acc[ai][bj][m][n], 0, 0, 0); __builtin_amdgcn_s_setprio(0); } while (0)
#define PG8_WAIT_V(n) asm volatile("s_waitcnt vmcnt(" #n ")" ::: "memory")
#define PG8_WAIT_L(n) asm volatile("s_waitcnt lgkmcnt(" #n ")" ::: "memory")
#define PG8_BAR __builtin_amdgcn_s_barrier()
#define PG8_SCHED __builtin_amdgcn_sched_barrier(0)
    Unit cur, nxt; int ui = 0;
    if (!S.next(0, cur)) return;
    f32x4 acc[2][2][4][2];
#pragma unroll
    for (int a = 0; a < 2; ++a)
#pragma unroll
        for (int b = 0; b < 2; ++b)
#pragma unroll
            for (int m = 0; m < 4; ++m)
#pragma unroll
                for (int n = 0; n < 2; ++n) acc[a][b][m][n] = (f32x4){0.f, 0.f, 0.f, 0.f};
    bf16x8 At[4][2], B0[2][2], B1[2][2];
    const char* cA = (const char*)g.A + (size_t)cur.pm * tstepA + S.a_off(cur); const char* cB = (const char*)g.Bt + (size_t)cur.pn * tstep;
    S.a_ready(cur);
    PG8_STAGE(PG8_SB(0, 0), cB, voffB); PG8_STAGE(PG8_SA(0, 0), cA, voffA); PG8_STAGE(PG8_SB(0, 1), cB + hstep, voffB); PG8_STAGE(PG8_SA(0, 1), cA + hstepA, voffA);
    if (wr == 1) PG8_BAR;
    PG8_WAIT_V(4); PG8_BAR;
    PG8_STAGE(PG8_SB(1, 0), cB + kstep, voffB); PG8_STAGE(PG8_SA(1, 0), cA + kstep, voffA); PG8_STAGE(PG8_SB(1, 1), cB + hstep + kstep, voffB);
    PG8_WAIT_V(6); PG8_BAR;
    PG8_STAMP();
    for (;;) {
        const bool has_next = S.next(ui + 1, nxt);
        const char* nA = has_next ? (const char*)g.A + (size_t)nxt.pm * tstepA + S.a_off(nxt) : cA; const char* nB = has_next ? (const char*)g.Bt + (size_t)nxt.pn * tstep : cB;
        for (int t = 0; t < nt; t += 2) {
            const bool last = (t == nt - 2);
            const char* a1 = cA + (size_t)(t + 1) * kstep;
            const char* a2 = last ? nA : cA + (size_t)(t + 2) * kstep; const char* b2 = last ? nB : cB + (size_t)(t + 2) * kstep;
            const char* a3 = a2 + kstep; const char* b3 = b2 + kstep;
            if (last && has_next) S.a_ready(nxt);
            PG8_LDB(B0, 0, 0); PG8_SCHED; PG8_LDA(At, 0, 0); PG8_STAGE(PG8_SA(1, 1), a1 + hstepA, voffA);
            PG8_WAIT_L(8); PG8_BAR; PG8_WAIT_L(0); PG8_MMA(0, 0, At, B0); PG8_BAR; PG8_SCHED;
            PG8_LDB(B1, 0, 1); PG8_STAGE(PG8_SB(0, 0), b2, voffB);
            PG8_BAR; PG8_WAIT_L(0); PG8_MMA(0, 1, At, B1); PG8_BAR;
            PG8_LDA(At, 0, 1); PG8_STAGE(PG8_SA(0, 0), a2, voffA);
            PG8_BAR; PG8_WAIT_L(0); PG8_MMA(1, 0, At, B0); PG8_BAR; PG8_SCHED;
            PG8_STAGE(PG8_SB(0, 1), b2 + hstep, voffB);
            PG8_WAIT_V(6); PG8_BAR; PG8_MMA(1, 1, At, B1); PG8_BAR;
            PG8_LDB(B0, 1, 0); PG8_SCHED; PG8_LDA(At, 1, 0); PG8_STAGE(PG8_SA(0, 1), a2 + hstepA, voffA);
            PG8_WAIT_L(8); PG8_BAR; PG8_WAIT_L(0); PG8_MMA(0, 0, At, B0); PG8_BAR; PG8_SCHED;
            PG8_LDB(B1, 1, 1); PG8_STAGE(PG8_SB(1, 0), b3, voffB);
            PG8_BAR; PG8_WAIT_L(0); PG8_MMA(0, 1, At, B1); PG8_BAR;
            PG8_LDA(At, 1, 1); PG8_STAGE(PG8_SA(1, 0), a3, voffA);
            PG8_BAR; PG8_WAIT_L(0); PG8_MMA(1, 0, At, B0); PG8_BAR; PG8_SCHED;
            PG8_STAGE(PG8_SB(1, 1), b3 + hstep, voffB);
            PG8_WAIT_V(6); PG8_BAR; PG8_MMA(1, 1, At, B1); PG8_BAR;
        }
        PG8_STAMP();
        if constexpr (!Epi::AFTER_DRAIN) { E(acc, cur, wr, wc, fr, fq); S.done(cur); }
        PG8_STAMP();
        if (!has_next) break;
#pragma unroll
        for (int a = 0; a < 2; ++a)
#pragma unroll
            for (int b = 0; b < 2; ++b)
#pragma unroll
                for (int m = 0; m < 4; ++m)
#pragma unroll
                    for (int n = 0; n < 2; ++n) acc[a][b][m][n] = (f32x4){0.f, 0.f, 0.f, 0.f};
        cur = nxt; cA = nA; cB = nB; ++ui;
    }
    PG8_WAIT_V(0);
    if (wr == 0) PG8_BAR;
    PG8_BAR;
    if constexpr (Epi::AFTER_DRAIN) { E.fused(acc, cur, wr, wc, fr, fq, lds, wid, lane); S.done(cur); }
    PG8_STAMP();
    if (STAMP && wid == 0) { stamps[lane] = lane < nts ? (((unsigned long long)(unsigned)ts_hi << 32) | (unsigned)ts_lo) : 0ull;
        if (lane == 62) stamps[62] = rt_entry; if (lane == 63) stamps[63] = (unsigned long long)wall_clock64(); }
#undef PG8_STAMP
#undef PG8_SA
#undef PG8_SB
#undef PG8_STAGE
#undef PG8_LDA
#undef PG8_LDB
#undef PG8_MMA
#undef PG8_WAIT_V
#undef PG8_WAIT_L
#undef PG8_BAR
#undef PG8_SCHED
}
}

struct EpiIn {
  static constexpr bool PERM = true, AFTER_DRAIN = false;
  CParams* kp;
  __device__ __forceinline__ void operator()(const pg8::f32x4 (&acc)[2][2][4][2], const pg8::Unit& u, int wr, int wc, int fr, int fq) const {
    const int pn = u.pn;
    u16* base; int ld, mode;
    if (pn < 4) { base = kp->U + pn * 256; ld = D; mode = 0; }
    else if (pn < 16) { base = kp->Z + (pn - 4) * 256; ld = 3072; mode = 1; }
    else { base = kp->Ms + (pn - 16) * 256; ld = 3072; mode = 2; }
    const int row0 = u.pm * 256 + wr * 64 + fr;
    const int col0 = wc * 32 + 8 * fq;
    u16* rowp0 = base + (size_t)row0 * ld + col0;
#pragma unroll
    for (int ai = 0; ai < 2; ++ai)
#pragma unroll
      for (int m = 0; m < 4; ++m)
#pragma unroll
        for (int bj = 0; bj < 2; ++bj) {
          pg8::f32x4 v0 = acc[ai][bj][m][0], v1 = acc[ai][bj][m][1];
          if (mode == 1) {
#pragma unroll
            for (int j = 0; j < 4; ++j) { v0[j] = siluf_(v0[j]); v1[j] = siluf_(v1[j]); }
          } else if (mode == 2) {
#pragma unroll
            for (int j = 0; j < 4; ++j) { v0[j] = sigmoidf_(v0[j]); v1[j] = sigmoidf_(v1[j]); }
          }
          u32x4 w; w.x = pack2(v0[0], v0[1]); w.y = pack2(v0[2], v0[3]); w.z = pack2(v1[0], v1[1]); w.w = pack2(v1[2], v1[3]);
          *(u32x4*)(rowp0 + (size_t)(ai * 128 + m * 16) * ld + bj * 128) = w;
        }
  }
};


DI bool tile_map(int i, int MT, int NT, int& mt, int& nt) {
  const int G = gridDim.x, bid = blockIdx.x;
  if ((G & 63) == 0 && (MT & 7) == 0 && (NT % (G >> 6)) == 0) {
    const int SH = G >> 6;
    const int xcd = bid & 7, slot = bid >> 3;
    const int sx = slot & 7, sy = slot >> 3;
    const int nsn = NT / SH, nsm = MT >> 3;
    const int st = i * 8 + xcd;
    if (st >= nsm * nsn) return false;
    mt = (st / nsn) * 8 + sx;
    nt = (st % nsn) * SH + sy;
    return true;
  }
  const int it = bid + i * G;
  if (it >= MT * NT) return false;
  mt = it / NT; nt = it % NT;
  return true;
}


struct OneUnit {
  int pm, pn;
  __device__ bool next(int i, pg8::Unit& u) const { if (i) return false; u.pm = pm; u.pn = pn; return true; }
  __device__ __forceinline__ void a_ready(const pg8::Unit&) const {}
  __device__ __forceinline__ void done(const pg8::Unit&) const {}
  __device__ __forceinline__ size_t a_off(const pg8::Unit&) const { return 0; }
};
struct EpiQKV {
  static constexpr bool PERM = false, AFTER_DRAIN = true;
  CParams* kp; char* lds; int l, nt, m0;
  __device__ __forceinline__ void fused(const pg8::f32x4 (&acc)[2][2][4][2], const pg8::Unit&, int wr, int wc, int fr, int fq,
                                        PG8_LAS unsigned char*, int, int) const {
    CParams& p = *kp;
    const int NB = p.NB, RL = NB * S;
    const int tid = otid();
    const bool lat = m0 < RL;
    int b, t0;
    if (lat) { b = m0 / S; t0 = m0 % S; } else { int rc = m0 - RL; b = rc / L; t0 = rc % L; }
    const bool isV = (nt == 13 || nt == 23);
    const bool isC = nt >= 18;
    const bool isQ = (nt >= 8 && nt < 12) || (nt >= 18 && nt < 22);
    auto process_unit = [&](int hsel, int u) {
      if (isV) {
        const int slot = (isC ? 2 : 0) + hsel;
        const int d = u >> 2, tq = u & 3;
        const float* Cs = (const float*)lds;
        u16* dst = lat ? p.VtL + ((size_t)(b * 4 + slot) * 128 + d) * S + t0 + tq * 64
                       : p.VtC + ((size_t)(b * 4 + slot) * 128 + d) * L + t0 + tq * 64;
#pragma unroll 1
        for (int c = 0; c < 4; ++c) {
          float v[16];
#pragma unroll
          for (int j = 0; j < 16; ++j) v[j] = Cs[(tq * 64 + c * 16 + j) * 132 + d];
          uint4 o0, o1;
          o0.x = pack2(v[0], v[1]); o0.y = pack2(v[2], v[3]); o0.z = pack2(v[4], v[5]); o0.w = pack2(v[6], v[7]);
          o1.x = pack2(v[8], v[9]); o1.y = pack2(v[10], v[11]); o1.z = pack2(v[12], v[13]); o1.w = pack2(v[14], v[15]);
          *(uint4*)(dst + c * 16) = o0;
          *(uint4*)(dst + c * 16 + 8) = o1;
        }
      } else {
        const int row = u >> 1, half = u & 1;
        const size_t gr = (size_t)m0 + row;
        const int t = t0 + row;
        const float* Cr = (const float*)lds + row * 132 + half * 64;
        float rstd = 1.f;
        const float* gn = (isQ ? p.q_norm_g : p.k_norm_g) + l * 128 + half * 64;
        if (isC) {
          float ss = 0.f;
#pragma unroll
          for (int j = 0; j < 16; ++j) {
            float4 tv = *(const float4*)(Cr + j * 4);
            ss += tv.x * tv.x + tv.y * tv.y + tv.z * tv.z + tv.w * tv.w;
          }
          ss += __shfl_xor(ss, 1);
          rstd = rsqrtf(ss * (1.f / 128.f) + EPS);
        }
        const int pos = (half == 0) ? (t >> 6) : (t & 63);
        const float* cs = p.rope + pos * 32;
        const float* sn = p.rope + 2048 + pos * 32;
        u16* dst;
        if (isQ) {
          const int head = (isC ? (nt - 18) : (nt - 8)) * 2 + hsel;
          dst = p.Q + gr * 2048 + (isC ? 1024 : 0) + head * 128 + half * 64;
        } else {
          dst = p.Kb + gr * 512 + (isC ? 256 : 0) + hsel * 128 + half * 64;
        }
#pragma unroll 1
        for (int c = 0; c < 2; ++c) {
          float x0[16], x1[16];
#pragma unroll
          for (int j = 0; j < 4; ++j) {
            float4 ta_ = *(const float4*)(Cr + c * 16 + j * 4);
            float4 tb_ = *(const float4*)(Cr + 32 + c * 16 + j * 4);
            x0[4 * j] = ta_.x; x0[4 * j + 1] = ta_.y; x0[4 * j + 2] = ta_.z; x0[4 * j + 3] = ta_.w;
            x1[4 * j] = tb_.x; x1[4 * j + 1] = tb_.y; x1[4 * j + 2] = tb_.z; x1[4 * j + 3] = tb_.w;
          }
          if (isC) {
#pragma unroll
            for (int j = 0; j < 16; ++j) { x0[j] = x0[j] * rstd * gn[c * 16 + j]; x1[j] = x1[j] * rstd * gn[32 + c * 16 + j]; }
          }
          if (lat) {
#pragma unroll
            for (int j = 0; j < 16; ++j) {
              float c_ = cs[c * 16 + j], s_ = sn[c * 16 + j];
              float a0 = x0[j], a1 = x1[j];
              x0[j] = a0 * c_ - a1 * s_;
              x1[j] = a1 * c_ + a0 * s_;
            }
          }
          if (isQ) {
#pragma unroll
            for (int j = 0; j < 16; ++j) { x0[j] *= QSCALE; x1[j] *= QSCALE; }
          }
          uint4 o0, o1, o2, o3;
          o0.x = pack2(x0[0], x0[1]); o0.y = pack2(x0[2], x0[3]); o0.z = pack2(x0[4], x0[5]); o0.w = pack2(x0[6], x0[7]);
          o1.x = pack2(x0[8], x0[9]); o1.y = pack2(x0[10], x0[11]); o1.z = pack2(x0[12], x0[13]); o1.w = pack2(x0[14], x0[15]);
          o2.x = pack2(x1[0], x1[1]); o2.y = pack2(x1[2], x1[3]); o2.z = pack2(x1[4], x1[5]); o2.w = pack2(x1[6], x1[7]);
          o3.x = pack2(x1[8], x1[9]); o3.y = pack2(x1[10], x1[11]); o3.z = pack2(x1[12], x1[13]); o3.w = pack2(x1[14], x1[15]);
          *(uint4*)(dst + c * 16) = o0;
          *(uint4*)(dst + c * 16 + 8) = o1;
          *(uint4*)(dst + 32 + c * 16) = o2;
          *(uint4*)(dst + 32 + c * 16 + 8) = o3;
        }
      }
    };

#pragma unroll
    for (int bj = 0; bj < 2; ++bj) {
      float* Cs = (float*)lds;
#pragma unroll
      for (int ai = 0; ai < 2; ++ai)
#pragma unroll
        for (int m = 0; m < 4; ++m)
#pragma unroll
          for (int n = 0; n < 2; ++n) {
            const int row = ai * 128 + wr * 64 + m * 16 + fr;
            const int col = wc * 32 + n * 16 + fq * 4;
            pg8::f32x4 v = acc[ai][bj][m][n];
            float4 o; o.x = v[0]; o.y = v[1]; o.z = v[2]; o.w = v[3];
            *(float4*)(Cs + row * 132 + col) = o;
          }
      __syncthreads();
      process_unit(bj, tid);
      __syncthreads();
    }
  }
};

DI void phase_gemm_in(CParams& p, int chunk, int l, char* lds) {
  const int NB = p.NB, RL = NB * S, R = NB * (S + L);
  const int MT = R / 256;
  const u16* Wt = p.WinT + (size_t)l * INW * D;
  {
    pg8::Gemm g{p.Hb, Wt, R, 7168, D, D};
    pg8::StaticOrder So; So.init(R, 7168, (int)gridDim.x, (int)blockIdx.x);
    EpiIn E{&p};
    pg8::gemm_phase<EpiIn, pg8::StaticOrder, false>((PG8_LAS unsigned char*)lds, g, So, E, nullptr);
  }
  for (int ti = 0;; ++ti) {
    int mt, jt;
    if (!tile_map(ti, MT, 12, mt, jt)) break;
    const int nt = (jt < 6) ? 8 + jt : 12 + jt;
    pg8::Gemm g{p.Hb, Wt + (size_t)28 * 256 * D, R, 3072, D, D};
    OneUnit One{mt, jt};
    EpiQKV E{&p, lds, l, nt, mt * 256};
    pg8::gemm_phase<EpiQKV, OneUnit, false>((PG8_LAS unsigned char*)lds, g, One, E, nullptr);
  }
}

struct AttnArgs {
  const u16* q;
  u16* z;
  const u16* kctx;
  const u16* vctx;
  const u16* klat;
  const u16* vlat;
  int n_lat_tiles;
  int lat_key0;
  int q_t0;
  int band;
  int has_sink;
  float sink_l2;
  int dry;
  int fixedm;
  float mfix;
};

DI void attn_load_tile(const AttnArgs& a, int ti, u32x4 (&rk)[2], u32x4 (&rv)[2]) {
  const int tid = otid();
  const u16* kp; const u16* vp; int vs;
  if (ti < 4) { kp = a.kctx + (size_t)(ti * 64) * 512; vp = a.vctx + ti * 64; vs = L; }
  else { kp = a.klat + (size_t)((ti - 4) * 64) * 512; vp = a.vlat + (ti - 4) * 64; vs = S; }
#pragma unroll
  for (int i = 0; i < 2; ++i) {
    int c = tid + NTHR * i;
    rk[i] = *(const u32x4*)(kp + (size_t)(c >> 4) * 512 + (c & 15) * 8);
    rv[i] = *(const u32x4*)(vp + (size_t)(c >> 3) * vs + (c & 7) * 8);
  }
}
DI void attn_store_tile(u16* sK, u16* sV, const u32x4 (&rk)[2], const u32x4 (&rv)[2]) {
  const int tid = otid();
#pragma unroll
  for (int i = 0; i < 2; ++i) {
    int c = tid + NTHR * i;
    *(u32x4*)(sK + (c >> 4) * 136 + (c & 15) * 8) = rk[i];
    u16* vd = sV + (c >> 3) * 72 + ((c & 7) >> 1) * 16 + ((c & 7) & 1) * 4;
    { u32x2 t0 = {rv[i].x, rv[i].y}; *(u32x2*)(vd) = t0; }
    { u32x2 t1 = {rv[i].z, rv[i].w}; *(u32x2*)(vd + 8) = t1; }
  }
}

template <bool NS>
DI void attn_item(const AttnArgs& a, char* lds) {
  const int tid = otid(), lane = tid & 63, w = tid >> 6;
  const int r = lane & 31, hh = lane >> 5;
  constexpr int STG = 17408 + 128 * 144;
  const int ntiles = 4 + a.n_lat_tiles;

  bf16x8 qf[8];
  {
    const u16* qp = a.q + (size_t)(w * 32 + r) * 2048 + hh * 8;
#pragma unroll
    for (int ks = 0; ks < 8; ++ks) qf[ks] = *(const bf16x8*)(qp + ks * 16);
  }
  f32x16 O[4];
#pragma unroll
  for (int dt = 0; dt < 4; ++dt)
#pragma unroll
    for (int x = 0; x < 16; ++x) O[dt][x] = 0.f;
  float m = a.fixedm ? a.mfix : (a.has_sink ? a.sink_l2 : -1e30f);
  float lsum = (a.has_sink && hh == 0) ? 1.f : 0.f;
  const int qpos = a.q_t0 + w * 32 + r;

  auto QK = [&](int stage, f32x16 (&sc)[2]) {
    const u16* sK = (const u16*)(lds + stage * STG);
#pragma unroll
    for (int x = 0; x < 16; ++x) { sc[0][x] = 0.f; sc[1][x] = 0.f; }
    const u16* kb0 = sK + r * 136 + hh * 8;
    const u16* kb1 = sK + (32 + r) * 136 + hh * 8;
#pragma unroll
    for (int ks = 0; ks < 8; ++ks) {
      bf16x8 ka0 = *(const bf16x8*)(kb0 + ks * 16);
      bf16x8 ka1 = *(const bf16x8*)(kb1 + ks * 16);
      sc[0] = MFMA32(ka0, qf[ks], sc[0]);
      sc[1] = MFMA32(ka1, qf[ks], sc[1]);
    }
  };
  u32x4 rk[2], rv[2], rk1[2], rv1[2];
  auto STEP = [&](int ti, int st, f32x16 (&sc)[2], f32x16 (&sn)[2], u32x4 (&lk)[2], u32x4 (&lv)[2], u32x4 (&sk)[2], u32x4 (&sv)[2]) {
    const int st1 = (st == 2) ? 0 : st + 1, st2 = (st == 0) ? 2 : st - 1;
    if (ti + 3 < ntiles) attn_load_tile(a, ti + 3, lk, lv);
    if (ti + 1 < ntiles) QK(st1, sn);
    if (a.band && ti >= 4) {
      const int k0 = a.lat_key0 + (ti - 4) * 64;
#pragma unroll
      for (int kt2 = 0; kt2 < 2; ++kt2)
#pragma unroll
        for (int x = 0; x < 16; ++x) {
          int kp = k0 + kt2 * 32 + crow(x, hh);
          int dlt = kp - qpos; dlt = dlt < 0 ? -dlt : dlt;
          if (dlt > 128) sc[kt2][x] = -1e30f;
        }
    }
    if (!NS && !a.fixedm) {
      float mx = sc[0][0];
#pragma unroll
      for (int kt2 = 0; kt2 < 2; ++kt2)
#pragma unroll
        for (int x = 0; x < 16; ++x) mx = fmaxf(mx, sc[kt2][x]);
      mx = fmaxf(mx, __shfl_xor(mx, 32));
      if (__any(mx > m + 8.f)) {
        const float mnew = fmaxf(m, mx);
        const float alpha = __builtin_amdgcn_exp2f(m - mnew);
        m = mnew;
        lsum *= alpha;
#pragma unroll
        for (int dt = 0; dt < 4; ++dt)
#pragma unroll
          for (int x = 0; x < 16; ++x) O[dt][x] *= alpha;
      }
    }
    float ps = 0.f;
#pragma unroll
    for (int kt2 = 0; kt2 < 2; ++kt2)
#pragma unroll
      for (int x = 0; x < 16; ++x) { float pv = NS ? __builtin_amdgcn_exp2f(sc[kt2][x]) : __builtin_amdgcn_exp2f(sc[kt2][x] - m); sc[kt2][x] = pv; ps += pv; }
    lsum += ps;
    const u16* sV = (const u16*)(lds + st * STG + 17408);
#pragma unroll
    for (int kt2 = 0; kt2 < 2; ++kt2)
#pragma unroll
      for (int s2 = 0; s2 < 2; ++s2) {
        union { unsigned u[4]; bf16x8 v; } pf;
#pragma unroll
        for (int j = 0; j < 4; ++j) pf.u[j] = pack2(sc[kt2][8 * s2 + 2 * j], sc[kt2][8 * s2 + 2 * j + 1]);
        const u16* vb = sV + r * 72 + kt2 * 32 + 16 * s2 + 8 * hh;
#pragma unroll
        for (int dt = 0; dt < 4; ++dt) {
          bf16x8 va = *(const bf16x8*)(vb + dt * 32 * 72);
          O[dt] = MFMA32(va, pf.v, O[dt]);
        }
      }
    if (ti + 2 < ntiles) attn_store_tile((u16*)(lds + st2 * STG), (u16*)(lds + st2 * STG + 17408), sk, sv);
    asm volatile("s_waitcnt lgkmcnt(0)" ::: "memory");
    __builtin_amdgcn_s_barrier();
    asm volatile("" ::: "memory");
  };

  attn_load_tile(a, 0, rk, rv);
  __syncthreads();
  attn_store_tile((u16*)lds, (u16*)(lds + 17408), rk, rv);
  attn_load_tile(a, 1, rk, rv);
  attn_store_tile((u16*)(lds + STG), (u16*)(lds + STG + 17408), rk, rv);
  attn_load_tile(a, 2, rk, rv);
  __syncthreads();
  f32x16 sA[2], sB[2];
  QK(0, sA);
  int st = 0;
  for (int ti = 0; ti < ntiles; ti += 2) {
    STEP(ti, st, sA, sB, rk1, rv1, rk, rv);
    st = (st == 2) ? 0 : st + 1;
    if (ti + 1 < ntiles) {
      STEP(ti + 1, st, sB, sA, rk, rv, rk1, rv1);
      st = (st == 2) ? 0 : st + 1;
    }
  }
  float ltot = lsum + __shfl_xor(lsum, 32);
  const float inv = 1.f / ltot;
  u16* zp = a.z + (size_t)(w * 32 + r) * 3072;
  u32x2 gv[4][4];
#pragma unroll
  for (int dt = 0; dt < 4; ++dt)
#pragma unroll
    for (int g4 = 0; g4 < 4; ++g4) gv[dt][g4] = *(const u32x2*)(zp + dt * 32 + 8 * g4 + 4 * hh);
#pragma unroll
  for (int dt = 0; dt < 4; ++dt)
#pragma unroll
    for (int g4 = 0; g4 < 4; ++g4) {
      int d0 = dt * 32 + 8 * g4 + 4 * hh;
      float y0 = O[dt][4 * g4 + 0] * inv * bflo(gv[dt][g4].x);
      float y1 = O[dt][4 * g4 + 1] * inv * bfhi(gv[dt][g4].x);
      float y2 = O[dt][4 * g4 + 2] * inv * bflo(gv[dt][g4].y);
      float y3 = O[dt][4 * g4 + 3] * inv * bfhi(gv[dt][g4].y);
      uint2 o; o.x = pack2(y0, y1); o.y = pack2(y2, y3);
      if (!a.dry || y0 != y0) *(uint2*)(zp + d0) = o;
    }
}

template <bool REV>
DI void lru_scan(float (&av)[2][16], float (&bv)[2][16], float& carry, int hh) {
  float segA[8], segB[8];
#pragma unroll
  for (int k = 0; k < 8; ++k) {
    const int mt = k >> 2, q = k & 3;
    float cA = 1.f, hl = 0.f;
#pragma unroll
    for (int jj = 0; jj < 4; ++jj) {
      const int j = REV ? 3 - jj : jj;
      const int i = 4 * q + j;
      hl = av[mt][i] * hl + bv[mt][i];
      cA *= av[mt][i];
      av[mt][i] = cA; bv[mt][i] = hl;
    }
    segA[k] = cA; segB[k] = hl;
  }
  float oA[8], oB[8];
#pragma unroll
  for (int k = 0; k < 8; ++k) { oA[k] = __shfl_xor(segA[k], 32); oB[k] = __shfl_xor(segB[k], 32); }
  float init[8];
  float st = carry;
#pragma unroll
  for (int kk = 0; kk < 8; ++kk) {
    const int k = REV ? 7 - kk : kk;
    const int first = REV ? 1 : 0;
    float A1 = (hh == first) ? segA[k] : oA[k];
    float B1 = (hh == first) ? segB[k] : oB[k];
    float st0 = st;
    st = A1 * st + B1;
    float A2 = (hh == first) ? oA[k] : segA[k];
    float B2 = (hh == first) ? oB[k] : segB[k];
    float st1 = st;
    st = A2 * st + B2;
    init[k] = (hh == first) ? st0 : st1;
  }
  carry = st;
#pragma unroll
  for (int k = 0; k < 8; ++k) {
    const int mt = k >> 2, q = k & 3;
#pragma unroll
    for (int j = 0; j < 4; ++j) {
      const int i = 4 * q + j;
      bv[mt][i] = bv[mt][i] + av[mt][i] * init[k];
    }
  }
}

DI void lru_item(CParams& p, int l, int b, int n, bool last, char* lds, int dry = 0) {
  const int NB = p.NB, RL = NB * S;
  const int tid = otid(), lane = tid & 63, w8 = tid >> 6;
  const int sub = __builtin_amdgcn_readfirstlane(w8 >> 2), w = w8 & 3;
  n = n + sub;
  lds += sub * 73728;
  const int dir = w >> 1, w2 = w & 1;
  const int tl = tid & 127;
  const int r = lane & 31, hh = lane >> 5;
  u16* sRaw = (u16*)lds + dir * (8704 / 2);
  u16* sUp = (u16*)(lds + 17408) + dir * (9216 / 2);
  float* sH = (float*)(lds + 35840) + w * (64 * 36);

  const int chb = n * 64;
  const int cp = (tl & 31) * 2, tg = tl >> 5;
  float cw0[4], cw1[4], cb0, cb1;
#pragma unroll
  for (int k = 0; k < 4; ++k) {
    cw0[k] = p.conv_w[((size_t)l * 4 + k) * D + chb + cp];
    cw1[k] = p.conv_w[((size_t)l * 4 + k) * D + chb + cp + 1];
  }
  cb0 = p.conv_b[l * D + chb + cp]; cb1 = p.conv_b[l * D + chb + cp + 1];
  bf16x8 waf[4], wxf[4];
  {
    const float* wa = p.lru_wa + (((size_t)(l * 2 + dir) * 16 + n) * 64) * 64;
    const float* wx = p.lru_wx + (((size_t)(l * 2 + dir) * 16 + n) * 64) * 64;
    const int e = 32 * w2 + r;
#pragma unroll
    for (int ks = 0; ks < 4; ++ks) {
      union { unsigned u[4]; bf16x8 v; } fa, fx;
#pragma unroll
      for (int j = 0; j < 4; ++j) {
        int d0 = ks * 16 + 8 * hh + 2 * j;
        fa.u[j] = pack2(wa[d0 * 64 + e], wa[(d0 + 1) * 64 + e]);
        fx.u[j] = pack2(wx[d0 * 64 + e], wx[(d0 + 1) * 64 + e]);
      }
      waf[ks] = fa.v; wxf[ks] = fx.v;
    }
  }
  const int che = chb + 32 * w2 + r;
  const float ba = p.lru_ba[(l * 2 + dir) * D + che];
  const float bx = p.lru_bx[(l * 2 + dir) * D + che];
  float c8sp;
  {
    float lam = p.lru_lambda[(l * 2 + dir) * D + che];
    float sp = (lam < -20.f) ? -lam : log1pf(expf(-lam));
    c8sp = 8.f * sp;
  }
  float carry = 0.f;

  auto step_tile = [&](int st, bool& isctx, int& tt) {
    if (dir == 0) { if (st < 4) { isctx = true; tt = st; } else { isctx = false; tt = st - 4; } }
    else { if (st < 4) { isctx = true; tt = 3 - st; } else { isctx = false; tt = 63 - (st - 4); } }
  };
  u32x4 pre[5];
  auto load_raw = [&](int st) {
    bool isctx; int tt; step_tile(st, isctx, tt);
    const int seqlen = isctx ? L : S;
    const size_t rowbase = isctx ? (size_t)RL + (size_t)b * L : (size_t)b * S;
    const int t0 = tt * 64;
#pragma unroll
    for (int i = 0; i < 5; ++i) {
      int c = tl + 128 * i;
      int rr = c >> 3, c16 = c & 7;
      int t = t0 - 2 + rr;
      u32x4 v = {0u, 0u, 0u, 0u};
      if (rr < 67 && t >= 0 && t < seqlen) v = *(const u32x4*)(p.U + (rowbase + t) * D + chb + c16 * 8);
      pre[i] = v;
    }
  };
  load_raw(0);
  __syncthreads();
  for (int st = 0; st < 68; ++st) {
    bool isctx; int tt; step_tile(st, isctx, tt);
    const size_t rowbase = isctx ? (size_t)RL + (size_t)b * L : (size_t)b * S;
    const int t0 = tt * 64;
#pragma unroll
    for (int i = 0; i < 5; ++i) {
      int c = tl + 128 * i;
      int rr = c >> 3, c16 = c & 7;
      if (rr < 67) *(u32x4*)(sRaw + rr * 64 + c16 * 8) = pre[i];
    }
    if (st + 1 < 68) load_raw(st + 1);
    asm volatile("s_waitcnt lgkmcnt(0)" ::: "memory"); __builtin_amdgcn_s_barrier(); asm volatile("" ::: "memory");
    {
      const u16* rp = sRaw + (tg * 16) * 64 + cp;
      unsigned r0 = *(const unsigned*)(rp), r1 = *(const unsigned*)(rp + 64), r2 = *(const unsigned*)(rp + 128);
#pragma unroll
      for (int i = 0; i < 16; ++i) {
        unsigned r3 = *(const unsigned*)(rp + (i + 3) * 64);
        float o0 = cb0 + cw0[0] * bflo(r0) + cw0[1] * bflo(r1) + cw0[2] * bflo(r2) + cw0[3] * bflo(r3);
        float o1 = cb1 + cw1[0] * bfhi(r0) + cw1[1] * bfhi(r1) + cw1[2] * bfhi(r2) + cw1[3] * bfhi(r3);
        *(unsigned*)(sUp + (tg * 16 + i) * 72 + cp) = pack2(o0, o1);
        r0 = r1; r1 = r2; r2 = r3;
      }
    }
    asm volatile("s_waitcnt lgkmcnt(0)" ::: "memory"); __builtin_amdgcn_s_barrier(); asm volatile("" ::: "memory");
    const bool fwd_first = isctx ? (tt <= 1) : (tt <= 31);
    const bool first = (dir == 0) ? fwd_first : !fwd_first;
    unsigned long long pt0[4], pt1[4];
    u32x4 pg[4];
    if (!first && !(isctx && last)) {
#pragma unroll
      for (int j = 0; j < 4; ++j) {
        const int q = lane + 64 * j;
        const int tok = q >> 2, cc = (q & 3) * 8;
        const size_t row = rowbase + t0 + tok;
        const int col = chb + 32 * w2 + cc;
        const u16* tp = p.Hb + row * D + col;
        pt0[j] = __hip_atomic_load((const unsigned long long*)tp, __ATOMIC_RELAXED, __HIP_MEMORY_SCOPE_AGENT);
        pt1[j] = __hip_atomic_load((const unsigned long long*)tp + 1, __ATOMIC_RELAXED, __HIP_MEMORY_SCOPE_AGENT);
        pg[j] = *(const u32x4*)(p.Z + row * 3072 + col);
      }
    } else {
#pragma unroll
      for (int j = 0; j < 4; ++j) { pt0[j] = 0; pt1[j] = 0; pg[j] = u32x4{0u, 0u, 0u, 0u}; }
    }
    float av[2][16], bv[2][16];
    {
      f32x16 aR[2];
#pragma unroll
      for (int mt = 0; mt < 2; ++mt) {
#pragma unroll
        for (int x = 0; x < 16; ++x) aR[mt][x] = 0.f;
        const u16* ub = sUp + (mt * 32 + r) * 72 + hh * 8;
#pragma unroll
        for (int ks = 0; ks < 4; ++ks) aR[mt] = MFMA32(*(const bf16x8*)(ub + ks * 16), waf[ks], aR[mt]);
      }
#pragma unroll
      for (int mt = 0; mt < 2; ++mt)
#pragma unroll
        for (int x = 0; x < 16; ++x) {
          const float rg = sigmoidf_(aR[mt][x] + ba);
          av[mt][x] = -c8sp * rg;
        }
    }
    {
      f32x16 aI[2];
#pragma unroll
      for (int mt = 0; mt < 2; ++mt) {
#pragma unroll
        for (int x = 0; x < 16; ++x) aI[mt][x] = 0.f;
        const u16* ub = sUp + (mt * 32 + r) * 72 + hh * 8;
#pragma unroll
        for (int ks = 0; ks < 4; ++ks) aI[mt] = MFMA32(*(const bf16x8*)(ub + ks * 16), wxf[ks], aI[mt]);
      }
#pragma unroll
      for (int mt = 0; mt < 2; ++mt)
#pragma unroll
        for (int x = 0; x < 16; ++x) {
          const int tok = mt * 32 + crow(x, hh);
          const float up = bf2f(sUp[tok * 72 + 32 * w2 + r]);
          const float ig = sigmoidf_(aI[mt][x] + bx);
          const float la = av[mt][x];
          const float a_ = __expf(la);
          const float om = fmaxf(1.f - a_ * a_, 0.f);
          av[mt][x] = a_;
          bv[mt][x] = __builtin_amdgcn_sqrtf(om) * (ig * up);
        }
    }
    if (dir == 0) lru_scan<false>(av, bv, carry, hh); else lru_scan<true>(av, bv, carry, hh);
#pragma unroll
    for (int mt = 0; mt < 2; ++mt)
#pragma unroll
      for (int x = 0; x < 16; ++x) sH[(mt * 32 + crow(x, hh)) * 36 + r] = bv[mt][x];
    if (!(isctx && last)) {
#pragma unroll
      for (int j = 0; j < 4; ++j) {
        const int q = lane + 64 * j;
        const int tok = q >> 2, cc = (q & 3) * 8;
        const float4 h0 = *(const float4*)(sH + tok * 36 + cc);
        const float4 h1 = *(const float4*)(sH + tok * 36 + cc + 4);
        const size_t row = rowbase + t0 + tok;
        const int col = chb + 32 * w2 + cc;
        u16* tp = p.Hb + row * D + col;
        if (first) {
          uint4 o; o.x = pack2(h0.x, h0.y); o.y = pack2(h0.z, h0.w); o.z = pack2(h1.x, h1.y); o.w = pack2(h1.z, h1.w);
          if (!dry || h0.x != h0.x) *(uint4*)tp = o;
        } else {
          unsigned tx = (unsigned)pt0[j], ty = (unsigned)(pt0[j] >> 32), tz = (unsigned)pt1[j], tw = (unsigned)(pt1[j] >> 32);
          u16* zp = p.Z + row * 3072 + col;
          u32x4 g = pg[j];
          uint4 o;
          o.x = pack2((h0.x + bflo(tx)) * bflo(g.x), (h0.y + bfhi(tx)) * bfhi(g.x));
          o.y = pack2((h0.z + bflo(ty)) * bflo(g.y), (h0.w + bfhi(ty)) * bfhi(g.y));
          o.z = pack2((h1.x + bflo(tz)) * bflo(g.z), (h1.y + bfhi(tz)) * bfhi(g.z));
          o.w = pack2((h1.z + bflo(tw)) * bflo(g.w), (h1.w + bfhi(tw)) * bfhi(g.w));
          if (!dry || h0.x != h0.x) *(uint4*)zp = o;
        }
      }
    }
    __builtin_amdgcn_fence(__ATOMIC_RELEASE, "workgroup");
  }
}

DI void phase_mixers(CParams& p, int chunk, int l, char* lds, int dry = 0) {
  const int NB = p.NB, RL = NB * S;
  const bool last = (l == DEPTH - 1);
  const int nLRU = (dry == 1) ? 0 : NB * 8, nC = (dry == 2) ? 0 : NB * 8 * 16, nBw = (dry == 2) ? 0 : NB * 8 * 16, nCtx = (last || dry == 2) ? 0 : NB * 8 * 2;
  const int total = nLRU + nC + nBw + nCtx;
  int* ctr = p.ctr + chunk * DEPTH + l + (dry ? 32 : 0);
  int* s_item = (int*)(lds + LDS_BYTES - 16);
  int it;
  while (true) {
    __syncthreads();
    if (threadIdx.x == 0) *s_item = atomicAdd(ctr, 1);
    __syncthreads();
    it = __builtin_amdgcn_readfirstlane(*s_item);
    __syncthreads();
    if (it >= nLRU) break;
    lru_item(p, l, it >> 3, (it & 7) * 2, last, lds, dry);
  }
  float gqm = 0.f, gkm = 0.f;
  {
    const int ln = otid() & 63;
    gqm = fmaxf(fabsf(p.q_norm_g[l * 128 + ln]), fabsf(p.q_norm_g[l * 128 + 64 + ln]));
    gkm = fmaxf(fabsf(p.k_norm_g[l * 128 + ln]), fabsf(p.k_norm_g[l * 128 + 64 + ln]));
#pragma unroll
    for (int o = 32; o >= 1; o >>= 1) { gqm = fmaxf(gqm, __shfl_xor(gqm, o)); gkm = fmaxf(gkm, __shfl_xor(gkm, o)); }
    gqm = __builtin_amdgcn_readfirstlane(gqm); gkm = __builtin_amdgcn_readfirstlane(gkm);
  }
  const float mfixC = 128.f * gqm * gkm * QSCALE;
  const int nCfast = (mfixC < 60.f) ? nC : 0;
  auto fetch = [&]() {
    __syncthreads();
    if (threadIdx.x == 0) *s_item = atomicAdd(ctr, 1);
    __syncthreads();
    it = __builtin_amdgcn_readfirstlane(*s_item);
    __syncthreads();
  };
  auto build = [&](int ir, AttnArgs& a) {
    a.dry = dry;
    if (ir < nC + nBw) {
      const bool isB = ir >= nC;
      if (isB) ir -= nC;
      const int b = ir >> 7, h = (ir >> 4) & 7, qb = ir & 15;
      const int kvh = h >> 2;
      const int br = isB ? 0 : 1;
      const size_t qrow0 = (size_t)b * S + qb * 256;
      a.q = p.Q + qrow0 * 2048 + br * 1024 + h * 128;
      a.z = p.Z + qrow0 * 3072 + (br + 1) * 1024 + h * 128;
      const int kcol = br * 256 + kvh * 128, slot = br * 2 + kvh;
      a.kctx = p.Kb + ((size_t)RL + (size_t)b * L) * 512 + kcol;
      a.vctx = p.VtC + (size_t)(b * 4 + slot) * 128 * L;
      int k0, k1;
      if (isB) { k0 = qb * 256 - 128; if (k0 < 0) k0 = 0; k1 = qb * 256 + 384; if (k1 > S) k1 = S; }
      else { k0 = 0; k1 = S; }
      a.lat_key0 = k0;
      a.n_lat_tiles = (k1 - k0) >> 6;
      a.klat = p.Kb + ((size_t)b * S + k0) * 512 + kcol;
      a.vlat = p.VtL + (size_t)(b * 4 + slot) * 128 * S + k0;
      a.q_t0 = qb * 256;
      a.band = isB ? 1 : 0;
      a.has_sink = isB ? 1 : 0;
      a.sink_l2 = isB ? p.attn_sink[l * 8 + h] * LOG2E : 0.f;
      a.fixedm = isB ? 0 : 1; a.mfix = mfixC;
    } else {
      ir -= nC + nBw;
      const int h = ir & 7, br = (ir >> 3) & 1, b = ir >> 4;
      const int kvh = h >> 2;
      const size_t qrow0 = (size_t)RL + (size_t)b * L;
      a.q = p.Q + qrow0 * 2048 + br * 1024 + h * 128;
      a.z = p.Z + qrow0 * 3072 + (br + 1) * 1024 + h * 128;
      const int kcol = br * 256 + kvh * 128, slot = br * 2 + kvh;
      a.kctx = p.Kb + ((size_t)RL + (size_t)b * L) * 512 + kcol;
      a.vctx = p.VtC + (size_t)(b * 4 + slot) * 128 * L;
      a.klat = a.kctx; a.vlat = a.vctx;
      a.n_lat_tiles = 0; a.lat_key0 = 0; a.q_t0 = 0; a.band = 0;
      a.has_sink = (br == 0) ? 1 : 0;
      a.sink_l2 = (br == 0) ? p.attn_sink[l * 8 + h] * LOG2E : 0.f;
      a.fixedm = (br == 0) ? 0 : 1; a.mfix = mfixC;
    }
  };
  while (it < nLRU + nCfast) {
    AttnArgs a;
    build(it - nLRU, a);
    attn_item<true>(a, lds);
    fetch();
  }
  while (it < total) {
    AttnArgs a;
    build(it - nLRU, a);
    attn_item<false>(a, lds);
    fetch();
  }
}

DI void merge_tiles_ctx(CParams& p, int l, char* lds) {
  const int NB = p.NB, RL = NB * S, R = NB * (S + L);
  const int MT = (R - RL) / 256, NT = 8;
  const int tid = otid();
  const int lane = tid & 63, w = tid >> 6, wm = w >> 1, wn = w & 1, r = lane & 31, hh = lane >> 5;
  for (int ti = 0;; ++ti) {
    int mt, nt;
    if (!tile_map(ti, MT, NT, mt, nt)) break;
    const int m0 = RL + mt * 256, n0 = nt * 128;
    f32x16 tot[2][2];
#pragma unroll
    for (int i = 0; i < 2; ++i)
#pragma unroll
      for (int j = 0; j < 2; ++j)
#pragma unroll
        for (int x = 0; x < 16; ++x) tot[i][j][x] = 0.f;
#pragma unroll 1
    for (int n = 0; n < 3; ++n) {
      f32x16 acc[2][2];
      gemm_core<128, false>(p.Z + (size_t)m0 * 3072 + n * 1024, 3072, 64, (size_t)128 * 3072,
                            p.WbT + ((size_t)(l * 3 + n) * D + n0) * D, D, 64, 0, D, lds, acc);
#pragma unroll
      for (int i = 0; i < 2; ++i)
#pragma unroll
        for (int j = 0; j < 2; ++j)
#pragma unroll
          for (int g = 0; g < 4; ++g) {
            const size_t row = (size_t)m0 + wm * 64 + i * 32 + r;
            const int col = n0 + wn * 64 + j * 32 + 8 * g + 4 * hh;
            uint2 sv = *(const uint2*)(p.Ms + row * 3072 + n * 1024 + col);
            tot[i][j][4 * g + 0] += bflo(sv.x) * acc[i][j][4 * g + 0];
            tot[i][j][4 * g + 1] += bfhi(sv.x) * acc[i][j][4 * g + 1];
            tot[i][j][4 * g + 2] += bflo(sv.y) * acc[i][j][4 * g + 2];
            tot[i][j][4 * g + 3] += bfhi(sv.y) * acc[i][j][4 * g + 3];
          }
    }
#pragma unroll
    for (int i = 0; i < 2; ++i)
#pragma unroll
      for (int j = 0; j < 2; ++j)
#pragma unroll
        for (int g = 0; g < 4; ++g) {
          const size_t row = (size_t)m0 + wm * 64 + i * 32 + r;
          const int col = n0 + wn * 64 + j * 32 + 8 * g + 4 * hh;
          uint2 o; o.x = pack2(tot[i][j][4 * g], tot[i][j][4 * g + 1]); o.y = pack2(tot[i][j][4 * g + 2], tot[i][j][4 * g + 3]);
          *(uint2*)(p.Hb + row * D + col) = o;
        }
  }
}

struct MergeOrder {
  pg8::StaticOrder inner;
  __device__ void init(int M, int G, int c) { inner.init(M, 1024, G, c); }
  __device__ bool next(int i, pg8::Unit& u) const {
    const int j = i / 3, n = i - 3 * j;
    pg8::Unit t;
    if (!inner.next(j, t)) return false;
    u.pm = t.pm; u.pn = n * 4 + t.pn;
    return true;
  }
  __device__ __forceinline__ void a_ready(const pg8::Unit&) const {}
  __device__ __forceinline__ void done(const pg8::Unit&) const {}
  __device__ __forceinline__ size_t a_off(const pg8::Unit& u) const { return (size_t)(u.pn >> 2) * 1024 * 2; }
};
struct EpiMerge {
  static constexpr bool PERM = true, AFTER_DRAIN = false;
  CParams* kp;
  __device__ __forceinline__ void operator()(const pg8::f32x4 (&acc)[2][2][4][2], const pg8::Unit& u, int wr, int wc, int fr, int fq) const {
    const int n = u.pn >> 2, ct = u.pn & 3;
    const int row0 = u.pm * 256 + wr * 64 + fr;
    const int col0 = ct * 256 + wc * 32 + 8 * fq;
    const u16* __restrict__ sg = kp->Ms + n * 1024;
    const u16* __restrict__ mrd = kp->Q;
    u16* __restrict__ mwr = kp->Q;
    u16* __restrict__ hb = kp->Hb;
#pragma unroll
    for (int am = 0; am < 4; ++am) {
      const int ai = am >> 1, mb = (am & 1) * 2;
      u32x4 sv[2][2], pa[2][2];
#pragma unroll
      for (int mm = 0; mm < 2; ++mm) {
        const size_t row = (size_t)(row0 + ai * 128 + (mb + mm) * 16);
#pragma unroll
        for (int bj = 0; bj < 2; ++bj) {
          sv[mm][bj] = *(const u32x4*)(sg + row * 3072 + col0 + bj * 128);
          if (n > 0) pa[mm][bj] = *(const u32x4*)(mrd + row * D + col0 + bj * 128);
        }
      }
#pragma unroll
      for (int mm = 0; mm < 2; ++mm) {
        const size_t row = (size_t)(row0 + ai * 128 + (mb + mm) * 16);
#pragma unroll
        for (int bj = 0; bj < 2; ++bj) {
          pg8::f32x4 v0 = acc[ai][bj][mb + mm][0], v1 = acc[ai][bj][mb + mm][1];
          v0[0] *= bflo(sv[mm][bj].x); v0[1] *= bfhi(sv[mm][bj].x); v0[2] *= bflo(sv[mm][bj].y); v0[3] *= bfhi(sv[mm][bj].y);
          v1[0] *= bflo(sv[mm][bj].z); v1[1] *= bfhi(sv[mm][bj].z); v1[2] *= bflo(sv[mm][bj].w); v1[3] *= bfhi(sv[mm][bj].w);
          if (n > 0) {
            v0[0] += bflo(pa[mm][bj].x); v0[1] += bfhi(pa[mm][bj].x); v0[2] += bflo(pa[mm][bj].y); v0[3] += bfhi(pa[mm][bj].y);
            v1[0] += bflo(pa[mm][bj].z); v1[1] += bfhi(pa[mm][bj].z); v1[2] += bflo(pa[mm][bj].w); v1[3] += bfhi(pa[mm][bj].w);
          }
          u32x4 w; w.x = pack2(v0[0], v0[1]); w.y = pack2(v0[2], v0[3]); w.z = pack2(v1[0], v1[1]); w.w = pack2(v1[2], v1[3]);
          if (n < 2) *(u32x4*)(mwr + row * D + col0 + bj * 128) = w;
          else *(u32x4*)(hb + row * D + col0 + bj * 128) = w;
        }
      }
    }
  }
};


DI void phase_merge(CParams& p, int chunk, int l, char* lds) {
  const int NB = p.NB, RL = NB * S;
  const bool last = (l == DEPTH - 1);
  pg8::Gemm g{p.Z, p.WbT + (size_t)l * 3 * D * D, RL, 3 * D, D, 3072};
  MergeOrder Mo; Mo.init(RL, (int)gridDim.x, (int)blockIdx.x);
  EpiMerge E{&p};
  pg8::gemm_phase<EpiMerge, MergeOrder, false>((PG8_LAS unsigned char*)lds, g, Mo, E, nullptr);
  if (!last) merge_tiles_ctx(p, l, lds);
}

struct EpiOut {
  static constexpr bool PERM = false, AFTER_DRAIN = false;
  CParams* kp; int chunk, l;
  __device__ __forceinline__ void operator()(const pg8::f32x4 (&acc)[2][2][4][2], const pg8::Unit& u, int wr, int wc, int fr, int fq) const {
    const int NB = kp->NB, RL = NB * S;
    const int gr0 = u.pm * 256;
    const float* src; float* dst; int mrow;
    if (gr0 < RL) {
      const int b = gr0 / S, t = gr0 % S, bg = chunk * NB + b;
      const size_t off = ((size_t)bg * S + t) * D;
      src = (l == 0 ? kp->x : kp->out) + off; dst = kp->out + off; mrow = bg;
    } else {
      const int rc = gr0 - RL, b = rc / L, t = rc % L, bg = chunk * NB + b;
      const size_t off = ((size_t)bg * L + t) * D;
      src = (l == 0 ? kp->ctx : kp->xc) + off; dst = kp->xc + off; mrow = 16;
    }
    const int col0 = u.pn * 256 + wc * 32 + 4 * fq;
    const float* gate = kp->modv + ((size_t)l * 17 + mrow) * 3072 + 2048 + col0;
    pg8::f32x4 gv[2][2];
#pragma unroll
    for (int bj = 0; bj < 2; ++bj)
#pragma unroll
      for (int n = 0; n < 2; ++n) gv[bj][n] = *(const pg8::f32x4*)(gate + bj * 128 + n * 16);
    const int row0 = wr * 64 + fr;
#pragma unroll
    for (int ai = 0; ai < 2; ++ai)
#pragma unroll
      for (int m = 0; m < 4; ++m) {
        const size_t ro = (size_t)(row0 + ai * 128 + m * 16) * D + col0;
        pg8::f32x4 xv[2][2];
#pragma unroll
        for (int bj = 0; bj < 2; ++bj)
#pragma unroll
          for (int n = 0; n < 2; ++n) xv[bj][n] = *(const pg8::f32x4*)(src + ro + bj * 128 + n * 16);
#pragma unroll
        for (int bj = 0; bj < 2; ++bj)
#pragma unroll
          for (int n = 0; n < 2; ++n) {
            pg8::f32x4 o = xv[bj][n] + gv[bj][n] * acc[ai][bj][m][n];
            *(pg8::f32x4*)(dst + ro + bj * 128 + n * 16) = o;
          }
      }
  }
};

DI void phase_outproj(CParams& p, int chunk, int l, char* lds) {
  const int NB = p.NB, RL = NB * S, R = NB * (S + L);
  const bool last = (l == DEPTH - 1);
  const int rows = last ? RL : R;
  pg8::Gemm g{p.Hb, p.WoT + (size_t)l * D * D, rows, D, D, D};
  pg8::StaticOrder So; So.init(rows, D, (int)gridDim.x, (int)blockIdx.x);
  EpiOut E{&p, chunk, l};
  pg8::gemm_phase<EpiOut, pg8::StaticOrder, false>((PG8_LAS unsigned char*)lds, g, So, E, nullptr);
}

DI void phase_final(CParams& p) {
  const int tid_ = otid();
  const int lane = tid_ & 63;
  const int wg = blockIdx.x * 8 + (tid_ >> 6), nw = gridDim.x * 8;
  for (int r = wg; r < NBATCH * S; r += nw) {
    float* src = p.out + (size_t)r * D;
    float4 v[4]; float ss = 0.f;
#pragma unroll
    for (int i = 0; i < 4; ++i) {
      v[i] = *(const float4*)(src + i * 256 + lane * 4);
      ss += v[i].x * v[i].x + v[i].y * v[i].y + v[i].z * v[i].z + v[i].w * v[i].w;
    }
#pragma unroll
    for (int o = 32; o >= 1; o >>= 1) ss += __shfl_xor(ss, o);
    float rstd = rsqrtf(ss * (1.f / D) + EPS);
#pragma unroll
    for (int i = 0; i < 4; ++i) {
      int cidx = i * 256 + lane * 4;
      float4 gg = *(const float4*)(p.final_g + cidx);
      float4 o;
      o.x = v[i].x * rstd * gg.x; o.y = v[i].y * rstd * gg.y; o.z = v[i].z * rstd * gg.z; o.w = v[i].w * rstd * gg.w;
      *(float4*)(src + cidx) = o;
    }
  }
}

#ifndef DUP_PHASE
#define DUP_PHASE 0
#endif
__global__ void __launch_bounds__(NTHR, 2) fwd_megakernel(Params p_unused) {
  CParams* kp = (CParams*)__builtin_amdgcn_kernarg_segment_ptr();
  cg::grid_group grid = cg::this_grid();
  __shared__ __attribute__((aligned(16))) char lds[LDS_BYTES];
  phase0(*opaque_kp(kp), lds);
  grid.sync();
  phase_mod(*opaque_kp(kp), lds);
  grid.sync();
  for (int chunk = 0; chunk < kp->nchunk; ++chunk) {
    for (int l = 0; l < DEPTH; ++l) {
      phase_prenorm(*opaque_kp(kp), chunk, l);
      grid.sync();
#if DUP_PHASE == 9
      grid.sync(); grid.sync(); grid.sync(); grid.sync(); grid.sync();
#endif
      phase_gemm_in(*opaque_kp(kp), chunk, l, lds);
      grid.sync();
#if DUP_PHASE == 3
      phase_gemm_in(*opaque_kp(kp), chunk, l, lds);
      grid.sync();
#endif
#if DUP_PHASE == 4
      phase_mixers(*opaque_kp(kp), chunk, l, lds, 1);
      grid.sync();
#endif
#if DUP_PHASE == 6
      phase_mixers(*opaque_kp(kp), chunk, l, lds, 2);
      grid.sync();
#endif
      phase_mixers(*opaque_kp(kp), chunk, l, lds);
      grid.sync();
      phase_merge(*opaque_kp(kp), chunk, l, lds);
      grid.sync();
#if DUP_PHASE == 5
      phase_merge(*opaque_kp(kp), chunk, l, lds);
      grid.sync();
#endif
      phase_outproj(*opaque_kp(kp), chunk, l, lds);
      grid.sync();
    }
  }
  phase_final(*opaque_kp(kp));
}

extern "C" void kernel_launch(void* const* d_in, const int* in_sizes, int n_in,
                              void* d_out, int out_size, void* d_ws, size_t ws_size,
                              hipStream_t stream) {
  static int grid_blocks = 0;
  if (!grid_blocks) {
    int dev = 0, cus = 0, per_cu = 0;
    (void)hipGetDevice(&dev);
    (void)hipDeviceGetAttribute(&cus, hipDeviceAttributeMultiprocessorCount, dev);
    (void)hipOccupancyMaxActiveBlocksPerMultiprocessor(&per_cu, fwd_megakernel, NTHR, 0);
    if (per_cu > 1) per_cu = 1;
    if (per_cu < 1) per_cu = 1;
    grid_blocks = cus * per_cu;
  }
  Params p{};
  const float* const* in = (const float* const*)d_in;
  p.x = in[0]; p.c = in[1]; p.ctx = in[2]; p.c_ctx = in[3]; p.norm_g = in[4]; p.w_mod = in[5]; p.b_mod = in[6];
  p.w_in = in[7]; p.conv_w = in[8]; p.conv_b = in[9]; p.lru_wa = in[10]; p.lru_ba = in[11]; p.lru_wx = in[12];
  p.lru_bx = in[13]; p.lru_lambda = in[14]; p.attn_sink = in[15]; p.q_norm_g = in[16]; p.k_norm_g = in[17];
  p.w_branch = in[18]; p.w_out = in[19]; p.final_g = in[20];
  p.out = (float*)d_out;
  char* ws = (char*)d_ws;
  size_t off = 0;
  auto take = [&](size_t bytes) { char* r = ws + off; off += (bytes + 255) & ~(size_t)255; return r; };
  p.ctr = (int*)take(256);
  p.modv = (float*)take((size_t)DEPTH * 17 * 3072 * 4);
  p.sc = (float*)take((size_t)17 * D * 4);
  p.rope = (float*)take(4096 * 4);
  p.xc = (float*)take((size_t)NBATCH * L * D * 4);
  p.WinT = (u16*)take((size_t)DEPTH * INW * D * 2);
  p.WbT = (u16*)take((size_t)DEPTH * 3 * D * D * 2);
  p.WoT = (u16*)take((size_t)DEPTH * D * D * 2);
  const size_t fixed = off;
  int NB = 8;
  while (NB > 1) {
    size_t R = (size_t)NB * (S + L);
    size_t need = fixed + R * (size_t)(1024 + 1024 + 3072 + 2048 + 512 + 512 + 3072) * 2 + 8 * 256;
    if (need <= ws_size) break;
    NB >>= 1;
  }
  p.NB = NB; p.nchunk = NBATCH / NB;
  const size_t R = (size_t)NB * (S + L);
  p.Hb = (u16*)take(R * 1024 * 2);
  p.U = (u16*)take(R * 1024 * 2);
  p.Z = (u16*)take(R * 3072 * 2);
  p.Q = (u16*)take(R * 2048 * 2);
  p.Kb = (u16*)take(R * 512 * 2);
  p.VtL = (u16*)take((size_t)NB * 4 * 128 * S * 2);
  p.VtC = (u16*)take((size_t)NB * 4 * 128 * L * 2);
  p.Ms = (u16*)take(R * 3072 * 2);
  void* args[] = {&p};
  hipError_t e = hipLaunchCooperativeKernel((void*)fwd_megakernel, dim3(grid_blocks), dim3(NTHR), args, 0, stream);
  if (e != hipSuccess) fprintf(stderr, "cooperative launch failed: %s (grid %d)\n", hipGetErrorString(e), grid_blocks);
}
```

```cpp
#include <hip/hip_runtime.h>
#include <hip/hip_cooperative_groups.h>
#include <cstdio>
#include <cstdint>
namespace cg = cooperative_groups;

typedef unsigned short u16;
typedef __attribute__((ext_vector_type(8))) short bf16x8;
typedef __attribute__((ext_vector_type(4))) short s16x4;
typedef __attribute__((ext_vector_type(16))) float f32x16;
typedef __bf16 bf16x2_t __attribute__((ext_vector_type(2)));
typedef float float2_t __attribute__((ext_vector_type(2)));
typedef __attribute__((ext_vector_type(4))) unsigned u32x4;
typedef __attribute__((ext_vector_type(2))) unsigned u32x2;

#define DI __device__ __forceinline__
#define MFMA32(a, b, c) __builtin_amdgcn_mfma_f32_32x32x16_bf16((a), (b), (c), 0, 0, 0)

constexpr int D = 1024, NBATCH = 16, S = 4096, L = 256, DEPTH = 4, INW = 10240;
constexpr int LDS_BYTES = 147456;
constexpr int NTHR = 512;
constexpr float EPS = 1e-6f;
constexpr float QSCALE = 0.08838834764831845f * 1.4426950408889634f;
constexpr float LOG2E = 1.4426950408889634f;

struct Params {
  const float *x, *c, *ctx, *c_ctx, *norm_g, *w_mod, *b_mod, *w_in, *conv_w, *conv_b, *lru_wa, *lru_ba, *lru_wx, *lru_bx,
      *lru_lambda, *attn_sink, *q_norm_g, *k_norm_g, *w_branch, *w_out, *final_g;
  float* out;
  u16 *WinT, *WbT, *WoT;
  u16 *Hb, *U, *Z, *Q, *Kb, *VtL, *VtC, *Ms;
  float *modv, *sc, *rope, *xc;
  int* ctr;
  int NB;
  int nchunk;
};

typedef const __attribute__((address_space(4))) Params CParams;
DI CParams* opaque_kp(CParams* q) { asm volatile("" : "+s"(q)); return q; }

DI unsigned pack2(float a, float b) {
  float2_t f = {a, b};
  bf16x2_t v = __builtin_convertvector(f, bf16x2_t);
  return __builtin_bit_cast(unsigned, v);
}
DI float bf2f(u16 v) { return __uint_as_float(((unsigned)v) << 16); }
DI float bflo(unsigned v) { return __uint_as_float(v << 16); }
DI float bfhi(unsigned v) { return __uint_as_float(v & 0xffff0000u); }
DI float sigmoidf_(float x) { return __builtin_amdgcn_rcpf(1.f + __expf(-x)); }
DI float siluf_(float x) { return x * __builtin_amdgcn_rcpf(1.f + __expf(-x)); }
DI int otid() { int t = threadIdx.x; asm volatile("" : "+v"(t)); return t; }
DI int crow(int i, int hh) { return (i & 3) + 8 * (i >> 2) + 4 * hh; }

DI void phase0(CParams& p, char* lds) {
  const int tid = otid();
  float* tile = (float*)lds;
  const int n_in = DEPTH * 16 * 160, n_b = DEPTH * 3 * 256, n_o = DEPTH * 256;
  for (int it = blockIdx.x; it < n_in + n_b + n_o; it += gridDim.x) {
    const float* src; u16* dst; int ldsrc; int dstride = 64;
    if (it < n_in) {
      int l = it / 2560, rem = it % 2560, kt = rem / 160, nt = rem % 160;
      src = p.w_in + (size_t)l * D * INW + (size_t)(kt * 64) * INW + nt * 64; ldsrc = INW;
      const int o = nt >> 2;
      const int n256 = (o < 8) ? o : (o >= 28) ? 16 + (o - 28) : (o >= 24) ? 12 + (o - 24) : (o == 23) ? 39 : (o == 22) ? 38
                     : (o >= 18) ? 34 + (o - 18) : (o >= 14) ? 8 + (o - 14) : (o == 13) ? 33 : (o == 12) ? 32 : 28 + (o - 8);
      dst = p.WinT + (size_t)l * INW * D + ((size_t)n256 * 256 + (nt & 3) * 64) * D + kt * 64; dstride = D;
    } else if (it < n_in + n_b) {
      int i2 = it - n_in; int mat = i2 / 256, rem = i2 % 256, kt = rem / 16, nt = rem % 16;
      src = p.w_branch + (size_t)mat * D * D + (size_t)(kt * 64) * D + nt * 64; ldsrc = D;
      dst = p.WbT + (size_t)mat * D * D + (size_t)(nt * 64) * D + kt * 64; dstride = D;
    } else {
      int i2 = it - n_in - n_b; int mat = i2 / 256, rem = i2 % 256, kt = rem / 16, nt = rem % 16;
      src = p.w_out + (size_t)mat * D * D + (size_t)(kt * 64) * D + nt * 64; ldsrc = D;
      dst = p.WoT + (size_t)mat * D * D + (size_t)(nt * 64) * D + kt * 64; dstride = D;
    }
    __syncthreads();
#pragma unroll
    for (int i = 0; i < 2; ++i) {
      int c = tid + NTHR * i; int row = c >> 4, c4 = c & 15;
      float4 v = *(const float4*)(src + (size_t)row * ldsrc + c4 * 4);
      float* t = tile + row * 65 + c4 * 4;
      t[0] = v.x; t[1] = v.y; t[2] = v.z; t[3] = v.w;
    }
    __syncthreads();
    {
      int c = tid; int nrow = c >> 3, k8 = c & 7;
      float v[8];
#pragma unroll
      for (int j = 0; j < 8; ++j) v[j] = tile[(k8 * 8 + j) * 65 + nrow];
      uint4 o; o.x = pack2(v[0], v[1]); o.y = pack2(v[2], v[3]); o.z = pack2(v[4], v[5]); o.w = pack2(v[6], v[7]);
      *(uint4*)(dst + (size_t)nrow * dstride + k8 * 8) = o;
    }
  }
  const int gt = blockIdx.x * NTHR + tid, gn = gridDim.x * NTHR;
  for (int i = gt; i < 17 * D; i += gn) {
    int r = i / D, k = i % D;
    float v = (r < 16) ? p.c[r * D + k] : p.c_ctx[k];
    p.sc[i] = siluf_(v);
  }
  for (int i = gt; i < 64 * 32; i += gn) {
    int pos = i >> 5, pp = i & 31;
    float inv = powf(10000.f, -(float)pp / 32.f);
    float ang = (float)pos * inv;
    p.rope[i] = cosf(ang);
    p.rope[2048 + i] = sinf(ang);
  }
  if (blockIdx.x == 0 && tid < 64) p.ctr[tid] = 0;
}

DI void phase_mod(CParams& p, char* lds) {
  const int tid = otid();
  float* red = (float*)lds;
  const int col = tid & 63, kg = tid >> 6;
  for (int it = blockIdx.x; it < DEPTH * 48; it += gridDim.x) {
    int l = it / 48, cb = it % 48;
    float acc[17];
#pragma unroll
    for (int r = 0; r < 17; ++r) acc[r] = 0.f;
    const float* w = p.w_mod + (size_t)l * D * 3072 + cb * 64 + col;
    for (int k = kg * 128; k < kg * 128 + 128; ++k) {
      float wv = w[(size_t)k * 3072];
#pragma unroll
      for (int r = 0; r < 17; ++r) acc[r] += p.sc[r * D + k] * wv;
    }
    __syncthreads();
#pragma unroll
    for (int r = 0; r < 17; ++r) red[(kg * 17 + r) * 64 + col] = acc[r];
    __syncthreads();
    for (int i = tid; i < 17 * 64; i += NTHR) {
      int r = i >> 6, cc = i & 63;
      float s = 0.f;
#pragma unroll
      for (int g = 0; g < 8; ++g) s += red[(g * 17 + r) * 64 + cc];
      p.modv[((size_t)l * 17 + r) * 3072 + cb * 64 + cc] = s + p.b_mod[l * 3072 + cb * 64 + cc];
    }
  }
}

DI void phase_prenorm(CParams& p, int chunk, int l) {
  const int NB = p.NB, RL = NB * S, R = NB * (S + L);
  const int tid_ = otid();
  const int lane = tid_ & 63;
  const int wg = blockIdx.x * 8 + (tid_ >> 6), nw = gridDim.x * 8;
  const float* g = p.norm_g + l * D;
  for (int r = wg; r < R; r += nw) {
    const float* src; int mrow;
    if (r < RL) {
      int b = r / S, t = r % S; int bg = chunk * NB + b;
      src = (l == 0 ? p.x : p.out) + ((size_t)bg * S + t) * D; mrow = bg;
    } else {
      int rc = r - RL; int b = rc / L, t = rc % L; int bg = chunk * NB + b;
      src = (l == 0 ? p.ctx : p.xc) + ((size_t)bg * L + t) * D; mrow = 16;
    }
    const float* mv = p.modv + ((size_t)l * 17 + mrow) * 3072;
    float4 v[4]; float ss = 0.f;
#pragma unroll
    for (int i = 0; i < 4; ++i) {
      v[i] = *(const float4*)(src + i * 256 + lane * 4);
      ss += v[i].x * v[i].x + v[i].y * v[i].y + v[i].z * v[i].z + v[i].w * v[i].w;
    }
#pragma unroll
    for (int o = 32; o >= 1; o >>= 1) ss += __shfl_xor(ss, o);
    float rstd = rsqrtf(ss * (1.f / D) + EPS);
#pragma unroll
    for (int i = 0; i < 4; ++i) {
      int cidx = i * 256 + lane * 4;
      float4 gg = *(const float4*)(g + cidx);
      float4 sh = *(const float4*)(mv + cidx);
      float4 scl = *(const float4*)(mv + 1024 + cidx);
      float h0 = v[i].x * rstd * gg.x * (1.f + scl.x) + sh.x;
      float h1 = v[i].y * rstd * gg.y * (1.f + scl.y) + sh.y;
      float h2 = v[i].z * rstd * gg.z * (1.f + scl.z) + sh.z;
      float h3 = v[i].w * rstd * gg.w * (1.f + scl.w) + sh.w;
      uint2 o; o.x = pack2(h0, h1); o.y = pack2(h2, h3);
      *(uint2*)(p.Hb + (size_t)r * D + cidx) = o;
    }
  }
}

template <int BN, bool PIPE>
DI void gemm_core(const u16* A, int lda, int ksa, size_t a_blk, const u16* Bt, int ldb, int ksb, size_t b_blk, int K, char* ldsc,
                  f32x16 (&acc)[BN / 64][2]) {
  constexpr int MI = BN / 64;
  constexpr int SS = 32768 + BN * 128;
  const int tid = otid(), lane = tid & 63, w = tid >> 6;
  const int wm = (BN == 256) ? (w >> 2) : (w >> 1), wn = (BN == 256) ? (w & 3) : (w & 1);
  const int r = lane & 31, hh = lane >> 5;
  const int drow = lane >> 3, dcp = lane & 7;
  const int chunk0 = dcp ^ (drow >> 1);
  const u16* gAe = A + (size_t)(w >> 2) * a_blk + (size_t)((w & 3) * 32 + drow) * lda + chunk0 * 8;
  const u16* gAo = gAe + (size_t)8 * lda + ((chunk0 ^ 4) - chunk0) * 8;
  const size_t a16 = (size_t)16 * lda;
  const int brow0 = (BN == 256) ? (w & 3) * 32 : w * 16;
  const u16* gBe = Bt + ((BN == 256) ? (size_t)(w >> 2) * b_blk : (size_t)0) + (size_t)(brow0 + drow) * ldb + chunk0 * 8;
  const u16* gBo = gBe + (size_t)8 * ldb + ((chunk0 ^ 4) - chunk0) * 8;
  const size_t b16 = (size_t)16 * ldb;
#pragma unroll
  for (int i = 0; i < MI; ++i)
#pragma unroll
    for (int j = 0; j < 2; ++j)
#pragma unroll
      for (int x = 0; x < 16; ++x) acc[i][j][x] = 0.f;
  auto DMA = [&](int kt, int stage) {
    char* sa = ldsc + stage * SS + (w * 4) * 1024;
    char* sb = ldsc + stage * SS + 32768 + ((BN == 256) ? (w * 4) : (w * 2)) * 1024;
    const size_t ka = (size_t)kt * ksa, kb = (size_t)kt * ksb;
    __builtin_amdgcn_global_load_lds((const unsigned*)(gAe + ka), (unsigned*)(sa), 16, 0, 0);
    __builtin_amdgcn_global_load_lds((const unsigned*)(gBe + kb), (unsigned*)(sb), 16, 0, 0);
    __builtin_amdgcn_global_load_lds((const unsigned*)(gAo + ka), (unsigned*)(sa + 1024), 16, 0, 0);
    __builtin_amdgcn_global_load_lds((const unsigned*)(gBo + kb), (unsigned*)(sb + 1024), 16, 0, 0);
    __builtin_amdgcn_global_load_lds((const unsigned*)(gAe + a16 + ka), (unsigned*)(sa + 2048), 16, 0, 0);
    __builtin_amdgcn_global_load_lds((const unsigned*)(gAo + a16 + ka), (unsigned*)(sa + 3072), 16, 0, 0);
    if (BN == 256) {
      __builtin_amdgcn_global_load_lds((const unsigned*)(gBe + b16 + kb), (unsigned*)(sb + 2048), 16, 0, 0);
      __builtin_amdgcn_global_load_lds((const unsigned*)(gBo + b16 + kb), (unsigned*)(sb + 3072), 16, 0, 0);
    }
  };
  const int sw = (r >> 1) & 7;
  int koff[4];
#pragma unroll
  for (int ks = 0; ks < 4; ++ks) koff[ks] = ((2 * ks + hh) ^ sw) << 4;
  auto COMPUTE = [&](int stage) {
    const char* ab = ldsc + stage * SS + (wm * (MI * 32) + r) * 128;
    const char* bb = ldsc + stage * SS + 32768 + (wn * 64 + r) * 128;
    bf16x8 fa[2][MI], fb[2][2];
    auto LDF = [&](int ks, int slot) {
#pragma unroll
      for (int i = 0; i < MI; ++i) fa[slot][i] = *(const bf16x8*)(ab + i * 32 * 128 + koff[ks]);
#pragma unroll
      for (int j = 0; j < 2; ++j) fb[slot][j] = *(const bf16x8*)(bb + j * 32 * 128 + koff[ks]);
    };
    auto MM = [&](int slot) {
#pragma unroll
      for (int i = 0; i < MI; ++i)
#pragma unroll
        for (int j = 0; j < 2; ++j) acc[i][j] = MFMA32(fb[slot][j], fa[slot][i], acc[i][j]);
    };
    if (!PIPE) {
#pragma unroll
      for (int ks = 0; ks < 4; ++ks) { LDF(ks, 0); MM(0); }
      return;
    }
    LDF(0, 0); LDF(1, 1);
    __builtin_amdgcn_sched_barrier(0);
    MM(0); LDF(2, 0);
    __builtin_amdgcn_sched_barrier(0);
    MM(1); LDF(3, 1);
    __builtin_amdgcn_sched_barrier(0);
    MM(0); MM(1);
  };
  const int KT = K >> 6;
  __syncthreads();
  DMA(0, 0);
  __syncthreads();
  for (int kt = 0; kt < KT; kt += 2) {
    DMA(kt + 1, 1);
    COMPUTE(0);
    __syncthreads();
    if (kt + 2 < KT) DMA(kt + 2, 0);
    COMPUTE(1);
    __syncthreads();
  }
}

template <int MI>
DI void stage_acc(char* ldsc, f32x16 (&acc)[MI][2], int wm, int ncol0, bool active) {
  const int tid = otid(), lane = tid & 63;
  const int r = lane & 31, hh = lane >> 5;
  float* Cs = (float*)ldsc;
  if (active) {
#pragma unroll
    for (int i = 0; i < MI; ++i)
#pragma unroll
      for (int j = 0; j < 2; ++j)
#pragma unroll
        for (int g = 0; g < 4; ++g) {
          int m = wm * (MI * 32) + i * 32 + r;
          int n = ncol0 + j * 32 + 8 * g + 4 * hh;
          float4 v; v.x = acc[i][j][4 * g]; v.y = acc[i][j][4 * g + 1]; v.z = acc[i][j][4 * g + 2]; v.w = acc[i][j][4 * g + 3];
          *(float4*)(Cs + m * 132 + n) = v;
        }
  }
  __syncthreads();
}

DI void read_row64(const char* ldsc, int row, int half, float (&v)[64]) {
  const float* Cs = (const float*)ldsc + row * 132 + half * 64;
#pragma unroll
  for (int j = 0; j < 16; ++j) {
    float4 t = *(const float4*)(Cs + j * 4);
    v[j * 4] = t.x; v[j * 4 + 1] = t.y; v[j * 4 + 2] = t.z; v[j * 4 + 3] = t.w;
  }
}

DI void store_row64_bf16(u16* dst, const float (&v)[64]) {
#pragma unroll
  for (int j = 0; j < 8; ++j) {
    uint4 o;
    o.x = pack2(v[j * 8], v[j * 8 + 1]); o.y = pack2(v[j * 8 + 2], v[j * 8 + 3]);
    o.z = pack2(v[j * 8 + 4], v[j * 8 + 5]); o.w = pack2(v[j * 8 + 6], v[j * 8 + 7]);
    *(uint4*)(dst + j * 8) = o;
  }
}

namespace pg8 {
#define PG8_LAS __attribute__((address_space(3)))
typedef unsigned short bf16_t;
typedef short bf16x8 __attribute__((ext_vector_type(8)));
typedef float f32x4 __attribute__((ext_vector_type(4)));
typedef unsigned u32x4 __attribute__((ext_vector_type(4)));
constexpr int BM = 256, BK = 64, HALF = 128, HTB = HALF * BK * 2  , STAGE_BYTES = 8 * HTB, NXCD = 8, WGM = 8;

__host__ __device__ __forceinline__ int lds_byte(int r, int c) { const int st = (r >> 4) * 2 + (c >> 5), rr = r & 15, cc = c & 31, ob = rr * 64 + cc * 2; return st * 1024 + (ob ^ (((ob >> 9) & 1) << 5)); }
__host__ __device__ __forceinline__ void stage_rc(int b, int& R, int& C) { const int st = b / 1024, sb = b % 1024, swz = sb ^ (((sb >> 9) & 1) << 5); R = (st >> 1) * 16 + swz / 64; C = (st & 1) * 32 + (swz % 64) / 2; }
__host__ __device__ __forceinline__ int perm32(int rho) { const int n = rho >> 4, i = rho & 15; return 8 * (i >> 2) + 4 * n + (i & 3); }
struct Unit { int pm, pn; };
struct Gemm { const bf16_t* A; const bf16_t* Bt; int M, N, K; int lda; };
struct StaticOrder {
    int nM, nN, nwg, G, c;
    __host__ __device__ void init(int M, int N, int G_, int c_) { nM = M / BM; nN = N / BM; nwg = nM * nN; G = G_; c = c_; }
    __host__ __device__ bool next(int i, Unit& u) const {
        const long L = (long)i * G + c; if (L >= nwg) return false;
        int wgid = (int)L; { const int q = nwg / NXCD, r = nwg % NXCD, xcd = wgid % NXCD, off = wgid / NXCD; wgid = (xcd < r ? xcd * (q + 1) : r * (q + 1) + (xcd - r) * q) + off; }
        const int nig = WGM * nN, gid = wgid / nig, fm = gid * WGM, gsz = (nM - fm) < WGM ? (nM - fm) : WGM;
        u.pm = fm + ((wgid % nig) % gsz); u.pn = (wgid % nig) / gsz; return true;
    }
    __device__ __forceinline__ void a_ready(const Unit&) const {}
    __device__ __forceinline__ void done(const Unit&) const {}
    __device__ __forceinline__ size_t a_off(const Unit&) const { return 0; }
};
template <class Epi, class Sched, bool STAMP = false>
__device__ __forceinline__ void gemm_phase(PG8_LAS unsigned char* lds, const Gemm g, const Sched& S, const Epi& E, unsigned long long* stamps) {
    int tid_raw = threadIdx.x; asm volatile("" : "+v"(tid_raw));
    const int tid = tid_raw, wid = __builtin_amdgcn_readfirstlane(tid >> 6), lane = tid & 63, wr = wid >> 2, wc = wid & 3, fr = lane & 15, fq = lane >> 4;
    const int K = g.K, nt = K / BK;
    int ts_lo = 0, ts_hi = 0, nts = 0; const unsigned long long rt_entry = STAMP ? (unsigned long long)wall_clock64() : 0ull;
#define PG8_STAMP() do { if (STAMP && wid == 0 && nts < 64) { const unsigned long long _c = (unsigned long long)clock64(); \
        ts_lo = (lane == nts) ? (int)(unsigned)_c : ts_lo; ts_hi = (lane == nts) ? (int)(unsigned)(_c >> 32) : ts_hi; ++nts; } } while (0)
    PG8_STAMP();
    unsigned voffA[2], voffB[2];
#pragma unroll
    for (int i = 0; i < 2; ++i) { int R, C; stage_rc(tid * 16 + i * 8192, R, C); const int Rb = Epi::PERM ? ((R & ~31) + perm32(R & 31)) : R;
        voffA[i] = (unsigned)(R * g.lda + C) * 2u; voffB[i] = (unsigned)(Rb * K + C) * 2u; }
    const size_t kstep = (size_t)(BK * 2);
    const size_t hstep = (size_t)HALF * K * 2;
    const size_t tstep = 2 * hstep;
    const size_t hstepA = (size_t)HALF * g.lda * 2, tstepA = 2 * hstepA;
    const unsigned ldsw = (unsigned)wid * 1024u;
    const int aoff = lds_byte(wr * 64 + fr, fq * 8), boff = lds_byte(wc * 32 + fr, fq * 8);
#define PG8_SA(b, h) (((b) * 2 + (h)) * HTB)
#define PG8_SB(b, h) ((4 + (b) * 2 + (h)) * HTB)
#define PG8_STAGE(bufoff, gbase, voff) do { _Pragma("unroll") for (int _i = 0; _i < 2; ++_i) \
        __builtin_amdgcn_global_load_lds((const unsigned*)((const char*)(gbase) + (voff)[_i]), (PG8_LAS unsigned*)(lds + (bufoff) + ldsw + _i * 8192), 16, 0, 0); } while (0)
#define PG8_LDA(dst, b, h) do { _Pragma("unroll") for (int m = 0; m < 4; ++m) _Pragma("unroll") for (int k = 0; k < 2; ++k) dst[m][k] = *(const PG8_LAS bf16x8*)(lds + PG8_SA(b, h) + aoff + m * 2048 + k * 1024); } while (0)
#define PG8_LDB(dst, b, h) do { _Pragma("unroll") for (int n = 0; n < 2; ++n) _Pragma("unroll") for (int k = 0; k < 2; ++k) dst[n][k] = *(const PG8_LAS bf16x8*)(lds + PG8_SB(b, h) + boff + n * 2048 + k * 1024); } while (0)
#define PG8_MMA(ai, bj, At, Bt) do { __builtin_amdgcn_s_setprio(1); _Pragma("unroll") for (int m = 0; m < 4; ++m) _Pragma("unroll") for (int n = 0; n < 2; ++n) _Pragma("unroll") for (int k = 0; k < 2; ++k) \
        acc[ai][bj][m][n] = __builtin_amdgcn_mfma_f32_16x16x32_bf16(Bt[n][k], At[m][k], acc[ai][bj][m][n], 0, 0, 0); __builtin_amdgcn_s_setprio(0); } while (0)
#define PG8_WAIT_V(n) asm volatile("s_waitcnt vmcnt(" #n ")" ::: "memory")
#define PG8_WAIT_L(n) asm volatile("s_waitcnt lgkmcnt(" #n ")" ::: "memory")
#define PG8_BAR __builtin_amdgcn_s_barrier()
#define PG8_SCHED __builtin_amdgcn_sched_barrier(0)
    Unit cur, nxt; int ui = 0;
    if (!S.next(0, cur)) return;
    f32x4 acc[2][2][4][2];
#pragma unroll
    for (int a = 0; a < 2; ++a)
#pragma unroll
        for (int b = 0; b < 2; ++b)
#pragma unroll
            for (int m = 0; m < 4; ++m)
#pragma unroll
                for (int n = 0; n < 2; ++n) acc[a][b][m][n] = (f32x4){0.f, 0.f, 0.f, 0.f};
    bf16x8 At[4][2], B0[2][2], B1[2][2];
    const char* cA = (const char*)g.A + (size_t)cur.pm * tstepA + S.a_off(cur); const char* cB = (const char*)g.Bt + (size_t)cur.pn * tstep;
    S.a_ready(cur);
    PG8_STAGE(PG8_SB(0, 0), cB, voffB); PG8_STAGE(PG8_SA(0, 0), cA, voffA); PG8_STAGE(PG8_SB(0, 1), cB + hstep, voffB); PG8_STAGE(PG8_SA(0, 1), cA + hstepA, voffA);
    if (wr == 1) PG8_BAR;
    PG8_WAIT_V(4); PG8_BAR;
    PG8_STAGE(PG8_SB(1, 0), cB + kstep, voffB); PG8_STAGE(PG8_SA(1, 0), cA + kstep, voffA); PG8_STAGE(PG8_SB(1, 1), cB + hstep + kstep, voffB);
    PG8_WAIT_V(6); PG8_BAR;
    PG8_STAMP();
    for (;;) {
        const bool has_next = S.next(ui + 1, nxt);
        const char* nA = has_next ? (const char*)g.A + (size_t)nxt.pm * tstepA + S.a_off(nxt) : cA; const char* nB = has_next ? (const char*)g.Bt + (size_t)nxt.pn * tstep : cB;
        for (int t = 0; t < nt; t += 2) {
            const bool last = (t == nt - 2);
            const char* a1 = cA + (size_t)(t + 1) * kstep;
            const char* a2 = last ? nA : cA + (size_t)(t + 2) * kstep; const char* b2 = last ? nB : cB + (size_t)(t + 2) * kstep;
            const char* a3 = a2 + kstep; const char* b3 = b2 + kstep;
            if (last && has_next) S.a_ready(nxt);
            PG8_LDB(B0, 0, 0); PG8_SCHED; PG8_LDA(At, 0, 0); PG8_STAGE(PG8_SA(1, 1), a1 + hstepA, voffA);
            PG8_WAIT_L(8); PG8_BAR; PG8_WAIT_L(0); PG8_MMA(0, 0, At, B0); PG8_BAR; PG8_SCHED;
            PG8_LDB(B1, 0, 1); PG8_STAGE(PG8_SB(0, 0), b2, voffB);
            PG8_BAR; PG8_WAIT_L(0); PG8_MMA(0, 1, At, B1); PG8_BAR;
            PG8_LDA(At, 0, 1); PG8_STAGE(PG8_SA(0, 0), a2, voffA);
            PG8_BAR; PG8_WAIT_L(0); PG8_MMA(1, 0, At, B0); PG8_BAR; PG8_SCHED;
            PG8_STAGE(PG8_SB(0, 1), b2 + hstep, voffB);
            PG8_WAIT_V(6); PG8_BAR; PG8_MMA(1, 1, At, B1); PG8_BAR;
            PG8_LDB(B0, 1, 0); PG8_SCHED; PG8_LDA(At, 1, 0); PG8_STAGE(PG8_SA(0, 1), a2 + hstepA, voffA);
            PG8_WAIT_L(8); PG8_BAR; PG8_WAIT_L(0); PG8_MMA(0, 0, At, B0); PG8_BAR; PG8_SCHED;
            PG8_LDB(B1, 1, 1); PG8_STAGE(PG8_SB(1, 0), b3, voffB);
            PG8_BAR; PG8_WAIT_L(0); PG8_MMA(0, 1, At, B1); PG8_BAR;
            PG8_LDA(At, 1, 1); PG8_STAGE(PG8_SA(1, 0), a3, voffA);
            PG8_BAR; PG8_WAIT_L(0); PG8_MMA(1, 0, At, B0); PG8_BAR; PG8_SCHED;
            PG8_STAGE(PG8_SB(1, 1), b3 + hstep, voffB);
            PG8_WAIT_V(6); PG8_BAR; PG8_MMA(1, 1, At, B1); PG8_BAR;
        }
        PG8_STAMP();
        if constexpr (!Epi::AFTER_DRAIN) { E(acc, cur, wr, wc, fr, fq); S.done(cur); }
        PG8_STAMP();
        if (!has_next) break;
#pragma unroll
        for (int a = 0; a < 2; ++a)
#pragma unroll
            for (int b = 0; b < 2; ++b)
#pragma unroll
                for (int m = 0; m < 4; ++m)
#pragma unroll
                    for (int n = 0; n < 2; ++n) acc[a][b][m][n] = (f32x4){0.f, 0.f, 0.f, 0.f};
        cur = nxt; cA = nA; cB = nB; ++ui;
    }
    PG8_WAIT_V(0);
    if (wr == 0) PG8_BAR;
    PG8_BAR;
    if constexpr (Epi::AFTER_DRAIN) { E.fused(acc, cur, wr, wc, fr, fq, lds, wid, lane); S.done(cur); }
    PG8_STAMP();
    if (STAMP && wid == 0) { stamps[lane] = lane < nts ? (((unsigned long long)(unsigned)ts_hi << 32) | (unsigned)ts_lo) : 0ull;
        if (lane == 62) stamps[62] = rt_entry; if (lane == 63) stamps[63] = (unsigned long long)wall_clock64(); }
#undef PG8_STAMP
#undef PG8_SA
#undef PG8_SB
#undef PG8_STAGE
#undef PG8_LDA
#undef PG8_LDB
#undef PG8_MMA
#undef PG8_WAIT_V
#undef PG8_WAIT_L
#undef PG8_BAR
#undef PG8_SCHED
}
}

struct EpiIn {
  static constexpr bool PERM = true, AFTER_DRAIN = false;
  CParams* kp;
  __device__ __forceinline__ void operator()(const pg8::f32x4 (&acc)[2][2][4][2], const pg8::Unit& u, int wr, int wc, int fr, int fq) const {
    const int pn = u.pn;
    u16* base; int ld, mode;
    if (pn < 4) { base = kp->U + pn * 256; ld = D; mode = 0; }
    else if (pn < 16) { base = kp->Z + (pn - 4) * 256; ld = 3072; mode = 1; }
    else { base = kp->Ms + (pn - 16) * 256; ld = 3072; mode = 2; }
    const int row0 = u.pm * 256 + wr * 64 + fr;
    const int col0 = wc * 32 + 8 * fq;
    u16* rowp0 = base + (size_t)row0 * ld + col0;
#pragma unroll
    for (int ai = 0; ai < 2; ++ai)
#pragma unroll
      for (int m = 0; m < 4; ++m)
#pragma unroll
        for (int bj = 0; bj < 2; ++bj) {
          pg8::f32x4 v0 = acc[ai][bj][m][0], v1 = acc[ai][bj][m][1];
          if (mode == 1) {
#pragma unroll
            for (int j = 0; j < 4; ++j) { v0[j] = siluf_(v0[j]); v1[j] = siluf_(v1[j]); }
          } else if (mode == 2) {
#pragma unroll
            for (int j = 0; j < 4; ++j) { v0[j] = sigmoidf_(v0[j]); v1[j] = sigmoidf_(v1[j]); }
          }
          u32x4 w; w.x = pack2(v0[0], v0[1]); w.y = pack2(v0[2], v0[3]); w.z = pack2(v1[0], v1[1]); w.w = pack2(v1[2], v1[3]);
          *(u32x4*)(rowp0 + (size_t)(ai * 128 + m * 16) * ld + bj * 128) = w;
        }
  }
};


DI bool tile_map(int i, int MT, int NT, int& mt, int& nt) {
  const int G = gridDim.x, bid = blockIdx.x;
  if ((G & 63) == 0 && (MT & 7) == 0 && (NT % (G >> 6)) == 0) {
    const int SH = G >> 6;
    const int xcd = bid & 7, slot = bid >> 3;
    const int sx = slot & 7, sy = slot >> 3;
    const int nsn = NT / SH, nsm = MT >> 3;
    const int st = i * 8 + xcd;
    if (st >= nsm * nsn) return false;
    mt = (st / nsn) * 8 + sx;
    nt = (st % nsn) * SH + sy;
    return true;
  }
  const int it = bid + i * G;
  if (it >= MT * NT) return false;
  mt = it / NT; nt = it % NT;
  return true;
}


struct OneUnit {
  int pm, pn;
  __device__ bool next(int i, pg8::Unit& u) const { if (i) return false; u.pm = pm; u.pn = pn; return true; }
  __device__ __forceinline__ void a_ready(const pg8::Unit&) const {}
  __device__ __forceinline__ void done(const pg8::Unit&) const {}
  __device__ __forceinline__ size_t a_off(const pg8::Unit&) const { return 0; }
};
struct EpiQKV {
  static constexpr bool PERM = false, AFTER_DRAIN = true;
  CParams* kp; char* lds; int l, nt, m0;
  __device__ __forceinline__ void fused(const pg8::f32x4 (&acc)[2][2][4][2], const pg8::Unit&, int wr, int wc, int fr, int fq,
                                        PG8_LAS unsigned char*, int, int) const {
    CParams& p = *kp;
    const int NB = p.NB, RL = NB * S;
    const int tid = otid();
    const bool lat = m0 < RL;
    int b, t0;
    if (lat) { b = m0 / S; t0 = m0 % S; } else { int rc = m0 - RL; b = rc / L; t0 = rc % L; }
    const bool isV = (nt == 13 || nt == 23);
    const bool isC = nt >= 18;
    const bool isQ = (nt >= 8 && nt < 12) || (nt >= 18 && nt < 22);
    auto process_unit = [&](int hsel, int u) {
      if (isV) {
        const int slot = (isC ? 2 : 0) + hsel;
        const int d = u >> 2, tq = u & 3;
        const float* Cs = (const float*)lds;
        u16* dst = lat ? p.VtL + ((size_t)(b * 4 + slot) * 128 + d) * S + t0 + tq * 64
                       : p.VtC + ((size_t)(b * 4 + slot) * 128 + d) * L + t0 + tq * 64;
#pragma unroll 1
        for (int c = 0; c < 4; ++c) {
          float v[16];
#pragma unroll
          for (int j = 0; j < 16; ++j) v[j] = Cs[(tq * 64 + c * 16 + j) * 132 + d];
          uint4 o0, o1;
          o0.x = pack2(v[0], v[1]); o0.y = pack2(v[2], v[3]); o0.z = pack2(v[4], v[5]); o0.w = pack2(v[6], v[7]);
          o1.x = pack2(v[8], v[9]); o1.y = pack2(v[10], v[11]); o1.z = pack2(v[12], v[13]); o1.w = pack2(v[14], v[15]);
          *(uint4*)(dst + c * 16) = o0;
          *(uint4*)(dst + c * 16 + 8) = o1;
        }
      } else {
        const int row = u >> 1, half = u & 1;
        const size_t gr = (size_t)m0 + row;
        const int t = t0 + row;
        const float* Cr = (const float*)lds + row * 132 + half * 64;
        float rstd = 1.f;
        const float* gn = (isQ ? p.q_norm_g : p.k_norm_g) + l * 128 + half * 64;
        if (isC) {
          float ss = 0.f;
#pragma unroll
          for (int j = 0; j < 16; ++j) {
            float4 tv = *(const float4*)(Cr + j * 4);
            ss += tv.x * tv.x + tv.y * tv.y + tv.z * tv.z + tv.w * tv.w;
          }
          ss += __shfl_xor(ss, 1);
          rstd = rsqrtf(ss * (1.f / 128.f) + EPS);
        }
        const int pos = (half == 0) ? (t >> 6) : (t & 63);
        const float* cs = p.rope + pos * 32;
        const float* sn = p.rope + 2048 + pos * 32;
        u16* dst;
        if (isQ) {
          const int head = (isC ? (nt - 18) : (nt - 8)) * 2 + hsel;
          dst = p.Q + gr * 2048 + (isC ? 1024 : 0) + head * 128 + half * 64;
        } else {
          dst = p.Kb + gr * 512 + (isC ? 256 : 0) + hsel * 128 + half * 64;
        }
#pragma unroll 1
        for (int c = 0; c < 2; ++c) {
          float x0[16], x1[16];
#pragma unroll
          for (int j = 0; j < 4; ++j) {
            float4 ta_ = *(const float4*)(Cr + c * 16 + j * 4);
            float4 tb_ = *(const float4*)(Cr + 32 + c * 16 + j * 4);
            x0[4 * j] = ta_.x; x0[4 * j + 1] = ta_.y; x0[4 * j + 2] = ta_.z; x0[4 * j + 3] = ta_.w;
            x1[4 * j] = tb_.x; x1[4 * j + 1] = tb_.y; x1[4 * j + 2] = tb_.z; x1[4 * j + 3] = tb_.w;
          }
          if (isC) {
#pragma unroll
            for (int j = 0; j < 16; ++j) { x0[j] = x0[j] * rstd * gn[c * 16 + j]; x1[j] = x1[j] * rstd * gn[32 + c * 16 + j]; }
          }
          if (lat) {
#pragma unroll
            for (int j = 0; j < 16; ++j) {
              float c_ = cs[c * 16 + j], s_ = sn[c * 16 + j];
              float a0 = x0[j], a1 = x1[j];
              x0[j] = a0 * c_ - a1 * s_;
              x1[j] = a1 * c_ + a0 * s_;
            }
          }
          if (isQ) {
#pragma unroll
            for (int j = 0; j < 16; ++j) { x0[j] *= QSCALE; x1[j] *= QSCALE; }
          }
          uint4 o0, o1, o2, o3;
          o0.x = pack2(x0[0], x0[1]); o0.y = pack2(x0[2], x0[3]); o0.z = pack2(x0[4], x0[5]); o0.w = pack2(x0[6], x0[7]);
          o1.x = pack2(x0[8], x0[9]); o1.y = pack2(x0[10], x0[11]); o1.z = pack2(x0[12], x0[13]); o1.w = pack2(x0[14], x0[15]);
          o2.x = pack2(x1[0], x1[1]); o2.y = pack2(x1[2], x1[3]); o2.z = pack2(x1[4], x1[5]); o2.w = pack2(x1[6], x1[7]);
          o3.x = pack2(x1[8], x1[9]); o3.y = pack2(x1[10], x1[11]); o3.z = pack2(x1[12], x1[13]); o3.w = pack2(x1[14], x1[15]);
          *(uint4*)(dst + c * 16) = o0;
          *(uint4*)(dst + c * 16 + 8) = o1;
          *(uint4*)(dst + 32 + c * 16) = o2;
          *(uint4*)(dst + 32 + c * 16 + 8) = o3;
        }
      }
    };

#pragma unroll
    for (int bj = 0; bj < 2; ++bj) {
      float* Cs = (float*)lds;
#pragma unroll
      for (int ai = 0; ai < 2; ++ai)
#pragma unroll
        for (int m = 0; m < 4; ++m)
#pragma unroll
          for (int n = 0; n < 2; ++n) {
            const int row = ai * 128 + wr * 64 + m * 16 + fr;
            const int col = wc * 32 + n * 16 + fq * 4;
            pg8::f32x4 v = acc[ai][bj][m][n];
            float4 o; o.x = v[0]; o.y = v[1]; o.z = v[2]; o.w = v[3];
            *(float4*)(Cs + row * 132 + col) = o;
          }
      __syncthreads();
      process_unit(bj, tid);
      __syncthreads();
    }
  }
};

DI void phase_gemm_in(CParams& p, int chunk, int l, char* lds) {
  const int NB = p.NB, RL = NB * S, R = NB * (S + L);
  const int MT = R / 256;
  const u16* Wt = p.WinT + (size_t)l * INW * D;
  {
    pg8::Gemm g{p.Hb, Wt, R, 7168, D, D};
    pg8::StaticOrder So; So.init(R, 7168, (int)gridDim.x, (int)blockIdx.x);
    EpiIn E{&p};
    pg8::gemm_phase<EpiIn, pg8::StaticOrder, false>((PG8_LAS unsigned char*)lds, g, So, E, nullptr);
  }
  for (int ti = 0;; ++ti) {
    int mt, jt;
    if (!tile_map(ti, MT, 12, mt, jt)) break;
    const int nt = (jt < 6) ? 8 + jt : 12 + jt;
    pg8::Gemm g{p.Hb, Wt + (size_t)28 * 256 * D, R, 3072, D, D};
    OneUnit One{mt, jt};
    EpiQKV E{&p, lds, l, nt, mt * 256};
    pg8::gemm_phase<EpiQKV, OneUnit, false>((PG8_LAS unsigned char*)lds, g, One, E, nullptr);
  }
}

struct AttnArgs {
  const u16* q;
  u16* z;
  const u16* kctx;
  const u16* vctx;
  const u16* klat;
  const u16* vlat;
  int n_lat_tiles;
  int lat_key0;
  int q_t0;
  int band;
  int has_sink;
  float sink_l2;
  int dry;
  int fixedm;
  float mfix;
};

DI void attn_load_tile(const AttnArgs& a, int ti, u32x4 (&rk)[2], u32x4 (&rv)[2]) {
  const int tid = otid();
  const u16* kp; const u16* vp; int vs;
  if (ti < 4) { kp = a.kctx + (size_t)(ti * 64) * 512; vp = a.vctx + ti * 64; vs = L; }
  else { kp = a.klat + (size_t)((ti - 4) * 64) * 512; vp = a.vlat + (ti - 4) * 64; vs = S; }
#pragma unroll
  for (int i = 0; i < 2; ++i) {
    int c = tid + NTHR * i;
    rk[i] = *(const u32x4*)(kp + (size_t)(c >> 4) * 512 + (c & 15) * 8);
    rv[i] = *(const u32x4*)(vp + (size_t)(c >> 3) * vs + (c & 7) * 8);
  }
}
DI void attn_store_tile(u16* sK, u16* sV, const u32x4 (&rk)[2], const u32x4 (&rv)[2]) {
  const int tid = otid();
#pragma unroll
  for (int i = 0; i < 2; ++i) {
    int c = tid + NTHR * i;
    *(u32x4*)(sK + (c >> 4) * 136 + (c & 15) * 8) = rk[i];
    u16* vd = sV + (c >> 3) * 72 + ((c & 7) >> 1) * 16 + ((c & 7) & 1) * 4;
    { u32x2 t0 = {rv[i].x, rv[i].y}; *(u32x2*)(vd) = t0; }
    { u32x2 t1 = {rv[i].z, rv[i].w}; *(u32x2*)(vd + 8) = t1; }
  }
}

template <bool NS>
DI void attn_item(const AttnArgs& a, char* lds) {
  const int tid = otid(), lane = tid & 63, w = tid >> 6;
  const int r = lane & 31, hh = lane >> 5;
  constexpr int STG = 17408 + 128 * 144;
  const int ntiles = 4 + a.n_lat_tiles;

  bf16x8 qf[8];
  {
    const u16* qp = a.q + (size_t)(w * 32 + r) * 2048 + hh * 8;
#pragma unroll
    for (int ks = 0; ks < 8; ++ks) qf[ks] = *(const bf16x8*)(qp + ks * 16);
  }
  f32x16 O[4];
#pragma unroll
  for (int dt = 0; dt < 4; ++dt)
#pragma unroll
    for (int x = 0; x < 16; ++x) O[dt][x] = 0.f;
  float m = a.fixedm ? a.mfix : (a.has_sink ? a.sink_l2 : -1e30f);
  float lsum = (a.has_sink && hh == 0) ? 1.f : 0.f;
  const int qpos = a.q_t0 + w * 32 + r;

  auto QK = [&](int stage, f32x16 (&sc)[2]) {
    const u16* sK = (const u16*)(lds + stage * STG);
#pragma unroll
    for (int x = 0; x < 16; ++x) { sc[0][x] = 0.f; sc[1][x] = 0.f; }
    const u16* kb0 = sK + r * 136 + hh * 8;
    const u16* kb1 = sK + (32 + r) * 136 + hh * 8;
#pragma unroll
    for (int ks = 0; ks < 8; ++ks) {
      bf16x8 ka0 = *(const bf16x8*)(kb0 + ks * 16);
      bf16x8 ka1 = *(const bf16x8*)(kb1 + ks * 16);
      sc[0] = MFMA32(ka0, qf[ks], sc[0]);
      sc[1] = MFMA32(ka1, qf[ks], sc[1]);
    }
  };
  u32x4 rk[2], rv[2], rk1[2], rv1[2];
  auto STEP = [&](int ti, int st, f32x16 (&sc)[2], f32x16 (&sn)[2], u32x4 (&lk)[2], u32x4 (&lv)[2], u32x4 (&sk)[2], u32x4 (&sv)[2]) {
    const int st1 = (st == 2) ? 0 : st + 1, st2 = (st == 0) ? 2 : st - 1;
    if (ti + 3 < ntiles) attn_load_tile(a, ti + 3, lk, lv);
    if (ti + 1 < ntiles) QK(st1, sn);
    if (a.band && ti >= 4) {
      const int k0 = a.lat_key0 + (ti - 4) * 64;
#pragma unroll
      for (int kt2 = 0; kt2 < 2; ++kt2)
#pragma unroll
        for (int x = 0; x < 16; ++x) {
          int kp = k0 + kt2 * 32 + crow(x, hh);
          int dlt = kp - qpos; dlt = dlt < 0 ? -dlt : dlt;
          if (dlt > 128) sc[kt2][x] = -1e30f;
        }
    }
    if (!NS && !a.fixedm) {
      float mx = sc[0][0];
#pragma unroll
      for (int kt2 = 0; kt2 < 2; ++kt2)
#pragma unroll
        for (int x = 0; x < 16; ++x) mx = fmaxf(mx, sc[kt2][x]);
      mx = fmaxf(mx, __shfl_xor(mx, 32));
      if (__any(mx > m + 8.f)) {
        const float mnew = fmaxf(m, mx);
        const float alpha = __builtin_amdgcn_exp2f(m - mnew);
        m = mnew;
        lsum *= alpha;
#pragma unroll
        for (int dt = 0; dt < 4; ++dt)
#pragma unroll
          for (int x = 0; x < 16; ++x) O[dt][x] *= alpha;
      }
    }
    float ps = 0.f;
#pragma unroll
    for (int kt2 = 0; kt2 < 2; ++kt2)
#pragma unroll
      for (int x = 0; x < 16; ++x) { float pv = NS ? __builtin_amdgcn_exp2f(sc[kt2][x]) : __builtin_amdgcn_exp2f(sc[kt2][x] - m); sc[kt2][x] = pv; ps += pv; }
    lsum += ps;
    const u16* sV = (const u16*)(lds + st * STG + 17408);
#pragma unroll
    for (int kt2 = 0; kt2 < 2; ++kt2)
#pragma unroll
      for (int s2 = 0; s2 < 2; ++s2) {
        union { unsigned u[4]; bf16x8 v; } pf;
#pragma unroll
        for (int j = 0; j < 4; ++j) pf.u[j] = pack2(sc[kt2][8 * s2 + 2 * j], sc[kt2][8 * s2 + 2 * j + 1]);
        const u16* vb = sV + r * 72 + kt2 * 32 + 16 * s2 + 8 * hh;
#pragma unroll
        for (int dt = 0; dt < 4; ++dt) {
          bf16x8 va = *(const bf16x8*)(vb + dt * 32 * 72);
          O[dt] = MFMA32(va, pf.v, O[dt]);
        }
      }
    if (ti + 2 < ntiles) attn_store_tile((u16*)(lds + st2 * STG), (u16*)(lds + st2 * STG + 17408), sk, sv);
    asm volatile("s_waitcnt lgkmcnt(0)" ::: "memory");
    __builtin_amdgcn_s_barrier();
    asm volatile("" ::: "memory");
  };

  attn_load_tile(a, 0, rk, rv);
  __syncthreads();
  attn_store_tile((u16*)lds, (u16*)(lds + 17408), rk, rv);
  attn_load_tile(a, 1, rk, rv);
  attn_store_tile((u16*)(lds + STG), (u16*)(lds + STG + 17408), rk, rv);
  attn_load_tile(a, 2, rk, rv);
  __syncthreads();
  f32x16 sA[2], sB[2];
  QK(0, sA);
  int st = 0;
  for (int ti = 0; ti < ntiles; ti += 2) {
    STEP(ti, st, sA, sB, rk1, rv1, rk, rv);
    st = (st == 2) ? 0 : st + 1;
    if (ti + 1 < ntiles) {
      STEP(ti + 1, st, sB, sA, rk, rv, rk1, rv1);
      st = (st == 2) ? 0 : st + 1;
    }
  }
  float ltot = lsum + __shfl_xor(lsum, 32);
  const float inv = 1.f / ltot;
  u16* zp = a.z + (size_t)(w * 32 + r) * 3072;
  u32x2 gv[4][4];
#pragma unroll
  for (int dt = 0; dt < 4; ++dt)
#pragma unroll
    for (int g4 = 0; g4 < 4; ++g4) gv[dt][g4] = *(const u32x2*)(zp + dt * 32 + 8 * g4 + 4 * hh);
#pragma unroll
  for (int dt = 0; dt < 4; ++dt)
#pragma unroll
    for (int g4 = 0; g4 < 4; ++g4) {
      int d0 = dt * 32 + 8 * g4 + 4 * hh;
      float y0 = O[dt][4 * g4 + 0] * inv * bflo(gv[dt][g4].x);
      float y1 = O[dt][4 * g4 + 1] * inv * bfhi(gv[dt][g4].x);
      float y2 = O[dt][4 * g4 + 2] * inv * bflo(gv[dt][g4].y);
      float y3 = O[dt][4 * g4 + 3] * inv * bfhi(gv[dt][g4].y);
      uint2 o; o.x = pack2(y0, y1); o.y = pack2(y2, y3);
      if (!a.dry || y0 != y0) *(uint2*)(zp + d0) = o;
    }
}

template <bool REV>
DI void lru_scan(float (&av)[2][16], float (&bv)[2][16], float& carry, int hh) {
  float segA[8], segB[8];
#pragma unroll
  for (int k = 0; k < 8; ++k) {
    const int mt = k >> 2, q = k & 3;
    float cA = 1.f, hl = 0.f;
#pragma unroll
    for (int jj = 0; jj < 4; ++jj) {
      const int j = REV ? 3 - jj : jj;
      const int i = 4 * q + j;
      hl = av[mt][i] * hl + bv[mt][i];
      cA *= av[mt][i];
      av[mt][i] = cA; bv[mt][i] = hl;
    }
    segA[k] = cA; segB[k] = hl;
  }
  float oA[8], oB[8];
#pragma unroll
  for (int k = 0; k < 8; ++k) { oA[k] = __shfl_xor(segA[k], 32); oB[k] = __shfl_xor(segB[k], 32); }
  float init[8];
  float st = carry;
#pragma unroll
  for (int kk = 0; kk < 8; ++kk) {
    const int k = REV ? 7 - kk : kk;
    const int first = REV ? 1 : 0;
    float A1 = (hh == first) ? segA[k] : oA[k];
    float B1 = (hh == first) ? segB[k] : oB[k];
    float st0 = st;
    st = A1 * st + B1;
    float A2 = (hh == first) ? oA[k] : segA[k];
    float B2 = (hh == first) ? oB[k] : segB[k];
    float st1 = st;
    st = A2 * st + B2;
    init[k] = (hh == first) ? st0 : st1;
  }
  carry = st;
#pragma unroll
  for (int k = 0; k < 8; ++k) {
    const int mt = k >> 2, q = k & 3;
#pragma unroll
    for (int j = 0; j < 4; ++j) {
      const int i = 4 * q + j;
      bv[mt][i] = bv[mt][i] + av[mt][i] * init[k];
    }
  }
}

DI void lru_item(CParams& p, int l, int b, int n, bool last, char* lds, int dry = 0) {
  const int NB = p.NB, RL = NB * S;
  const int tid = otid(), lane = tid & 63, w8 = tid >> 6;
  const int sub = __builtin_amdgcn_readfirstlane(w8 >> 2), w = w8 & 3;
  n = n + sub;
  lds += sub * 73728;
  const int dir = w >> 1, w2 = w & 1;
  const int tl = tid & 127;
  const int r = lane & 31, hh = lane >> 5;
  u16* sRaw = (u16*)lds + dir * (8704 / 2);
  u16* sUp = (u16*)(lds + 17408) + dir * (9216 / 2);
  float* sH = (float*)(lds + 35840) + w * (64 * 36);

  const int chb = n * 64;
  const int cp = (tl & 31) * 2, tg = tl >> 5;
  float cw0[4], cw1[4], cb0, cb1;
#pragma unroll
  for (int k = 0; k < 4; ++k) {
    cw0[k] = p.conv_w[((size_t)l * 4 + k) * D + chb + cp];
    cw1[k] = p.conv_w[((size_t)l * 4 + k) * D + chb + cp + 1];
  }
  cb0 = p.conv_b[l * D + chb + cp]; cb1 = p.conv_b[l * D + chb + cp + 1];
  bf16x8 waf[4], wxf[4];
  {
    const float* wa = p.lru_wa + (((size_t)(l * 2 + dir) * 16 + n) * 64) * 64;
    const float* wx = p.lru_wx + (((size_t)(l * 2 + dir) * 16 + n) * 64) * 64;
    const int e = 32 * w2 + r;
#pragma unroll
    for (int ks = 0; ks < 4; ++ks) {
      union { unsigned u[4]; bf16x8 v; } fa, fx;
#pragma unroll
      for (int j = 0; j < 4; ++j) {
        int d0 = ks * 16 + 8 * hh + 2 * j;
        fa.u[j] = pack2(wa[d0 * 64 + e], wa[(d0 + 1) * 64 + e]);
        fx.u[j] = pack2(wx[d0 * 64 + e], wx[(d0 + 1) * 64 + e]);
      }
      waf[ks] = fa.v; wxf[ks] = fx.v;
    }
  }
  const int che = chb + 32 * w2 + r;
  const float ba = p.lru_ba[(l * 2 + dir) * D + che];
  const float bx = p.lru_bx[(l * 2 + dir) * D + che];
  float c8sp;
  {
    float lam = p.lru_lambda[(l * 2 + dir) * D + che];
    float sp = (lam < -20.f) ? -lam : log1pf(expf(-lam));
    c8sp = 8.f * sp;
  }
  float carry = 0.f;

  auto step_tile = [&](int st, bool& isctx, int& tt) {
    if (dir == 0) { if (st < 4) { isctx = true; tt = st; } else { isctx = false; tt = st - 4; } }
    else { if (st < 4) { isctx = true; tt = 3 - st; } else { isctx = false; tt = 63 - (st - 4); } }
  };
  u32x4 pre[5];
  auto load_raw = [&](int st) {
    bool isctx; int tt; step_tile(st, isctx, tt);
    const int seqlen = isctx ? L : S;
    const size_t rowbase = isctx ? (size_t)RL + (size_t)b * L : (size_t)b * S;
    const int t0 = tt * 64;
#pragma unroll
    for (int i = 0; i < 5; ++i) {
      int c = tl + 128 * i;
      int rr = c >> 3, c16 = c & 7;
      int t = t0 - 2 + rr;
      u32x4 v = {0u, 0u, 0u, 0u};
      if (rr < 67 && t >= 0 && t < seqlen) v = *(const u32x4*)(p.U + (rowbase + t) * D + chb + c16 * 8);
      pre[i] = v;
    }
  };
  load_raw(0);
  __syncthreads();
  for (int st = 0; st < 68; ++st) {
    bool isctx; int tt; step_tile(st, isctx, tt);
    const size_t rowbase = isctx ? (size_t)RL + (size_t)b * L : (size_t)b * S;
    const int t0 = tt * 64;
#pragma unroll
    for (int i = 0; i < 5; ++i) {
      int c = tl + 128 * i;
      int rr = c >> 3, c16 = c & 7;
      if (rr < 67) *(u32x4*)(sRaw + rr * 64 + c16 * 8) = pre[i];
    }
    if (st + 1 < 68) load_raw(st + 1);
    asm volatile("s_waitcnt lgkmcnt(0)" ::: "memory"); __builtin_amdgcn_s_barrier(); asm volatile("" ::: "memory");
    {
      const u16* rp = sRaw + (tg * 16) * 64 + cp;
      unsigned r0 = *(const unsigned*)(rp), r1 = *(const unsigned*)(rp + 64), r2 = *(const unsigned*)(rp + 128);
#pragma unroll
      for (int i = 0; i < 16; ++i) {
        unsigned r3 = *(const unsigned*)(rp + (i + 3) * 64);
        float o0 = cb0 + cw0[0] * bflo(r0) + cw0[1] * bflo(r1) + cw0[2] * bflo(r2) + cw0[3] * bflo(r3);
        float o1 = cb1 + cw1[0] * bfhi(r0) + cw1[1] * bfhi(r1) + cw1[2] * bfhi(r2) + cw1[3] * bfhi(r3);
        *(unsigned*)(sUp + (tg * 16 + i) * 72 + cp) = pack2(o0, o1);
        r0 = r1; r1 = r2; r2 = r3;
      }
    }
    asm volatile("s_waitcnt lgkmcnt(0)" ::: "memory"); __builtin_amdgcn_s_barrier(); asm volatile("" ::: "memory");
    const bool fwd_first = isctx ? (tt <= 1) : (tt <= 31);
    const bool first = (dir == 0) ? fwd_first : !fwd_first;
    unsigned long long pt0[4], pt1[4];
    u32x4 pg[4];
    if (!first && !(isctx && last)) {
#pragma unroll
      for (int j = 0; j < 4; ++j) {
        const int q = lane + 64 * j;
        const int tok = q >> 2, cc = (q & 3) * 8;
        const size_t row = rowbase + t0 + tok;
        const int col = chb + 32 * w2 + cc;
        const u16* tp = p.Hb + row * D + col;
        pt0[j] = __hip_atomic_load((const unsigned long long*)tp, __ATOMIC_RELAXED, __HIP_MEMORY_SCOPE_AGENT);
        pt1[j] = __hip_atomic_load((const unsigned long long*)tp + 1, __ATOMIC_RELAXED, __HIP_MEMORY_SCOPE_AGENT);
        pg[j] = *(const u32x4*)(p.Z + row * 3072 + col);
      }
    } else {
#pragma unroll
      for (int j = 0; j < 4; ++j) { pt0[j] = 0; pt1[j] = 0; pg[j] = u32x4{0u, 0u, 0u, 0u}; }
    }
    float av[2][16], bv[2][16];
    {
      f32x16 aR[2];
#pragma unroll
      for (int mt = 0; mt < 2; ++mt) {
#pragma unroll
        for (int x = 0; x < 16; ++x) aR[mt][x] = 0.f;
        const u16* ub = sUp + (mt * 32 + r) * 72 + hh * 8;
#pragma unroll
        for (int ks = 0; ks < 4; ++ks) aR[mt] = MFMA32(*(const bf16x8*)(ub + ks * 16), waf[ks], aR[mt]);
      }
#pragma unroll
      for (int mt = 0; mt < 2; ++mt)
#pragma unroll
        for (int x = 0; x < 16; ++x) {
          const float rg = sigmoidf_(aR[mt][x] + ba);
          av[mt][x] = -c8sp * rg;
        }
    }
    {
      f32x16 aI[2];
#pragma unroll
      for (int mt = 0; mt < 2; ++mt) {
#pragma unroll
        for (int x = 0; x < 16; ++x) aI[mt][x] = 0.f;
        const u16* ub = sUp + (mt * 32 + r) * 72 + hh * 8;
#pragma unroll
        for (int ks = 0; ks < 4; ++ks) aI[mt] = MFMA32(*(const bf16x8*)(ub + ks * 16), wxf[ks], aI[mt]);
      }
#pragma unroll
      for (int mt = 0; mt < 2; ++mt)
#pragma unroll
        for (int x = 0; x < 16; ++x) {
          const int tok = mt * 32 + crow(x, hh);
          const float up = bf2f(sUp[tok * 72 + 32 * w2 + r]);
          const float ig = sigmoidf_(aI[mt][x] + bx);
          const float la = av[mt][x];
          const float a_ = __expf(la);
          const float om = fmaxf(1.f - a_ * a_, 0.f);
          av[mt][x] = a_;
          bv[mt][x] = __builtin_amdgcn_sqrtf(om) * (ig * up);
        }
    }
    if (dir == 0) lru_scan<false>(av, bv, carry, hh); else lru_scan<true>(av, bv, carry, hh);
#pragma unroll
    for (int mt = 0; mt < 2; ++mt)
#pragma unroll
      for (int x = 0; x < 16; ++x) sH[(mt * 32 + crow(x, hh)) * 36 + r] = bv[mt][x];
    if (!(isctx && last)) {
#pragma unroll
      for (int j = 0; j < 4; ++j) {
        const int q = lane + 64 * j;
        const int tok = q >> 2, cc = (q & 3) * 8;
        const float4 h0 = *(const float4*)(sH + tok * 36 + cc);
        const float4 h1 = *(const float4*)(sH + tok * 36 + cc + 4);
        const size_t row = rowbase + t0 + tok;
        const int col = chb + 32 * w2 + cc;
        u16* tp = p.Hb + row * D + col;
        if (first) {
          uint4 o; o.x = pack2(h0.x, h0.y); o.y = pack2(h0.z, h0.w); o.z = pack2(h1.x, h1.y); o.w = pack2(h1.z, h1.w);
          if (!dry || h0.x != h0.x) *(uint4*)tp = o;
        } else {
          unsigned tx = (unsigned)pt0[j], ty = (unsigned)(pt0[j] >> 32), tz = (unsigned)pt1[j], tw = (unsigned)(pt1[j] >> 32);
          u16* zp = p.Z + row * 3072 + col;
          u32x4 g = pg[j];
          uint4 o;
          o.x = pack2((h0.x + bflo(tx)) * bflo(g.x), (h0.y + bfhi(tx)) * bfhi(g.x));
          o.y = pack2((h0.z + bflo(ty)) * bflo(g.y), (h0.w + bfhi(ty)) * bfhi(g.y));
          o.z = pack2((h1.x + bflo(tz)) * bflo(g.z), (h1.y + bfhi(tz)) * bfhi(g.z));
          o.w = pack2((h1.z + bflo(tw)) * bflo(g.w), (h1.w + bfhi(tw)) * bfhi(g.w));
          if (!dry || h0.x != h0.x) *(uint4*)zp = o;
        }
      }
    }
    __builtin_amdgcn_fence(__ATOMIC_RELEASE, "workgroup");
  }
}

DI void phase_mixers(CParams& p, int chunk, int l, char* lds, int dry = 0) {
  const int NB = p.NB, RL = NB * S;
  const bool last = (l == DEPTH - 1);
  const int nLRU = (dry == 1) ? 0 : NB * 8, nC = (dry == 2) ? 0 : NB * 8 * 16, nBw = (dry == 2) ? 0 : NB * 8 * 16, nCtx = (last || dry == 2) ? 0 : NB * 8 * 2;
  const int total = nLRU + nC + nBw + nCtx;
  int* ctr = p.ctr + chunk * DEPTH + l + (dry ? 32 : 0);
  int* s_item = (int*)(lds + LDS_BYTES - 16);
  int it;
  while (true) {
    __syncthreads();
    if (threadIdx.x == 0) *s_item = atomicAdd(ctr, 1);
    __syncthreads();
    it = __builtin_amdgcn_readfirstlane(*s_item);
    __syncthreads();
    if (it >= nLRU) break;
    lru_item(p, l, it >> 3, (it & 7) * 2, last, lds, dry);
  }
  float gqm = 0.f, gkm = 0.f;
  {
    const int ln = otid() & 63;
    gqm = fmaxf(fabsf(p.q_norm_g[l * 128 + ln]), fabsf(p.q_norm_g[l * 128 + 64 + ln]));
    gkm = fmaxf(fabsf(p.k_norm_g[l * 128 + ln]), fabsf(p.k_norm_g[l * 128 + 64 + ln]));
#pragma unroll
    for (int o = 32; o >= 1; o >>= 1) { gqm = fmaxf(gqm, __shfl_xor(gqm, o)); gkm = fmaxf(gkm, __shfl_xor(gkm, o)); }
    gqm = __builtin_amdgcn_readfirstlane(gqm); gkm = __builtin_amdgcn_readfirstlane(gkm);
  }
  const float mfixC = 128.f * gqm * gkm * QSCALE;
  const int nCfast = (mfixC < 60.f) ? nC : 0;
  auto fetch = [&]() {
    __syncthreads();
    if (threadIdx.x == 0) *s_item = atomicAdd(ctr, 1);
    __syncthreads();
    it = __builtin_amdgcn_readfirstlane(*s_item);
    __syncthreads();
  };
  auto build = [&](int ir, AttnArgs& a) {
    a.dry = dry;
    if (ir < nC + nBw) {
      const bool isB = ir >= nC;
      if (isB) ir -= nC;
      const int b = ir >> 7, h = (ir >> 4) & 7, qb = ir & 15;
      const int kvh = h >> 2;
      const int br = isB ? 0 : 1;
      const size_t qrow0 = (size_t)b * S + qb * 256;
      a.q = p.Q + qrow0 * 2048 + br * 1024 + h * 128;
      a.z = p.Z + qrow0 * 3072 + (br + 1) * 1024 + h * 128;
      const int kcol = br * 256 + kvh * 128, slot = br * 2 + kvh;
      a.kctx = p.Kb + ((size_t)RL + (size_t)b * L) * 512 + kcol;
      a.vctx = p.VtC + (size_t)(b * 4 + slot) * 128 * L;
      int k0, k1;
      if (isB) { k0 = qb * 256 - 128; if (k0 < 0) k0 = 0; k1 = qb * 256 + 384; if (k1 > S) k1 = S; }
      else { k0 = 0; k1 = S; }
      a.lat_key0 = k0;
      a.n_lat_tiles = (k1 - k0) >> 6;
      a.klat = p.Kb + ((size_t)b * S + k0) * 512 + kcol;
      a.vlat = p.VtL + (size_t)(b * 4 + slot) * 128 * S + k0;
      a.q_t0 = qb * 256;
      a.band = isB ? 1 : 0;
      a.has_sink = isB ? 1 : 0;
      a.sink_l2 = isB ? p.attn_sink[l * 8 + h] * LOG2E : 0.f;
      a.fixedm = isB ? 0 : 1; a.mfix = mfixC;
    } else {
      ir -= nC + nBw;
      const int h = ir & 7, br = (ir >> 3) & 1, b = ir >> 4;
      const int kvh = h >> 2;
      const size_t qrow0 = (size_t)RL + (size_t)b * L;
      a.q = p.Q + qrow0 * 2048 + br * 1024 + h * 128;
      a.z = p.Z + qrow0 * 3072 + (br + 1) * 1024 + h * 128;
      const int kcol = br * 256 + kvh * 128, slot = br * 2 + kvh;
      a.kctx = p.Kb + ((size_t)RL + (size_t)b * L) * 512 + kcol;
      a.vctx = p.VtC + (size_t)(b * 4 + slot) * 128 * L;
      a.klat = a.kctx; a.vlat = a.vctx;
      a.n_lat_tiles = 0; a.lat_key0 = 0; a.q_t0 = 0; a.band = 0;
      a.has_sink = (br == 0) ? 1 : 0;
      a.sink_l2 = (br == 0) ? p.attn_sink[l * 8 + h] * LOG2E : 0.f;
      a.fixedm = (br == 0) ? 0 : 1; a.mfix = mfixC;
    }
  };
  while (it < nLRU + nCfast) {
    AttnArgs a;
    build(it - nLRU, a);
    attn_item<true>(a, lds);
    fetch();
  }
  while (it < total) {
    AttnArgs a;
    build(it - nLRU, a);
    attn_item<false>(a, lds);
    fetch();
  }
}

DI void merge_tiles_ctx(CParams& p, int l, char* lds) {
  const int NB = p.NB, RL = NB * S, R = NB * (S + L);
  const int MT = (R - RL) / 256, NT = 8;
  const int tid = otid();
  const int lane = tid & 63, w = tid >> 6, wm = w >> 1, wn = w & 1, r = lane & 31, hh = lane >> 5;
  for (int ti = 0;; ++ti) {
    int mt, nt;
    if (!tile_map(ti, MT, NT, mt, nt)) break;
    const int m0 = RL + mt * 256, n0 = nt * 128;
    f32x16 tot[2][2];
#pragma unroll
    for (int i = 0; i < 2; ++i)
#pragma unroll
      for (int j = 0; j < 2; ++j)
#pragma unroll
        for (int x = 0; x < 16; ++x) tot[i][j][x] = 0.f;
#pragma unroll 1
    for (int n = 0; n < 3; ++n) {
      f32x16 acc[2][2];
      gemm_core<128, false>(p.Z + (size_t)m0 * 3072 + n * 1024, 3072, 64, (size_t)128 * 3072,
                            p.WbT + ((size_t)(l * 3 + n) * D + n0) * D, D, 64, 0, D, lds, acc);
#pragma unroll
      for (int i = 0; i < 2; ++i)
#pragma unroll
        for (int j = 0; j < 2; ++j)
#pragma unroll
          for (int g = 0; g < 4; ++g) {
            const size_t row = (size_t)m0 + wm * 64 + i * 32 + r;
            const int col = n0 + wn * 64 + j * 32 + 8 * g + 4 * hh;
            uint2 sv = *(const uint2*)(p.Ms + row * 3072 + n * 1024 + col);
            tot[i][j][4 * g + 0] += bflo(sv.x) * acc[i][j][4 * g + 0];
            tot[i][j][4 * g + 1] += bfhi(sv.x) * acc[i][j][4 * g + 1];
            tot[i][j][4 * g + 2] += bflo(sv.y) * acc[i][j][4 * g + 2];
            tot[i][j][4 * g + 3] += bfhi(sv.y) * acc[i][j][4 * g + 3];
          }
    }
#pragma unroll
    for (int i = 0; i < 2; ++i)
#pragma unroll
      for (int j = 0; j < 2; ++j)
#pragma unroll
        for (int g = 0; g < 4; ++g) {
          const size_t row = (size_t)m0 + wm * 64 + i * 32 + r;
          const int col = n0 + wn * 64 + j * 32 + 8 * g + 4 * hh;
          uint2 o; o.x = pack2(tot[i][j][4 * g], tot[i][j][4 * g + 1]); o.y = pack2(tot[i][j][4 * g + 2], tot[i][j][4 * g + 3]);
          *(uint2*)(p.Hb + row * D + col) = o;
        }
  }
}

struct MergeOrder {
  pg8::StaticOrder inner;
  __device__ void init(int M, int G, int c) { inner.init(M, 1024, G, c); }
  __device__ bool next(int i, pg8::Unit& u) const {
    const int j = i / 3, n = i - 3 * j;
    pg8::Unit t;
    if (!inner.next(j, t)) return false;
    u.pm = t.pm; u.pn = n * 4 + t.pn;
    return true;
  }
  __device__ __forceinline__ void a_ready(const pg8::Unit&) const {}
  __device__ __forceinline__ void done(const pg8::Unit&) const {}
  __device__ __forceinline__ size_t a_off(const pg8::Unit& u) const { return (size_t)(u.pn >> 2) * 1024 * 2; }
};
struct EpiMerge {
  static constexpr bool PERM = true, AFTER_DRAIN = false;
  CParams* kp;
  __device__ __forceinline__ void operator()(const pg8::f32x4 (&acc)[2][2][4][2], const pg8::Unit& u, int wr, int wc, int fr, int fq) const {
    const int n = u.pn >> 2, ct = u.pn & 3;
    const int row0 = u.pm * 256 + wr * 64 + fr;
    const int col0 = ct * 256 + wc * 32 + 8 * fq;
    const u16* __restrict__ sg = kp->Ms + n * 1024;
    const u16* __restrict__ mrd = kp->Q;
    u16* __restrict__ mwr = kp->Q;
    u16* __restrict__ hb = kp->Hb;
#pragma unroll
    for (int ai = 0; ai < 2; ++ai) {
      const int mb = 0;
      u32x4 sv[4][2], pa[4][2];
#pragma unroll
      for (int mm = 0; mm < 4; ++mm) {
        const size_t row = (size_t)(row0 + ai * 128 + (mb + mm) * 16);
#pragma unroll
        for (int bj = 0; bj < 2; ++bj) {
          sv[mm][bj] = *(const u32x4*)(sg + row * 3072 + col0 + bj * 128);
          if (n > 0) pa[mm][bj] = *(const u32x4*)(mrd + row * D + col0 + bj * 128);
        }
      }
#pragma unroll
      for (int mm = 0; mm < 4; ++mm) {
        const size_t row = (size_t)(row0 + ai * 128 + (mb + mm) * 16);
#pragma unroll
        for (int bj = 0; bj < 2; ++bj) {
          pg8::f32x4 v0 = acc[ai][bj][mb + mm][0], v1 = acc[ai][bj][mb + mm][1];
          v0[0] *= bflo(sv[mm][bj].x); v0[1] *= bfhi(sv[mm][bj].x); v0[2] *= bflo(sv[mm][bj].y); v0[3] *= bfhi(sv[mm][bj].y);
          v1[0] *= bflo(sv[mm][bj].z); v1[1] *= bfhi(sv[mm][bj].z); v1[2] *= bflo(sv[mm][bj].w); v1[3] *= bfhi(sv[mm][bj].w);
          if (n > 0) {
            v0[0] += bflo(pa[mm][bj].x); v0[1] += bfhi(pa[mm][bj].x); v0[2] += bflo(pa[mm][bj].y); v0[3] += bfhi(pa[mm][bj].y);
            v1[0] += bflo(pa[mm][bj].z); v1[1] += bfhi(pa[mm][bj].z); v1[2] += bflo(pa[mm][bj].w); v1[3] += bfhi(pa[mm][bj].w);
          }
          u32x4 w; w.x = pack2(v0[0], v0[1]); w.y = pack2(v0[2], v0[3]); w.z = pack2(v1[0], v1[1]); w.w = pack2(v1[2], v1[3]);
          if (n < 2) *(u32x4*)(mwr + row * D + col0 + bj * 128) = w;
          else *(u32x4*)(hb + row * D + col0 + bj * 128) = w;
        }
      }
    }
  }
};


DI void phase_merge(CParams& p, int chunk, int l, char* lds) {
  const int NB = p.NB, RL = NB * S;
  const bool last = (l == DEPTH - 1);
  pg8::Gemm g{p.Z, p.WbT + (size_t)l * 3 * D * D, RL, 3 * D, D, 3072};
  MergeOrder Mo; Mo.init(RL, (int)gridDim.x, (int)blockIdx.x);
  EpiMerge E{&p};
  pg8::gemm_phase<EpiMerge, MergeOrder, false>((PG8_LAS unsigned char*)lds, g, Mo, E, nullptr);
  if (!last) merge_tiles_ctx(p, l, lds);
}

struct EpiOut {
  static constexpr bool PERM = false, AFTER_DRAIN = false;
  CParams* kp; int chunk, l;
  __device__ __forceinline__ void operator()(const pg8::f32x4 (&acc)[2][2][4][2], const pg8::Unit& u, int wr, int wc, int fr, int fq) const {
    const int NB = kp->NB, RL = NB * S;
    const int gr0 = u.pm * 256;
    const float* src; float* dst; int mrow;
    if (gr0 < RL) {
      const int b = gr0 / S, t = gr0 % S, bg = chunk * NB + b;
      const size_t off = ((size_t)bg * S + t) * D;
      src = (l == 0 ? kp->x : kp->out) + off; dst = kp->out + off; mrow = bg;
    } else {
      const int rc = gr0 - RL, b = rc / L, t = rc % L, bg = chunk * NB + b;
      const size_t off = ((size_t)bg * L + t) * D;
      src = (l == 0 ? kp->ctx : kp->xc) + off; dst = kp->xc + off; mrow = 16;
    }
    const int col0 = u.pn * 256 + wc * 32 + 4 * fq;
    const float* gate = kp->modv + ((size_t)l * 17 + mrow) * 3072 + 2048 + col0;
    pg8::f32x4 gv[2][2];
#pragma unroll
    for (int bj = 0; bj < 2; ++bj)
#pragma unroll
      for (int n = 0; n < 2; ++n) gv[bj][n] = *(const pg8::f32x4*)(gate + bj * 128 + n * 16);
    const int row0 = wr * 64 + fr;
#pragma unroll
    for (int ai = 0; ai < 2; ++ai)
#pragma unroll
      for (int m = 0; m < 4; ++m) {
        const size_t ro = (size_t)(row0 + ai * 128 + m * 16) * D + col0;
        pg8::f32x4 xv[2][2];
#pragma unroll
        for (int bj = 0; bj < 2; ++bj)
#pragma unroll
          for (int n = 0; n < 2; ++n) xv[bj][n] = *(const pg8::f32x4*)(src + ro + bj * 128 + n * 16);
#pragma unroll
        for (int bj = 0; bj < 2; ++bj)
#pragma unroll
          for (int n = 0; n < 2; ++n) {
            pg8::f32x4 o = xv[bj][n] + gv[bj][n] * acc[ai][bj][m][n];
            *(pg8::f32x4*)(dst + ro + bj * 128 + n * 16) = o;
          }
      }
  }
};

DI void phase_outproj(CParams& p, int chunk, int l, char* lds) {
  const int NB = p.NB, RL = NB * S, R = NB * (S + L);
  const bool last = (l == DEPTH - 1);
  const int rows = last ? RL : R;
  pg8::Gemm g{p.Hb, p.WoT + (size_t)l * D * D, rows, D, D, D};
  pg8::StaticOrder So; So.init(rows, D, (int)gridDim.x, (int)blockIdx.x);
  EpiOut E{&p, chunk, l};
  pg8::gemm_phase<EpiOut, pg8::StaticOrder, false>((PG8_LAS unsigned char*)lds, g, So, E, nullptr);
}

DI void phase_final(CParams& p) {
  const int tid_ = otid();
  const int lane = tid_ & 63;
  const int wg = blockIdx.x * 8 + (tid_ >> 6), nw = gridDim.x * 8;
  for (int r = wg; r < NBATCH * S; r += nw) {
    float* src = p.out + (size_t)r * D;
    float4 v[4]; float ss = 0.f;
#pragma unroll
    for (int i = 0; i < 4; ++i) {
      v[i] = *(const float4*)(src + i * 256 + lane * 4);
      ss += v[i].x * v[i].x + v[i].y * v[i].y + v[i].z * v[i].z + v[i].w * v[i].w;
    }
#pragma unroll
    for (int o = 32; o >= 1; o >>= 1) ss += __shfl_xor(ss, o);
    float rstd = rsqrtf(ss * (1.f / D) + EPS);
#pragma unroll
    for (int i = 0; i < 4; ++i) {
      int cidx = i * 256 + lane * 4;
      float4 gg = *(const float4*)(p.final_g + cidx);
      float4 o;
      o.x = v[i].x * rstd * gg.x; o.y = v[i].y * rstd * gg.y; o.z = v[i].z * rstd * gg.z; o.w = v[i].w * rstd * gg.w;
      *(float4*)(src + cidx) = o;
    }
  }
}

#ifndef DUP_PHASE
#define DUP_PHASE 0
#endif
__global__ void __launch_bounds__(NTHR, 2) fwd_megakernel(Params p_unused) {
  CParams* kp = (CParams*)__builtin_amdgcn_kernarg_segment_ptr();
  cg::grid_group grid = cg::this_grid();
  __shared__ __attribute__((aligned(16))) char lds[LDS_BYTES];
  phase0(*opaque_kp(kp), lds);
  grid.sync();
  phase_mod(*opaque_kp(kp), lds);
  grid.sync();
  for (int chunk = 0; chunk < kp->nchunk; ++chunk) {
    for (int l = 0; l < DEPTH; ++l) {
      phase_prenorm(*opaque_kp(kp), chunk, l);
      grid.sync();
#if DUP_PHASE == 9
      grid.sync(); grid.sync(); grid.sync(); grid.sync(); grid.sync();
#endif
      phase_gemm_in(*opaque_kp(kp), chunk, l, lds);
      grid.sync();
#if DUP_PHASE == 3
      phase_gemm_in(*opaque_kp(kp), chunk, l, lds);
      grid.sync();
#endif
#if DUP_PHASE == 4
      phase_mixers(*opaque_kp(kp), chunk, l, lds, 1);
      grid.sync();
#endif
#if DUP_PHASE == 6
      phase_mixers(*opaque_kp(kp), chunk, l, lds, 2);
      grid.sync();
#endif
      phase_mixers(*opaque_kp(kp), chunk, l, lds);
      grid.sync();
      phase_merge(*opaque_kp(kp), chunk, l, lds);
      grid.sync();
#if DUP_PHASE == 5
      phase_merge(*opaque_kp(kp), chunk, l, lds);
      grid.sync();
#endif
      phase_outproj(*opaque_kp(kp), chunk, l, lds);
      grid.sync();
    }
  }
  phase_final(*opaque_kp(kp));
}

extern "C" void kernel_launch(void* const* d_in, const int* in_sizes, int n_in,
                              void* d_out, int out_size, void* d_ws, size_t ws_size,
                              hipStream_t stream) {
  static int grid_blocks = 0;
  if (!grid_blocks) {
    int dev = 0, cus = 0, per_cu = 0;
    (void)hipGetDevice(&dev);
    (void)hipDeviceGetAttribute(&cus, hipDeviceAttributeMultiprocessorCount, dev);
    (void)hipOccupancyMaxActiveBlocksPerMultiprocessor(&per_cu, fwd_megakernel, NTHR, 0);
    if (per_cu > 1) per_cu = 1;
    if (per_cu < 1) per_cu = 1;
    grid_blocks = cus * per_cu;
  }
  Params p{};
  const float* const* in = (const float* const*)d_in;
  p.x = in[0]; p.c = in[1]; p.ctx = in[2]; p.c_ctx = in[3]; p.norm_g = in[4]; p.w_mod = in[5]; p.b_mod = in[6];
  p.w_in = in[7]; p.conv_w = in[8]; p.conv_b = in[9]; p.lru_wa = in[10]; p.lru_ba = in[11]; p.lru_wx = in[12];
  p.lru_bx = in[13]; p.lru_lambda = in[14]; p.attn_sink = in[15]; p.q_norm_g = in[16]; p.k_norm_g = in[17];
  p.w_branch = in[18]; p.w_out = in[19]; p.final_g = in[20];
  p.out = (float*)d_out;
  char* ws = (char*)d_ws;
  size_t off = 0;
  auto take = [&](size_t bytes) { char* r = ws + off; off += (bytes + 255) & ~(size_t)255; return r; };
  p.ctr = (int*)take(256);
  p.modv = (float*)take((size_t)DEPTH * 17 * 3072 * 4);
  p.sc = (float*)take((size_t)17 * D * 4);
  p.rope = (float*)take(4096 * 4);
  p.xc = (float*)take((size_t)NBATCH * L * D * 4);
  p.WinT = (u16*)take((size_t)DEPTH * INW * D * 2);
  p.WbT = (u16*)take((size_t)DEPTH * 3 * D * D * 2);
  p.WoT = (u16*)take((size_t)DEPTH * D * D * 2);
  const size_t fixed = off;
  int NB = 8;
  while (NB > 1) {
    size_t R = (size_t)NB * (S + L);
    size_t need = fixed + R * (size_t)(1024 + 1024 + 3072 + 2048 + 512 + 512 + 3072) * 2 + 8 * 256;
    if (need <= ws_size) break;
    NB >>= 1;
  }
  p.NB = NB; p.nchunk = NBATCH / NB;
  const size_t R = (size_t)NB * (S + L);
  p.Hb = (u16*)take(R * 1024 * 2);
  p.U = (u16*)take(R * 1024 * 2);
  p.Z = (u16*)take(R * 3072 * 2);
  p.Q = (u16*)take(R * 2048 * 2);
  p.Kb = (u16*)take(R * 512 * 2);
  p.VtL = (u16*)take((size_t)NB * 4 * 128 * S * 2);
  p.VtC = (u16*)take((size_t)NB * 4 * 128 * L * 2);
  p.Ms = (u16*)take(R * 3072 * 2);
  void* args[] = {&p};
  hipError_t e = hipLaunchCooperativeKernel((void*)fwd_megakernel, dim3(grid_blocks), dim3(NTHR), args, 0, stream);
  if (e != hipSuccess) fprintf(stderr, "cooperative launch failed: %s (grid %d)\n", hipGetErrorString(e), grid_blocks);
}
```

```cpp
#include <hip/hip_runtime.h>
#include <hip/hip_cooperative_groups.h>
#include <cstdio>
#include <cstdint>
namespace cg = cooperative_groups;

typedef unsigned short u16;
typedef __attribute__((ext_vector_type(8))) short bf16x8;
typedef __attribute__((ext_vector_type(4))) short s16x4;
typedef __attribute__((ext_vector_type(16))) float f32x16;
typedef __bf16 bf16x2_t __attribute__((ext_vector_type(2)));
typedef float float2_t __attribute__((ext_vector_type(2)));
typedef __attribute__((ext_vector_type(4))) unsigned u32x4;
typedef __attribute__((ext_vector_type(2))) unsigned u32x2;

#define DI __device__ __forceinline__
#define MFMA32(a, b, c) __builtin_amdgcn_mfma_f32_32x32x16_bf16((a), (b), (c), 0, 0, 0)

constexpr int D = 1024, NBATCH = 16, S = 4096, L = 256, DEPTH = 4, INW = 10240;
constexpr int LDS_BYTES = 147456;
constexpr int NTHR = 512;
constexpr float EPS = 1e-6f;
constexpr float QSCALE = 0.08838834764831845f * 1.4426950408889634f;
constexpr float LOG2E = 1.4426950408889634f;

struct Params {
  const float *x, *c, *ctx, *c_ctx, *norm_g, *w_mod, *b_mod, *w_in, *conv_w, *conv_b, *lru_wa, *lru_ba, *lru_wx, *lru_bx,
      *lru_lambda, *attn_sink, *q_norm_g, *k_norm_g, *w_branch, *w_out, *final_g;
  float* out;
  u16 *WinT, *WbT, *WoT;
  u16 *Hb, *U, *Z, *Q, *Kb, *VtL, *VtC, *Ms;
  float *modv, *sc, *rope, *xc;
  int* ctr;
  int NB;
  int nchunk;
};

typedef const __attribute__((address_space(4))) Params CParams;
DI CParams* opaque_kp(CParams* q) { asm volatile("" : "+s"(q)); return q; }

DI unsigned pack2(float a, float b) {
  float2_t f = {a, b};
  bf16x2_t v = __builtin_convertvector(f, bf16x2_t);
  return __builtin_bit_cast(unsigned, v);
}
DI float bf2f(u16 v) { return __uint_as_float(((unsigned)v) << 16); }
DI float bflo(unsigned v) { return __uint_as_float(v << 16); }
DI float bfhi(unsigned v) { return __uint_as_float(v & 0xffff0000u); }
DI float sigmoidf_(float x) { return __builtin_amdgcn_rcpf(1.f + __expf(-x)); }
DI float siluf_(float x) { return x * __builtin_amdgcn_rcpf(1.f + __expf(-x)); }
DI int otid() { int t = threadIdx.x; asm volatile("" : "+v"(t)); return t; }
DI int crow(int i, int hh) { return (i & 3) + 8 * (i >> 2) + 4 * hh; }

DI void phase0(CParams& p, char* lds) {
  const int tid = otid();
  float* tile = (float*)lds;
  const int n_in = DEPTH * 16 * 160, n_b = DEPTH * 3 * 256, n_o = DEPTH * 256;
  for (int it = blockIdx.x; it < n_in + n_b + n_o; it += gridDim.x) {
    const float* src; u16* dst; int ldsrc; int dstride = 64;
    if (it < n_in) {
      int l = it / 2560, rem = it % 2560, kt = rem / 160, nt = rem % 160;
      src = p.w_in + (size_t)l * D * INW + (size_t)(kt * 64) * INW + nt * 64; ldsrc = INW;
      const int o = nt >> 2;
      const int n256 = (o < 8) ? o : (o >= 28) ? 16 + (o - 28) : (o >= 24) ? 12 + (o - 24) : (o == 23) ? 39 : (o == 22) ? 38
                     : (o >= 18) ? 34 + (o - 18) : (o >= 14) ? 8 + (o - 14) : (o == 13) ? 33 : (o == 12) ? 32 : 28 + (o - 8);
      dst = p.WinT + (size_t)l * INW * D + ((size_t)n256 * 256 + (nt & 3) * 64) * D + kt * 64; dstride = D;
    } else if (it < n_in + n_b) {
      int i2 = it - n_in; int mat = i2 / 256, rem = i2 % 256, kt = rem / 16, nt = rem % 16;
      src = p.w_branch + (size_t)mat * D * D + (size_t)(kt * 64) * D + nt * 64; ldsrc = D;
      dst = p.WbT + (size_t)mat * D * D + (size_t)(nt * 64) * D + kt * 64; dstride = D;
    } else {
      int i2 = it - n_in - n_b; int mat = i2 / 256, rem = i2 % 256, kt = rem / 16, nt = rem % 16;
      src = p.w_out + (size_t)mat * D * D + (size_t)(kt * 64) * D + nt * 64; ldsrc = D;
      dst = p.WoT + (size_t)mat * D * D + (size_t)(nt * 64) * D + kt * 64; dstride = D;
    }
    __syncthreads();
#pragma unroll
    for (int i = 0; i < 2; ++i) {
      int c = tid + NTHR * i; int row = c >> 4, c4 = c & 15;
      float4 v = *(const float4*)(src + (size_t)row * ldsrc + c4 * 4);
      float* t = tile + row * 65 + c4 * 4;
      t[0] = v.x; t[1] = v.y; t[2] = v.z; t[3] = v.w;
    }
    __syncthreads();
    {
      int c = tid; int nrow = c >> 3, k8 = c & 7;
      float v[8];
#pragma unroll
      for (int j = 0; j < 8; ++j) v[j] = tile[(k8 * 8 + j) * 65 + nrow];
      uint4 o; o.x = pack2(v[0], v[1]); o.y = pack2(v[2], v[3]); o.z = pack2(v[4], v[5]); o.w = pack2(v[6], v[7]);
      *(uint4*)(dst + (size_t)nrow * dstride + k8 * 8) = o;
    }
  }
  const int gt = blockIdx.x * NTHR + tid, gn = gridDim.x * NTHR;
  for (int i = gt; i < 17 * D; i += gn) {
    int r = i / D, k = i % D;
    float v = (r < 16) ? p.c[r * D + k] : p.c_ctx[k];
    p.sc[i] = siluf_(v);
  }
  for (int i = gt; i < 64 * 32; i += gn) {
    int pos = i >> 5, pp = i & 31;
    float inv = powf(10000.f, -(float)pp / 32.f);
    float ang = (float)pos * inv;
    p.rope[i] = cosf(ang);
    p.rope[2048 + i] = sinf(ang);
  }
  if (blockIdx.x == 0 && tid < 64) p.ctr[tid] = 0;
}

DI void phase_mod(CParams& p, char* lds) {
  const int tid = otid();
  float* red = (float*)lds;
  const int col = tid & 63, kg = tid >> 6;
  for (int it = blockIdx.x; it < DEPTH * 48; it += gridDim.x) {
    int l = it / 48, cb = it % 48;
    float acc[17];
#pragma unroll
    for (int r = 0; r < 17; ++r) acc[r] = 0.f;
    const float* w = p.w_mod + (size_t)l * D * 3072 + cb * 64 + col;
    for (int k = kg * 128; k < kg * 128 + 128; ++k) {
      float wv = w[(size_t)k * 3072];
#pragma unroll
      for (int r = 0; r < 17; ++r) acc[r] += p.sc[r * D + k] * wv;
    }
    __syncthreads();
#pragma unroll
    for (int r = 0; r < 17; ++r) red[(kg * 17 + r) * 64 + col] = acc[r];
    __syncthreads();
    for (int i = tid; i < 17 * 64; i += NTHR) {
      int r = i >> 6, cc = i & 63;
      float s = 0.f;
#pragma unroll
      for (int g = 0; g < 8; ++g) s += red[(g * 17 + r) * 64 + cc];
      p.modv[((size_t)l * 17 + r) * 3072 + cb * 64 + cc] = s + p.b_mod[l * 3072 + cb * 64 + cc];
    }
  }
}

DI void phase_prenorm(CParams& p, int chunk, int l) {
  const int NB = p.NB, RL = NB * S, R = NB * (S + L);
  const int tid_ = otid();
  const int lane = tid_ & 63;
  const int wg = blockIdx.x * 8 + (tid_ >> 6), nw = gridDim.x * 8;
  const float* g = p.norm_g + l * D;
  for (int r = wg; r < R; r += nw) {
    const float* src; int mrow;
    if (r < RL) {
      int b = r / S, t = r % S; int bg = chunk * NB + b;
      src = (l == 0 ? p.x : p.out) + ((size_t)bg * S + t) * D; mrow = bg;
    } else {
      int rc = r - RL; int b = rc / L, t = rc % L; int bg = chunk * NB + b;
      src = (l == 0 ? p.ctx : p.xc) + ((size_t)bg * L + t) * D; mrow = 16;
    }
    const float* mv = p.modv + ((size_t)l * 17 + mrow) * 3072;
    float4 v[4]; float ss = 0.f;
#pragma unroll
    for (int i = 0; i < 4; ++i) {
      v[i] = *(const float4*)(src + i * 256 + lane * 4);
      ss += v[i].x * v[i].x + v[i].y * v[i].y + v[i].z * v[i].z + v[i].w * v[i].w;
    }
#pragma unroll
    for (int o = 32; o >= 1; o >>= 1) ss += __shfl_xor(ss, o);
    float rstd = rsqrtf(ss * (1.f / D) + EPS);
#pragma unroll
    for (int i = 0; i < 4; ++i) {
      int cidx = i * 256 + lane * 4;
      float4 gg = *(const float4*)(g + cidx);
      float4 sh = *(const float4*)(mv + cidx);
      float4 scl = *(const float4*)(mv + 1024 + cidx);
      float h0 = v[i].x * rstd * gg.x * (1.f + scl.x) + sh.x;
      float h1 = v[i].y * rstd * gg.y * (1.f + scl.y) + sh.y;
      float h2 = v[i].z * rstd * gg.z * (1.f + scl.z) + sh.z;
      float h3 = v[i].w * rstd * gg.w * (1.f + scl.w) + sh.w;
      uint2 o; o.x = pack2(h0, h1); o.y = pack2(h2, h3);
      *(uint2*)(p.Hb + (size_t)r * D + cidx) = o;
    }
  }
}

template <int BN, bool PIPE>
DI void gemm_core(const u16* A, int lda, int ksa, size_t a_blk, const u16* Bt, int ldb, int ksb, size_t b_blk, int K, char* ldsc,
                  f32x16 (&acc)[BN / 64][2]) {
  constexpr int MI = BN / 64;
  constexpr int SS = 32768 + BN * 128;
  const int tid = otid(), lane = tid & 63, w = tid >> 6;
  const int wm = (BN == 256) ? (w >> 2) : (w >> 1), wn = (BN == 256) ? (w & 3) : (w & 1);
  const int r = lane & 31, hh = lane >> 5;
  const int drow = lane >> 3, dcp = lane & 7;
  const int chunk0 = dcp ^ (drow >> 1);
  const u16* gAe = A + (size_t)(w >> 2) * a_blk + (size_t)((w & 3) * 32 + drow) * lda + chunk0 * 8;
  const u16* gAo = gAe + (size_t)8 * lda + ((chunk0 ^ 4) - chunk0) * 8;
  const size_t a16 = (size_t)16 * lda;
  const int brow0 = (BN == 256) ? (w & 3) * 32 : w * 16;
  const u16* gBe = Bt + ((BN == 256) ? (size_t)(w >> 2) * b_blk : (size_t)0) + (size_t)(brow0 + drow) * ldb + chunk0 * 8;
  const u16* gBo = gBe + (size_t)8 * ldb + ((chunk0 ^ 4) - chunk0) * 8;
  const size_t b16 = (size_t)16 * ldb;
#pragma unroll
  for (int i = 0; i < MI; ++i)
#pragma unroll
    for (int j = 0; j < 2; ++j)
#pragma unroll
      for (int x = 0; x < 16; ++x) acc[i][j][x] = 0.f;
  auto DMA = [&](int kt, int stage) {
    char* sa = ldsc + stage * SS + (w * 4) * 1024;
    char* sb = ldsc + stage * SS + 32768 + ((BN == 256) ? (w * 4) : (w * 2)) * 1024;
    const size_t ka = (size_t)kt * ksa, kb = (size_t)kt * ksb;
    __builtin_amdgcn_global_load_lds((const unsigned*)(gAe + ka), (unsigned*)(sa), 16, 0, 0);
    __builtin_amdgcn_global_load_lds((const unsigned*)(gBe + kb), (unsigned*)(sb), 16, 0, 0);
    __builtin_amdgcn_global_load_lds((const unsigned*)(gAo + ka), (unsigned*)(sa + 1024), 16, 0, 0);
    __builtin_amdgcn_global_load_lds((const unsigned*)(gBo + kb), (unsigned*)(sb + 1024), 16, 0, 0);
    __builtin_amdgcn_global_load_lds((const unsigned*)(gAe + a16 + ka), (unsigned*)(sa + 2048), 16, 0, 0);
    __builtin_amdgcn_global_load_lds((const unsigned*)(gAo + a16 + ka), (unsigned*)(sa + 3072), 16, 0, 0);
    if (BN == 256) {
      __builtin_amdgcn_global_load_lds((const unsigned*)(gBe + b16 + kb), (unsigned*)(sb + 2048), 16, 0, 0);
      __builtin_amdgcn_global_load_lds((const unsigned*)(gBo + b16 + kb), (unsigned*)(sb + 3072), 16, 0, 0);
    }
  };
  const int sw = (r >> 1) & 7;
  int koff[4];
#pragma unroll
  for (int ks = 0; ks < 4; ++ks) koff[ks] = ((2 * ks + hh) ^ sw) << 4;
  auto COMPUTE = [&](int stage) {
    const char* ab = ldsc + stage * SS + (wm * (MI * 32) + r) * 128;
    const char* bb = ldsc + stage * SS + 32768 + (wn * 64 + r) * 128;
    bf16x8 fa[2][MI], fb[2][2];
    auto LDF = [&](int ks, int slot) {
#pragma unroll
      for (int i = 0; i < MI; ++i) fa[slot][i] = *(const bf16x8*)(ab + i * 32 * 128 + koff[ks]);
#pragma unroll
      for (int j = 0; j < 2; ++j) fb[slot][j] = *(const bf16x8*)(bb + j * 32 * 128 + koff[ks]);
    };
    auto MM = [&](int slot) {
#pragma unroll
      for (int i = 0; i < MI; ++i)
#pragma unroll
        for (int j = 0; j < 2; ++j) acc[i][j] = MFMA32(fb[slot][j], fa[slot][i], acc[i][j]);
    };
    if (!PIPE) {
#pragma unroll
      for (int ks = 0; ks < 4; ++ks) { LDF(ks, 0); MM(0); }
      return;
    }
    LDF(0, 0); LDF(1, 1);
    __builtin_amdgcn_sched_barrier(0);
    MM(0); LDF(2, 0);
    __builtin_amdgcn_sched_barrier(0);
    MM(1); LDF(3, 1);
    __builtin_amdgcn_sched_barrier(0);
    MM(0); MM(1);
  };
  const int KT = K >> 6;
  __syncthreads();
  DMA(0, 0);
  __syncthreads();
  for (int kt = 0; kt < KT; kt += 2) {
    DMA(kt + 1, 1);
    COMPUTE(0);
    __syncthreads();
    if (kt + 2 < KT) DMA(kt + 2, 0);
    COMPUTE(1);
    __syncthreads();
  }
}

template <int MI>
DI void stage_acc(char* ldsc, f32x16 (&acc)[MI][2], int wm, int ncol0, bool active) {
  const int tid = otid(), lane = tid & 63;
  const int r = lane & 31, hh = lane >> 5;
  float* Cs = (float*)ldsc;
  if (active) {
#pragma unroll
    for (int i = 0; i < MI; ++i)
#pragma unroll
      for (int j = 0; j < 2; ++j)
#pragma unroll
        for (int g = 0; g < 4; ++g) {
          int m = wm * (MI * 32) + i * 32 + r;
          int n = ncol0 + j * 32 + 8 * g + 4 * hh;
          float4 v; v.x = acc[i][j][4 * g]; v.y = acc[i][j][4 * g + 1]; v.z = acc[i][j][4 * g + 2]; v.w = acc[i][j][4 * g + 3];
          *(float4*)(Cs + m * 132 + n) = v;
        }
  }
  __syncthreads();
}

DI void read_row64(const char* ldsc, int row, int half, float (&v)[64]) {
  const float* Cs = (const float*)ldsc + row * 132 + half * 64;
#pragma unroll
  for (int j = 0; j < 16; ++j) {
    float4 t = *(const float4*)(Cs + j * 4);
    v[j * 4] = t.x; v[j * 4 + 1] = t.y; v[j * 4 + 2] = t.z; v[j * 4 + 3] = t.w;
  }
}

DI void store_row64_bf16(u16* dst, const float (&v)[64]) {
#pragma unroll
  for (int j = 0; j < 8; ++j) {
    uint4 o;
    o.x = pack2(v[j * 8], v[j * 8 + 1]); o.y = pack2(v[j * 8 + 2], v[j * 8 + 3]);
    o.z = pack2(v[j * 8 + 4], v[j * 8 + 5]); o.w = pack2(v[j * 8 + 6], v[j * 8 + 7]);
    *(uint4*)(dst + j * 8) = o;
  }
}

namespace pg8 {
#define PG8_LAS __attribute__((address_space(3)))
typedef unsigned short bf16_t;
typedef short bf16x8 __attribute__((ext_vector_type(8)));
typedef float f32x4 __attribute__((ext_vector_type(4)));
typedef unsigned u32x4 __attribute__((ext_vector_type(4)));
constexpr int BM = 256, BK = 64, HALF = 128, HTB = HALF * BK * 2  , STAGE_BYTES = 8 * HTB, NXCD = 8, WGM = 8;

__host__ __device__ __forceinline__ int lds_byte(int r, int c) { const int st = (r >> 4) * 2 + (c >> 5), rr = r & 15, cc = c & 31, ob = rr * 64 + cc * 2; return st * 1024 + (ob ^ (((ob >> 9) & 1) << 5)); }
__host__ __device__ __forceinline__ void stage_rc(int b, int& R, int& C) { const int st = b / 1024, sb = b % 1024, swz = sb ^ (((sb >> 9) & 1) << 5); R = (st >> 1) * 16 + swz / 64; C = (st & 1) * 32 + (swz % 64) / 2; }
__host__ __device__ __forceinline__ int perm32(int rho) { const int n = rho >> 4, i = rho & 15; return 8 * (i >> 2) + 4 * n + (i & 3); }
struct Unit { int pm, pn; };
struct Gemm { const bf16_t* A; const bf16_t* Bt; int M, N, K; int lda; };
struct StaticOrder {
    int nM, nN, nwg, G, c;
    __host__ __device__ void init(int M, int N, int G_, int c_) { nM = M / BM; nN = N / BM; nwg = nM * nN; G = G_; c = c_; }
    __host__ __device__ bool next(int i, Unit& u) const {
        const long L = (long)i * G + c; if (L >= nwg) return false;
        int wgid = (int)L; { const int q = nwg / NXCD, r = nwg % NXCD, xcd = wgid % NXCD, off = wgid / NXCD; wgid = (xcd < r ? xcd * (q + 1) : r * (q + 1) + (xcd - r) * q) + off; }
        const int nig = WGM * nN, gid = wgid / nig, fm = gid * WGM, gsz = (nM - fm) < WGM ? (nM - fm) : WGM;
        u.pm = fm + ((wgid % nig) % gsz); u.pn = (wgid % nig) / gsz; return true;
    }
    __device__ __forceinline__ void a_ready(const Unit&) const {}
    __device__ __forceinline__ void done(const Unit&) const {}
    __device__ __forceinline__ size_t a_off(const Unit&) const { return 0; }
};
template <class Epi, class Sched, bool STAMP = false>
__device__ __forceinline__ void gemm_phase(PG8_LAS unsigned char* lds, const Gemm g, const Sched& S, const Epi& E, unsigned long long* stamps) {
    int tid_raw = threadIdx.x; asm volatile("" : "+v"(tid_raw));
    const int tid = tid_raw, wid = __builtin_amdgcn_readfirstlane(tid >> 6), lane = tid & 63, wr = wid >> 2, wc = wid & 3, fr = lane & 15, fq = lane >> 4;
    const int K = g.K, nt = K / BK;
    int ts_lo = 0, ts_hi = 0, nts = 0; const unsigned long long rt_entry = STAMP ? (unsigned long long)wall_clock64() : 0ull;
#define PG8_STAMP() do { if (STAMP && wid == 0 && nts < 64) { const unsigned long long _c = (unsigned long long)clock64(); \
        ts_lo = (lane == nts) ? (int)(unsigned)_c : ts_lo; ts_hi = (lane == nts) ? (int)(unsigned)(_c >> 32) : ts_hi; ++nts; } } while (0)
    PG8_STAMP();
    unsigned voffA[2], voffB[2];
#pragma unroll
    for (int i = 0; i < 2; ++i) { int R, C; stage_rc(tid * 16 + i * 8192, R, C); const int Rb = Epi::PERM ? ((R & ~31) + perm32(R & 31)) : R;
        voffA[i] = (unsigned)(R * g.lda + C) * 2u; voffB[i] = (unsigned)(Rb * K + C) * 2u; }
    const size_t kstep = (size_t)(BK * 2);
    const size_t hstep = (size_t)HALF * K * 2;
    const size_t tstep = 2 * hstep;
    const size_t hstepA = (size_t)HALF * g.lda * 2, tstepA = 2 * hstepA;
    const unsigned ldsw = (unsigned)wid * 1024u;
    const int aoff = lds_byte(wr * 64 + fr, fq * 8), boff = lds_byte(wc * 32 + fr, fq * 8);
#define PG8_SA(b, h) (((b) * 2 + (h)) * HTB)
#define PG8_SB(b, h) ((4 + (b) * 2 + (h)) * HTB)
#define PG8_STAGE(bufoff, gbase, voff) do { _Pragma("unroll") for (int _i = 0; _i < 2; ++_i) \
        __builtin_amdgcn_global_load_lds((const unsigned*)((const char*)(gbase) + (voff)[_i]), (PG8_LAS unsigned*)(lds + (bufoff) + ldsw + _i * 8192), 16, 0, 0); } while (0)
#define PG8_LDA(dst, b, h) do { _Pragma("unroll") for (int m = 0; m < 4; ++m) _Pragma("unroll") for (int k = 0; k < 2; ++k) dst[m][k] = *(const PG8_LAS bf16x8*)(lds + PG8_SA(b, h) + aoff + m * 2048 + k * 1024); } while (0)
#define PG8_LDB(dst, b, h) do { _Pragma("unroll") for (int n = 0; n < 2; ++n) _Pragma("unroll") for (int k = 0; k < 2; ++k) dst[n][k] = *(const PG8_LAS bf16x8*)(lds + PG8_SB(b, h) + boff + n * 2048 + k * 1024); } while (0)
#define PG8_MMA(ai, bj, At, Bt) do { __builtin_amdgcn_s_setprio(1); _Pragma("unroll") for (int m = 0; m < 4; ++m) _Pragma("unroll") for (int n = 0; n < 2; ++n) _Pragma("unroll") for (int k = 0; k < 2; ++k) \
        acc[ai][bj][m][n] = __builtin_amdgcn_mfma_f32_16x16x32_bf16(Bt[n][k], At[m][k], acc[ai][bj][m][n], 0, 0, 0); __builtin_amdgcn_s_setprio(0); } while (0)
#define PG8_WAIT_V(n) asm volatile("s_waitcnt vmcnt(" #n ")" ::: "memory")
#define PG8_WAIT_L(n) asm volatile("s_waitcnt lgkmcnt(" #n ")" ::: "memory")
#define PG8_BAR __builtin_amdgcn_s_barrier()
#define PG8_SCHED __builtin_amdgcn_sched_barrier(0)
    Unit cur, nxt; int ui = 0;
    if (!S.next(0, cur)) return;
    f32x4 acc[2][2][4][2];
#pragma unroll
    for (int a = 0; a < 2; ++a)
#pragma unroll
        for (int b = 0; b < 2; ++b)
#pragma unroll
            for (int m = 0; m < 4; ++m)
#pragma unroll
                for (int n = 0; n < 2; ++n) acc[a][b][m][n] = (f32x4){0.f, 0.f, 0.f, 0.f};
    bf16x8 At[4][2], B0[2][2], B1[2][2];
    const char* cA = (const char*)g.A + (size_t)cur.pm * tstepA + S.a_off(cur); const char* cB = (const char*)g.Bt + (size_t)cur.pn * tstep;
    S.a_ready(cur);
    PG8_STAGE(PG8_SB(0, 0), cB, voffB); PG8_STAGE(PG8_SA(0, 0), cA, voffA); PG8_STAGE(PG8_SB(0, 1), cB + hstep, voffB); PG8_STAGE(PG8_SA(0, 1), cA + hstepA, voffA);
    if (wr == 1) PG8_BAR;
    PG8_WAIT_V(4); PG8_BAR;
    PG8_STAGE(PG8_SB(1, 0), cB + kstep, voffB); PG8_STAGE(PG8_SA(1, 0), cA + kstep, voffA); PG8_STAGE(PG8_SB(1, 1), cB + hstep + kstep, voffB);
    PG8_WAIT_V(6); PG8_BAR;
    PG8_STAMP();
    for (;;) {
        const bool has_next = S.next(ui + 1, nxt);
        const char* nA = has_next ? (const char*)g.A + (size_t)nxt.pm * tstepA + S.a_off(nxt) : cA; const char* nB = has_next ? (const char*)g.Bt + (size_t)nxt.pn * tstep : cB;
        for (int t = 0; t < nt; t += 2) {
            const bool last = (t == nt - 2);
            const char* a1 = cA + (size_t)(t + 1) * kstep;
            const char* a2 = last ? nA : cA + (size_t)(t + 2) * kstep; const char* b2 = last ? nB : cB + (size_t)(t + 2) * kstep;
            const char* a3 = a2 + kstep; const char* b3 = b2 + kstep;
            if (last && has_next) S.a_ready(nxt);
            PG8_LDB(B0, 0, 0); PG8_SCHED; PG8_LDA(At, 0, 0); PG8_STAGE(PG8_SA(1, 1), a1 + hstepA, voffA);
            PG8_WAIT_L(8); PG8_BAR; PG8_WAIT_L(0); PG8_MMA(0, 0, At, B0); PG8_BAR; PG8_SCHED;
            PG8_LDB(B1, 0, 1); PG8_STAGE(PG8_SB(0, 0), b2, voffB);
            PG8_BAR; PG8_WAIT_L(0); PG8_MMA(0, 1, At, B1); PG8_BAR;
            PG8_LDA(At, 0, 1); PG8_STAGE(PG8_SA(0, 0), a2, voffA);
            PG8_BAR; PG8_WAIT_L(0); PG8_MMA(1, 0, At, B0); PG8_BAR; PG8_SCHED;
            PG8_STAGE(PG8_SB(0, 1), b2 + hstep, voffB);
            PG8_WAIT_V(6); PG8_BAR; PG8_MMA(1, 1, At, B1); PG8_BAR;
            PG8_LDB(B0, 1, 0); PG8_SCHED; PG8_LDA(At, 1, 0); PG8_STAGE(PG8_SA(0, 1), a2 + hstepA, voffA);
            PG8_WAIT_L(8); PG8_BAR; PG8_WAIT_L(0); PG8_MMA(0, 0, At, B0); PG8_BAR; PG8_SCHED;
            PG8_LDB(B1, 1, 1); PG8_STAGE(PG8_SB(1, 0), b3, voffB);
            PG8_BAR; PG8_WAIT_L(0); PG8_MMA(0, 1, At, B1); PG8_BAR;
            PG8_LDA(At, 1, 1); PG8_STAGE(PG8_SA(1, 0), a3, voffA);
            PG8_BAR; PG8_WAIT_L(0); PG8_MMA(1, 0, At, B0); PG8_BAR; PG8_SCHED;
            PG8_STAGE(PG8_SB(1, 1), b3 + hstep, voffB);
            PG8_WAIT_V(6); PG8_BAR; PG8_MMA(1, 1, At, B1); PG8_BAR;
        }
        PG8_STAMP();
        if constexpr (!Epi::AFTER_DRAIN) { E(acc, cur, wr, wc, fr, fq); S.done(cur); }
        PG8_STAMP();
        if (!has_next) break;
#pragma unroll
        for (int a = 0; a < 2; ++a)
#pragma unroll
            for (int b = 0; b < 2; ++b)
#pragma unroll
                for (int m = 0; m < 4; ++m)
#pragma unroll
                    for (int n = 0; n < 2; ++n) acc[a][b][m][n] = (f32x4){0.f, 0.f, 0.f, 0.f};
        cur = nxt; cA = nA; cB = nB; ++ui;
    }
    PG8_WAIT_V(0);
    if (wr == 0) PG8_BAR;
    PG8_BAR;
    if constexpr (Epi::AFTER_DRAIN) { E.fused(acc, cur, wr, wc, fr, fq, lds, wid, lane); S.done(cur); }
    PG8_STAMP();
    if (STAMP && wid == 0) { stamps[lane] = lane < nts ? (((unsigned long long)(unsigned)ts_hi << 32) | (unsigned)ts_lo) : 0ull;
        if (lane == 62) stamps[62] = rt_entry; if (lane == 63) stamps[63] = (unsigned long long)wall_clock64(); }
#undef PG8_STAMP
#undef PG8_SA
#undef PG8_SB
#undef PG8_STAGE
#undef PG8_LDA
#undef PG8_LDB
#undef PG8_MMA
#undef PG8_WAIT_V
#undef PG8_WAIT_L
#undef PG8_BAR
#undef PG8_SCHED
}
}

struct EpiIn {
  static constexpr bool PERM = true, AFTER_DRAIN = false;
  CParams* kp;
  __device__ __forceinline__ void operator()(const pg8::f32x4 (&acc)[2][2][4][2], const pg8::Unit& u, int wr, int wc, int fr, int fq) const {
    const int pn = u.pn;
    u16* base; int ld, mode;
    if (pn < 4) { base = kp->U + pn * 256; ld = D; mode = 0; }
    else if (pn < 16) { base = kp->Z + (pn - 4) * 256; ld = 3072; mode = 1; }
    else { base = kp->Ms + (pn - 16) * 256; ld = 3072; mode = 2; }
    const int row0 = u.pm * 256 + wr * 64 + fr;
    const int col0 = wc * 32 + 8 * fq;
    u16* rowp0 = base + (size_t)row0 * ld + col0;
#pragma unroll
    for (int ai = 0; ai < 2; ++ai)
#pragma unroll
      for (int m = 0; m < 4; ++m)
#pragma unroll
        for (int bj = 0; bj < 2; ++bj) {
          pg8::f32x4 v0 = acc[ai][bj][m][0], v1 = acc[ai][bj][m][1];
          if (mode == 1) {
#pragma unroll
            for (int j = 0; j < 4; ++j) { v0[j] = siluf_(v0[j]); v1[j] = siluf_(v1[j]); }
          } else if (mode == 2) {
#pragma unroll
            for (int j = 0; j < 4; ++j) { v0[j] = sigmoidf_(v0[j]); v1[j] = sigmoidf_(v1[j]); }
          }
          u32x4 w; w.x = pack2(v0[0], v0[1]); w.y = pack2(v0[2], v0[3]); w.z = pack2(v1[0], v1[1]); w.w = pack2(v1[2], v1[3]);
          *(u32x4*)(rowp0 + (size_t)(ai * 128 + m * 16) * ld + bj * 128) = w;
        }
  }
};


DI bool tile_map(int i, int MT, int NT, int& mt, int& nt) {
  const int G = gridDim.x, bid = blockIdx.x;
  if ((G & 63) == 0 && (MT & 7) == 0 && (NT % (G >> 6)) == 0) {
    const int SH = G >> 6;
    const int xcd = bid & 7, slot = bid >> 3;
    const int sx = slot & 7, sy = slot >> 3;
    const int nsn = NT / SH, nsm = MT >> 3;
    const int st = i * 8 + xcd;
    if (st >= nsm * nsn) return false;
    mt = (st / nsn) * 8 + sx;
    nt = (st % nsn) * SH + sy;
    return true;
  }
  const int it = bid + i * G;
  if (it >= MT * NT) return false;
  mt = it / NT; nt = it % NT;
  return true;
}


struct OneUnit {
  int pm, pn;
  __device__ bool next(int i, pg8::Unit& u) const { if (i) return false; u.pm = pm; u.pn = pn; return true; }
  __device__ __forceinline__ void a_ready(const pg8::Unit&) const {}
  __device__ __forceinline__ void done(const pg8::Unit&) const {}
  __device__ __forceinline__ size_t a_off(const pg8::Unit&) const { return 0; }
};
struct EpiQKV {
  static constexpr bool PERM = false, AFTER_DRAIN = true;
  CParams* kp; char* lds; int l, nt, m0;
  __device__ __forceinline__ void fused(const pg8::f32x4 (&acc)[2][2][4][2], const pg8::Unit&, int wr, int wc, int fr, int fq,
                                        PG8_LAS unsigned char*, int, int) const {
    CParams& p = *kp;
    const int NB = p.NB, RL = NB * S;
    const int tid = otid();
    const bool lat = m0 < RL;
    int b, t0;
    if (lat) { b = m0 / S; t0 = m0 % S; } else { int rc = m0 - RL; b = rc / L; t0 = rc % L; }
    const bool isV = (nt == 13 || nt == 23);
    const bool isC = nt >= 18;
    const bool isQ = (nt >= 8 && nt < 12) || (nt >= 18 && nt < 22);
    auto process_unit = [&](int hsel, int u) {
      if (isV) {
        const int slot = (isC ? 2 : 0) + hsel;
        const int d = u >> 2, tq = u & 3;
        const float* Cs = (const float*)lds;
        u16* dst = lat ? p.VtL + ((size_t)(b * 4 + slot) * 128 + d) * S + t0 + tq * 64
                       : p.VtC + ((size_t)(b * 4 + slot) * 128 + d) * L + t0 + tq * 64;
#pragma unroll 1
        for (int c = 0; c < 4; ++c) {
          float v[16];
#pragma unroll
          for (int j = 0; j < 16; ++j) v[j] = Cs[(tq * 64 + c * 16 + j) * 132 + d];
          uint4 o0, o1;
          o0.x = pack2(v[0], v[1]); o0.y = pack2(v[2], v[3]); o0.z = pack2(v[4], v[5]); o0.w = pack2(v[6], v[7]);
          o1.x = pack2(v[8], v[9]); o1.y = pack2(v[10], v[11]); o1.z = pack2(v[12], v[13]); o1.w = pack2(v[14], v[15]);
          *(uint4*)(dst + c * 16) = o0;
          *(uint4*)(dst + c * 16 + 8) = o1;
        }
      } else {
        const int row = u >> 1, half = u & 1;
        const size_t gr = (size_t)m0 + row;
        const int t = t0 + row;
        const float* Cr = (const float*)lds + row * 132 + half * 64;
        float rstd = 1.f;
        const float* gn = (isQ ? p.q_norm_g : p.k_norm_g) + l * 128 + half * 64;
        if (isC) {
          float ss = 0.f;
#pragma unroll
          for (int j = 0; j < 16; ++j) {
            float4 tv = *(const float4*)(Cr + j * 4);
            ss += tv.x * tv.x + tv.y * tv.y + tv.z * tv.z + tv.w * tv.w;
          }
          ss += __shfl_xor(ss, 1);
          rstd = rsqrtf(ss * (1.f / 128.f) + EPS);
        }
        const int pos = (half == 0) ? (t >> 6) : (t & 63);
        const float* cs = p.rope + pos * 32;
        const float* sn = p.rope + 2048 + pos * 32;
        u16* dst;
        if (isQ) {
          const int head = (isC ? (nt - 18) : (nt - 8)) * 2 + hsel;
          dst = p.Q + gr * 2048 + (isC ? 1024 : 0) + head * 128 + half * 64;
        } else {
          dst = p.Kb + gr * 512 + (isC ? 256 : 0) + hsel * 128 + half * 64;
        }
#pragma unroll 1
        for (int c = 0; c < 2; ++c) {
          float x0[16], x1[16];
#pragma unroll
          for (int j = 0; j < 4; ++j) {
            float4 ta_ = *(const float4*)(Cr + c * 16 + j * 4);
            float4 tb_ = *(const float4*)(Cr + 32 + c * 16 + j * 4);
            x0[4 * j] = ta_.x; x0[4 * j + 1] = ta_.y; x0[4 * j + 2] = ta_.z; x0[4 * j + 3] = ta_.w;
            x1[4 * j] = tb_.x; x1[4 * j + 1] = tb_.y; x1[4 * j + 2] = tb_.z; x1[4 * j + 3] = tb_.w;
          }
          if (isC) {
#pragma unroll
            for (int j = 0; j < 16; ++j) { x0[j] = x0[j] * rstd * gn[c * 16 + j]; x1[j] = x1[j] * rstd * gn[32 + c * 16 + j]; }
          }
          if (lat) {
#pragma unroll
            for (int j = 0; j < 16; ++j) {
              float c_ = cs[c * 16 + j], s_ = sn[c * 16 + j];
              float a0 = x0[j], a1 = x1[j];
              x0[j] = a0 * c_ - a1 * s_;
              x1[j] = a1 * c_ + a0 * s_;
            }
          }
          if (isQ) {
#pragma unroll
            for (int j = 0; j < 16; ++j) { x0[j] *= QSCALE; x1[j] *= QSCALE; }
          }
          uint4 o0, o1, o2, o3;
          o0.x = pack2(x0[0], x0[1]); o0.y = pack2(x0[2], x0[3]); o0.z = pack2(x0[4], x0[5]); o0.w = pack2(x0[6], x0[7]);
          o1.x = pack2(x0[8], x0[9]); o1.y = pack2(x0[10], x0[11]); o1.z = pack2(x0[12], x0[13]); o1.w = pack2(x0[14], x0[15]);
          o2.x = pack2(x1[0], x1[1]); o2.y = pack2(x1[2], x1[3]); o2.z = pack2(x1[4], x1[5]); o2.w = pack2(x1[6], x1[7]);
          o3.x = pack2(x1[8], x1[9]); o3.y = pack2(x1[10], x1[11]); o3.z = pack2(x1[12], x1[13]); o3.w = pack2(x1[14], x1[15]);
          *(uint4*)(dst + c * 16) = o0;
          *(uint4*)(dst + c * 16 + 8) = o1;
          *(uint4*)(dst + 32 + c * 16) = o2;
          *(uint4*)(dst + 32 + c * 16 + 8) = o3;
        }
      }
    };

#pragma unroll
    for (int bj = 0; bj < 2; ++bj) {
      float* Cs = (float*)lds;
#pragma unroll
      for (int ai = 0; ai < 2; ++ai)
#pragma unroll
        for (int m = 0; m < 4; ++m)
#pragma unroll
          for (int n = 0; n < 2; ++n) {
            const int row = ai * 128 + wr * 64 + m * 16 + fr;
            const int col = wc * 32 + n * 16 + fq * 4;
            pg8::f32x4 v = acc[ai][bj][m][n];
            float4 o; o.x = v[0]; o.y = v[1]; o.z = v[2]; o.w = v[3];
            *(float4*)(Cs + row * 132 + col) = o;
          }
      __syncthreads();
      process_unit(bj, tid);
      __syncthreads();
    }
  }
};

DI void phase_gemm_in(CParams& p, int chunk, int l, char* lds) {
  const int NB = p.NB, RL = NB * S, R = NB * (S + L);
  const int MT = R / 256;
  const u16* Wt = p.WinT + (size_t)l * INW * D;
  {
    pg8::Gemm g{p.Hb, Wt, R, 7168, D, D};
    pg8::StaticOrder So; So.init(R, 7168, (int)gridDim.x, (int)blockIdx.x);
    EpiIn E{&p};
    pg8::gemm_phase<EpiIn, pg8::StaticOrder, false>((PG8_LAS unsigned char*)lds, g, So, E, nullptr);
  }
  for (int ti = 0;; ++ti) {
    int mt, jt;
    if (!tile_map(ti, MT, 12, mt, jt)) break;
    const int nt = (jt < 6) ? 8 + jt : 12 + jt;
    pg8::Gemm g{p.Hb, Wt + (size_t)28 * 256 * D, R, 3072, D, D};
    OneUnit One{mt, jt};
    EpiQKV E{&p, lds, l, nt, mt * 256};
    pg8::gemm_phase<EpiQKV, OneUnit, false>((PG8_LAS unsigned char*)lds, g, One, E, nullptr);
  }
}

struct AttnArgs {
  const u16* q;
  u16* z;
  const u16* kctx;
  const u16* vctx;
  const u16* klat;
  const u16* vlat;
  int n_lat_tiles;
  int lat_key0;
  int q_t0;
  int band;
  int has_sink;
  float sink_l2;
  int dry;
  int fixedm;
  float mfix;
};

DI void attn_load_tile(const AttnArgs& a, int ti, u32x4 (&rk)[2], u32x4 (&rv)[2]) {
  const int tid = otid();
  const u16* kp; const u16* vp; int vs;
  if (ti < 4) { kp = a.kctx + (size_t)(ti * 64) * 512; vp = a.vctx + ti * 64; vs = L; }
  else { kp = a.klat + (size_t)((ti - 4) * 64) * 512; vp = a.vlat + (ti - 4) * 64; vs = S; }
#pragma unroll
  for (int i = 0; i < 2; ++i) {
    int c = tid + NTHR * i;
    rk[i] = *(const u32x4*)(kp + (size_t)(c >> 4) * 512 + (c & 15) * 8);
    rv[i] = *(const u32x4*)(vp + (size_t)(c >> 3) * vs + (c & 7) * 8);
  }
}
DI void attn_store_tile(u16* sK, u16* sV, const u32x4 (&rk)[2], const u32x4 (&rv)[2]) {
  const int tid = otid();
#pragma unroll
  for (int i = 0; i < 2; ++i) {
    int c = tid + NTHR * i;
    *(u32x4*)(sK + (c >> 4) * 136 + (c & 15) * 8) = rk[i];
    u16* vd = sV + (c >> 3) * 72 + ((c & 7) >> 1) * 16 + ((c & 7) & 1) * 4;
    { u32x2 t0 = {rv[i].x, rv[i].y}; *(u32x2*)(vd) = t0; }
    { u32x2 t1 = {rv[i].z, rv[i].w}; *(u32x2*)(vd + 8) = t1; }
  }
}

template <bool NS>
DI void attn_item(const AttnArgs& a, char* lds) {
  const int tid = otid(), lane = tid & 63, w = tid >> 6;
  const int r = lane & 31, hh = lane >> 5;
  constexpr int STG = 17408 + 128 * 144;
  const int ntiles = 4 + a.n_lat_tiles;

  bf16x8 qf[8];
  {
    const u16* qp = a.q + (size_t)(w * 32 + r) * 2048 + hh * 8;
#pragma unroll
    for (int ks = 0; ks < 8; ++ks) qf[ks] = *(const bf16x8*)(qp + ks * 16);
  }
  f32x16 O[4];
#pragma unroll
  for (int dt = 0; dt < 4; ++dt)
#pragma unroll
    for (int x = 0; x < 16; ++x) O[dt][x] = 0.f;
  float m = a.fixedm ? a.mfix : (a.has_sink ? a.sink_l2 : -1e30f);
  float lsum = (a.has_sink && hh == 0) ? 1.f : 0.f;
  const int qpos = a.q_t0 + w * 32 + r;

  auto QK = [&](int stage, f32x16 (&sc)[2]) {
    const u16* sK = (const u16*)(lds + stage * STG);
#pragma unroll
    for (int x = 0; x < 16; ++x) { sc[0][x] = 0.f; sc[1][x] = 0.f; }
    const u16* kb0 = sK + r * 136 + hh * 8;
    const u16* kb1 = sK + (32 + r) * 136 + hh * 8;
#pragma unroll
    for (int ks = 0; ks < 8; ++ks) {
      bf16x8 ka0 = *(const bf16x8*)(kb0 + ks * 16);
      bf16x8 ka1 = *(const bf16x8*)(kb1 + ks * 16);
      sc[0] = MFMA32(ka0, qf[ks], sc[0]);
      sc[1] = MFMA32(ka1, qf[ks], sc[1]);
    }
  };
  u32x4 rk[2], rv[2], rk1[2], rv1[2];
  auto STEP = [&](int ti, int st, f32x16 (&sc)[2], f32x16 (&sn)[2], u32x4 (&lk)[2], u32x4 (&lv)[2], u32x4 (&sk)[2], u32x4 (&sv)[2]) {
    const int st1 = (st == 2) ? 0 : st + 1, st2 = (st == 0) ? 2 : st - 1;
    if (ti + 3 < ntiles) attn_load_tile(a, ti + 3, lk, lv);
    if (ti + 1 < ntiles) QK(st1, sn);
    if (a.band && ti >= 4) {
      const int k0 = a.lat_key0 + (ti - 4) * 64;
#pragma unroll
      for (int kt2 = 0; kt2 < 2; ++kt2)
#pragma unroll
        for (int x = 0; x < 16; ++x) {
          int kp = k0 + kt2 * 32 + crow(x, hh);
          int dlt = kp - qpos; dlt = dlt < 0 ? -dlt : dlt;
          if (dlt > 128) sc[kt2][x] = -1e30f;
        }
    }
    if (!NS && !a.fixedm) {
      float mx = sc[0][0];
#pragma unroll
      for (int kt2 = 0; kt2 < 2; ++kt2)
#pragma unroll
        for (int x = 0; x < 16; ++x) mx = fmaxf(mx, sc[kt2][x]);
      mx = fmaxf(mx, __shfl_xor(mx, 32));
      if (__any(mx > m + 8.f)) {
        const float mnew = fmaxf(m, mx);
        const float alpha = __builtin_amdgcn_exp2f(m - mnew);
        m = mnew;
        lsum *= alpha;
#pragma unroll
        for (int dt = 0; dt < 4; ++dt)
#pragma unroll
          for (int x = 0; x < 16; ++x) O[dt][x] *= alpha;
      }
    }
    float ps = 0.f;
#pragma unroll
    for (int kt2 = 0; kt2 < 2; ++kt2)
#pragma unroll
      for (int x = 0; x < 16; ++x) { float pv = NS ? __builtin_amdgcn_exp2f(sc[kt2][x]) : __builtin_amdgcn_exp2f(sc[kt2][x] - m); sc[kt2][x] = pv; ps += pv; }
    lsum += ps;
    const u16* sV = (const u16*)(lds + st * STG + 17408);
#pragma unroll
    for (int kt2 = 0; kt2 < 2; ++kt2)
#pragma unroll
      for (int s2 = 0; s2 < 2; ++s2) {
        union { unsigned u[4]; bf16x8 v; } pf;
#pragma unroll
        for (int j = 0; j < 4; ++j) pf.u[j] = pack2(sc[kt2][8 * s2 + 2 * j], sc[kt2][8 * s2 + 2 * j + 1]);
        const u16* vb = sV + r * 72 + kt2 * 32 + 16 * s2 + 8 * hh;
#pragma unroll
        for (int dt = 0; dt < 4; ++dt) {
          bf16x8 va = *(const bf16x8*)(vb + dt * 32 * 72);
          O[dt] = MFMA32(va, pf.v, O[dt]);
        }
      }
    if (ti + 2 < ntiles) attn_store_tile((u16*)(lds + st2 * STG), (u16*)(lds + st2 * STG + 17408), sk, sv);
    asm volatile("s_waitcnt lgkmcnt(0)" ::: "memory");
    __builtin_amdgcn_s_barrier();
    asm volatile("" ::: "memory");
  };

  attn_load_tile(a, 0, rk, rv);
  __syncthreads();
  attn_store_tile((u16*)lds, (u16*)(lds + 17408), rk, rv);
  attn_load_tile(a, 1, rk, rv);
  attn_store_tile((u16*)(lds + STG), (u16*)(lds + STG + 17408), rk, rv);
  attn_load_tile(a, 2, rk, rv);
  __syncthreads();
  f32x16 sA[2], sB[2];
  QK(0, sA);
  int st = 0;
  for (int ti = 0; ti < ntiles; ti += 2) {
    STEP(ti, st, sA, sB, rk1, rv1, rk, rv);
    st = (st == 2) ? 0 : st + 1;
    if (ti + 1 < ntiles) {
      STEP(ti + 1, st, sB, sA, rk, rv, rk1, rv1);
      st = (st == 2) ? 0 : st + 1;
    }
  }
  float ltot = lsum + __shfl_xor(lsum, 32);
  const float inv = 1.f / ltot;
  u16* zp = a.z + (size_t)(w * 32 + r) * 3072;
  u32x2 gv[4][4];
#pragma unroll
  for (int dt = 0; dt < 4; ++dt)
#pragma unroll
    for (int g4 = 0; g4 < 4; ++g4) gv[dt][g4] = *(const u32x2*)(zp + dt * 32 + 8 * g4 + 4 * hh);
#pragma unroll
  for (int dt = 0; dt < 4; ++dt)
#pragma unroll
    for (int g4 = 0; g4 < 4; ++g4) {
      int d0 = dt * 32 + 8 * g4 + 4 * hh;
      float y0 = O[dt][4 * g4 + 0] * inv * bflo(gv[dt][g4].x);
      float y1 = O[dt][4 * g4 + 1] * inv * bfhi(gv[dt][g4].x);
      float y2 = O[dt][4 * g4 + 2] * inv * bflo(gv[dt][g4].y);
      float y3 = O[dt][4 * g4 + 3] * inv * bfhi(gv[dt][g4].y);
      uint2 o; o.x = pack2(y0, y1); o.y = pack2(y2, y3);
      if (!a.dry || y0 != y0) *(uint2*)(zp + d0) = o;
    }
}

template <bool REV>
DI void lru_scan(float (&av)[2][16], float (&bv)[2][16], float& carry, int hh) {
  float segA[8], segB[8];
#pragma unroll
  for (int k = 0; k < 8; ++k) {
    const int mt = k >> 2, q = k & 3;
    float cA = 1.f, hl = 0.f;
#pragma unroll
    for (int jj = 0; jj < 4; ++jj) {
      const int j = REV ? 3 - jj : jj;
      const int i = 4 * q + j;
      hl = av[mt][i] * hl + bv[mt][i];
      cA *= av[mt][i];
      av[mt][i] = cA; bv[mt][i] = hl;
    }
    segA[k] = cA; segB[k] = hl;
  }
  float oA[8], oB[8];
#pragma unroll
  for (int k = 0; k < 8; ++k) { oA[k] = __shfl_xor(segA[k], 32); oB[k] = __shfl_xor(segB[k], 32); }
  float init[8];
  float st = carry;
#pragma unroll
  for (int kk = 0; kk < 8; ++kk) {
    const int k = REV ? 7 - kk : kk;
    const int first = REV ? 1 : 0;
    float A1 = (hh == first) ? segA[k] : oA[k];
    float B1 = (hh == first) ? segB[k] : oB[k];
    float st0 = st;
    st = A1 * st + B1;
    float A2 = (hh == first) ? oA[k] : segA[k];
    float B2 = (hh == first) ? oB[k] : segB[k];
    float st1 = st;
    st = A2 * st + B2;
    init[k] = (hh == first) ? st0 : st1;
  }
  carry = st;
#pragma unroll
  for (int k = 0; k < 8; ++k) {
    const int mt = k >> 2, q = k & 3;
#pragma unroll
    for (int j = 0; j < 4; ++j) {
      const int i = 4 * q + j;
      bv[mt][i] = bv[mt][i] + av[mt][i] * init[k];
    }
  }
}

DI void lru_item(CParams& p, int l, int b, int n, bool last, char* lds, int dry = 0) {
  const int NB = p.NB, RL = NB * S;
  const int tid = otid(), lane = tid & 63, w8 = tid >> 6;
  const int sub = __builtin_amdgcn_readfirstlane(w8 >> 2), w = w8 & 3;
  n = n + sub;
  lds += sub * 73728;
  const int dir = w >> 1, w2 = w & 1;
  const int tl = tid & 127;
  const int r = lane & 31, hh = lane >> 5;
  u16* sRaw = (u16*)lds + dir * (8704 / 2);
  u16* sUp = (u16*)(lds + 17408) + dir * (9216 / 2);
  float* sH = (float*)(lds + 35840) + w * (64 * 36);

  const int chb = n * 64;
  const int cp = (tl & 31) * 2, tg = tl >> 5;
  float cw0[4], cw1[4], cb0, cb1;
#pragma unroll
  for (int k = 0; k < 4; ++k) {
    cw0[k] = p.conv_w[((size_t)l * 4 + k) * D + chb + cp];
    cw1[k] = p.conv_w[((size_t)l * 4 + k) * D + chb + cp + 1];
  }
  cb0 = p.conv_b[l * D + chb + cp]; cb1 = p.conv_b[l * D + chb + cp + 1];
  bf16x8 waf[4], wxf[4];
  {
    const float* wa = p.lru_wa + (((size_t)(l * 2 + dir) * 16 + n) * 64) * 64;
    const float* wx = p.lru_wx + (((size_t)(l * 2 + dir) * 16 + n) * 64) * 64;
    const int e = 32 * w2 + r;
#pragma unroll
    for (int ks = 0; ks < 4; ++ks) {
      union { unsigned u[4]; bf16x8 v; } fa, fx;
#pragma unroll
      for (int j = 0; j < 4; ++j) {
        int d0 = ks * 16 + 8 * hh + 2 * j;
        fa.u[j] = pack2(wa[d0 * 64 + e], wa[(d0 + 1) * 64 + e]);
        fx.u[j] = pack2(wx[d0 * 64 + e], wx[(d0 + 1) * 64 + e]);
      }
      waf[ks] = fa.v; wxf[ks] = fx.v;
    }
  }
  const int che = chb + 32 * w2 + r;
  const float ba = p.lru_ba[(l * 2 + dir) * D + che];
  const float bx = p.lru_bx[(l * 2 + dir) * D + che];
  float c8sp;
  {
    float lam = p.lru_lambda[(l * 2 + dir) * D + che];
    float sp = (lam < -20.f) ? -lam : log1pf(expf(-lam));
    c8sp = 8.f * sp;
  }
  float carry = 0.f;

  auto step_tile = [&](int st, bool& isctx, int& tt) {
    if (dir == 0) { if (st < 4) { isctx = true; tt = st; } else { isctx = false; tt = st - 4; } }
    else { if (st < 4) { isctx = true; tt = 3 - st; } else { isctx = false; tt = 63 - (st - 4); } }
  };
  u32x4 pre[5];
  auto load_raw = [&](int st) {
    bool isctx; int tt; step_tile(st, isctx, tt);
    const int seqlen = isctx ? L : S;
    const size_t rowbase = isctx ? (size_t)RL + (size_t)b * L : (size_t)b * S;
    const int t0 = tt * 64;
#pragma unroll
    for (int i = 0; i < 5; ++i) {
      int c = tl + 128 * i;
      int rr = c >> 3, c16 = c & 7;
      int t = t0 - 2 + rr;
      u32x4 v = {0u, 0u, 0u, 0u};
      if (rr < 67 && t >= 0 && t < seqlen) v = *(const u32x4*)(p.U + (rowbase + t) * D + chb + c16 * 8);
      pre[i] = v;
    }
  };
  load_raw(0);
  __syncthreads();
  for (int st = 0; st < 68; ++st) {
    bool isctx; int tt; step_tile(st, isctx, tt);
    const size_t rowbase = isctx ? (size_t)RL + (size_t)b * L : (size_t)b * S;
    const int t0 = tt * 64;
#pragma unroll
    for (int i = 0; i < 5; ++i) {
      int c = tl + 128 * i;
      int rr = c >> 3, c16 = c & 7;
      if (rr < 67) *(u32x4*)(sRaw + rr * 64 + c16 * 8) = pre[i];
    }
    if (st + 1 < 68) load_raw(st + 1);
    asm volatile("s_waitcnt lgkmcnt(0)" ::: "memory"); __builtin_amdgcn_s_barrier(); asm volatile("" ::: "memory");
    {
      const u16* rp = sRaw + (tg * 16) * 64 + cp;
      unsigned r0 = *(const unsigned*)(rp), r1 = *(const unsigned*)(rp + 64), r2 = *(const unsigned*)(rp + 128);
#pragma unroll
      for (int i = 0; i < 16; ++i) {
        unsigned r3 = *(const unsigned*)(rp + (i + 3) * 64);
        float o0 = cb0 + cw0[0] * bflo(r0) + cw0[1] * bflo(r1) + cw0[2] * bflo(r2) + cw0[3] * bflo(r3);
        float o1 = cb1 + cw1[0] * bfhi(r0) + cw1[1] * bfhi(r1) + cw1[2] * bfhi(r2) + cw1[3] * bfhi(r3);
        *(unsigned*)(sUp + (tg * 16 + i) * 72 + cp) = pack2(o0, o1);
        r0 = r1; r1 = r2; r2 = r3;
      }
    }
    asm volatile("s_waitcnt lgkmcnt(0)" ::: "memory"); __builtin_amdgcn_s_barrier(); asm volatile("" ::: "memory");
    const bool fwd_first = isctx ? (tt <= 1) : (tt <= 31);
    const bool first = (dir == 0) ? fwd_first : !fwd_first;
    unsigned long long pt0[4], pt1[4];
    u32x4 pg[4];
    if (!first && !(isctx && last)) {
#pragma unroll
      for (int j = 0; j < 4; ++j) {
        const int q = lane + 64 * j;
        const int tok = q >> 2, cc = (q & 3) * 8;
        const size_t row = rowbase + t0 + tok;
        const int col = chb + 32 * w2 + cc;
        const u16* tp = p.Hb + row * D + col;
        pt0[j] = __hip_atomic_load((const unsigned long long*)tp, __ATOMIC_RELAXED, __HIP_MEMORY_SCOPE_AGENT);
        pt1[j] = __hip_atomic_load((const unsigned long long*)tp + 1, __ATOMIC_RELAXED, __HIP_MEMORY_SCOPE_AGENT);
        pg[j] = *(const u32x4*)(p.Z + row * 3072 + col);
      }
    } else {
#pragma unroll
      for (int j = 0; j < 4; ++j) { pt0[j] = 0; pt1[j] = 0; pg[j] = u32x4{0u, 0u, 0u, 0u}; }
    }
    float av[2][16], bv[2][16];
    {
      f32x16 aR[2];
#pragma unroll
      for (int mt = 0; mt < 2; ++mt) {
#pragma unroll
        for (int x = 0; x < 16; ++x) aR[mt][x] = 0.f;
        const u16* ub = sUp + (mt * 32 + r) * 72 + hh * 8;
#pragma unroll
        for (int ks = 0; ks < 4; ++ks) aR[mt] = MFMA32(*(const bf16x8*)(ub + ks * 16), waf[ks], aR[mt]);
      }
#pragma unroll
      for (int mt = 0; mt < 2; ++mt)
#pragma unroll
        for (int x = 0; x < 16; ++x) {
          const float rg = sigmoidf_(aR[mt][x] + ba);
          av[mt][x] = -c8sp * rg;
        }
    }
    {
      f32x16 aI[2];
#pragma unroll
      for (int mt = 0; mt < 2; ++mt) {
#pragma unroll
        for (int x = 0; x < 16; ++x) aI[mt][x] = 0.f;
        const u16* ub = sUp + (mt * 32 + r) * 72 + hh * 8;
#pragma unroll
        for (int ks = 0; ks < 4; ++ks) aI[mt] = MFMA32(*(const bf16x8*)(ub + ks * 16), wxf[ks], aI[mt]);
      }
#pragma unroll
      for (int mt = 0; mt < 2; ++mt)
#pragma unroll
        for (int x = 0; x < 16; ++x) {
          const int tok = mt * 32 + crow(x, hh);
          const float up = bf2f(sUp[tok * 72 + 32 * w2 + r]);
          const float ig = sigmoidf_(aI[mt][x] + bx);
          const float la = av[mt][x];
          const float a_ = __expf(la);
          const float om = fmaxf(1.f - a_ * a_, 0.f);
          av[mt][x] = a_;
          bv[mt][x] = __builtin_amdgcn_sqrtf(om) * (ig * up);
        }
    }
    if (dir == 0) lru_scan<false>(av, bv, carry, hh); else lru_scan<true>(av, bv, carry, hh);
#pragma unroll
    for (int mt = 0; mt < 2; ++mt)
#pragma unroll
      for (int x = 0; x < 16; ++x) sH[(mt * 32 + crow(x, hh)) * 36 + r] = bv[mt][x];
    if (!(isctx && last)) {
#pragma unroll
      for (int j = 0; j < 4; ++j) {
        const int q = lane + 64 * j;
        const int tok = q >> 2, cc = (q & 3) * 8;
        const float4 h0 = *(const float4*)(sH + tok * 36 + cc);
        const float4 h1 = *(const float4*)(sH + tok * 36 + cc + 4);
        const size_t row = rowbase + t0 + tok;
        const int col = chb + 32 * w2 + cc;
        u16* tp = p.Hb + row * D + col;
        if (first) {
          uint4 o; o.x = pack2(h0.x, h0.y); o.y = pack2(h0.z, h0.w); o.z = pack2(h1.x, h1.y); o.w = pack2(h1.z, h1.w);
          if (!dry || h0.x != h0.x) *(uint4*)tp = o;
        } else {
          unsigned tx = (unsigned)pt0[j], ty = (unsigned)(pt0[j] >> 32), tz = (unsigned)pt1[j], tw = (unsigned)(pt1[j] >> 32);
          u16* zp = p.Z + row * 3072 + col;
          u32x4 g = pg[j];
          uint4 o;
          o.x = pack2((h0.x + bflo(tx)) * bflo(g.x), (h0.y + bfhi(tx)) * bfhi(g.x));
          o.y = pack2((h0.z + bflo(ty)) * bflo(g.y), (h0.w + bfhi(ty)) * bfhi(g.y));
          o.z = pack2((h1.x + bflo(tz)) * bflo(g.z), (h1.y + bfhi(tz)) * bfhi(g.z));
          o.w = pack2((h1.z + bflo(tw)) * bflo(g.w), (h1.w + bfhi(tw)) * bfhi(g.w));
          if (!dry || h0.x != h0.x) *(uint4*)zp = o;
        }
      }
    }
    __builtin_amdgcn_fence(__ATOMIC_RELEASE, "workgroup");
  }
}

DI void phase_mixers(CParams& p, int chunk, int l, char* lds, int dry = 0) {
  const int NB = p.NB, RL = NB * S;
  const bool last = (l == DEPTH - 1);
  const int nLRU = (dry == 1) ? 0 : NB * 8, nC = (dry == 2) ? 0 : NB * 8 * 16, nBw = (dry == 2) ? 0 : NB * 8 * 16, nCtx = (last || dry == 2) ? 0 : NB * 8 * 2;
  const int total = nLRU + nC + nBw + nCtx;
  int* ctr = p.ctr + chunk * DEPTH + l + (dry ? 32 : 0);
  int* s_item = (int*)(lds + LDS_BYTES - 16);
  int it;
  while (true) {
    __syncthreads();
    if (threadIdx.x == 0) *s_item = atomicAdd(ctr, 1);
    __syncthreads();
    it = __builtin_amdgcn_readfirstlane(*s_item);
    __syncthreads();
    if (it >= nLRU) break;
    lru_item(p, l, it >> 3, (it & 7) * 2, last, lds, dry);
  }
  float gqm = 0.f, gkm = 0.f;
  {
    const int ln = otid() & 63;
    gqm = fmaxf(fabsf(p.q_norm_g[l * 128 + ln]), fabsf(p.q_norm_g[l * 128 + 64 + ln]));
    gkm = fmaxf(fabsf(p.k_norm_g[l * 128 + ln]), fabsf(p.k_norm_g[l * 128 + 64 + ln]));
#pragma unroll
    for (int o = 32; o >= 1; o >>= 1) { gqm = fmaxf(gqm, __shfl_xor(gqm, o)); gkm = fmaxf(gkm, __shfl_xor(gkm, o)); }
    gqm = __builtin_amdgcn_readfirstlane(gqm); gkm = __builtin_amdgcn_readfirstlane(gkm);
  }
  const float mfixC = 128.f * gqm * gkm * QSCALE;
  const int nCfast = (mfixC < 60.f) ? nC : 0;
  auto fetch = [&]() {
    __syncthreads();
    if (threadIdx.x == 0) *s_item = atomicAdd(ctr, 1);
    __syncthreads();
    it = __builtin_amdgcn_readfirstlane(*s_item);
    __syncthreads();
  };
  auto build = [&](int ir, AttnArgs& a) {
    a.dry = dry;
    if (ir < nC + nBw) {
      const bool isB = ir >= nC;
      if (isB) ir -= nC;
      const int b = ir >> 7, h = (ir >> 4) & 7, qb = ir & 15;
      const int kvh = h >> 2;
      const int br = isB ? 0 : 1;
      const size_t qrow0 = (size_t)b * S + qb * 256;
      a.q = p.Q + qrow0 * 2048 + br * 1024 + h * 128;
      a.z = p.Z + qrow0 * 3072 + (br + 1) * 1024 + h * 128;
      const int kcol = br * 256 + kvh * 128, slot = br * 2 + kvh;
      a.kctx = p.Kb + ((size_t)RL + (size_t)b * L) * 512 + kcol;
      a.vctx = p.VtC + (size_t)(b * 4 + slot) * 128 * L;
      int k0, k1;
      if (isB) { k0 = qb * 256 - 128; if (k0 < 0) k0 = 0; k1 = qb * 256 + 384; if (k1 > S) k1 = S; }
      else { k0 = 0; k1 = S; }
      a.lat_key0 = k0;
      a.n_lat_tiles = (k1 - k0) >> 6;
      a.klat = p.Kb + ((size_t)b * S + k0) * 512 + kcol;
      a.vlat = p.VtL + (size_t)(b * 4 + slot) * 128 * S + k0;
      a.q_t0 = qb * 256;
      a.band = isB ? 1 : 0;
      a.has_sink = isB ? 1 : 0;
      a.sink_l2 = isB ? p.attn_sink[l * 8 + h] * LOG2E : 0.f;
      a.fixedm = isB ? 0 : 1; a.mfix = mfixC;
    } else {
      ir -= nC + nBw;
      const int h = ir & 7, br = (ir >> 3) & 1, b = ir >> 4;
      const int kvh = h >> 2;
      const size_t qrow0 = (size_t)RL + (size_t)b * L;
      a.q = p.Q + qrow0 * 2048 + br * 1024 + h * 128;
      a.z = p.Z + qrow0 * 3072 + (br + 1) * 1024 + h * 128;
      const int kcol = br * 256 + kvh * 128, slot = br * 2 + kvh;
      a.kctx = p.Kb + ((size_t)RL + (size_t)b * L) * 512 + kcol;
      a.vctx = p.VtC + (size_t)(b * 4 + slot) * 128 * L;
      a.klat = a.kctx; a.vlat = a.vctx;
      a.n_lat_tiles = 0; a.lat_key0 = 0; a.q_t0 = 0; a.band = 0;
      a.has_sink = (br == 0) ? 1 : 0;
      a.sink_l2 = (br == 0) ? p.attn_sink[l * 8 + h] * LOG2E : 0.f;
      a.fixedm = (br == 0) ? 0 : 1; a.mfix = mfixC;
    }
  };
  while (it < nLRU + nCfast) {
    AttnArgs a;
    build(it - nLRU, a);
    attn_item<true>(a, lds);
    fetch();
  }
  while (it < total) {
    AttnArgs a;
    build(it - nLRU, a);
    attn_item<false>(a, lds);
    fetch();
  }
}

DI void merge_tiles_ctx(CParams& p, int l, char* lds) {
  const int NB = p.NB, RL = NB * S, R = NB * (S + L);
  const int MT = (R - RL) / 256, NT = 8;
  const int tid = otid();
  const int lane = tid & 63, w = tid >> 6, wm = w >> 1, wn = w & 1, r = lane & 31, hh = lane >> 5;
  for (int ti = 0;; ++ti) {
    int mt, nt;
    if (!tile_map(ti, MT, NT, mt, nt)) break;
    const int m0 = RL + mt * 256, n0 = nt * 128;
    f32x16 tot[2][2];
#pragma unroll
    for (int i = 0; i < 2; ++i)
#pragma unroll
      for (int j = 0; j < 2; ++j)
#pragma unroll
        for (int x = 0; x < 16; ++x) tot[i][j][x] = 0.f;
#pragma unroll 1
    for (int n = 0; n < 3; ++n) {
      f32x16 acc[2][2];
      gemm_core<128, false>(p.Z + (size_t)m0 * 3072 + n * 1024, 3072, 64, (size_t)128 * 3072,
                            p.WbT + ((size_t)(l * 3 + n) * D + n0) * D, D, 64, 0, D, lds, acc);
#pragma unroll
      for (int i = 0; i < 2; ++i)
#pragma unroll
        for (int j = 0; j < 2; ++j)
#pragma unroll
          for (int g = 0; g < 4; ++g) {
            const size_t row = (size_t)m0 + wm * 64 + i * 32 + r;
            const int col = n0 + wn * 64 + j * 32 + 8 * g + 4 * hh;
            uint2 sv = *(const uint2*)(p.Ms + row * 3072 + n * 1024 + col);
            tot[i][j][4 * g + 0] += bflo(sv.x) * acc[i][j][4 * g + 0];
            tot[i][j][4 * g + 1] += bfhi(sv.x) * acc[i][j][4 * g + 1];
            tot[i][j][4 * g + 2] += bflo(sv.y) * acc[i][j][4 * g + 2];
            tot[i][j][4 * g + 3] += bfhi(sv.y) * acc[i][j][4 * g + 3];
          }
    }
#pragma unroll
    for (int i = 0; i < 2; ++i)
#pragma unroll
      for (int j = 0; j < 2; ++j)
#pragma unroll
        for (int g = 0; g < 4; ++g) {
          const size_t row = (size_t)m0 + wm * 64 + i * 32 + r;
          const int col = n0 + wn * 64 + j * 32 + 8 * g + 4 * hh;
          uint2 o; o.x = pack2(tot[i][j][4 * g], tot[i][j][4 * g + 1]); o.y = pack2(tot[i][j][4 * g + 2], tot[i][j][4 * g + 3]);
          *(uint2*)(p.Hb + row * D + col) = o;
        }
  }
}

struct MergeOrder {
  pg8::StaticOrder inner;
  __device__ void init(int M, int G, int c) { inner.init(M, 1024, G, c); }
  __device__ bool next(int i, pg8::Unit& u) const {
    const int j = i / 3, n = i - 3 * j;
    pg8::Unit t;
    if (!inner.next(j, t)) return false;
    u.pm = t.pm; u.pn = n * 4 + t.pn;
    return true;
  }
  __device__ __forceinline__ void a_ready(const pg8::Unit&) const {}
  __device__ __forceinline__ void done(const pg8::Unit&) const {}
  __device__ __forceinline__ size_t a_off(const pg8::Unit& u) const { return (size_t)(u.pn >> 2) * 1024 * 2; }
};
struct EpiMerge {
  static constexpr bool PERM = true, AFTER_DRAIN = false;
  CParams* kp;
  __device__ __forceinline__ void operator()(const pg8::f32x4 (&acc)[2][2][4][2], const pg8::Unit& u, int wr, int wc, int fr, int fq) const {
    const int n = u.pn >> 2, ct = u.pn & 3;
    const int row0 = u.pm * 256 + wr * 64 + fr;
    const int col0 = ct * 256 + wc * 32 + 8 * fq;
    const u16* __restrict__ sg = kp->Ms + n * 1024;
    const u16* __restrict__ mrd = kp->Q;
    u16* __restrict__ mwr = kp->Q;
    u16* __restrict__ hb = kp->Hb;
#pragma unroll
    for (int ai = 0; ai < 2; ++ai) {
      const int mb = 0;
      u32x4 sv[4][2], pa[4][2];
#pragma unroll
      for (int mm = 0; mm < 4; ++mm) {
        const size_t row = (size_t)(row0 + ai * 128 + (mb + mm) * 16);
#pragma unroll
        for (int bj = 0; bj < 2; ++bj) {
          sv[mm][bj] = *(const u32x4*)(sg + row * 3072 + col0 + bj * 128);
          if (n > 0) pa[mm][bj] = *(const u32x4*)(mrd + row * D + col0 + bj * 128);
        }
      }
#pragma unroll
      for (int mm = 0; mm < 4; ++mm) {
        const size_t row = (size_t)(row0 + ai * 128 + (mb + mm) * 16);
#pragma unroll
        for (int bj = 0; bj < 2; ++bj) {
          pg8::f32x4 v0 = acc[ai][bj][mb + mm][0], v1 = acc[ai][bj][mb + mm][1];
          v0[0] *= bflo(sv[mm][bj].x); v0[1] *= bfhi(sv[mm][bj].x); v0[2] *= bflo(sv[mm][bj].y); v0[3] *= bfhi(sv[mm][bj].y);
          v1[0] *= bflo(sv[mm][bj].z); v1[1] *= bfhi(sv[mm][bj].z); v1[2] *= bflo(sv[mm][bj].w); v1[3] *= bfhi(sv[mm][bj].w);
          if (n > 0) {
            v0[0] += bflo(pa[mm][bj].x); v0[1] += bfhi(pa[mm][bj].x); v0[2] += bflo(pa[mm][bj].y); v0[3] += bfhi(pa[mm][bj].y);
            v1[0] += bflo(pa[mm][bj].z); v1[1] += bfhi(pa[mm][bj].z); v1[2] += bflo(pa[mm][bj].w); v1[3] += bfhi(pa[mm][bj].w);
          }
          u32x4 w; w.x = pack2(v0[0], v0[1]); w.y = pack2(v0[2], v0[3]); w.z = pack2(v1[0], v1[1]); w.w = pack2(v1[2], v1[3]);
          if (n < 2) *(u32x4*)(mwr + row * D + col0 + bj * 128) = w;
          else *(u32x4*)(hb + row * D + col0 + bj * 128) = w;
        }
      }
    }
  }
};


DI void phase_merge(CParams& p, int chunk, int l, char* lds) {
  const int NB = p.NB, RL = NB * S;
  const bool last = (l == DEPTH - 1);
  pg8::Gemm g{p.Z, p.WbT + (size_t)l * 3 * D * D, RL, 3 * D, D, 3072};
  MergeOrder Mo; Mo.init(RL, (int)gridDim.x, (int)blockIdx.x);
  EpiMerge E{&p};
  pg8::gemm_phase<EpiMerge, MergeOrder, false>((PG8_LAS unsigned char*)lds, g, Mo, E, nullptr);
  if (!last) merge_tiles_ctx(p, l, lds);
}

struct EpiOut {
  static constexpr bool PERM = false, AFTER_DRAIN = false;
  CParams* kp; int chunk, l;
  __device__ __forceinline__ void operator()(const pg8::f32x4 (&acc)[2][2][4][2], const pg8::Unit& u, int wr, int wc, int fr, int fq) const {
    const int NB = kp->NB, RL = NB * S;
    const int gr0 = u.pm * 256;
    const float* src; float* dst; int mrow;
    if (gr0 < RL) {
      const int b = gr0 / S, t = gr0 % S, bg = chunk * NB + b;
      const size_t off = ((size_t)bg * S + t) * D;
      src = (l == 0 ? kp->x : kp->out) + off; dst = kp->out + off; mrow = bg;
    } else {
      const int rc = gr0 - RL, b = rc / L, t = rc % L, bg = chunk * NB + b;
      const size_t off = ((size_t)bg * L + t) * D;
      src = (l == 0 ? kp->ctx : kp->xc) + off; dst = kp->xc + off; mrow = 16;
    }
    const int col0 = u.pn * 256 + wc * 32 + 4 * fq;
    const float* gate = kp->modv + ((size_t)l * 17 + mrow) * 3072 + 2048 + col0;
    pg8::f32x4 gv[2][2];
#pragma unroll
    for (int bj = 0; bj < 2; ++bj)
#pragma unroll
      for (int n = 0; n < 2; ++n) gv[bj][n] = *(const pg8::f32x4*)(gate + bj * 128 + n * 16);
    const int row0 = wr * 64 + fr;
    const float* __restrict__ srd = src;
    float* __restrict__ dwr = dst;
#pragma unroll
    for (int ai = 0; ai < 2; ++ai) {
      pg8::f32x4 xv[4][2][2];
#pragma unroll
      for (int m = 0; m < 4; ++m) {
        const size_t ro = (size_t)(row0 + ai * 128 + m * 16) * D + col0;
#pragma unroll
        for (int bj = 0; bj < 2; ++bj)
#pragma unroll
          for (int n = 0; n < 2; ++n) xv[m][bj][n] = *(const pg8::f32x4*)(srd + ro + bj * 128 + n * 16);
      }
#pragma unroll
      for (int m = 0; m < 4; ++m) {
        const size_t ro = (size_t)(row0 + ai * 128 + m * 16) * D + col0;
#pragma unroll
        for (int bj = 0; bj < 2; ++bj)
#pragma unroll
          for (int n = 0; n < 2; ++n) {
            pg8::f32x4 o = xv[m][bj][n] + gv[bj][n] * acc[ai][bj][m][n];
            *(pg8::f32x4*)(dwr + ro + bj * 128 + n * 16) = o;
          }
      }
    }
  }
};

DI void phase_outproj(CParams& p, int chunk, int l, char* lds) {
  const int NB = p.NB, RL = NB * S, R = NB * (S + L);
  const bool last = (l == DEPTH - 1);
  const int rows = last ? RL : R;
  pg8::Gemm g{p.Hb, p.WoT + (size_t)l * D * D, rows, D, D, D};
  pg8::StaticOrder So; So.init(rows, D, (int)gridDim.x, (int)blockIdx.x);
  EpiOut E{&p, chunk, l};
  pg8::gemm_phase<EpiOut, pg8::StaticOrder, false>((PG8_LAS unsigned char*)lds, g, So, E, nullptr);
}

DI void phase_final(CParams& p) {
  const int tid_ = otid();
  const int lane = tid_ & 63;
  const int wg = blockIdx.x * 8 + (tid_ >> 6), nw = gridDim.x * 8;
  for (int r = wg; r < NBATCH * S; r += nw) {
    float* src = p.out + (size_t)r * D;
    float4 v[4]; float ss = 0.f;
#pragma unroll
    for (int i = 0; i < 4; ++i) {
      v[i] = *(const float4*)(src + i * 256 + lane * 4);
      ss += v[i].x * v[i].x + v[i].y * v[i].y + v[i].z * v[i].z + v[i].w * v[i].w;
    }
#pragma unroll
    for (int o = 32; o >= 1; o >>= 1) ss += __shfl_xor(ss, o);
    float rstd = rsqrtf(ss * (1.f / D) + EPS);
#pragma unroll
    for (int i = 0; i < 4; ++i) {
      int cidx = i * 256 + lane * 4;
      float4 gg = *(const float4*)(p.final_g + cidx);
      float4 o;
      o.x = v[i].x * rstd * gg.x; o.y = v[i].y * rstd * gg.y; o.z = v[i].z * rstd * gg.z; o.w = v[i].w * rstd * gg.w;
      *(float4*)(src + cidx) = o;
    }
  }
}

#ifndef DUP_PHASE
#define DUP_PHASE 0
#endif
__global__ void __launch_bounds__(NTHR, 2) fwd_megakernel(Params p_unused) {
  CParams* kp = (CParams*)__builtin_amdgcn_kernarg_segment_ptr();
  cg::grid_group grid = cg::this_grid();
  __shared__ __attribute__((aligned(16))) char lds[LDS_BYTES];
  phase0(*opaque_kp(kp), lds);
  grid.sync();
  phase_mod(*opaque_kp(kp), lds);
  grid.sync();
  for (int chunk = 0; chunk < kp->nchunk; ++chunk) {
    for (int l = 0; l < DEPTH; ++l) {
      phase_prenorm(*opaque_kp(kp), chunk, l);
      grid.sync();
#if DUP_PHASE == 9
      grid.sync(); grid.sync(); grid.sync(); grid.sync(); grid.sync();
#endif
      phase_gemm_in(*opaque_kp(kp), chunk, l, lds);
      grid.sync();
#if DUP_PHASE == 3
      phase_gemm_in(*opaque_kp(kp), chunk, l, lds);
      grid.sync();
#endif
#if DUP_PHASE == 4
      phase_mixers(*opaque_kp(kp), chunk, l, lds, 1);
      grid.sync();
#endif
#if DUP_PHASE == 6
      phase_mixers(*opaque_kp(kp), chunk, l, lds, 2);
      grid.sync();
#endif
      phase_mixers(*opaque_kp(kp), chunk, l, lds);
      grid.sync();
      phase_merge(*opaque_kp(kp), chunk, l, lds);
      grid.sync();
#if DUP_PHASE == 5
      phase_merge(*opaque_kp(kp), chunk, l, lds);
      grid.sync();
#endif
      phase_outproj(*opaque_kp(kp), chunk, l, lds);
      grid.sync();
    }
  }
  phase_final(*opaque_kp(kp));
}

extern "C" void kernel_launch(void* const* d_in, const int* in_sizes, int n_in,
                              void* d_out, int out_size, void* d_ws, size_t ws_size,
                              hipStream_t stream) {
  static int grid_blocks = 0;
  if (!grid_blocks) {
    int dev = 0, cus = 0, per_cu = 0;
    (void)hipGetDevice(&dev);
    (void)hipDeviceGetAttribute(&cus, hipDeviceAttributeMultiprocessorCount, dev);
    (void)hipOccupancyMaxActiveBlocksPerMultiprocessor(&per_cu, fwd_megakernel, NTHR, 0);
    if (per_cu > 1) per_cu = 1;
    if (per_cu < 1) per_cu = 1;
    grid_blocks = cus * per_cu;
  }
  Params p{};
  const float* const* in = (const float* const*)d_in;
  p.x = in[0]; p.c = in[1]; p.ctx = in[2]; p.c_ctx = in[3]; p.norm_g = in[4]; p.w_mod = in[5]; p.b_mod = in[6];
  p.w_in = in[7]; p.conv_w = in[8]; p.conv_b = in[9]; p.lru_wa = in[10]; p.lru_ba = in[11]; p.lru_wx = in[12];
  p.lru_bx = in[13]; p.lru_lambda = in[14]; p.attn_sink = in[15]; p.q_norm_g = in[16]; p.k_norm_g = in[17];
  p.w_branch = in[18]; p.w_out = in[19]; p.final_g = in[20];
  p.out = (float*)d_out;
  char* ws = (char*)d_ws;
  size_t off = 0;
  auto take = [&](size_t bytes) { char* r = ws + off; off += (bytes + 255) & ~(size_t)255; return r; };
  p.ctr = (int*)take(256);
  p.modv = (float*)take((size_t)DEPTH * 17 * 3072 * 4);
  p.sc = (float*)take((size_t)17 * D * 4);
  p.rope = (float*)take(4096 * 4);
  p.xc = (float*)take((size_t)NBATCH * L * D * 4);
  p.WinT = (u16*)take((size_t)DEPTH * INW * D * 2);
  p.WbT = (u16*)take((size_t)DEPTH * 3 * D * D * 2);
  p.WoT = (u16*)take((size_t)DEPTH * D * D * 2);
  const size_t fixed = off;
  int NB = 8;
  while (NB > 1) {
    size_t R = (size_t)NB * (S + L);
    size_t need = fixed + R * (size_t)(1024 + 1024 + 3072 + 2048 + 512 + 512 + 3072) * 2 + 8 * 256;
    if (need <= ws_size) break;
    NB >>= 1;
  }
  p.NB = NB; p.nchunk = NBATCH / NB;
  const size_t R = (size_t)NB * (S + L);
  p.Hb = (u16*)take(R * 1024 * 2);
  p.U = (u16*)take(R * 1024 * 2);
  p.Z = (u16*)take(R * 3072 * 2);
  p.Q = (u16*)take(R * 2048 * 2);
  p.Kb = (u16*)take(R * 512 * 2);
  p.VtL = (u16*)take((size_t)NB * 4 * 128 * S * 2);
  p.VtC = (u16*)take((size_t)NB * 4 * 128 * L * 2);
  p.Ms = (u16*)take(R * 3072 * 2);
  void* args[] = {&p};
  hipError_t e = hipLaunchCooperativeKernel((void*)fwd_megakernel, dim3(grid_blocks), dim3(NTHR), args, 0, stream);
  if (e != hipSuccess) fprintf(stderr, "cooperative launch failed: %s (grid %d)\n", hipGetErrorString(e), grid_blocks);
}
```
